# Optimizing an MI355X kernel written in HIP

```python
import math
import jax
import jax.numpy as jnp
from jax import lax
import numpy as np

D_MODEL = 1024
BATCH = 16
SEQ = 2048
DEPTH = 2
DEC_BATCH = 8
DEC_SEQ = 64
PAST_LEN = 1024

CHUNK = 64
CONV_WIDTH = 4
EPS = 1e-6
D_LRU = 512
LRU_BLOCKS = 8
LRU_BLOCK_DIM = D_LRU // LRU_BLOCKS
LRU_C = 8.0
N_ATT_HEADS = 8
N_KV_HEADS = 2
ATT_HEAD_DIM = 64
D_ATT = N_ATT_HEADS * ATT_HEAD_DIM
D_KV = N_KV_HEADS * ATT_HEAD_DIM
N_IDX_HEADS = 4
IDX_DIM = 64
TOPK_MAX = 256
Q_BLOCK = 64
NUM_BUCKETS = 32
MAX_DISTANCE = 128
SSD_HEADS = 16
SSD_HEAD_DIM = 64
D_SSD = SSD_HEADS * SSD_HEAD_DIM
SSD_GROUPS = 2
D_STATE = 128
SSD_CONV_DIM = D_SSD + 2 * SSD_GROUPS * D_STATE
SSD_CHUNK = 64
D_MIX = D_LRU + D_ATT + D_SSD
SPLITS = (D_LRU, D_LRU, D_ATT, D_KV, D_KV, D_ATT, N_IDX_HEADS * IDX_DIM, IDX_DIM, N_IDX_HEADS, D_SSD, SSD_CONV_DIM, SSD_HEADS)
D_IN_PROJ = 2 * D_LRU + 2 * D_ATT + 2 * D_KV + N_IDX_HEADS * IDX_DIM + IDX_DIM + N_IDX_HEADS + D_SSD + SSD_CONV_DIM + SSD_HEADS

kernel_name = 'hymba_lru_dsa_ssd_streaming_step'


def rmsnorm(x, g):
    xf = x.astype(jnp.float32)
    y = xf * lax.rsqrt(jnp.mean(xf * xf, axis=-1, keepdims=True) + EPS)
    return (y * g.astype(jnp.float32)).astype(x.dtype)


def causal_conv(x, buf, w, b):
    T = x.shape[1]
    xp = jnp.concatenate([buf.astype(x.dtype), x], axis=1)
    y = b.astype(x.dtype)
    for j in range(CONV_WIDTH):
        y = y + xp[:, j:j + T] * w[j].astype(x.dtype)
    return y, xp[:, T:]


def rg_lru(x, h0, w_a, b_a, w_x, b_x, lam):
    Bn, T, _ = x.shape
    xf = x.astype(jnp.float32)
    xb = xf.reshape(Bn, T, LRU_BLOCKS, LRU_BLOCK_DIM)
    r = jax.nn.sigmoid(jnp.einsum('btnc,ncd->btnd', xb, w_a.astype(jnp.float32)).reshape(Bn, T, D_LRU) + b_a.astype(jnp.float32))
    i = jax.nn.sigmoid(jnp.einsum('btnc,ncd->btnd', xb, w_x.astype(jnp.float32)).reshape(Bn, T, D_LRU) + b_x.astype(jnp.float32))
    log_a = -LRU_C * r * jax.nn.softplus(-lam.astype(jnp.float32))
    a = jnp.exp(log_a)
    b = jnp.sqrt(-jnp.expm1(2.0 * log_a)) * (i * xf)
    b = b.at[:, 0].add(a[:, 0] * h0.astype(jnp.float32))

    def combine(e1, e2):
        a1, b1 = e1
        a2, b2 = e2
        return a1 * a2, a2 * b1 + b2

    _, h = lax.associative_scan(combine, (a, b), axis=1)
    return h, h[:, -1]


def t5_bucket(rel):
    half = NUM_BUCKETS // 2
    max_exact = half // 2
    n = jnp.abs(rel)
    large = max_exact + (jnp.log(jnp.maximum(n, 1).astype(jnp.float32) / max_exact) / math.log(MAX_DISTANCE / max_exact) * (half - max_exact)).astype(jnp.int32)
    large = jnp.minimum(large, half - 1)
    return jnp.where(rel > 0, half, 0) + jnp.where(n < max_exact, n, large)


def sparse_attention(q, k, v, q_idx, k_idx, w_idx, pos_q, pos_k, rel_bias):
    Bn, T = q.shape[:2]
    L = k.shape[1]
    k_top = min(TOPK_MAX, L // 4)
    qb = min(Q_BLOCK, T)
    nb = T // qb
    G = N_ATT_HEADS // N_KV_HEADS
    chunk_k = pos_k // CHUNK

    def to_blocks(a):
        return jnp.moveaxis(a.reshape(Bn, nb, qb, *a.shape[2:]), 1, 0)

    def block(args):
        qq, qi, wi, pq = args
        chunk_q = pq // CHUNK
        s = jnp.einsum('bqhd,bld->bqhl', qi, k_idx).astype(jnp.float32) * (IDX_DIM ** -0.5)
        score = jnp.einsum('bqh,bqhl->bql', wi.astype(jnp.float32), jax.nn.relu(s)) * (N_IDX_HEADS ** -0.5)
        admissible = chunk_k[None, :] <= chunk_q[:, None]
        score = jnp.where(admissible[None], score, -jnp.inf)
        _, idx = lax.top_k(score, k_top)
        ksel = jax.vmap(lambda kk, ii: kk[ii])(k, idx)
        vsel = jax.vmap(lambda vv, ii: vv[ii])(v, idx)
        psel = pos_k[idx]
        valid = (psel // CHUNK) <= chunk_q[None, :, None]
        qg = qq.reshape(Bn, qb, N_KV_HEADS, G, ATT_HEAD_DIM)
        logits = jnp.einsum('bqgrd,bqkgd->bqgrk', qg, ksel).astype(jnp.float32) * (ATT_HEAD_DIM ** -0.5)
        bias = rel_bias[t5_bucket(psel - pq[None, :, None])]
        bias = jnp.moveaxis(bias, 2, 3).reshape(Bn, qb, N_KV_HEADS, G, k_top).astype(jnp.float32)
        logits = jnp.where(valid[:, :, None, None, :], logits + bias, -jnp.inf)
        p = jax.nn.softmax(logits, axis=-1)
        o = jnp.einsum('bqgrk,bqkgd->bqgrd', p.astype(vsel.dtype), vsel)
        return o.reshape(Bn, qb, D_ATT)

    out = lax.map(block, (to_blocks(q), to_blocks(q_idx), to_blocks(w_idx), pos_q.reshape(nb, qb)))
    return jnp.moveaxis(out, 0, 1).reshape(Bn, T, D_ATT)


def ssd_scan(x, dt, a, bm, cm, h0):
    Bn, T = x.shape[:2]
    lc = min(SSD_CHUNK, T)
    nc = T // lc

    def chunks(arr):
        return arr.reshape(Bn, nc, lc, *arr.shape[2:])

    x, dt, bm, cm = chunks(x), chunks(dt), chunks(bm), chunks(cm)
    cum = jnp.cumsum(dt * a, axis=2)
    tril = jnp.tril(jnp.ones((lc, lc), dtype=bool))
    seg = cum[:, :, :, None] - cum[:, :, None, :]
    decay = jnp.exp(jnp.where(tril[None, None, :, :, None, None], seg, -jnp.inf))
    cb = jnp.einsum('bclgn,bcsgn->bclsg', cm, bm)
    wts = decay * cb[..., None] * dt[:, :, None]
    y_diag = jnp.einsum('bclsgr,bcsgrp->bclgrp', wts, x)
    to_end = jnp.exp(cum[:, :, -1:] - cum) * dt
    states = jnp.einsum('bclgn,bclgr,bclgrp->bcgrpn', bm, to_end, x)
    chunk_decay = jnp.exp(cum[:, :, -1])

    def step(h, inp):
        dec, st = inp
        return dec[..., None, None] * h + st, h

    h_last, h_prev = lax.scan(step, h0, (jnp.moveaxis(chunk_decay, 1, 0), jnp.moveaxis(states, 1, 0)))
    h_prev = jnp.moveaxis(h_prev, 0, 1)
    y_off = jnp.einsum('bclgn,bcgrpn,bclgr->bclgrp', cm, h_prev, jnp.exp(cum))
    return (y_diag + y_off).reshape(Bn, T, *x.shape[3:]), h_last


def mixer_layer(x, past, p):
    past_k, past_v, past_ki, lru_buf, lru_h0, ssd_buf, ssd_h0 = past
    Bn, T, _ = x.shape
    P = past_k.shape[1]
    pos_k = jnp.arange(P + T, dtype=jnp.int32)
    pos_q = pos_k[P:]
    h = rmsnorm(x, p['norm_w'])
    proj = jnp.einsum('btd,de->bte', h, p['w_in'].astype(h.dtype))
    offs = np.cumsum(np.array(SPLITS))[:-1].tolist()
    xl, gl, q, k, v, ga, qi, ki, wi, z, xbc, dtr = jnp.split(proj, offs, axis=-1)
    xl, lru_buf_new = causal_conv(xl, lru_buf, p['lru_conv_w'], p['lru_conv_b'])
    hl, lru_h_new = rg_lru(xl, lru_h0, p['lru_w_a'], p['lru_b_a'], p['lru_w_x'], p['lru_b_x'], p['lru_lambda'])
    y_a = hl.astype(x.dtype) * jax.nn.silu(gl)
    q = rmsnorm(q.reshape(Bn, T, N_ATT_HEADS, ATT_HEAD_DIM), p['att_q_norm'])
    k = rmsnorm(k.reshape(Bn, T, N_KV_HEADS, ATT_HEAD_DIM), p['att_k_norm'])
    v = v.reshape(Bn, T, N_KV_HEADS, ATT_HEAD_DIM)
    qi = qi.reshape(Bn, T, N_IDX_HEADS, IDX_DIM)
    k_all = jnp.concatenate([past_k.astype(k.dtype), k], axis=1)
    v_all = jnp.concatenate([past_v.astype(v.dtype), v], axis=1)
    ki_all = jnp.concatenate([past_ki.astype(ki.dtype), ki], axis=1)
    o = sparse_attention(q, k_all, v_all, qi, ki_all, wi, pos_q, pos_k, p['rel_bias'])
    y_b = o * jax.nn.silu(ga)
    R = SSD_HEADS // SSD_GROUPS
    xbc, ssd_buf_new = causal_conv(xbc, ssd_buf, p['ssd_conv_w'], p['ssd_conv_b'])
    xbc = jax.nn.silu(xbc)
    xs, bm, cm = jnp.split(xbc, [D_SSD, D_SSD + SSD_GROUPS * D_STATE], axis=-1)
    dt = jax.nn.softplus(dtr.astype(jnp.float32) + p['ssd_dt_bias'].astype(jnp.float32))
    a = -jnp.exp(p['ssd_a_log'].astype(jnp.float32))
    xs5 = xs.astype(jnp.float32).reshape(Bn, T, SSD_GROUPS, R, SSD_HEAD_DIM)
    y_ssd, ssd_h_new = ssd_scan(
        xs5,
        dt.reshape(Bn, T, SSD_GROUPS, R),
        a.reshape(SSD_GROUPS, R),
        bm.astype(jnp.float32).reshape(Bn, T, SSD_GROUPS, D_STATE),
        cm.astype(jnp.float32).reshape(Bn, T, SSD_GROUPS, D_STATE),
        ssd_h0.astype(jnp.float32).reshape(Bn, SSD_GROUPS, R, SSD_HEAD_DIM, D_STATE))
    y_ssd = y_ssd + p['ssd_d'].astype(jnp.float32).reshape(SSD_GROUPS, R, 1) * xs5
    y_ssd = y_ssd.reshape(Bn, T, D_SSD) * jax.nn.silu(z.astype(jnp.float32))
    y_c = rmsnorm(y_ssd.reshape(Bn, T, SSD_GROUPS, D_SSD // SSD_GROUPS),
                  p['ssd_norm'].reshape(SSD_GROUPS, D_SSD // SSD_GROUPS)).reshape(Bn, T, D_SSD).astype(x.dtype)
    mix = jnp.concatenate([y_a, y_b, y_c], axis=-1)
    x = x + jnp.einsum('bte,ed->btd', mix, p['w_out'].astype(mix.dtype)).astype(x.dtype)
    new_state = (k, v, ki, lru_buf_new, lru_h_new, ssd_buf_new, ssd_h_new.reshape(Bn, SSD_HEADS, SSD_HEAD_DIM, D_STATE))
    return x, new_state


def stack_states(states):
    return [jnp.stack([s[i] for s in states]) for i in range(len(states[0]))]


def setup_inputs(seed: int = 0) -> dict:
    key = jax.random.key(seed)
    ks = jax.random.split(key, 32)
    f32 = jnp.float32

    def nrm(k, shape, scale):
        return scale * jax.random.normal(k, shape, f32)

    u_lam = jax.random.uniform(ks[14], (DEPTH, D_LRU), f32, 0.9, 0.999)
    dt0 = jnp.exp(jax.random.uniform(ks[19], (DEPTH, SSD_HEADS), f32, math.log(1e-3), math.log(1e-1)))
    return {
        'x_prompt': nrm(ks[0], (BATCH, SEQ, D_MODEL), 1.0),
        'x_sample': nrm(ks[1], (DEC_BATCH, DEC_SEQ, D_MODEL), 1.0),
        'cache_att_k': nrm(ks[2], (DEPTH, DEC_BATCH, PAST_LEN, N_KV_HEADS, ATT_HEAD_DIM), 1.0),
        'cache_att_v': nrm(ks[3], (DEPTH, DEC_BATCH, PAST_LEN, N_KV_HEADS, ATT_HEAD_DIM), 1.0),
        'cache_idx_k': nrm(ks[4], (DEPTH, DEC_BATCH, PAST_LEN, IDX_DIM), 1.0),
        'state_lru_conv': nrm(ks[5], (DEPTH, DEC_BATCH, CONV_WIDTH - 1, D_LRU), 1.0),
        'state_lru_h': nrm(ks[6], (DEPTH, DEC_BATCH, D_LRU), 0.5),
        'state_ssd_conv': nrm(ks[7], (DEPTH, DEC_BATCH, CONV_WIDTH - 1, SSD_CONV_DIM), 1.0),
        'state_ssd_h': nrm(ks[8], (DEPTH, DEC_BATCH, SSD_HEADS, SSD_HEAD_DIM, D_STATE), 0.1),
        'norm_w': 1.0 + nrm(ks[9], (DEPTH, D_MODEL), 0.05),
        'w_in': nrm(ks[10], (DEPTH, D_MODEL, D_IN_PROJ), D_MODEL ** -0.5),
        'lru_conv_w': nrm(ks[11], (DEPTH, CONV_WIDTH, D_LRU), CONV_WIDTH ** -0.5),
        'lru_conv_b': nrm(ks[12], (DEPTH, D_LRU), 0.02),
        'lru_w_a': nrm(ks[13], (DEPTH, LRU_BLOCKS, LRU_BLOCK_DIM, LRU_BLOCK_DIM), LRU_BLOCK_DIM ** -0.5),
        'lru_b_a': nrm(ks[15], (DEPTH, D_LRU), 0.02),
        'lru_w_x': nrm(ks[16], (DEPTH, LRU_BLOCKS, LRU_BLOCK_DIM, LRU_BLOCK_DIM), LRU_BLOCK_DIM ** -0.5),
        'lru_b_x': nrm(ks[17], (DEPTH, D_LRU), 0.02),
        'lru_lambda': jnp.log(u_lam / (1.0 - u_lam)),
        'att_q_norm': 1.0 + nrm(ks[18], (DEPTH, ATT_HEAD_DIM), 0.05),
        'att_k_norm': 1.0 + nrm(ks[20], (DEPTH, ATT_HEAD_DIM), 0.05),
        'rel_bias': nrm(ks[21], (NUM_BUCKETS, N_ATT_HEADS), 0.5),
        'ssd_conv_w': nrm(ks[22], (DEPTH, CONV_WIDTH, SSD_CONV_DIM), CONV_WIDTH ** -0.5),
        'ssd_conv_b': nrm(ks[23], (DEPTH, SSD_CONV_DIM), 0.02),
        'ssd_dt_bias': dt0 + jnp.log(-jnp.expm1(-dt0)),
        'ssd_a_log': jnp.log(jax.random.uniform(ks[24], (DEPTH, SSD_HEADS), f32, 1.0, 16.0)),
        'ssd_d': 1.0 + nrm(ks[25], (DEPTH, SSD_HEADS), 0.1),
        'ssd_norm': 1.0 + nrm(ks[26], (DEPTH, D_SSD), 0.05),
        'w_out': nrm(ks[27], (DEPTH, D_MIX, D_MODEL), D_MIX ** -0.5),
    }


def reference(x_prompt, x_sample, cache_att_k, cache_att_v, cache_idx_k, state_lru_conv, state_lru_h,
              state_ssd_conv, state_ssd_h, norm_w, w_in, lru_conv_w, lru_conv_b, lru_w_a, lru_b_a,
              lru_w_x, lru_b_x, lru_lambda, att_q_norm, att_k_norm, rel_bias, ssd_conv_w, ssd_conv_b,
              ssd_dt_bias, ssd_a_log, ssd_d, ssd_norm, w_out):
    dtype = x_prompt.dtype
    nb_p = x_prompt.shape[0]
    hp = x_prompt
    hs = x_sample
    prompt_states = []
    sample_states = []
    for l in range(DEPTH):
        p = {
            'norm_w': norm_w[l], 'w_in': w_in[l],
            'lru_conv_w': lru_conv_w[l], 'lru_conv_b': lru_conv_b[l],
            'lru_w_a': lru_w_a[l], 'lru_b_a': lru_b_a[l], 'lru_w_x': lru_w_x[l], 'lru_b_x': lru_b_x[l],
            'lru_lambda': lru_lambda[l],
            'att_q_norm': att_q_norm[l], 'att_k_norm': att_k_norm[l], 'rel_bias': rel_bias,
            'ssd_conv_w': ssd_conv_w[l], 'ssd_conv_b': ssd_conv_b[l], 'ssd_dt_bias': ssd_dt_bias[l],
            'ssd_a_log': ssd_a_log[l], 'ssd_d': ssd_d[l], 'ssd_norm': ssd_norm[l],
            'w_out': w_out[l],
        }
        empty = (
            jnp.zeros((nb_p, 0, N_KV_HEADS, ATT_HEAD_DIM), dtype),
            jnp.zeros((nb_p, 0, N_KV_HEADS, ATT_HEAD_DIM), dtype),
            jnp.zeros((nb_p, 0, IDX_DIM), dtype),
            jnp.zeros((nb_p, CONV_WIDTH - 1, D_LRU), dtype),
            jnp.zeros((nb_p, D_LRU), dtype),
            jnp.zeros((nb_p, CONV_WIDTH - 1, SSD_CONV_DIM), dtype),
            jnp.zeros((nb_p, SSD_HEADS, SSD_HEAD_DIM, D_STATE), dtype),
        )
        hp, st_p = mixer_layer(hp, empty, p)
        prompt_states.append(st_p)
        past = (cache_att_k[l], cache_att_v[l], cache_idx_k[l], state_lru_conv[l], state_lru_h[l],
                state_ssd_conv[l], state_ssd_h[l])
        hs, st_s = mixer_layer(hs, past, p)
        sample_states.append(st_s)
    att_k_p, att_v_p, idx_k_p, lru_conv_p, lru_h_p, ssd_conv_p, ssd_h_p = stack_states(prompt_states)
    att_k_s, att_v_s, idx_k_s, lru_conv_s, lru_h_s, ssd_conv_s, ssd_h_s = stack_states(sample_states)
    return (hp, hs, att_k_p, att_v_p, idx_k_p, lru_conv_p, lru_h_p, ssd_conv_p, ssd_h_p,
            att_k_s, att_v_s, idx_k_s, lru_conv_s, lru_h_s, ssd_conv_s, ssd_h_s)
```

```cpp
#include <hip/hip_runtime.h>
#include <hip/hip_cooperative_groups.h>
#include <cstdio>
#include <cstdint>
namespace cg = cooperative_groups;

#ifndef ONLY
#define ONLY 0xffff
#endif
#ifndef MK_ONE_LAUNCH
#define MK_ONE_LAUNCH 0
#endif

typedef unsigned short bf16_t;
typedef short bf16x8 __attribute__((ext_vector_type(8)));
typedef float f32x4 __attribute__((ext_vector_type(4)));
typedef float f32x16 __attribute__((ext_vector_type(16)));
typedef unsigned u32x4 __attribute__((ext_vector_type(4)));
typedef unsigned u32x2 __attribute__((ext_vector_type(2)));
#define LAS __attribute__((address_space(3)))
#define DI __device__ __forceinline__

constexpr int DM = 1024, NPB = 16, SEQ = 2048, NSB_S = 8, DSEQ = 64, PAST = 1024;
constexpr int ROWS_P = NPB * SEQ;
constexpr int ROWS = ROWS_P + NSB_S * DSEQ;
constexpr int NSB = NPB + NSB_S;
constexpr int DINP = 5204, NPAD = 5376;
constexpr int PJW = 4864;
constexpr int DMIX = 2048;
constexpr float EPS = 1e-6f;
constexpr int C_GL = 0, C_GA = 512, C_Z = 1024, C_XL = 2048, C_Q = 2560, C_QI = 3072, C_XBC = 3328, C_T19 = 4864, C_T20 = 5120;
constexpr int KVW = 320;
constexpr size_t KVB_LAYER = (size_t)NPB * SEQ * KVW + (size_t)NSB_S * (PAST + DSEQ) * KVW;

constexpr size_t O_YP = 0;
constexpr size_t O_YS = O_YP + (size_t)NPB * SEQ * DM;
constexpr size_t O_AKP = O_YS + (size_t)NSB_S * DSEQ * DM;
constexpr size_t O_AVP = O_AKP + (size_t)2 * NPB * SEQ * 128;
constexpr size_t O_IKP = O_AVP + (size_t)2 * NPB * SEQ * 128;
constexpr size_t O_LCP = O_IKP + (size_t)2 * NPB * SEQ * 64;
constexpr size_t O_LHP = O_LCP + (size_t)2 * NPB * 3 * 512;
constexpr size_t O_SCP = O_LHP + (size_t)2 * NPB * 512;
constexpr size_t O_SHP = O_SCP + (size_t)2 * NPB * 3 * 1536;
constexpr size_t O_AKS = O_SHP + (size_t)2 * NPB * 16 * 64 * 128;
constexpr size_t O_AVS = O_AKS + (size_t)2 * NSB_S * DSEQ * 128;
constexpr size_t O_IKS = O_AVS + (size_t)2 * NSB_S * DSEQ * 128;
constexpr size_t O_LCS = O_IKS + (size_t)2 * NSB_S * DSEQ * 64;
constexpr size_t O_LHS = O_LCS + (size_t)2 * NSB_S * 3 * 512;
constexpr size_t O_SCS = O_LHS + (size_t)2 * NSB_S * 512;
constexpr size_t O_SHS = O_SCS + (size_t)2 * NSB_S * 3 * 1536;
constexpr size_t O_END = O_SHS + (size_t)2 * NSB_S * 16 * 64 * 128;

constexpr size_t MiB = 1u << 20;
constexpr size_t WS_CTL = 0, CTL_BYTES = 1 * MiB;
constexpr size_t WS_WIN = 1 * MiB;
constexpr size_t WIN_LAYER = (size_t)NPAD * DM;
constexpr size_t WS_WOUT = 22 * MiB;
constexpr size_t WOUT_LAYER = (size_t)DM * DMIX;
constexpr size_t WS_HB = 30 * MiB;
constexpr size_t WS_RSS = 95 * MiB;
constexpr size_t WS_WI = 98 * MiB;
constexpr size_t WS_DTR = 99 * MiB;
constexpr size_t WS_SSQ = 102 * MiB;
constexpr size_t WS_KVB = 112 * MiB;
constexpr size_t WS_PROJ = 164 * MiB;
constexpr size_t WS_END = WS_PROJ + (size_t)ROWS * PJW * 2;
static_assert(WS_KVB + 2 * KVB_LAYER * 2 <= WS_PROJ, "ws map");
static_assert(WS_END <= 512 * MiB, "ws map");

constexpr int NTHREADS = 512, NWAVES = 8;
constexpr int LDS_BYTES = 147456;

DI float bf2f(bf16_t v) { return __uint_as_float(((unsigned)v) << 16); }
DI bf16_t f2bf(float f) { unsigned u = __float_as_uint(f); return (bf16_t)((u + 0x7fffu + ((u >> 16) & 1u)) >> 16); }
DI unsigned pk2(float lo, float hi) { return (unsigned)f2bf(lo) | ((unsigned)f2bf(hi) << 16); }
DI int crow(int reg, int h) { return (reg & 3) + 8 * (reg >> 2) + 4 * h; }
DI float wave_sum(float v) {
#pragma unroll
    for (int o = 1; o < 64; o <<= 1) v += __shfl_xor(v, o);
    return v;
}
DI float wave_max(float v) {
#pragma unroll
    for (int o = 1; o < 64; o <<= 1) v = fmaxf(v, __shfl_xor(v, o));
    return v;
}
DI float half_sum32(float v) {
#pragma unroll
    for (int o = 1; o < 32; o <<= 1) v += __shfl_xor(v, o);
    return v;
}
DI float silu_f(float x) { return x / (1.f + expf(-x)); }
DI float sigmoid_f(float x) { return 1.f / (1.f + expf(-x)); }
DI float softplus_f(float x) { return x > 20.f ? x : log1pf(expf(x)); }
#define LDS_FENCE() asm volatile("s_waitcnt lgkmcnt(0)" ::: "memory")

__host__ __device__ inline int orig_col(int c) {
    if (c < 512) return 512 + c;
    if (c < 1024) return 1792 + (c - 512);
    if (c < 2048) return 2628 + (c - 1024);
    if (c < 2560) return c - 2048;
    if (c < 3072) return 1024 + (c - 2560);
    if (c < 3328) return 2304 + (c - 3072);
    if (c < 4864) return 3652 + (c - 3328);
    if (c < 5120) { const int cl = c - 4864, bj = cl >> 7, wc = (cl >> 5) & 3, j = cl & 31, d = 32 * bj + j; return (wc < 2 ? 1536 : 1664) + (wc & 1) * 64 + d; }
    const int cl = c - 5120;
    if (cl < 64) return 2560 + cl;
    if (cl < 68) return 2624 + (cl - 64);
    if (cl < 84) return 5188 + (cl - 68);
    return -1;
}
DI int sb_T(int sb) { return sb < NPB ? SEQ : DSEQ; }
DI int sb_P(int sb) { return sb < NPB ? 0 : PAST; }
DI int sb_row0(int sb) { return sb < NPB ? sb * SEQ : ROWS_P + (sb - NPB) * DSEQ; }
DI size_t kvb_off(int sb) { return sb < NPB ? (size_t)sb * SEQ * KVW : (size_t)NPB * SEQ * KVW + (size_t)(sb - NPB) * (PAST + DSEQ) * KVW; }
DI void row_sbt(int m, int& sb, int& t) { if (m < ROWS_P) { sb = m >> 11; t = m & 2047; } else { const int r = m - ROWS_P; sb = NPB + (r >> 6); t = r & 63; } }

typedef const float* cfp_t;
struct Args { const float* in[28]; float* out; unsigned char* ws; int ph_lo, ph_hi; };

struct Ctx {
    float* out; unsigned char* ws;
    LAS unsigned char* lds;
    DI const float* inp(int k) const { return ((LAS cfp_t*)(lds + LDS_BYTES - 256))[k]; }
    int tid, lane, wave, G, bid;
    DI bf16_t* win(int l) const { return (bf16_t*)(ws + WS_WIN) + (size_t)l * WIN_LAYER; }
    DI bf16_t* wout(int l) const { return (bf16_t*)(ws + WS_WOUT) + (size_t)l * WOUT_LAYER; }
    DI bf16_t* hb() const { return (bf16_t*)(ws + WS_HB); }
    DI float* rss() const { return (float*)(ws + WS_RSS); }
    DI float* wi() const { return (float*)(ws + WS_WI); }
    DI float* dtr() const { return (float*)(ws + WS_DTR); }
    DI float* ssq() const { return (float*)(ws + WS_SSQ); }
    DI bf16_t* kvb(int l) const { return (bf16_t*)(ws + WS_KVB) + (size_t)l * KVB_LAYER; }
    DI bf16_t* proj() const { return (bf16_t*)(ws + WS_PROJ); }
};
DI float* out_ak(const Ctx& C, int l, int sb) { return sb < NPB ? C.out + O_AKP + ((size_t)(l * NPB + sb) * SEQ) * 128 : C.out + O_AKS + ((size_t)(l * NSB_S + sb - NPB) * DSEQ) * 128; }
DI float* out_av(const Ctx& C, int l, int sb) { return sb < NPB ? C.out + O_AVP + ((size_t)(l * NPB + sb) * SEQ) * 128 : C.out + O_AVS + ((size_t)(l * NSB_S + sb - NPB) * DSEQ) * 128; }
DI float* out_ik(const Ctx& C, int l, int sb) { return sb < NPB ? C.out + O_IKP + ((size_t)(l * NPB + sb) * SEQ) * 64 : C.out + O_IKS + ((size_t)(l * NSB_S + sb - NPB) * DSEQ) * 64; }
DI float* out_lc(const Ctx& C, int l, int sb) { return sb < NPB ? C.out + O_LCP + (size_t)(l * NPB + sb) * 3 * 512 : C.out + O_LCS + (size_t)(l * NSB_S + sb - NPB) * 3 * 512; }
DI float* out_lh(const Ctx& C, int l, int sb) { return sb < NPB ? C.out + O_LHP + (size_t)(l * NPB + sb) * 512 : C.out + O_LHS + (size_t)(l * NSB_S + sb - NPB) * 512; }
DI float* out_sc(const Ctx& C, int l, int sb) { return sb < NPB ? C.out + O_SCP + (size_t)(l * NPB + sb) * 3 * 1536 : C.out + O_SCS + (size_t)(l * NSB_S + sb - NPB) * 3 * 1536; }
DI float* out_sh(const Ctx& C, int l, int sb) { return sb < NPB ? C.out + O_SHP + (size_t)(l * NPB + sb) * 16 * 64 * 128 : C.out + O_SHS + (size_t)(l * NSB_S + sb - NPB) * 16 * 64 * 128; }

template <int MODE>
DI void p0_transpose_item(const Ctx& C, const float* W, const float* scale, int K, int Nsrc, int Ndst, bf16_t* WT, LAS float* scr, int item) {
    const int lane = C.lane, nblk = Ndst / 32, kb = item / nblk, nb = item % nblk, k0 = 64 * kb, n0 = 32 * nb;
    const int ncol = n0 + (lane & 31);
    const int src = (MODE == 0) ? orig_col(ncol) : ncol;
#pragma unroll 8
    for (int i = 0; i < 32; ++i) {
        const int kk = 2 * i + (lane >> 5), k = k0 + kk;
        float v = 0.f;
        if (src >= 0) {
            v = W[(size_t)k * Nsrc + src];
            if (MODE == 0) v *= scale[k];
            else if (k >= 1024) v *= scale[k - 1024];
        }
        scr[kk * 33 + (lane & 31)] = v;
    }
    LDS_FENCE();
    const int c = lane & 7;
#pragma unroll
    for (int j = 0; j < 4; ++j) {
        const int n = (lane >> 3) + 8 * j; const LAS float* s = scr + (8 * c) * 33 + n;
        u32x4 o; o.x = pk2(s[0 * 33], s[1 * 33]); o.y = pk2(s[2 * 33], s[3 * 33]); o.z = pk2(s[4 * 33], s[5 * 33]); o.w = pk2(s[6 * 33], s[7 * 33]);
        *(u32x4*)(WT + (size_t)(n0 + n) * K + k0 + 8 * c) = o;
    }
    LDS_FENCE();
}
DI void phase_prologue(const Ctx& C) {
    LAS float* scr = (LAS float*)(C.lds + C.wave * 16384);
    const int gw = C.bid * NWAVES + C.wave, NGW = C.G * NWAVES;
    constexpr int I_IN = (DM / 64) * (NPAD / 32), I_OUT = (DMIX / 64) * (DM / 32);
    for (int it = gw; it < 2 * (I_IN + I_OUT); it += NGW) {
        int r = it; const int l = r / (I_IN + I_OUT); r -= l * (I_IN + I_OUT);
        if (r < I_IN) p0_transpose_item<0>(C, C.inp(10) + (size_t)l * DM * DINP, C.inp(9) + l * DM, DM, DINP, NPAD, C.win(l), scr, r);
        else p0_transpose_item<1>(C, C.inp(27) + (size_t)l * DMIX * DM, C.inp(26) + l * 1024, DMIX, DM, DM, C.wout(l), scr, r - I_IN);
    }
    for (int m = gw; m < ROWS; m += NGW) {
        const float* xr = (m < ROWS_P) ? C.inp(0) + (size_t)m * DM : C.inp(1) + (size_t)(m - ROWS_P) * DM;
        float ss = 0.f;
#pragma unroll
        for (int j = 0; j < 4; ++j) {
            const f32x4 v = *(const f32x4*)(xr + 4 * C.lane + 256 * j);
            ss += (v.x * v.x + v.y * v.y) + (v.z * v.z + v.w * v.w);
            u32x2 o; o.x = pk2(v.x, v.y); o.y = pk2(v.z, v.w);
            *(u32x2*)(C.hb() + (size_t)m * DM + 4 * C.lane + 256 * j) = o;
        }
        ss = wave_sum(ss);
        if (C.lane < 16) C.rss()[(size_t)m * 16 + C.lane] = (C.lane == 0) ? ss : 0.f;
    }
    for (int it = gw; it < 2 * NSB_S * PAST; it += NGW) {
        const int l = it / (NSB_S * PAST), r = it % (NSB_S * PAST), b = r / PAST, pos = r % PAST;
        bf16_t* dst = C.kvb(l) + kvb_off(NPB + b) + (size_t)pos * KVW;
        const size_t base = ((size_t)(l * NSB_S + b) * PAST + pos);
#pragma unroll
        for (int j = 0; j < 5; ++j) {
            const int c = C.lane + 64 * j; float v;
            if (c < 128) v = C.inp(2)[base * 128 + c]; else if (c < 256) v = C.inp(3)[base * 128 + (c - 128)]; else v = C.inp(4)[base * 64 + (c - 256)];
            dst[c] = f2bf(v);
        }
    }
}

#define MFMA32(a, b, c) __builtin_amdgcn_mfma_f32_32x32x16_bf16((a), (b), (c), 0, 0, 0)
DI void phase_inproj_simple(const Ctx& C, int l) {
    const int gw = C.bid * NWAVES + C.wave, NGW = C.G * NWAVES, lane = C.lane, r = lane & 31, h = lane >> 5;
    constexpr int NG = 82, NRT = ROWS / 32;
    const bf16_t* WIN = C.win(l); const bf16_t* HB = C.hb(); bf16_t* PJ = C.proj();
    for (int it = gw; it < NRT * NG; it += NGW) {
        const int rt = it / NG, g = it % NG, m0 = rt * 32;
        int c0, c1, type;
        if (g < 76) { c0 = 64 * g; c1 = c0 + 32; type = 0; }
        else if (g < 80) { const int hs = g - 76; c0 = C_T19 + 32 * hs; c1 = c0 + 128; type = hs < 2 ? 1 : 2; }
        else if (g == 80) { c0 = C_T20; c1 = C_T20 + 32; type = 3; }
        else { c0 = C_T20 + 64; c1 = C_T20 + 96; type = 4; }
        f32x16 acc0, acc1;
#pragma unroll
        for (int i = 0; i < 16; ++i) { acc0[i] = 0.f; acc1[i] = 0.f; }
        const bf16_t* Ap = HB + (size_t)(m0 + r) * DM + 8 * h;
        const bf16_t* B0 = WIN + (size_t)(c0 + r) * DM + 8 * h;
        const bf16_t* B1 = WIN + (size_t)(c1 + r) * DM + 8 * h;
#pragma unroll 4
        for (int k0 = 0; k0 < DM; k0 += 16) {
            const bf16x8 a = *(const bf16x8*)(Ap + k0), b0 = *(const bf16x8*)(B0 + k0), b1 = *(const bf16x8*)(B1 + k0);
            acc0 = MFMA32(a, b0, acc0); acc1 = MFMA32(a, b1, acc1);
        }
        float rsc; { const float* p = C.rss() + (size_t)(m0 + r) * 16; float s = 0.f;
#pragma unroll
            for (int j = 0; j < 16; ++j) s += p[j];
            rsc = rsqrtf(s * (1.f / DM) + EPS); }
        const float kn0 = (type == 1) ? C.inp(19)[l * 64 + r] : 1.f, kn1 = (type == 1) ? C.inp(19)[l * 64 + 32 + r] : 1.f;
#pragma unroll
        for (int reg = 0; reg < 16; ++reg) {
            const int rowl = crow(reg, h), m = m0 + rowl;
            const float sc = __shfl(rsc, rowl);
            float v0 = acc0[reg] * sc, v1 = acc1[reg] * sc;
            if (type == 0) { PJ[(size_t)m * PJW + c0 + r] = f2bf(v0); PJ[(size_t)m * PJW + c1 + r] = f2bf(v1); }
            else {
                int sb, t; row_sbt(m, sb, t); const int pos = sb_P(sb) + t;
                bf16_t* kv = C.kvb(l) + kvb_off(sb) + (size_t)pos * KVW;
                if (type == 1) {
                    const int kvh = g - 76;
                    const float ss = half_sum32(v0 * v0 + v1 * v1), rn = rsqrtf(ss * (1.f / 64.f) + EPS);
                    v0 = v0 * rn * kn0; v1 = v1 * rn * kn1;
                    float* o = out_ak(C, l, sb) + (size_t)t * 128 + kvh * 64;
                    o[r] = v0; o[32 + r] = v1; kv[kvh * 64 + r] = f2bf(v0); kv[kvh * 64 + 32 + r] = f2bf(v1);
                } else if (type == 2) {
                    const int kvh = g - 78;
                    float* o = out_av(C, l, sb) + (size_t)t * 128 + kvh * 64;
                    o[r] = v0; o[32 + r] = v1; kv[128 + kvh * 64 + r] = f2bf(v0); kv[128 + kvh * 64 + 32 + r] = f2bf(v1);
                } else if (type == 3) {
                    float* o = out_ik(C, l, sb) + (size_t)t * 64;
                    o[r] = v0; o[32 + r] = v1; kv[256 + r] = f2bf(v0); kv[256 + 32 + r] = f2bf(v1);
                } else {
                    if (r < 4) C.wi()[(size_t)m * 4 + r] = v0; else if (r < 20) C.dtr()[(size_t)m * 16 + (r - 4)] = v0;
                }
            }
        }
    }
}

DI void phase_outproj_simple(const Ctx& C, int l) {
    const int gw = C.bid * NWAVES + C.wave, NGW = C.G * NWAVES, lane = C.lane, r = lane & 31, h = lane >> 5;
    constexpr int NG = DM / 64, NRT = ROWS / 32;
    const bf16_t* WO = C.wout(l); const bf16_t* PJ = C.proj();
    for (int it = gw; it < NRT * NG; it += NGW) {
        const int rt = it / NG, g = it % NG, m0 = rt * 32, c0 = 64 * g, c1 = c0 + 32;
        f32x16 a00, a01, a10, a11, a20, a21;
#pragma unroll
        for (int i = 0; i < 16; ++i) { a00[i] = 0.f; a01[i] = 0.f; a10[i] = 0.f; a11[i] = 0.f; a20[i] = 0.f; a21[i] = 0.f; }
        const bf16_t* Ap = PJ + (size_t)(m0 + r) * PJW + 8 * h;
        const bf16_t* B0 = WO + (size_t)(c0 + r) * DMIX + 8 * h;
        const bf16_t* B1 = WO + (size_t)(c1 + r) * DMIX + 8 * h;
#pragma unroll 4
        for (int k0 = 0; k0 < 1024; k0 += 16) { const bf16x8 a = *(const bf16x8*)(Ap + k0); a00 = MFMA32(a, *(const bf16x8*)(B0 + k0), a00); a01 = MFMA32(a, *(const bf16x8*)(B1 + k0), a01); }
#pragma unroll 4
        for (int k0 = 1024; k0 < 1536; k0 += 16) { const bf16x8 a = *(const bf16x8*)(Ap + k0); a10 = MFMA32(a, *(const bf16x8*)(B0 + k0), a10); a11 = MFMA32(a, *(const bf16x8*)(B1 + k0), a11); }
#pragma unroll 4
        for (int k0 = 1536; k0 < 2048; k0 += 16) { const bf16x8 a = *(const bf16x8*)(Ap + k0); a20 = MFMA32(a, *(const bf16x8*)(B0 + k0), a20); a21 = MFMA32(a, *(const bf16x8*)(B1 + k0), a21); }
        float r0, r1; { const float* p = C.ssq() + (size_t)(m0 + r) * 64; float s0 = 0.f, s1 = 0.f;
#pragma unroll
            for (int j = 0; j < 32; ++j) { s0 += p[j]; s1 += p[32 + j]; }
            r0 = rsqrtf(s0 * (1.f / 512.f) + EPS); r1 = rsqrtf(s1 * (1.f / 512.f) + EPS); }
#pragma unroll
        for (int reg = 0; reg < 16; ++reg) {
            const int rowl = crow(reg, h), m = m0 + rowl;
            const float g0 = __shfl(r0, rowl), g1 = __shfl(r1, rowl);
            const float* xres = (l == 0) ? ((m < ROWS_P) ? C.inp(0) + (size_t)m * DM : C.inp(1) + (size_t)(m - ROWS_P) * DM) : C.out + (size_t)m * DM;
            const float v0 = xres[c0 + r] + a00[reg] + g0 * a10[reg] + g1 * a20[reg];
            const float v1 = xres[c1 + r] + a01[reg] + g0 * a11[reg] + g1 * a21[reg];
            C.out[(size_t)m * DM + c0 + r] = v0; C.out[(size_t)m * DM + c1 + r] = v1;
            if (l == 0) {
                C.hb()[(size_t)m * DM + c0 + r] = f2bf(v0); C.hb()[(size_t)m * DM + c1 + r] = f2bf(v1);
                const float ss = half_sum32(v0 * v0 + v1 * v1);
                if (r == 0) C.rss()[(size_t)m * 16 + g] = ss;
            }
        }
    }
}

DI void phase_conv_naive(const Ctx& C, int l) {
    const int gt = C.bid * NTHREADS + C.tid, NGT = C.G * NTHREADS;
    bf16_t* PJ = C.proj();
    for (int i = gt; i < NSB * 1536; i += NGT) {
        const int sb = i / 1536, ch = i % 1536, T = sb_T(sb), row0 = sb_row0(sb);
        const float* cw = C.inp(21) + (size_t)l * 4 * 1536; const float w0 = cw[ch], w1 = cw[1536 + ch], w2 = cw[2 * 1536 + ch], w3 = cw[3 * 1536 + ch], bias = C.inp(22)[l * 1536 + ch];
        float h0 = 0.f, h1 = 0.f, h2 = 0.f;
        if (sb >= NPB) { const float* st = C.inp(7) + ((size_t)(l * NSB_S + sb - NPB) * 3) * 1536; h0 = st[ch]; h1 = st[1536 + ch]; h2 = st[2 * 1536 + ch]; }
        bf16_t* p = PJ + (size_t)row0 * PJW + C_XBC + ch;
        for (int t = 0; t < T; ++t) {
            const float x = bf2f(p[(size_t)t * PJW]);
            const float y = bias + w0 * h0 + w1 * h1 + w2 * h2 + w3 * x;
            p[(size_t)t * PJW] = f2bf(silu_f(y));
            h0 = h1; h1 = h2; h2 = x;
        }
        float* o = out_sc(C, l, sb); o[ch] = h0; o[1536 + ch] = h1; o[2 * 1536 + ch] = h2;
    }
}

DI void lru_item_naive(const Ctx& C, int l, int sb, int blk, LAS unsigned char* scr) {
    const int lane = C.lane, ch = blk * 64 + lane, T = sb_T(sb), row0 = sb_row0(sb);
    bf16_t* PJ = C.proj();
    LAS unsigned* wl = (LAS unsigned*)scr;
    { const float* pa = C.inp(13) + (size_t)(l * 8 + blk) * 4096 + lane; const float* px = C.inp(15) + (size_t)(l * 8 + blk) * 4096 + lane;
      for (int c = 0; c < 64; ++c) wl[c * 64 + lane] = pk2(pa[c * 64], px[c * 64]); }
    LDS_FENCE();
    const float ba = C.inp(14)[l * 512 + ch], bx = C.inp(16)[l * 512 + ch];
    const float spl = softplus_f(-C.inp(17)[l * 512 + ch]);
    const float* cw = C.inp(11) + (size_t)l * 4 * 512; const float w0 = cw[ch], w1 = cw[512 + ch], w2 = cw[1024 + ch], w3 = cw[1536 + ch], cb = C.inp(12)[l * 512 + ch];
    float h0 = 0.f, h1 = 0.f, h2 = 0.f, hs = 0.f;
    if (sb >= NPB) { const float* st = C.inp(5) + ((size_t)(l * NSB_S + sb - NPB) * 3) * 512; h0 = st[ch]; h1 = st[512 + ch]; h2 = st[1024 + ch]; hs = C.inp(6)[(size_t)(l * NSB_S + sb - NPB) * 512 + ch]; }
    for (int t = 0; t < T; ++t) {
        const size_t rb = (size_t)(row0 + t) * PJW;
        const float x = bf2f(PJ[rb + C_XL + ch]);
        const float xc = cb + w0 * h0 + w1 * h1 + w2 * h2 + w3 * x;
        h0 = h1; h1 = h2; h2 = x;
        float ga = ba, gx = bx;
#pragma unroll 8
        for (int c = 0; c < 64; ++c) { const float xv = __shfl(xc, c); const unsigned w = wl[c * 64 + lane]; ga += xv * __uint_as_float(w << 16); gx += xv * __uint_as_float(w & 0xffff0000u); }
        const float rg = sigmoid_f(ga), ig = sigmoid_f(gx);
        const float log_a = -8.f * rg * spl, a = expf(log_a), mult = sqrtf(-expm1f(2.f * log_a));
        hs = a * hs + mult * (ig * xc);
        const float gl = bf2f(PJ[rb + C_GL + ch]);
        PJ[rb + C_GL + ch] = f2bf(hs * silu_f(gl));
    }
    float* oc = out_lc(C, l, sb); oc[ch] = h0; oc[512 + ch] = h1; oc[1024 + ch] = h2;
    out_lh(C, l, sb)[ch] = hs;
}

DI void ssd_item_naive(const Ctx& C, int l, int sb, int hd, int pq) {
    const int lane = C.lane, T = sb_T(sb), row0 = sb_row0(sb), g = hd >> 3;
    const int p = 16 * pq + (lane & 15), nq = lane >> 4, n0 = 32 * nq;
    bf16_t* PJ = C.proj();
    float hst[32];
    if (sb >= NPB) { const float* st = C.inp(8) + (((size_t)(l * NSB_S + sb - NPB) * 16 + hd) * 64 + p) * 128 + n0;
#pragma unroll
        for (int n = 0; n < 32; n += 4) { const f32x4 v = *(const f32x4*)(st + n); hst[n] = v.x; hst[n + 1] = v.y; hst[n + 2] = v.z; hst[n + 3] = v.w; } }
    else {
#pragma unroll
        for (int n = 0; n < 32; ++n) hst[n] = 0.f; }
    const float aneg = -expf(C.inp(24)[l * 16 + hd]), dtb = C.inp(23)[l * 16 + hd], Dh = C.inp(25)[l * 16 + hd];
    for (int t = 0; t < T; ++t) {
        const size_t rb = (size_t)(row0 + t) * PJW;
        const float dt = softplus_f(C.dtr()[(size_t)(row0 + t) * 16 + hd] + dtb), da = expf(dt * aneg);
        const float xs = bf2f(PJ[rb + C_XBC + hd * 64 + p]), dtx = dt * xs;
        const bf16_t* Bp = PJ + rb + C_XBC + 1024 + g * 128 + n0; const bf16_t* Cp = PJ + rb + C_XBC + 1280 + g * 128 + n0;
        float y = 0.f;
#pragma unroll
        for (int n = 0; n < 32; n += 8) {
            const bf16x8 bv = *(const bf16x8*)(Bp + n), cv = *(const bf16x8*)(Cp + n);
#pragma unroll
            for (int j = 0; j < 8; ++j) { hst[n + j] = da * hst[n + j] + dtx * bf2f((bf16_t)bv[j]); y += bf2f((bf16_t)cv[j]) * hst[n + j]; }
        }
        y += __shfl_xor(y, 16); y += __shfl_xor(y, 32);
        y += Dh * xs;
        const float z = bf2f(PJ[rb + C_Z + hd * 64 + p]);
        y *= silu_f(z);
        if (nq == 0) PJ[rb + C_Z + hd * 64 + p] = f2bf(y);
        const float ss = wave_sum(nq == 0 ? y * y : 0.f);
        if (lane == 0) C.ssq()[(size_t)(row0 + t) * 64 + hd * 4 + pq] = ss;
    }
    float* o = out_sh(C, l, sb) + ((size_t)hd * 64 + p) * 128 + n0;
#pragma unroll
    for (int n = 0; n < 32; n += 4) { f32x4 v; v.x = hst[n]; v.y = hst[n + 1]; v.z = hst[n + 2]; v.w = hst[n + 3]; *(f32x4*)(o + n) = v; }
}

DI unsigned mono_key(float f) { const unsigned u = __float_as_uint(f); return (u & 0x80000000u) ? ~u : (u | 0x80000000u); }
DI int t5_bucket(int rel) {
    const int n = rel < 0 ? -rel : rel; int b;
    if (n < 8) b = n; else if (n < 12) b = 8; else if (n < 16) b = 9; else if (n < 23) b = 10; else if (n < 32) b = 11; else if (n < 46) b = 12; else if (n < 64) b = 13; else if (n < 91) b = 14; else b = 15;
    return b + (rel > 0 ? 16 : 0);
}
DI void attn_item_naive(const Ctx& C, int l, int m, LAS unsigned char* scr) {
    const int lane = C.lane;
    int sb, t; row_sbt(m, sb, t);
    const int P = sb_P(sb), posq = P + t, Ladm = 64 * ((posq >> 6) + 1), nsel = Ladm < 256 ? Ladm : 256;
    LAS unsigned* keys = (LAS unsigned*)scr; LAS unsigned* sel = keys + 2048; LAS float* qs = (LAS float*)(sel + 256); LAS float* ps = qs + 64; LAS float* qis = ps + 256;
    bf16_t* PJ = C.proj(); const bf16_t* KV = C.kvb(l) + kvb_off(sb);
    const size_t rb = (size_t)m * PJW;
#pragma unroll
    for (int j = 0; j < 4; ++j) qis[64 * j + lane] = bf2f(PJ[rb + C_QI + 64 * j + lane]);
    LDS_FENCE();
    const float w0 = C.wi()[(size_t)m * 4 + 0], w1 = C.wi()[(size_t)m * 4 + 1], w2 = C.wi()[(size_t)m * 4 + 2], w3 = C.wi()[(size_t)m * 4 + 3];
    for (int s = lane; s < Ladm; s += 64) {
        asm volatile("" ::: "memory");
        const bf16_t* kp = KV + (size_t)s * KVW + 256;
        float d0 = 0.f, d1 = 0.f, d2 = 0.f, d3 = 0.f;
#pragma unroll
        for (int d = 0; d < 64; d += 8) {
            const bf16x8 kv8 = *(const bf16x8*)(kp + d);
#pragma unroll
            for (int j = 0; j < 8; ++j) { const float kf = bf2f((bf16_t)kv8[j]); d0 += qis[d + j] * kf; d1 += qis[64 + d + j] * kf; d2 += qis[128 + d + j] * kf; d3 += qis[192 + d + j] * kf; }
            asm volatile("" ::: "memory");
        }
        const float score = ((w0 * fmaxf(d0, 0.f) + w1 * fmaxf(d1, 0.f)) + w2 * fmaxf(d2, 0.f)) + w3 * fmaxf(d3, 0.f);
        keys[s] = mono_key(score);
    }
    LDS_FENCE();
    for (int s = lane; s < Ladm; s += 64) {
        const unsigned km = keys[s]; int cnt = 0;
        for (int sp = 0; sp < Ladm; sp += 4) {
            const u32x4 kq = *(const LAS u32x4*)(keys + sp);
            cnt += (kq.x > km) | ((kq.x == km) & (sp < s));
            cnt += (kq.y > km) | ((kq.y == km) & (sp + 1 < s));
            cnt += (kq.z > km) | ((kq.z == km) & (sp + 2 < s));
            cnt += (kq.w > km) | ((kq.w == km) & (sp + 3 < s));
        }
        if (cnt < 256) sel[cnt] = (unsigned)s;
    }
    LDS_FENCE();
    for (int hq = 0; hq < 8; ++hq) {
        const int kvh = hq >> 2;
        { const float raw = bf2f(PJ[rb + C_Q + hq * 64 + lane]); const float ss = wave_sum(raw * raw);
          qs[lane] = raw * rsqrtf(ss * (1.f / 64.f) + EPS) * C.inp(18)[l * 64 + lane]; }
        LDS_FENCE();
        float lg[4]; float mx = -INFINITY;
#pragma unroll
        for (int i = 0; i < 4; ++i) {
            const int j = lane + 64 * i; lg[i] = -INFINITY;
            asm volatile("" ::: "memory");
            if (j < nsel) {
                const int s = (int)sel[j]; const bf16_t* kp = KV + (size_t)s * KVW + kvh * 64; float dot = 0.f;
#pragma unroll
                for (int d = 0; d < 64; d += 8) { const bf16x8 kv8 = *(const bf16x8*)(kp + d);
#pragma unroll
                    for (int jj = 0; jj < 8; ++jj) dot += qs[d + jj] * bf2f((bf16_t)kv8[jj]); }
                lg[i] = dot * 0.125f + C.inp(20)[t5_bucket(s - posq) * 8 + hq];
                mx = fmaxf(mx, lg[i]);
            }
        }
        mx = wave_max(mx);
        float sum = 0.f;
#pragma unroll
        for (int i = 0; i < 4; ++i) { const int j = lane + 64 * i; if (j < nsel) { lg[i] = expf(lg[i] - mx); sum += lg[i]; } }
        sum = wave_sum(sum); const float inv = 1.f / sum;
#pragma unroll
        for (int i = 0; i < 4; ++i) { const int j = lane + 64 * i; if (j < nsel) ps[j] = lg[i] * inv; }
        LDS_FENCE();
        float o = 0.f;
        for (int j = 0; j < nsel; ++j) o += ps[j] * bf2f(KV[(size_t)sel[j] * KVW + 128 + kvh * 64 + lane]);
        const float ga = bf2f(PJ[rb + C_GA + hq * 64 + lane]);
        PJ[rb + C_GA + hq * 64 + lane] = f2bf(o * silu_f(ga));
        LDS_FENCE();
    }
}

DI void phase_mixers_naive(const Ctx& C, int l) {
    for (int i = C.bid + C.G * C.wave; i < 1728; i += C.G * NWAVES) {
        int kind, sb, sub;
        if (i < 1024) { kind = 0; sb = i >> 6; sub = i & 63; }
        else if (i < 1152) { kind = 1; sb = (i - 1024) >> 3; sub = (i - 1024) & 7; }
        else if (i < 1664) { kind = 0; sb = NPB + ((i - 1152) >> 6); sub = (i - 1152) & 63; }
        else { kind = 1; sb = NPB + ((i - 1664) >> 3); sub = (i - 1664) & 7; }
        if (kind == 0) { if (ONLY & 32) ssd_item_naive(C, l, sb, sub >> 2, sub & 3); }
        else { if (ONLY & 64) lru_item_naive(C, l, sb, sub, C.lds + C.wave * 16384); }
    }
    LAS unsigned char* scr = C.lds + C.wave * 16384;
    const int gw = C.bid * NWAVES + C.wave, NGW = C.G * NWAVES;
    if (ONLY & 128) for (int m = gw; m < ROWS; m += NGW) attn_item_naive(C, l, m, scr);
}

constexpr int N_PHASES = 9;
__global__ void __launch_bounds__(NTHREADS, 2) mk_fwd(Args a) {
    extern __shared__ __attribute__((aligned(16))) unsigned char lds_raw[];
    Ctx C; C.out = a.out; C.ws = a.ws; C.lds = (LAS unsigned char*)lds_raw;
    C.tid = threadIdx.x; C.lane = C.tid & 63; C.wave = __builtin_amdgcn_readfirstlane(C.tid >> 6); C.G = gridDim.x; C.bid = blockIdx.x;
    if (C.tid == 0) {
#pragma unroll
        for (int i = 0; i < 28; ++i) ((LAS cfp_t*)(C.lds + LDS_BYTES - 256))[i] = a.in[i];
    }
    __syncthreads();
    const Ctx C0 = C;
    for (int ph = a.ph_lo; ph < a.ph_hi; ++ph) {
        C = C0; asm volatile("" : "+v"(C.lane), "+v"(C.tid)); asm volatile("" : "+s"(C.ws), "+s"(C.out));
        if (ph == 0) { if (ONLY & 16) phase_prologue(C); }
        else {
            const int l = (ph - 1) >> 2, k = (ph - 1) & 3;
            if (k == 0) { if (ONLY & 1) phase_inproj_simple(C, l); }
            else if (k == 1) { if (ONLY & 2) phase_conv_naive(C, l); }
            else if (k == 2) { if (ONLY & 4) phase_mixers_naive(C, l); }
            else { if (ONLY & 8) phase_outproj_simple(C, l); }
        }
#if MK_ONE_LAUNCH
        if (ph + 1 < a.ph_hi) cg::this_grid().sync();
#endif
    }
}

extern "C" void kernel_launch(void* const* d_in, const int* in_sizes, int n_in, void* d_out, int out_size, void* d_ws, size_t ws_size, hipStream_t stream) {
    static int grid = 0;
    if (grid == 0) {
        if (n_in != 28 || (size_t)out_size != O_END || ws_size < WS_END) { fprintf(stderr, "kernel_launch: unexpected shapes n_in %d out %d ws %zu\n", n_in, out_size, ws_size); grid = -1; return; }
        int dev = 0, cus = 0, per_cu = 0;
        hipGetDevice(&dev); hipDeviceGetAttribute(&cus, hipDeviceAttributeMultiprocessorCount, dev);
        hipFuncSetAttribute((const void*)mk_fwd, hipFuncAttributeMaxDynamicSharedMemorySize, LDS_BYTES);
        hipOccupancyMaxActiveBlocksPerMultiprocessor(&per_cu, (const void*)mk_fwd, NTHREADS, LDS_BYTES);
        if (per_cu < 1) per_cu = 1;
        grid = cus * 1;
        (void)hipGetLastError();
    }
    if (grid < 0) return;
    hipMemsetAsync((char*)d_ws + WS_CTL, 0, CTL_BYTES, stream);
    Args a{};
    for (int i = 0; i < 28; ++i) a.in[i] = (const float*)d_in[i];
    a.out = (float*)d_out; a.ws = (unsigned char*)d_ws;
#if MK_ONE_LAUNCH
    a.ph_lo = 0; a.ph_hi = N_PHASES;
    void* args[] = {&a};
    hipError_t e = hipLaunchCooperativeKernel((const void*)mk_fwd, dim3(grid), dim3(NTHREADS), args, LDS_BYTES, stream);
    if (e != hipSuccess) fprintf(stderr, "cooperative launch failed: %s (grid %d)\n", hipGetErrorString(e), grid);
#else
    for (int ph = 0; ph < N_PHASES; ++ph) { a.ph_lo = ph; a.ph_hi = ph + 1; hipLaunchKernelGGL(mk_fwd, dim3(grid), dim3(NTHREADS), LDS_BYTES, stream, a); }
#endif
}
```

```cpp
#include <hip/hip_runtime.h>
#include <hip/hip_cooperative_groups.h>
#include <cstdio>
#include <cstdint>
namespace cg = cooperative_groups;

#ifndef ONLY
#define ONLY 0xffff
#endif
#ifndef MK_ONE_LAUNCH
#define MK_ONE_LAUNCH 1
#endif

typedef unsigned short bf16_t;
typedef short bf16x8 __attribute__((ext_vector_type(8)));
typedef float f32x4 __attribute__((ext_vector_type(4)));
typedef float f32x16 __attribute__((ext_vector_type(16)));
typedef unsigned u32x4 __attribute__((ext_vector_type(4)));
typedef unsigned u32x2 __attribute__((ext_vector_type(2)));
#define LAS __attribute__((address_space(3)))
#define DI __device__ __forceinline__

constexpr int DM = 1024, NPB = 16, SEQ = 2048, NSB_S = 8, DSEQ = 64, PAST = 1024;
constexpr int ROWS_P = NPB * SEQ;
constexpr int ROWS = ROWS_P + NSB_S * DSEQ;
constexpr int NSB = NPB + NSB_S;
constexpr int DINP = 5204, NPAD = 5376;
constexpr int PJW = 4864;
constexpr int DMIX = 2048;
constexpr float EPS = 1e-6f;
constexpr int C_GL = 0, C_GA = 512, C_Z = 1024, C_XL = 2048, C_Q = 2560, C_QI = 3072, C_XBC = 3328, C_T19 = 4864, C_T20 = 5120;
constexpr int KVW = 320;
constexpr size_t KVB_LAYER = (size_t)NPB * SEQ * KVW + (size_t)NSB_S * (PAST + DSEQ) * KVW;

constexpr size_t O_YP = 0;
constexpr size_t O_YS = O_YP + (size_t)NPB * SEQ * DM;
constexpr size_t O_AKP = O_YS + (size_t)NSB_S * DSEQ * DM;
constexpr size_t O_AVP = O_AKP + (size_t)2 * NPB * SEQ * 128;
constexpr size_t O_IKP = O_AVP + (size_t)2 * NPB * SEQ * 128;
constexpr size_t O_LCP = O_IKP + (size_t)2 * NPB * SEQ * 64;
constexpr size_t O_LHP = O_LCP + (size_t)2 * NPB * 3 * 512;
constexpr size_t O_SCP = O_LHP + (size_t)2 * NPB * 512;
constexpr size_t O_SHP = O_SCP + (size_t)2 * NPB * 3 * 1536;
constexpr size_t O_AKS = O_SHP + (size_t)2 * NPB * 16 * 64 * 128;
constexpr size_t O_AVS = O_AKS + (size_t)2 * NSB_S * DSEQ * 128;
constexpr size_t O_IKS = O_AVS + (size_t)2 * NSB_S * DSEQ * 128;
constexpr size_t O_LCS = O_IKS + (size_t)2 * NSB_S * DSEQ * 64;
constexpr size_t O_LHS = O_LCS + (size_t)2 * NSB_S * 3 * 512;
constexpr size_t O_SCS = O_LHS + (size_t)2 * NSB_S * 512;
constexpr size_t O_SHS = O_SCS + (size_t)2 * NSB_S * 3 * 1536;
constexpr size_t O_END = O_SHS + (size_t)2 * NSB_S * 16 * 64 * 128;

constexpr size_t MiB = 1u << 20;
constexpr size_t WS_CTL = 0, CTL_BYTES = 1 * MiB;
constexpr size_t WS_WIN = 1 * MiB;
constexpr size_t WIN_LAYER = (size_t)NPAD * DM;
constexpr size_t WS_WOUT = 22 * MiB;
constexpr size_t WOUT_LAYER = (size_t)DM * DMIX;
constexpr size_t WS_HB = 30 * MiB;
constexpr size_t WS_RSS = 95 * MiB;
constexpr size_t WS_WI = 98 * MiB;
constexpr size_t WS_DTR = 99 * MiB;
constexpr size_t WS_SSQ = 102 * MiB;
constexpr size_t WS_KVB = 112 * MiB;
constexpr size_t WS_PROJ = 164 * MiB;
constexpr size_t WS_END = WS_PROJ + (size_t)ROWS * PJW * 2;
static_assert(WS_KVB + 2 * KVB_LAYER * 2 <= WS_PROJ, "ws map");
static_assert(WS_END <= 512 * MiB, "ws map");

constexpr int NTHREADS = 512, NWAVES = 8;
constexpr int LDS_BYTES = 147456;

DI float bf2f(bf16_t v) { return __uint_as_float(((unsigned)v) << 16); }
DI bf16_t f2bf(float f) { unsigned u = __float_as_uint(f); return (bf16_t)((u + 0x7fffu + ((u >> 16) & 1u)) >> 16); }
DI unsigned pk2(float lo, float hi) { return (unsigned)f2bf(lo) | ((unsigned)f2bf(hi) << 16); }
DI int crow(int reg, int h) { return (reg & 3) + 8 * (reg >> 2) + 4 * h; }
DI float wave_sum(float v) {
#pragma unroll
    for (int o = 1; o < 64; o <<= 1) v += __shfl_xor(v, o);
    return v;
}
DI float wave_max(float v) {
#pragma unroll
    for (int o = 1; o < 64; o <<= 1) v = fmaxf(v, __shfl_xor(v, o));
    return v;
}
DI float half_sum32(float v) {
#pragma unroll
    for (int o = 1; o < 32; o <<= 1) v += __shfl_xor(v, o);
    return v;
}
DI float silu_f(float x) { return x / (1.f + expf(-x)); }
DI float sigmoid_f(float x) { return 1.f / (1.f + expf(-x)); }
DI float softplus_f(float x) { return x > 20.f ? x : log1pf(expf(x)); }
#define LDS_FENCE() asm volatile("s_waitcnt lgkmcnt(0)" ::: "memory")

__host__ __device__ inline int orig_col(int c) {
    if (c < 512) return 512 + c;
    if (c < 1024) return 1792 + (c - 512);
    if (c < 2048) return 2628 + (c - 1024);
    if (c < 2560) return c - 2048;
    if (c < 3072) return 1024 + (c - 2560);
    if (c < 3328) return 2304 + (c - 3072);
    if (c < 4864) return 3652 + (c - 3328);
    if (c < 5120) { const int cl = c - 4864, bj = cl >> 7, wc = (cl >> 5) & 3, j = cl & 31, d = 32 * bj + j; return (wc < 2 ? 1536 : 1664) + (wc & 1) * 64 + d; }
    const int cl = c - 5120;
    if (cl < 64) return 2560 + cl;
    if (cl < 68) return 2624 + (cl - 64);
    if (cl < 84) return 5188 + (cl - 68);
    return -1;
}
DI int sb_T(int sb) { return sb < NPB ? SEQ : DSEQ; }
DI int sb_P(int sb) { return sb < NPB ? 0 : PAST; }
DI int sb_row0(int sb) { return sb < NPB ? sb * SEQ : ROWS_P + (sb - NPB) * DSEQ; }
DI size_t kvb_off(int sb) { return sb < NPB ? (size_t)sb * SEQ * KVW : (size_t)NPB * SEQ * KVW + (size_t)(sb - NPB) * (PAST + DSEQ) * KVW; }
DI void row_sbt(int m, int& sb, int& t) { if (m < ROWS_P) { sb = m >> 11; t = m & 2047; } else { const int r = m - ROWS_P; sb = NPB + (r >> 6); t = r & 63; } }

typedef const float* cfp_t;
struct Args { const float* in[28]; float* out; unsigned char* ws; int ph_lo, ph_hi; };

struct Ctx {
    float* out; unsigned char* ws;
    LAS unsigned char* lds;
    DI const float* inp(int k) const { return ((LAS cfp_t*)(lds + LDS_BYTES - 256))[k]; }
    int tid, lane, wave, G, bid;
    DI bf16_t* win(int l) const { return (bf16_t*)(ws + WS_WIN) + (size_t)l * WIN_LAYER; }
    DI bf16_t* wout(int l) const { return (bf16_t*)(ws + WS_WOUT) + (size_t)l * WOUT_LAYER; }
    DI bf16_t* hb() const { return (bf16_t*)(ws + WS_HB); }
    DI float* rss() const { return (float*)(ws + WS_RSS); }
    DI float* wi() const { return (float*)(ws + WS_WI); }
    DI float* dtr() const { return (float*)(ws + WS_DTR); }
    DI float* ssq() const { return (float*)(ws + WS_SSQ); }
    DI bf16_t* kvb(int l) const { return (bf16_t*)(ws + WS_KVB) + (size_t)l * KVB_LAYER; }
    DI bf16_t* proj() const { return (bf16_t*)(ws + WS_PROJ); }
};
DI float* out_ak(const Ctx& C, int l, int sb) { return sb < NPB ? C.out + O_AKP + ((size_t)(l * NPB + sb) * SEQ) * 128 : C.out + O_AKS + ((size_t)(l * NSB_S + sb - NPB) * DSEQ) * 128; }
DI float* out_av(const Ctx& C, int l, int sb) { return sb < NPB ? C.out + O_AVP + ((size_t)(l * NPB + sb) * SEQ) * 128 : C.out + O_AVS + ((size_t)(l * NSB_S + sb - NPB) * DSEQ) * 128; }
DI float* out_ik(const Ctx& C, int l, int sb) { return sb < NPB ? C.out + O_IKP + ((size_t)(l * NPB + sb) * SEQ) * 64 : C.out + O_IKS + ((size_t)(l * NSB_S + sb - NPB) * DSEQ) * 64; }
DI float* out_lc(const Ctx& C, int l, int sb) { return sb < NPB ? C.out + O_LCP + (size_t)(l * NPB + sb) * 3 * 512 : C.out + O_LCS + (size_t)(l * NSB_S + sb - NPB) * 3 * 512; }
DI float* out_lh(const Ctx& C, int l, int sb) { return sb < NPB ? C.out + O_LHP + (size_t)(l * NPB + sb) * 512 : C.out + O_LHS + (size_t)(l * NSB_S + sb - NPB) * 512; }
DI float* out_sc(const Ctx& C, int l, int sb) { return sb < NPB ? C.out + O_SCP + (size_t)(l * NPB + sb) * 3 * 1536 : C.out + O_SCS + (size_t)(l * NSB_S + sb - NPB) * 3 * 1536; }
DI float* out_sh(const Ctx& C, int l, int sb) { return sb < NPB ? C.out + O_SHP + (size_t)(l * NPB + sb) * 16 * 64 * 128 : C.out + O_SHS + (size_t)(l * NSB_S + sb - NPB) * 16 * 64 * 128; }

template <int MODE>
DI void p0_transpose_item(const Ctx& C, const float* W, const float* scale, int K, int Nsrc, int Ndst, bf16_t* WT, LAS float* scr, int item) {
    const int lane = C.lane, nblk = Ndst / 32, kb = item / nblk, nb = item % nblk, k0 = 64 * kb, n0 = 32 * nb;
    const int ncol = n0 + (lane & 31);
    const int src = (MODE == 0) ? orig_col(ncol) : ncol;
#pragma unroll 8
    for (int i = 0; i < 32; ++i) {
        const int kk = 2 * i + (lane >> 5), k = k0 + kk;
        float v = 0.f;
        if (src >= 0) {
            v = W[(size_t)k * Nsrc + src];
            if (MODE == 0) v *= scale[k];
            else if (k >= 1024) v *= scale[k - 1024];
        }
        scr[kk * 33 + (lane & 31)] = v;
    }
    LDS_FENCE();
    const int c = lane & 7;
#pragma unroll
    for (int j = 0; j < 4; ++j) {
        const int n = (lane >> 3) + 8 * j; const LAS float* s = scr + (8 * c) * 33 + n;
        u32x4 o; o.x = pk2(s[0 * 33], s[1 * 33]); o.y = pk2(s[2 * 33], s[3 * 33]); o.z = pk2(s[4 * 33], s[5 * 33]); o.w = pk2(s[6 * 33], s[7 * 33]);
        *(u32x4*)(WT + (size_t)(n0 + n) * K + k0 + 8 * c) = o;
    }
    LDS_FENCE();
}
DI void phase_prologue(const Ctx& C) {
    LAS float* scr = (LAS float*)(C.lds + C.wave * 16384);
    const int gw = C.bid * NWAVES + C.wave, NGW = C.G * NWAVES;
    constexpr int I_IN = (DM / 64) * (NPAD / 32), I_OUT = (DMIX / 64) * (DM / 32);
    for (int it = gw; it < 2 * (I_IN + I_OUT); it += NGW) {
        int r = it; const int l = r / (I_IN + I_OUT); r -= l * (I_IN + I_OUT);
        if (r < I_IN) p0_transpose_item<0>(C, C.inp(10) + (size_t)l * DM * DINP, C.inp(9) + l * DM, DM, DINP, NPAD, C.win(l), scr, r);
        else p0_transpose_item<1>(C, C.inp(27) + (size_t)l * DMIX * DM, C.inp(26) + l * 1024, DMIX, DM, DM, C.wout(l), scr, r - I_IN);
    }
    for (int m = gw; m < ROWS; m += NGW) {
        const float* xr = (m < ROWS_P) ? C.inp(0) + (size_t)m * DM : C.inp(1) + (size_t)(m - ROWS_P) * DM;
        float ss = 0.f;
#pragma unroll
        for (int j = 0; j < 4; ++j) {
            const f32x4 v = *(const f32x4*)(xr + 4 * C.lane + 256 * j);
            ss += (v.x * v.x + v.y * v.y) + (v.z * v.z + v.w * v.w);
            u32x2 o; o.x = pk2(v.x, v.y); o.y = pk2(v.z, v.w);
            *(u32x2*)(C.hb() + (size_t)m * DM + 4 * C.lane + 256 * j) = o;
        }
        ss = wave_sum(ss);
        if (C.lane < 16) C.rss()[(size_t)m * 16 + C.lane] = (C.lane == 0) ? ss : 0.f;
    }
    for (int it = gw; it < 2 * NSB_S * PAST; it += NGW) {
        const int l = it / (NSB_S * PAST), r = it % (NSB_S * PAST), b = r / PAST, pos = r % PAST;
        bf16_t* dst = C.kvb(l) + kvb_off(NPB + b) + (size_t)pos * KVW;
        const size_t base = ((size_t)(l * NSB_S + b) * PAST + pos);
#pragma unroll
        for (int j = 0; j < 5; ++j) {
            const int c = C.lane + 64 * j; float v;
            if (c < 128) v = C.inp(2)[base * 128 + c]; else if (c < 256) v = C.inp(3)[base * 128 + (c - 128)]; else v = C.inp(4)[base * 64 + (c - 256)];
            dst[c] = f2bf(v);
        }
    }
}

#define MFMA32(a, b, c) __builtin_amdgcn_mfma_f32_32x32x16_bf16((a), (b), (c), 0, 0, 0)
DI void phase_inproj_simple(const Ctx& C, int l) {
    const int gw = C.bid * NWAVES + C.wave, NGW = C.G * NWAVES, lane = C.lane, r = lane & 31, h = lane >> 5;
    constexpr int NG = 82, NRT = ROWS / 32;
    const bf16_t* WIN = C.win(l); const bf16_t* HB = C.hb(); bf16_t* PJ = C.proj();
    for (int it = gw; it < NRT * NG; it += NGW) {
        const int rt = it / NG, g = it % NG, m0 = rt * 32;
        int c0, c1, type;
        if (g < 76) { c0 = 64 * g; c1 = c0 + 32; type = 0; }
        else if (g < 80) { const int hs = g - 76; c0 = C_T19 + 32 * hs; c1 = c0 + 128; type = hs < 2 ? 1 : 2; }
        else if (g == 80) { c0 = C_T20; c1 = C_T20 + 32; type = 3; }
        else { c0 = C_T20 + 64; c1 = C_T20 + 96; type = 4; }
        f32x16 acc0, acc1;
#pragma unroll
        for (int i = 0; i < 16; ++i) { acc0[i] = 0.f; acc1[i] = 0.f; }
        const bf16_t* Ap = HB + (size_t)(m0 + r) * DM + 8 * h;
        const bf16_t* B0 = WIN + (size_t)(c0 + r) * DM + 8 * h;
        const bf16_t* B1 = WIN + (size_t)(c1 + r) * DM + 8 * h;
#pragma unroll 4
        for (int k0 = 0; k0 < DM; k0 += 16) {
            const bf16x8 a = *(const bf16x8*)(Ap + k0), b0 = *(const bf16x8*)(B0 + k0), b1 = *(const bf16x8*)(B1 + k0);
            acc0 = MFMA32(a, b0, acc0); acc1 = MFMA32(a, b1, acc1);
        }
        float rsc; { const float* p = C.rss() + (size_t)(m0 + r) * 16; float s = 0.f;
#pragma unroll
            for (int j = 0; j < 16; ++j) s += p[j];
            rsc = rsqrtf(s * (1.f / DM) + EPS); }
        const float kn0 = (type == 1) ? C.inp(19)[l * 64 + r] : 1.f, kn1 = (type == 1) ? C.inp(19)[l * 64 + 32 + r] : 1.f;
#pragma unroll
        for (int reg = 0; reg < 16; ++reg) {
            const int rowl = crow(reg, h), m = m0 + rowl;
            const float sc = __shfl(rsc, rowl);
            float v0 = acc0[reg] * sc, v1 = acc1[reg] * sc;
            if (type == 0) { PJ[(size_t)m * PJW + c0 + r] = f2bf(v0); PJ[(size_t)m * PJW + c1 + r] = f2bf(v1); }
            else {
                int sb, t; row_sbt(m, sb, t); const int pos = sb_P(sb) + t;
                bf16_t* kv = C.kvb(l) + kvb_off(sb) + (size_t)pos * KVW;
                if (type == 1) {
                    const int kvh = g - 76;
                    const float ss = half_sum32(v0 * v0 + v1 * v1), rn = rsqrtf(ss * (1.f / 64.f) + EPS);
                    v0 = v0 * rn * kn0; v1 = v1 * rn * kn1;
                    float* o = out_ak(C, l, sb) + (size_t)t * 128 + kvh * 64;
                    o[r] = v0; o[32 + r] = v1; kv[kvh * 64 + r] = f2bf(v0); kv[kvh * 64 + 32 + r] = f2bf(v1);
                } else if (type == 2) {
                    const int kvh = g - 78;
                    float* o = out_av(C, l, sb) + (size_t)t * 128 + kvh * 64;
                    o[r] = v0; o[32 + r] = v1; kv[128 + kvh * 64 + r] = f2bf(v0); kv[128 + kvh * 64 + 32 + r] = f2bf(v1);
                } else if (type == 3) {
                    float* o = out_ik(C, l, sb) + (size_t)t * 64;
                    o[r] = v0; o[32 + r] = v1; kv[256 + r] = f2bf(v0); kv[256 + 32 + r] = f2bf(v1);
                } else {
                    if (r < 4) C.wi()[(size_t)m * 4 + r] = v0; else if (r < 20) C.dtr()[(size_t)m * 16 + (r - 4)] = v0;
                }
            }
        }
    }
}

DI void phase_outproj_simple(const Ctx& C, int l) {
    const int gw = C.bid * NWAVES + C.wave, NGW = C.G * NWAVES, lane = C.lane, r = lane & 31, h = lane >> 5;
    constexpr int NG = DM / 64, NRT = ROWS / 32;
    const bf16_t* WO = C.wout(l); const bf16_t* PJ = C.proj();
    for (int it = gw; it < NRT * NG; it += NGW) {
        const int rt = it / NG, g = it % NG, m0 = rt * 32, c0 = 64 * g, c1 = c0 + 32;
        f32x16 a00, a01, a10, a11, a20, a21;
#pragma unroll
        for (int i = 0; i < 16; ++i) { a00[i] = 0.f; a01[i] = 0.f; a10[i] = 0.f; a11[i] = 0.f; a20[i] = 0.f; a21[i] = 0.f; }
        const bf16_t* Ap = PJ + (size_t)(m0 + r) * PJW + 8 * h;
        const bf16_t* B0 = WO + (size_t)(c0 + r) * DMIX + 8 * h;
        const bf16_t* B1 = WO + (size_t)(c1 + r) * DMIX + 8 * h;
#pragma unroll 4
        for (int k0 = 0; k0 < 1024; k0 += 16) { const bf16x8 a = *(const bf16x8*)(Ap + k0); a00 = MFMA32(a, *(const bf16x8*)(B0 + k0), a00); a01 = MFMA32(a, *(const bf16x8*)(B1 + k0), a01); }
#pragma unroll 4
        for (int k0 = 1024; k0 < 1536; k0 += 16) { const bf16x8 a = *(const bf16x8*)(Ap + k0); a10 = MFMA32(a, *(const bf16x8*)(B0 + k0), a10); a11 = MFMA32(a, *(const bf16x8*)(B1 + k0), a11); }
#pragma unroll 4
        for (int k0 = 1536; k0 < 2048; k0 += 16) { const bf16x8 a = *(const bf16x8*)(Ap + k0); a20 = MFMA32(a, *(const bf16x8*)(B0 + k0), a20); a21 = MFMA32(a, *(const bf16x8*)(B1 + k0), a21); }
        float r0, r1; { const float* p = C.ssq() + (size_t)(m0 + r) * 64; float s0 = 0.f, s1 = 0.f;
#pragma unroll
            for (int j = 0; j < 32; ++j) { s0 += p[j]; s1 += p[32 + j]; }
            r0 = rsqrtf(s0 * (1.f / 512.f) + EPS); r1 = rsqrtf(s1 * (1.f / 512.f) + EPS); }
#pragma unroll
        for (int reg = 0; reg < 16; ++reg) {
            const int rowl = crow(reg, h), m = m0 + rowl;
            const float g0 = __shfl(r0, rowl), g1 = __shfl(r1, rowl);
            const float* xres = (l == 0) ? ((m < ROWS_P) ? C.inp(0) + (size_t)m * DM : C.inp(1) + (size_t)(m - ROWS_P) * DM) : C.out + (size_t)m * DM;
            const float v0 = xres[c0 + r] + a00[reg] + g0 * a10[reg] + g1 * a20[reg];
            const float v1 = xres[c1 + r] + a01[reg] + g0 * a11[reg] + g1 * a21[reg];
            C.out[(size_t)m * DM + c0 + r] = v0; C.out[(size_t)m * DM + c1 + r] = v1;
            if (l == 0) {
                C.hb()[(size_t)m * DM + c0 + r] = f2bf(v0); C.hb()[(size_t)m * DM + c1 + r] = f2bf(v1);
                const float ss = half_sum32(v0 * v0 + v1 * v1);
                if (r == 0) C.rss()[(size_t)m * 16 + g] = ss;
            }
        }
    }
}

DI void phase_conv_naive(const Ctx& C, int l) {
    const int gt = C.bid * NTHREADS + C.tid, NGT = C.G * NTHREADS;
    bf16_t* PJ = C.proj();
    for (int i = gt; i < NSB * 1536; i += NGT) {
        const int sb = i / 1536, ch = i % 1536, T = sb_T(sb), row0 = sb_row0(sb);
        const float* cw = C.inp(21) + (size_t)l * 4 * 1536; const float w0 = cw[ch], w1 = cw[1536 + ch], w2 = cw[2 * 1536 + ch], w3 = cw[3 * 1536 + ch], bias = C.inp(22)[l * 1536 + ch];
        float h0 = 0.f, h1 = 0.f, h2 = 0.f;
        if (sb >= NPB) { const float* st = C.inp(7) + ((size_t)(l * NSB_S + sb - NPB) * 3) * 1536; h0 = st[ch]; h1 = st[1536 + ch]; h2 = st[2 * 1536 + ch]; }
        bf16_t* p = PJ + (size_t)row0 * PJW + C_XBC + ch;
        for (int t = 0; t < T; ++t) {
            const float x = bf2f(p[(size_t)t * PJW]);
            const float y = bias + w0 * h0 + w1 * h1 + w2 * h2 + w3 * x;
            p[(size_t)t * PJW] = f2bf(silu_f(y));
            h0 = h1; h1 = h2; h2 = x;
        }
        float* o = out_sc(C, l, sb); o[ch] = h0; o[1536 + ch] = h1; o[2 * 1536 + ch] = h2;
    }
}

DI void lru_item_naive(const Ctx& C, int l, int sb, int blk, LAS unsigned char* scr) {
    const int lane = C.lane, ch = blk * 64 + lane, T = sb_T(sb), row0 = sb_row0(sb);
    bf16_t* PJ = C.proj();
    LAS unsigned* wl = (LAS unsigned*)scr;
    { const float* pa = C.inp(13) + (size_t)(l * 8 + blk) * 4096 + lane; const float* px = C.inp(15) + (size_t)(l * 8 + blk) * 4096 + lane;
      for (int c = 0; c < 64; ++c) wl[c * 64 + lane] = pk2(pa[c * 64], px[c * 64]); }
    LDS_FENCE();
    const float ba = C.inp(14)[l * 512 + ch], bx = C.inp(16)[l * 512 + ch];
    const float spl = softplus_f(-C.inp(17)[l * 512 + ch]);
    const float* cw = C.inp(11) + (size_t)l * 4 * 512; const float w0 = cw[ch], w1 = cw[512 + ch], w2 = cw[1024 + ch], w3 = cw[1536 + ch], cb = C.inp(12)[l * 512 + ch];
    float h0 = 0.f, h1 = 0.f, h2 = 0.f, hs = 0.f;
    if (sb >= NPB) { const float* st = C.inp(5) + ((size_t)(l * NSB_S + sb - NPB) * 3) * 512; h0 = st[ch]; h1 = st[512 + ch]; h2 = st[1024 + ch]; hs = C.inp(6)[(size_t)(l * NSB_S + sb - NPB) * 512 + ch]; }
    for (int t = 0; t < T; ++t) {
        const size_t rb = (size_t)(row0 + t) * PJW;
        const float x = bf2f(PJ[rb + C_XL + ch]);
        const float xc = cb + w0 * h0 + w1 * h1 + w2 * h2 + w3 * x;
        h0 = h1; h1 = h2; h2 = x;
        float ga = ba, gx = bx;
#pragma unroll 8
        for (int c = 0; c < 64; ++c) { const float xv = __shfl(xc, c); const unsigned w = wl[c * 64 + lane]; ga += xv * __uint_as_float(w << 16); gx += xv * __uint_as_float(w & 0xffff0000u); }
        const float rg = sigmoid_f(ga), ig = sigmoid_f(gx);
        const float log_a = -8.f * rg * spl, a = expf(log_a), mult = sqrtf(-expm1f(2.f * log_a));
        hs = a * hs + mult * (ig * xc);
        const float gl = bf2f(PJ[rb + C_GL + ch]);
        PJ[rb + C_GL + ch] = f2bf(hs * silu_f(gl));
    }
    float* oc = out_lc(C, l, sb); oc[ch] = h0; oc[512 + ch] = h1; oc[1024 + ch] = h2;
    out_lh(C, l, sb)[ch] = hs;
}

DI void ssd_item_naive(const Ctx& C, int l, int sb, int hd, int pq) {
    const int lane = C.lane, T = sb_T(sb), row0 = sb_row0(sb), g = hd >> 3;
    const int p = 16 * pq + (lane & 15), nq = lane >> 4, n0 = 32 * nq;
    bf16_t* PJ = C.proj();
    float hst[32];
    if (sb >= NPB) { const float* st = C.inp(8) + (((size_t)(l * NSB_S + sb - NPB) * 16 + hd) * 64 + p) * 128 + n0;
#pragma unroll
        for (int n = 0; n < 32; n += 4) { const f32x4 v = *(const f32x4*)(st + n); hst[n] = v.x; hst[n + 1] = v.y; hst[n + 2] = v.z; hst[n + 3] = v.w; } }
    else {
#pragma unroll
        for (int n = 0; n < 32; ++n) hst[n] = 0.f; }
    const float aneg = -expf(C.inp(24)[l * 16 + hd]), dtb = C.inp(23)[l * 16 + hd], Dh = C.inp(25)[l * 16 + hd];
    for (int t = 0; t < T; ++t) {
        const size_t rb = (size_t)(row0 + t) * PJW;
        const float dt = softplus_f(C.dtr()[(size_t)(row0 + t) * 16 + hd] + dtb), da = expf(dt * aneg);
        const float xs = bf2f(PJ[rb + C_XBC + hd * 64 + p]), dtx = dt * xs;
        const bf16_t* Bp = PJ + rb + C_XBC + 1024 + g * 128 + n0; const bf16_t* Cp = PJ + rb + C_XBC + 1280 + g * 128 + n0;
        float y = 0.f;
#pragma unroll
        for (int n = 0; n < 32; n += 8) {
            const bf16x8 bv = *(const bf16x8*)(Bp + n), cv = *(const bf16x8*)(Cp + n);
#pragma unroll
            for (int j = 0; j < 8; ++j) { hst[n + j] = da * hst[n + j] + dtx * bf2f((bf16_t)bv[j]); y += bf2f((bf16_t)cv[j]) * hst[n + j]; }
        }
        y += __shfl_xor(y, 16); y += __shfl_xor(y, 32);
        y += Dh * xs;
        const float z = bf2f(PJ[rb + C_Z + hd * 64 + p]);
        y *= silu_f(z);
        if (nq == 0) PJ[rb + C_Z + hd * 64 + p] = f2bf(y);
        const float ss = wave_sum(nq == 0 ? y * y : 0.f);
        if (lane == 0) C.ssq()[(size_t)(row0 + t) * 64 + hd * 4 + pq] = ss;
    }
    float* o = out_sh(C, l, sb) + ((size_t)hd * 64 + p) * 128 + n0;
#pragma unroll
    for (int n = 0; n < 32; n += 4) { f32x4 v; v.x = hst[n]; v.y = hst[n + 1]; v.z = hst[n + 2]; v.w = hst[n + 3]; *(f32x4*)(o + n) = v; }
}

DI unsigned mono_key(float f) { const unsigned u = __float_as_uint(f); return (u & 0x80000000u) ? ~u : (u | 0x80000000u); }
DI int t5_bucket(int rel) {
    const int n = rel < 0 ? -rel : rel; int b;
    if (n < 8) b = n; else if (n < 12) b = 8; else if (n < 16) b = 9; else if (n < 23) b = 10; else if (n < 32) b = 11; else if (n < 46) b = 12; else if (n < 64) b = 13; else if (n < 91) b = 14; else b = 15;
    return b + (rel > 0 ? 16 : 0);
}
DI void attn_item_naive(const Ctx& C, int l, int m, LAS unsigned char* scr) {
    const int lane = C.lane;
    int sb, t; row_sbt(m, sb, t);
    const int P = sb_P(sb), posq = P + t, Ladm = 64 * ((posq >> 6) + 1), nsel = Ladm < 256 ? Ladm : 256;
    LAS unsigned* keys = (LAS unsigned*)scr; LAS unsigned* sel = keys + 2048; LAS float* qs = (LAS float*)(sel + 256); LAS float* ps = qs + 64; LAS float* qis = ps + 256;
    bf16_t* PJ = C.proj(); const bf16_t* KV = C.kvb(l) + kvb_off(sb);
    const size_t rb = (size_t)m * PJW;
#pragma unroll
    for (int j = 0; j < 4; ++j) qis[64 * j + lane] = bf2f(PJ[rb + C_QI + 64 * j + lane]);
    LDS_FENCE();
    const float w0 = C.wi()[(size_t)m * 4 + 0], w1 = C.wi()[(size_t)m * 4 + 1], w2 = C.wi()[(size_t)m * 4 + 2], w3 = C.wi()[(size_t)m * 4 + 3];
    for (int s = lane; s < Ladm; s += 64) {
        asm volatile("" ::: "memory");
        const bf16_t* kp = KV + (size_t)s * KVW + 256;
        float d0 = 0.f, d1 = 0.f, d2 = 0.f, d3 = 0.f;
#pragma unroll
        for (int d = 0; d < 64; d += 8) {
            const bf16x8 kv8 = *(const bf16x8*)(kp + d);
#pragma unroll
            for (int j = 0; j < 8; ++j) { const float kf = bf2f((bf16_t)kv8[j]); d0 += qis[d + j] * kf; d1 += qis[64 + d + j] * kf; d2 += qis[128 + d + j] * kf; d3 += qis[192 + d + j] * kf; }
            asm volatile("" ::: "memory");
        }
        const float score = ((w0 * fmaxf(d0, 0.f) + w1 * fmaxf(d1, 0.f)) + w2 * fmaxf(d2, 0.f)) + w3 * fmaxf(d3, 0.f);
        keys[s] = mono_key(score);
    }
    LDS_FENCE();
    for (int s = lane; s < Ladm; s += 64) {
        const unsigned km = keys[s]; int cnt = 0;
        for (int sp = 0; sp < Ladm; sp += 4) {
            const u32x4 kq = *(const LAS u32x4*)(keys + sp);
            cnt += (kq.x > km) | ((kq.x == km) & (sp < s));
            cnt += (kq.y > km) | ((kq.y == km) & (sp + 1 < s));
            cnt += (kq.z > km) | ((kq.z == km) & (sp + 2 < s));
            cnt += (kq.w > km) | ((kq.w == km) & (sp + 3 < s));
        }
        if (cnt < 256) sel[cnt] = (unsigned)s;
    }
    LDS_FENCE();
    for (int hq = 0; hq < 8; ++hq) {
        const int kvh = hq >> 2;
        { const float raw = bf2f(PJ[rb + C_Q + hq * 64 + lane]); const float ss = wave_sum(raw * raw);
          qs[lane] = raw * rsqrtf(ss * (1.f / 64.f) + EPS) * C.inp(18)[l * 64 + lane]; }
        LDS_FENCE();
        float lg[4]; float mx = -INFINITY;
#pragma unroll
        for (int i = 0; i < 4; ++i) {
            const int j = lane + 64 * i; lg[i] = -INFINITY;
            asm volatile("" ::: "memory");
            if (j < nsel) {
                const int s = (int)sel[j]; const bf16_t* kp = KV + (size_t)s * KVW + kvh * 64; float dot = 0.f;
#pragma unroll
                for (int d = 0; d < 64; d += 8) { const bf16x8 kv8 = *(const bf16x8*)(kp + d);
#pragma unroll
                    for (int jj = 0; jj < 8; ++jj) dot += qs[d + jj] * bf2f((bf16_t)kv8[jj]); }
                lg[i] = dot * 0.125f + C.inp(20)[t5_bucket(s - posq) * 8 + hq];
                mx = fmaxf(mx, lg[i]);
            }
        }
        mx = wave_max(mx);
        float sum = 0.f;
#pragma unroll
        for (int i = 0; i < 4; ++i) { const int j = lane + 64 * i; if (j < nsel) { lg[i] = expf(lg[i] - mx); sum += lg[i]; } }
        sum = wave_sum(sum); const float inv = 1.f / sum;
#pragma unroll
        for (int i = 0; i < 4; ++i) { const int j = lane + 64 * i; if (j < nsel) ps[j] = lg[i] * inv; }
        LDS_FENCE();
        float o = 0.f;
        for (int j = 0; j < nsel; ++j) o += ps[j] * bf2f(KV[(size_t)sel[j] * KVW + 128 + kvh * 64 + lane]);
        const float ga = bf2f(PJ[rb + C_GA + hq * 64 + lane]);
        PJ[rb + C_GA + hq * 64 + lane] = f2bf(o * silu_f(ga));
        LDS_FENCE();
    }
}

DI void phase_mixers_naive(const Ctx& C, int l) {
    for (int i = C.bid + C.G * C.wave; i < 1728; i += C.G * NWAVES) {
        int kind, sb, sub;
        if (i < 1024) { kind = 0; sb = i >> 6; sub = i & 63; }
        else if (i < 1152) { kind = 1; sb = (i - 1024) >> 3; sub = (i - 1024) & 7; }
        else if (i < 1664) { kind = 0; sb = NPB + ((i - 1152) >> 6); sub = (i - 1152) & 63; }
        else { kind = 1; sb = NPB + ((i - 1664) >> 3); sub = (i - 1664) & 7; }
        if (kind == 0) { if (ONLY & 32) ssd_item_naive(C, l, sb, sub >> 2, sub & 3); }
        else { if (ONLY & 64) lru_item_naive(C, l, sb, sub, C.lds + C.wave * 16384); }
    }
    LAS unsigned char* scr = C.lds + C.wave * 16384;
    const int gw = C.bid * NWAVES + C.wave, NGW = C.G * NWAVES;
    if (ONLY & 128) for (int m = gw; m < ROWS; m += NGW) attn_item_naive(C, l, m, scr);
}

constexpr int N_PHASES = 9;
__global__ void __launch_bounds__(NTHREADS, 2) mk_fwd(Args a) {
    extern __shared__ __attribute__((aligned(16))) unsigned char lds_raw[];
    Ctx C; C.out = a.out; C.ws = a.ws; C.lds = (LAS unsigned char*)lds_raw;
    C.tid = threadIdx.x; C.lane = C.tid & 63; C.wave = __builtin_amdgcn_readfirstlane(C.tid >> 6); C.G = gridDim.x; C.bid = blockIdx.x;
    if (C.tid == 0) {
#pragma unroll
        for (int i = 0; i < 28; ++i) ((LAS cfp_t*)(C.lds + LDS_BYTES - 256))[i] = a.in[i];
    }
    __syncthreads();
    const Ctx C0 = C;
    for (int ph = a.ph_lo; ph < a.ph_hi; ++ph) {
        C = C0; asm volatile("" : "+v"(C.lane), "+v"(C.tid)); asm volatile("" : "+s"(C.ws), "+s"(C.out));
        if (ph == 0) { if (ONLY & 16) phase_prologue(C); }
        else {
            const int l = (ph - 1) >> 2, k = (ph - 1) & 3;
            if (k == 0) { if (ONLY & 1) phase_inproj_simple(C, l); }
            else if (k == 1) { if (ONLY & 2) phase_conv_naive(C, l); }
            else if (k == 2) { if (ONLY & 4) phase_mixers_naive(C, l); }
            else { if (ONLY & 8) phase_outproj_simple(C, l); }
        }
#if MK_ONE_LAUNCH
        if (ph + 1 < a.ph_hi) cg::this_grid().sync();
#endif
    }
}

extern "C" void kernel_launch(void* const* d_in, const int* in_sizes, int n_in, void* d_out, int out_size, void* d_ws, size_t ws_size, hipStream_t stream) {
    static int grid = 0;
    if (grid == 0) {
        if (n_in != 28 || (size_t)out_size != O_END || ws_size < WS_END) { fprintf(stderr, "kernel_launch: unexpected shapes n_in %d out %d ws %zu\n", n_in, out_size, ws_size); grid = -1; return; }
        int dev = 0, cus = 0, per_cu = 0;
        hipGetDevice(&dev); hipDeviceGetAttribute(&cus, hipDeviceAttributeMultiprocessorCount, dev);
        hipFuncSetAttribute((const void*)mk_fwd, hipFuncAttributeMaxDynamicSharedMemorySize, LDS_BYTES);
        hipOccupancyMaxActiveBlocksPerMultiprocessor(&per_cu, (const void*)mk_fwd, NTHREADS, LDS_BYTES);
        if (per_cu < 1) per_cu = 1;
        grid = cus * 1;
        (void)hipGetLastError();
    }
    if (grid < 0) return;
    hipMemsetAsync((char*)d_ws + WS_CTL, 0, CTL_BYTES, stream);
    Args a{};
    for (int i = 0; i < 28; ++i) a.in[i] = (const float*)d_in[i];
    a.out = (float*)d_out; a.ws = (unsigned char*)d_ws;
#if MK_ONE_LAUNCH
    a.ph_lo = 0; a.ph_hi = N_PHASES;
    void* args[] = {&a};
    hipError_t e = hipLaunchCooperativeKernel((const void*)mk_fwd, dim3(grid), dim3(NTHREADS), args, LDS_BYTES, stream);
    if (e != hipSuccess) fprintf(stderr, "cooperative launch failed: %s (grid %d)\n", hipGetErrorString(e), grid);
#else
    for (int ph = 0; ph < N_PHASES; ++ph) { a.ph_lo = ph; a.ph_hi = ph + 1; hipLaunchKernelGGL(mk_fwd, dim3(grid), dim3(NTHREADS), LDS_BYTES, stream, a); }
#endif
}
```

```cpp
#include <hip/hip_runtime.h>
#include <hip/hip_cooperative_groups.h>
#include <cstdio>
#include <cstdint>
namespace cg = cooperative_groups;

#ifndef ONLY
#define ONLY 0xffff
#endif
#ifndef USE_ATTN_OPT
#define USE_ATTN_OPT 1
#endif
#ifndef USE_SSD_OPT
#define USE_SSD_OPT 1
#endif
#ifndef USE_GEMM_IN
#define USE_GEMM_IN 1
#endif
#ifndef USE_GEMM_OUT
#define USE_GEMM_OUT 1
#endif
#ifndef MK_ONE_LAUNCH
#define MK_ONE_LAUNCH 1
#endif

typedef unsigned short bf16_t;
typedef short bf16x8 __attribute__((ext_vector_type(8)));
typedef float f32x4 __attribute__((ext_vector_type(4)));
typedef float f32x16 __attribute__((ext_vector_type(16)));
typedef unsigned u32x4 __attribute__((ext_vector_type(4)));
typedef unsigned u32x2 __attribute__((ext_vector_type(2)));
#define LAS __attribute__((address_space(3)))
#define DI __device__ __forceinline__

constexpr int DM = 1024, NPB = 16, SEQ = 2048, NSB_S = 8, DSEQ = 64, PAST = 1024;
constexpr int ROWS_P = NPB * SEQ;
constexpr int ROWS = ROWS_P + NSB_S * DSEQ;
constexpr int NSB = NPB + NSB_S;
constexpr int DINP = 5204, NPAD = 5376;
constexpr int PJW = 4864;
constexpr int DMIX = 2048;
constexpr float EPS = 1e-6f;
constexpr int C_GL = 0, C_GA = 512, C_Z = 1024, C_XL = 2048, C_Q = 2560, C_QI = 3072, C_XBC = 3328, C_T19 = 4864, C_T20 = 5120;
constexpr int KVW = 320;
constexpr size_t KVB_LAYER = (size_t)NPB * SEQ * KVW + (size_t)NSB_S * (PAST + DSEQ) * KVW;

constexpr size_t O_YP = 0;
constexpr size_t O_YS = O_YP + (size_t)NPB * SEQ * DM;
constexpr size_t O_AKP = O_YS + (size_t)NSB_S * DSEQ * DM;
constexpr size_t O_AVP = O_AKP + (size_t)2 * NPB * SEQ * 128;
constexpr size_t O_IKP = O_AVP + (size_t)2 * NPB * SEQ * 128;
constexpr size_t O_LCP = O_IKP + (size_t)2 * NPB * SEQ * 64;
constexpr size_t O_LHP = O_LCP + (size_t)2 * NPB * 3 * 512;
constexpr size_t O_SCP = O_LHP + (size_t)2 * NPB * 512;
constexpr size_t O_SHP = O_SCP + (size_t)2 * NPB * 3 * 1536;
constexpr size_t O_AKS = O_SHP + (size_t)2 * NPB * 16 * 64 * 128;
constexpr size_t O_AVS = O_AKS + (size_t)2 * NSB_S * DSEQ * 128;
constexpr size_t O_IKS = O_AVS + (size_t)2 * NSB_S * DSEQ * 128;
constexpr size_t O_LCS = O_IKS + (size_t)2 * NSB_S * DSEQ * 64;
constexpr size_t O_LHS = O_LCS + (size_t)2 * NSB_S * 3 * 512;
constexpr size_t O_SCS = O_LHS + (size_t)2 * NSB_S * 512;
constexpr size_t O_SHS = O_SCS + (size_t)2 * NSB_S * 3 * 1536;
constexpr size_t O_END = O_SHS + (size_t)2 * NSB_S * 16 * 64 * 128;

constexpr size_t MiB = 1u << 20;
constexpr size_t WS_CTL = 0, CTL_BYTES = 1 * MiB;
constexpr size_t WS_WIN = 1 * MiB;
constexpr size_t WIN_LAYER = (size_t)NPAD * DM;
constexpr size_t WS_WOUT = 22 * MiB;
constexpr size_t WOUT_LAYER = (size_t)DM * DMIX;
constexpr size_t WS_HB = 30 * MiB;
constexpr size_t WS_RSS = 95 * MiB;
constexpr size_t WS_WI = 98 * MiB;
constexpr size_t WS_DTR = 99 * MiB;
constexpr size_t WS_SSQ = 102 * MiB;
constexpr size_t WS_KVB = 112 * MiB;
constexpr size_t WS_PROJ = 164 * MiB;
constexpr size_t WS_END = WS_PROJ + (size_t)ROWS * PJW * 2;
static_assert(WS_KVB + 2 * KVB_LAYER * 2 <= WS_PROJ, "ws map");
static_assert(WS_END <= 512 * MiB, "ws map");

constexpr int NTHREADS = 512, NWAVES = 8;
constexpr int LDS_BYTES = 163840;

DI float bf2f(bf16_t v) { return __uint_as_float(((unsigned)v) << 16); }
DI bf16_t f2bf(float f) { unsigned u = __float_as_uint(f); return (bf16_t)((u + 0x7fffu + ((u >> 16) & 1u)) >> 16); }
DI unsigned pk2(float lo, float hi) { return (unsigned)f2bf(lo) | ((unsigned)f2bf(hi) << 16); }
DI int crow(int reg, int h) { return (reg & 3) + 8 * (reg >> 2) + 4 * h; }
template <int O> DI float swz_xor(float v) { return __int_as_float(__builtin_amdgcn_ds_swizzle(__float_as_int(v), (O << 10) | 0x1f)); }
DI float xor32_sum(float v) { auto rr = __builtin_amdgcn_permlane32_swap(__float_as_uint(v), __float_as_uint(v), false, false); return __uint_as_float(rr[0]) + __uint_as_float(rr[1]); }
DI float xor32_max(float v) { auto rr = __builtin_amdgcn_permlane32_swap(__float_as_uint(v), __float_as_uint(v), false, false); return fmaxf(__uint_as_float(rr[0]), __uint_as_float(rr[1])); }
DI float half_sum32(float v) {
    v += swz_xor<1>(v); v += swz_xor<2>(v); v += swz_xor<4>(v); v += swz_xor<8>(v); v += swz_xor<16>(v); return v;
}
DI float wave_sum(float v) { return xor32_sum(half_sum32(v)); }
DI float wave_max(float v) {
    v = fmaxf(v, swz_xor<1>(v)); v = fmaxf(v, swz_xor<2>(v)); v = fmaxf(v, swz_xor<4>(v)); v = fmaxf(v, swz_xor<8>(v)); v = fmaxf(v, swz_xor<16>(v)); return xor32_max(v);
}
DI float sum_fq(float v) { return xor32_sum(v + swz_xor<16>(v)); }
DI float bperm(float v, int srclane) { return __int_as_float(__builtin_amdgcn_ds_bpermute(srclane << 2, __float_as_int(v))); }
DI float silu_f(float x) { return x / (1.f + expf(-x)); }
DI float sigmoid_f(float x) { return 1.f / (1.f + expf(-x)); }
DI float softplus_f(float x) { return x > 20.f ? x : log1pf(expf(x)); }
#define LDS_FENCE() asm volatile("s_waitcnt lgkmcnt(0)" ::: "memory")

__host__ __device__ inline int orig_col(int c) {
    if (c < 512) return 512 + c;
    if (c < 1024) return 1792 + (c - 512);
    if (c < 2048) return 2628 + (c - 1024);
    if (c < 2560) return c - 2048;
    if (c < 3072) return 1024 + (c - 2560);
    if (c < 3328) return 2304 + (c - 3072);
    if (c < 4864) return 3652 + (c - 3328);
    if (c < 5120) { const int cl = c - 4864, bj = cl >> 7, wc = (cl >> 5) & 3, j = cl & 31, d = 32 * bj + j; return (wc < 2 ? 1536 : 1664) + (wc & 1) * 64 + d; }
    const int cl = c - 5120;
    if (cl < 64) return 2560 + cl;
    if (cl < 68) return 2624 + (cl - 64);
    if (cl < 84) return 5188 + (cl - 68);
    return -1;
}
DI int sb_T(int sb) { return sb < NPB ? SEQ : DSEQ; }
DI int sb_P(int sb) { return sb < NPB ? 0 : PAST; }
DI int sb_row0(int sb) { return sb < NPB ? sb * SEQ : ROWS_P + (sb - NPB) * DSEQ; }
DI size_t kvb_off(int sb) { return sb < NPB ? (size_t)sb * SEQ * KVW : (size_t)NPB * SEQ * KVW + (size_t)(sb - NPB) * (PAST + DSEQ) * KVW; }
DI void row_sbt(int m, int& sb, int& t) { if (m < ROWS_P) { sb = m >> 11; t = m & 2047; } else { const int r = m - ROWS_P; sb = NPB + (r >> 6); t = r & 63; } }

typedef const float* cfp_t;
struct Args { const float* in[28]; float* out; unsigned char* ws; int ph_lo, ph_hi; };

struct Ctx {
    float* out; unsigned char* ws;
    LAS unsigned char* lds;
    DI const float* inp(int k) const { return ((LAS cfp_t*)(lds + LDS_BYTES - 256))[k]; }
    int tid, lane, wave, G, bid;
    DI bf16_t* win(int l) const { return (bf16_t*)(ws + WS_WIN) + (size_t)l * WIN_LAYER; }
    DI bf16_t* wout(int l) const { return (bf16_t*)(ws + WS_WOUT) + (size_t)l * WOUT_LAYER; }
    DI bf16_t* hb() const { return (bf16_t*)(ws + WS_HB); }
    DI float* rss() const { return (float*)(ws + WS_RSS); }
    DI float* wi() const { return (float*)(ws + WS_WI); }
    DI float* dtr() const { return (float*)(ws + WS_DTR); }
    DI float* ssq() const { return (float*)(ws + WS_SSQ); }
    DI bf16_t* kvb(int l) const { return (bf16_t*)(ws + WS_KVB) + (size_t)l * KVB_LAYER; }
    DI bf16_t* proj() const { return (bf16_t*)(ws + WS_PROJ); }
};
DI float* out_ak(const Ctx& C, int l, int sb) { return sb < NPB ? C.out + O_AKP + ((size_t)(l * NPB + sb) * SEQ) * 128 : C.out + O_AKS + ((size_t)(l * NSB_S + sb - NPB) * DSEQ) * 128; }
DI float* out_av(const Ctx& C, int l, int sb) { return sb < NPB ? C.out + O_AVP + ((size_t)(l * NPB + sb) * SEQ) * 128 : C.out + O_AVS + ((size_t)(l * NSB_S + sb - NPB) * DSEQ) * 128; }
DI float* out_ik(const Ctx& C, int l, int sb) { return sb < NPB ? C.out + O_IKP + ((size_t)(l * NPB + sb) * SEQ) * 64 : C.out + O_IKS + ((size_t)(l * NSB_S + sb - NPB) * DSEQ) * 64; }
DI float* out_lc(const Ctx& C, int l, int sb) { return sb < NPB ? C.out + O_LCP + (size_t)(l * NPB + sb) * 3 * 512 : C.out + O_LCS + (size_t)(l * NSB_S + sb - NPB) * 3 * 512; }
DI float* out_lh(const Ctx& C, int l, int sb) { return sb < NPB ? C.out + O_LHP + (size_t)(l * NPB + sb) * 512 : C.out + O_LHS + (size_t)(l * NSB_S + sb - NPB) * 512; }
DI float* out_sc(const Ctx& C, int l, int sb) { return sb < NPB ? C.out + O_SCP + (size_t)(l * NPB + sb) * 3 * 1536 : C.out + O_SCS + (size_t)(l * NSB_S + sb - NPB) * 3 * 1536; }
DI float* out_sh(const Ctx& C, int l, int sb) { return sb < NPB ? C.out + O_SHP + (size_t)(l * NPB + sb) * 16 * 64 * 128 : C.out + O_SHS + (size_t)(l * NSB_S + sb - NPB) * 16 * 64 * 128; }

namespace pg8 {
#define PG8_LAS __attribute__((address_space(3)))
constexpr int BM = 256, BK = 64, HALF = 128, HTB = HALF * BK * 2  , STAGE_BYTES = 8 * HTB, NXCD = 8, WGM = 8;

__host__ __device__ __forceinline__ int lds_byte(int r, int c) { const int st = (r >> 4) * 2 + (c >> 5), rr = r & 15, cc = c & 31, ob = rr * 64 + cc * 2; return st * 1024 + (ob ^ (((ob >> 9) & 1) << 5)); }
__host__ __device__ __forceinline__ void stage_rc(int b, int& R, int& C) { const int st = b / 1024, sb = b % 1024, swz = sb ^ (((sb >> 9) & 1) << 5); R = (st >> 1) * 16 + swz / 64; C = (st & 1) * 32 + (swz % 64) / 2; }
__host__ __device__ __forceinline__ int perm32(int rho) { const int n = rho >> 4, i = rho & 15; return 8 * (i >> 2) + 4 * n + (i & 3); }

struct Unit { int pm, pn; };
struct Gemm { const bf16_t* A; const bf16_t* Bt; int M, N, K, lda; };

struct StaticOrder {
    int nM, nN, nwg, G, c;
    __host__ __device__ void init(int M, int N, int G_, int c_) { nM = M / BM; nN = N / BM; nwg = nM * nN; G = G_; c = c_; }
    __host__ __device__ bool next(int i, Unit& u) const {
        const long L = (long)i * G + c; if (L >= nwg) return false;
        int wgid = (int)L; { const int q = nwg / NXCD, r = nwg % NXCD, xcd = wgid % NXCD, off = wgid / NXCD; wgid = (xcd < r ? xcd * (q + 1) : r * (q + 1) + (xcd - r) * q) + off; }
        const int nig = WGM * nN, gid = wgid / nig, fm = gid * WGM, gsz = (nM - fm) < WGM ? (nM - fm) : WGM;
        u.pm = fm + ((wgid % nig) % gsz); u.pn = (wgid % nig) / gsz; return true;
    }
    __device__ __forceinline__ void a_ready(const Unit&) const {}
    __device__ __forceinline__ void done(const Unit&) const {}
};

template <class Epi, class Sched, bool ALIGN_EPI = false, bool SP2 = false>
__device__ __forceinline__ void gemm_phase(PG8_LAS unsigned char* lds, const Gemm g, const Sched& S, const Epi& E, const int tid) {
    const int wid = __builtin_amdgcn_readfirstlane(tid >> 6), lane = tid & 63, wr = wid >> 2, wc = wid & 3, fr = lane & 15, fq = lane >> 4;
    const int K = g.K, nt = K / BK;
    unsigned voffA[2], voffB[2];
#pragma unroll
    for (int i = 0; i < 2; ++i) { int R, C; stage_rc(tid * 16 + i * 8192, R, C); const int Rb = Epi::PERM ? ((R & ~31) + perm32(R & 31)) : R;
        voffA[i] = (unsigned)(R * g.lda + C) * 2u; voffB[i] = (unsigned)(Rb * K + C) * 2u; }
    const size_t kstep = (size_t)(BK * 2);
    const size_t hstepA = (size_t)HALF * g.lda * 2, hstepB = (size_t)HALF * K * 2;
    const size_t tstepA = 2 * hstepA, tstepB = 2 * hstepB;
    const unsigned ldsw = (unsigned)wid * 1024u;
    const int aoff = lds_byte(wr * 64 + fr, fq * 8), boff = lds_byte(wc * 32 + fr, fq * 8);
#define PG8_SA(b, h) (((b) * 2 + (h)) * HTB)
#define PG8_SB(b, h) ((4 + (b) * 2 + (h)) * HTB)
#define PG8_STAGE(bufoff, gbase, voff) do { _Pragma("unroll") for (int _i = 0; _i < 2; ++_i) \
        __builtin_amdgcn_global_load_lds((const unsigned*)((const char*)(gbase) + (voff)[_i]), (PG8_LAS unsigned*)(lds + (bufoff) + ldsw + _i * 8192), 16, 0, 0); } while (0)
#define PG8_LDA(dst, b, h) do { _Pragma("unroll") for (int m = 0; m < 4; ++m) _Pragma("unroll") for (int k = 0; k < 2; ++k) dst[m][k] = *(const PG8_LAS bf16x8*)(lds + PG8_SA(b, h) + aoff + m * 2048 + k * 1024); } while (0)
#define PG8_LDB(dst, b, h) do { _Pragma("unroll") for (int n = 0; n < 2; ++n) _Pragma("unroll") for (int k = 0; k < 2; ++k) dst[n][k] = *(const PG8_LAS bf16x8*)(lds + PG8_SB(b, h) + boff + n * 2048 + k * 1024); } while (0)
#define PG8_MMA(ai, bj, At, Bt) do { __builtin_amdgcn_s_setprio(1); _Pragma("unroll") for (int m = 0; m < 4; ++m) _Pragma("unroll") for (int n = 0; n < 2; ++n) _Pragma("unroll") for (int k = 0; k < 2; ++k) \
        acc[ai][bj][m][n] = __builtin_amdgcn_mfma_f32_16x16x32_bf16(Bt[n][k], At[m][k], acc[ai][bj][m][n], 0, 0, 0); __builtin_amdgcn_s_setprio(0); } while (0)
#define PG8_WAIT_V(n) asm volatile("s_waitcnt vmcnt(" #n ")" ::: "memory")
#define PG8_WAIT_L(n) asm volatile("s_waitcnt lgkmcnt(" #n ")" ::: "memory")
#define PG8_BAR __builtin_amdgcn_s_barrier()
#define PG8_SCHED __builtin_amdgcn_sched_barrier(0)
    Unit cur, nxt; int ui = 0;
    if (!S.next(0, cur)) return;
    f32x4 acc[2][2][4][2];
#pragma unroll
    for (int a = 0; a < 2; ++a)
#pragma unroll
        for (int b = 0; b < 2; ++b)
#pragma unroll
            for (int m = 0; m < 4; ++m)
#pragma unroll
                for (int n = 0; n < 2; ++n) acc[a][b][m][n] = (f32x4){0.f, 0.f, 0.f, 0.f};
    bf16x8 At[4][2], B0[2][2], B1[2][2];
    const char* cA = (const char*)g.A + (size_t)cur.pm * tstepA; const char* cB = (const char*)g.Bt + (size_t)cur.pn * tstepB;
    S.a_ready(cur);
    if constexpr (SP2) {
        PG8_STAGE(PG8_SB(0, 0), cB, voffB); PG8_STAGE(PG8_SB(0, 1), cB + hstepB, voffB); PG8_STAGE(PG8_SA(0, 0), cA, voffA); PG8_STAGE(PG8_SA(0, 1), cA + hstepA, voffA);
        if (wr == 1) PG8_BAR;
        PG8_WAIT_V(2); PG8_BAR;
        PG8_STAGE(PG8_SB(1, 0), cB + kstep, voffB); PG8_STAGE(PG8_SA(1, 0), cA + kstep, voffA); PG8_STAGE(PG8_SB(1, 1), cB + hstepB + kstep, voffB);
        PG8_WAIT_V(6); PG8_BAR;
    } else {
        PG8_STAGE(PG8_SB(0, 0), cB, voffB); PG8_STAGE(PG8_SA(0, 0), cA, voffA); PG8_STAGE(PG8_SB(0, 1), cB + hstepB, voffB); PG8_STAGE(PG8_SA(0, 1), cA + hstepA, voffA);
        if (wr == 1) PG8_BAR;
        PG8_WAIT_V(4); PG8_BAR;
        PG8_STAGE(PG8_SB(1, 0), cB + kstep, voffB); PG8_STAGE(PG8_SA(1, 0), cA + kstep, voffA); PG8_STAGE(PG8_SB(1, 1), cB + hstepB + kstep, voffB);
        PG8_WAIT_V(6); PG8_BAR;
    }
    for (;;) {
        const bool has_next = S.next(ui + 1, nxt);
        const char* nA = has_next ? (const char*)g.A + (size_t)nxt.pm * tstepA : cA; const char* nB = has_next ? (const char*)g.Bt + (size_t)nxt.pn * tstepB : cB;
        for (int t = 0; t < nt; t += 2) {
            const bool last = (t == nt - 2);
            const char* a1 = cA + (size_t)(t + 1) * kstep;
            const char* a2 = last ? nA : cA + (size_t)(t + 2) * kstep; const char* b2 = last ? nB : cB + (size_t)(t + 2) * kstep;
            const char* a3 = a2 + kstep; const char* b3 = b2 + kstep;
            if (last && has_next) S.a_ready(nxt);
            if constexpr (SP2) {
            PG8_LDB(B0, 0, 0); PG8_LDB(B1, 0, 1); PG8_SCHED; PG8_LDA(At, 0, 0); PG8_STAGE(PG8_SA(1, 1), a1 + hstepA, voffA);
            PG8_WAIT_V(8); PG8_WAIT_L(0); PG8_BAR; PG8_MMA(0, 0, At, B0); PG8_MMA(0, 1, At, B1); PG8_BAR; PG8_SCHED;
            PG8_LDA(At, 0, 1); PG8_STAGE(PG8_SB(0, 0), b2, voffB); PG8_STAGE(PG8_SB(0, 1), b2 + hstepB, voffB); PG8_STAGE(PG8_SA(0, 0), a2, voffA);
            PG8_WAIT_V(8); PG8_WAIT_L(0); PG8_BAR; PG8_MMA(1, 0, At, B0); PG8_MMA(1, 1, At, B1); PG8_BAR; PG8_SCHED;
            PG8_LDB(B0, 1, 0); PG8_LDB(B1, 1, 1); PG8_SCHED; PG8_LDA(At, 1, 0); PG8_STAGE(PG8_SA(0, 1), a2 + hstepA, voffA);
            PG8_WAIT_V(8); PG8_WAIT_L(0); PG8_BAR; PG8_MMA(0, 0, At, B0); PG8_MMA(0, 1, At, B1); PG8_BAR; PG8_SCHED;
            PG8_LDA(At, 1, 1); PG8_STAGE(PG8_SB(1, 0), b3, voffB); PG8_STAGE(PG8_SB(1, 1), b3 + hstepB, voffB); PG8_STAGE(PG8_SA(1, 0), a3, voffA);
            PG8_WAIT_V(8); PG8_WAIT_L(0); PG8_BAR; PG8_MMA(1, 0, At, B0); PG8_MMA(1, 1, At, B1); PG8_BAR; PG8_SCHED;
            } else {
            PG8_LDB(B0, 0, 0); PG8_SCHED; PG8_LDA(At, 0, 0); PG8_STAGE(PG8_SA(1, 1), a1 + hstepA, voffA);
            PG8_WAIT_L(8); PG8_BAR; PG8_WAIT_L(0); PG8_MMA(0, 0, At, B0); PG8_BAR; PG8_SCHED;
            PG8_LDB(B1, 0, 1); PG8_STAGE(PG8_SB(0, 0), b2, voffB);
            PG8_BAR; PG8_WAIT_L(0); PG8_MMA(0, 1, At, B1); PG8_BAR;
            PG8_LDA(At, 0, 1); PG8_STAGE(PG8_SA(0, 0), a2, voffA);
            PG8_BAR; PG8_WAIT_L(0); PG8_MMA(1, 0, At, B0); PG8_BAR; PG8_SCHED;
            PG8_STAGE(PG8_SB(0, 1), b2 + hstepB, voffB);
            PG8_WAIT_V(6); PG8_BAR; PG8_MMA(1, 1, At, B1); PG8_BAR;
            PG8_LDB(B0, 1, 0); PG8_SCHED; PG8_LDA(At, 1, 0); PG8_STAGE(PG8_SA(0, 1), a2 + hstepA, voffA);
            PG8_WAIT_L(8); PG8_BAR; PG8_WAIT_L(0); PG8_MMA(0, 0, At, B0); PG8_BAR; PG8_SCHED;
            PG8_LDB(B1, 1, 1); PG8_STAGE(PG8_SB(1, 0), b3, voffB);
            PG8_BAR; PG8_WAIT_L(0); PG8_MMA(0, 1, At, B1); PG8_BAR;
            PG8_LDA(At, 1, 1); PG8_STAGE(PG8_SA(1, 0), a3, voffA);
            PG8_BAR; PG8_WAIT_L(0); PG8_MMA(1, 0, At, B0); PG8_BAR; PG8_SCHED;
            PG8_STAGE(PG8_SB(1, 1), b3 + hstepB, voffB);
            PG8_WAIT_V(6); PG8_BAR; PG8_MMA(1, 1, At, B1); PG8_BAR;
            }
        }
        if constexpr (ALIGN_EPI) { if (wr == 0) PG8_BAR; }
        if constexpr (!Epi::AFTER_DRAIN) { E(acc, cur, wr, wc, fr, fq); S.done(cur); }
        if (!has_next) break;
#pragma unroll
        for (int a = 0; a < 2; ++a)
#pragma unroll
            for (int b = 0; b < 2; ++b)
#pragma unroll
                for (int m = 0; m < 4; ++m)
#pragma unroll
                    for (int n = 0; n < 2; ++n) acc[a][b][m][n] = (f32x4){0.f, 0.f, 0.f, 0.f};
        cur = nxt; cA = nA; cB = nB; ++ui;
        if constexpr (ALIGN_EPI) { if (wr == 1) PG8_BAR; }
    }
    PG8_WAIT_V(0);
    if constexpr (!ALIGN_EPI) { if (wr == 0) PG8_BAR; }
    PG8_BAR;
    if constexpr (Epi::AFTER_DRAIN) { E.fused(acc, cur, wr, wc, fr, fq, lds, wid, lane); S.done(cur); }
#undef PG8_SA
#undef PG8_SB
#undef PG8_STAGE
#undef PG8_LDA
#undef PG8_LDB
#undef PG8_MMA
#undef PG8_WAIT_V
#undef PG8_WAIT_L
#undef PG8_BAR
#undef PG8_SCHED
}
}

typedef float f32x2_t __attribute__((ext_vector_type(2))); typedef __bf16 bf16x2_t __attribute__((ext_vector_type(2)));
DI unsigned cvt_pk_bf16(float lo, float hi) { const f32x2_t v = {lo, hi}; const bf16x2_t b = __builtin_convertvector(v, bf16x2_t); return __builtin_bit_cast(unsigned, b); }
DI u32x4 pack8(const f32x4 a, const f32x4 b) { u32x4 w; w.x = cvt_pk_bf16(a[0], a[1]); w.y = cvt_pk_bf16(a[2], a[3]); w.z = cvt_pk_bf16(b[0], b[1]); w.w = cvt_pk_bf16(b[2], b[3]); return w; }
struct EpiIn {
    static constexpr bool PERM = true, AFTER_DRAIN = false;
    Ctx C; int l;
    DI void operator()(const f32x4 (&acc)[2][2][4][2], const pg8::Unit& u, int wr, int wc, int fr, int fq) const {
        const int row0 = u.pm * 256 + wr * 64 + fr;
        float rs[2][4];
#pragma unroll
        for (int ai = 0; ai < 2; ++ai)
#pragma unroll
            for (int m = 0; m < 4; ++m) {
                const f32x4 p = *(const f32x4*)(C.rss() + (size_t)(row0 + ai * 128 + m * 16) * 16 + 4 * fq);
                float s = sum_fq((p[0] + p[1]) + (p[2] + p[3]));
                rs[ai][m] = rsqrtf(s * (1.f / DM) + EPS);
            }
        if (u.pn < 19) {
            bf16_t* base = C.proj() + (size_t)row0 * PJW + u.pn * 256 + wc * 32 + 8 * fq;
#pragma unroll
            for (int ai = 0; ai < 2; ++ai)
#pragma unroll
                for (int m = 0; m < 4; ++m) {
                    bf16_t* rowp = base + (size_t)(ai * 128 + m * 16) * PJW; const float sc = rs[ai][m];
#pragma unroll
                    for (int bj = 0; bj < 2; ++bj) *(u32x4*)(rowp + bj * 128) = pack8(acc[ai][bj][m][0] * sc, acc[ai][bj][m][1] * sc);
                }
        } else if (u.pn == 19) {
            if (wc < 2) {
                const float* kw = C.inp(19) + l * 64 + 8 * fq;
                const f32x4 k00 = *(const f32x4*)(kw), k01 = *(const f32x4*)(kw + 4), k10 = *(const f32x4*)(kw + 32), k11 = *(const f32x4*)(kw + 36);
#pragma unroll
                for (int ai = 0; ai < 2; ++ai)
#pragma unroll
                    for (int m = 0; m < 4; ++m) {
                        const int row = row0 + ai * 128 + m * 16; int sb, t; row_sbt(row, sb, t);
                        const float sc = rs[ai][m];
                        f32x4 a0 = acc[ai][0][m][0] * sc, a1 = acc[ai][0][m][1] * sc, b0 = acc[ai][1][m][0] * sc, b1 = acc[ai][1][m][1] * sc;
                        float ss = 0.f;
#pragma unroll
                        for (int i = 0; i < 4; ++i) ss += (a0[i] * a0[i] + a1[i] * a1[i]) + (b0[i] * b0[i] + b1[i] * b1[i]);
                        ss = sum_fq(ss);
                        const float rn = rsqrtf(ss * (1.f / 64.f) + EPS);
                        a0 = a0 * rn * k00; a1 = a1 * rn * k01; b0 = b0 * rn * k10; b1 = b1 * rn * k11;
                        float* o = out_ak(C, l, sb) + (size_t)t * 128 + wc * 64 + 8 * fq;
                        *(f32x4*)(o) = a0; *(f32x4*)(o + 4) = a1; *(f32x4*)(o + 32) = b0; *(f32x4*)(o + 36) = b1;
                        bf16_t* kv = C.kvb(l) + kvb_off(sb) + (size_t)(sb_P(sb) + t) * KVW + wc * 64 + 8 * fq;
                        *(u32x4*)(kv) = pack8(a0, a1); *(u32x4*)(kv + 32) = pack8(b0, b1);
                    }
            } else {
                const int kvh = wc - 2;
#pragma unroll
                for (int ai = 0; ai < 2; ++ai)
#pragma unroll
                    for (int m = 0; m < 4; ++m) {
                        const int row = row0 + ai * 128 + m * 16; int sb, t; row_sbt(row, sb, t);
                        const float sc = rs[ai][m];
                        const f32x4 a0 = acc[ai][0][m][0] * sc, a1 = acc[ai][0][m][1] * sc, b0 = acc[ai][1][m][0] * sc, b1 = acc[ai][1][m][1] * sc;
                        float* o = out_av(C, l, sb) + (size_t)t * 128 + kvh * 64 + 8 * fq;
                        *(f32x4*)(o) = a0; *(f32x4*)(o + 4) = a1; *(f32x4*)(o + 32) = b0; *(f32x4*)(o + 36) = b1;
                        bf16_t* kv = C.kvb(l) + kvb_off(sb) + (size_t)(sb_P(sb) + t) * KVW + 128 + kvh * 64 + 8 * fq;
                        *(u32x4*)(kv) = pack8(a0, a1); *(u32x4*)(kv + 32) = pack8(b0, b1);
                    }
            }
        } else {
#pragma unroll
            for (int ai = 0; ai < 2; ++ai)
#pragma unroll
                for (int m = 0; m < 4; ++m) {
                    const int row = row0 + ai * 128 + m * 16; int sb, t; row_sbt(row, sb, t);
                    const float sc = rs[ai][m];
                    const f32x4 a0 = acc[ai][0][m][0] * sc, a1 = acc[ai][0][m][1] * sc;
                    if (wc < 2) {
                        const int d = 32 * wc + 8 * fq;
                        float* o = out_ik(C, l, sb) + (size_t)t * 64 + d;
                        *(f32x4*)(o) = a0; *(f32x4*)(o + 4) = a1;
                        *(u32x4*)(C.kvb(l) + kvb_off(sb) + (size_t)(sb_P(sb) + t) * KVW + 256 + d) = pack8(a0, a1);
                    } else if (wc == 2) {
                        if (fq == 0) { *(f32x4*)(C.wi() + (size_t)row * 4) = a0; *(f32x4*)(C.dtr() + (size_t)row * 16) = a1; }
                        else if (fq == 1) { *(f32x4*)(C.dtr() + (size_t)row * 16 + 4) = a0; *(f32x4*)(C.dtr() + (size_t)row * 16 + 8) = a1; }
                        else if (fq == 2) { *(f32x4*)(C.dtr() + (size_t)row * 16 + 12) = a0; }
                    }
                }
        }
    }
};
struct EpiOut {
    static constexpr bool PERM = false, AFTER_DRAIN = false;
    Ctx C; int l;
    DI void operator()(const f32x4 (&acc)[2][2][4][2], const pg8::Unit& u, int wr, int wc, int fr, int fq) const {
        const int row0 = u.pm * 256 + wr * 64 + fr, col0 = u.pn * 256 + wc * 32 + 4 * fq;
#pragma unroll
        for (int ai = 0; ai < 2; ++ai)
#pragma unroll
            for (int m = 0; m < 4; ++m) {
                const int row = row0 + ai * 128 + m * 16;
                const float* xres = (l == 0) ? ((row < ROWS_P) ? C.inp(0) + (size_t)row * DM : C.inp(1) + (size_t)(row - ROWS_P) * DM) : C.out + (size_t)row * DM;
                float ss = 0.f;
#pragma unroll
                for (int bj = 0; bj < 2; ++bj)
#pragma unroll
                    for (int n = 0; n < 2; ++n) {
                        const int col = col0 + bj * 128 + n * 16;
                        const f32x4 v = *(const f32x4*)(xres + col) + acc[ai][bj][m][n];
                        *(f32x4*)(C.out + (size_t)row * DM + col) = v;
                        if (l == 0) {
                            u32x2 w; w.x = cvt_pk_bf16(v[0], v[1]); w.y = cvt_pk_bf16(v[2], v[3]);
                            *(u32x2*)(C.hb() + (size_t)row * DM + col) = w;
                            ss += (v[0] * v[0] + v[1] * v[1]) + (v[2] * v[2] + v[3] * v[3]);
                        }
                    }
                if (l == 0) {
                    ss = sum_fq(ss);
                    if (fq == 0) C.rss()[(size_t)row * 16 + u.pn * 4 + wc] = ss;
                }
            }
    }
};
DI void phase_inproj_gemm(const Ctx& C, int l) {
    pg8::Gemm g{C.hb(), C.win(l), ROWS, NPAD, DM, DM};
    pg8::StaticOrder S; S.init(ROWS, NPAD, C.G, C.bid);
    EpiIn E{C, l};
    pg8::gemm_phase<EpiIn, pg8::StaticOrder, true, true>(C.lds, g, S, E, C.tid);
}
DI void phase_outproj_gemm(const Ctx& C, int l) {
    pg8::Gemm g{C.proj(), C.wout(l), ROWS, DM, DMIX, PJW};
    pg8::StaticOrder S; S.init(ROWS, DM, C.G, C.bid);
    EpiOut E{C, l};
    pg8::gemm_phase<EpiOut, pg8::StaticOrder, true, true>(C.lds, g, S, E, C.tid);
}
DI void phase_ycnorm(const Ctx& C, int l) {
    const int gw = C.bid * NWAVES + C.wave, NGW = C.G * NWAVES, lane = C.lane;
#if USE_SSD_OPT
    for (int i = C.bid * NTHREADS + C.tid; i < NSB * 3 * 1536; i += C.G * NTHREADS) {
        const int sb = i / (3 * 1536), j = (i / 1536) % 3, ch = i % 1536;
        out_sc(C, l, sb)[j * 1536 + ch] = bf2f(C.proj()[(size_t)(sb_row0(sb) + sb_T(sb) - 3 + j) * PJW + C_XBC + ch]);
    }
#endif
    for (int m = gw; m < ROWS; m += NGW) {
        const float s = C.ssq()[(size_t)m * 64 + lane];
        float h = s;
        h = half_sum32(h);
        const float rg = rsqrtf(h * (1.f / 512.f) + EPS);
        const float r0 = bperm(rg, 0), r1 = bperm(rg, 32);
        bf16_t* p = C.proj() + (size_t)m * PJW + C_Z;
#pragma unroll
        for (int j = 0; j < 2; ++j) {
            const int c = 8 * lane + 512 * j;
            const u32x4 v = *(const u32x4*)(p + c); const float r = j == 0 ? r0 : r1; u32x4 o;
            o.x = cvt_pk_bf16(__uint_as_float(v.x << 16) * r, __uint_as_float(v.x & 0xffff0000u) * r);
            o.y = cvt_pk_bf16(__uint_as_float(v.y << 16) * r, __uint_as_float(v.y & 0xffff0000u) * r);
            o.z = cvt_pk_bf16(__uint_as_float(v.z << 16) * r, __uint_as_float(v.z & 0xffff0000u) * r);
            o.w = cvt_pk_bf16(__uint_as_float(v.w << 16) * r, __uint_as_float(v.w & 0xffff0000u) * r);
            *(u32x4*)(p + c) = o;
        }
    }
}

template <int MODE>
DI void p0_transpose_item(const Ctx& C, const float* W, const float* scale, int K, int Nsrc, int Ndst, bf16_t* WT, LAS float* scr, int item) {
    const int lane = C.lane, nblk = Ndst / 32, kb = item / nblk, nb = item % nblk, k0 = 64 * kb, n0 = 32 * nb;
    const int ncol = n0 + (lane & 31);
    const int src = (MODE == 0) ? orig_col(ncol) : ncol;
#pragma unroll 8
    for (int i = 0; i < 32; ++i) {
        const int kk = 2 * i + (lane >> 5), k = k0 + kk;
        float v = 0.f;
        if (src >= 0) {
            v = W[(size_t)k * Nsrc + src];
            if (MODE == 0) v *= scale[k];
            else if (k >= 1024) v *= scale[k - 1024];
        }
        scr[kk * 33 + (lane & 31)] = v;
    }
    LDS_FENCE();
    const int c = lane & 7;
#pragma unroll
    for (int j = 0; j < 4; ++j) {
        const int n = (lane >> 3) + 8 * j; const LAS float* s = scr + (8 * c) * 33 + n;
        u32x4 o; o.x = pk2(s[0 * 33], s[1 * 33]); o.y = pk2(s[2 * 33], s[3 * 33]); o.z = pk2(s[4 * 33], s[5 * 33]); o.w = pk2(s[6 * 33], s[7 * 33]);
        *(u32x4*)(WT + (size_t)(n0 + n) * K + k0 + 8 * c) = o;
    }
    LDS_FENCE();
}
DI void phase_prologue(const Ctx& C) {
    LAS float* scr = (LAS float*)(C.lds + C.wave * 16384);
    const int gw = C.bid * NWAVES + C.wave, NGW = C.G * NWAVES;
    constexpr int I_IN = (DM / 64) * (NPAD / 32), I_OUT = (DMIX / 64) * (DM / 32);
    for (int it = gw; it < 2 * (I_IN + I_OUT); it += NGW) {
        int r = it; const int l = r / (I_IN + I_OUT); r -= l * (I_IN + I_OUT);
        if (r < I_IN) p0_transpose_item<0>(C, C.inp(10) + (size_t)l * DM * DINP, C.inp(9) + l * DM, DM, DINP, NPAD, C.win(l), scr, r);
        else p0_transpose_item<1>(C, C.inp(27) + (size_t)l * DMIX * DM, C.inp(26) + l * 1024, DMIX, DM, DM, C.wout(l), scr, r - I_IN);
    }
    for (int m = gw; m < ROWS; m += NGW) {
        const float* xr = (m < ROWS_P) ? C.inp(0) + (size_t)m * DM : C.inp(1) + (size_t)(m - ROWS_P) * DM;
        float ss = 0.f;
#pragma unroll
        for (int j = 0; j < 4; ++j) {
            const f32x4 v = *(const f32x4*)(xr + 4 * C.lane + 256 * j);
            ss += (v.x * v.x + v.y * v.y) + (v.z * v.z + v.w * v.w);
            u32x2 o; o.x = pk2(v.x, v.y); o.y = pk2(v.z, v.w);
            *(u32x2*)(C.hb() + (size_t)m * DM + 4 * C.lane + 256 * j) = o;
        }
        ss = wave_sum(ss);
        if (C.lane < 16) C.rss()[(size_t)m * 16 + C.lane] = (C.lane == 0) ? ss : 0.f;
    }
    for (int it = gw; it < 2 * NSB_S * PAST; it += NGW) {
        const int l = it / (NSB_S * PAST), r = it % (NSB_S * PAST), b = r / PAST, pos = r % PAST;
        bf16_t* dst = C.kvb(l) + kvb_off(NPB + b) + (size_t)pos * KVW;
        const size_t base = ((size_t)(l * NSB_S + b) * PAST + pos);
#pragma unroll
        for (int j = 0; j < 5; ++j) {
            const int c = C.lane + 64 * j; float v;
            if (c < 128) v = C.inp(2)[base * 128 + c]; else if (c < 256) v = C.inp(3)[base * 128 + (c - 128)]; else v = C.inp(4)[base * 64 + (c - 256)];
            dst[c] = f2bf(v);
        }
    }
}

#define MFMA32(a, b, c) __builtin_amdgcn_mfma_f32_32x32x16_bf16((a), (b), (c), 0, 0, 0)
DI void phase_inproj_simple(const Ctx& C, int l) {
    const int gw = C.bid * NWAVES + C.wave, NGW = C.G * NWAVES, lane = C.lane, r = lane & 31, h = lane >> 5;
    constexpr int NG = 82, NRT = ROWS / 32;
    const bf16_t* WIN = C.win(l); const bf16_t* HB = C.hb(); bf16_t* PJ = C.proj();
    for (int it = gw; it < NRT * NG; it += NGW) {
        const int rt = it / NG, g = it % NG, m0 = rt * 32;
        int c0, c1, type;
        if (g < 76) { c0 = 64 * g; c1 = c0 + 32; type = 0; }
        else if (g < 80) { const int hs = g - 76; c0 = C_T19 + 32 * hs; c1 = c0 + 128; type = hs < 2 ? 1 : 2; }
        else if (g == 80) { c0 = C_T20; c1 = C_T20 + 32; type = 3; }
        else { c0 = C_T20 + 64; c1 = C_T20 + 96; type = 4; }
        f32x16 acc0, acc1;
#pragma unroll
        for (int i = 0; i < 16; ++i) { acc0[i] = 0.f; acc1[i] = 0.f; }
        const bf16_t* Ap = HB + (size_t)(m0 + r) * DM + 8 * h;
        const bf16_t* B0 = WIN + (size_t)(c0 + r) * DM + 8 * h;
        const bf16_t* B1 = WIN + (size_t)(c1 + r) * DM + 8 * h;
#pragma unroll 4
        for (int k0 = 0; k0 < DM; k0 += 16) {
            const bf16x8 a = *(const bf16x8*)(Ap + k0), b0 = *(const bf16x8*)(B0 + k0), b1 = *(const bf16x8*)(B1 + k0);
            acc0 = MFMA32(a, b0, acc0); acc1 = MFMA32(a, b1, acc1);
        }
        float rsc; { const float* p = C.rss() + (size_t)(m0 + r) * 16; float s = 0.f;
#pragma unroll
            for (int j = 0; j < 16; ++j) s += p[j];
            rsc = rsqrtf(s * (1.f / DM) + EPS); }
        const float kn0 = (type == 1) ? C.inp(19)[l * 64 + r] : 1.f, kn1 = (type == 1) ? C.inp(19)[l * 64 + 32 + r] : 1.f;
#pragma unroll
        for (int reg = 0; reg < 16; ++reg) {
            const int rowl = crow(reg, h), m = m0 + rowl;
            const float sc = bperm(rsc, rowl);
            float v0 = acc0[reg] * sc, v1 = acc1[reg] * sc;
            if (type == 0) { PJ[(size_t)m * PJW + c0 + r] = f2bf(v0); PJ[(size_t)m * PJW + c1 + r] = f2bf(v1); }
            else {
                int sb, t; row_sbt(m, sb, t); const int pos = sb_P(sb) + t;
                bf16_t* kv = C.kvb(l) + kvb_off(sb) + (size_t)pos * KVW;
                if (type == 1) {
                    const int kvh = g - 76;
                    const float ss = half_sum32(v0 * v0 + v1 * v1), rn = rsqrtf(ss * (1.f / 64.f) + EPS);
                    v0 = v0 * rn * kn0; v1 = v1 * rn * kn1;
                    float* o = out_ak(C, l, sb) + (size_t)t * 128 + kvh * 64;
                    o[r] = v0; o[32 + r] = v1; kv[kvh * 64 + r] = f2bf(v0); kv[kvh * 64 + 32 + r] = f2bf(v1);
                } else if (type == 2) {
                    const int kvh = g - 78;
                    float* o = out_av(C, l, sb) + (size_t)t * 128 + kvh * 64;
                    o[r] = v0; o[32 + r] = v1; kv[128 + kvh * 64 + r] = f2bf(v0); kv[128 + kvh * 64 + 32 + r] = f2bf(v1);
                } else if (type == 3) {
                    float* o = out_ik(C, l, sb) + (size_t)t * 64;
                    o[r] = v0; o[32 + r] = v1; kv[256 + r] = f2bf(v0); kv[256 + 32 + r] = f2bf(v1);
                } else {
                    if (r < 4) C.wi()[(size_t)m * 4 + r] = v0; else if (r < 20) C.dtr()[(size_t)m * 16 + (r - 4)] = v0;
                }
            }
        }
    }
}

DI void phase_outproj_simple(const Ctx& C, int l) {
    const int gw = C.bid * NWAVES + C.wave, NGW = C.G * NWAVES, lane = C.lane, r = lane & 31, h = lane >> 5;
    constexpr int NG = DM / 64, NRT = ROWS / 32;
    const bf16_t* WO = C.wout(l); const bf16_t* PJ = C.proj();
    for (int it = gw; it < NRT * NG; it += NGW) {
        const int rt = it / NG, g = it % NG, m0 = rt * 32, c0 = 64 * g, c1 = c0 + 32;
        f32x16 a00, a01, a10, a11, a20, a21;
#pragma unroll
        for (int i = 0; i < 16; ++i) { a00[i] = 0.f; a01[i] = 0.f; a10[i] = 0.f; a11[i] = 0.f; a20[i] = 0.f; a21[i] = 0.f; }
        const bf16_t* Ap = PJ + (size_t)(m0 + r) * PJW + 8 * h;
        const bf16_t* B0 = WO + (size_t)(c0 + r) * DMIX + 8 * h;
        const bf16_t* B1 = WO + (size_t)(c1 + r) * DMIX + 8 * h;
#pragma unroll 4
        for (int k0 = 0; k0 < 1024; k0 += 16) { const bf16x8 a = *(const bf16x8*)(Ap + k0); a00 = MFMA32(a, *(const bf16x8*)(B0 + k0), a00); a01 = MFMA32(a, *(const bf16x8*)(B1 + k0), a01); }
#pragma unroll 4
        for (int k0 = 1024; k0 < 1536; k0 += 16) { const bf16x8 a = *(const bf16x8*)(Ap + k0); a10 = MFMA32(a, *(const bf16x8*)(B0 + k0), a10); a11 = MFMA32(a, *(const bf16x8*)(B1 + k0), a11); }
#pragma unroll 4
        for (int k0 = 1536; k0 < 2048; k0 += 16) { const bf16x8 a = *(const bf16x8*)(Ap + k0); a20 = MFMA32(a, *(const bf16x8*)(B0 + k0), a20); a21 = MFMA32(a, *(const bf16x8*)(B1 + k0), a21); }
        float r0, r1; { const float* p = C.ssq() + (size_t)(m0 + r) * 64; float s0 = 0.f, s1 = 0.f;
#pragma unroll
            for (int j = 0; j < 32; ++j) { s0 += p[j]; s1 += p[32 + j]; }
            r0 = rsqrtf(s0 * (1.f / 512.f) + EPS); r1 = rsqrtf(s1 * (1.f / 512.f) + EPS); }
#pragma unroll
        for (int reg = 0; reg < 16; ++reg) {
            const int rowl = crow(reg, h), m = m0 + rowl;
            const float g0 = bperm(r0, rowl), g1 = bperm(r1, rowl);
            const float* xres = (l == 0) ? ((m < ROWS_P) ? C.inp(0) + (size_t)m * DM : C.inp(1) + (size_t)(m - ROWS_P) * DM) : C.out + (size_t)m * DM;
            const float v0 = xres[c0 + r] + a00[reg] + g0 * a10[reg] + g1 * a20[reg];
            const float v1 = xres[c1 + r] + a01[reg] + g0 * a11[reg] + g1 * a21[reg];
            C.out[(size_t)m * DM + c0 + r] = v0; C.out[(size_t)m * DM + c1 + r] = v1;
            if (l == 0) {
                C.hb()[(size_t)m * DM + c0 + r] = f2bf(v0); C.hb()[(size_t)m * DM + c1 + r] = f2bf(v1);
                const float ss = half_sum32(v0 * v0 + v1 * v1);
                if (r == 0) C.rss()[(size_t)m * 16 + g] = ss;
            }
        }
    }
}

DI void phase_conv_naive(const Ctx& C, int l) {
    const int gt = C.bid * NTHREADS + C.tid, NGT = C.G * NTHREADS;
    bf16_t* PJ = C.proj();
    for (int i = gt; i < NSB * 1536; i += NGT) {
        const int sb = i / 1536, ch = i % 1536, T = sb_T(sb), row0 = sb_row0(sb);
        const float* cw = C.inp(21) + (size_t)l * 4 * 1536; const float w0 = cw[ch], w1 = cw[1536 + ch], w2 = cw[2 * 1536 + ch], w3 = cw[3 * 1536 + ch], bias = C.inp(22)[l * 1536 + ch];
        float h0 = 0.f, h1 = 0.f, h2 = 0.f;
        if (sb >= NPB) { const float* st = C.inp(7) + ((size_t)(l * NSB_S + sb - NPB) * 3) * 1536; h0 = st[ch]; h1 = st[1536 + ch]; h2 = st[2 * 1536 + ch]; }
        bf16_t* p = PJ + (size_t)row0 * PJW + C_XBC + ch;
        for (int t = 0; t < T; ++t) {
            const float x = bf2f(p[(size_t)t * PJW]);
            const float y = bias + w0 * h0 + w1 * h1 + w2 * h2 + w3 * x;
            p[(size_t)t * PJW] = f2bf(silu_f(y));
            h0 = h1; h1 = h2; h2 = x;
        }
        float* o = out_sc(C, l, sb); o[ch] = h0; o[1536 + ch] = h1; o[2 * 1536 + ch] = h2;
    }
}

DI void lru_item_naive(const Ctx& C, int l, int sb, int blk, LAS unsigned char* scr) {
    const int lane = C.lane, ch = blk * 64 + lane, T = sb_T(sb), row0 = sb_row0(sb);
    bf16_t* PJ = C.proj();
    LAS unsigned* wl = (LAS unsigned*)scr;
    { const float* pa = C.inp(13) + (size_t)(l * 8 + blk) * 4096 + lane; const float* px = C.inp(15) + (size_t)(l * 8 + blk) * 4096 + lane;
      for (int c = 0; c < 64; ++c) wl[c * 64 + lane] = pk2(pa[c * 64], px[c * 64]); }
    LDS_FENCE();
    const float ba = C.inp(14)[l * 512 + ch], bx = C.inp(16)[l * 512 + ch];
    const float spl = softplus_f(-C.inp(17)[l * 512 + ch]);
    const float* cw = C.inp(11) + (size_t)l * 4 * 512; const float w0 = cw[ch], w1 = cw[512 + ch], w2 = cw[1024 + ch], w3 = cw[1536 + ch], cb = C.inp(12)[l * 512 + ch];
    float h0 = 0.f, h1 = 0.f, h2 = 0.f, hs = 0.f;
    if (sb >= NPB) { const float* st = C.inp(5) + ((size_t)(l * NSB_S + sb - NPB) * 3) * 512; h0 = st[ch]; h1 = st[512 + ch]; h2 = st[1024 + ch]; hs = C.inp(6)[(size_t)(l * NSB_S + sb - NPB) * 512 + ch]; }
    for (int t = 0; t < T; ++t) {
        const size_t rb = (size_t)(row0 + t) * PJW;
        const float x = bf2f(PJ[rb + C_XL + ch]);
        const float xc = cb + w0 * h0 + w1 * h1 + w2 * h2 + w3 * x;
        h0 = h1; h1 = h2; h2 = x;
        float ga = ba, gx = bx;
#pragma unroll 8
        for (int c = 0; c < 64; ++c) { const float xv = __int_as_float(__builtin_amdgcn_readlane(__float_as_int(xc), c)); const unsigned w = wl[c * 64 + lane]; ga += xv * __uint_as_float(w << 16); gx += xv * __uint_as_float(w & 0xffff0000u); }
        const float rg = sigmoid_f(ga), ig = sigmoid_f(gx);
        const float log_a = -8.f * rg * spl, a = expf(log_a), mult = sqrtf(-expm1f(2.f * log_a));
        hs = a * hs + mult * (ig * xc);
        const float gl = bf2f(PJ[rb + C_GL + ch]);
        PJ[rb + C_GL + ch] = f2bf(hs * silu_f(gl));
    }
    float* oc = out_lc(C, l, sb); oc[ch] = h0; oc[512 + ch] = h1; oc[1024 + ch] = h2;
    out_lh(C, l, sb)[ch] = hs;
}

DI void ssd_item_naive(const Ctx& C, int l, int sb, int hd, int pq) {
    const int lane = C.lane, T = sb_T(sb), row0 = sb_row0(sb), g = hd >> 3;
    const int p = 16 * pq + (lane & 15), nq = lane >> 4, n0 = 32 * nq;
    bf16_t* PJ = C.proj();
    float hst[32];
    if (sb >= NPB) { const float* st = C.inp(8) + (((size_t)(l * NSB_S + sb - NPB) * 16 + hd) * 64 + p) * 128 + n0;
#pragma unroll
        for (int n = 0; n < 32; n += 4) { const f32x4 v = *(const f32x4*)(st + n); hst[n] = v.x; hst[n + 1] = v.y; hst[n + 2] = v.z; hst[n + 3] = v.w; } }
    else {
#pragma unroll
        for (int n = 0; n < 32; ++n) hst[n] = 0.f; }
    const float aneg = -expf(C.inp(24)[l * 16 + hd]), dtb = C.inp(23)[l * 16 + hd], Dh = C.inp(25)[l * 16 + hd];
    for (int t = 0; t < T; ++t) {
        const size_t rb = (size_t)(row0 + t) * PJW;
        const float dt = softplus_f(C.dtr()[(size_t)(row0 + t) * 16 + hd] + dtb), da = expf(dt * aneg);
        const float xs = bf2f(PJ[rb + C_XBC + hd * 64 + p]), dtx = dt * xs;
        const bf16_t* Bp = PJ + rb + C_XBC + 1024 + g * 128 + n0; const bf16_t* Cp = PJ + rb + C_XBC + 1280 + g * 128 + n0;
        float y = 0.f;
#pragma unroll
        for (int n = 0; n < 32; n += 8) {
            const bf16x8 bv = *(const bf16x8*)(Bp + n), cv = *(const bf16x8*)(Cp + n);
#pragma unroll
            for (int j = 0; j < 8; ++j) { hst[n + j] = da * hst[n + j] + dtx * bf2f((bf16_t)bv[j]); y += bf2f((bf16_t)cv[j]) * hst[n + j]; }
        }
        y = sum_fq(y);
        y += Dh * xs;
        const float z = bf2f(PJ[rb + C_Z + hd * 64 + p]);
        y *= silu_f(z);
        if (nq == 0) PJ[rb + C_Z + hd * 64 + p] = f2bf(y);
        const float ss = wave_sum(nq == 0 ? y * y : 0.f);
        if (lane == 0) C.ssq()[(size_t)(row0 + t) * 64 + hd * 4 + pq] = ss;
    }
    float* o = out_sh(C, l, sb) + ((size_t)hd * 64 + p) * 128 + n0;
#pragma unroll
    for (int n = 0; n < 32; n += 4) { f32x4 v; v.x = hst[n]; v.y = hst[n + 1]; v.z = hst[n + 2]; v.w = hst[n + 3]; *(f32x4*)(o + n) = v; }
}

constexpr int SS_XST = 0;
constexpr int SS_BM = SS_XST + 64 * 144;
constexpr int SS_CM = SS_BM + 64 * 272;
constexpr int SS_BWT = SS_CM + 64 * 272;
constexpr int SS_HA = SS_BWT + 128 * 144;
constexpr int SS_SCAL = SS_HA + 2 * 64 * 272;
constexpr int SS_CW = SS_SCAL + 2 * 1024;
constexpr int SS_RAW = SS_CW + 5 * 320 * 4;
constexpr int SS_Z = SS_RAW + 67 * 640;
constexpr int SS_END = SS_Z + 8192;
static_assert(SS_END <= LDS_BYTES - 256, "SSD LDS map");
typedef short s16x4 __attribute__((ext_vector_type(4)));
DI float fast_silu(float x) { return x * __builtin_amdgcn_rcpf(1.f + __builtin_amdgcn_exp2f(-1.4426950408889634f * x)); }
DI bf16x8 lds_frag(const LAS unsigned char* base, int row, int rowbytes, int col) { return *(const LAS bf16x8*)(base + row * rowbytes + col * 2); }

DI void ssd_item(const Ctx& C, int l, int sb, int hd) {
    const int tid = C.tid, lane = C.lane, wave = C.wave, r = lane & 31, h = lane >> 5;
    const int T = sb_T(sb), row0 = sb_row0(sb), g = hd >> 3, NC = T / 64;
    LAS unsigned char* L = C.lds;
    bf16_t* PJ = C.proj();
    const float aneg = -expf(C.inp(24)[l * 16 + hd]), dtb = C.inp(23)[l * 16 + hd], Dh = C.inp(25)[l * 16 + hd];
    const bool stager = tid < 320;
    const int cg = 8 * (tid >> 6) + (tid & 7), seg = (tid >> 3) & 7;
    int colbase, cch;
    if (cg < 8) { cch = hd * 64 + 8 * cg; } else if (cg < 24) { cch = 1024 + g * 128 + 8 * (cg - 8); } else { cch = 1280 + g * 128 + 8 * (cg - 24); }
    colbase = C_XBC + cch;
    for (int i = tid; i < 5 * 320; i += NTHREADS) {
        const int j = i / 320, c = i % 320, cg2 = c >> 3, e = c & 7;
        const int ch = (cg2 < 8) ? hd * 64 + 8 * cg2 + e : (cg2 < 24 ? 1024 + g * 128 + 8 * (cg2 - 8) + e : 1280 + g * 128 + 8 * (cg2 - 24) + e);
        ((LAS float*)(L + SS_CW))[i] = (j < 4) ? C.inp(21)[((size_t)l * 4 + j) * 1536 + ch] : C.inp(22)[l * 1536 + ch];
    }
    const int sj = wave - 4, sph = sj & 1, nq0 = 2 * (sj >> 1);
    f32x16 hacc0, hacc1;
#pragma unroll
    for (int i = 0; i < 16; ++i) { hacc0[i] = 0.f; hacc1[i] = 0.f; }
    if (wave >= 4) {
        if (sb >= NPB) {
            const float* st = C.inp(8) + (((size_t)(l * NSB_S + sb - NPB) * 16 + hd) * 64 + 32 * sph + r) * 128;
#pragma unroll
            for (int gq = 0; gq < 4; ++gq) {
                const f32x4 v0 = *(const f32x4*)(st + 32 * nq0 + 8 * gq + 4 * h), v1 = *(const f32x4*)(st + 32 * (nq0 + 1) + 8 * gq + 4 * h);
#pragma unroll
                for (int e = 0; e < 4; ++e) { hacc0[4 * gq + e] = v0[e]; hacc1[4 * gq + e] = v1[e]; }
            }
        }
#pragma unroll
        for (int gq = 0; gq < 4; ++gq) {
            u32x2 w0, w1; w0.x = cvt_pk_bf16(hacc0[4 * gq], hacc0[4 * gq + 1]); w0.y = cvt_pk_bf16(hacc0[4 * gq + 2], hacc0[4 * gq + 3]);
            w1.x = cvt_pk_bf16(hacc1[4 * gq], hacc1[4 * gq + 1]); w1.y = cvt_pk_bf16(hacc1[4 * gq + 2], hacc1[4 * gq + 3]);
            *(LAS u32x2*)(L + SS_HA + (32 * sph + r) * 272 + (32 * nq0 + 8 * gq + 4 * h) * 2) = w0;
            *(LAS u32x2*)(L + SS_HA + (32 * sph + r) * 272 + (32 * (nq0 + 1) + 8 * gq + 4 * h) * 2) = w1;
        }
    }
    const int yph = wave & 1, ylh = (wave >> 1) & 1;
    float dtr_pf = 0.f;
#define SSD_DMA_RAW(cc) do { const int t0_ = 64 * (cc); \
        for (int k_ = wave; k_ < 42; k_ += NWAVES) { \
            const int q_ = 64 * k_ + lane, rr_ = q_ / 40, pc_ = q_ - 40 * rr_, t_ = t0_ - 3 + rr_; \
            const int col_ = C_XBC + ((pc_ < 8) ? hd * 64 + 8 * pc_ : (pc_ < 24 ? 1024 + g * 128 + 8 * (pc_ - 8) : 1280 + g * 128 + 8 * (pc_ - 24))); \
            if (q_ < 2680 && t_ >= 0) __builtin_amdgcn_global_load_lds((const unsigned*)(PJ + (size_t)(row0 + t_) * PJW + col_), (LAS unsigned*)(L + SS_RAW + k_ * 1024), 16, 0, 0); } \
    } while (0)
#define SSD_DMA_Z(cc) do { const int t0_ = 64 * (cc); \
        if (wave < 4) { _Pragma("unroll") for (int k_ = 0; k_ < 2; ++k_) { const int rr_ = 16 * k_ + (lane >> 2), pc_ = lane & 3; \
            __builtin_amdgcn_global_load_lds((const unsigned*)(PJ + (size_t)(row0 + t0_ + 32 * ylh + rr_) * PJW + C_Z + hd * 64 + 32 * yph + 8 * pc_), \
                                             (LAS unsigned*)(L + SS_Z + (2 * yph + ylh) * 2048 + k_ * 1024), 16, 0, 0); } } \
    } while (0)
    if (tid < 120) {
        const int rr = tid / 40, pc = tid % 40;
        const int ch = (pc < 8) ? hd * 64 + 8 * pc : (pc < 24 ? 1024 + g * 128 + 8 * (pc - 8) : 1280 + g * 128 + 8 * (pc - 24));
        u32x4 v = (u32x4){0u, 0u, 0u, 0u};
        if (sb >= NPB) { const float* st = C.inp(7) + ((size_t)(l * NSB_S + sb - NPB) * 3 + rr) * 1536 + ch; v = pack8(*(const f32x4*)st, *(const f32x4*)(st + 4)); }
        *(LAS u32x4*)(L + SS_RAW + rr * 640 + pc * 16) = v;
    }
    if (wave == 0) dtr_pf = C.dtr()[(size_t)(row0 + lane) * 16 + hd];
    SSD_DMA_RAW(0); SSD_DMA_Z(0);
    asm volatile("s_waitcnt vmcnt(0)" ::: "memory");
    __syncthreads();
    for (int c = 0; c < NC; ++c) {
        const int t0 = 64 * c, par = c & 1;
        LAS float* SC = (LAS float*)(L + SS_SCAL + par * 1024);
        if (wave == 0) {
            const float dt = softplus_f(dtr_pf + dtb);
            float x = dt * aneg;
#pragma unroll
            for (int o = 1; o < 64; o <<= 1) { const float y = bperm(x, lane - o); if (lane >= o) x += y; }
            const float cum63 = __int_as_float(__builtin_amdgcn_readlane(__float_as_int(x), 63));
            SC[lane] = x; SC[64 + lane] = dt; SC[128 + lane] = expf(cum63 - x) * dt; SC[192 + lane] = expf(x);
        }
        asm volatile("s_waitcnt vmcnt(0)" ::: "memory"); LDS_FENCE(); __syncthreads();
        if (stager) {
            const LAS float* CW = (const LAS float*)(L + SS_CW) + 8 * cg;
            const int s0 = 8 * seg;
            float te[8];
#pragma unroll
            for (int j = 0; j < 8; ++j) te[j] = (cg >= 8 && cg < 24) ? SC[128 + s0 + j] : 1.f;
            const int n0 = (cg < 24) ? 8 * (cg - 8) : 8 * (cg - 24);
#pragma unroll
            for (int ep = 0; ep < 4; ++ep) {
                float xa[11], xb[11];
#pragma unroll
                for (int i = 0; i < 11; ++i) { const unsigned w = *(const LAS unsigned*)(L + SS_RAW + (s0 + i) * 640 + cg * 16 + ep * 4); xa[i] = __uint_as_float(w << 16); xb[i] = __uint_as_float(w & 0xffff0000u); }
                const float a0 = CW[2 * ep], a1 = CW[320 + 2 * ep], a2 = CW[640 + 2 * ep], a3 = CW[960 + 2 * ep], ab = CW[1280 + 2 * ep];
                const float b0 = CW[2 * ep + 1], b1 = CW[320 + 2 * ep + 1], b2 = CW[640 + 2 * ep + 1], b3 = CW[960 + 2 * ep + 1], bb = CW[1280 + 2 * ep + 1];
                float ta[8], tb[8];
#pragma unroll
                for (int j = 0; j < 8; ++j) {
                    ta[j] = fast_silu(ab + a0 * xa[j] + a1 * xa[j + 1] + a2 * xa[j + 2] + a3 * xa[j + 3]);
                    tb[j] = fast_silu(bb + b0 * xb[j] + b1 * xb[j + 1] + b2 * xb[j + 2] + b3 * xb[j + 3]);
                }
                if (cg < 8) {
#pragma unroll
                    for (int jp = 0; jp < 4; ++jp) {
                        *(LAS unsigned*)(L + SS_XST + (8 * cg + 2 * ep) * 144 + (s0 + 2 * jp) * 2) = cvt_pk_bf16(ta[2 * jp], ta[2 * jp + 1]);
                        *(LAS unsigned*)(L + SS_XST + (8 * cg + 2 * ep + 1) * 144 + (s0 + 2 * jp) * 2) = cvt_pk_bf16(tb[2 * jp], tb[2 * jp + 1]);
                    }
                } else if (cg < 24) {
#pragma unroll
                    for (int j = 0; j < 8; ++j) *(LAS unsigned*)(L + SS_BM + (s0 + j) * 272 + (n0 + 2 * ep) * 2) = cvt_pk_bf16(ta[j], tb[j]);
#pragma unroll
                    for (int jp = 0; jp < 4; ++jp) {
                        *(LAS unsigned*)(L + SS_BWT + (n0 + 2 * ep) * 144 + (s0 + 2 * jp) * 2) = cvt_pk_bf16(ta[2 * jp] * te[2 * jp], ta[2 * jp + 1] * te[2 * jp + 1]);
                        *(LAS unsigned*)(L + SS_BWT + (n0 + 2 * ep + 1) * 144 + (s0 + 2 * jp) * 2) = cvt_pk_bf16(tb[2 * jp] * te[2 * jp], tb[2 * jp + 1] * te[2 * jp + 1]);
                    }
                } else {
#pragma unroll
                    for (int j = 0; j < 8; ++j) *(LAS unsigned*)(L + SS_CM + (s0 + j) * 272 + (n0 + 2 * ep) * 2) = cvt_pk_bf16(ta[j], tb[j]);
                }
            }
        }
        if (c + 1 < NC && wave == 0) dtr_pf = C.dtr()[(size_t)(row0 + t0 + 64 + lane) * 16 + hd];
        LDS_FENCE(); __syncthreads();
        if (c + 1 < NC) SSD_DMA_RAW(c + 1);
        if (wave < 4) {
            const LAS unsigned char* HAc = L + SS_HA + par * (64 * 272);
            bf16x8 cf[8];
#pragma unroll
            for (int ks = 0; ks < 8; ++ks) cf[ks] = lds_frag(L + SS_CM, 32 * ylh + r, 272, 16 * ks + 8 * h);
            const float cuml = SC[32 * ylh + r], ecl = SC[192 + 32 * ylh + r];
            bf16x8 wf[2][2];
#pragma unroll
            for (int sh = 0; sh < 2; ++sh) {
                if (sh <= ylh) {
                    f32x16 ga;
#pragma unroll
                    for (int i = 0; i < 16; ++i) ga[i] = 0.f;
#pragma unroll
                    for (int ks = 0; ks < 8; ++ks) ga = MFMA32(lds_frag(L + SS_BM, 32 * sh + r, 272, 16 * ks + 8 * h), cf[ks], ga);
                    float wv[16];
#pragma unroll
                    for (int reg = 0; reg < 16; ++reg) {
                        const int s = 32 * sh + crow(reg, h), ll = 32 * ylh + r;
                        const float cs = SC[s], ds = SC[64 + s];
                        float w = (s <= ll) ? ga[reg] * __builtin_amdgcn_exp2f(1.4426950408889634f * (cuml - cs)) * ds : 0.f;
                        if (s == ll) w += Dh;
                        wv[reg] = w;
                    }
#pragma unroll
                    for (int s2 = 0; s2 < 2; ++s2) {
                        u32x4 p; p.x = cvt_pk_bf16(wv[8 * s2], wv[8 * s2 + 1]); p.y = cvt_pk_bf16(wv[8 * s2 + 2], wv[8 * s2 + 3]); p.z = cvt_pk_bf16(wv[8 * s2 + 4], wv[8 * s2 + 5]); p.w = cvt_pk_bf16(wv[8 * s2 + 6], wv[8 * s2 + 7]);
                        wf[sh][s2] = __builtin_bit_cast(bf16x8, p);
                    }
                }
            }
            f32x16 ya;
#pragma unroll
            for (int i = 0; i < 16; ++i) ya[i] = 0.f;
#pragma unroll
            for (int ks = 0; ks < 8; ++ks) ya = MFMA32(lds_frag(HAc, 32 * yph + r, 272, 16 * ks + 8 * h), cf[ks], ya);
#pragma unroll
            for (int i = 0; i < 16; ++i) ya[i] *= ecl;
#pragma unroll
            for (int sh = 0; sh < 2; ++sh) {
                if (sh <= ylh) {
#pragma unroll
                    for (int s2 = 0; s2 < 2; ++s2) {
                        const LAS unsigned char* xp = L + SS_XST + (32 * yph + r) * 144 + (32 * sh + 16 * s2 + 4 * h) * 2;
                        const u32x2 lo = *(const LAS u32x2*)(xp), hi = *(const LAS u32x2*)(xp + 16);
                        u32x4 a; a.x = lo.x; a.y = lo.y; a.z = hi.x; a.w = hi.y;
                        ya = MFMA32(__builtin_bit_cast(bf16x8, a), wf[sh][s2], ya);
                    }
                }
            }
            float ss = 0.f;
            bf16_t* zp = PJ + (size_t)(row0 + t0 + 32 * ylh + r) * PJW + C_Z + hd * 64 + 32 * yph + 4 * h;
#pragma unroll
            for (int gq = 0; gq < 4; ++gq) {
                const u32x2 zz = *(const LAS u32x2*)(L + SS_Z + (2 * yph + ylh) * 2048 + r * 64 + (8 * gq + 4 * h) * 2);
                const float z0 = __uint_as_float(zz.x << 16), z1 = __uint_as_float(zz.x & 0xffff0000u), z2 = __uint_as_float(zz.y << 16), z3 = __uint_as_float(zz.y & 0xffff0000u);
                const float y0 = ya[4 * gq] * fast_silu(z0), y1 = ya[4 * gq + 1] * fast_silu(z1), y2 = ya[4 * gq + 2] * fast_silu(z2), y3 = ya[4 * gq + 3] * fast_silu(z3);
                ss += (y0 * y0 + y1 * y1) + (y2 * y2 + y3 * y3);
                u32x2 w; w.x = cvt_pk_bf16(y0, y1); w.y = cvt_pk_bf16(y2, y3);
                *(u32x2*)(zp + 8 * gq) = w;
            }
            ss = xor32_sum(ss);
            if (h == 0) { float* q = C.ssq() + (size_t)(row0 + t0 + 32 * ylh + r) * 64 + hd * 4 + yph; q[0] = ss; q[2] = 0.f; }
            LDS_FENCE();
            if (c + 1 < NC) SSD_DMA_Z(c + 1);
        } else {
            const float decay = SC[192 + 63];
#pragma unroll
            for (int i = 0; i < 16; ++i) { hacc0[i] *= decay; hacc1[i] *= decay; }
#pragma unroll
            for (int ks = 0; ks < 4; ++ks) {
                const bf16x8 xb = lds_frag(L + SS_XST, 32 * sph + r, 144, 16 * ks + 8 * h);
                hacc0 = MFMA32(lds_frag(L + SS_BWT, 32 * nq0 + r, 144, 16 * ks + 8 * h), xb, hacc0);
                hacc1 = MFMA32(lds_frag(L + SS_BWT, 32 * (nq0 + 1) + r, 144, 16 * ks + 8 * h), xb, hacc1);
            }
            LAS unsigned char* HAn = L + SS_HA + (par ^ 1) * (64 * 272);
#pragma unroll
            for (int gq = 0; gq < 4; ++gq) {
                u32x2 w0, w1; w0.x = cvt_pk_bf16(hacc0[4 * gq], hacc0[4 * gq + 1]); w0.y = cvt_pk_bf16(hacc0[4 * gq + 2], hacc0[4 * gq + 3]);
                w1.x = cvt_pk_bf16(hacc1[4 * gq], hacc1[4 * gq + 1]); w1.y = cvt_pk_bf16(hacc1[4 * gq + 2], hacc1[4 * gq + 3]);
                *(LAS u32x2*)(HAn + (32 * sph + r) * 272 + (32 * nq0 + 8 * gq + 4 * h) * 2) = w0;
                *(LAS u32x2*)(HAn + (32 * sph + r) * 272 + (32 * (nq0 + 1) + 8 * gq + 4 * h) * 2) = w1;
            }
        }
    }
    if (wave >= 4) {
        float* o = out_sh(C, l, sb) + ((size_t)hd * 64 + 32 * sph + r) * 128;
#pragma unroll
        for (int gq = 0; gq < 4; ++gq) {
            f32x4 v0, v1;
#pragma unroll
            for (int e = 0; e < 4; ++e) { v0[e] = hacc0[4 * gq + e]; v1[e] = hacc1[4 * gq + e]; }
            *(f32x4*)(o + 32 * nq0 + 8 * gq + 4 * h) = v0; *(f32x4*)(o + 32 * (nq0 + 1) + 8 * gq + 4 * h) = v1;
        }
    }
    __syncthreads();
#undef SSD_DMA_RAW
#undef SSD_DMA_Z
}

DI unsigned mono_key(float f) { const unsigned u = __float_as_uint(f); return (u & 0x80000000u) ? ~u : (u | 0x80000000u); }
DI int t5_bucket(int rel) {
    const int n = rel < 0 ? -rel : rel; int b;
    if (n < 8) b = n; else if (n < 12) b = 8; else if (n < 16) b = 9; else if (n < 23) b = 10; else if (n < 32) b = 11; else if (n < 46) b = 12; else if (n < 64) b = 13; else if (n < 91) b = 14; else b = 15;
    return b + (rel > 0 ? 16 : 0);
}
DI void attn_item_naive(const Ctx& C, int l, int m, LAS unsigned char* scr) {
    const int lane = C.lane;
    int sb, t; row_sbt(m, sb, t);
    const int P = sb_P(sb), posq = P + t, Ladm = 64 * ((posq >> 6) + 1), nsel = Ladm < 256 ? Ladm : 256;
    LAS unsigned* keys = (LAS unsigned*)scr; LAS unsigned* sel = keys + 2048; LAS float* qs = (LAS float*)(sel + 256); LAS float* ps = qs + 64; LAS float* qis = ps + 256;
    bf16_t* PJ = C.proj(); const bf16_t* KV = C.kvb(l) + kvb_off(sb);
    const size_t rb = (size_t)m * PJW;
#pragma unroll
    for (int j = 0; j < 4; ++j) qis[64 * j + lane] = bf2f(PJ[rb + C_QI + 64 * j + lane]);
    LDS_FENCE();
    const float w0 = C.wi()[(size_t)m * 4 + 0], w1 = C.wi()[(size_t)m * 4 + 1], w2 = C.wi()[(size_t)m * 4 + 2], w3 = C.wi()[(size_t)m * 4 + 3];
    for (int s = lane; s < Ladm; s += 64) {
        asm volatile("" ::: "memory");
        const bf16_t* kp = KV + (size_t)s * KVW + 256;
        float d0 = 0.f, d1 = 0.f, d2 = 0.f, d3 = 0.f;
#pragma unroll
        for (int d = 0; d < 64; d += 8) {
            const bf16x8 kv8 = *(const bf16x8*)(kp + d);
#pragma unroll
            for (int j = 0; j < 8; ++j) { const float kf = bf2f((bf16_t)kv8[j]); d0 += qis[d + j] * kf; d1 += qis[64 + d + j] * kf; d2 += qis[128 + d + j] * kf; d3 += qis[192 + d + j] * kf; }
            asm volatile("" ::: "memory");
        }
        const float score = ((w0 * fmaxf(d0, 0.f) + w1 * fmaxf(d1, 0.f)) + w2 * fmaxf(d2, 0.f)) + w3 * fmaxf(d3, 0.f);
        keys[s] = mono_key(score);
    }
    LDS_FENCE();
    for (int s = lane; s < Ladm; s += 64) {
        const unsigned km = keys[s]; int cnt = 0;
        for (int sp = 0; sp < Ladm; sp += 4) {
            const u32x4 kq = *(const LAS u32x4*)(keys + sp);
            cnt += (kq.x > km) | ((kq.x == km) & (sp < s));
            cnt += (kq.y > km) | ((kq.y == km) & (sp + 1 < s));
            cnt += (kq.z > km) | ((kq.z == km) & (sp + 2 < s));
            cnt += (kq.w > km) | ((kq.w == km) & (sp + 3 < s));
        }
        if (cnt < 256) sel[cnt] = (unsigned)s;
    }
    LDS_FENCE();
    for (int hq = 0; hq < 8; ++hq) {
        const int kvh = hq >> 2;
        { const float raw = bf2f(PJ[rb + C_Q + hq * 64 + lane]); const float ss = wave_sum(raw * raw);
          qs[lane] = raw * rsqrtf(ss * (1.f / 64.f) + EPS) * C.inp(18)[l * 64 + lane]; }
        LDS_FENCE();
        float lg[4]; float mx = -INFINITY;
#pragma unroll
        for (int i = 0; i < 4; ++i) {
            const int j = lane + 64 * i; lg[i] = -INFINITY;
            asm volatile("" ::: "memory");
            if (j < nsel) {
                const int s = (int)sel[j]; const bf16_t* kp = KV + (size_t)s * KVW + kvh * 64; float dot = 0.f;
#pragma unroll
                for (int d = 0; d < 64; d += 8) { const bf16x8 kv8 = *(const bf16x8*)(kp + d);
#pragma unroll
                    for (int jj = 0; jj < 8; ++jj) dot += qs[d + jj] * bf2f((bf16_t)kv8[jj]); }
                lg[i] = dot * 0.125f + C.inp(20)[t5_bucket(s - posq) * 8 + hq];
                mx = fmaxf(mx, lg[i]);
            }
        }
        mx = wave_max(mx);
        float sum = 0.f;
#pragma unroll
        for (int i = 0; i < 4; ++i) { const int j = lane + 64 * i; if (j < nsel) { lg[i] = expf(lg[i] - mx); sum += lg[i]; } }
        sum = wave_sum(sum); const float inv = 1.f / sum;
#pragma unroll
        for (int i = 0; i < 4; ++i) { const int j = lane + 64 * i; if (j < nsel) ps[j] = lg[i] * inv; }
        LDS_FENCE();
        float o = 0.f;
        for (int j = 0; j < nsel; ++j) o += ps[j] * bf2f(KV[(size_t)sel[j] * KVW + 128 + kvh * 64 + lane]);
        const float ga = bf2f(PJ[rb + C_GA + hq * 64 + lane]);
        PJ[rb + C_GA + hq * 64 + lane] = f2bf(o * silu_f(ga));
        LDS_FENCE();
    }
}

constexpr int AT_MASK = 0;
constexpr int AT_TMASK = AT_MASK + 64 * 65 * 4;
constexpr int AT_QST = AT_TMASK + 64 * 65 * 4;
constexpr int AT_MISC = AT_QST + 1024;
constexpr int AT_LUT = AT_MISC + 64;
constexpr int AT_HIST = AT_LUT + 8192;
constexpr int AT_RING = AT_HIST;
constexpr int AT_QI = AT_HIST + 65792;
constexpr int AT_END = AT_QI + 64 * 528;
static_assert(AT_END <= LDS_BYTES - 256 && AT_RING + 65536 <= AT_END, "attention LDS map");
typedef short v4i16_t __attribute__((ext_vector_type(4)));
#define AT_WAIT_V(n) asm volatile("s_waitcnt vmcnt(" #n ")" ::: "memory")
#define AT_BAR() do { asm volatile("s_waitcnt lgkmcnt(0)" ::: "memory"); __builtin_amdgcn_s_barrier(); asm volatile("" ::: "memory"); } while (0)

template <int MODE>
DI void idx_pass(const Ctx& C, const bf16_t* KV, const float (&w4)[4], int ntiles, int tq4, int q, int r, int h) {
    LAS unsigned char* L = C.lds;
    const LAS unsigned* QS = (const LAS unsigned*)(L + AT_QST) + 4 * q;
    const unsigned pfx = QS[0], info = QS[1];
    const int lvl = info & 15; const bool done = (info >> 4) & 1, tie = (info >> 5) & 1;
    const int sh = (MODE == 0) ? (lvl == 0 ? 23 : (lvl == 1 ? 14 : (lvl == 2 ? 5 : 0))) : (int)(info >> 8);
    const unsigned bmask = (lvl == 3) ? 31u : 511u;
    const int psh = (lvl == 1) ? 23 : (lvl == 2 ? 14 : 5);
    for (int t = tq4; t < ntiles; t += 4) {
#pragma unroll 1
        for (int kh = 0; kh < 2; ++kh) {
            const bf16_t* kp = KV + (size_t)(64 * t + 32 * kh + r) * KVW + 256 + 8 * h;
            bf16x8 a[4];
#pragma unroll
            for (int ks = 0; ks < 4; ++ks) a[ks] = *(const bf16x8*)(kp + 16 * ks);
            float sc[16];
#pragma unroll
            for (int i = 0; i < 16; ++i) sc[i] = 0.f;
#pragma unroll
            for (int hh = 0; hh < 4; ++hh) {
                f32x16 acc;
#pragma unroll
                for (int i = 0; i < 16; ++i) acc[i] = 0.f;
#pragma unroll
                for (int ks = 0; ks < 4; ++ks) acc = MFMA32(a[ks], *(const LAS bf16x8*)(L + AT_QI + q * 528 + (64 * hh + 16 * ks + 8 * h) * 2), acc);
#pragma unroll
                for (int i = 0; i < 16; ++i) sc[i] += w4[hh] * fmaxf(acc[i], 0.f);
            }
            if (MODE == 0) {
                if (!done) {
                    LAS unsigned* HR = (LAS unsigned*)(L + AT_HIST) + 257 * q;
#pragma unroll
                    for (int i = 0; i < 16; ++i) {
                        const unsigned key = mono_key(sc[i]);
                        const bool part = (lvl == 0) || ((key >> psh) == pfx);
                        if (part) { const unsigned bin = (key >> sh) & bmask; atomicAdd((unsigned*)(HR + (bin >> 1)), 1u << ((bin & 1u) << 4)); }
                    }
                }
            } else {
                unsigned mw = 0u, tw = 0u;
#pragma unroll
                for (int i = 15; i >= 0; --i) {
                    const unsigned key = mono_key(sc[i]);
                    const bool sel = tie ? (key > pfx) : ((key >> sh) >= pfx);
                    const bool tb = tie && (key == pfx);
                    mw = (mw << 1) | (sel ? 1u : 0u); tw = (tw << 1) | (tb ? 1u : 0u);
                    if ((i & 3) == 0 && i > 0) { mw <<= 4; tw <<= 4; }
                }
                mw <<= 4 * h; tw <<= 4 * h;
                if (mw) atomicOr((unsigned*)((LAS unsigned*)(L + AT_MASK) + 65 * q + 2 * t + kh), mw);
                if (tw) atomicOr((unsigned*)((LAS unsigned*)(L + AT_TMASK) + 65 * q + 2 * t + kh), tw);
            }
        }
    }
}

DI void attn_item(const Ctx& C, int l, int sb, int qb) {
    const int tid = C.tid, lane = C.lane, wave = C.wave, r = lane & 31, h = lane >> 5;
    LAS unsigned char* L = C.lds;
    const int P = sb_P(sb), row0 = sb_row0(sb), t0 = 64 * qb, pos0 = P + t0;
    const int ntiles = (pos0 >> 6) + 1, Ladm = 64 * ntiles;
    bf16_t* PJ = C.proj(); const bf16_t* KV = C.kvb(l) + kvb_off(sb);
    LAS unsigned* MASK = (LAS unsigned*)(L + AT_MASK); LAS unsigned* TMASK = (LAS unsigned*)(L + AT_TMASK);
    LAS unsigned* QST = (LAS unsigned*)(L + AT_QST); LAS unsigned* MISC = (LAS unsigned*)(L + AT_MISC);
    for (int i = tid; i < 64 * 65; i += NTHREADS) { const int w = i % 65; MASK[i] = (Ladm <= 256 && w < 2 * ntiles) ? 0xffffffffu : 0u; TMASK[i] = 0u; }
    for (int i = tid; i < 64 * 257; i += NTHREADS) ((LAS unsigned*)(L + AT_HIST))[i] = 0u;
    if (tid < 64) { unsigned k256 = 256u; asm volatile("" : "+v"(k256)); QST[4 * tid] = 0u; QST[4 * tid + 1] = 0u; QST[4 * tid + 2] = k256; QST[4 * tid + 3] = 0u; }
    for (int i = tid; i < 8 * 256; i += NTHREADS) { const int hq = i >> 8, rel = (i & 255) - 191; ((LAS float*)(L + AT_LUT))[i] = 1.4426950408889634f * C.inp(20)[t5_bucket(rel) * 8 + hq]; }
    if (tid == 0) MISC[0] = 0u;
    __syncthreads();
    if (Ladm > 256) {
        const int qh = wave & 1, tq4 = wave >> 1, q = 32 * qh + r;
        float w4[4];
        { const f32x4 wv = *(const f32x4*)(C.wi() + (size_t)(row0 + t0 + q) * 4); w4[0] = wv[0]; w4[1] = wv[1]; w4[2] = wv[2]; w4[3] = wv[3]; }
        for (int i = tid; i < 2048; i += NTHREADS) { const int qq = i >> 5, pc = i & 31;
            *(LAS u32x4*)(L + AT_QI + qq * 528 + pc * 16) = *(const u32x4*)(PJ + (size_t)(row0 + t0 + qq) * PJW + C_QI + 8 * pc); }
        __syncthreads();
        for (int lvl = 0; lvl < 4; ++lvl) {
            idx_pass<0>(C, KV, w4, ntiles, tq4, q, r, h);
            if (tid == 0) MISC[0] = 0u;
            __syncthreads();
            int ln = lane; asm volatile("" : "+v"(ln));
            for (int qq = 8 * wave; qq < 8 * wave + 8; ++qq) {
                const unsigned pfx = QST[4 * qq], info = QST[4 * qq + 1], need = QST[4 * qq + 2];
                if ((info >> 4) & 1) continue;
                LAS unsigned* HR = (LAS unsigned*)(L + AT_HIST) + 257 * qq + 4 * ln;
                unsigned c[8];
#pragma unroll
                for (int j = 0; j < 4; ++j) { const unsigned wv = HR[j]; c[2 * j] = wv & 0xffffu; c[2 * j + 1] = wv >> 16; HR[j] = 0u; }
                unsigned ct = 0u;
#pragma unroll
                for (int j = 0; j < 8; ++j) ct += c[j];
                unsigned S = ct;
#pragma unroll
                for (int o = 1; o < 64; o <<= 1) { const unsigned y = (unsigned)__builtin_amdgcn_ds_bpermute((ln + o) << 2, (int)S); if (ln + o < 64) S += y; }
                if (S >= need && (S - ct) < need) {
                    unsigned rem = need - (S - ct), cum = 0u; int b = 0; unsigned cb = 0u;
                    bool found = false;
#pragma unroll
                    for (int j = 7; j >= 0; --j) { if (!found) { if (cum + c[j] >= rem) { b = j; cb = c[j]; found = true; } else cum += c[j]; } }
                    const unsigned need2 = rem - cum, binidx = 8u * ln + (unsigned)b;
                    const int bits = (lvl == 3) ? 5 : 9, shc = (lvl == 0) ? 23 : (lvl == 1 ? 14 : (lvl == 2 ? 5 : 0));
                    const unsigned npfx = (lvl == 0) ? binidx : ((pfx << bits) | binidx);
                    unsigned ninfo, nneed = need2, opfx = npfx;
                    if (need2 == cb) ninfo = (unsigned)lvl | 16u | ((unsigned)shc << 8);
                    else if (lvl == 0 && (binidx == 256u || binidx == 255u)) { ninfo = 16u | 32u; opfx = (binidx == 256u) ? 0x80000000u : 0x7fffffffu; }
                    else if (lvl == 3) ninfo = 16u | 32u;
                    else { ninfo = (unsigned)(lvl + 1); atomicAdd((unsigned*)MISC, 1u); }
                    QST[4 * qq] = opfx; QST[4 * qq + 1] = ninfo; QST[4 * qq + 2] = nneed;
                }
            }
            __syncthreads();
            if (MISC[0] == 0u) break;
            __syncthreads();
        }
        idx_pass<1>(C, KV, w4, ntiles, tq4, q, r, h);
        __syncthreads();
        int ln2 = lane; asm volatile("" : "+v"(ln2));
        for (int qq = 8 * wave; qq < 8 * wave + 8; ++qq) {
            if (!((QST[4 * qq + 1] >> 5) & 1)) continue;
            const unsigned mwd = (ln2 < 2 * ntiles) ? MASK[65 * qq + ln2] : 0u, twd = (ln2 < 2 * ntiles) ? TMASK[65 * qq + ln2] : 0u;
            int have = __popc(mwd);
#pragma unroll
            for (int o = 1; o < 64; o <<= 1) have += __builtin_amdgcn_ds_bpermute((ln2 ^ o) << 2, have);
            const int want = 256 - have, pc = __popc(twd);
            int incl = pc;
#pragma unroll
            for (int o = 1; o < 64; o <<= 1) { const int y = __builtin_amdgcn_ds_bpermute((ln2 - o) << 2, incl); if (ln2 >= o) incl += y; }
            int take = want - (incl - pc); take = take < 0 ? 0 : (take > pc ? pc : take);
            unsigned wrem = twd, add = 0u;
            for (int k = 0; k < take; ++k) { add |= wrem & (0u - wrem); wrem &= wrem - 1u; }
            if (add) MASK[65 * qq + ln2] = mwd | add;
        }
        __syncthreads();
    }
    const int hq = wave, kvh = wave >> 2;
    const unsigned ring = (unsigned)(size_t)(L + AT_RING);
    const float* LUT = nullptr; (void)LUT;
    const LAS float* lut = (const LAS float*)(L + AT_LUT) + 256 * hq;
    const float cfar = lut[0];
#define AT_DMA(tt, slot) do { const bf16_t* src_ = KV + (size_t)(64 * (tt)) * KVW; \
        _Pragma("unroll") for (int i_ = 0; i_ < 2; ++i_) { const int k_ = wave * 2 + i_, row_ = 4 * k_ + (lane >> 4), pc_ = lane & 15; \
            __builtin_amdgcn_global_load_lds((const unsigned*)(src_ + (size_t)row_ * KVW + 8 * (pc_ ^ (row_ & 15))), (LAS unsigned*)(L + AT_RING + (slot) * 32768 + k_ * 1024), 16, 0, 0); \
            __builtin_amdgcn_global_load_lds((const unsigned*)(src_ + (size_t)row_ * KVW + 128 + 8 * pc_), (LAS unsigned*)(L + AT_RING + (slot) * 32768 + 16384 + k_ * 1024), 16, 0, 0); } \
    } while (0)
    for (int qh = 0; qh < 2; ++qh) {
        const int q = 32 * qh + r, qrow = row0 + t0 + q;
        bf16x8 qf[4];
        { const bf16_t* qp = PJ + (size_t)qrow * PJW + C_Q + hq * 64 + 8 * h; float qv[4][8]; float ss = 0.f;
#pragma unroll
          for (int ks = 0; ks < 4; ++ks) { const u32x4 v = *(const u32x4*)(qp + 16 * ks);
              qv[ks][0] = __uint_as_float(v.x << 16); qv[ks][1] = __uint_as_float(v.x & 0xffff0000u); qv[ks][2] = __uint_as_float(v.y << 16); qv[ks][3] = __uint_as_float(v.y & 0xffff0000u);
              qv[ks][4] = __uint_as_float(v.z << 16); qv[ks][5] = __uint_as_float(v.z & 0xffff0000u); qv[ks][6] = __uint_as_float(v.w << 16); qv[ks][7] = __uint_as_float(v.w & 0xffff0000u);
#pragma unroll
              for (int j = 0; j < 8; ++j) ss += qv[ks][j] * qv[ks][j]; }
          ss = xor32_sum(ss);
          const float sc = rsqrtf(ss * (1.f / 64.f) + EPS) * (0.125f * 1.4426950408889634f);
          const float* qn = C.inp(18) + l * 64 + 8 * h;
#pragma unroll
          for (int ks = 0; ks < 4; ++ks) { const f32x4 n0 = *(const f32x4*)(qn + 16 * ks), n1 = *(const f32x4*)(qn + 16 * ks + 4);
              u32x4 p; p.x = cvt_pk_bf16(qv[ks][0] * sc * n0[0], qv[ks][1] * sc * n0[1]); p.y = cvt_pk_bf16(qv[ks][2] * sc * n0[2], qv[ks][3] * sc * n0[3]);
              p.z = cvt_pk_bf16(qv[ks][4] * sc * n1[0], qv[ks][5] * sc * n1[1]); p.w = cvt_pk_bf16(qv[ks][6] * sc * n1[2], qv[ks][7] * sc * n1[3]);
              qf[ks] = __builtin_bit_cast(bf16x8, p); } }
        f32x16 o0, o1;
#pragma unroll
        for (int i = 0; i < 16; ++i) { o0[i] = 0.f; o1[i] = 0.f; }
        float mrun = -1e30f, lrun = 0.f;
        AT_WAIT_V(0);
        AT_DMA(0, 0);
        for (int t = 0; t < ntiles; ++t) {
            const int slot = t & 1;
            if (t + 1 < ntiles) { AT_DMA(t + 1, slot ^ 1); AT_WAIT_V(4); } else { AT_WAIT_V(0); }
            AT_BAR();
            const LAS unsigned char* Kt = L + AT_RING + slot * 32768; const LAS unsigned char* Vt = Kt + 16384;
            f32x16 s0, s1;
#pragma unroll
            for (int i = 0; i < 16; ++i) { s0[i] = 0.f; s1[i] = 0.f; }
#pragma unroll
            for (int ks = 0; ks < 4; ++ks) {
                const int pc = kvh * 8 + 2 * ks + h;
                const bf16x8 k0 = *(const LAS bf16x8*)(Kt + r * 256 + ((pc ^ (r & 15)) << 4));
                const bf16x8 k1 = *(const LAS bf16x8*)(Kt + (32 + r) * 256 + ((pc ^ (r & 15)) << 4));
                s0 = MFMA32(k0, qf[ks], s0); s1 = MFMA32(k1, qf[ks], s1);
            }
            const unsigned m0 = MASK[65 * q + 2 * t] >> (4 * h), m1 = MASK[65 * q + 2 * t + 1] >> (4 * h);
            const bool nearb = (t + 3 > ntiles - 1);
            float tmax = -1e30f;
#pragma unroll
            for (int i = 0; i < 16; ++i) {
                const int kl = (i & 3) + 8 * (i >> 2);
                float b0 = cfar, b1 = cfar;
                if (nearb) { const int rel = 64 * t + kl + 4 * h - (pos0 + q); b0 = lut[rel + 191]; b1 = lut[rel + 32 + 191]; }
                s0[i] += b0; s1[i] += b1;
                if ((m0 >> kl) & 1u) tmax = fmaxf(tmax, s0[i]);
                if ((m1 >> kl) & 1u) tmax = fmaxf(tmax, s1[i]);
            }
            tmax = xor32_max(tmax);
            const float mnew = fmaxf(mrun, tmax), alpha = __builtin_amdgcn_exp2f(mrun - mnew);
            mrun = mnew;
            float psum = 0.f;
#pragma unroll
            for (int i = 0; i < 16; ++i) {
                const int kl = (i & 3) + 8 * (i >> 2);
                const float p0 = ((m0 >> kl) & 1u) ? __builtin_amdgcn_exp2f(s0[i] - mnew) : 0.f, p1 = ((m1 >> kl) & 1u) ? __builtin_amdgcn_exp2f(s1[i] - mnew) : 0.f;
                s0[i] = p0; s1[i] = p1; psum += p0 + p1;
            }
            lrun = lrun * alpha + psum;
#pragma unroll
            for (int i = 0; i < 16; ++i) { o0[i] *= alpha; o1[i] *= alpha; }
#pragma unroll
            for (int kk = 0; kk < 4; ++kk) {
                u32x4 pw;
                if (kk == 0) { pw.x = cvt_pk_bf16(s0[0], s0[1]); pw.y = cvt_pk_bf16(s0[2], s0[3]); pw.z = cvt_pk_bf16(s0[4], s0[5]); pw.w = cvt_pk_bf16(s0[6], s0[7]); }
                else if (kk == 1) { pw.x = cvt_pk_bf16(s0[8], s0[9]); pw.y = cvt_pk_bf16(s0[10], s0[11]); pw.z = cvt_pk_bf16(s0[12], s0[13]); pw.w = cvt_pk_bf16(s0[14], s0[15]); }
                else if (kk == 2) { pw.x = cvt_pk_bf16(s1[0], s1[1]); pw.y = cvt_pk_bf16(s1[2], s1[3]); pw.z = cvt_pk_bf16(s1[4], s1[5]); pw.w = cvt_pk_bf16(s1[6], s1[7]); }
                else { pw.x = cvt_pk_bf16(s1[8], s1[9]); pw.y = cvt_pk_bf16(s1[10], s1[11]); pw.z = cvt_pk_bf16(s1[12], s1[13]); pw.w = cvt_pk_bf16(s1[14], s1[15]); }
                const bf16x8 pb = __builtin_bit_cast(bf16x8, pw);
                const int i16 = lane & 15, key0 = 16 * kk + 4 * h + (i16 >> 2);
#pragma unroll
                for (int dh = 0; dh < 2; ++dh) {
                    const int dcol = kvh * 64 + 32 * dh + 16 * ((lane >> 4) & 1) + 4 * (i16 & 3);
                    const v4i16_t lo = __builtin_amdgcn_ds_read_tr16_b64_v4i16((LAS v4i16_t*)(Vt + key0 * 256 + dcol * 2));
                    const v4i16_t hi = __builtin_amdgcn_ds_read_tr16_b64_v4i16((LAS v4i16_t*)(Vt + (key0 + 8) * 256 + dcol * 2));
                    const bf16x8 va = (bf16x8){lo[0], lo[1], lo[2], lo[3], hi[0], hi[1], hi[2], hi[3]};
                    if (dh == 0) o0 = MFMA32(va, pb, o0); else o1 = MFMA32(va, pb, o1);
                }
            }
            AT_BAR();
        }
        lrun = xor32_sum(lrun);
        const float inv = 1.f / lrun;
        bf16_t* gp = PJ + (size_t)qrow * PJW + C_GA + hq * 64 + 4 * h;
#pragma unroll
        for (int dh = 0; dh < 2; ++dh)
#pragma unroll
            for (int gq = 0; gq < 4; ++gq) {
                const u32x2 gg = *(const u32x2*)(gp + 32 * dh + 8 * gq);
                const float g0 = __uint_as_float(gg.x << 16), g1 = __uint_as_float(gg.x & 0xffff0000u), g2 = __uint_as_float(gg.y << 16), g3 = __uint_as_float(gg.y & 0xffff0000u);
                const float a0 = (dh == 0 ? o0[4 * gq] : o1[4 * gq]) * inv, a1 = (dh == 0 ? o0[4 * gq + 1] : o1[4 * gq + 1]) * inv, a2 = (dh == 0 ? o0[4 * gq + 2] : o1[4 * gq + 2]) * inv, a3 = (dh == 0 ? o0[4 * gq + 3] : o1[4 * gq + 3]) * inv;
                u32x2 w; w.x = cvt_pk_bf16(a0 * fast_silu(g0), a1 * fast_silu(g1)); w.y = cvt_pk_bf16(a2 * fast_silu(g2), a3 * fast_silu(g3));
                *(u32x2*)(gp + 32 * dh + 8 * gq) = w;
            }
    }
#undef AT_DMA
    AT_WAIT_V(0);
    __syncthreads();
}

DI Ctx relaunder(const Ctx& C0) {
    Ctx C = C0; int ln; asm volatile("v_mbcnt_lo_u32_b32 %0, -1, 0\n\tv_mbcnt_hi_u32_b32 %0, -1, %0" : "=v"(ln)); C.lane = ln; C.tid = C.wave * 64 + ln;
    asm volatile("" : "+s"(C.ws), "+s"(C.out)); asm volatile("" : "+s"(C.G), "+s"(C.bid));
    return C;
}
DI void phase_mixers(const Ctx& Cin, int l) {
#if USE_SSD_OPT
    { const Ctx C = relaunder(Cin);
    for (int i = C.bid; i < 384; i += C.G) {
        const int sb = (i < 256) ? (i >> 4) : NPB + ((i - 256) >> 4), hd = i & 15;
        ssd_item(C, l, sb, hd);
    } }
    { const Ctx C = relaunder(Cin);
    for (int i = C.bid + C.G * C.wave; i < 192; i += C.G * NWAVES) {
        const int sb = (i < 128) ? (i >> 3) : NPB + ((i - 128) >> 3), sub = i & 7;
        lru_item_naive(C, l, sb, sub, C.lds + C.wave * 16384);
    } }
#else
    const Ctx C = Cin;
    for (int i = C.bid + C.G * C.wave; i < 1728; i += C.G * NWAVES) {
        int kind, sb, sub;
        if (i < 1024) { kind = 0; sb = i >> 6; sub = i & 63; }
        else if (i < 1152) { kind = 1; sb = (i - 1024) >> 3; sub = (i - 1024) & 7; }
        else if (i < 1664) { kind = 0; sb = NPB + ((i - 1152) >> 6); sub = (i - 1152) & 63; }
        else { kind = 1; sb = NPB + ((i - 1664) >> 3); sub = (i - 1664) & 7; }
        if (kind == 0) ssd_item_naive(C, l, sb, sub >> 2, sub & 3);
        else lru_item_naive(C, l, sb, sub, C.lds + C.wave * 16384);
    }
#endif
#if USE_ATTN_OPT
    __syncthreads();
    const Ctx C = relaunder(Cin);
    for (int i = C.bid; i < 520; i += C.G) {
        int sb, qb;
        if (i < 256) { sb = i & 15; qb = 31 - (i >> 4); } else if (i < 512) { sb = i & 15; qb = (i - 256) >> 4; } else { sb = NPB + (i - 512); qb = 0; }
        attn_item(C, l, sb, qb);
    }
#else
    const Ctx C = relaunder(Cin);
    LAS unsigned char* scr = C.lds + C.wave * 16384;
    const int gw = C.bid * NWAVES + C.wave, NGW = C.G * NWAVES;
    for (int m = gw; m < ROWS; m += NGW) attn_item_naive(C, l, m, scr);
#endif
}

constexpr int PH_PER_LAYER = 5;
constexpr int N_PHASES = 1 + 2 * PH_PER_LAYER;
__global__ void __launch_bounds__(NTHREADS, 2) mk_fwd(Args a) {
    extern __shared__ __attribute__((aligned(16))) unsigned char lds_raw[];
    Ctx C; C.out = a.out; C.ws = a.ws; C.lds = (LAS unsigned char*)lds_raw;
    C.tid = threadIdx.x; C.lane = C.tid & 63; C.wave = __builtin_amdgcn_readfirstlane(C.tid >> 6); C.G = gridDim.x; C.bid = blockIdx.x;
    if (C.tid == 0) {
#pragma unroll
        for (int i = 0; i < 28; ++i) ((LAS cfp_t*)(C.lds + LDS_BYTES - 256))[i] = a.in[i];
    }
    __syncthreads();
    const Ctx C0 = C;
#define LAUNDER() Ctx C = C0; { int ln; asm volatile("v_mbcnt_lo_u32_b32 %0, -1, 0\n\tv_mbcnt_hi_u32_b32 %0, -1, %0" : "=v"(ln)); C.lane = ln; C.tid = C.wave * 64 + ln; } \
        asm volatile("" : "+s"(C.ws), "+s"(C.out)); asm volatile("" : "+s"(C.G), "+s"(C.bid))
    for (int ph = a.ph_lo; ph < a.ph_hi; ++ph) {
        if (ph == 0) { LAUNDER(); phase_prologue(C); }
        else {
            const int l = (ph - 1) / PH_PER_LAYER, k = (ph - 1) % PH_PER_LAYER;
            if (k == 0) { LAUNDER(); if (USE_GEMM_IN) phase_inproj_gemm(C, l); else phase_inproj_simple(C, l); }
            else if (k == 1) { if (!USE_SSD_OPT) { LAUNDER(); phase_conv_naive(C, l); } }
            else if (k == 2) { LAUNDER(); phase_mixers(C, l); }
            else if (k == 3) { if (USE_GEMM_OUT) { LAUNDER(); phase_ycnorm(C, l); } }
            else { LAUNDER(); if (USE_GEMM_OUT) phase_outproj_gemm(C, l); else phase_outproj_simple(C, l); }
        }
#if MK_ONE_LAUNCH
        if (ph + 1 < a.ph_hi) cg::this_grid().sync();
#endif
    }
}

extern "C" void kernel_launch(void* const* d_in, const int* in_sizes, int n_in, void* d_out, int out_size, void* d_ws, size_t ws_size, hipStream_t stream) {
    static int grid = 0;
    if (grid == 0) {
        if (n_in != 28 || (size_t)out_size != O_END || ws_size < WS_END) { fprintf(stderr, "kernel_launch: unexpected shapes n_in %d out %d ws %zu\n", n_in, out_size, ws_size); grid = -1; return; }
        int dev = 0, cus = 0, per_cu = 0;
        hipGetDevice(&dev); hipDeviceGetAttribute(&cus, hipDeviceAttributeMultiprocessorCount, dev);
        hipFuncSetAttribute((const void*)mk_fwd, hipFuncAttributeMaxDynamicSharedMemorySize, LDS_BYTES);
        hipOccupancyMaxActiveBlocksPerMultiprocessor(&per_cu, (const void*)mk_fwd, NTHREADS, LDS_BYTES);
        if (per_cu < 1) per_cu = 1;
        grid = cus * 1;
        (void)hipGetLastError();
    }
    if (grid < 0) return;
    hipMemsetAsync((char*)d_ws + WS_CTL, 0, CTL_BYTES, stream);
    Args a{};
    for (int i = 0; i < 28; ++i) a.in[i] = (const float*)d_in[i];
    a.out = (float*)d_out; a.ws = (unsigned char*)d_ws;
#if MK_ONE_LAUNCH
    a.ph_lo = 0; a.ph_hi = N_PHASES;
    void* args[] = {&a};
    hipError_t e = hipLaunchCooperativeKernel((const void*)mk_fwd, dim3(grid), dim3(NTHREADS), args, LDS_BYTES, stream);
    if (e != hipSuccess) fprintf(stderr, "cooperative launch failed: %s (grid %d)\n", hipGetErrorString(e), grid);
#else
    for (int ph = 0; ph < N_PHASES; ++ph) { a.ph_lo = ph; a.ph_hi = ph + 1; hipLaunchKernelGGL(mk_fwd, dim3(grid), dim3(NTHREADS), LDS_BYTES, stream, a); }
#endif
}
```

```cpp
#include <hip/hip_runtime.h>
#include <hip/hip_cooperative_groups.h>
#include <cstdio>
#include <cstdint>
namespace cg = cooperative_groups;

#ifndef ONLY
#define ONLY 0xffff
#endif
#ifndef USE_LRU_OPT
#define USE_LRU_OPT 1
#endif
#ifndef USE_ATTN_OPT
#define USE_ATTN_OPT 1
#endif
#ifndef USE_SSD_OPT
#define USE_SSD_OPT 1
#endif
#ifndef USE_GEMM_IN
#define USE_GEMM_IN 1
#endif
#ifndef USE_GEMM_OUT
#define USE_GEMM_OUT 1
#endif
#ifndef MK_ONE_LAUNCH
#define MK_ONE_LAUNCH 1
#endif

typedef unsigned short bf16_t;
typedef short bf16x8 __attribute__((ext_vector_type(8)));
typedef float f32x4 __attribute__((ext_vector_type(4)));
typedef float f32x16 __attribute__((ext_vector_type(16)));
typedef unsigned u32x4 __attribute__((ext_vector_type(4)));
typedef unsigned u32x2 __attribute__((ext_vector_type(2)));
#define LAS __attribute__((address_space(3)))
#define DI __device__ __forceinline__

constexpr int DM = 1024, NPB = 16, SEQ = 2048, NSB_S = 8, DSEQ = 64, PAST = 1024;
constexpr int ROWS_P = NPB * SEQ;
constexpr int ROWS = ROWS_P + NSB_S * DSEQ;
constexpr int NSB = NPB + NSB_S;
constexpr int DINP = 5204, NPAD = 5376;
constexpr int PJW = 4864;
constexpr int DMIX = 2048;
constexpr float EPS = 1e-6f;
constexpr int C_GL = 0, C_GA = 512, C_Z = 1024, C_XL = 2048, C_Q = 2560, C_QI = 3072, C_XBC = 3328, C_T19 = 4864, C_T20 = 5120;
constexpr int KVW = 320;
constexpr size_t KVB_LAYER = (size_t)NPB * SEQ * KVW + (size_t)NSB_S * (PAST + DSEQ) * KVW;

constexpr size_t O_YP = 0;
constexpr size_t O_YS = O_YP + (size_t)NPB * SEQ * DM;
constexpr size_t O_AKP = O_YS + (size_t)NSB_S * DSEQ * DM;
constexpr size_t O_AVP = O_AKP + (size_t)2 * NPB * SEQ * 128;
constexpr size_t O_IKP = O_AVP + (size_t)2 * NPB * SEQ * 128;
constexpr size_t O_LCP = O_IKP + (size_t)2 * NPB * SEQ * 64;
constexpr size_t O_LHP = O_LCP + (size_t)2 * NPB * 3 * 512;
constexpr size_t O_SCP = O_LHP + (size_t)2 * NPB * 512;
constexpr size_t O_SHP = O_SCP + (size_t)2 * NPB * 3 * 1536;
constexpr size_t O_AKS = O_SHP + (size_t)2 * NPB * 16 * 64 * 128;
constexpr size_t O_AVS = O_AKS + (size_t)2 * NSB_S * DSEQ * 128;
constexpr size_t O_IKS = O_AVS + (size_t)2 * NSB_S * DSEQ * 128;
constexpr size_t O_LCS = O_IKS + (size_t)2 * NSB_S * DSEQ * 64;
constexpr size_t O_LHS = O_LCS + (size_t)2 * NSB_S * 3 * 512;
constexpr size_t O_SCS = O_LHS + (size_t)2 * NSB_S * 512;
constexpr size_t O_SHS = O_SCS + (size_t)2 * NSB_S * 3 * 1536;
constexpr size_t O_END = O_SHS + (size_t)2 * NSB_S * 16 * 64 * 128;

constexpr size_t MiB = 1u << 20;
constexpr size_t WS_CTL = 0, CTL_BYTES = 1 * MiB;
constexpr size_t WS_WIN = 1 * MiB;
constexpr size_t WIN_LAYER = (size_t)NPAD * DM;
constexpr size_t WS_WOUT = 22 * MiB;
constexpr size_t WOUT_LAYER = (size_t)DM * DMIX;
constexpr size_t WS_HB = 30 * MiB;
constexpr size_t WS_RSS = 95 * MiB;
constexpr size_t WS_WI = 98 * MiB;
constexpr size_t WS_DTR = 99 * MiB;
constexpr size_t WS_SSQ = 102 * MiB;
constexpr size_t WS_KVB = 112 * MiB;
constexpr size_t WS_PROJ = 164 * MiB;
constexpr size_t WS_END = WS_PROJ + (size_t)ROWS * PJW * 2;
static_assert(WS_KVB + 2 * KVB_LAYER * 2 <= WS_PROJ, "ws map");
static_assert(WS_END <= 512 * MiB, "ws map");

constexpr int NTHREADS = 512, NWAVES = 8;
constexpr int LDS_BYTES = 163840;

DI float bf2f(bf16_t v) { return __uint_as_float(((unsigned)v) << 16); }
DI bf16_t f2bf(float f) { unsigned u = __float_as_uint(f); return (bf16_t)((u + 0x7fffu + ((u >> 16) & 1u)) >> 16); }
DI unsigned pk2(float lo, float hi) { return (unsigned)f2bf(lo) | ((unsigned)f2bf(hi) << 16); }
DI int crow(int reg, int h) { return (reg & 3) + 8 * (reg >> 2) + 4 * h; }
template <int O> DI float swz_xor(float v) { return __int_as_float(__builtin_amdgcn_ds_swizzle(__float_as_int(v), (O << 10) | 0x1f)); }
DI float xor32_sum(float v) { auto rr = __builtin_amdgcn_permlane32_swap(__float_as_uint(v), __float_as_uint(v), false, false); return __uint_as_float(rr[0]) + __uint_as_float(rr[1]); }
DI float xor32_max(float v) { auto rr = __builtin_amdgcn_permlane32_swap(__float_as_uint(v), __float_as_uint(v), false, false); return fmaxf(__uint_as_float(rr[0]), __uint_as_float(rr[1])); }
DI float half_sum32(float v) {
    v += swz_xor<1>(v); v += swz_xor<2>(v); v += swz_xor<4>(v); v += swz_xor<8>(v); v += swz_xor<16>(v); return v;
}
DI float wave_sum(float v) { return xor32_sum(half_sum32(v)); }
DI float wave_max(float v) {
    v = fmaxf(v, swz_xor<1>(v)); v = fmaxf(v, swz_xor<2>(v)); v = fmaxf(v, swz_xor<4>(v)); v = fmaxf(v, swz_xor<8>(v)); v = fmaxf(v, swz_xor<16>(v)); return xor32_max(v);
}
DI float sum_fq(float v) { return xor32_sum(v + swz_xor<16>(v)); }
DI float bperm(float v, int srclane) { return __int_as_float(__builtin_amdgcn_ds_bpermute(srclane << 2, __float_as_int(v))); }
DI float silu_f(float x) { return x / (1.f + expf(-x)); }
DI float sigmoid_f(float x) { return 1.f / (1.f + expf(-x)); }
DI float softplus_f(float x) { return x > 20.f ? x : log1pf(expf(x)); }
#define LDS_FENCE() asm volatile("s_waitcnt lgkmcnt(0)" ::: "memory")

__host__ __device__ inline int orig_col(int c) {
    if (c < 512) return 512 + c;
    if (c < 1024) return 1792 + (c - 512);
    if (c < 2048) return 2628 + (c - 1024);
    if (c < 2560) return c - 2048;
    if (c < 3072) return 1024 + (c - 2560);
    if (c < 3328) return 2304 + (c - 3072);
    if (c < 4864) return 3652 + (c - 3328);
    if (c < 5120) { const int cl = c - 4864, bj = cl >> 7, wc = (cl >> 5) & 3, j = cl & 31, d = 32 * bj + j; return (wc < 2 ? 1536 : 1664) + (wc & 1) * 64 + d; }
    const int cl = c - 5120;
    if (cl < 64) return 2560 + cl;
    if (cl < 68) return 2624 + (cl - 64);
    if (cl < 84) return 5188 + (cl - 68);
    return -1;
}
DI int sb_T(int sb) { return sb < NPB ? SEQ : DSEQ; }
DI int sb_P(int sb) { return sb < NPB ? 0 : PAST; }
DI int sb_row0(int sb) { return sb < NPB ? sb * SEQ : ROWS_P + (sb - NPB) * DSEQ; }
DI size_t kvb_off(int sb) { return sb < NPB ? (size_t)sb * SEQ * KVW : (size_t)NPB * SEQ * KVW + (size_t)(sb - NPB) * (PAST + DSEQ) * KVW; }
DI void row_sbt(int m, int& sb, int& t) { if (m < ROWS_P) { sb = m >> 11; t = m & 2047; } else { const int r = m - ROWS_P; sb = NPB + (r >> 6); t = r & 63; } }

typedef const float* cfp_t;
struct Args { const float* in[28]; float* out; unsigned char* ws; int ph_lo, ph_hi; };

struct Ctx {
    float* out; unsigned char* ws;
    LAS unsigned char* lds;
    DI const float* inp(int k) const { return ((LAS cfp_t*)(lds + LDS_BYTES - 256))[k]; }
    int tid, lane, wave, G, bid;
    DI bf16_t* win(int l) const { return (bf16_t*)(ws + WS_WIN) + (size_t)l * WIN_LAYER; }
    DI bf16_t* wout(int l) const { return (bf16_t*)(ws + WS_WOUT) + (size_t)l * WOUT_LAYER; }
    DI bf16_t* hb() const { return (bf16_t*)(ws + WS_HB); }
    DI float* rss() const { return (float*)(ws + WS_RSS); }
    DI float* wi() const { return (float*)(ws + WS_WI); }
    DI float* dtr() const { return (float*)(ws + WS_DTR); }
    DI float* ssq() const { return (float*)(ws + WS_SSQ); }
    DI bf16_t* kvb(int l) const { return (bf16_t*)(ws + WS_KVB) + (size_t)l * KVB_LAYER; }
    DI bf16_t* proj() const { return (bf16_t*)(ws + WS_PROJ); }
};
DI float* out_ak(const Ctx& C, int l, int sb) { return sb < NPB ? C.out + O_AKP + ((size_t)(l * NPB + sb) * SEQ) * 128 : C.out + O_AKS + ((size_t)(l * NSB_S + sb - NPB) * DSEQ) * 128; }
DI float* out_av(const Ctx& C, int l, int sb) { return sb < NPB ? C.out + O_AVP + ((size_t)(l * NPB + sb) * SEQ) * 128 : C.out + O_AVS + ((size_t)(l * NSB_S + sb - NPB) * DSEQ) * 128; }
DI float* out_ik(const Ctx& C, int l, int sb) { return sb < NPB ? C.out + O_IKP + ((size_t)(l * NPB + sb) * SEQ) * 64 : C.out + O_IKS + ((size_t)(l * NSB_S + sb - NPB) * DSEQ) * 64; }
DI float* out_lc(const Ctx& C, int l, int sb) { return sb < NPB ? C.out + O_LCP + (size_t)(l * NPB + sb) * 3 * 512 : C.out + O_LCS + (size_t)(l * NSB_S + sb - NPB) * 3 * 512; }
DI float* out_lh(const Ctx& C, int l, int sb) { return sb < NPB ? C.out + O_LHP + (size_t)(l * NPB + sb) * 512 : C.out + O_LHS + (size_t)(l * NSB_S + sb - NPB) * 512; }
DI float* out_sc(const Ctx& C, int l, int sb) { return sb < NPB ? C.out + O_SCP + (size_t)(l * NPB + sb) * 3 * 1536 : C.out + O_SCS + (size_t)(l * NSB_S + sb - NPB) * 3 * 1536; }
DI float* out_sh(const Ctx& C, int l, int sb) { return sb < NPB ? C.out + O_SHP + (size_t)(l * NPB + sb) * 16 * 64 * 128 : C.out + O_SHS + (size_t)(l * NSB_S + sb - NPB) * 16 * 64 * 128; }

namespace pg8 {
#define PG8_LAS __attribute__((address_space(3)))
constexpr int BM = 256, BK = 64, HALF = 128, HTB = HALF * BK * 2  , STAGE_BYTES = 8 * HTB, NXCD = 8, WGM = 8;

__host__ __device__ __forceinline__ int lds_byte(int r, int c) { const int st = (r >> 4) * 2 + (c >> 5), rr = r & 15, cc = c & 31, ob = rr * 64 + cc * 2; return st * 1024 + (ob ^ (((ob >> 9) & 1) << 5)); }
__host__ __device__ __forceinline__ void stage_rc(int b, int& R, int& C) { const int st = b / 1024, sb = b % 1024, swz = sb ^ (((sb >> 9) & 1) << 5); R = (st >> 1) * 16 + swz / 64; C = (st & 1) * 32 + (swz % 64) / 2; }
__host__ __device__ __forceinline__ int perm32(int rho) { const int n = rho >> 4, i = rho & 15; return 8 * (i >> 2) + 4 * n + (i & 3); }

struct Unit { int pm, pn; };
struct Gemm { const bf16_t* A; const bf16_t* Bt; int M, N, K, lda; };

struct StaticOrder {
    int nM, nN, nwg, G, c;
    __host__ __device__ void init(int M, int N, int G_, int c_) { nM = M / BM; nN = N / BM; nwg = nM * nN; G = G_; c = c_; }
    __host__ __device__ bool next(int i, Unit& u) const {
        const long L = (long)i * G + c; if (L >= nwg) return false;
        int wgid = (int)L; { const int q = nwg / NXCD, r = nwg % NXCD, xcd = wgid % NXCD, off = wgid / NXCD; wgid = (xcd < r ? xcd * (q + 1) : r * (q + 1) + (xcd - r) * q) + off; }
        const int nig = WGM * nN, gid = wgid / nig, fm = gid * WGM, gsz = (nM - fm) < WGM ? (nM - fm) : WGM;
        u.pm = fm + ((wgid % nig) % gsz); u.pn = (wgid % nig) / gsz; return true;
    }
    __device__ __forceinline__ void a_ready(const Unit&) const {}
    __device__ __forceinline__ void done(const Unit&) const {}
};

template <class Epi, class Sched, bool ALIGN_EPI = false, bool SP2 = false>
__device__ __forceinline__ void gemm_phase(PG8_LAS unsigned char* lds, const Gemm g, const Sched& S, const Epi& E, const int tid) {
    const int wid = __builtin_amdgcn_readfirstlane(tid >> 6), lane = tid & 63, wr = wid >> 2, wc = wid & 3, fr = lane & 15, fq = lane >> 4;
    const int K = g.K, nt = K / BK;
    unsigned voffA[2], voffB[2];
#pragma unroll
    for (int i = 0; i < 2; ++i) { int R, C; stage_rc(tid * 16 + i * 8192, R, C); const int Rb = Epi::PERM ? ((R & ~31) + perm32(R & 31)) : R;
        voffA[i] = (unsigned)(R * g.lda + C) * 2u; voffB[i] = (unsigned)(Rb * K + C) * 2u; }
    const size_t kstep = (size_t)(BK * 2);
    const size_t hstepA = (size_t)HALF * g.lda * 2, hstepB = (size_t)HALF * K * 2;
    const size_t tstepA = 2 * hstepA, tstepB = 2 * hstepB;
    const unsigned ldsw = (unsigned)wid * 1024u;
    const int aoff = lds_byte(wr * 64 + fr, fq * 8), boff = lds_byte(wc * 32 + fr, fq * 8);
#define PG8_SA(b, h) (((b) * 2 + (h)) * HTB)
#define PG8_SB(b, h) ((4 + (b) * 2 + (h)) * HTB)
#define PG8_STAGE(bufoff, gbase, voff) do { _Pragma("unroll") for (int _i = 0; _i < 2; ++_i) \
        __builtin_amdgcn_global_load_lds((const unsigned*)((const char*)(gbase) + (voff)[_i]), (PG8_LAS unsigned*)(lds + (bufoff) + ldsw + _i * 8192), 16, 0, 0); } while (0)
#define PG8_LDA(dst, b, h) do { _Pragma("unroll") for (int m = 0; m < 4; ++m) _Pragma("unroll") for (int k = 0; k < 2; ++k) dst[m][k] = *(const PG8_LAS bf16x8*)(lds + PG8_SA(b, h) + aoff + m * 2048 + k * 1024); } while (0)
#define PG8_LDB(dst, b, h) do { _Pragma("unroll") for (int n = 0; n < 2; ++n) _Pragma("unroll") for (int k = 0; k < 2; ++k) dst[n][k] = *(const PG8_LAS bf16x8*)(lds + PG8_SB(b, h) + boff + n * 2048 + k * 1024); } while (0)
#define PG8_MMA(ai, bj, At, Bt) do { __builtin_amdgcn_s_setprio(1); _Pragma("unroll") for (int m = 0; m < 4; ++m) _Pragma("unroll") for (int n = 0; n < 2; ++n) _Pragma("unroll") for (int k = 0; k < 2; ++k) \
        acc[ai][bj][m][n] = __builtin_amdgcn_mfma_f32_16x16x32_bf16(Bt[n][k], At[m][k], acc[ai][bj][m][n], 0, 0, 0); __builtin_amdgcn_s_setprio(0); } while (0)
#define PG8_WAIT_V(n) asm volatile("s_waitcnt vmcnt(" #n ")" ::: "memory")
#define PG8_WAIT_L(n) asm volatile("s_waitcnt lgkmcnt(" #n ")" ::: "memory")
#define PG8_BAR __builtin_amdgcn_s_barrier()
#define PG8_SCHED __builtin_amdgcn_sched_barrier(0)
    Unit cur, nxt; int ui = 0;
    if (!S.next(0, cur)) return;
    f32x4 acc[2][2][4][2];
#pragma unroll
    for (int a = 0; a < 2; ++a)
#pragma unroll
        for (int b = 0; b < 2; ++b)
#pragma unroll
            for (int m = 0; m < 4; ++m)
#pragma unroll
                for (int n = 0; n < 2; ++n) acc[a][b][m][n] = (f32x4){0.f, 0.f, 0.f, 0.f};
    bf16x8 At[4][2], B0[2][2], B1[2][2];
    const char* cA = (const char*)g.A + (size_t)cur.pm * tstepA; const char* cB = (const char*)g.Bt + (size_t)cur.pn * tstepB;
    S.a_ready(cur);
    if constexpr (SP2) {
        PG8_STAGE(PG8_SB(0, 0), cB, voffB); PG8_STAGE(PG8_SB(0, 1), cB + hstepB, voffB); PG8_STAGE(PG8_SA(0, 0), cA, voffA); PG8_STAGE(PG8_SA(0, 1), cA + hstepA, voffA);
        if (wr == 1) PG8_BAR;
        PG8_WAIT_V(2); PG8_BAR;
        PG8_STAGE(PG8_SB(1, 0), cB + kstep, voffB); PG8_STAGE(PG8_SA(1, 0), cA + kstep, voffA); PG8_STAGE(PG8_SB(1, 1), cB + hstepB + kstep, voffB);
        PG8_WAIT_V(6); PG8_BAR;
    } else {
        PG8_STAGE(PG8_SB(0, 0), cB, voffB); PG8_STAGE(PG8_SA(0, 0), cA, voffA); PG8_STAGE(PG8_SB(0, 1), cB + hstepB, voffB); PG8_STAGE(PG8_SA(0, 1), cA + hstepA, voffA);
        if (wr == 1) PG8_BAR;
        PG8_WAIT_V(4); PG8_BAR;
        PG8_STAGE(PG8_SB(1, 0), cB + kstep, voffB); PG8_STAGE(PG8_SA(1, 0), cA + kstep, voffA); PG8_STAGE(PG8_SB(1, 1), cB + hstepB + kstep, voffB);
        PG8_WAIT_V(6); PG8_BAR;
    }
    for (;;) {
        const bool has_next = S.next(ui + 1, nxt);
        const char* nA = has_next ? (const char*)g.A + (size_t)nxt.pm * tstepA : cA; const char* nB = has_next ? (const char*)g.Bt + (size_t)nxt.pn * tstepB : cB;
        for (int t = 0; t < nt; t += 2) {
            const bool last = (t == nt - 2);
            const char* a1 = cA + (size_t)(t + 1) * kstep;
            const char* a2 = last ? nA : cA + (size_t)(t + 2) * kstep; const char* b2 = last ? nB : cB + (size_t)(t + 2) * kstep;
            const char* a3 = a2 + kstep; const char* b3 = b2 + kstep;
            if (last && has_next) S.a_ready(nxt);
            if constexpr (SP2) {
            PG8_LDB(B0, 0, 0); PG8_LDB(B1, 0, 1); PG8_SCHED; PG8_LDA(At, 0, 0); PG8_STAGE(PG8_SA(1, 1), a1 + hstepA, voffA);
            PG8_WAIT_V(8); PG8_WAIT_L(0); PG8_BAR; PG8_MMA(0, 0, At, B0); PG8_MMA(0, 1, At, B1); PG8_BAR; PG8_SCHED;
            PG8_LDA(At, 0, 1); PG8_STAGE(PG8_SB(0, 0), b2, voffB); PG8_STAGE(PG8_SB(0, 1), b2 + hstepB, voffB); PG8_STAGE(PG8_SA(0, 0), a2, voffA);
            PG8_WAIT_V(8); PG8_WAIT_L(0); PG8_BAR; PG8_MMA(1, 0, At, B0); PG8_MMA(1, 1, At, B1); PG8_BAR; PG8_SCHED;
            PG8_LDB(B0, 1, 0); PG8_LDB(B1, 1, 1); PG8_SCHED; PG8_LDA(At, 1, 0); PG8_STAGE(PG8_SA(0, 1), a2 + hstepA, voffA);
            PG8_WAIT_V(8); PG8_WAIT_L(0); PG8_BAR; PG8_MMA(0, 0, At, B0); PG8_MMA(0, 1, At, B1); PG8_BAR; PG8_SCHED;
            PG8_LDA(At, 1, 1); PG8_STAGE(PG8_SB(1, 0), b3, voffB); PG8_STAGE(PG8_SB(1, 1), b3 + hstepB, voffB); PG8_STAGE(PG8_SA(1, 0), a3, voffA);
            PG8_WAIT_V(8); PG8_WAIT_L(0); PG8_BAR; PG8_MMA(1, 0, At, B0); PG8_MMA(1, 1, At, B1); PG8_BAR; PG8_SCHED;
            } else {
            PG8_LDB(B0, 0, 0); PG8_SCHED; PG8_LDA(At, 0, 0); PG8_STAGE(PG8_SA(1, 1), a1 + hstepA, voffA);
            PG8_WAIT_L(8); PG8_BAR; PG8_WAIT_L(0); PG8_MMA(0, 0, At, B0); PG8_BAR; PG8_SCHED;
            PG8_LDB(B1, 0, 1); PG8_STAGE(PG8_SB(0, 0), b2, voffB);
            PG8_BAR; PG8_WAIT_L(0); PG8_MMA(0, 1, At, B1); PG8_BAR;
            PG8_LDA(At, 0, 1); PG8_STAGE(PG8_SA(0, 0), a2, voffA);
            PG8_BAR; PG8_WAIT_L(0); PG8_MMA(1, 0, At, B0); PG8_BAR; PG8_SCHED;
            PG8_STAGE(PG8_SB(0, 1), b2 + hstepB, voffB);
            PG8_WAIT_V(6); PG8_BAR; PG8_MMA(1, 1, At, B1); PG8_BAR;
            PG8_LDB(B0, 1, 0); PG8_SCHED; PG8_LDA(At, 1, 0); PG8_STAGE(PG8_SA(0, 1), a2 + hstepA, voffA);
            PG8_WAIT_L(8); PG8_BAR; PG8_WAIT_L(0); PG8_MMA(0, 0, At, B0); PG8_BAR; PG8_SCHED;
            PG8_LDB(B1, 1, 1); PG8_STAGE(PG8_SB(1, 0), b3, voffB);
            PG8_BAR; PG8_WAIT_L(0); PG8_MMA(0, 1, At, B1); PG8_BAR;
            PG8_LDA(At, 1, 1); PG8_STAGE(PG8_SA(1, 0), a3, voffA);
            PG8_BAR; PG8_WAIT_L(0); PG8_MMA(1, 0, At, B0); PG8_BAR; PG8_SCHED;
            PG8_STAGE(PG8_SB(1, 1), b3 + hstepB, voffB);
            PG8_WAIT_V(6); PG8_BAR; PG8_MMA(1, 1, At, B1); PG8_BAR;
            }
        }
        if constexpr (ALIGN_EPI) { if (wr == 0) PG8_BAR; }
        if constexpr (!Epi::AFTER_DRAIN) { E(acc, cur, wr, wc, fr, fq); S.done(cur); }
        if (!has_next) break;
#pragma unroll
        for (int a = 0; a < 2; ++a)
#pragma unroll
            for (int b = 0; b < 2; ++b)
#pragma unroll
                for (int m = 0; m < 4; ++m)
#pragma unroll
                    for (int n = 0; n < 2; ++n) acc[a][b][m][n] = (f32x4){0.f, 0.f, 0.f, 0.f};
        cur = nxt; cA = nA; cB = nB; ++ui;
        if constexpr (ALIGN_EPI) { if (wr == 1) PG8_BAR; }
    }
    PG8_WAIT_V(0);
    if constexpr (!ALIGN_EPI) { if (wr == 0) PG8_BAR; }
    PG8_BAR;
    if constexpr (Epi::AFTER_DRAIN) { E.fused(acc, cur, wr, wc, fr, fq, lds, wid, lane); S.done(cur); }
#undef PG8_SA
#undef PG8_SB
#undef PG8_STAGE
#undef PG8_LDA
#undef PG8_LDB
#undef PG8_MMA
#undef PG8_WAIT_V
#undef PG8_WAIT_L
#undef PG8_BAR
#undef PG8_SCHED
}
}

typedef float f32x2_t __attribute__((ext_vector_type(2))); typedef __bf16 bf16x2_t __attribute__((ext_vector_type(2)));
DI unsigned cvt_pk_bf16(float lo, float hi) { const f32x2_t v = {lo, hi}; const bf16x2_t b = __builtin_convertvector(v, bf16x2_t); return __builtin_bit_cast(unsigned, b); }
DI u32x4 pack8(const f32x4 a, const f32x4 b) { u32x4 w; w.x = cvt_pk_bf16(a[0], a[1]); w.y = cvt_pk_bf16(a[2], a[3]); w.z = cvt_pk_bf16(b[0], b[1]); w.w = cvt_pk_bf16(b[2], b[3]); return w; }
struct EpiIn {
    static constexpr bool PERM = true, AFTER_DRAIN = false;
    Ctx C; int l;
    DI void operator()(const f32x4 (&acc)[2][2][4][2], const pg8::Unit& u, int wr, int wc, int fr, int fq) const {
        const int row0 = u.pm * 256 + wr * 64 + fr;
        float rs[2][4];
#pragma unroll
        for (int ai = 0; ai < 2; ++ai)
#pragma unroll
            for (int m = 0; m < 4; ++m) {
                const f32x4 p = *(const f32x4*)(C.rss() + (size_t)(row0 + ai * 128 + m * 16) * 16 + 4 * fq);
                float s = sum_fq((p[0] + p[1]) + (p[2] + p[3]));
                rs[ai][m] = rsqrtf(s * (1.f / DM) + EPS);
            }
        if (u.pn < 19) {
            bf16_t* base = C.proj() + (size_t)row0 * PJW + u.pn * 256 + wc * 32 + 8 * fq;
#pragma unroll
            for (int ai = 0; ai < 2; ++ai)
#pragma unroll
                for (int m = 0; m < 4; ++m) {
                    bf16_t* rowp = base + (size_t)(ai * 128 + m * 16) * PJW; const float sc = rs[ai][m];
#pragma unroll
                    for (int bj = 0; bj < 2; ++bj) *(u32x4*)(rowp + bj * 128) = pack8(acc[ai][bj][m][0] * sc, acc[ai][bj][m][1] * sc);
                }
        } else if (u.pn == 19) {
            if (wc < 2) {
                const float* kw = C.inp(19) + l * 64 + 8 * fq;
                const f32x4 k00 = *(const f32x4*)(kw), k01 = *(const f32x4*)(kw + 4), k10 = *(const f32x4*)(kw + 32), k11 = *(const f32x4*)(kw + 36);
#pragma unroll
                for (int ai = 0; ai < 2; ++ai)
#pragma unroll
                    for (int m = 0; m < 4; ++m) {
                        const int row = row0 + ai * 128 + m * 16; int sb, t; row_sbt(row, sb, t);
                        const float sc = rs[ai][m];
                        f32x4 a0 = acc[ai][0][m][0] * sc, a1 = acc[ai][0][m][1] * sc, b0 = acc[ai][1][m][0] * sc, b1 = acc[ai][1][m][1] * sc;
                        float ss = 0.f;
#pragma unroll
                        for (int i = 0; i < 4; ++i) ss += (a0[i] * a0[i] + a1[i] * a1[i]) + (b0[i] * b0[i] + b1[i] * b1[i]);
                        ss = sum_fq(ss);
                        const float rn = rsqrtf(ss * (1.f / 64.f) + EPS);
                        a0 = a0 * rn * k00; a1 = a1 * rn * k01; b0 = b0 * rn * k10; b1 = b1 * rn * k11;
                        float* o = out_ak(C, l, sb) + (size_t)t * 128 + wc * 64 + 8 * fq;
                        *(f32x4*)(o) = a0; *(f32x4*)(o + 4) = a1; *(f32x4*)(o + 32) = b0; *(f32x4*)(o + 36) = b1;
                        bf16_t* kv = C.kvb(l) + kvb_off(sb) + (size_t)(sb_P(sb) + t) * KVW + wc * 64 + 8 * fq;
                        *(u32x4*)(kv) = pack8(a0, a1); *(u32x4*)(kv + 32) = pack8(b0, b1);
                    }
            } else {
                const int kvh = wc - 2;
#pragma unroll
                for (int ai = 0; ai < 2; ++ai)
#pragma unroll
                    for (int m = 0; m < 4; ++m) {
                        const int row = row0 + ai * 128 + m * 16; int sb, t; row_sbt(row, sb, t);
                        const float sc = rs[ai][m];
                        const f32x4 a0 = acc[ai][0][m][0] * sc, a1 = acc[ai][0][m][1] * sc, b0 = acc[ai][1][m][0] * sc, b1 = acc[ai][1][m][1] * sc;
                        float* o = out_av(C, l, sb) + (size_t)t * 128 + kvh * 64 + 8 * fq;
                        *(f32x4*)(o) = a0; *(f32x4*)(o + 4) = a1; *(f32x4*)(o + 32) = b0; *(f32x4*)(o + 36) = b1;
                        bf16_t* kv = C.kvb(l) + kvb_off(sb) + (size_t)(sb_P(sb) + t) * KVW + 128 + kvh * 64 + 8 * fq;
                        *(u32x4*)(kv) = pack8(a0, a1); *(u32x4*)(kv + 32) = pack8(b0, b1);
                    }
            }
        } else {
#pragma unroll
            for (int ai = 0; ai < 2; ++ai)
#pragma unroll
                for (int m = 0; m < 4; ++m) {
                    const int row = row0 + ai * 128 + m * 16; int sb, t; row_sbt(row, sb, t);
                    const float sc = rs[ai][m];
                    const f32x4 a0 = acc[ai][0][m][0] * sc, a1 = acc[ai][0][m][1] * sc;
                    if (wc < 2) {
                        const int d = 32 * wc + 8 * fq;
                        float* o = out_ik(C, l, sb) + (size_t)t * 64 + d;
                        *(f32x4*)(o) = a0; *(f32x4*)(o + 4) = a1;
                        *(u32x4*)(C.kvb(l) + kvb_off(sb) + (size_t)(sb_P(sb) + t) * KVW + 256 + d) = pack8(a0, a1);
                    } else if (wc == 2) {
                        if (fq == 0) { *(f32x4*)(C.wi() + (size_t)row * 4) = a0; *(f32x4*)(C.dtr() + (size_t)row * 16) = a1; }
                        else if (fq == 1) { *(f32x4*)(C.dtr() + (size_t)row * 16 + 4) = a0; *(f32x4*)(C.dtr() + (size_t)row * 16 + 8) = a1; }
                        else if (fq == 2) { *(f32x4*)(C.dtr() + (size_t)row * 16 + 12) = a0; }
                    }
                }
        }
    }
};
struct EpiOut {
    static constexpr bool PERM = false, AFTER_DRAIN = false;
    Ctx C; int l;
    DI void operator()(const f32x4 (&acc)[2][2][4][2], const pg8::Unit& u, int wr, int wc, int fr, int fq) const {
        const int row0 = u.pm * 256 + wr * 64 + fr, col0 = u.pn * 256 + wc * 32 + 4 * fq;
#pragma unroll
        for (int ai = 0; ai < 2; ++ai)
#pragma unroll
            for (int m = 0; m < 4; ++m) {
                const int row = row0 + ai * 128 + m * 16;
                const float* xres = (l == 0) ? ((row < ROWS_P) ? C.inp(0) + (size_t)row * DM : C.inp(1) + (size_t)(row - ROWS_P) * DM) : C.out + (size_t)row * DM;
                float ss = 0.f;
#pragma unroll
                for (int bj = 0; bj < 2; ++bj)
#pragma unroll
                    for (int n = 0; n < 2; ++n) {
                        const int col = col0 + bj * 128 + n * 16;
                        const f32x4 v = *(const f32x4*)(xres + col) + acc[ai][bj][m][n];
                        *(f32x4*)(C.out + (size_t)row * DM + col) = v;
                        if (l == 0) {
                            u32x2 w; w.x = cvt_pk_bf16(v[0], v[1]); w.y = cvt_pk_bf16(v[2], v[3]);
                            *(u32x2*)(C.hb() + (size_t)row * DM + col) = w;
                            ss += (v[0] * v[0] + v[1] * v[1]) + (v[2] * v[2] + v[3] * v[3]);
                        }
                    }
                if (l == 0) {
                    ss = sum_fq(ss);
                    if (fq == 0) C.rss()[(size_t)row * 16 + u.pn * 4 + wc] = ss;
                }
            }
    }
};
DI void phase_inproj_gemm(const Ctx& C, int l) {
    pg8::Gemm g{C.hb(), C.win(l), ROWS, NPAD, DM, DM};
    pg8::StaticOrder S; S.init(ROWS, NPAD, C.G, C.bid);
    EpiIn E{C, l};
    pg8::gemm_phase<EpiIn, pg8::StaticOrder, true, true>(C.lds, g, S, E, C.tid);
}
DI void phase_outproj_gemm(const Ctx& C, int l) {
    pg8::Gemm g{C.proj(), C.wout(l), ROWS, DM, DMIX, PJW};
    pg8::StaticOrder S; S.init(ROWS, DM, C.G, C.bid);
    EpiOut E{C, l};
    pg8::gemm_phase<EpiOut, pg8::StaticOrder, true, true>(C.lds, g, S, E, C.tid);
}
DI void phase_ycnorm(const Ctx& C, int l) {
    const int gw = C.bid * NWAVES + C.wave, NGW = C.G * NWAVES, lane = C.lane;
#if USE_SSD_OPT
    for (int i = C.bid * NTHREADS + C.tid; i < NSB * 3 * 1536; i += C.G * NTHREADS) {
        const int sb = i / (3 * 1536), j = (i / 1536) % 3, ch = i % 1536;
        out_sc(C, l, sb)[j * 1536 + ch] = bf2f(C.proj()[(size_t)(sb_row0(sb) + sb_T(sb) - 3 + j) * PJW + C_XBC + ch]);
    }
#endif
#if USE_LRU_OPT
    for (int i = C.bid * NTHREADS + C.tid; i < NSB * 3 * 512; i += C.G * NTHREADS) {
        const int sb = i / (3 * 512), j = (i / 512) % 3, ch = i % 512;
        out_lc(C, l, sb)[j * 512 + ch] = bf2f(C.proj()[(size_t)(sb_row0(sb) + sb_T(sb) - 3 + j) * PJW + C_XL + ch]);
    }
#endif
    for (int m = gw; m < ROWS; m += NGW) {
        const float s = C.ssq()[(size_t)m * 64 + lane];
        float h = s;
        h = half_sum32(h);
        const float rg = rsqrtf(h * (1.f / 512.f) + EPS);
        const float r0 = bperm(rg, 0), r1 = bperm(rg, 32);
        bf16_t* p = C.proj() + (size_t)m * PJW + C_Z;
#pragma unroll
        for (int j = 0; j < 2; ++j) {
            const int c = 8 * lane + 512 * j;
            const u32x4 v = *(const u32x4*)(p + c); const float r = j == 0 ? r0 : r1; u32x4 o;
            o.x = cvt_pk_bf16(__uint_as_float(v.x << 16) * r, __uint_as_float(v.x & 0xffff0000u) * r);
            o.y = cvt_pk_bf16(__uint_as_float(v.y << 16) * r, __uint_as_float(v.y & 0xffff0000u) * r);
            o.z = cvt_pk_bf16(__uint_as_float(v.z << 16) * r, __uint_as_float(v.z & 0xffff0000u) * r);
            o.w = cvt_pk_bf16(__uint_as_float(v.w << 16) * r, __uint_as_float(v.w & 0xffff0000u) * r);
            *(u32x4*)(p + c) = o;
        }
    }
}

template <int MODE>
DI void p0_transpose_item(const Ctx& C, const float* W, const float* scale, int K, int Nsrc, int Ndst, bf16_t* WT, LAS float* scr, int item) {
    const int lane = C.lane, nblk = Ndst / 32, kb = item / nblk, nb = item % nblk, k0 = 64 * kb, n0 = 32 * nb;
    const int ncol = n0 + (lane & 31);
    const int src = (MODE == 0) ? orig_col(ncol) : ncol;
#pragma unroll 8
    for (int i = 0; i < 32; ++i) {
        const int kk = 2 * i + (lane >> 5), k = k0 + kk;
        float v = 0.f;
        if (src >= 0) {
            v = W[(size_t)k * Nsrc + src];
            if (MODE == 0) v *= scale[k];
            else if (k >= 1024) v *= scale[k - 1024];
        }
        scr[kk * 33 + (lane & 31)] = v;
    }
    LDS_FENCE();
    const int c = lane & 7;
#pragma unroll
    for (int j = 0; j < 4; ++j) {
        const int n = (lane >> 3) + 8 * j; const LAS float* s = scr + (8 * c) * 33 + n;
        u32x4 o; o.x = pk2(s[0 * 33], s[1 * 33]); o.y = pk2(s[2 * 33], s[3 * 33]); o.z = pk2(s[4 * 33], s[5 * 33]); o.w = pk2(s[6 * 33], s[7 * 33]);
        *(u32x4*)(WT + (size_t)(n0 + n) * K + k0 + 8 * c) = o;
    }
    LDS_FENCE();
}
DI void phase_prologue(const Ctx& C) {
    LAS float* scr = (LAS float*)(C.lds + C.wave * 16384);
    const int gw = C.bid * NWAVES + C.wave, NGW = C.G * NWAVES;
    constexpr int I_IN = (DM / 64) * (NPAD / 32), I_OUT = (DMIX / 64) * (DM / 32);
    for (int it = gw; it < 2 * (I_IN + I_OUT); it += NGW) {
        int r = it; const int l = r / (I_IN + I_OUT); r -= l * (I_IN + I_OUT);
        if (r < I_IN) p0_transpose_item<0>(C, C.inp(10) + (size_t)l * DM * DINP, C.inp(9) + l * DM, DM, DINP, NPAD, C.win(l), scr, r);
        else p0_transpose_item<1>(C, C.inp(27) + (size_t)l * DMIX * DM, C.inp(26) + l * 1024, DMIX, DM, DM, C.wout(l), scr, r - I_IN);
    }
    for (int m = gw; m < ROWS; m += NGW) {
        const float* xr = (m < ROWS_P) ? C.inp(0) + (size_t)m * DM : C.inp(1) + (size_t)(m - ROWS_P) * DM;
        float ss = 0.f;
#pragma unroll
        for (int j = 0; j < 4; ++j) {
            const f32x4 v = *(const f32x4*)(xr + 4 * C.lane + 256 * j);
            ss += (v.x * v.x + v.y * v.y) + (v.z * v.z + v.w * v.w);
            u32x2 o; o.x = pk2(v.x, v.y); o.y = pk2(v.z, v.w);
            *(u32x2*)(C.hb() + (size_t)m * DM + 4 * C.lane + 256 * j) = o;
        }
        ss = wave_sum(ss);
        if (C.lane < 16) C.rss()[(size_t)m * 16 + C.lane] = (C.lane == 0) ? ss : 0.f;
    }
    for (int it = gw; it < 2 * NSB_S * PAST; it += NGW) {
        const int l = it / (NSB_S * PAST), r = it % (NSB_S * PAST), b = r / PAST, pos = r % PAST;
        bf16_t* dst = C.kvb(l) + kvb_off(NPB + b) + (size_t)pos * KVW;
        const size_t base = ((size_t)(l * NSB_S + b) * PAST + pos);
#pragma unroll
        for (int j = 0; j < 5; ++j) {
            const int c = C.lane + 64 * j; float v;
            if (c < 128) v = C.inp(2)[base * 128 + c]; else if (c < 256) v = C.inp(3)[base * 128 + (c - 128)]; else v = C.inp(4)[base * 64 + (c - 256)];
            dst[c] = f2bf(v);
        }
    }
}

#define MFMA32(a, b, c) __builtin_amdgcn_mfma_f32_32x32x16_bf16((a), (b), (c), 0, 0, 0)
DI void phase_inproj_simple(const Ctx& C, int l) {
    const int gw = C.bid * NWAVES + C.wave, NGW = C.G * NWAVES, lane = C.lane, r = lane & 31, h = lane >> 5;
    constexpr int NG = 82, NRT = ROWS / 32;
    const bf16_t* WIN = C.win(l); const bf16_t* HB = C.hb(); bf16_t* PJ = C.proj();
    for (int it = gw; it < NRT * NG; it += NGW) {
        const int rt = it / NG, g = it % NG, m0 = rt * 32;
        int c0, c1, type;
        if (g < 76) { c0 = 64 * g; c1 = c0 + 32; type = 0; }
        else if (g < 80) { const int hs = g - 76; c0 = C_T19 + 32 * hs; c1 = c0 + 128; type = hs < 2 ? 1 : 2; }
        else if (g == 80) { c0 = C_T20; c1 = C_T20 + 32; type = 3; }
        else { c0 = C_T20 + 64; c1 = C_T20 + 96; type = 4; }
        f32x16 acc0, acc1;
#pragma unroll
        for (int i = 0; i < 16; ++i) { acc0[i] = 0.f; acc1[i] = 0.f; }
        const bf16_t* Ap = HB + (size_t)(m0 + r) * DM + 8 * h;
        const bf16_t* B0 = WIN + (size_t)(c0 + r) * DM + 8 * h;
        const bf16_t* B1 = WIN + (size_t)(c1 + r) * DM + 8 * h;
#pragma unroll 4
        for (int k0 = 0; k0 < DM; k0 += 16) {
            const bf16x8 a = *(const bf16x8*)(Ap + k0), b0 = *(const bf16x8*)(B0 + k0), b1 = *(const bf16x8*)(B1 + k0);
            acc0 = MFMA32(a, b0, acc0); acc1 = MFMA32(a, b1, acc1);
        }
        float rsc; { const float* p = C.rss() + (size_t)(m0 + r) * 16; float s = 0.f;
#pragma unroll
            for (int j = 0; j < 16; ++j) s += p[j];
            rsc = rsqrtf(s * (1.f / DM) + EPS); }
        const float kn0 = (type == 1) ? C.inp(19)[l * 64 + r] : 1.f, kn1 = (type == 1) ? C.inp(19)[l * 64 + 32 + r] : 1.f;
#pragma unroll
        for (int reg = 0; reg < 16; ++reg) {
            const int rowl = crow(reg, h), m = m0 + rowl;
            const float sc = bperm(rsc, rowl);
            float v0 = acc0[reg] * sc, v1 = acc1[reg] * sc;
            if (type == 0) { PJ[(size_t)m * PJW + c0 + r] = f2bf(v0); PJ[(size_t)m * PJW + c1 + r] = f2bf(v1); }
            else {
                int sb, t; row_sbt(m, sb, t); const int pos = sb_P(sb) + t;
                bf16_t* kv = C.kvb(l) + kvb_off(sb) + (size_t)pos * KVW;
                if (type == 1) {
                    const int kvh = g - 76;
                    const float ss = half_sum32(v0 * v0 + v1 * v1), rn = rsqrtf(ss * (1.f / 64.f) + EPS);
                    v0 = v0 * rn * kn0; v1 = v1 * rn * kn1;
                    float* o = out_ak(C, l, sb) + (size_t)t * 128 + kvh * 64;
                    o[r] = v0; o[32 + r] = v1; kv[kvh * 64 + r] = f2bf(v0); kv[kvh * 64 + 32 + r] = f2bf(v1);
                } else if (type == 2) {
                    const int kvh = g - 78;
                    float* o = out_av(C, l, sb) + (size_t)t * 128 + kvh * 64;
                    o[r] = v0; o[32 + r] = v1; kv[128 + kvh * 64 + r] = f2bf(v0); kv[128 + kvh * 64 + 32 + r] = f2bf(v1);
                } else if (type == 3) {
                    float* o = out_ik(C, l, sb) + (size_t)t * 64;
                    o[r] = v0; o[32 + r] = v1; kv[256 + r] = f2bf(v0); kv[256 + 32 + r] = f2bf(v1);
                } else {
                    if (r < 4) C.wi()[(size_t)m * 4 + r] = v0; else if (r < 20) C.dtr()[(size_t)m * 16 + (r - 4)] = v0;
                }
            }
        }
    }
}

DI void phase_outproj_simple(const Ctx& C, int l) {
    const int gw = C.bid * NWAVES + C.wave, NGW = C.G * NWAVES, lane = C.lane, r = lane & 31, h = lane >> 5;
    constexpr int NG = DM / 64, NRT = ROWS / 32;
    const bf16_t* WO = C.wout(l); const bf16_t* PJ = C.proj();
    for (int it = gw; it < NRT * NG; it += NGW) {
        const int rt = it / NG, g = it % NG, m0 = rt * 32, c0 = 64 * g, c1 = c0 + 32;
        f32x16 a00, a01, a10, a11, a20, a21;
#pragma unroll
        for (int i = 0; i < 16; ++i) { a00[i] = 0.f; a01[i] = 0.f; a10[i] = 0.f; a11[i] = 0.f; a20[i] = 0.f; a21[i] = 0.f; }
        const bf16_t* Ap = PJ + (size_t)(m0 + r) * PJW + 8 * h;
        const bf16_t* B0 = WO + (size_t)(c0 + r) * DMIX + 8 * h;
        const bf16_t* B1 = WO + (size_t)(c1 + r) * DMIX + 8 * h;
#pragma unroll 4
        for (int k0 = 0; k0 < 1024; k0 += 16) { const bf16x8 a = *(const bf16x8*)(Ap + k0); a00 = MFMA32(a, *(const bf16x8*)(B0 + k0), a00); a01 = MFMA32(a, *(const bf16x8*)(B1 + k0), a01); }
#pragma unroll 4
        for (int k0 = 1024; k0 < 1536; k0 += 16) { const bf16x8 a = *(const bf16x8*)(Ap + k0); a10 = MFMA32(a, *(const bf16x8*)(B0 + k0), a10); a11 = MFMA32(a, *(const bf16x8*)(B1 + k0), a11); }
#pragma unroll 4
        for (int k0 = 1536; k0 < 2048; k0 += 16) { const bf16x8 a = *(const bf16x8*)(Ap + k0); a20 = MFMA32(a, *(const bf16x8*)(B0 + k0), a20); a21 = MFMA32(a, *(const bf16x8*)(B1 + k0), a21); }
        float r0, r1; { const float* p = C.ssq() + (size_t)(m0 + r) * 64; float s0 = 0.f, s1 = 0.f;
#pragma unroll
            for (int j = 0; j < 32; ++j) { s0 += p[j]; s1 += p[32 + j]; }
            r0 = rsqrtf(s0 * (1.f / 512.f) + EPS); r1 = rsqrtf(s1 * (1.f / 512.f) + EPS); }
#pragma unroll
        for (int reg = 0; reg < 16; ++reg) {
            const int rowl = crow(reg, h), m = m0 + rowl;
            const float g0 = bperm(r0, rowl), g1 = bperm(r1, rowl);
            const float* xres = (l == 0) ? ((m < ROWS_P) ? C.inp(0) + (size_t)m * DM : C.inp(1) + (size_t)(m - ROWS_P) * DM) : C.out + (size_t)m * DM;
            const float v0 = xres[c0 + r] + a00[reg] + g0 * a10[reg] + g1 * a20[reg];
            const float v1 = xres[c1 + r] + a01[reg] + g0 * a11[reg] + g1 * a21[reg];
            C.out[(size_t)m * DM + c0 + r] = v0; C.out[(size_t)m * DM + c1 + r] = v1;
            if (l == 0) {
                C.hb()[(size_t)m * DM + c0 + r] = f2bf(v0); C.hb()[(size_t)m * DM + c1 + r] = f2bf(v1);
                const float ss = half_sum32(v0 * v0 + v1 * v1);
                if (r == 0) C.rss()[(size_t)m * 16 + g] = ss;
            }
        }
    }
}

DI void phase_conv_naive(const Ctx& C, int l) {
    const int gt = C.bid * NTHREADS + C.tid, NGT = C.G * NTHREADS;
    bf16_t* PJ = C.proj();
    for (int i = gt; i < NSB * 1536; i += NGT) {
        const int sb = i / 1536, ch = i % 1536, T = sb_T(sb), row0 = sb_row0(sb);
        const float* cw = C.inp(21) + (size_t)l * 4 * 1536; const float w0 = cw[ch], w1 = cw[1536 + ch], w2 = cw[2 * 1536 + ch], w3 = cw[3 * 1536 + ch], bias = C.inp(22)[l * 1536 + ch];
        float h0 = 0.f, h1 = 0.f, h2 = 0.f;
        if (sb >= NPB) { const float* st = C.inp(7) + ((size_t)(l * NSB_S + sb - NPB) * 3) * 1536; h0 = st[ch]; h1 = st[1536 + ch]; h2 = st[2 * 1536 + ch]; }
        bf16_t* p = PJ + (size_t)row0 * PJW + C_XBC + ch;
        for (int t = 0; t < T; ++t) {
            const float x = bf2f(p[(size_t)t * PJW]);
            const float y = bias + w0 * h0 + w1 * h1 + w2 * h2 + w3 * x;
            p[(size_t)t * PJW] = f2bf(silu_f(y));
            h0 = h1; h1 = h2; h2 = x;
        }
        float* o = out_sc(C, l, sb); o[ch] = h0; o[1536 + ch] = h1; o[2 * 1536 + ch] = h2;
    }
}

DI void lru_item_naive(const Ctx& C, int l, int sb, int blk, LAS unsigned char* scr) {
    const int lane = C.lane, ch = blk * 64 + lane, T = sb_T(sb), row0 = sb_row0(sb);
    bf16_t* PJ = C.proj();
    LAS unsigned* wl = (LAS unsigned*)scr;
    { const float* pa = C.inp(13) + (size_t)(l * 8 + blk) * 4096 + lane; const float* px = C.inp(15) + (size_t)(l * 8 + blk) * 4096 + lane;
      for (int c = 0; c < 64; ++c) wl[c * 64 + lane] = pk2(pa[c * 64], px[c * 64]); }
    LDS_FENCE();
    const float ba = C.inp(14)[l * 512 + ch], bx = C.inp(16)[l * 512 + ch];
    const float spl = softplus_f(-C.inp(17)[l * 512 + ch]);
    const float* cw = C.inp(11) + (size_t)l * 4 * 512; const float w0 = cw[ch], w1 = cw[512 + ch], w2 = cw[1024 + ch], w3 = cw[1536 + ch], cb = C.inp(12)[l * 512 + ch];
    float h0 = 0.f, h1 = 0.f, h2 = 0.f, hs = 0.f;
    if (sb >= NPB) { const float* st = C.inp(5) + ((size_t)(l * NSB_S + sb - NPB) * 3) * 512; h0 = st[ch]; h1 = st[512 + ch]; h2 = st[1024 + ch]; hs = C.inp(6)[(size_t)(l * NSB_S + sb - NPB) * 512 + ch]; }
    for (int t = 0; t < T; ++t) {
        const size_t rb = (size_t)(row0 + t) * PJW;
        const float x = bf2f(PJ[rb + C_XL + ch]);
        const float xc = cb + w0 * h0 + w1 * h1 + w2 * h2 + w3 * x;
        h0 = h1; h1 = h2; h2 = x;
        float ga = ba, gx = bx;
#pragma unroll 8
        for (int c = 0; c < 64; ++c) { const float xv = __int_as_float(__builtin_amdgcn_readlane(__float_as_int(xc), c)); const unsigned w = wl[c * 64 + lane]; ga += xv * __uint_as_float(w << 16); gx += xv * __uint_as_float(w & 0xffff0000u); }
        const float rg = sigmoid_f(ga), ig = sigmoid_f(gx);
        const float log_a = -8.f * rg * spl, a = expf(log_a), mult = sqrtf(-expm1f(2.f * log_a));
        hs = a * hs + mult * (ig * xc);
        const float gl = bf2f(PJ[rb + C_GL + ch]);
        PJ[rb + C_GL + ch] = f2bf(hs * silu_f(gl));
    }
    float* oc = out_lc(C, l, sb); oc[ch] = h0; oc[512 + ch] = h1; oc[1024 + ch] = h2;
    out_lh(C, l, sb)[ch] = hs;
}

DI void ssd_item_naive(const Ctx& C, int l, int sb, int hd, int pq) {
    const int lane = C.lane, T = sb_T(sb), row0 = sb_row0(sb), g = hd >> 3;
    const int p = 16 * pq + (lane & 15), nq = lane >> 4, n0 = 32 * nq;
    bf16_t* PJ = C.proj();
    float hst[32];
    if (sb >= NPB) { const float* st = C.inp(8) + (((size_t)(l * NSB_S + sb - NPB) * 16 + hd) * 64 + p) * 128 + n0;
#pragma unroll
        for (int n = 0; n < 32; n += 4) { const f32x4 v = *(const f32x4*)(st + n); hst[n] = v.x; hst[n + 1] = v.y; hst[n + 2] = v.z; hst[n + 3] = v.w; } }
    else {
#pragma unroll
        for (int n = 0; n < 32; ++n) hst[n] = 0.f; }
    const float aneg = -expf(C.inp(24)[l * 16 + hd]), dtb = C.inp(23)[l * 16 + hd], Dh = C.inp(25)[l * 16 + hd];
    for (int t = 0; t < T; ++t) {
        const size_t rb = (size_t)(row0 + t) * PJW;
        const float dt = softplus_f(C.dtr()[(size_t)(row0 + t) * 16 + hd] + dtb), da = expf(dt * aneg);
        const float xs = bf2f(PJ[rb + C_XBC + hd * 64 + p]), dtx = dt * xs;
        const bf16_t* Bp = PJ + rb + C_XBC + 1024 + g * 128 + n0; const bf16_t* Cp = PJ + rb + C_XBC + 1280 + g * 128 + n0;
        float y = 0.f;
#pragma unroll
        for (int n = 0; n < 32; n += 8) {
            const bf16x8 bv = *(const bf16x8*)(Bp + n), cv = *(const bf16x8*)(Cp + n);
#pragma unroll
            for (int j = 0; j < 8; ++j) { hst[n + j] = da * hst[n + j] + dtx * bf2f((bf16_t)bv[j]); y += bf2f((bf16_t)cv[j]) * hst[n + j]; }
        }
        y = sum_fq(y);
        y += Dh * xs;
        const float z = bf2f(PJ[rb + C_Z + hd * 64 + p]);
        y *= silu_f(z);
        if (nq == 0) PJ[rb + C_Z + hd * 64 + p] = f2bf(y);
        const float ss = wave_sum(nq == 0 ? y * y : 0.f);
        if (lane == 0) C.ssq()[(size_t)(row0 + t) * 64 + hd * 4 + pq] = ss;
    }
    float* o = out_sh(C, l, sb) + ((size_t)hd * 64 + p) * 128 + n0;
#pragma unroll
    for (int n = 0; n < 32; n += 4) { f32x4 v; v.x = hst[n]; v.y = hst[n + 1]; v.z = hst[n + 2]; v.w = hst[n + 3]; *(f32x4*)(o + n) = v; }
}

constexpr int SS_XST = 0;
constexpr int SS_BM = SS_XST + 64 * 144;
constexpr int SS_CM = SS_BM + 64 * 272;
constexpr int SS_BWT = SS_CM + 64 * 272;
constexpr int SS_HA = SS_BWT + 128 * 144;
constexpr int SS_SCAL = SS_HA + 2 * 64 * 272;
constexpr int SS_CW = SS_SCAL + 2 * 1024;
constexpr int SS_RAW = SS_CW + 5 * 320 * 4;
constexpr int SS_Z = SS_RAW + 67 * 640;
constexpr int SS_END = SS_Z + 8192;
static_assert(SS_END <= LDS_BYTES - 256, "SSD LDS map");
typedef short s16x4 __attribute__((ext_vector_type(4)));
DI float fast_silu(float x) { return x * __builtin_amdgcn_rcpf(1.f + __builtin_amdgcn_exp2f(-1.4426950408889634f * x)); }
DI bf16x8 lds_frag(const LAS unsigned char* base, int row, int rowbytes, int col) { return *(const LAS bf16x8*)(base + row * rowbytes + col * 2); }

DI void ssd_item(const Ctx& C, int l, int sb, int hd) {
    const int tid = C.tid, lane = C.lane, wave = C.wave, r = lane & 31, h = lane >> 5;
    const int T = sb_T(sb), row0 = sb_row0(sb), g = hd >> 3, NC = T / 64;
    LAS unsigned char* L = C.lds;
    bf16_t* PJ = C.proj();
    const float aneg = -expf(C.inp(24)[l * 16 + hd]), dtb = C.inp(23)[l * 16 + hd], Dh = C.inp(25)[l * 16 + hd];
    const bool stager = tid < 320;
    const int cg = 8 * (tid >> 6) + (tid & 7), seg = (tid >> 3) & 7;
    int colbase, cch;
    if (cg < 8) { cch = hd * 64 + 8 * cg; } else if (cg < 24) { cch = 1024 + g * 128 + 8 * (cg - 8); } else { cch = 1280 + g * 128 + 8 * (cg - 24); }
    colbase = C_XBC + cch;
    for (int i = tid; i < 5 * 320; i += NTHREADS) {
        const int j = i / 320, c = i % 320, cg2 = c >> 3, e = c & 7;
        const int ch = (cg2 < 8) ? hd * 64 + 8 * cg2 + e : (cg2 < 24 ? 1024 + g * 128 + 8 * (cg2 - 8) + e : 1280 + g * 128 + 8 * (cg2 - 24) + e);
        ((LAS float*)(L + SS_CW))[i] = (j < 4) ? C.inp(21)[((size_t)l * 4 + j) * 1536 + ch] : C.inp(22)[l * 1536 + ch];
    }
    const int sj = wave - 4, sph = sj & 1, nq0 = 2 * (sj >> 1);
    f32x16 hacc0, hacc1;
#pragma unroll
    for (int i = 0; i < 16; ++i) { hacc0[i] = 0.f; hacc1[i] = 0.f; }
    if (wave >= 4) {
        if (sb >= NPB) {
            const float* st = C.inp(8) + (((size_t)(l * NSB_S + sb - NPB) * 16 + hd) * 64 + 32 * sph + r) * 128;
#pragma unroll
            for (int gq = 0; gq < 4; ++gq) {
                const f32x4 v0 = *(const f32x4*)(st + 32 * nq0 + 8 * gq + 4 * h), v1 = *(const f32x4*)(st + 32 * (nq0 + 1) + 8 * gq + 4 * h);
#pragma unroll
                for (int e = 0; e < 4; ++e) { hacc0[4 * gq + e] = v0[e]; hacc1[4 * gq + e] = v1[e]; }
            }
        }
#pragma unroll
        for (int gq = 0; gq < 4; ++gq) {
            u32x2 w0, w1; w0.x = cvt_pk_bf16(hacc0[4 * gq], hacc0[4 * gq + 1]); w0.y = cvt_pk_bf16(hacc0[4 * gq + 2], hacc0[4 * gq + 3]);
            w1.x = cvt_pk_bf16(hacc1[4 * gq], hacc1[4 * gq + 1]); w1.y = cvt_pk_bf16(hacc1[4 * gq + 2], hacc1[4 * gq + 3]);
            *(LAS u32x2*)(L + SS_HA + (32 * sph + r) * 272 + (32 * nq0 + 8 * gq + 4 * h) * 2) = w0;
            *(LAS u32x2*)(L + SS_HA + (32 * sph + r) * 272 + (32 * (nq0 + 1) + 8 * gq + 4 * h) * 2) = w1;
        }
    }
    const int yph = wave & 1, ylh = (wave >> 1) & 1;
    float dtr_pf = 0.f;
#define SSD_DMA_RAW(cc) do { const int t0_ = 64 * (cc); \
        for (int k_ = wave; k_ < 42; k_ += NWAVES) { \
            const int q_ = 64 * k_ + lane, rr_ = q_ / 40, pc_ = q_ - 40 * rr_, t_ = t0_ - 3 + rr_; \
            const int col_ = C_XBC + ((pc_ < 8) ? hd * 64 + 8 * pc_ : (pc_ < 24 ? 1024 + g * 128 + 8 * (pc_ - 8) : 1280 + g * 128 + 8 * (pc_ - 24))); \
            if (q_ < 2680 && t_ >= 0) __builtin_amdgcn_global_load_lds((const unsigned*)(PJ + (size_t)(row0 + t_) * PJW + col_), (LAS unsigned*)(L + SS_RAW + k_ * 1024), 16, 0, 0); } \
    } while (0)
#define SSD_DMA_Z(cc) do { const int t0_ = 64 * (cc); \
        if (wave < 4) { _Pragma("unroll") for (int k_ = 0; k_ < 2; ++k_) { const int rr_ = 16 * k_ + (lane >> 2), pc_ = lane & 3; \
            __builtin_amdgcn_global_load_lds((const unsigned*)(PJ + (size_t)(row0 + t0_ + 32 * ylh + rr_) * PJW + C_Z + hd * 64 + 32 * yph + 8 * pc_), \
                                             (LAS unsigned*)(L + SS_Z + (2 * yph + ylh) * 2048 + k_ * 1024), 16, 0, 0); } } \
    } while (0)
    if (tid < 120) {
        const int rr = tid / 40, pc = tid % 40;
        const int ch = (pc < 8) ? hd * 64 + 8 * pc : (pc < 24 ? 1024 + g * 128 + 8 * (pc - 8) : 1280 + g * 128 + 8 * (pc - 24));
        u32x4 v = (u32x4){0u, 0u, 0u, 0u};
        if (sb >= NPB) { const float* st = C.inp(7) + ((size_t)(l * NSB_S + sb - NPB) * 3 + rr) * 1536 + ch; v = pack8(*(const f32x4*)st, *(const f32x4*)(st + 4)); }
        *(LAS u32x4*)(L + SS_RAW + rr * 640 + pc * 16) = v;
    }
    if (wave == 0) dtr_pf = C.dtr()[(size_t)(row0 + lane) * 16 + hd];
    SSD_DMA_RAW(0); SSD_DMA_Z(0);
    asm volatile("s_waitcnt vmcnt(0)" ::: "memory");
    __syncthreads();
    for (int c = 0; c < NC; ++c) {
        const int t0 = 64 * c, par = c & 1;
        LAS float* SC = (LAS float*)(L + SS_SCAL + par * 1024);
        if (wave == 0) {
            const float dt = softplus_f(dtr_pf + dtb);
            float x = dt * aneg;
#pragma unroll
            for (int o = 1; o < 64; o <<= 1) { const float y = bperm(x, lane - o); if (lane >= o) x += y; }
            const float cum63 = __int_as_float(__builtin_amdgcn_readlane(__float_as_int(x), 63));
            SC[lane] = x; SC[64 + lane] = dt; SC[128 + lane] = expf(cum63 - x) * dt; SC[192 + lane] = expf(x);
        }
        asm volatile("s_waitcnt vmcnt(0)" ::: "memory"); LDS_FENCE(); __syncthreads();
        if (stager) {
            const LAS float* CW = (const LAS float*)(L + SS_CW) + 8 * cg;
            const int s0 = 8 * seg;
            float te[8];
#pragma unroll
            for (int j = 0; j < 8; ++j) te[j] = (cg >= 8 && cg < 24) ? SC[128 + s0 + j] : 1.f;
            const int n0 = (cg < 24) ? 8 * (cg - 8) : 8 * (cg - 24);
#pragma unroll
            for (int ep = 0; ep < 4; ++ep) {
                float xa[11], xb[11];
#pragma unroll
                for (int i = 0; i < 11; ++i) { const unsigned w = *(const LAS unsigned*)(L + SS_RAW + (s0 + i) * 640 + cg * 16 + ep * 4); xa[i] = __uint_as_float(w << 16); xb[i] = __uint_as_float(w & 0xffff0000u); }
                const float a0 = CW[2 * ep], a1 = CW[320 + 2 * ep], a2 = CW[640 + 2 * ep], a3 = CW[960 + 2 * ep], ab = CW[1280 + 2 * ep];
                const float b0 = CW[2 * ep + 1], b1 = CW[320 + 2 * ep + 1], b2 = CW[640 + 2 * ep + 1], b3 = CW[960 + 2 * ep + 1], bb = CW[1280 + 2 * ep + 1];
                float ta[8], tb[8];
#pragma unroll
                for (int j = 0; j < 8; ++j) {
                    ta[j] = fast_silu(ab + a0 * xa[j] + a1 * xa[j + 1] + a2 * xa[j + 2] + a3 * xa[j + 3]);
                    tb[j] = fast_silu(bb + b0 * xb[j] + b1 * xb[j + 1] + b2 * xb[j + 2] + b3 * xb[j + 3]);
                }
                if (cg < 8) {
#pragma unroll
                    for (int jp = 0; jp < 4; ++jp) {
                        *(LAS unsigned*)(L + SS_XST + (8 * cg + 2 * ep) * 144 + (s0 + 2 * jp) * 2) = cvt_pk_bf16(ta[2 * jp], ta[2 * jp + 1]);
                        *(LAS unsigned*)(L + SS_XST + (8 * cg + 2 * ep + 1) * 144 + (s0 + 2 * jp) * 2) = cvt_pk_bf16(tb[2 * jp], tb[2 * jp + 1]);
                    }
                } else if (cg < 24) {
#pragma unroll
                    for (int j = 0; j < 8; ++j) *(LAS unsigned*)(L + SS_BM + (s0 + j) * 272 + (n0 + 2 * ep) * 2) = cvt_pk_bf16(ta[j], tb[j]);
#pragma unroll
                    for (int jp = 0; jp < 4; ++jp) {
                        *(LAS unsigned*)(L + SS_BWT + (n0 + 2 * ep) * 144 + (s0 + 2 * jp) * 2) = cvt_pk_bf16(ta[2 * jp] * te[2 * jp], ta[2 * jp + 1] * te[2 * jp + 1]);
                        *(LAS unsigned*)(L + SS_BWT + (n0 + 2 * ep + 1) * 144 + (s0 + 2 * jp) * 2) = cvt_pk_bf16(tb[2 * jp] * te[2 * jp], tb[2 * jp + 1] * te[2 * jp + 1]);
                    }
                } else {
#pragma unroll
                    for (int j = 0; j < 8; ++j) *(LAS unsigned*)(L + SS_CM + (s0 + j) * 272 + (n0 + 2 * ep) * 2) = cvt_pk_bf16(ta[j], tb[j]);
                }
            }
        }
        if (c + 1 < NC && wave == 0) dtr_pf = C.dtr()[(size_t)(row0 + t0 + 64 + lane) * 16 + hd];
        LDS_FENCE(); __syncthreads();
        if (c + 1 < NC) SSD_DMA_RAW(c + 1);
        if (wave < 4) {
            const LAS unsigned char* HAc = L + SS_HA + par * (64 * 272);
            bf16x8 cf[8];
#pragma unroll
            for (int ks = 0; ks < 8; ++ks) cf[ks] = lds_frag(L + SS_CM, 32 * ylh + r, 272, 16 * ks + 8 * h);
            const float cuml = SC[32 * ylh + r], ecl = SC[192 + 32 * ylh + r];
            bf16x8 wf[2][2];
#pragma unroll
            for (int sh = 0; sh < 2; ++sh) {
                if (sh <= ylh) {
                    f32x16 ga;
#pragma unroll
                    for (int i = 0; i < 16; ++i) ga[i] = 0.f;
#pragma unroll
                    for (int ks = 0; ks < 8; ++ks) ga = MFMA32(lds_frag(L + SS_BM, 32 * sh + r, 272, 16 * ks + 8 * h), cf[ks], ga);
                    float wv[16];
#pragma unroll
                    for (int reg = 0; reg < 16; ++reg) {
                        const int s = 32 * sh + crow(reg, h), ll = 32 * ylh + r;
                        const float cs = SC[s], ds = SC[64 + s];
                        float w = (s <= ll) ? ga[reg] * __builtin_amdgcn_exp2f(1.4426950408889634f * (cuml - cs)) * ds : 0.f;
                        if (s == ll) w += Dh;
                        wv[reg] = w;
                    }
#pragma unroll
                    for (int s2 = 0; s2 < 2; ++s2) {
                        u32x4 p; p.x = cvt_pk_bf16(wv[8 * s2], wv[8 * s2 + 1]); p.y = cvt_pk_bf16(wv[8 * s2 + 2], wv[8 * s2 + 3]); p.z = cvt_pk_bf16(wv[8 * s2 + 4], wv[8 * s2 + 5]); p.w = cvt_pk_bf16(wv[8 * s2 + 6], wv[8 * s2 + 7]);
                        wf[sh][s2] = __builtin_bit_cast(bf16x8, p);
                    }
                }
            }
            f32x16 ya;
#pragma unroll
            for (int i = 0; i < 16; ++i) ya[i] = 0.f;
#pragma unroll
            for (int ks = 0; ks < 8; ++ks) ya = MFMA32(lds_frag(HAc, 32 * yph + r, 272, 16 * ks + 8 * h), cf[ks], ya);
#pragma unroll
            for (int i = 0; i < 16; ++i) ya[i] *= ecl;
#pragma unroll
            for (int sh = 0; sh < 2; ++sh) {
                if (sh <= ylh) {
#pragma unroll
                    for (int s2 = 0; s2 < 2; ++s2) {
                        const LAS unsigned char* xp = L + SS_XST + (32 * yph + r) * 144 + (32 * sh + 16 * s2 + 4 * h) * 2;
                        const u32x2 lo = *(const LAS u32x2*)(xp), hi = *(const LAS u32x2*)(xp + 16);
                        u32x4 a; a.x = lo.x; a.y = lo.y; a.z = hi.x; a.w = hi.y;
                        ya = MFMA32(__builtin_bit_cast(bf16x8, a), wf[sh][s2], ya);
                    }
                }
            }
            float ss = 0.f;
            bf16_t* zp = PJ + (size_t)(row0 + t0 + 32 * ylh + r) * PJW + C_Z + hd * 64 + 32 * yph + 4 * h;
#pragma unroll
            for (int gq = 0; gq < 4; ++gq) {
                const u32x2 zz = *(const LAS u32x2*)(L + SS_Z + (2 * yph + ylh) * 2048 + r * 64 + (8 * gq + 4 * h) * 2);
                const float z0 = __uint_as_float(zz.x << 16), z1 = __uint_as_float(zz.x & 0xffff0000u), z2 = __uint_as_float(zz.y << 16), z3 = __uint_as_float(zz.y & 0xffff0000u);
                const float y0 = ya[4 * gq] * fast_silu(z0), y1 = ya[4 * gq + 1] * fast_silu(z1), y2 = ya[4 * gq + 2] * fast_silu(z2), y3 = ya[4 * gq + 3] * fast_silu(z3);
                ss += (y0 * y0 + y1 * y1) + (y2 * y2 + y3 * y3);
                u32x2 w; w.x = cvt_pk_bf16(y0, y1); w.y = cvt_pk_bf16(y2, y3);
                *(u32x2*)(zp + 8 * gq) = w;
            }
            ss = xor32_sum(ss);
            if (h == 0) { float* q = C.ssq() + (size_t)(row0 + t0 + 32 * ylh + r) * 64 + hd * 4 + yph; q[0] = ss; q[2] = 0.f; }
            LDS_FENCE();
            if (c + 1 < NC) SSD_DMA_Z(c + 1);
        } else {
            const float decay = SC[192 + 63];
#pragma unroll
            for (int i = 0; i < 16; ++i) { hacc0[i] *= decay; hacc1[i] *= decay; }
#pragma unroll
            for (int ks = 0; ks < 4; ++ks) {
                const bf16x8 xb = lds_frag(L + SS_XST, 32 * sph + r, 144, 16 * ks + 8 * h);
                hacc0 = MFMA32(lds_frag(L + SS_BWT, 32 * nq0 + r, 144, 16 * ks + 8 * h), xb, hacc0);
                hacc1 = MFMA32(lds_frag(L + SS_BWT, 32 * (nq0 + 1) + r, 144, 16 * ks + 8 * h), xb, hacc1);
            }
            LAS unsigned char* HAn = L + SS_HA + (par ^ 1) * (64 * 272);
#pragma unroll
            for (int gq = 0; gq < 4; ++gq) {
                u32x2 w0, w1; w0.x = cvt_pk_bf16(hacc0[4 * gq], hacc0[4 * gq + 1]); w0.y = cvt_pk_bf16(hacc0[4 * gq + 2], hacc0[4 * gq + 3]);
                w1.x = cvt_pk_bf16(hacc1[4 * gq], hacc1[4 * gq + 1]); w1.y = cvt_pk_bf16(hacc1[4 * gq + 2], hacc1[4 * gq + 3]);
                *(LAS u32x2*)(HAn + (32 * sph + r) * 272 + (32 * nq0 + 8 * gq + 4 * h) * 2) = w0;
                *(LAS u32x2*)(HAn + (32 * sph + r) * 272 + (32 * (nq0 + 1) + 8 * gq + 4 * h) * 2) = w1;
            }
        }
    }
    if (wave >= 4) {
        float* o = out_sh(C, l, sb) + ((size_t)hd * 64 + 32 * sph + r) * 128;
#pragma unroll
        for (int gq = 0; gq < 4; ++gq) {
            f32x4 v0, v1;
#pragma unroll
            for (int e = 0; e < 4; ++e) { v0[e] = hacc0[4 * gq + e]; v1[e] = hacc1[4 * gq + e]; }
            *(f32x4*)(o + 32 * nq0 + 8 * gq + 4 * h) = v0; *(f32x4*)(o + 32 * (nq0 + 1) + 8 * gq + 4 * h) = v1;
        }
    }
    __syncthreads();
#undef SSD_DMA_RAW
#undef SSD_DMA_Z
}

DI unsigned mono_key(float f) { const unsigned u = __float_as_uint(f); return (u & 0x80000000u) ? ~u : (u | 0x80000000u); }
DI int t5_bucket(int rel) {
    const int n = rel < 0 ? -rel : rel; int b;
    if (n < 8) b = n; else if (n < 12) b = 8; else if (n < 16) b = 9; else if (n < 23) b = 10; else if (n < 32) b = 11; else if (n < 46) b = 12; else if (n < 64) b = 13; else if (n < 91) b = 14; else b = 15;
    return b + (rel > 0 ? 16 : 0);
}
DI void attn_item_naive(const Ctx& C, int l, int m, LAS unsigned char* scr) {
    const int lane = C.lane;
    int sb, t; row_sbt(m, sb, t);
    const int P = sb_P(sb), posq = P + t, Ladm = 64 * ((posq >> 6) + 1), nsel = Ladm < 256 ? Ladm : 256;
    LAS unsigned* keys = (LAS unsigned*)scr; LAS unsigned* sel = keys + 2048; LAS float* qs = (LAS float*)(sel + 256); LAS float* ps = qs + 64; LAS float* qis = ps + 256;
    bf16_t* PJ = C.proj(); const bf16_t* KV = C.kvb(l) + kvb_off(sb);
    const size_t rb = (size_t)m * PJW;
#pragma unroll
    for (int j = 0; j < 4; ++j) qis[64 * j + lane] = bf2f(PJ[rb + C_QI + 64 * j + lane]);
    LDS_FENCE();
    const float w0 = C.wi()[(size_t)m * 4 + 0], w1 = C.wi()[(size_t)m * 4 + 1], w2 = C.wi()[(size_t)m * 4 + 2], w3 = C.wi()[(size_t)m * 4 + 3];
    for (int s = lane; s < Ladm; s += 64) {
        asm volatile("" ::: "memory");
        const bf16_t* kp = KV + (size_t)s * KVW + 256;
        float d0 = 0.f, d1 = 0.f, d2 = 0.f, d3 = 0.f;
#pragma unroll
        for (int d = 0; d < 64; d += 8) {
            const bf16x8 kv8 = *(const bf16x8*)(kp + d);
#pragma unroll
            for (int j = 0; j < 8; ++j) { const float kf = bf2f((bf16_t)kv8[j]); d0 += qis[d + j] * kf; d1 += qis[64 + d + j] * kf; d2 += qis[128 + d + j] * kf; d3 += qis[192 + d + j] * kf; }
            asm volatile("" ::: "memory");
        }
        const float score = ((w0 * fmaxf(d0, 0.f) + w1 * fmaxf(d1, 0.f)) + w2 * fmaxf(d2, 0.f)) + w3 * fmaxf(d3, 0.f);
        keys[s] = mono_key(score);
    }
    LDS_FENCE();
    for (int s = lane; s < Ladm; s += 64) {
        const unsigned km = keys[s]; int cnt = 0;
        for (int sp = 0; sp < Ladm; sp += 4) {
            const u32x4 kq = *(const LAS u32x4*)(keys + sp);
            cnt += (kq.x > km) | ((kq.x == km) & (sp < s));
            cnt += (kq.y > km) | ((kq.y == km) & (sp + 1 < s));
            cnt += (kq.z > km) | ((kq.z == km) & (sp + 2 < s));
            cnt += (kq.w > km) | ((kq.w == km) & (sp + 3 < s));
        }
        if (cnt < 256) sel[cnt] = (unsigned)s;
    }
    LDS_FENCE();
    for (int hq = 0; hq < 8; ++hq) {
        const int kvh = hq >> 2;
        { const float raw = bf2f(PJ[rb + C_Q + hq * 64 + lane]); const float ss = wave_sum(raw * raw);
          qs[lane] = raw * rsqrtf(ss * (1.f / 64.f) + EPS) * C.inp(18)[l * 64 + lane]; }
        LDS_FENCE();
        float lg[4]; float mx = -INFINITY;
#pragma unroll
        for (int i = 0; i < 4; ++i) {
            const int j = lane + 64 * i; lg[i] = -INFINITY;
            asm volatile("" ::: "memory");
            if (j < nsel) {
                const int s = (int)sel[j]; const bf16_t* kp = KV + (size_t)s * KVW + kvh * 64; float dot = 0.f;
#pragma unroll
                for (int d = 0; d < 64; d += 8) { const bf16x8 kv8 = *(const bf16x8*)(kp + d);
#pragma unroll
                    for (int jj = 0; jj < 8; ++jj) dot += qs[d + jj] * bf2f((bf16_t)kv8[jj]); }
                lg[i] = dot * 0.125f + C.inp(20)[t5_bucket(s - posq) * 8 + hq];
                mx = fmaxf(mx, lg[i]);
            }
        }
        mx = wave_max(mx);
        float sum = 0.f;
#pragma unroll
        for (int i = 0; i < 4; ++i) { const int j = lane + 64 * i; if (j < nsel) { lg[i] = expf(lg[i] - mx); sum += lg[i]; } }
        sum = wave_sum(sum); const float inv = 1.f / sum;
#pragma unroll
        for (int i = 0; i < 4; ++i) { const int j = lane + 64 * i; if (j < nsel) ps[j] = lg[i] * inv; }
        LDS_FENCE();
        float o = 0.f;
        for (int j = 0; j < nsel; ++j) o += ps[j] * bf2f(KV[(size_t)sel[j] * KVW + 128 + kvh * 64 + lane]);
        const float ga = bf2f(PJ[rb + C_GA + hq * 64 + lane]);
        PJ[rb + C_GA + hq * 64 + lane] = f2bf(o * silu_f(ga));
        LDS_FENCE();
    }
}

constexpr int AT_MASK = 0;
constexpr int AT_TMASK = AT_MASK + 64 * 65 * 4;
constexpr int AT_QST = AT_TMASK + 64 * 65 * 4;
constexpr int AT_MISC = AT_QST + 1024;
constexpr int AT_LUT = AT_MISC + 64;
constexpr int AT_HIST = AT_LUT + 8192;
constexpr int AT_RING = AT_HIST;
constexpr int AT_QI = AT_HIST + 65792;
constexpr int AT_END = AT_QI + 64 * 528;
static_assert(AT_END <= LDS_BYTES - 256 && AT_RING + 65536 <= AT_END, "attention LDS map");
typedef short v4i16_t __attribute__((ext_vector_type(4)));
#define AT_WAIT_V(n) asm volatile("s_waitcnt vmcnt(" #n ")" ::: "memory")
#define AT_BAR() do { asm volatile("s_waitcnt lgkmcnt(0)" ::: "memory"); __builtin_amdgcn_s_barrier(); asm volatile("" ::: "memory"); } while (0)

template <int MODE>
DI void idx_pass(const Ctx& C, const bf16_t* KV, const float (&w4)[4], int ntiles, int tq4, int q, int r, int h) {
    LAS unsigned char* L = C.lds;
    const LAS unsigned* QS = (const LAS unsigned*)(L + AT_QST) + 4 * q;
    const unsigned pfx = QS[0], info = QS[1];
    const int lvl = info & 15; const bool done = (info >> 4) & 1, tie = (info >> 5) & 1;
    const int sh = (MODE == 0) ? (lvl == 0 ? 23 : (lvl == 1 ? 14 : (lvl == 2 ? 5 : 0))) : (int)(info >> 8);
    const unsigned bmask = (lvl == 3) ? 31u : 511u;
    const int psh = (lvl == 1) ? 23 : (lvl == 2 ? 14 : 5);
    for (int t = tq4; t < ntiles; t += 4) {
#pragma unroll 1
        for (int kh = 0; kh < 2; ++kh) {
            const bf16_t* kp = KV + (size_t)(64 * t + 32 * kh + r) * KVW + 256 + 8 * h;
            bf16x8 a[4];
#pragma unroll
            for (int ks = 0; ks < 4; ++ks) a[ks] = *(const bf16x8*)(kp + 16 * ks);
            float sc[16];
#pragma unroll
            for (int i = 0; i < 16; ++i) sc[i] = 0.f;
#pragma unroll
            for (int hh = 0; hh < 4; ++hh) {
                f32x16 acc;
#pragma unroll
                for (int i = 0; i < 16; ++i) acc[i] = 0.f;
#pragma unroll
                for (int ks = 0; ks < 4; ++ks) acc = MFMA32(a[ks], *(const LAS bf16x8*)(L + AT_QI + q * 528 + (64 * hh + 16 * ks + 8 * h) * 2), acc);
#pragma unroll
                for (int i = 0; i < 16; ++i) sc[i] += w4[hh] * fmaxf(acc[i], 0.f);
            }
            if (MODE == 0) {
                if (!done) {
                    LAS unsigned* HR = (LAS unsigned*)(L + AT_HIST) + 257 * q;
#pragma unroll
                    for (int i = 0; i < 16; ++i) {
                        const unsigned key = mono_key(sc[i]);
                        const bool part = (lvl == 0) || ((key >> psh) == pfx);
                        if (part) { const unsigned bin = (key >> sh) & bmask; atomicAdd((unsigned*)(HR + (bin >> 1)), 1u << ((bin & 1u) << 4)); }
                    }
                }
            } else {
                unsigned mw = 0u, tw = 0u;
#pragma unroll
                for (int i = 15; i >= 0; --i) {
                    const unsigned key = mono_key(sc[i]);
                    const bool sel = tie ? (key > pfx) : ((key >> sh) >= pfx);
                    const bool tb = tie && (key == pfx);
                    mw = (mw << 1) | (sel ? 1u : 0u); tw = (tw << 1) | (tb ? 1u : 0u);
                    if ((i & 3) == 0 && i > 0) { mw <<= 4; tw <<= 4; }
                }
                mw <<= 4 * h; tw <<= 4 * h;
                if (mw) atomicOr((unsigned*)((LAS unsigned*)(L + AT_MASK) + 65 * q + 2 * t + kh), mw);
                if (tw) atomicOr((unsigned*)((LAS unsigned*)(L + AT_TMASK) + 65 * q + 2 * t + kh), tw);
            }
        }
    }
}

DI void attn_item(const Ctx& C, int l, int sb, int qb) {
    const int tid = C.tid, lane = C.lane, wave = C.wave, r = lane & 31, h = lane >> 5;
    LAS unsigned char* L = C.lds;
    const int P = sb_P(sb), row0 = sb_row0(sb), t0 = 64 * qb, pos0 = P + t0;
    const int ntiles = (pos0 >> 6) + 1, Ladm = 64 * ntiles;
    bf16_t* PJ = C.proj(); const bf16_t* KV = C.kvb(l) + kvb_off(sb);
    LAS unsigned* MASK = (LAS unsigned*)(L + AT_MASK); LAS unsigned* TMASK = (LAS unsigned*)(L + AT_TMASK);
    LAS unsigned* QST = (LAS unsigned*)(L + AT_QST); LAS unsigned* MISC = (LAS unsigned*)(L + AT_MISC);
    for (int i = tid; i < 64 * 65; i += NTHREADS) { const int w = i % 65; MASK[i] = (Ladm <= 256 && w < 2 * ntiles) ? 0xffffffffu : 0u; TMASK[i] = 0u; }
    for (int i = tid; i < 64 * 257; i += NTHREADS) ((LAS unsigned*)(L + AT_HIST))[i] = 0u;
    if (tid < 64) { unsigned k256 = 256u; asm volatile("" : "+v"(k256)); QST[4 * tid] = 0u; QST[4 * tid + 1] = 0u; QST[4 * tid + 2] = k256; QST[4 * tid + 3] = 0u; }
    for (int i = tid; i < 8 * 256; i += NTHREADS) { const int hq = i >> 8, rel = (i & 255) - 191; ((LAS float*)(L + AT_LUT))[i] = 1.4426950408889634f * C.inp(20)[t5_bucket(rel) * 8 + hq]; }
    if (tid == 0) MISC[0] = 0u;
    __syncthreads();
    if (Ladm > 256) {
        const int qh = wave & 1, tq4 = wave >> 1, q = 32 * qh + r;
        float w4[4];
        { const f32x4 wv = *(const f32x4*)(C.wi() + (size_t)(row0 + t0 + q) * 4); w4[0] = wv[0]; w4[1] = wv[1]; w4[2] = wv[2]; w4[3] = wv[3]; }
        for (int i = tid; i < 2048; i += NTHREADS) { const int qq = i >> 5, pc = i & 31;
            *(LAS u32x4*)(L + AT_QI + qq * 528 + pc * 16) = *(const u32x4*)(PJ + (size_t)(row0 + t0 + qq) * PJW + C_QI + 8 * pc); }
        __syncthreads();
        for (int lvl = 0; lvl < 4; ++lvl) {
            idx_pass<0>(C, KV, w4, ntiles, tq4, q, r, h);
            if (tid == 0) MISC[0] = 0u;
            __syncthreads();
            int ln = lane; asm volatile("" : "+v"(ln));
            for (int qq = 8 * wave; qq < 8 * wave + 8; ++qq) {
                const unsigned pfx = QST[4 * qq], info = QST[4 * qq + 1], need = QST[4 * qq + 2];
                if ((info >> 4) & 1) continue;
                LAS unsigned* HR = (LAS unsigned*)(L + AT_HIST) + 257 * qq + 4 * ln;
                unsigned c[8];
#pragma unroll
                for (int j = 0; j < 4; ++j) { const unsigned wv = HR[j]; c[2 * j] = wv & 0xffffu; c[2 * j + 1] = wv >> 16; HR[j] = 0u; }
                unsigned ct = 0u;
#pragma unroll
                for (int j = 0; j < 8; ++j) ct += c[j];
                unsigned S = ct;
#pragma unroll
                for (int o = 1; o < 64; o <<= 1) { const unsigned y = (unsigned)__builtin_amdgcn_ds_bpermute((ln + o) << 2, (int)S); if (ln + o < 64) S += y; }
                if (S >= need && (S - ct) < need) {
                    unsigned rem = need - (S - ct), cum = 0u; int b = 0; unsigned cb = 0u;
                    bool found = false;
#pragma unroll
                    for (int j = 7; j >= 0; --j) { if (!found) { if (cum + c[j] >= rem) { b = j; cb = c[j]; found = true; } else cum += c[j]; } }
                    const unsigned need2 = rem - cum, binidx = 8u * ln + (unsigned)b;
                    const int bits = (lvl == 3) ? 5 : 9, shc = (lvl == 0) ? 23 : (lvl == 1 ? 14 : (lvl == 2 ? 5 : 0));
                    const unsigned npfx = (lvl == 0) ? binidx : ((pfx << bits) | binidx);
                    unsigned ninfo, nneed = need2, opfx = npfx;
                    if (need2 == cb) ninfo = (unsigned)lvl | 16u | ((unsigned)shc << 8);
                    else if (lvl == 0 && (binidx == 256u || binidx == 255u)) { ninfo = 16u | 32u; opfx = (binidx == 256u) ? 0x80000000u : 0x7fffffffu; }
                    else if (lvl == 3) ninfo = 16u | 32u;
                    else { ninfo = (unsigned)(lvl + 1); atomicAdd((unsigned*)MISC, 1u); }
                    QST[4 * qq] = opfx; QST[4 * qq + 1] = ninfo; QST[4 * qq + 2] = nneed;
                }
            }
            __syncthreads();
            if (MISC[0] == 0u) break;
            __syncthreads();
        }
        idx_pass<1>(C, KV, w4, ntiles, tq4, q, r, h);
        __syncthreads();
        int ln2 = lane; asm volatile("" : "+v"(ln2));
        for (int qq = 8 * wave; qq < 8 * wave + 8; ++qq) {
            if (!((QST[4 * qq + 1] >> 5) & 1)) continue;
            const unsigned mwd = (ln2 < 2 * ntiles) ? MASK[65 * qq + ln2] : 0u, twd = (ln2 < 2 * ntiles) ? TMASK[65 * qq + ln2] : 0u;
            int have = __popc(mwd);
#pragma unroll
            for (int o = 1; o < 64; o <<= 1) have += __builtin_amdgcn_ds_bpermute((ln2 ^ o) << 2, have);
            const int want = 256 - have, pc = __popc(twd);
            int incl = pc;
#pragma unroll
            for (int o = 1; o < 64; o <<= 1) { const int y = __builtin_amdgcn_ds_bpermute((ln2 - o) << 2, incl); if (ln2 >= o) incl += y; }
            int take = want - (incl - pc); take = take < 0 ? 0 : (take > pc ? pc : take);
            unsigned wrem = twd, add = 0u;
            for (int k = 0; k < take; ++k) { add |= wrem & (0u - wrem); wrem &= wrem - 1u; }
            if (add) MASK[65 * qq + ln2] = mwd | add;
        }
        __syncthreads();
    }
    const int hq = wave, kvh = wave >> 2;
    const unsigned ring = (unsigned)(size_t)(L + AT_RING);
    const float* LUT = nullptr; (void)LUT;
    const LAS float* lut = (const LAS float*)(L + AT_LUT) + 256 * hq;
    const float cfar = lut[0];
#define AT_DMA(tt, slot) do { const bf16_t* src_ = KV + (size_t)(64 * (tt)) * KVW; \
        _Pragma("unroll") for (int i_ = 0; i_ < 2; ++i_) { const int k_ = wave * 2 + i_, row_ = 4 * k_ + (lane >> 4), pc_ = lane & 15; \
            __builtin_amdgcn_global_load_lds((const unsigned*)(src_ + (size_t)row_ * KVW + 8 * (pc_ ^ (row_ & 15))), (LAS unsigned*)(L + AT_RING + (slot) * 32768 + k_ * 1024), 16, 0, 0); \
            __builtin_amdgcn_global_load_lds((const unsigned*)(src_ + (size_t)row_ * KVW + 128 + 8 * pc_), (LAS unsigned*)(L + AT_RING + (slot) * 32768 + 16384 + k_ * 1024), 16, 0, 0); } \
    } while (0)
    for (int qh = 0; qh < 2; ++qh) {
        const int q = 32 * qh + r, qrow = row0 + t0 + q;
        bf16x8 qf[4];
        { const bf16_t* qp = PJ + (size_t)qrow * PJW + C_Q + hq * 64 + 8 * h; float qv[4][8]; float ss = 0.f;
#pragma unroll
          for (int ks = 0; ks < 4; ++ks) { const u32x4 v = *(const u32x4*)(qp + 16 * ks);
              qv[ks][0] = __uint_as_float(v.x << 16); qv[ks][1] = __uint_as_float(v.x & 0xffff0000u); qv[ks][2] = __uint_as_float(v.y << 16); qv[ks][3] = __uint_as_float(v.y & 0xffff0000u);
              qv[ks][4] = __uint_as_float(v.z << 16); qv[ks][5] = __uint_as_float(v.z & 0xffff0000u); qv[ks][6] = __uint_as_float(v.w << 16); qv[ks][7] = __uint_as_float(v.w & 0xffff0000u);
#pragma unroll
              for (int j = 0; j < 8; ++j) ss += qv[ks][j] * qv[ks][j]; }
          ss = xor32_sum(ss);
          const float sc = rsqrtf(ss * (1.f / 64.f) + EPS) * (0.125f * 1.4426950408889634f);
          const float* qn = C.inp(18) + l * 64 + 8 * h;
#pragma unroll
          for (int ks = 0; ks < 4; ++ks) { const f32x4 n0 = *(const f32x4*)(qn + 16 * ks), n1 = *(const f32x4*)(qn + 16 * ks + 4);
              u32x4 p; p.x = cvt_pk_bf16(qv[ks][0] * sc * n0[0], qv[ks][1] * sc * n0[1]); p.y = cvt_pk_bf16(qv[ks][2] * sc * n0[2], qv[ks][3] * sc * n0[3]);
              p.z = cvt_pk_bf16(qv[ks][4] * sc * n1[0], qv[ks][5] * sc * n1[1]); p.w = cvt_pk_bf16(qv[ks][6] * sc * n1[2], qv[ks][7] * sc * n1[3]);
              qf[ks] = __builtin_bit_cast(bf16x8, p); } }
        f32x16 o0, o1;
#pragma unroll
        for (int i = 0; i < 16; ++i) { o0[i] = 0.f; o1[i] = 0.f; }
        float mrun = -1e30f, lrun = 0.f;
        AT_WAIT_V(0);
        AT_DMA(0, 0);
        for (int t = 0; t < ntiles; ++t) {
            const int slot = t & 1;
            if (t + 1 < ntiles) { AT_DMA(t + 1, slot ^ 1); AT_WAIT_V(4); } else { AT_WAIT_V(0); }
            AT_BAR();
            const LAS unsigned char* Kt = L + AT_RING + slot * 32768; const LAS unsigned char* Vt = Kt + 16384;
            f32x16 s0, s1;
#pragma unroll
            for (int i = 0; i < 16; ++i) { s0[i] = 0.f; s1[i] = 0.f; }
#pragma unroll
            for (int ks = 0; ks < 4; ++ks) {
                const int pc = kvh * 8 + 2 * ks + h;
                const bf16x8 k0 = *(const LAS bf16x8*)(Kt + r * 256 + ((pc ^ (r & 15)) << 4));
                const bf16x8 k1 = *(const LAS bf16x8*)(Kt + (32 + r) * 256 + ((pc ^ (r & 15)) << 4));
                s0 = MFMA32(k0, qf[ks], s0); s1 = MFMA32(k1, qf[ks], s1);
            }
            const unsigned m0 = MASK[65 * q + 2 * t] >> (4 * h), m1 = MASK[65 * q + 2 * t + 1] >> (4 * h);
            const bool nearb = (t + 3 > ntiles - 1);
            float tmax = -1e30f;
#pragma unroll
            for (int i = 0; i < 16; ++i) {
                const int kl = (i & 3) + 8 * (i >> 2);
                float b0 = cfar, b1 = cfar;
                if (nearb) { const int rel = 64 * t + kl + 4 * h - (pos0 + q); b0 = lut[rel + 191]; b1 = lut[rel + 32 + 191]; }
                s0[i] += b0; s1[i] += b1;
                if ((m0 >> kl) & 1u) tmax = fmaxf(tmax, s0[i]);
                if ((m1 >> kl) & 1u) tmax = fmaxf(tmax, s1[i]);
            }
            tmax = xor32_max(tmax);
            const float mnew = fmaxf(mrun, tmax), alpha = __builtin_amdgcn_exp2f(mrun - mnew);
            mrun = mnew;
            float psum = 0.f;
#pragma unroll
            for (int i = 0; i < 16; ++i) {
                const int kl = (i & 3) + 8 * (i >> 2);
                const float p0 = ((m0 >> kl) & 1u) ? __builtin_amdgcn_exp2f(s0[i] - mnew) : 0.f, p1 = ((m1 >> kl) & 1u) ? __builtin_amdgcn_exp2f(s1[i] - mnew) : 0.f;
                s0[i] = p0; s1[i] = p1; psum += p0 + p1;
            }
            lrun = lrun * alpha + psum;
#pragma unroll
            for (int i = 0; i < 16; ++i) { o0[i] *= alpha; o1[i] *= alpha; }
#pragma unroll
            for (int kk = 0; kk < 4; ++kk) {
                u32x4 pw;
                if (kk == 0) { pw.x = cvt_pk_bf16(s0[0], s0[1]); pw.y = cvt_pk_bf16(s0[2], s0[3]); pw.z = cvt_pk_bf16(s0[4], s0[5]); pw.w = cvt_pk_bf16(s0[6], s0[7]); }
                else if (kk == 1) { pw.x = cvt_pk_bf16(s0[8], s0[9]); pw.y = cvt_pk_bf16(s0[10], s0[11]); pw.z = cvt_pk_bf16(s0[12], s0[13]); pw.w = cvt_pk_bf16(s0[14], s0[15]); }
                else if (kk == 2) { pw.x = cvt_pk_bf16(s1[0], s1[1]); pw.y = cvt_pk_bf16(s1[2], s1[3]); pw.z = cvt_pk_bf16(s1[4], s1[5]); pw.w = cvt_pk_bf16(s1[6], s1[7]); }
                else { pw.x = cvt_pk_bf16(s1[8], s1[9]); pw.y = cvt_pk_bf16(s1[10], s1[11]); pw.z = cvt_pk_bf16(s1[12], s1[13]); pw.w = cvt_pk_bf16(s1[14], s1[15]); }
                const bf16x8 pb = __builtin_bit_cast(bf16x8, pw);
                const int i16 = lane & 15, key0 = 16 * kk + 4 * h + (i16 >> 2);
#pragma unroll
                for (int dh = 0; dh < 2; ++dh) {
                    const int dcol = kvh * 64 + 32 * dh + 16 * ((lane >> 4) & 1) + 4 * (i16 & 3);
                    const v4i16_t lo = __builtin_amdgcn_ds_read_tr16_b64_v4i16((LAS v4i16_t*)(Vt + key0 * 256 + dcol * 2));
                    const v4i16_t hi = __builtin_amdgcn_ds_read_tr16_b64_v4i16((LAS v4i16_t*)(Vt + (key0 + 8) * 256 + dcol * 2));
                    const bf16x8 va = (bf16x8){lo[0], lo[1], lo[2], lo[3], hi[0], hi[1], hi[2], hi[3]};
                    if (dh == 0) o0 = MFMA32(va, pb, o0); else o1 = MFMA32(va, pb, o1);
                }
            }
            AT_BAR();
        }
        lrun = xor32_sum(lrun);
        const float inv = 1.f / lrun;
        bf16_t* gp = PJ + (size_t)qrow * PJW + C_GA + hq * 64 + 4 * h;
#pragma unroll
        for (int dh = 0; dh < 2; ++dh)
#pragma unroll
            for (int gq = 0; gq < 4; ++gq) {
                const u32x2 gg = *(const u32x2*)(gp + 32 * dh + 8 * gq);
                const float g0 = __uint_as_float(gg.x << 16), g1 = __uint_as_float(gg.x & 0xffff0000u), g2 = __uint_as_float(gg.y << 16), g3 = __uint_as_float(gg.y & 0xffff0000u);
                const float a0 = (dh == 0 ? o0[4 * gq] : o1[4 * gq]) * inv, a1 = (dh == 0 ? o0[4 * gq + 1] : o1[4 * gq + 1]) * inv, a2 = (dh == 0 ? o0[4 * gq + 2] : o1[4 * gq + 2]) * inv, a3 = (dh == 0 ? o0[4 * gq + 3] : o1[4 * gq + 3]) * inv;
                u32x2 w; w.x = cvt_pk_bf16(a0 * fast_silu(g0), a1 * fast_silu(g1)); w.y = cvt_pk_bf16(a2 * fast_silu(g2), a3 * fast_silu(g3));
                *(u32x2*)(gp + 32 * dh + 8 * gq) = w;
            }
    }
#undef AT_DMA
    AT_WAIT_V(0);
    __syncthreads();
}

constexpr int LR_RAW = 0;
constexpr int LR_GL = LR_RAW + 67 * 128;
constexpr int LR_XC = LR_GL + 2 * 8192;
constexpr int LR_XCF = LR_XC + 64 * 144;
constexpr int LR_SEG = LR_XCF + 64 * 256;
constexpr int LR_YS = LR_SEG + 2048;
constexpr int LR_END = LR_YS + 8192;
static_assert(LR_END <= LDS_BYTES - 256, "LRU LDS map");
typedef float f32x4v __attribute__((ext_vector_type(4)));
#define MFMA16(a, b, c) __builtin_amdgcn_mfma_f32_16x16x32_bf16((a), (b), (c), 0, 0, 0)
DI float fast_sigmoid(float x) { return __builtin_amdgcn_rcpf(1.f + __builtin_amdgcn_exp2f(-1.4426950408889634f * x)); }

DI void lru_item(const Ctx& C, int l, int sb, int blk) {
    const int tid = C.tid, lane = C.lane, wave = C.wave, fr = lane & 15, fq = lane >> 4;
    const int T = sb_T(sb), row0 = sb_row0(sb), NC = T / 64;
    LAS unsigned char* L = C.lds;
    bf16_t* PJ = C.proj();
    const int ts = wave >> 1, dh = wave & 1;
    bf16x8 wf[2][2][2];
#pragma unroll
    for (int gt = 0; gt < 2; ++gt)
#pragma unroll
        for (int db = 0; db < 2; ++db)
#pragma unroll
            for (int kb = 0; kb < 2; ++kb) {
                const float* wp = (gt == 0 ? C.inp(13) : C.inp(15)) + ((size_t)(l * 8 + blk) * 64 + 32 * kb + 8 * fq) * 64 + 32 * dh + 16 * db + fr;
                u32x4 p; p.x = cvt_pk_bf16(wp[0], wp[64]); p.y = cvt_pk_bf16(wp[128], wp[192]); p.z = cvt_pk_bf16(wp[256], wp[320]); p.w = cvt_pk_bf16(wp[384], wp[448]);
                wf[gt][db][kb] = __builtin_bit_cast(bf16x8, p);
            }
    float ba[2], bx[2], spl[2], hc[2];
#pragma unroll
    for (int db = 0; db < 2; ++db) {
        const int ch = blk * 64 + 32 * dh + 16 * db + fr;
        ba[db] = C.inp(14)[l * 512 + ch]; bx[db] = C.inp(16)[l * 512 + ch]; spl[db] = 8.f * 1.4426950408889634f * softplus_f(-C.inp(17)[l * 512 + ch]);
        hc[db] = (sb >= NPB) ? C.inp(6)[(size_t)(l * NSB_S + sb - NPB) * 512 + ch] : 0.f;
    }
    const int cp = tid & 31, sg = tid >> 5;
    float cw[2][5];
#pragma unroll
    for (int e = 0; e < 2; ++e) { const int ch = blk * 64 + 2 * cp + e;
#pragma unroll
        for (int j = 0; j < 4; ++j) cw[e][j] = C.inp(11)[((size_t)l * 4 + j) * 512 + ch];
        cw[e][4] = C.inp(12)[l * 512 + ch]; }
#define LRU_DMA(cc) do { const int t0_ = 64 * (cc); \
        for (int k_ = wave; k_ < 9; k_ += NWAVES) { const int q_ = 64 * k_ + lane, rr_ = q_ >> 3, pc_ = q_ & 7, t_ = t0_ - 3 + rr_; \
            if (q_ < 536 && t_ >= 0) __builtin_amdgcn_global_load_lds((const unsigned*)(PJ + (size_t)(row0 + t_) * PJW + C_XL + blk * 64 + 8 * pc_), (LAS unsigned*)(L + LR_RAW + k_ * 1024), 16, 0, 0); } \
        { const int rr_ = 8 * wave + (lane >> 3), pc_ = lane & 7; \
          __builtin_amdgcn_global_load_lds((const unsigned*)(PJ + (size_t)(row0 + t0_ + rr_) * PJW + C_GL + blk * 64 + 8 * pc_), (LAS unsigned*)(L + LR_GL + ((cc) & 1) * 8192 + wave * 1024), 16, 0, 0); } \
    } while (0)
    if (tid < 24) {
        const int rr = tid >> 3, pc = tid & 7; u32x4 v = (u32x4){0u, 0u, 0u, 0u};
        if (sb >= NPB) { const float* st = C.inp(5) + ((size_t)(l * NSB_S + sb - NPB) * 3 + rr) * 512 + blk * 64 + 8 * pc; v = pack8(*(const f32x4*)st, *(const f32x4*)(st + 4)); }
        *(LAS u32x4*)(L + LR_RAW + rr * 128 + pc * 16) = v;
    }
    LRU_DMA(0);
    asm volatile("s_waitcnt vmcnt(0)" ::: "memory");
    __syncthreads();
    for (int c = 0; c < NC; ++c) {
        const int t0 = 64 * c;
        {
            float xa[7], xb[7];
#pragma unroll
            for (int i = 0; i < 7; ++i) { const unsigned w = *(const LAS unsigned*)(L + LR_RAW + (4 * sg + i) * 128 + 4 * cp); xa[i] = __uint_as_float(w << 16); xb[i] = __uint_as_float(w & 0xffff0000u); }
#pragma unroll
            for (int j = 0; j < 4; ++j) {
                const float ya = cw[0][4] + cw[0][0] * xa[j] + cw[0][1] * xa[j + 1] + cw[0][2] * xa[j + 2] + cw[0][3] * xa[j + 3];
                const float yb = cw[1][4] + cw[1][0] * xb[j] + cw[1][1] * xb[j + 1] + cw[1][2] * xb[j + 2] + cw[1][3] * xb[j + 3];
                *(LAS unsigned*)(L + LR_XC + (4 * sg + j) * 144 + 4 * cp) = cvt_pk_bf16(ya, yb);
                f32x2_t v2 = {ya, yb}; *(LAS f32x2_t*)(L + LR_XCF + (4 * sg + j) * 256 + 8 * cp) = v2;
            }
        }
        LDS_FENCE(); __syncthreads();
        if (c + 1 < NC) LRU_DMA(c + 1);
        f32x4v ga[2], gx[2];
#pragma unroll
        for (int db = 0; db < 2; ++db) { ga[db] = (f32x4v){0.f, 0.f, 0.f, 0.f}; gx[db] = (f32x4v){0.f, 0.f, 0.f, 0.f}; }
#pragma unroll
        for (int kb = 0; kb < 2; ++kb) {
            const bf16x8 af = *(const LAS bf16x8*)(L + LR_XC + (16 * ts + fr) * 144 + (32 * kb + 8 * fq) * 2);
#pragma unroll
            for (int db = 0; db < 2; ++db) { ga[db] = MFMA16(af, wf[0][db][kb], ga[db]); gx[db] = MFMA16(af, wf[1][db][kb], gx[db]); }
        }
        float Pk[2][4], Hk[2][4], Pq[2], Hq[2];
#pragma unroll
        for (int db = 0; db < 2; ++db) {
            float P = 1.f, H = 0.f;
#pragma unroll
            for (int reg = 0; reg < 4; ++reg) {
                const float xc = *(const LAS float*)(L + LR_XCF + (16 * ts + 4 * fq + reg) * 256 + (32 * dh + 16 * db + fr) * 4);
                const float rg = fast_sigmoid(ga[db][reg] + ba[db]), ig = fast_sigmoid(gx[db][reg] + bx[db]);
                const float a = __builtin_amdgcn_exp2f(-rg * spl[db]);
                const float b = sqrtf(fmaxf(1.f - a * a, 0.f)) * (ig * xc);
                H = a * H + b; P = a * P; Pk[db][reg] = P; Hk[db][reg] = H;
            }
            float Pi = P, Hi = H;
            { const float Pp = bperm(Pi, lane - 16), Hp = bperm(Hi, lane - 16); if (fq >= 1) { Hi = Pi * Hp + Hi; Pi = Pi * Pp; } }
            { const float Pp = bperm(Pi, lane - 32), Hp = bperm(Hi, lane - 32); if (fq >= 2) { Hi = Pi * Hp + Hi; Pi = Pi * Pp; } }
            if (fq == 3) { f32x2_t v2 = {Pi, Hi}; *(LAS f32x2_t*)(L + LR_SEG + (ts * 64 + 32 * dh + 16 * db + fr) * 8) = v2; }
            const float Pe = bperm(Pi, lane - 16), He = bperm(Hi, lane - 16);
            Pq[db] = (fq >= 1) ? Pe : 1.f; Hq[db] = (fq >= 1) ? He : 0.f;
        }
        LDS_FENCE(); __syncthreads();
#pragma unroll
        for (int db = 0; db < 2; ++db) {
            float s = hc[db], sin = hc[db];
#pragma unroll
            for (int k = 0; k < 4; ++k) { const f32x2_t m = *(const LAS f32x2_t*)(L + LR_SEG + (k * 64 + 32 * dh + 16 * db + fr) * 8); if (k == ts) sin = s; s = m[0] * s + m[1]; }
            hc[db] = s;
            const float hin = Pq[db] * sin + Hq[db];
            const bf16_t* glp = nullptr; (void)glp;
#pragma unroll
            for (int reg = 0; reg < 4; ++reg) {
                const float hval = Pk[db][reg] * hin + Hk[db][reg];
                const int t = 16 * ts + 4 * fq + reg, d = 32 * dh + 16 * db + fr;
                const float glv = bf2f(*(const LAS bf16_t*)(L + LR_GL + (c & 1) * 8192 + t * 128 + d * 2));
                *(LAS bf16_t*)(L + LR_YS + t * 128 + d * 2) = f2bf(hval * fast_silu(glv));
            }
        }
        asm volatile("s_waitcnt vmcnt(0)" ::: "memory");
        LDS_FENCE(); __syncthreads();
        { const int rr = tid >> 3, pc = tid & 7;
          *(u32x4*)(PJ + (size_t)(row0 + t0 + rr) * PJW + C_GL + blk * 64 + 8 * pc) = *(const LAS u32x4*)(L + LR_YS + rr * 128 + pc * 16); }
    }
    if (ts == 0 && fq == 0) {
#pragma unroll
        for (int db = 0; db < 2; ++db) out_lh(C, l, sb)[blk * 64 + 32 * dh + 16 * db + fr] = hc[db];
    }
#undef LRU_DMA
    asm volatile("s_waitcnt vmcnt(0)" ::: "memory");
    __syncthreads();
}

DI Ctx relaunder(const Ctx& C0) {
    Ctx C = C0; int ln; asm volatile("v_mbcnt_lo_u32_b32 %0, -1, 0\n\tv_mbcnt_hi_u32_b32 %0, -1, %0" : "=v"(ln)); C.lane = ln; C.tid = C.wave * 64 + ln;
    asm volatile("" : "+s"(C.ws), "+s"(C.out)); asm volatile("" : "+s"(C.G), "+s"(C.bid));
    return C;
}
DI void phase_mixers(const Ctx& Cin, int l) {
#if USE_SSD_OPT
    { const Ctx C = relaunder(Cin);
    for (int i = C.bid; i < 384; i += C.G) {
        const int sb = (i < 256) ? (i >> 4) : NPB + ((i - 256) >> 4), hd = i & 15;
        ssd_item(C, l, sb, hd);
    } }
    { const Ctx C = relaunder(Cin);
    for (int i = C.bid; i < 192; i += C.G) {
        const int sb = (i < 128) ? (i >> 3) : NPB + ((i - 128) >> 3), sub = i & 7;
#if USE_LRU_OPT
        lru_item(C, l, sb, sub);
#else
        if (C.wave == 0) lru_item_naive(C, l, sb, sub, C.lds);
#endif
    } }
#else
    const Ctx C = Cin;
    for (int i = C.bid + C.G * C.wave; i < 1728; i += C.G * NWAVES) {
        int kind, sb, sub;
        if (i < 1024) { kind = 0; sb = i >> 6; sub = i & 63; }
        else if (i < 1152) { kind = 1; sb = (i - 1024) >> 3; sub = (i - 1024) & 7; }
        else if (i < 1664) { kind = 0; sb = NPB + ((i - 1152) >> 6); sub = (i - 1152) & 63; }
        else { kind = 1; sb = NPB + ((i - 1664) >> 3); sub = (i - 1664) & 7; }
        if (kind == 0) ssd_item_naive(C, l, sb, sub >> 2, sub & 3);
        else lru_item_naive(C, l, sb, sub, C.lds + C.wave * 16384);
    }
#endif
#if USE_ATTN_OPT
    __syncthreads();
    const Ctx C = relaunder(Cin);
    for (int i = C.bid; i < 520; i += C.G) {
        int sb, qb;
        if (i < 256) { sb = i & 15; qb = 31 - (i >> 4); } else if (i < 512) { sb = i & 15; qb = (i - 256) >> 4; } else { sb = NPB + (i - 512); qb = 0; }
        attn_item(C, l, sb, qb);
    }
#else
    const Ctx C = relaunder(Cin);
    LAS unsigned char* scr = C.lds + C.wave * 16384;
    const int gw = C.bid * NWAVES + C.wave, NGW = C.G * NWAVES;
    for (int m = gw; m < ROWS; m += NGW) attn_item_naive(C, l, m, scr);
#endif
}

constexpr int PH_PER_LAYER = 5;
constexpr int N_PHASES = 1 + 2 * PH_PER_LAYER;
__global__ void __launch_bounds__(NTHREADS, 2) mk_fwd(Args a) {
    extern __shared__ __attribute__((aligned(16))) unsigned char lds_raw[];
    Ctx C; C.out = a.out; C.ws = a.ws; C.lds = (LAS unsigned char*)lds_raw;
    C.tid = threadIdx.x; C.lane = C.tid & 63; C.wave = __builtin_amdgcn_readfirstlane(C.tid >> 6); C.G = gridDim.x; C.bid = blockIdx.x;
    if (C.tid == 0) {
#pragma unroll
        for (int i = 0; i < 28; ++i) ((LAS cfp_t*)(C.lds + LDS_BYTES - 256))[i] = a.in[i];
    }
    __syncthreads();
    const Ctx C0 = C;
#define LAUNDER() Ctx C = C0; { int ln; asm volatile("v_mbcnt_lo_u32_b32 %0, -1, 0\n\tv_mbcnt_hi_u32_b32 %0, -1, %0" : "=v"(ln)); C.lane = ln; C.tid = C.wave * 64 + ln; } \
        asm volatile("" : "+s"(C.ws), "+s"(C.out)); asm volatile("" : "+s"(C.G), "+s"(C.bid))
    for (int ph = a.ph_lo; ph < a.ph_hi; ++ph) {
        if (ph == 0) { LAUNDER(); phase_prologue(C); }
        else {
            const int l = (ph - 1) / PH_PER_LAYER, k = (ph - 1) % PH_PER_LAYER;
            if (k == 0) { LAUNDER(); if (USE_GEMM_IN) phase_inproj_gemm(C, l); else phase_inproj_simple(C, l); }
            else if (k == 1) { if (!USE_SSD_OPT) { LAUNDER(); phase_conv_naive(C, l); } }
            else if (k == 2) { LAUNDER(); phase_mixers(C, l); }
            else if (k == 3) { if (USE_GEMM_OUT) { LAUNDER(); phase_ycnorm(C, l); } }
            else { LAUNDER(); if (USE_GEMM_OUT) phase_outproj_gemm(C, l); else phase_outproj_simple(C, l); }
        }
#if MK_ONE_LAUNCH
        if (ph + 1 < a.ph_hi) cg::this_grid().sync();
#endif
    }
}

extern "C" void kernel_launch(void* const* d_in, const int* in_sizes, int n_in, void* d_out, int out_size, void* d_ws, size_t ws_size, hipStream_t stream) {
    static int grid = 0;
    if (grid == 0) {
        if (n_in != 28 || (size_t)out_size != O_END || ws_size < WS_END) { fprintf(stderr, "kernel_launch: unexpected shapes n_in %d out %d ws %zu\n", n_in, out_size, ws_size); grid = -1; return; }
        int dev = 0, cus = 0, per_cu = 0;
        hipGetDevice(&dev); hipDeviceGetAttribute(&cus, hipDeviceAttributeMultiprocessorCount, dev);
        hipFuncSetAttribute((const void*)mk_fwd, hipFuncAttributeMaxDynamicSharedMemorySize, LDS_BYTES);
        hipOccupancyMaxActiveBlocksPerMultiprocessor(&per_cu, (const void*)mk_fwd, NTHREADS, LDS_BYTES);
        if (per_cu < 1) per_cu = 1;
        grid = cus * 1;
        (void)hipGetLastError();
    }
    if (grid < 0) return;
    hipMemsetAsync((char*)d_ws + WS_CTL, 0, CTL_BYTES, stream);
    Args a{};
    for (int i = 0; i < 28; ++i) a.in[i] = (const float*)d_in[i];
    a.out = (float*)d_out; a.ws = (unsigned char*)d_ws;
#if MK_ONE_LAUNCH
    a.ph_lo = 0; a.ph_hi = N_PHASES;
    void* args[] = {&a};
    hipError_t e = hipLaunchCooperativeKernel((const void*)mk_fwd, dim3(grid), dim3(NTHREADS), args, LDS_BYTES, stream);
    if (e != hipSuccess) fprintf(stderr, "cooperative launch failed: %s (grid %d)\n", hipGetErrorString(e), grid);
#else
    for (int ph = 0; ph < N_PHASES; ++ph) { a.ph_lo = ph; a.ph_hi = ph + 1; hipLaunchKernelGGL(mk_fwd, dim3(grid), dim3(NTHREADS), LDS_BYTES, stream, a); }
#endif
}
```

```cpp
#include <hip/hip_runtime.h>
#include <hip/hip_cooperative_groups.h>
#include <cstdio>
#include <cstdint>
namespace cg = cooperative_groups;

#ifndef ONLY
#define ONLY 0xffff
#endif
#ifndef USE_LRU_OPT
#define USE_LRU_OPT 1
#endif
#ifndef USE_ATTN_OPT
#define USE_ATTN_OPT 1
#endif
#ifndef USE_SSD_OPT
#define USE_SSD_OPT 1
#endif
#ifndef USE_GEMM_IN
#define USE_GEMM_IN 1
#endif
#ifndef USE_GEMM_OUT
#define USE_GEMM_OUT 1
#endif
#ifndef MK_ONE_LAUNCH
#define MK_ONE_LAUNCH 1
#endif

typedef unsigned short bf16_t;
typedef short bf16x8 __attribute__((ext_vector_type(8)));
typedef float f32x4 __attribute__((ext_vector_type(4)));
typedef float f32x16 __attribute__((ext_vector_type(16)));
typedef unsigned u32x4 __attribute__((ext_vector_type(4)));
typedef unsigned u32x2 __attribute__((ext_vector_type(2)));
#define LAS __attribute__((address_space(3)))
#define DI __device__ __forceinline__

constexpr int DM = 1024, NPB = 16, SEQ = 2048, NSB_S = 8, DSEQ = 64, PAST = 1024;
constexpr int ROWS_P = NPB * SEQ;
constexpr int ROWS = ROWS_P + NSB_S * DSEQ;
constexpr int NSB = NPB + NSB_S;
constexpr int DINP = 5204, NPAD = 5376;
constexpr int PJW = 4864;
constexpr int DMIX = 2048;
constexpr float EPS = 1e-6f;
constexpr int C_GL = 0, C_GA = 512, C_Z = 1024, C_XL = 2048, C_Q = 2560, C_QI = 3072, C_XBC = 3328, C_T19 = 4864, C_T20 = 5120;
constexpr int KVW = 320;
constexpr size_t KVB_LAYER = (size_t)NPB * SEQ * KVW + (size_t)NSB_S * (PAST + DSEQ) * KVW;

constexpr size_t O_YP = 0;
constexpr size_t O_YS = O_YP + (size_t)NPB * SEQ * DM;
constexpr size_t O_AKP = O_YS + (size_t)NSB_S * DSEQ * DM;
constexpr size_t O_AVP = O_AKP + (size_t)2 * NPB * SEQ * 128;
constexpr size_t O_IKP = O_AVP + (size_t)2 * NPB * SEQ * 128;
constexpr size_t O_LCP = O_IKP + (size_t)2 * NPB * SEQ * 64;
constexpr size_t O_LHP = O_LCP + (size_t)2 * NPB * 3 * 512;
constexpr size_t O_SCP = O_LHP + (size_t)2 * NPB * 512;
constexpr size_t O_SHP = O_SCP + (size_t)2 * NPB * 3 * 1536;
constexpr size_t O_AKS = O_SHP + (size_t)2 * NPB * 16 * 64 * 128;
constexpr size_t O_AVS = O_AKS + (size_t)2 * NSB_S * DSEQ * 128;
constexpr size_t O_IKS = O_AVS + (size_t)2 * NSB_S * DSEQ * 128;
constexpr size_t O_LCS = O_IKS + (size_t)2 * NSB_S * DSEQ * 64;
constexpr size_t O_LHS = O_LCS + (size_t)2 * NSB_S * 3 * 512;
constexpr size_t O_SCS = O_LHS + (size_t)2 * NSB_S * 512;
constexpr size_t O_SHS = O_SCS + (size_t)2 * NSB_S * 3 * 1536;
constexpr size_t O_END = O_SHS + (size_t)2 * NSB_S * 16 * 64 * 128;

constexpr size_t MiB = 1u << 20;
constexpr size_t WS_CTL = 0, CTL_BYTES = 1 * MiB;
constexpr size_t WS_WIN = 1 * MiB;
constexpr size_t WIN_LAYER = (size_t)NPAD * DM;
constexpr size_t WS_WOUT = 22 * MiB;
constexpr size_t WOUT_LAYER = (size_t)DM * DMIX;
constexpr size_t WS_HB = 30 * MiB;
constexpr size_t WS_RSS = 95 * MiB;
constexpr size_t WS_WI = 98 * MiB;
constexpr size_t WS_DTR = 99 * MiB;
constexpr size_t WS_SSQ = 102 * MiB;
constexpr size_t WS_KVB = 112 * MiB;
constexpr size_t WS_PROJ = 164 * MiB;
constexpr size_t WS_END = WS_PROJ + (size_t)ROWS * PJW * 2;
static_assert(WS_KVB + 2 * KVB_LAYER * 2 <= WS_PROJ, "ws map");
static_assert(WS_END <= 512 * MiB, "ws map");

constexpr int NTHREADS = 512, NWAVES = 8;
constexpr int LDS_BYTES = 163840;

DI float bf2f(bf16_t v) { return __uint_as_float(((unsigned)v) << 16); }
DI bf16_t f2bf(float f) { unsigned u = __float_as_uint(f); return (bf16_t)((u + 0x7fffu + ((u >> 16) & 1u)) >> 16); }
DI unsigned pk2(float lo, float hi) { return (unsigned)f2bf(lo) | ((unsigned)f2bf(hi) << 16); }
DI int crow(int reg, int h) { return (reg & 3) + 8 * (reg >> 2) + 4 * h; }
template <int O> DI float swz_xor(float v) { return __int_as_float(__builtin_amdgcn_ds_swizzle(__float_as_int(v), (O << 10) | 0x1f)); }
DI float xor32_sum(float v) { auto rr = __builtin_amdgcn_permlane32_swap(__float_as_uint(v), __float_as_uint(v), false, false); return __uint_as_float(rr[0]) + __uint_as_float(rr[1]); }
DI float xor32_max(float v) { auto rr = __builtin_amdgcn_permlane32_swap(__float_as_uint(v), __float_as_uint(v), false, false); return fmaxf(__uint_as_float(rr[0]), __uint_as_float(rr[1])); }
DI float half_sum32(float v) {
    v += swz_xor<1>(v); v += swz_xor<2>(v); v += swz_xor<4>(v); v += swz_xor<8>(v); v += swz_xor<16>(v); return v;
}
DI float wave_sum(float v) { return xor32_sum(half_sum32(v)); }
DI float wave_max(float v) {
    v = fmaxf(v, swz_xor<1>(v)); v = fmaxf(v, swz_xor<2>(v)); v = fmaxf(v, swz_xor<4>(v)); v = fmaxf(v, swz_xor<8>(v)); v = fmaxf(v, swz_xor<16>(v)); return xor32_max(v);
}
DI float sum_fq(float v) { return xor32_sum(v + swz_xor<16>(v)); }
DI float bperm(float v, int srclane) { return __int_as_float(__builtin_amdgcn_ds_bpermute(srclane << 2, __float_as_int(v))); }
DI float silu_f(float x) { return x / (1.f + expf(-x)); }
DI float sigmoid_f(float x) { return 1.f / (1.f + expf(-x)); }
DI float softplus_f(float x) { return x > 20.f ? x : log1pf(expf(x)); }
#define LDS_FENCE() asm volatile("s_waitcnt lgkmcnt(0)" ::: "memory")

__host__ __device__ inline int orig_col(int c) {
    if (c < 512) return 512 + c;
    if (c < 1024) return 1792 + (c - 512);
    if (c < 2048) return 2628 + (c - 1024);
    if (c < 2560) return c - 2048;
    if (c < 3072) return 1024 + (c - 2560);
    if (c < 3328) return 2304 + (c - 3072);
    if (c < 4864) return 3652 + (c - 3328);
    if (c < 5120) { const int cl = c - 4864, bj = cl >> 7, wc = (cl >> 5) & 3, j = cl & 31, d = 32 * bj + j; return (wc < 2 ? 1536 : 1664) + (wc & 1) * 64 + d; }
    const int cl = c - 5120;
    if (cl < 64) return 2560 + cl;
    if (cl < 68) return 2624 + (cl - 64);
    if (cl < 84) return 5188 + (cl - 68);
    return -1;
}
DI int sb_T(int sb) { return sb < NPB ? SEQ : DSEQ; }
DI int sb_P(int sb) { return sb < NPB ? 0 : PAST; }
DI int sb_row0(int sb) { return sb < NPB ? sb * SEQ : ROWS_P + (sb - NPB) * DSEQ; }
DI size_t kvb_off(int sb) { return sb < NPB ? (size_t)sb * SEQ * KVW : (size_t)NPB * SEQ * KVW + (size_t)(sb - NPB) * (PAST + DSEQ) * KVW; }
DI void row_sbt(int m, int& sb, int& t) { if (m < ROWS_P) { sb = m >> 11; t = m & 2047; } else { const int r = m - ROWS_P; sb = NPB + (r >> 6); t = r & 63; } }

typedef const float* cfp_t;
struct Args { const float* in[28]; float* out; unsigned char* ws; int ph_lo, ph_hi; };

struct Ctx {
    float* out; unsigned char* ws;
    LAS unsigned char* lds;
    DI const float* inp(int k) const { return ((LAS cfp_t*)(lds + LDS_BYTES - 256))[k]; }
    int tid, lane, wave, G, bid;
    DI bf16_t* win(int l) const { return (bf16_t*)(ws + WS_WIN) + (size_t)l * WIN_LAYER; }
    DI bf16_t* wout(int l) const { return (bf16_t*)(ws + WS_WOUT) + (size_t)l * WOUT_LAYER; }
    DI bf16_t* hb() const { return (bf16_t*)(ws + WS_HB); }
    DI float* rss() const { return (float*)(ws + WS_RSS); }
    DI float* wi() const { return (float*)(ws + WS_WI); }
    DI float* dtr() const { return (float*)(ws + WS_DTR); }
    DI float* ssq() const { return (float*)(ws + WS_SSQ); }
    DI bf16_t* kvb(int l) const { return (bf16_t*)(ws + WS_KVB) + (size_t)l * KVB_LAYER; }
    DI bf16_t* proj() const { return (bf16_t*)(ws + WS_PROJ); }
};
DI float* out_ak(const Ctx& C, int l, int sb) { return sb < NPB ? C.out + O_AKP + ((size_t)(l * NPB + sb) * SEQ) * 128 : C.out + O_AKS + ((size_t)(l * NSB_S + sb - NPB) * DSEQ) * 128; }
DI float* out_av(const Ctx& C, int l, int sb) { return sb < NPB ? C.out + O_AVP + ((size_t)(l * NPB + sb) * SEQ) * 128 : C.out + O_AVS + ((size_t)(l * NSB_S + sb - NPB) * DSEQ) * 128; }
DI float* out_ik(const Ctx& C, int l, int sb) { return sb < NPB ? C.out + O_IKP + ((size_t)(l * NPB + sb) * SEQ) * 64 : C.out + O_IKS + ((size_t)(l * NSB_S + sb - NPB) * DSEQ) * 64; }
DI float* out_lc(const Ctx& C, int l, int sb) { return sb < NPB ? C.out + O_LCP + (size_t)(l * NPB + sb) * 3 * 512 : C.out + O_LCS + (size_t)(l * NSB_S + sb - NPB) * 3 * 512; }
DI float* out_lh(const Ctx& C, int l, int sb) { return sb < NPB ? C.out + O_LHP + (size_t)(l * NPB + sb) * 512 : C.out + O_LHS + (size_t)(l * NSB_S + sb - NPB) * 512; }
DI float* out_sc(const Ctx& C, int l, int sb) { return sb < NPB ? C.out + O_SCP + (size_t)(l * NPB + sb) * 3 * 1536 : C.out + O_SCS + (size_t)(l * NSB_S + sb - NPB) * 3 * 1536; }
DI float* out_sh(const Ctx& C, int l, int sb) { return sb < NPB ? C.out + O_SHP + (size_t)(l * NPB + sb) * 16 * 64 * 128 : C.out + O_SHS + (size_t)(l * NSB_S + sb - NPB) * 16 * 64 * 128; }

#ifdef PROBE_SUB
#define PROBE_BEGIN(id) unsigned long long pb_##id = __builtin_amdgcn_s_memrealtime()
#define PROBE_END(id, Cx) do { if ((id) == PROBE_SUB && (Cx).tid == 0) *(LAS unsigned long long*)((Cx).lds + LDS_BYTES - 16) += __builtin_amdgcn_s_memrealtime() - pb_##id; } while (0)
#else
#define PROBE_BEGIN(id) do {} while (0)
#define PROBE_END(id, Cx) do {} while (0)
#endif
namespace pg8 {
#define PG8_LAS __attribute__((address_space(3)))
constexpr int BM = 256, BK = 64, HALF = 128, HTB = HALF * BK * 2  , STAGE_BYTES = 8 * HTB, NXCD = 8, WGM = 8;

__host__ __device__ __forceinline__ int lds_byte(int r, int c) { const int st = (r >> 4) * 2 + (c >> 5), rr = r & 15, cc = c & 31, ob = rr * 64 + cc * 2; return st * 1024 + (ob ^ (((ob >> 9) & 1) << 5)); }
__host__ __device__ __forceinline__ void stage_rc(int b, int& R, int& C) { const int st = b / 1024, sb = b % 1024, swz = sb ^ (((sb >> 9) & 1) << 5); R = (st >> 1) * 16 + swz / 64; C = (st & 1) * 32 + (swz % 64) / 2; }
__host__ __device__ __forceinline__ int perm32(int rho) { const int n = rho >> 4, i = rho & 15; return 8 * (i >> 2) + 4 * n + (i & 3); }

struct Unit { int pm, pn; };
struct Gemm { const bf16_t* A; const bf16_t* Bt; int M, N, K, lda; };

struct StaticOrder {
    int nM, nN, nwg, G, c;
    __host__ __device__ void init(int M, int N, int G_, int c_) { nM = M / BM; nN = N / BM; nwg = nM * nN; G = G_; c = c_; }
    __host__ __device__ bool next(int i, Unit& u) const {
        const long L = (long)i * G + c; if (L >= nwg) return false;
        int wgid = (int)L; { const int q = nwg / NXCD, r = nwg % NXCD, xcd = wgid % NXCD, off = wgid / NXCD; wgid = (xcd < r ? xcd * (q + 1) : r * (q + 1) + (xcd - r) * q) + off; }
        const int nig = WGM * nN, gid = wgid / nig, fm = gid * WGM, gsz = (nM - fm) < WGM ? (nM - fm) : WGM;
        u.pm = fm + ((wgid % nig) % gsz); u.pn = (wgid % nig) / gsz; return true;
    }
    __device__ __forceinline__ void a_ready(const Unit&) const {}
    __device__ __forceinline__ void done(const Unit&) const {}
};

template <class Epi, class Sched, bool ALIGN_EPI = false, bool SP2 = false>
__device__ __forceinline__ void gemm_phase(PG8_LAS unsigned char* lds, const Gemm g, const Sched& S, const Epi& E, const int tid) {
    const int wid = __builtin_amdgcn_readfirstlane(tid >> 6), lane = tid & 63, wr = wid >> 2, wc = wid & 3, fr = lane & 15, fq = lane >> 4;
    const int K = g.K, nt = K / BK;
    unsigned voffA[2], voffB[2];
#pragma unroll
    for (int i = 0; i < 2; ++i) { int R, C; stage_rc(tid * 16 + i * 8192, R, C); const int Rb = Epi::PERM ? ((R & ~31) + perm32(R & 31)) : R;
        voffA[i] = (unsigned)(R * g.lda + C) * 2u; voffB[i] = (unsigned)(Rb * K + C) * 2u; }
    const size_t kstep = (size_t)(BK * 2);
    const size_t hstepA = (size_t)HALF * g.lda * 2, hstepB = (size_t)HALF * K * 2;
    const size_t tstepA = 2 * hstepA, tstepB = 2 * hstepB;
    const unsigned ldsw = (unsigned)wid * 1024u;
    const int aoff = lds_byte(wr * 64 + fr, fq * 8), boff = lds_byte(wc * 32 + fr, fq * 8);
#define PG8_SA(b, h) (((b) * 2 + (h)) * HTB)
#define PG8_SB(b, h) ((4 + (b) * 2 + (h)) * HTB)
#define PG8_STAGE(bufoff, gbase, voff) do { _Pragma("unroll") for (int _i = 0; _i < 2; ++_i) \
        __builtin_amdgcn_global_load_lds((const unsigned*)((const char*)(gbase) + (voff)[_i]), (PG8_LAS unsigned*)(lds + (bufoff) + ldsw + _i * 8192), 16, 0, 0); } while (0)
#define PG8_LDA(dst, b, h) do { _Pragma("unroll") for (int m = 0; m < 4; ++m) _Pragma("unroll") for (int k = 0; k < 2; ++k) dst[m][k] = *(const PG8_LAS bf16x8*)(lds + PG8_SA(b, h) + aoff + m * 2048 + k * 1024); } while (0)
#define PG8_LDB(dst, b, h) do { _Pragma("unroll") for (int n = 0; n < 2; ++n) _Pragma("unroll") for (int k = 0; k < 2; ++k) dst[n][k] = *(const PG8_LAS bf16x8*)(lds + PG8_SB(b, h) + boff + n * 2048 + k * 1024); } while (0)
#define PG8_MMA(ai, bj, At, Bt) do { __builtin_amdgcn_s_setprio(1); _Pragma("unroll") for (int m = 0; m < 4; ++m) _Pragma("unroll") for (int n = 0; n < 2; ++n) _Pragma("unroll") for (int k = 0; k < 2; ++k) \
        acc[ai][bj][m][n] = __builtin_amdgcn_mfma_f32_16x16x32_bf16(Bt[n][k], At[m][k], acc[ai][bj][m][n], 0, 0, 0); __builtin_amdgcn_s_setprio(0); } while (0)
#define PG8_WAIT_V(n) asm volatile("s_waitcnt vmcnt(" #n ")" ::: "memory")
#define PG8_WAIT_L(n) asm volatile("s_waitcnt lgkmcnt(" #n ")" ::: "memory")
#define PG8_BAR __builtin_amdgcn_s_barrier()
#define PG8_SCHED __builtin_amdgcn_sched_barrier(0)
    Unit cur, nxt; int ui = 0;
    if (!S.next(0, cur)) return;
    f32x4 acc[2][2][4][2];
#pragma unroll
    for (int a = 0; a < 2; ++a)
#pragma unroll
        for (int b = 0; b < 2; ++b)
#pragma unroll
            for (int m = 0; m < 4; ++m)
#pragma unroll
                for (int n = 0; n < 2; ++n) acc[a][b][m][n] = (f32x4){0.f, 0.f, 0.f, 0.f};
    bf16x8 At[4][2], B0[2][2], B1[2][2];
    const char* cA = (const char*)g.A + (size_t)cur.pm * tstepA; const char* cB = (const char*)g.Bt + (size_t)cur.pn * tstepB;
    S.a_ready(cur);
    if constexpr (SP2) {
        PG8_STAGE(PG8_SB(0, 0), cB, voffB); PG8_STAGE(PG8_SB(0, 1), cB + hstepB, voffB); PG8_STAGE(PG8_SA(0, 0), cA, voffA); PG8_STAGE(PG8_SA(0, 1), cA + hstepA, voffA);
        if (wr == 1) PG8_BAR;
        PG8_WAIT_V(2); PG8_BAR;
        PG8_STAGE(PG8_SB(1, 0), cB + kstep, voffB); PG8_STAGE(PG8_SA(1, 0), cA + kstep, voffA); PG8_STAGE(PG8_SB(1, 1), cB + hstepB + kstep, voffB);
        PG8_WAIT_V(6); PG8_BAR;
    } else {
        PG8_STAGE(PG8_SB(0, 0), cB, voffB); PG8_STAGE(PG8_SA(0, 0), cA, voffA); PG8_STAGE(PG8_SB(0, 1), cB + hstepB, voffB); PG8_STAGE(PG8_SA(0, 1), cA + hstepA, voffA);
        if (wr == 1) PG8_BAR;
        PG8_WAIT_V(4); PG8_BAR;
        PG8_STAGE(PG8_SB(1, 0), cB + kstep, voffB); PG8_STAGE(PG8_SA(1, 0), cA + kstep, voffA); PG8_STAGE(PG8_SB(1, 1), cB + hstepB + kstep, voffB);
        PG8_WAIT_V(6); PG8_BAR;
    }
    for (;;) {
        const bool has_next = S.next(ui + 1, nxt);
        const char* nA = has_next ? (const char*)g.A + (size_t)nxt.pm * tstepA : cA; const char* nB = has_next ? (const char*)g.Bt + (size_t)nxt.pn * tstepB : cB;
        for (int t = 0; t < nt; t += 2) {
            const bool last = (t == nt - 2);
            const char* a1 = cA + (size_t)(t + 1) * kstep;
            const char* a2 = last ? nA : cA + (size_t)(t + 2) * kstep; const char* b2 = last ? nB : cB + (size_t)(t + 2) * kstep;
            const char* a3 = a2 + kstep; const char* b3 = b2 + kstep;
            if (last && has_next) S.a_ready(nxt);
            if constexpr (SP2) {
            PG8_LDB(B0, 0, 0); PG8_LDB(B1, 0, 1); PG8_SCHED; PG8_LDA(At, 0, 0); PG8_STAGE(PG8_SA(1, 1), a1 + hstepA, voffA);
            PG8_WAIT_V(8); PG8_WAIT_L(0); PG8_BAR; PG8_MMA(0, 0, At, B0); PG8_MMA(0, 1, At, B1); PG8_BAR; PG8_SCHED;
            PG8_LDA(At, 0, 1); PG8_STAGE(PG8_SB(0, 0), b2, voffB); PG8_STAGE(PG8_SB(0, 1), b2 + hstepB, voffB); PG8_STAGE(PG8_SA(0, 0), a2, voffA);
            PG8_WAIT_V(8); PG8_WAIT_L(0); PG8_BAR; PG8_MMA(1, 0, At, B0); PG8_MMA(1, 1, At, B1); PG8_BAR; PG8_SCHED;
            PG8_LDB(B0, 1, 0); PG8_LDB(B1, 1, 1); PG8_SCHED; PG8_LDA(At, 1, 0); PG8_STAGE(PG8_SA(0, 1), a2 + hstepA, voffA);
            PG8_WAIT_V(8); PG8_WAIT_L(0); PG8_BAR; PG8_MMA(0, 0, At, B0); PG8_MMA(0, 1, At, B1); PG8_BAR; PG8_SCHED;
            PG8_LDA(At, 1, 1); PG8_STAGE(PG8_SB(1, 0), b3, voffB); PG8_STAGE(PG8_SB(1, 1), b3 + hstepB, voffB); PG8_STAGE(PG8_SA(1, 0), a3, voffA);
            PG8_WAIT_V(8); PG8_WAIT_L(0); PG8_BAR; PG8_MMA(1, 0, At, B0); PG8_MMA(1, 1, At, B1); PG8_BAR; PG8_SCHED;
            } else {
            PG8_LDB(B0, 0, 0); PG8_SCHED; PG8_LDA(At, 0, 0); PG8_STAGE(PG8_SA(1, 1), a1 + hstepA, voffA);
            PG8_WAIT_L(8); PG8_BAR; PG8_WAIT_L(0); PG8_MMA(0, 0, At, B0); PG8_BAR; PG8_SCHED;
            PG8_LDB(B1, 0, 1); PG8_STAGE(PG8_SB(0, 0), b2, voffB);
            PG8_BAR; PG8_WAIT_L(0); PG8_MMA(0, 1, At, B1); PG8_BAR;
            PG8_LDA(At, 0, 1); PG8_STAGE(PG8_SA(0, 0), a2, voffA);
            PG8_BAR; PG8_WAIT_L(0); PG8_MMA(1, 0, At, B0); PG8_BAR; PG8_SCHED;
            PG8_STAGE(PG8_SB(0, 1), b2 + hstepB, voffB);
            PG8_WAIT_V(6); PG8_BAR; PG8_MMA(1, 1, At, B1); PG8_BAR;
            PG8_LDB(B0, 1, 0); PG8_SCHED; PG8_LDA(At, 1, 0); PG8_STAGE(PG8_SA(0, 1), a2 + hstepA, voffA);
            PG8_WAIT_L(8); PG8_BAR; PG8_WAIT_L(0); PG8_MMA(0, 0, At, B0); PG8_BAR; PG8_SCHED;
            PG8_LDB(B1, 1, 1); PG8_STAGE(PG8_SB(1, 0), b3, voffB);
            PG8_BAR; PG8_WAIT_L(0); PG8_MMA(0, 1, At, B1); PG8_BAR;
            PG8_LDA(At, 1, 1); PG8_STAGE(PG8_SA(1, 0), a3, voffA);
            PG8_BAR; PG8_WAIT_L(0); PG8_MMA(1, 0, At, B0); PG8_BAR; PG8_SCHED;
            PG8_STAGE(PG8_SB(1, 1), b3 + hstepB, voffB);
            PG8_WAIT_V(6); PG8_BAR; PG8_MMA(1, 1, At, B1); PG8_BAR;
            }
        }
        if constexpr (ALIGN_EPI) { if (wr == 0) PG8_BAR; }
        if constexpr (!Epi::AFTER_DRAIN) { E(acc, cur, wr, wc, fr, fq); S.done(cur); }
        if (!has_next) break;
#pragma unroll
        for (int a = 0; a < 2; ++a)
#pragma unroll
            for (int b = 0; b < 2; ++b)
#pragma unroll
                for (int m = 0; m < 4; ++m)
#pragma unroll
                    for (int n = 0; n < 2; ++n) acc[a][b][m][n] = (f32x4){0.f, 0.f, 0.f, 0.f};
        cur = nxt; cA = nA; cB = nB; ++ui;
        if constexpr (ALIGN_EPI) { if (wr == 1) PG8_BAR; }
    }
    PG8_WAIT_V(0);
    if constexpr (!ALIGN_EPI) { if (wr == 0) PG8_BAR; }
    PG8_BAR;
    if constexpr (Epi::AFTER_DRAIN) { E.fused(acc, cur, wr, wc, fr, fq, lds, wid, lane); S.done(cur); }
#undef PG8_SA
#undef PG8_SB
#undef PG8_STAGE
#undef PG8_LDA
#undef PG8_LDB
#undef PG8_MMA
#undef PG8_WAIT_V
#undef PG8_WAIT_L
#undef PG8_BAR
#undef PG8_SCHED
}
}

typedef float f32x2_t __attribute__((ext_vector_type(2))); typedef __bf16 bf16x2_t __attribute__((ext_vector_type(2)));
DI unsigned cvt_pk_bf16(float lo, float hi) { const f32x2_t v = {lo, hi}; const bf16x2_t b = __builtin_convertvector(v, bf16x2_t); return __builtin_bit_cast(unsigned, b); }
DI u32x4 pack8(const f32x4 a, const f32x4 b) { u32x4 w; w.x = cvt_pk_bf16(a[0], a[1]); w.y = cvt_pk_bf16(a[2], a[3]); w.z = cvt_pk_bf16(b[0], b[1]); w.w = cvt_pk_bf16(b[2], b[3]); return w; }
struct EpiIn {
    static constexpr bool PERM = true, AFTER_DRAIN = false;
    Ctx C; int l;
    DI void operator()(const f32x4 (&acc)[2][2][4][2], const pg8::Unit& u, int wr, int wc, int fr, int fq) const {
        const int row0 = u.pm * 256 + wr * 64 + fr;
        float rs[2][4];
#pragma unroll
        for (int ai = 0; ai < 2; ++ai)
#pragma unroll
            for (int m = 0; m < 4; ++m) {
                const f32x4 p = *(const f32x4*)(C.rss() + (size_t)(row0 + ai * 128 + m * 16) * 16 + 4 * fq);
                float s = sum_fq((p[0] + p[1]) + (p[2] + p[3]));
                rs[ai][m] = rsqrtf(s * (1.f / DM) + EPS);
            }
        if (u.pn < 19) {
            bf16_t* base = C.proj() + (size_t)row0 * PJW + u.pn * 256 + wc * 32 + 8 * fq;
#pragma unroll
            for (int ai = 0; ai < 2; ++ai)
#pragma unroll
                for (int m = 0; m < 4; ++m) {
                    bf16_t* rowp = base + (size_t)(ai * 128 + m * 16) * PJW; const float sc = rs[ai][m];
#pragma unroll
                    for (int bj = 0; bj < 2; ++bj) *(u32x4*)(rowp + bj * 128) = pack8(acc[ai][bj][m][0] * sc, acc[ai][bj][m][1] * sc);
                }
        } else if (u.pn == 19) {
            if (wc < 2) {
                const float* kw = C.inp(19) + l * 64 + 8 * fq;
                const f32x4 k00 = *(const f32x4*)(kw), k01 = *(const f32x4*)(kw + 4), k10 = *(const f32x4*)(kw + 32), k11 = *(const f32x4*)(kw + 36);
#pragma unroll
                for (int ai = 0; ai < 2; ++ai)
#pragma unroll
                    for (int m = 0; m < 4; ++m) {
                        const int row = row0 + ai * 128 + m * 16; int sb, t; row_sbt(row, sb, t);
                        const float sc = rs[ai][m];
                        f32x4 a0 = acc[ai][0][m][0] * sc, a1 = acc[ai][0][m][1] * sc, b0 = acc[ai][1][m][0] * sc, b1 = acc[ai][1][m][1] * sc;
                        float ss = 0.f;
#pragma unroll
                        for (int i = 0; i < 4; ++i) ss += (a0[i] * a0[i] + a1[i] * a1[i]) + (b0[i] * b0[i] + b1[i] * b1[i]);
                        ss = sum_fq(ss);
                        const float rn = rsqrtf(ss * (1.f / 64.f) + EPS);
                        a0 = a0 * rn * k00; a1 = a1 * rn * k01; b0 = b0 * rn * k10; b1 = b1 * rn * k11;
                        float* o = out_ak(C, l, sb) + (size_t)t * 128 + wc * 64 + 8 * fq;
                        *(f32x4*)(o) = a0; *(f32x4*)(o + 4) = a1; *(f32x4*)(o + 32) = b0; *(f32x4*)(o + 36) = b1;
                        bf16_t* kv = C.kvb(l) + kvb_off(sb) + (size_t)(sb_P(sb) + t) * KVW + wc * 64 + 8 * fq;
                        *(u32x4*)(kv) = pack8(a0, a1); *(u32x4*)(kv + 32) = pack8(b0, b1);
                    }
            } else {
                const int kvh = wc - 2;
#pragma unroll
                for (int ai = 0; ai < 2; ++ai)
#pragma unroll
                    for (int m = 0; m < 4; ++m) {
                        const int row = row0 + ai * 128 + m * 16; int sb, t; row_sbt(row, sb, t);
                        const float sc = rs[ai][m];
                        const f32x4 a0 = acc[ai][0][m][0] * sc, a1 = acc[ai][0][m][1] * sc, b0 = acc[ai][1][m][0] * sc, b1 = acc[ai][1][m][1] * sc;
                        float* o = out_av(C, l, sb) + (size_t)t * 128 + kvh * 64 + 8 * fq;
                        *(f32x4*)(o) = a0; *(f32x4*)(o + 4) = a1; *(f32x4*)(o + 32) = b0; *(f32x4*)(o + 36) = b1;
                        bf16_t* kv = C.kvb(l) + kvb_off(sb) + (size_t)(sb_P(sb) + t) * KVW + 128 + kvh * 64 + 8 * fq;
                        *(u32x4*)(kv) = pack8(a0, a1); *(u32x4*)(kv + 32) = pack8(b0, b1);
                    }
            }
        } else {
#pragma unroll
            for (int ai = 0; ai < 2; ++ai)
#pragma unroll
                for (int m = 0; m < 4; ++m) {
                    const int row = row0 + ai * 128 + m * 16; int sb, t; row_sbt(row, sb, t);
                    const float sc = rs[ai][m];
                    const f32x4 a0 = acc[ai][0][m][0] * sc, a1 = acc[ai][0][m][1] * sc;
                    if (wc < 2) {
                        const int d = 32 * wc + 8 * fq;
                        float* o = out_ik(C, l, sb) + (size_t)t * 64 + d;
                        *(f32x4*)(o) = a0; *(f32x4*)(o + 4) = a1;
                        *(u32x4*)(C.kvb(l) + kvb_off(sb) + (size_t)(sb_P(sb) + t) * KVW + 256 + d) = pack8(a0, a1);
                    } else if (wc == 2) {
                        if (fq == 0) { *(f32x4*)(C.wi() + (size_t)row * 4) = a0; *(f32x4*)(C.dtr() + (size_t)row * 16) = a1; }
                        else if (fq == 1) { *(f32x4*)(C.dtr() + (size_t)row * 16 + 4) = a0; *(f32x4*)(C.dtr() + (size_t)row * 16 + 8) = a1; }
                        else if (fq == 2) { *(f32x4*)(C.dtr() + (size_t)row * 16 + 12) = a0; }
                    }
                }
        }
    }
};
struct EpiOut {
    static constexpr bool PERM = false, AFTER_DRAIN = false;
    Ctx C; int l;
    DI void operator()(const f32x4 (&acc)[2][2][4][2], const pg8::Unit& u, int wr, int wc, int fr, int fq) const {
        const int row0 = u.pm * 256 + wr * 64 + fr, col0 = u.pn * 256 + wc * 32 + 4 * fq;
#pragma unroll
        for (int ai = 0; ai < 2; ++ai)
#pragma unroll
            for (int m = 0; m < 4; ++m) {
                const int row = row0 + ai * 128 + m * 16;
                const float* xres = (l == 0) ? ((row < ROWS_P) ? C.inp(0) + (size_t)row * DM : C.inp(1) + (size_t)(row - ROWS_P) * DM) : C.out + (size_t)row * DM;
                float ss = 0.f;
#pragma unroll
                for (int bj = 0; bj < 2; ++bj)
#pragma unroll
                    for (int n = 0; n < 2; ++n) {
                        const int col = col0 + bj * 128 + n * 16;
                        const f32x4 v = *(const f32x4*)(xres + col) + acc[ai][bj][m][n];
                        *(f32x4*)(C.out + (size_t)row * DM + col) = v;
                        if (l == 0) {
                            u32x2 w; w.x = cvt_pk_bf16(v[0], v[1]); w.y = cvt_pk_bf16(v[2], v[3]);
                            *(u32x2*)(C.hb() + (size_t)row * DM + col) = w;
                            ss += (v[0] * v[0] + v[1] * v[1]) + (v[2] * v[2] + v[3] * v[3]);
                        }
                    }
                if (l == 0) {
                    ss = sum_fq(ss);
                    if (fq == 0) C.rss()[(size_t)row * 16 + u.pn * 4 + wc] = ss;
                }
            }
    }
};
DI void phase_inproj_gemm(const Ctx& C, int l) {
    pg8::Gemm g{C.hb(), C.win(l), ROWS, NPAD, DM, DM};
    pg8::StaticOrder S; S.init(ROWS, NPAD, C.G, C.bid);
    EpiIn E{C, l};
    pg8::gemm_phase<EpiIn, pg8::StaticOrder, true, true>(C.lds, g, S, E, C.tid);
}
DI void phase_outproj_gemm(const Ctx& C, int l) {
    pg8::Gemm g{C.proj(), C.wout(l), ROWS, DM, DMIX, PJW};
    pg8::StaticOrder S; S.init(ROWS, DM, C.G, C.bid);
    EpiOut E{C, l};
    pg8::gemm_phase<EpiOut, pg8::StaticOrder, true, true>(C.lds, g, S, E, C.tid);
}
DI void phase_ycnorm(const Ctx& C, int l) {
    const int gw = C.bid * NWAVES + C.wave, NGW = C.G * NWAVES, lane = C.lane;
#if USE_SSD_OPT
    for (int i = C.bid * NTHREADS + C.tid; i < NSB * 3 * 1536; i += C.G * NTHREADS) {
        const int sb = i / (3 * 1536), j = (i / 1536) % 3, ch = i % 1536;
        out_sc(C, l, sb)[j * 1536 + ch] = bf2f(C.proj()[(size_t)(sb_row0(sb) + sb_T(sb) - 3 + j) * PJW + C_XBC + ch]);
    }
#endif
#if USE_LRU_OPT
    for (int i = C.bid * NTHREADS + C.tid; i < NSB * 3 * 512; i += C.G * NTHREADS) {
        const int sb = i / (3 * 512), j = (i / 512) % 3, ch = i % 512;
        out_lc(C, l, sb)[j * 512 + ch] = bf2f(C.proj()[(size_t)(sb_row0(sb) + sb_T(sb) - 3 + j) * PJW + C_XL + ch]);
    }
#endif
    for (int m = gw; m < ROWS; m += NGW) {
        const float s = C.ssq()[(size_t)m * 64 + lane];
        float h = s;
        h = half_sum32(h);
        const float rg = rsqrtf(h * (1.f / 512.f) + EPS);
        const float r0 = bperm(rg, 0), r1 = bperm(rg, 32);
        bf16_t* p = C.proj() + (size_t)m * PJW + C_Z;
#pragma unroll
        for (int j = 0; j < 2; ++j) {
            const int c = 8 * lane + 512 * j;
            const u32x4 v = *(const u32x4*)(p + c); const float r = j == 0 ? r0 : r1; u32x4 o;
            o.x = cvt_pk_bf16(__uint_as_float(v.x << 16) * r, __uint_as_float(v.x & 0xffff0000u) * r);
            o.y = cvt_pk_bf16(__uint_as_float(v.y << 16) * r, __uint_as_float(v.y & 0xffff0000u) * r);
            o.z = cvt_pk_bf16(__uint_as_float(v.z << 16) * r, __uint_as_float(v.z & 0xffff0000u) * r);
            o.w = cvt_pk_bf16(__uint_as_float(v.w << 16) * r, __uint_as_float(v.w & 0xffff0000u) * r);
            *(u32x4*)(p + c) = o;
        }
    }
}

template <int MODE>
DI void p0_transpose_item(const Ctx& C, const float* W, const float* scale, int K, int Nsrc, int Ndst, bf16_t* WT, LAS float* scr, int item) {
    const int lane = C.lane, nblk = Ndst / 32, kb = item / nblk, nb = item % nblk, k0 = 64 * kb, n0 = 32 * nb;
    const int ncol = n0 + (lane & 31);
    const int src = (MODE == 0) ? orig_col(ncol) : ncol;
#pragma unroll 8
    for (int i = 0; i < 32; ++i) {
        const int kk = 2 * i + (lane >> 5), k = k0 + kk;
        float v = 0.f;
        if (src >= 0) {
            v = W[(size_t)k * Nsrc + src];
            if (MODE == 0) v *= scale[k];
            else if (k >= 1024) v *= scale[k - 1024];
        }
        scr[kk * 33 + (lane & 31)] = v;
    }
    LDS_FENCE();
    const int c = lane & 7;
#pragma unroll
    for (int j = 0; j < 4; ++j) {
        const int n = (lane >> 3) + 8 * j; const LAS float* s = scr + (8 * c) * 33 + n;
        u32x4 o; o.x = pk2(s[0 * 33], s[1 * 33]); o.y = pk2(s[2 * 33], s[3 * 33]); o.z = pk2(s[4 * 33], s[5 * 33]); o.w = pk2(s[6 * 33], s[7 * 33]);
        *(u32x4*)(WT + (size_t)(n0 + n) * K + k0 + 8 * c) = o;
    }
    LDS_FENCE();
}
DI void phase_prologue(const Ctx& C) {
    LAS float* scr = (LAS float*)(C.lds + C.wave * 16384);
    const int gw = C.bid * NWAVES + C.wave, NGW = C.G * NWAVES;
    constexpr int I_IN = (DM / 64) * (NPAD / 32), I_OUT = (DMIX / 64) * (DM / 32);
    for (int it = gw; it < 2 * (I_IN + I_OUT); it += NGW) {
        int r = it; const int l = r / (I_IN + I_OUT); r -= l * (I_IN + I_OUT);
        if (r < I_IN) p0_transpose_item<0>(C, C.inp(10) + (size_t)l * DM * DINP, C.inp(9) + l * DM, DM, DINP, NPAD, C.win(l), scr, r);
        else p0_transpose_item<1>(C, C.inp(27) + (size_t)l * DMIX * DM, C.inp(26) + l * 1024, DMIX, DM, DM, C.wout(l), scr, r - I_IN);
    }
    for (int m = gw; m < ROWS; m += NGW) {
        const float* xr = (m < ROWS_P) ? C.inp(0) + (size_t)m * DM : C.inp(1) + (size_t)(m - ROWS_P) * DM;
        float ss = 0.f;
#pragma unroll
        for (int j = 0; j < 4; ++j) {
            const f32x4 v = *(const f32x4*)(xr + 4 * C.lane + 256 * j);
            ss += (v.x * v.x + v.y * v.y) + (v.z * v.z + v.w * v.w);
            u32x2 o; o.x = pk2(v.x, v.y); o.y = pk2(v.z, v.w);
            *(u32x2*)(C.hb() + (size_t)m * DM + 4 * C.lane + 256 * j) = o;
        }
        ss = wave_sum(ss);
        if (C.lane < 16) C.rss()[(size_t)m * 16 + C.lane] = (C.lane == 0) ? ss : 0.f;
    }
    for (int it = gw; it < 2 * NSB_S * PAST; it += NGW) {
        const int l = it / (NSB_S * PAST), r = it % (NSB_S * PAST), b = r / PAST, pos = r % PAST;
        bf16_t* dst = C.kvb(l) + kvb_off(NPB + b) + (size_t)pos * KVW;
        const size_t base = ((size_t)(l * NSB_S + b) * PAST + pos);
#pragma unroll
        for (int j = 0; j < 5; ++j) {
            const int c = C.lane + 64 * j; float v;
            if (c < 128) v = C.inp(2)[base * 128 + c]; else if (c < 256) v = C.inp(3)[base * 128 + (c - 128)]; else v = C.inp(4)[base * 64 + (c - 256)];
            dst[c] = f2bf(v);
        }
    }
}

#define MFMA32(a, b, c) __builtin_amdgcn_mfma_f32_32x32x16_bf16((a), (b), (c), 0, 0, 0)
DI void phase_inproj_simple(const Ctx& C, int l) {
    const int gw = C.bid * NWAVES + C.wave, NGW = C.G * NWAVES, lane = C.lane, r = lane & 31, h = lane >> 5;
    constexpr int NG = 82, NRT = ROWS / 32;
    const bf16_t* WIN = C.win(l); const bf16_t* HB = C.hb(); bf16_t* PJ = C.proj();
    for (int it = gw; it < NRT * NG; it += NGW) {
        const int rt = it / NG, g = it % NG, m0 = rt * 32;
        int c0, c1, type;
        if (g < 76) { c0 = 64 * g; c1 = c0 + 32; type = 0; }
        else if (g < 80) { const int hs = g - 76; c0 = C_T19 + 32 * hs; c1 = c0 + 128; type = hs < 2 ? 1 : 2; }
        else if (g == 80) { c0 = C_T20; c1 = C_T20 + 32; type = 3; }
        else { c0 = C_T20 + 64; c1 = C_T20 + 96; type = 4; }
        f32x16 acc0, acc1;
#pragma unroll
        for (int i = 0; i < 16; ++i) { acc0[i] = 0.f; acc1[i] = 0.f; }
        const bf16_t* Ap = HB + (size_t)(m0 + r) * DM + 8 * h;
        const bf16_t* B0 = WIN + (size_t)(c0 + r) * DM + 8 * h;
        const bf16_t* B1 = WIN + (size_t)(c1 + r) * DM + 8 * h;
#pragma unroll 4
        for (int k0 = 0; k0 < DM; k0 += 16) {
            const bf16x8 a = *(const bf16x8*)(Ap + k0), b0 = *(const bf16x8*)(B0 + k0), b1 = *(const bf16x8*)(B1 + k0);
            acc0 = MFMA32(a, b0, acc0); acc1 = MFMA32(a, b1, acc1);
        }
        float rsc; { const float* p = C.rss() + (size_t)(m0 + r) * 16; float s = 0.f;
#pragma unroll
            for (int j = 0; j < 16; ++j) s += p[j];
            rsc = rsqrtf(s * (1.f / DM) + EPS); }
        const float kn0 = (type == 1) ? C.inp(19)[l * 64 + r] : 1.f, kn1 = (type == 1) ? C.inp(19)[l * 64 + 32 + r] : 1.f;
#pragma unroll
        for (int reg = 0; reg < 16; ++reg) {
            const int rowl = crow(reg, h), m = m0 + rowl;
            const float sc = bperm(rsc, rowl);
            float v0 = acc0[reg] * sc, v1 = acc1[reg] * sc;
            if (type == 0) { PJ[(size_t)m * PJW + c0 + r] = f2bf(v0); PJ[(size_t)m * PJW + c1 + r] = f2bf(v1); }
            else {
                int sb, t; row_sbt(m, sb, t); const int pos = sb_P(sb) + t;
                bf16_t* kv = C.kvb(l) + kvb_off(sb) + (size_t)pos * KVW;
                if (type == 1) {
                    const int kvh = g - 76;
                    const float ss = half_sum32(v0 * v0 + v1 * v1), rn = rsqrtf(ss * (1.f / 64.f) + EPS);
                    v0 = v0 * rn * kn0; v1 = v1 * rn * kn1;
                    float* o = out_ak(C, l, sb) + (size_t)t * 128 + kvh * 64;
                    o[r] = v0; o[32 + r] = v1; kv[kvh * 64 + r] = f2bf(v0); kv[kvh * 64 + 32 + r] = f2bf(v1);
                } else if (type == 2) {
                    const int kvh = g - 78;
                    float* o = out_av(C, l, sb) + (size_t)t * 128 + kvh * 64;
                    o[r] = v0; o[32 + r] = v1; kv[128 + kvh * 64 + r] = f2bf(v0); kv[128 + kvh * 64 + 32 + r] = f2bf(v1);
                } else if (type == 3) {
                    float* o = out_ik(C, l, sb) + (size_t)t * 64;
                    o[r] = v0; o[32 + r] = v1; kv[256 + r] = f2bf(v0); kv[256 + 32 + r] = f2bf(v1);
                } else {
                    if (r < 4) C.wi()[(size_t)m * 4 + r] = v0; else if (r < 20) C.dtr()[(size_t)m * 16 + (r - 4)] = v0;
                }
            }
        }
    }
}

DI void phase_outproj_simple(const Ctx& C, int l) {
    const int gw = C.bid * NWAVES + C.wave, NGW = C.G * NWAVES, lane = C.lane, r = lane & 31, h = lane >> 5;
    constexpr int NG = DM / 64, NRT = ROWS / 32;
    const bf16_t* WO = C.wout(l); const bf16_t* PJ = C.proj();
    for (int it = gw; it < NRT * NG; it += NGW) {
        const int rt = it / NG, g = it % NG, m0 = rt * 32, c0 = 64 * g, c1 = c0 + 32;
        f32x16 a00, a01, a10, a11, a20, a21;
#pragma unroll
        for (int i = 0; i < 16; ++i) { a00[i] = 0.f; a01[i] = 0.f; a10[i] = 0.f; a11[i] = 0.f; a20[i] = 0.f; a21[i] = 0.f; }
        const bf16_t* Ap = PJ + (size_t)(m0 + r) * PJW + 8 * h;
        const bf16_t* B0 = WO + (size_t)(c0 + r) * DMIX + 8 * h;
        const bf16_t* B1 = WO + (size_t)(c1 + r) * DMIX + 8 * h;
#pragma unroll 4
        for (int k0 = 0; k0 < 1024; k0 += 16) { const bf16x8 a = *(const bf16x8*)(Ap + k0); a00 = MFMA32(a, *(const bf16x8*)(B0 + k0), a00); a01 = MFMA32(a, *(const bf16x8*)(B1 + k0), a01); }
#pragma unroll 4
        for (int k0 = 1024; k0 < 1536; k0 += 16) { const bf16x8 a = *(const bf16x8*)(Ap + k0); a10 = MFMA32(a, *(const bf16x8*)(B0 + k0), a10); a11 = MFMA32(a, *(const bf16x8*)(B1 + k0), a11); }
#pragma unroll 4
        for (int k0 = 1536; k0 < 2048; k0 += 16) { const bf16x8 a = *(const bf16x8*)(Ap + k0); a20 = MFMA32(a, *(const bf16x8*)(B0 + k0), a20); a21 = MFMA32(a, *(const bf16x8*)(B1 + k0), a21); }
        float r0, r1; { const float* p = C.ssq() + (size_t)(m0 + r) * 64; float s0 = 0.f, s1 = 0.f;
#pragma unroll
            for (int j = 0; j < 32; ++j) { s0 += p[j]; s1 += p[32 + j]; }
            r0 = rsqrtf(s0 * (1.f / 512.f) + EPS); r1 = rsqrtf(s1 * (1.f / 512.f) + EPS); }
#pragma unroll
        for (int reg = 0; reg < 16; ++reg) {
            const int rowl = crow(reg, h), m = m0 + rowl;
            const float g0 = bperm(r0, rowl), g1 = bperm(r1, rowl);
            const float* xres = (l == 0) ? ((m < ROWS_P) ? C.inp(0) + (size_t)m * DM : C.inp(1) + (size_t)(m - ROWS_P) * DM) : C.out + (size_t)m * DM;
            const float v0 = xres[c0 + r] + a00[reg] + g0 * a10[reg] + g1 * a20[reg];
            const float v1 = xres[c1 + r] + a01[reg] + g0 * a11[reg] + g1 * a21[reg];
            C.out[(size_t)m * DM + c0 + r] = v0; C.out[(size_t)m * DM + c1 + r] = v1;
            if (l == 0) {
                C.hb()[(size_t)m * DM + c0 + r] = f2bf(v0); C.hb()[(size_t)m * DM + c1 + r] = f2bf(v1);
                const float ss = half_sum32(v0 * v0 + v1 * v1);
                if (r == 0) C.rss()[(size_t)m * 16 + g] = ss;
            }
        }
    }
}

DI void phase_conv_naive(const Ctx& C, int l) {
    const int gt = C.bid * NTHREADS + C.tid, NGT = C.G * NTHREADS;
    bf16_t* PJ = C.proj();
    for (int i = gt; i < NSB * 1536; i += NGT) {
        const int sb = i / 1536, ch = i % 1536, T = sb_T(sb), row0 = sb_row0(sb);
        const float* cw = C.inp(21) + (size_t)l * 4 * 1536; const float w0 = cw[ch], w1 = cw[1536 + ch], w2 = cw[2 * 1536 + ch], w3 = cw[3 * 1536 + ch], bias = C.inp(22)[l * 1536 + ch];
        float h0 = 0.f, h1 = 0.f, h2 = 0.f;
        if (sb >= NPB) { const float* st = C.inp(7) + ((size_t)(l * NSB_S + sb - NPB) * 3) * 1536; h0 = st[ch]; h1 = st[1536 + ch]; h2 = st[2 * 1536 + ch]; }
        bf16_t* p = PJ + (size_t)row0 * PJW + C_XBC + ch;
        for (int t = 0; t < T; ++t) {
            const float x = bf2f(p[(size_t)t * PJW]);
            const float y = bias + w0 * h0 + w1 * h1 + w2 * h2 + w3 * x;
            p[(size_t)t * PJW] = f2bf(silu_f(y));
            h0 = h1; h1 = h2; h2 = x;
        }
        float* o = out_sc(C, l, sb); o[ch] = h0; o[1536 + ch] = h1; o[2 * 1536 + ch] = h2;
    }
}

DI void lru_item_naive(const Ctx& C, int l, int sb, int blk, LAS unsigned char* scr) {
    const int lane = C.lane, ch = blk * 64 + lane, T = sb_T(sb), row0 = sb_row0(sb);
    bf16_t* PJ = C.proj();
    LAS unsigned* wl = (LAS unsigned*)scr;
    { const float* pa = C.inp(13) + (size_t)(l * 8 + blk) * 4096 + lane; const float* px = C.inp(15) + (size_t)(l * 8 + blk) * 4096 + lane;
      for (int c = 0; c < 64; ++c) wl[c * 64 + lane] = pk2(pa[c * 64], px[c * 64]); }
    LDS_FENCE();
    const float ba = C.inp(14)[l * 512 + ch], bx = C.inp(16)[l * 512 + ch];
    const float spl = softplus_f(-C.inp(17)[l * 512 + ch]);
    const float* cw = C.inp(11) + (size_t)l * 4 * 512; const float w0 = cw[ch], w1 = cw[512 + ch], w2 = cw[1024 + ch], w3 = cw[1536 + ch], cb = C.inp(12)[l * 512 + ch];
    float h0 = 0.f, h1 = 0.f, h2 = 0.f, hs = 0.f;
    if (sb >= NPB) { const float* st = C.inp(5) + ((size_t)(l * NSB_S + sb - NPB) * 3) * 512; h0 = st[ch]; h1 = st[512 + ch]; h2 = st[1024 + ch]; hs = C.inp(6)[(size_t)(l * NSB_S + sb - NPB) * 512 + ch]; }
    for (int t = 0; t < T; ++t) {
        const size_t rb = (size_t)(row0 + t) * PJW;
        const float x = bf2f(PJ[rb + C_XL + ch]);
        const float xc = cb + w0 * h0 + w1 * h1 + w2 * h2 + w3 * x;
        h0 = h1; h1 = h2; h2 = x;
        float ga = ba, gx = bx;
#pragma unroll 8
        for (int c = 0; c < 64; ++c) { const float xv = __int_as_float(__builtin_amdgcn_readlane(__float_as_int(xc), c)); const unsigned w = wl[c * 64 + lane]; ga += xv * __uint_as_float(w << 16); gx += xv * __uint_as_float(w & 0xffff0000u); }
        const float rg = sigmoid_f(ga), ig = sigmoid_f(gx);
        const float log_a = -8.f * rg * spl, a = expf(log_a), mult = sqrtf(-expm1f(2.f * log_a));
        hs = a * hs + mult * (ig * xc);
        const float gl = bf2f(PJ[rb + C_GL + ch]);
        PJ[rb + C_GL + ch] = f2bf(hs * silu_f(gl));
    }
    float* oc = out_lc(C, l, sb); oc[ch] = h0; oc[512 + ch] = h1; oc[1024 + ch] = h2;
    out_lh(C, l, sb)[ch] = hs;
}

DI void ssd_item_naive(const Ctx& C, int l, int sb, int hd, int pq) {
    const int lane = C.lane, T = sb_T(sb), row0 = sb_row0(sb), g = hd >> 3;
    const int p = 16 * pq + (lane & 15), nq = lane >> 4, n0 = 32 * nq;
    bf16_t* PJ = C.proj();
    float hst[32];
    if (sb >= NPB) { const float* st = C.inp(8) + (((size_t)(l * NSB_S + sb - NPB) * 16 + hd) * 64 + p) * 128 + n0;
#pragma unroll
        for (int n = 0; n < 32; n += 4) { const f32x4 v = *(const f32x4*)(st + n); hst[n] = v.x; hst[n + 1] = v.y; hst[n + 2] = v.z; hst[n + 3] = v.w; } }
    else {
#pragma unroll
        for (int n = 0; n < 32; ++n) hst[n] = 0.f; }
    const float aneg = -expf(C.inp(24)[l * 16 + hd]), dtb = C.inp(23)[l * 16 + hd], Dh = C.inp(25)[l * 16 + hd];
    for (int t = 0; t < T; ++t) {
        const size_t rb = (size_t)(row0 + t) * PJW;
        const float dt = softplus_f(C.dtr()[(size_t)(row0 + t) * 16 + hd] + dtb), da = expf(dt * aneg);
        const float xs = bf2f(PJ[rb + C_XBC + hd * 64 + p]), dtx = dt * xs;
        const bf16_t* Bp = PJ + rb + C_XBC + 1024 + g * 128 + n0; const bf16_t* Cp = PJ + rb + C_XBC + 1280 + g * 128 + n0;
        float y = 0.f;
#pragma unroll
        for (int n = 0; n < 32; n += 8) {
            const bf16x8 bv = *(const bf16x8*)(Bp + n), cv = *(const bf16x8*)(Cp + n);
#pragma unroll
            for (int j = 0; j < 8; ++j) { hst[n + j] = da * hst[n + j] + dtx * bf2f((bf16_t)bv[j]); y += bf2f((bf16_t)cv[j]) * hst[n + j]; }
        }
        y = sum_fq(y);
        y += Dh * xs;
        const float z = bf2f(PJ[rb + C_Z + hd * 64 + p]);
        y *= silu_f(z);
        if (nq == 0) PJ[rb + C_Z + hd * 64 + p] = f2bf(y);
        const float ss = wave_sum(nq == 0 ? y * y : 0.f);
        if (lane == 0) C.ssq()[(size_t)(row0 + t) * 64 + hd * 4 + pq] = ss;
    }
    float* o = out_sh(C, l, sb) + ((size_t)hd * 64 + p) * 128 + n0;
#pragma unroll
    for (int n = 0; n < 32; n += 4) { f32x4 v; v.x = hst[n]; v.y = hst[n + 1]; v.z = hst[n + 2]; v.w = hst[n + 3]; *(f32x4*)(o + n) = v; }
}

constexpr int SS_XST = 0;
constexpr int SS_BM = SS_XST + 64 * 144;
constexpr int SS_CM = SS_BM + 64 * 272;
constexpr int SS_BWT = SS_CM + 64 * 272;
constexpr int SS_HA = SS_BWT + 128 * 144;
constexpr int SS_SCAL = SS_HA + 2 * 64 * 272;
constexpr int SS_CW = SS_SCAL + 2 * 1024;
constexpr int SS_RAW = SS_CW + 5 * 320 * 4;
constexpr int SS_Z = SS_RAW + 67 * 640;
constexpr int SS_END = SS_Z + 8192;
static_assert(SS_END <= LDS_BYTES - 256, "SSD LDS map");
typedef short s16x4 __attribute__((ext_vector_type(4)));
DI float fast_silu(float x) { return x * __builtin_amdgcn_rcpf(1.f + __builtin_amdgcn_exp2f(-1.4426950408889634f * x)); }
DI bf16x8 lds_frag(const LAS unsigned char* base, int row, int rowbytes, int col) { return *(const LAS bf16x8*)(base + row * rowbytes + col * 2); }

DI void ssd_item(const Ctx& C, int l, int sb, int hd) {
    const int tid = C.tid, lane = C.lane, wave = C.wave, r = lane & 31, h = lane >> 5;
    const int T = sb_T(sb), row0 = sb_row0(sb), g = hd >> 3, NC = T / 64;
    LAS unsigned char* L = C.lds;
    bf16_t* PJ = C.proj();
    const float aneg = -expf(C.inp(24)[l * 16 + hd]), dtb = C.inp(23)[l * 16 + hd], Dh = C.inp(25)[l * 16 + hd];
    const bool stager = tid < 320;
    const int cg = 8 * (tid >> 6) + (tid & 7), seg = (tid >> 3) & 7;
    int colbase, cch;
    if (cg < 8) { cch = hd * 64 + 8 * cg; } else if (cg < 24) { cch = 1024 + g * 128 + 8 * (cg - 8); } else { cch = 1280 + g * 128 + 8 * (cg - 24); }
    colbase = C_XBC + cch;
    for (int i = tid; i < 5 * 320; i += NTHREADS) {
        const int j = i / 320, c = i % 320, cg2 = c >> 3, e = c & 7;
        const int ch = (cg2 < 8) ? hd * 64 + 8 * cg2 + e : (cg2 < 24 ? 1024 + g * 128 + 8 * (cg2 - 8) + e : 1280 + g * 128 + 8 * (cg2 - 24) + e);
        ((LAS float*)(L + SS_CW))[i] = (j < 4) ? C.inp(21)[((size_t)l * 4 + j) * 1536 + ch] : C.inp(22)[l * 1536 + ch];
    }
    const int sj = wave - 4, sph = sj & 1, nq0 = 2 * (sj >> 1);
    f32x16 hacc0, hacc1;
#pragma unroll
    for (int i = 0; i < 16; ++i) { hacc0[i] = 0.f; hacc1[i] = 0.f; }
    if (wave >= 4) {
        if (sb >= NPB) {
            const float* st = C.inp(8) + (((size_t)(l * NSB_S + sb - NPB) * 16 + hd) * 64 + 32 * sph + r) * 128;
#pragma unroll
            for (int gq = 0; gq < 4; ++gq) {
                const f32x4 v0 = *(const f32x4*)(st + 32 * nq0 + 8 * gq + 4 * h), v1 = *(const f32x4*)(st + 32 * (nq0 + 1) + 8 * gq + 4 * h);
#pragma unroll
                for (int e = 0; e < 4; ++e) { hacc0[4 * gq + e] = v0[e]; hacc1[4 * gq + e] = v1[e]; }
            }
        }
#pragma unroll
        for (int gq = 0; gq < 4; ++gq) {
            u32x2 w0, w1; w0.x = cvt_pk_bf16(hacc0[4 * gq], hacc0[4 * gq + 1]); w0.y = cvt_pk_bf16(hacc0[4 * gq + 2], hacc0[4 * gq + 3]);
            w1.x = cvt_pk_bf16(hacc1[4 * gq], hacc1[4 * gq + 1]); w1.y = cvt_pk_bf16(hacc1[4 * gq + 2], hacc1[4 * gq + 3]);
            *(LAS u32x2*)(L + SS_HA + (32 * sph + r) * 272 + (32 * nq0 + 8 * gq + 4 * h) * 2) = w0;
            *(LAS u32x2*)(L + SS_HA + (32 * sph + r) * 272 + (32 * (nq0 + 1) + 8 * gq + 4 * h) * 2) = w1;
        }
    }
    const int yph = wave & 1, ylh = (wave >> 1) & 1;
    float dtr_pf = 0.f;
#define SSD_DMA_RAW(cc) do { const int t0_ = 64 * (cc); \
        for (int k_ = wave; k_ < 42; k_ += NWAVES) { \
            const int q_ = 64 * k_ + lane, rr_ = q_ / 40, pc_ = q_ - 40 * rr_, t_ = t0_ - 3 + rr_; \
            const int col_ = C_XBC + ((pc_ < 8) ? hd * 64 + 8 * pc_ : (pc_ < 24 ? 1024 + g * 128 + 8 * (pc_ - 8) : 1280 + g * 128 + 8 * (pc_ - 24))); \
            if (q_ < 2680 && t_ >= 0) __builtin_amdgcn_global_load_lds((const unsigned*)(PJ + (size_t)(row0 + t_) * PJW + col_), (LAS unsigned*)(L + SS_RAW + k_ * 1024), 16, 0, 0); } \
    } while (0)
#define SSD_DMA_Z(cc) do { const int t0_ = 64 * (cc); \
        if (wave < 4) { _Pragma("unroll") for (int k_ = 0; k_ < 2; ++k_) { const int rr_ = 16 * k_ + (lane >> 2), pc_ = lane & 3; \
            __builtin_amdgcn_global_load_lds((const unsigned*)(PJ + (size_t)(row0 + t0_ + 32 * ylh + rr_) * PJW + C_Z + hd * 64 + 32 * yph + 8 * pc_), \
                                             (LAS unsigned*)(L + SS_Z + (2 * yph + ylh) * 2048 + k_ * 1024), 16, 0, 0); } } \
    } while (0)
    if (tid < 120) {
        const int rr = tid / 40, pc = tid % 40;
        const int ch = (pc < 8) ? hd * 64 + 8 * pc : (pc < 24 ? 1024 + g * 128 + 8 * (pc - 8) : 1280 + g * 128 + 8 * (pc - 24));
        u32x4 v = (u32x4){0u, 0u, 0u, 0u};
        if (sb >= NPB) { const float* st = C.inp(7) + ((size_t)(l * NSB_S + sb - NPB) * 3 + rr) * 1536 + ch; v = pack8(*(const f32x4*)st, *(const f32x4*)(st + 4)); }
        *(LAS u32x4*)(L + SS_RAW + rr * 640 + pc * 16) = v;
    }
    if (wave == 0) dtr_pf = C.dtr()[(size_t)(row0 + lane) * 16 + hd];
    SSD_DMA_RAW(0); SSD_DMA_Z(0);
    asm volatile("s_waitcnt vmcnt(0)" ::: "memory");
    __syncthreads();
    for (int c = 0; c < NC; ++c) {
        const int t0 = 64 * c, par = c & 1;
        LAS float* SC = (LAS float*)(L + SS_SCAL + par * 1024);
        if (wave == 0) {
            const float dt = softplus_f(dtr_pf + dtb);
            float x = dt * aneg;
#pragma unroll
            for (int o = 1; o < 64; o <<= 1) { const float y = bperm(x, lane - o); if (lane >= o) x += y; }
            const float cum63 = __int_as_float(__builtin_amdgcn_readlane(__float_as_int(x), 63));
            SC[lane] = x; SC[64 + lane] = dt; SC[128 + lane] = expf(cum63 - x) * dt; SC[192 + lane] = expf(x);
        }
        asm volatile("s_waitcnt vmcnt(0)" ::: "memory"); LDS_FENCE(); __syncthreads();
        if (stager) {
            const LAS float* CW = (const LAS float*)(L + SS_CW) + 8 * cg;
            const int s0 = 8 * seg;
            float te[8];
#pragma unroll
            for (int j = 0; j < 8; ++j) te[j] = (cg >= 8 && cg < 24) ? SC[128 + s0 + j] : 1.f;
            const int n0 = (cg < 24) ? 8 * (cg - 8) : 8 * (cg - 24);
#pragma unroll
            for (int ep = 0; ep < 4; ++ep) {
                float xa[11], xb[11];
#pragma unroll
                for (int i = 0; i < 11; ++i) { const unsigned w = *(const LAS unsigned*)(L + SS_RAW + (s0 + i) * 640 + cg * 16 + ep * 4); xa[i] = __uint_as_float(w << 16); xb[i] = __uint_as_float(w & 0xffff0000u); }
                const float a0 = CW[2 * ep], a1 = CW[320 + 2 * ep], a2 = CW[640 + 2 * ep], a3 = CW[960 + 2 * ep], ab = CW[1280 + 2 * ep];
                const float b0 = CW[2 * ep + 1], b1 = CW[320 + 2 * ep + 1], b2 = CW[640 + 2 * ep + 1], b3 = CW[960 + 2 * ep + 1], bb = CW[1280 + 2 * ep + 1];
                float ta[8], tb[8];
#pragma unroll
                for (int j = 0; j < 8; ++j) {
                    ta[j] = fast_silu(ab + a0 * xa[j] + a1 * xa[j + 1] + a2 * xa[j + 2] + a3 * xa[j + 3]);
                    tb[j] = fast_silu(bb + b0 * xb[j] + b1 * xb[j + 1] + b2 * xb[j + 2] + b3 * xb[j + 3]);
                }
                if (cg < 8) {
#pragma unroll
                    for (int jp = 0; jp < 4; ++jp) {
                        *(LAS unsigned*)(L + SS_XST + (8 * cg + 2 * ep) * 144 + (s0 + 2 * jp) * 2) = cvt_pk_bf16(ta[2 * jp], ta[2 * jp + 1]);
                        *(LAS unsigned*)(L + SS_XST + (8 * cg + 2 * ep + 1) * 144 + (s0 + 2 * jp) * 2) = cvt_pk_bf16(tb[2 * jp], tb[2 * jp + 1]);
                    }
                } else if (cg < 24) {
#pragma unroll
                    for (int j = 0; j < 8; ++j) *(LAS unsigned*)(L + SS_BM + (s0 + j) * 272 + (n0 + 2 * ep) * 2) = cvt_pk_bf16(ta[j], tb[j]);
#pragma unroll
                    for (int jp = 0; jp < 4; ++jp) {
                        *(LAS unsigned*)(L + SS_BWT + (n0 + 2 * ep) * 144 + (s0 + 2 * jp) * 2) = cvt_pk_bf16(ta[2 * jp] * te[2 * jp], ta[2 * jp + 1] * te[2 * jp + 1]);
                        *(LAS unsigned*)(L + SS_BWT + (n0 + 2 * ep + 1) * 144 + (s0 + 2 * jp) * 2) = cvt_pk_bf16(tb[2 * jp] * te[2 * jp], tb[2 * jp + 1] * te[2 * jp + 1]);
                    }
                } else {
#pragma unroll
                    for (int j = 0; j < 8; ++j) *(LAS unsigned*)(L + SS_CM + (s0 + j) * 272 + (n0 + 2 * ep) * 2) = cvt_pk_bf16(ta[j], tb[j]);
                }
            }
        }
        if (c + 1 < NC && wave == 0) dtr_pf = C.dtr()[(size_t)(row0 + t0 + 64 + lane) * 16 + hd];
        LDS_FENCE(); __syncthreads();
        if (c + 1 < NC) SSD_DMA_RAW(c + 1);
        if (wave < 4) {
            const LAS unsigned char* HAc = L + SS_HA + par * (64 * 272);
            bf16x8 cf[8];
#pragma unroll
            for (int ks = 0; ks < 8; ++ks) cf[ks] = lds_frag(L + SS_CM, 32 * ylh + r, 272, 16 * ks + 8 * h);
            const float cuml = SC[32 * ylh + r], ecl = SC[192 + 32 * ylh + r];
            bf16x8 wf[2][2];
#pragma unroll
            for (int sh = 0; sh < 2; ++sh) {
                if (sh <= ylh) {
                    f32x16 ga;
#pragma unroll
                    for (int i = 0; i < 16; ++i) ga[i] = 0.f;
#pragma unroll
                    for (int ks = 0; ks < 8; ++ks) ga = MFMA32(lds_frag(L + SS_BM, 32 * sh + r, 272, 16 * ks + 8 * h), cf[ks], ga);
                    float wv[16];
#pragma unroll
                    for (int reg = 0; reg < 16; ++reg) {
                        const int s = 32 * sh + crow(reg, h), ll = 32 * ylh + r;
                        const float cs = SC[s], ds = SC[64 + s];
                        float w = (s <= ll) ? ga[reg] * __builtin_amdgcn_exp2f(1.4426950408889634f * (cuml - cs)) * ds : 0.f;
                        if (s == ll) w += Dh;
                        wv[reg] = w;
                    }
#pragma unroll
                    for (int s2 = 0; s2 < 2; ++s2) {
                        u32x4 p; p.x = cvt_pk_bf16(wv[8 * s2], wv[8 * s2 + 1]); p.y = cvt_pk_bf16(wv[8 * s2 + 2], wv[8 * s2 + 3]); p.z = cvt_pk_bf16(wv[8 * s2 + 4], wv[8 * s2 + 5]); p.w = cvt_pk_bf16(wv[8 * s2 + 6], wv[8 * s2 + 7]);
                        wf[sh][s2] = __builtin_bit_cast(bf16x8, p);
                    }
                }
            }
            f32x16 ya;
#pragma unroll
            for (int i = 0; i < 16; ++i) ya[i] = 0.f;
#pragma unroll
            for (int ks = 0; ks < 8; ++ks) ya = MFMA32(lds_frag(HAc, 32 * yph + r, 272, 16 * ks + 8 * h), cf[ks], ya);
#pragma unroll
            for (int i = 0; i < 16; ++i) ya[i] *= ecl;
#pragma unroll
            for (int sh = 0; sh < 2; ++sh) {
                if (sh <= ylh) {
#pragma unroll
                    for (int s2 = 0; s2 < 2; ++s2) {
                        const LAS unsigned char* xp = L + SS_XST + (32 * yph + r) * 144 + (32 * sh + 16 * s2 + 4 * h) * 2;
                        const u32x2 lo = *(const LAS u32x2*)(xp), hi = *(const LAS u32x2*)(xp + 16);
                        u32x4 a; a.x = lo.x; a.y = lo.y; a.z = hi.x; a.w = hi.y;
                        ya = MFMA32(__builtin_bit_cast(bf16x8, a), wf[sh][s2], ya);
                    }
                }
            }
            float ss = 0.f;
            bf16_t* zp = PJ + (size_t)(row0 + t0 + 32 * ylh + r) * PJW + C_Z + hd * 64 + 32 * yph + 4 * h;
#pragma unroll
            for (int gq = 0; gq < 4; ++gq) {
                const u32x2 zz = *(const LAS u32x2*)(L + SS_Z + (2 * yph + ylh) * 2048 + r * 64 + (8 * gq + 4 * h) * 2);
                const float z0 = __uint_as_float(zz.x << 16), z1 = __uint_as_float(zz.x & 0xffff0000u), z2 = __uint_as_float(zz.y << 16), z3 = __uint_as_float(zz.y & 0xffff0000u);
                const float y0 = ya[4 * gq] * fast_silu(z0), y1 = ya[4 * gq + 1] * fast_silu(z1), y2 = ya[4 * gq + 2] * fast_silu(z2), y3 = ya[4 * gq + 3] * fast_silu(z3);
                ss += (y0 * y0 + y1 * y1) + (y2 * y2 + y3 * y3);
                u32x2 w; w.x = cvt_pk_bf16(y0, y1); w.y = cvt_pk_bf16(y2, y3);
                *(u32x2*)(zp + 8 * gq) = w;
            }
            ss = xor32_sum(ss);
            if (h == 0) { float* q = C.ssq() + (size_t)(row0 + t0 + 32 * ylh + r) * 64 + hd * 4 + yph; q[0] = ss; q[2] = 0.f; }
            LDS_FENCE();
            if (c + 1 < NC) SSD_DMA_Z(c + 1);
        } else {
            const float decay = SC[192 + 63];
#pragma unroll
            for (int i = 0; i < 16; ++i) { hacc0[i] *= decay; hacc1[i] *= decay; }
#pragma unroll
            for (int ks = 0; ks < 4; ++ks) {
                const bf16x8 xb = lds_frag(L + SS_XST, 32 * sph + r, 144, 16 * ks + 8 * h);
                hacc0 = MFMA32(lds_frag(L + SS_BWT, 32 * nq0 + r, 144, 16 * ks + 8 * h), xb, hacc0);
                hacc1 = MFMA32(lds_frag(L + SS_BWT, 32 * (nq0 + 1) + r, 144, 16 * ks + 8 * h), xb, hacc1);
            }
            LAS unsigned char* HAn = L + SS_HA + (par ^ 1) * (64 * 272);
#pragma unroll
            for (int gq = 0; gq < 4; ++gq) {
                u32x2 w0, w1; w0.x = cvt_pk_bf16(hacc0[4 * gq], hacc0[4 * gq + 1]); w0.y = cvt_pk_bf16(hacc0[4 * gq + 2], hacc0[4 * gq + 3]);
                w1.x = cvt_pk_bf16(hacc1[4 * gq], hacc1[4 * gq + 1]); w1.y = cvt_pk_bf16(hacc1[4 * gq + 2], hacc1[4 * gq + 3]);
                *(LAS u32x2*)(HAn + (32 * sph + r) * 272 + (32 * nq0 + 8 * gq + 4 * h) * 2) = w0;
                *(LAS u32x2*)(HAn + (32 * sph + r) * 272 + (32 * (nq0 + 1) + 8 * gq + 4 * h) * 2) = w1;
            }
        }
    }
    if (wave >= 4) {
        float* o = out_sh(C, l, sb) + ((size_t)hd * 64 + 32 * sph + r) * 128;
#pragma unroll
        for (int gq = 0; gq < 4; ++gq) {
            f32x4 v0, v1;
#pragma unroll
            for (int e = 0; e < 4; ++e) { v0[e] = hacc0[4 * gq + e]; v1[e] = hacc1[4 * gq + e]; }
            *(f32x4*)(o + 32 * nq0 + 8 * gq + 4 * h) = v0; *(f32x4*)(o + 32 * (nq0 + 1) + 8 * gq + 4 * h) = v1;
        }
    }
    __syncthreads();
#undef SSD_DMA_RAW
#undef SSD_DMA_Z
}

DI unsigned mono_key(float f) { const unsigned u = __float_as_uint(f); return (u & 0x80000000u) ? ~u : (u | 0x80000000u); }
DI int t5_bucket(int rel) {
    const int n = rel < 0 ? -rel : rel; int b;
    if (n < 8) b = n; else if (n < 12) b = 8; else if (n < 16) b = 9; else if (n < 23) b = 10; else if (n < 32) b = 11; else if (n < 46) b = 12; else if (n < 64) b = 13; else if (n < 91) b = 14; else b = 15;
    return b + (rel > 0 ? 16 : 0);
}
DI void attn_item_naive(const Ctx& C, int l, int m, LAS unsigned char* scr) {
    const int lane = C.lane;
    int sb, t; row_sbt(m, sb, t);
    const int P = sb_P(sb), posq = P + t, Ladm = 64 * ((posq >> 6) + 1), nsel = Ladm < 256 ? Ladm : 256;
    LAS unsigned* keys = (LAS unsigned*)scr; LAS unsigned* sel = keys + 2048; LAS float* qs = (LAS float*)(sel + 256); LAS float* ps = qs + 64; LAS float* qis = ps + 256;
    bf16_t* PJ = C.proj(); const bf16_t* KV = C.kvb(l) + kvb_off(sb);
    const size_t rb = (size_t)m * PJW;
#pragma unroll
    for (int j = 0; j < 4; ++j) qis[64 * j + lane] = bf2f(PJ[rb + C_QI + 64 * j + lane]);
    LDS_FENCE();
    const float w0 = C.wi()[(size_t)m * 4 + 0], w1 = C.wi()[(size_t)m * 4 + 1], w2 = C.wi()[(size_t)m * 4 + 2], w3 = C.wi()[(size_t)m * 4 + 3];
    for (int s = lane; s < Ladm; s += 64) {
        asm volatile("" ::: "memory");
        const bf16_t* kp = KV + (size_t)s * KVW + 256;
        float d0 = 0.f, d1 = 0.f, d2 = 0.f, d3 = 0.f;
#pragma unroll
        for (int d = 0; d < 64; d += 8) {
            const bf16x8 kv8 = *(const bf16x8*)(kp + d);
#pragma unroll
            for (int j = 0; j < 8; ++j) { const float kf = bf2f((bf16_t)kv8[j]); d0 += qis[d + j] * kf; d1 += qis[64 + d + j] * kf; d2 += qis[128 + d + j] * kf; d3 += qis[192 + d + j] * kf; }
            asm volatile("" ::: "memory");
        }
        const float score = ((w0 * fmaxf(d0, 0.f) + w1 * fmaxf(d1, 0.f)) + w2 * fmaxf(d2, 0.f)) + w3 * fmaxf(d3, 0.f);
        keys[s] = mono_key(score);
    }
    LDS_FENCE();
    for (int s = lane; s < Ladm; s += 64) {
        const unsigned km = keys[s]; int cnt = 0;
        for (int sp = 0; sp < Ladm; sp += 4) {
            const u32x4 kq = *(const LAS u32x4*)(keys + sp);
            cnt += (kq.x > km) | ((kq.x == km) & (sp < s));
            cnt += (kq.y > km) | ((kq.y == km) & (sp + 1 < s));
            cnt += (kq.z > km) | ((kq.z == km) & (sp + 2 < s));
            cnt += (kq.w > km) | ((kq.w == km) & (sp + 3 < s));
        }
        if (cnt < 256) sel[cnt] = (unsigned)s;
    }
    LDS_FENCE();
    for (int hq = 0; hq < 8; ++hq) {
        const int kvh = hq >> 2;
        { const float raw = bf2f(PJ[rb + C_Q + hq * 64 + lane]); const float ss = wave_sum(raw * raw);
          qs[lane] = raw * rsqrtf(ss * (1.f / 64.f) + EPS) * C.inp(18)[l * 64 + lane]; }
        LDS_FENCE();
        float lg[4]; float mx = -INFINITY;
#pragma unroll
        for (int i = 0; i < 4; ++i) {
            const int j = lane + 64 * i; lg[i] = -INFINITY;
            asm volatile("" ::: "memory");
            if (j < nsel) {
                const int s = (int)sel[j]; const bf16_t* kp = KV + (size_t)s * KVW + kvh * 64; float dot = 0.f;
#pragma unroll
                for (int d = 0; d < 64; d += 8) { const bf16x8 kv8 = *(const bf16x8*)(kp + d);
#pragma unroll
                    for (int jj = 0; jj < 8; ++jj) dot += qs[d + jj] * bf2f((bf16_t)kv8[jj]); }
                lg[i] = dot * 0.125f + C.inp(20)[t5_bucket(s - posq) * 8 + hq];
                mx = fmaxf(mx, lg[i]);
            }
        }
        mx = wave_max(mx);
        float sum = 0.f;
#pragma unroll
        for (int i = 0; i < 4; ++i) { const int j = lane + 64 * i; if (j < nsel) { lg[i] = expf(lg[i] - mx); sum += lg[i]; } }
        sum = wave_sum(sum); const float inv = 1.f / sum;
#pragma unroll
        for (int i = 0; i < 4; ++i) { const int j = lane + 64 * i; if (j < nsel) ps[j] = lg[i] * inv; }
        LDS_FENCE();
        float o = 0.f;
        for (int j = 0; j < nsel; ++j) o += ps[j] * bf2f(KV[(size_t)sel[j] * KVW + 128 + kvh * 64 + lane]);
        const float ga = bf2f(PJ[rb + C_GA + hq * 64 + lane]);
        PJ[rb + C_GA + hq * 64 + lane] = f2bf(o * silu_f(ga));
        LDS_FENCE();
    }
}

constexpr int AT_MASK = 0;
constexpr int AT_TMASK = AT_MASK + 64 * 65 * 4;
constexpr int AT_QST = AT_TMASK + 64 * 65 * 4;
constexpr int AT_MISC = AT_QST + 1024;
constexpr int AT_LUT = AT_MISC + 64;
constexpr int AT_HIST = AT_LUT + 8192;
constexpr int AT_RING = AT_HIST;
constexpr int AT_QI = AT_HIST + 65792;
constexpr int AT_END = AT_QI + 64 * 528;
static_assert(AT_END <= LDS_BYTES - 256 && AT_RING + 65536 <= AT_END, "attention LDS map");
typedef short v4i16_t __attribute__((ext_vector_type(4)));
#define AT_WAIT_V(n) asm volatile("s_waitcnt vmcnt(" #n ")" ::: "memory")
#define AT_BAR() do { asm volatile("s_waitcnt lgkmcnt(0)" ::: "memory"); __builtin_amdgcn_s_barrier(); asm volatile("" ::: "memory"); } while (0)

template <int MODE>
DI void idx_pass(const Ctx& C, const bf16_t* KV, const float (&w4)[4], int ntiles, int tq4, int q, int r, int h) {
    LAS unsigned char* L = C.lds;
    const LAS unsigned* QS = (const LAS unsigned*)(L + AT_QST) + 4 * q;
    const unsigned pfx = QS[0], info = QS[1];
    const int lvl = info & 15; const bool done = (info >> 4) & 1, tie = (info >> 5) & 1;
    const int sh = (MODE == 0) ? (lvl == 0 ? 23 : (lvl == 1 ? 14 : (lvl == 2 ? 5 : 0))) : (int)(info >> 8);
    const unsigned bmask = (lvl == 3) ? 31u : 511u;
    const int psh = (lvl == 1) ? 23 : (lvl == 2 ? 14 : 5);
    bf16x8 an[2][4];
    if (tq4 < ntiles) {
#pragma unroll
        for (int kh = 0; kh < 2; ++kh)
#pragma unroll
            for (int ks = 0; ks < 4; ++ks) an[kh][ks] = *(const bf16x8*)(KV + (size_t)(64 * tq4 + 32 * kh + r) * KVW + 256 + 8 * h + 16 * ks);
    }
    for (int t = tq4; t < ntiles; t += 4) {
        bf16x8 ac[2][4];
#pragma unroll
        for (int kh = 0; kh < 2; ++kh)
#pragma unroll
            for (int ks = 0; ks < 4; ++ks) ac[kh][ks] = an[kh][ks];
        if (t + 4 < ntiles) {
#pragma unroll
            for (int kh = 0; kh < 2; ++kh)
#pragma unroll
                for (int ks = 0; ks < 4; ++ks) an[kh][ks] = *(const bf16x8*)(KV + (size_t)(64 * (t + 4) + 32 * kh + r) * KVW + 256 + 8 * h + 16 * ks);
        }
#pragma unroll
        for (int kh = 0; kh < 2; ++kh) {
            bf16x8 a[4];
#pragma unroll
            for (int ks = 0; ks < 4; ++ks) a[ks] = ac[kh][ks];
            float sc[16];
#pragma unroll
            for (int i = 0; i < 16; ++i) sc[i] = 0.f;
#pragma unroll
            for (int hh = 0; hh < 4; ++hh) {
                f32x16 acc;
#pragma unroll
                for (int i = 0; i < 16; ++i) acc[i] = 0.f;
#pragma unroll
                for (int ks = 0; ks < 4; ++ks) acc = MFMA32(a[ks], *(const LAS bf16x8*)(L + AT_QI + q * 528 + (64 * hh + 16 * ks + 8 * h) * 2), acc);
#pragma unroll
                for (int i = 0; i < 16; ++i) sc[i] += w4[hh] * fmaxf(acc[i], 0.f);
            }
            if (MODE == 0) {
                if (!done) {
                    LAS unsigned* HR = (LAS unsigned*)(L + AT_HIST) + 257 * q;
#pragma unroll
                    for (int i = 0; i < 16; ++i) {
                        const unsigned key = mono_key(sc[i]);
                        const bool part = (lvl == 0) || ((key >> psh) == pfx);
                        if (part) { const unsigned bin = (key >> sh) & bmask; atomicAdd((unsigned*)(HR + (bin >> 1)), 1u << ((bin & 1u) << 4)); }
                    }
                }
            } else {
                unsigned mw = 0u, tw = 0u;
#pragma unroll
                for (int i = 15; i >= 0; --i) {
                    const unsigned key = mono_key(sc[i]);
                    const bool sel = tie ? (key > pfx) : ((key >> sh) >= pfx);
                    const bool tb = tie && (key == pfx);
                    mw = (mw << 1) | (sel ? 1u : 0u); tw = (tw << 1) | (tb ? 1u : 0u);
                    if ((i & 3) == 0 && i > 0) { mw <<= 4; tw <<= 4; }
                }
                mw <<= 4 * h; tw <<= 4 * h;
                if (mw) atomicOr((unsigned*)((LAS unsigned*)(L + AT_MASK) + 65 * q + 2 * t + kh), mw);
                if (tw) atomicOr((unsigned*)((LAS unsigned*)(L + AT_TMASK) + 65 * q + 2 * t + kh), tw);
            }
        }
    }
}

DI void attn_item(const Ctx& C, int l, int sb, int qb) {
    const int tid = C.tid, lane = C.lane, wave = C.wave, r = lane & 31, h = lane >> 5;
    LAS unsigned char* L = C.lds;
    const int P = sb_P(sb), row0 = sb_row0(sb), t0 = 64 * qb, pos0 = P + t0;
    const int ntiles = (pos0 >> 6) + 1, Ladm = 64 * ntiles;
    bf16_t* PJ = C.proj(); const bf16_t* KV = C.kvb(l) + kvb_off(sb);
    LAS unsigned* MASK = (LAS unsigned*)(L + AT_MASK); LAS unsigned* TMASK = (LAS unsigned*)(L + AT_TMASK);
    LAS unsigned* QST = (LAS unsigned*)(L + AT_QST); LAS unsigned* MISC = (LAS unsigned*)(L + AT_MISC);
    for (int i = tid; i < 64 * 65; i += NTHREADS) { const int w = i % 65; MASK[i] = (Ladm <= 256 && w < 2 * ntiles) ? 0xffffffffu : 0u; TMASK[i] = 0u; }
    for (int i = tid; i < 64 * 257; i += NTHREADS) ((LAS unsigned*)(L + AT_HIST))[i] = 0u;
    if (tid < 64) { unsigned k256 = 256u; asm volatile("" : "+v"(k256)); QST[4 * tid] = 0u; QST[4 * tid + 1] = 0u; QST[4 * tid + 2] = k256; QST[4 * tid + 3] = 0u; }
    for (int i = tid; i < 8 * 256; i += NTHREADS) { const int hq = i >> 8, rel = (i & 255) - 191; ((LAS float*)(L + AT_LUT))[i] = 1.4426950408889634f * C.inp(20)[t5_bucket(rel) * 8 + hq]; }
    if (tid == 0) MISC[0] = 0u;
    __syncthreads();
    PROBE_BEGIN(4);
    if (Ladm > 256) {
        const int qh = wave & 1, tq4 = wave >> 1, q = 32 * qh + r;
        float w4[4];
        { const f32x4 wv = *(const f32x4*)(C.wi() + (size_t)(row0 + t0 + q) * 4); w4[0] = wv[0]; w4[1] = wv[1]; w4[2] = wv[2]; w4[3] = wv[3]; }
        for (int i = tid; i < 2048; i += NTHREADS) { const int qq = i >> 5, pc = i & 31;
            *(LAS u32x4*)(L + AT_QI + qq * 528 + pc * 16) = *(const u32x4*)(PJ + (size_t)(row0 + t0 + qq) * PJW + C_QI + 8 * pc); }
        __syncthreads();
        for (int lvl = 0; lvl < 4; ++lvl) {
            idx_pass<0>(C, KV, w4, ntiles, tq4, q, r, h);
            if (tid == 0) MISC[0] = 0u;
            __syncthreads();
            int ln = lane; asm volatile("" : "+v"(ln));
            for (int qq = 8 * wave; qq < 8 * wave + 8; ++qq) {
                const unsigned pfx = QST[4 * qq], info = QST[4 * qq + 1], need = QST[4 * qq + 2];
                if ((info >> 4) & 1) continue;
                LAS unsigned* HR = (LAS unsigned*)(L + AT_HIST) + 257 * qq + 4 * ln;
                unsigned c[8];
#pragma unroll
                for (int j = 0; j < 4; ++j) { const unsigned wv = HR[j]; c[2 * j] = wv & 0xffffu; c[2 * j + 1] = wv >> 16; HR[j] = 0u; }
                unsigned ct = 0u;
#pragma unroll
                for (int j = 0; j < 8; ++j) ct += c[j];
                unsigned S = ct;
#pragma unroll
                for (int o = 1; o < 64; o <<= 1) { const unsigned y = (unsigned)__builtin_amdgcn_ds_bpermute((ln + o) << 2, (int)S); if (ln + o < 64) S += y; }
                if (S >= need && (S - ct) < need) {
                    unsigned rem = need - (S - ct), cum = 0u; int b = 0; unsigned cb = 0u;
                    bool found = false;
#pragma unroll
                    for (int j = 7; j >= 0; --j) { if (!found) { if (cum + c[j] >= rem) { b = j; cb = c[j]; found = true; } else cum += c[j]; } }
                    const unsigned need2 = rem - cum, binidx = 8u * ln + (unsigned)b;
                    const int bits = (lvl == 3) ? 5 : 9, shc = (lvl == 0) ? 23 : (lvl == 1 ? 14 : (lvl == 2 ? 5 : 0));
                    const unsigned npfx = (lvl == 0) ? binidx : ((pfx << bits) | binidx);
                    unsigned ninfo, nneed = need2, opfx = npfx;
                    if (need2 == cb) ninfo = (unsigned)lvl | 16u | ((unsigned)shc << 8);
                    else if (lvl == 0 && (binidx == 256u || binidx == 255u)) { ninfo = 16u | 32u; opfx = (binidx == 256u) ? 0x80000000u : 0x7fffffffu; }
                    else if (lvl == 3) ninfo = 16u | 32u;
                    else { ninfo = (unsigned)(lvl + 1); atomicAdd((unsigned*)MISC, 1u); }
                    QST[4 * qq] = opfx; QST[4 * qq + 1] = ninfo; QST[4 * qq + 2] = nneed;
                }
            }
            __syncthreads();
            if (MISC[0] == 0u) break;
            __syncthreads();
        }
        idx_pass<1>(C, KV, w4, ntiles, tq4, q, r, h);
        __syncthreads();
        int ln2 = lane; asm volatile("" : "+v"(ln2));
        for (int qq = 8 * wave; qq < 8 * wave + 8; ++qq) {
            if (!((QST[4 * qq + 1] >> 5) & 1)) continue;
            const unsigned mwd = (ln2 < 2 * ntiles) ? MASK[65 * qq + ln2] : 0u, twd = (ln2 < 2 * ntiles) ? TMASK[65 * qq + ln2] : 0u;
            int have = __popc(mwd);
#pragma unroll
            for (int o = 1; o < 64; o <<= 1) have += __builtin_amdgcn_ds_bpermute((ln2 ^ o) << 2, have);
            const int want = 256 - have, pc = __popc(twd);
            int incl = pc;
#pragma unroll
            for (int o = 1; o < 64; o <<= 1) { const int y = __builtin_amdgcn_ds_bpermute((ln2 - o) << 2, incl); if (ln2 >= o) incl += y; }
            int take = want - (incl - pc); take = take < 0 ? 0 : (take > pc ? pc : take);
            unsigned wrem = twd, add = 0u;
            for (int k = 0; k < take; ++k) { add |= wrem & (0u - wrem); wrem &= wrem - 1u; }
            if (add) MASK[65 * qq + ln2] = mwd | add;
        }
        __syncthreads();
    }
    if (l == 0) PROBE_END(4, C);
    PROBE_BEGIN(5);
    const int hq = wave, kvh = wave >> 2;
    const unsigned ring = (unsigned)(size_t)(L + AT_RING);
    const float* LUT = nullptr; (void)LUT;
    const LAS float* lut = (const LAS float*)(L + AT_LUT) + 256 * hq;
    const float cfar = lut[0];
#define AT_DMA(tt, slot) do { const bf16_t* src_ = KV + (size_t)(64 * (tt)) * KVW; \
        _Pragma("unroll") for (int i_ = 0; i_ < 2; ++i_) { const int k_ = wave * 2 + i_, row_ = 4 * k_ + (lane >> 4), pc_ = lane & 15; \
            __builtin_amdgcn_global_load_lds((const unsigned*)(src_ + (size_t)row_ * KVW + 8 * (pc_ ^ (row_ & 15))), (LAS unsigned*)(L + AT_RING + (slot) * 32768 + k_ * 1024), 16, 0, 0); \
            __builtin_amdgcn_global_load_lds((const unsigned*)(src_ + (size_t)row_ * KVW + 128 + 8 * pc_), (LAS unsigned*)(L + AT_RING + (slot) * 32768 + 16384 + k_ * 1024), 16, 0, 0); } \
    } while (0)
    for (int qh = 0; qh < 2; ++qh) {
        const int q = 32 * qh + r, qrow = row0 + t0 + q;
        bf16x8 qf[4];
        { const bf16_t* qp = PJ + (size_t)qrow * PJW + C_Q + hq * 64 + 8 * h; float qv[4][8]; float ss = 0.f;
#pragma unroll
          for (int ks = 0; ks < 4; ++ks) { const u32x4 v = *(const u32x4*)(qp + 16 * ks);
              qv[ks][0] = __uint_as_float(v.x << 16); qv[ks][1] = __uint_as_float(v.x & 0xffff0000u); qv[ks][2] = __uint_as_float(v.y << 16); qv[ks][3] = __uint_as_float(v.y & 0xffff0000u);
              qv[ks][4] = __uint_as_float(v.z << 16); qv[ks][5] = __uint_as_float(v.z & 0xffff0000u); qv[ks][6] = __uint_as_float(v.w << 16); qv[ks][7] = __uint_as_float(v.w & 0xffff0000u);
#pragma unroll
              for (int j = 0; j < 8; ++j) ss += qv[ks][j] * qv[ks][j]; }
          ss = xor32_sum(ss);
          const float sc = rsqrtf(ss * (1.f / 64.f) + EPS) * (0.125f * 1.4426950408889634f);
          const float* qn = C.inp(18) + l * 64 + 8 * h;
#pragma unroll
          for (int ks = 0; ks < 4; ++ks) { const f32x4 n0 = *(const f32x4*)(qn + 16 * ks), n1 = *(const f32x4*)(qn + 16 * ks + 4);
              u32x4 p; p.x = cvt_pk_bf16(qv[ks][0] * sc * n0[0], qv[ks][1] * sc * n0[1]); p.y = cvt_pk_bf16(qv[ks][2] * sc * n0[2], qv[ks][3] * sc * n0[3]);
              p.z = cvt_pk_bf16(qv[ks][4] * sc * n1[0], qv[ks][5] * sc * n1[1]); p.w = cvt_pk_bf16(qv[ks][6] * sc * n1[2], qv[ks][7] * sc * n1[3]);
              qf[ks] = __builtin_bit_cast(bf16x8, p); } }
        f32x16 o0, o1;
#pragma unroll
        for (int i = 0; i < 16; ++i) { o0[i] = 0.f; o1[i] = 0.f; }
        float mrun = -1e30f, lrun = 0.f;
        AT_WAIT_V(0);
        AT_DMA(0, 0);
        for (int t = 0; t < ntiles; ++t) {
            const int slot = t & 1;
            if (t + 1 < ntiles) { AT_DMA(t + 1, slot ^ 1); AT_WAIT_V(4); } else { AT_WAIT_V(0); }
            AT_BAR();
            const LAS unsigned char* Kt = L + AT_RING + slot * 32768; const LAS unsigned char* Vt = Kt + 16384;
            f32x16 s0, s1;
#pragma unroll
            for (int i = 0; i < 16; ++i) { s0[i] = 0.f; s1[i] = 0.f; }
#pragma unroll
            for (int ks = 0; ks < 4; ++ks) {
                const int pc = kvh * 8 + 2 * ks + h;
                const bf16x8 k0 = *(const LAS bf16x8*)(Kt + r * 256 + ((pc ^ (r & 15)) << 4));
                const bf16x8 k1 = *(const LAS bf16x8*)(Kt + (32 + r) * 256 + ((pc ^ (r & 15)) << 4));
                s0 = MFMA32(k0, qf[ks], s0); s1 = MFMA32(k1, qf[ks], s1);
            }
            const unsigned m0 = MASK[65 * q + 2 * t] >> (4 * h), m1 = MASK[65 * q + 2 * t + 1] >> (4 * h);
            const bool nearb = (t + 3 > ntiles - 1);
            float tmax = -1e30f;
#pragma unroll
            for (int i = 0; i < 16; ++i) {
                const int kl = (i & 3) + 8 * (i >> 2);
                float b0 = cfar, b1 = cfar;
                if (nearb) { const int rel = 64 * t + kl + 4 * h - (pos0 + q); b0 = lut[rel + 191]; b1 = lut[rel + 32 + 191]; }
                s0[i] += b0; s1[i] += b1;
                if ((m0 >> kl) & 1u) tmax = fmaxf(tmax, s0[i]);
                if ((m1 >> kl) & 1u) tmax = fmaxf(tmax, s1[i]);
            }
            tmax = xor32_max(tmax);
            const float mnew = fmaxf(mrun, tmax), alpha = __builtin_amdgcn_exp2f(mrun - mnew);
            mrun = mnew;
            float psum = 0.f;
#pragma unroll
            for (int i = 0; i < 16; ++i) {
                const int kl = (i & 3) + 8 * (i >> 2);
                const float p0 = ((m0 >> kl) & 1u) ? __builtin_amdgcn_exp2f(s0[i] - mnew) : 0.f, p1 = ((m1 >> kl) & 1u) ? __builtin_amdgcn_exp2f(s1[i] - mnew) : 0.f;
                s0[i] = p0; s1[i] = p1; psum += p0 + p1;
            }
            lrun = lrun * alpha + psum;
#pragma unroll
            for (int i = 0; i < 16; ++i) { o0[i] *= alpha; o1[i] *= alpha; }
#pragma unroll
            for (int kk = 0; kk < 4; ++kk) {
                u32x4 pw;
                if (kk == 0) { pw.x = cvt_pk_bf16(s0[0], s0[1]); pw.y = cvt_pk_bf16(s0[2], s0[3]); pw.z = cvt_pk_bf16(s0[4], s0[5]); pw.w = cvt_pk_bf16(s0[6], s0[7]); }
                else if (kk == 1) { pw.x = cvt_pk_bf16(s0[8], s0[9]); pw.y = cvt_pk_bf16(s0[10], s0[11]); pw.z = cvt_pk_bf16(s0[12], s0[13]); pw.w = cvt_pk_bf16(s0[14], s0[15]); }
                else if (kk == 2) { pw.x = cvt_pk_bf16(s1[0], s1[1]); pw.y = cvt_pk_bf16(s1[2], s1[3]); pw.z = cvt_pk_bf16(s1[4], s1[5]); pw.w = cvt_pk_bf16(s1[6], s1[7]); }
                else { pw.x = cvt_pk_bf16(s1[8], s1[9]); pw.y = cvt_pk_bf16(s1[10], s1[11]); pw.z = cvt_pk_bf16(s1[12], s1[13]); pw.w = cvt_pk_bf16(s1[14], s1[15]); }
                const bf16x8 pb = __builtin_bit_cast(bf16x8, pw);
                const int i16 = lane & 15, key0 = 16 * kk + 4 * h + (i16 >> 2);
#pragma unroll
                for (int dh = 0; dh < 2; ++dh) {
                    const int dcol = kvh * 64 + 32 * dh + 16 * ((lane >> 4) & 1) + 4 * (i16 & 3);
                    const v4i16_t lo = __builtin_amdgcn_ds_read_tr16_b64_v4i16((LAS v4i16_t*)(Vt + key0 * 256 + dcol * 2));
                    const v4i16_t hi = __builtin_amdgcn_ds_read_tr16_b64_v4i16((LAS v4i16_t*)(Vt + (key0 + 8) * 256 + dcol * 2));
                    const bf16x8 va = (bf16x8){lo[0], lo[1], lo[2], lo[3], hi[0], hi[1], hi[2], hi[3]};
                    if (dh == 0) o0 = MFMA32(va, pb, o0); else o1 = MFMA32(va, pb, o1);
                }
            }
            AT_BAR();
        }
        lrun = xor32_sum(lrun);
        const float inv = 1.f / lrun;
        bf16_t* gp = PJ + (size_t)qrow * PJW + C_GA + hq * 64 + 4 * h;
#pragma unroll
        for (int dh = 0; dh < 2; ++dh)
#pragma unroll
            for (int gq = 0; gq < 4; ++gq) {
                const u32x2 gg = *(const u32x2*)(gp + 32 * dh + 8 * gq);
                const float g0 = __uint_as_float(gg.x << 16), g1 = __uint_as_float(gg.x & 0xffff0000u), g2 = __uint_as_float(gg.y << 16), g3 = __uint_as_float(gg.y & 0xffff0000u);
                const float a0 = (dh == 0 ? o0[4 * gq] : o1[4 * gq]) * inv, a1 = (dh == 0 ? o0[4 * gq + 1] : o1[4 * gq + 1]) * inv, a2 = (dh == 0 ? o0[4 * gq + 2] : o1[4 * gq + 2]) * inv, a3 = (dh == 0 ? o0[4 * gq + 3] : o1[4 * gq + 3]) * inv;
                u32x2 w; w.x = cvt_pk_bf16(a0 * fast_silu(g0), a1 * fast_silu(g1)); w.y = cvt_pk_bf16(a2 * fast_silu(g2), a3 * fast_silu(g3));
                *(u32x2*)(gp + 32 * dh + 8 * gq) = w;
            }
    }
#undef AT_DMA
    AT_WAIT_V(0);
    __syncthreads();
    if (l == 0) PROBE_END(5, C);
}

constexpr int LR_RAW = 0;
constexpr int LR_GL = LR_RAW + 67 * 128;
constexpr int LR_XC = LR_GL + 2 * 8192;
constexpr int LR_XCF = LR_XC + 64 * 144;
constexpr int LR_SEG = LR_XCF + 64 * 256;
constexpr int LR_YS = LR_SEG + 2048;
constexpr int LR_END = LR_YS + 8192;
static_assert(LR_END <= LDS_BYTES - 256, "LRU LDS map");
typedef float f32x4v __attribute__((ext_vector_type(4)));
#define MFMA16(a, b, c) __builtin_amdgcn_mfma_f32_16x16x32_bf16((a), (b), (c), 0, 0, 0)
DI float fast_sigmoid(float x) { return __builtin_amdgcn_rcpf(1.f + __builtin_amdgcn_exp2f(-1.4426950408889634f * x)); }

DI void lru_item(const Ctx& C, int l, int sb, int blk) {
    const int tid = C.tid, lane = C.lane, wave = C.wave, fr = lane & 15, fq = lane >> 4;
    const int T = sb_T(sb), row0 = sb_row0(sb), NC = T / 64;
    LAS unsigned char* L = C.lds;
    bf16_t* PJ = C.proj();
    const int ts = wave >> 1, dh = wave & 1;
    bf16x8 wf[2][2][2];
#pragma unroll
    for (int gt = 0; gt < 2; ++gt)
#pragma unroll
        for (int db = 0; db < 2; ++db)
#pragma unroll
            for (int kb = 0; kb < 2; ++kb) {
                const float* wp = (gt == 0 ? C.inp(13) : C.inp(15)) + ((size_t)(l * 8 + blk) * 64 + 32 * kb + 8 * fq) * 64 + 32 * dh + 16 * db + fr;
                u32x4 p; p.x = cvt_pk_bf16(wp[0], wp[64]); p.y = cvt_pk_bf16(wp[128], wp[192]); p.z = cvt_pk_bf16(wp[256], wp[320]); p.w = cvt_pk_bf16(wp[384], wp[448]);
                wf[gt][db][kb] = __builtin_bit_cast(bf16x8, p);
            }
    float ba[2], bx[2], spl[2], hc[2];
#pragma unroll
    for (int db = 0; db < 2; ++db) {
        const int ch = blk * 64 + 32 * dh + 16 * db + fr;
        ba[db] = C.inp(14)[l * 512 + ch]; bx[db] = C.inp(16)[l * 512 + ch]; spl[db] = 8.f * 1.4426950408889634f * softplus_f(-C.inp(17)[l * 512 + ch]);
        hc[db] = (sb >= NPB) ? C.inp(6)[(size_t)(l * NSB_S + sb - NPB) * 512 + ch] : 0.f;
    }
    const int cp = tid & 31, sg = tid >> 5;
    float cw[2][5];
#pragma unroll
    for (int e = 0; e < 2; ++e) { const int ch = blk * 64 + 2 * cp + e;
#pragma unroll
        for (int j = 0; j < 4; ++j) cw[e][j] = C.inp(11)[((size_t)l * 4 + j) * 512 + ch];
        cw[e][4] = C.inp(12)[l * 512 + ch]; }
#define LRU_DMA(cc) do { const int t0_ = 64 * (cc); \
        for (int k_ = wave; k_ < 9; k_ += NWAVES) { const int q_ = 64 * k_ + lane, rr_ = q_ >> 3, pc_ = q_ & 7, t_ = t0_ - 3 + rr_; \
            if (q_ < 536 && t_ >= 0) __builtin_amdgcn_global_load_lds((const unsigned*)(PJ + (size_t)(row0 + t_) * PJW + C_XL + blk * 64 + 8 * pc_), (LAS unsigned*)(L + LR_RAW + k_ * 1024), 16, 0, 0); } \
        { const int rr_ = 8 * wave + (lane >> 3), pc_ = lane & 7; \
          __builtin_amdgcn_global_load_lds((const unsigned*)(PJ + (size_t)(row0 + t0_ + rr_) * PJW + C_GL + blk * 64 + 8 * pc_), (LAS unsigned*)(L + LR_GL + ((cc) & 1) * 8192 + wave * 1024), 16, 0, 0); } \
    } while (0)
    if (tid < 24) {
        const int rr = tid >> 3, pc = tid & 7; u32x4 v = (u32x4){0u, 0u, 0u, 0u};
        if (sb >= NPB) { const float* st = C.inp(5) + ((size_t)(l * NSB_S + sb - NPB) * 3 + rr) * 512 + blk * 64 + 8 * pc; v = pack8(*(const f32x4*)st, *(const f32x4*)(st + 4)); }
        *(LAS u32x4*)(L + LR_RAW + rr * 128 + pc * 16) = v;
    }
    LRU_DMA(0);
    asm volatile("s_waitcnt vmcnt(0)" ::: "memory");
    __syncthreads();
    for (int c = 0; c < NC; ++c) {
        const int t0 = 64 * c;
        {
            float xa[7], xb[7];
#pragma unroll
            for (int i = 0; i < 7; ++i) { const unsigned w = *(const LAS unsigned*)(L + LR_RAW + (4 * sg + i) * 128 + 4 * cp); xa[i] = __uint_as_float(w << 16); xb[i] = __uint_as_float(w & 0xffff0000u); }
#pragma unroll
            for (int j = 0; j < 4; ++j) {
                const float ya = cw[0][4] + cw[0][0] * xa[j] + cw[0][1] * xa[j + 1] + cw[0][2] * xa[j + 2] + cw[0][3] * xa[j + 3];
                const float yb = cw[1][4] + cw[1][0] * xb[j] + cw[1][1] * xb[j + 1] + cw[1][2] * xb[j + 2] + cw[1][3] * xb[j + 3];
                *(LAS unsigned*)(L + LR_XC + (4 * sg + j) * 144 + 4 * cp) = cvt_pk_bf16(ya, yb);
                f32x2_t v2 = {ya, yb}; *(LAS f32x2_t*)(L + LR_XCF + (4 * sg + j) * 256 + 8 * cp) = v2;
            }
        }
        LDS_FENCE(); __syncthreads();
        if (c + 1 < NC) LRU_DMA(c + 1);
        f32x4v ga[2], gx[2];
#pragma unroll
        for (int db = 0; db < 2; ++db) { ga[db] = (f32x4v){0.f, 0.f, 0.f, 0.f}; gx[db] = (f32x4v){0.f, 0.f, 0.f, 0.f}; }
#pragma unroll
        for (int kb = 0; kb < 2; ++kb) {
            const bf16x8 af = *(const LAS bf16x8*)(L + LR_XC + (16 * ts + fr) * 144 + (32 * kb + 8 * fq) * 2);
#pragma unroll
            for (int db = 0; db < 2; ++db) { ga[db] = MFMA16(af, wf[0][db][kb], ga[db]); gx[db] = MFMA16(af, wf[1][db][kb], gx[db]); }
        }
        float Pk[2][4], Hk[2][4], Pq[2], Hq[2];
#pragma unroll
        for (int db = 0; db < 2; ++db) {
            float P = 1.f, H = 0.f;
#pragma unroll
            for (int reg = 0; reg < 4; ++reg) {
                const float xc = *(const LAS float*)(L + LR_XCF + (16 * ts + 4 * fq + reg) * 256 + (32 * dh + 16 * db + fr) * 4);
                const float rg = fast_sigmoid(ga[db][reg] + ba[db]), ig = fast_sigmoid(gx[db][reg] + bx[db]);
                const float a = __builtin_amdgcn_exp2f(-rg * spl[db]);
                const float b = sqrtf(fmaxf(1.f - a * a, 0.f)) * (ig * xc);
                H = a * H + b; P = a * P; Pk[db][reg] = P; Hk[db][reg] = H;
            }
            float Pi = P, Hi = H;
            { const float Pp = bperm(Pi, lane - 16), Hp = bperm(Hi, lane - 16); if (fq >= 1) { Hi = Pi * Hp + Hi; Pi = Pi * Pp; } }
            { const float Pp = bperm(Pi, lane - 32), Hp = bperm(Hi, lane - 32); if (fq >= 2) { Hi = Pi * Hp + Hi; Pi = Pi * Pp; } }
            if (fq == 3) { f32x2_t v2 = {Pi, Hi}; *(LAS f32x2_t*)(L + LR_SEG + (ts * 64 + 32 * dh + 16 * db + fr) * 8) = v2; }
            const float Pe = bperm(Pi, lane - 16), He = bperm(Hi, lane - 16);
            Pq[db] = (fq >= 1) ? Pe : 1.f; Hq[db] = (fq >= 1) ? He : 0.f;
        }
        LDS_FENCE(); __syncthreads();
#pragma unroll
        for (int db = 0; db < 2; ++db) {
            float s = hc[db], sin = hc[db];
#pragma unroll
            for (int k = 0; k < 4; ++k) { const f32x2_t m = *(const LAS f32x2_t*)(L + LR_SEG + (k * 64 + 32 * dh + 16 * db + fr) * 8); if (k == ts) sin = s; s = m[0] * s + m[1]; }
            hc[db] = s;
            const float hin = Pq[db] * sin + Hq[db];
            const bf16_t* glp = nullptr; (void)glp;
#pragma unroll
            for (int reg = 0; reg < 4; ++reg) {
                const float hval = Pk[db][reg] * hin + Hk[db][reg];
                const int t = 16 * ts + 4 * fq + reg, d = 32 * dh + 16 * db + fr;
                const float glv = bf2f(*(const LAS bf16_t*)(L + LR_GL + (c & 1) * 8192 + t * 128 + d * 2));
                *(LAS bf16_t*)(L + LR_YS + t * 128 + d * 2) = f2bf(hval * fast_silu(glv));
            }
        }
        asm volatile("s_waitcnt vmcnt(0)" ::: "memory");
        LDS_FENCE(); __syncthreads();
        { const int rr = tid >> 3, pc = tid & 7;
          *(u32x4*)(PJ + (size_t)(row0 + t0 + rr) * PJW + C_GL + blk * 64 + 8 * pc) = *(const LAS u32x4*)(L + LR_YS + rr * 128 + pc * 16); }
    }
    if (ts == 0 && fq == 0) {
#pragma unroll
        for (int db = 0; db < 2; ++db) out_lh(C, l, sb)[blk * 64 + 32 * dh + 16 * db + fr] = hc[db];
    }
#undef LRU_DMA
    asm volatile("s_waitcnt vmcnt(0)" ::: "memory");
    __syncthreads();
}

DI Ctx relaunder(const Ctx& C0) {
    Ctx C = C0; int ln; asm volatile("v_mbcnt_lo_u32_b32 %0, -1, 0\n\tv_mbcnt_hi_u32_b32 %0, -1, %0" : "=v"(ln)); C.lane = ln; C.tid = C.wave * 64 + ln;
    asm volatile("" : "+s"(C.ws), "+s"(C.out)); asm volatile("" : "+s"(C.G), "+s"(C.bid));
    return C;
}
constexpr int CW_QUEUE = 8192;
constexpr int MX_A = 144, MX_B = MX_A + 256, MX_C0 = MX_B + 8, MX_C = MX_C0 + 240, MX_D = MX_C + 128, MX_E = MX_D + 128, MX_F = MX_E + 128, MX_N = MX_F + 64;
DI void phase_mixers(const Ctx& Cin, int l) {
    unsigned* head = (unsigned*)(Cin.ws + WS_CTL) + CW_QUEUE + 64 * l;
    volatile LAS int* slot = (volatile LAS int*)(Cin.lds + LDS_BYTES - 24);
    for (;;) {
        __syncthreads();
        if (Cin.tid == 0) *slot = (int)__hip_atomic_fetch_add(head, 1u, __ATOMIC_RELAXED, __HIP_MEMORY_SCOPE_AGENT);
        __syncthreads();
        const int i = __builtin_amdgcn_readfirstlane(*slot);
        if (i >= MX_N) break;
        const Ctx C = relaunder(Cin);
        if (i < MX_A) { attn_item(C, l, i & 15, 31 - (i >> 4)); }
        else if (i < MX_B) { const int j = i - MX_A; ssd_item(C, l, j >> 4, j & 15); }
        else if (i < MX_C0) { attn_item(C, l, NPB + (i - MX_B), 0); }
        else if (i < MX_C) { const int j = i - MX_C0; attn_item(C, l, j & 15, 22 - (j >> 4)); }
        else if (i < MX_D) { const int j = i - MX_C; lru_item(C, l, j >> 3, j & 7); }
        else if (i < MX_E) { const int j = i - MX_D; attn_item(C, l, j & 15, 7 - (j >> 4)); }
        else if (i < MX_F) { const int j = i - MX_E; ssd_item(C, l, NPB + (j >> 4), j & 15); }
        else { const int j = i - MX_F; lru_item(C, l, NPB + (j >> 3), j & 7); }
    }
}

#define XB_TMO      128
#define XB_XCNT(j)  (256  + 64 * (j))
#define XB_XSUB(j)  (1280 + 64 * (j))
#define XB_XGEN(j)  (2304 + 64 * (j))
#define XB_TOP      3328
#define XB_TOPGEN   3392
#define XCD_BAR_WORDS 3456
#define XB_SPIN_CAP (1u << 22)

__device__ __forceinline__ unsigned xb_ld(unsigned* p)              { return __hip_atomic_load(p, __ATOMIC_RELAXED, __HIP_MEMORY_SCOPE_AGENT); }
__device__ __forceinline__ unsigned xb_add(unsigned* p, unsigned v) { return __hip_atomic_fetch_add(p, v, __ATOMIC_RELAXED, __HIP_MEMORY_SCOPE_AGENT); }
__device__ __forceinline__ unsigned xb_xcc_id() { return (unsigned)__builtin_amdgcn_s_getreg((3 << 11) | 20) & 0xFu; }
#define XB_SPIN(cond, bar) do { unsigned _sp = 0; while (cond) { __builtin_amdgcn_s_sleep(1); \
    if ((++_sp & 255u) == 0u) { if (xb_ld(&(bar)[XB_TMO])) break; if (_sp > XB_SPIN_CAP) { atomicAdd(&(bar)[XB_TMO], 1u); break; } } } } while (0)

struct XcdBarrier {
    unsigned* bar; unsigned x;
    volatile LAS unsigned* st;
};

__device__ __forceinline__ XcdBarrier xcd_barrier_post(unsigned* bar, volatile LAS unsigned* st) {
    XcdBarrier b; b.bar = bar; b.x = xb_xcc_id(); b.st = st;
    if (threadIdx.x == 0) (void)xb_add(&bar[XB_XCNT(b.x)], 1u);
    return b;
}
__device__ __forceinline__ void xcd_barrier_complete(unsigned* bar, unsigned x, unsigned& nloc, unsigned& nx) {
    const unsigned G = gridDim.x * gridDim.y * gridDim.z;
    unsigned sum, cnt, mine, sp = 0u;
    for (;;) {
        sum = 0u; cnt = 0u; mine = 0u;
#pragma unroll
        for (unsigned j = 0; j < 16; ++j) { const unsigned c = xb_ld(&bar[XB_XCNT(j)]); sum += c; cnt += (c > 0u) ? 1u : 0u; mine = (j == x) ? c : mine; }
        if (sum == G) break;
        __builtin_amdgcn_s_sleep(1);
        if ((++sp & 255u) == 0u) { if (xb_ld(&bar[XB_TMO])) break; if (sp > XB_SPIN_CAP) { atomicAdd(&bar[XB_TMO], 1u); break; } }
    }
    nloc = mine > 0u ? mine : 1u; nx = cnt > 0u ? cnt : 1u;
}

__device__ __forceinline__ void xcd_barrier(const XcdBarrier& b) {
    asm volatile("s_waitcnt vmcnt(0)" ::: "memory");
    __syncthreads();
    if (threadIdx.x == 0) {
        unsigned* bar = b.bar;
        __builtin_amdgcn_s_waitcnt(0);
        unsigned nloc = b.st[0], nx = b.st[1];
        if (nloc == 0u) { xcd_barrier_complete(bar, b.x, nloc, nx); b.st[0] = nloc; b.st[1] = nx; }
        const unsigned old = xb_add(&bar[XB_XSUB(b.x)], 1u);
        const unsigned gen = old / nloc;
        if (old + 1u == (gen + 1u) * nloc) {
            __builtin_amdgcn_fence(__ATOMIC_RELEASE, "agent");
            asm volatile("s_waitcnt vmcnt(0)" ::: "memory");
            const unsigned og = xb_add(&bar[XB_TOP], 1u);
            const unsigned tg = og / nx;
            if (og + 1u == (tg + 1u) * nx) xb_add(&bar[XB_TOPGEN], 1u);
            else XB_SPIN(xb_ld(&bar[XB_TOPGEN]) == tg, bar);
            __builtin_amdgcn_fence(__ATOMIC_ACQUIRE, "agent");
            xb_add(&bar[XB_XGEN(b.x)], 1u);
            asm volatile("s_waitcnt vmcnt(0)" ::: "memory");
        } else {
            XB_SPIN(xb_ld(&bar[XB_XGEN(b.x)]) == gen, bar);
            __builtin_amdgcn_fence(__ATOMIC_ACQUIRE, "agent");
            asm volatile("s_waitcnt vmcnt(0)" ::: "memory");
        }
    }
    __syncthreads();
}


constexpr int PH_PER_LAYER = 4;
constexpr int N_PHASES = 1 + 2 * PH_PER_LAYER;
constexpr int CW_BAR = 4096;
__global__ void __launch_bounds__(NTHREADS, 2) mk_fwd(Args a) {
    extern __shared__ __attribute__((aligned(16))) unsigned char lds_raw[];
    Ctx C; C.out = a.out; C.ws = a.ws; C.lds = (LAS unsigned char*)lds_raw;
    C.tid = threadIdx.x; C.lane = C.tid & 63; C.wave = __builtin_amdgcn_readfirstlane(C.tid >> 6); C.G = gridDim.x; C.bid = blockIdx.x;
    if (C.tid == 0) {
#pragma unroll
        for (int i = 0; i < 28; ++i) ((LAS cfp_t*)(C.lds + LDS_BYTES - 256))[i] = a.in[i];
        ((volatile LAS unsigned*)(C.lds + LDS_BYTES - 32))[0] = 0u; ((volatile LAS unsigned*)(C.lds + LDS_BYTES - 32))[1] = 0u;
        *(LAS unsigned long long*)(C.lds + LDS_BYTES - 16) = 0ull;
    }
    __syncthreads();
    const XcdBarrier bar = xcd_barrier_post((unsigned*)(a.ws + WS_CTL) + CW_BAR, (volatile LAS unsigned*)(C.lds + LDS_BYTES - 32));
    const Ctx C0 = C;
#define LAUNDER() const Ctx C = relaunder(C0)
#ifdef PROBE_PHASE
    unsigned long long pr_t0 = 0, pr_t1 = 0;
#endif
    for (int ph = a.ph_lo; ph < a.ph_hi; ++ph) {
#ifdef PROBE_PHASE
        if (ph == PROBE_PHASE) pr_t0 = __builtin_amdgcn_s_memrealtime();
#endif
        if (ph == 0) { LAUNDER(); phase_prologue(C); }
        else {
            const int l = (ph - 1) / PH_PER_LAYER, k = (ph - 1) % PH_PER_LAYER;
            if (k == 0) { LAUNDER(); phase_inproj_gemm(C, l); }
            else if (k == 1) { LAUNDER(); phase_mixers(C, l); }
            else if (k == 2) { LAUNDER(); phase_ycnorm(C, l); }
            else { LAUNDER(); phase_outproj_gemm(C, l); }
        }
        if (ph + 1 < a.ph_hi) { if (ph == 0) cg::this_grid().sync(); else xcd_barrier(bar); }
#ifdef PROBE_PHASE
        if (ph == PROBE_PHASE) pr_t1 = __builtin_amdgcn_s_memrealtime();
#endif
    }
#ifdef PROBE_PHASE
#ifdef PROBE_SUB
    pr_t0 = 0; pr_t1 = *(LAS unsigned long long*)(C0.lds + LDS_BYTES - 16);
#endif
#ifndef PROBE_BLOCK
#define PROBE_BLOCK 0
#endif
    if (blockIdx.x == PROBE_BLOCK) { const unsigned long long te = __builtin_amdgcn_s_memrealtime(), span = 4ull * (pr_t1 - pr_t0); while (__builtin_amdgcn_s_memrealtime() - te < span) __builtin_amdgcn_s_sleep(8); }
#endif
}

extern "C" void kernel_launch(void* const* d_in, const int* in_sizes, int n_in, void* d_out, int out_size, void* d_ws, size_t ws_size, hipStream_t stream) {
    static int grid = 0;
    if (grid == 0) {
        if (n_in != 28 || (size_t)out_size != O_END || ws_size < WS_END) { fprintf(stderr, "kernel_launch: unexpected shapes n_in %d out %d ws %zu\n", n_in, out_size, ws_size); grid = -1; return; }
        int dev = 0, cus = 0, per_cu = 0;
        hipGetDevice(&dev); hipDeviceGetAttribute(&cus, hipDeviceAttributeMultiprocessorCount, dev);
        hipFuncSetAttribute((const void*)mk_fwd, hipFuncAttributeMaxDynamicSharedMemorySize, LDS_BYTES);
        hipOccupancyMaxActiveBlocksPerMultiprocessor(&per_cu, (const void*)mk_fwd, NTHREADS, LDS_BYTES);
        if (per_cu < 1) per_cu = 1;
        grid = cus * 1;
        (void)hipGetLastError();
    }
    if (grid < 0) return;
    hipMemsetAsync((char*)d_ws + WS_CTL, 0, CTL_BYTES, stream);
    Args a{};
    for (int i = 0; i < 28; ++i) a.in[i] = (const float*)d_in[i];
    a.out = (float*)d_out; a.ws = (unsigned char*)d_ws;
    a.ph_lo = 0; a.ph_hi = N_PHASES;
    void* args[] = {&a};
    hipError_t e = hipLaunchCooperativeKernel((const void*)mk_fwd, dim3(grid), dim3(NTHREADS), args, LDS_BYTES, stream);
    if (e != hipSuccess) fprintf(stderr, "cooperative launch failed: %s (grid %d)\n", hipGetErrorString(e), grid);
}
```

```cpp
#include <hip/hip_runtime.h>
#include <hip/hip_cooperative_groups.h>
#include <cstdio>
#include <cstdint>
namespace cg = cooperative_groups;

#ifndef ONLY
#define ONLY 0xffff
#endif
#ifndef USE_LRU_OPT
#define USE_LRU_OPT 1
#endif
#ifndef USE_ATTN_OPT
#define USE_ATTN_OPT 1
#endif
#ifndef USE_SSD_OPT
#define USE_SSD_OPT 1
#endif
#ifndef USE_GEMM_IN
#define USE_GEMM_IN 1
#endif
#ifndef USE_GEMM_OUT
#define USE_GEMM_OUT 1
#endif
#ifndef MK_ONE_LAUNCH
#define MK_ONE_LAUNCH 1
#endif

typedef unsigned short bf16_t;
typedef short bf16x8 __attribute__((ext_vector_type(8)));
typedef float f32x4 __attribute__((ext_vector_type(4)));
typedef float f32x16 __attribute__((ext_vector_type(16)));
typedef unsigned u32x4 __attribute__((ext_vector_type(4)));
typedef unsigned u32x2 __attribute__((ext_vector_type(2)));
#define LAS __attribute__((address_space(3)))
#define DI __device__ __forceinline__

constexpr int DM = 1024, NPB = 16, SEQ = 2048, NSB_S = 8, DSEQ = 64, PAST = 1024;
constexpr int ROWS_P = NPB * SEQ;
constexpr int ROWS = ROWS_P + NSB_S * DSEQ;
constexpr int NSB = NPB + NSB_S;
constexpr int DINP = 5204, NPAD = 5376;
constexpr int PJW = 4864;
constexpr int DMIX = 2048;
constexpr float EPS = 1e-6f;
constexpr int C_GL = 0, C_GA = 512, C_Z = 1024, C_XL = 2048, C_Q = 2560, C_QI = 3072, C_XBC = 3328, C_T19 = 4864, C_T20 = 5120;
constexpr int KVW = 320;
constexpr size_t KVB_LAYER = (size_t)NPB * SEQ * KVW + (size_t)NSB_S * (PAST + DSEQ) * KVW;

constexpr size_t O_YP = 0;
constexpr size_t O_YS = O_YP + (size_t)NPB * SEQ * DM;
constexpr size_t O_AKP = O_YS + (size_t)NSB_S * DSEQ * DM;
constexpr size_t O_AVP = O_AKP + (size_t)2 * NPB * SEQ * 128;
constexpr size_t O_IKP = O_AVP + (size_t)2 * NPB * SEQ * 128;
constexpr size_t O_LCP = O_IKP + (size_t)2 * NPB * SEQ * 64;
constexpr size_t O_LHP = O_LCP + (size_t)2 * NPB * 3 * 512;
constexpr size_t O_SCP = O_LHP + (size_t)2 * NPB * 512;
constexpr size_t O_SHP = O_SCP + (size_t)2 * NPB * 3 * 1536;
constexpr size_t O_AKS = O_SHP + (size_t)2 * NPB * 16 * 64 * 128;
constexpr size_t O_AVS = O_AKS + (size_t)2 * NSB_S * DSEQ * 128;
constexpr size_t O_IKS = O_AVS + (size_t)2 * NSB_S * DSEQ * 128;
constexpr size_t O_LCS = O_IKS + (size_t)2 * NSB_S * DSEQ * 64;
constexpr size_t O_LHS = O_LCS + (size_t)2 * NSB_S * 3 * 512;
constexpr size_t O_SCS = O_LHS + (size_t)2 * NSB_S * 512;
constexpr size_t O_SHS = O_SCS + (size_t)2 * NSB_S * 3 * 1536;
constexpr size_t O_END = O_SHS + (size_t)2 * NSB_S * 16 * 64 * 128;

constexpr size_t MiB = 1u << 20;
constexpr size_t WS_CTL = 0, CTL_BYTES = 1 * MiB;
constexpr size_t WS_WIN = 1 * MiB;
constexpr size_t WIN_LAYER = (size_t)NPAD * DM;
constexpr size_t WS_WOUT = 22 * MiB;
constexpr size_t WOUT_LAYER = (size_t)DM * DMIX;
constexpr size_t WS_HB = 30 * MiB;
constexpr size_t WS_RSS = 95 * MiB;
constexpr size_t WS_WI = 98 * MiB;
constexpr size_t WS_DTR = 99 * MiB;
constexpr size_t WS_SSQ = 102 * MiB;
constexpr size_t WS_KVB = 112 * MiB;
constexpr size_t WS_PROJ = 164 * MiB;
constexpr size_t WS_END = WS_PROJ + (size_t)ROWS * PJW * 2;
static_assert(WS_KVB + 2 * KVB_LAYER * 2 <= WS_PROJ, "ws map");
static_assert(WS_END <= 512 * MiB, "ws map");

constexpr int NTHREADS = 512, NWAVES = 8;
constexpr int LDS_BYTES = 163840;

DI float bf2f(bf16_t v) { return __uint_as_float(((unsigned)v) << 16); }
DI bf16_t f2bf(float f) { unsigned u = __float_as_uint(f); return (bf16_t)((u + 0x7fffu + ((u >> 16) & 1u)) >> 16); }
DI unsigned pk2(float lo, float hi) { return (unsigned)f2bf(lo) | ((unsigned)f2bf(hi) << 16); }
DI int crow(int reg, int h) { return (reg & 3) + 8 * (reg >> 2) + 4 * h; }
template <int O> DI float swz_xor(float v) { return __int_as_float(__builtin_amdgcn_ds_swizzle(__float_as_int(v), (O << 10) | 0x1f)); }
DI float xor32_sum(float v) { auto rr = __builtin_amdgcn_permlane32_swap(__float_as_uint(v), __float_as_uint(v), false, false); return __uint_as_float(rr[0]) + __uint_as_float(rr[1]); }
DI float xor32_max(float v) { auto rr = __builtin_amdgcn_permlane32_swap(__float_as_uint(v), __float_as_uint(v), false, false); return fmaxf(__uint_as_float(rr[0]), __uint_as_float(rr[1])); }
DI float half_sum32(float v) {
    v += swz_xor<1>(v); v += swz_xor<2>(v); v += swz_xor<4>(v); v += swz_xor<8>(v); v += swz_xor<16>(v); return v;
}
DI float wave_sum(float v) { return xor32_sum(half_sum32(v)); }
DI float wave_max(float v) {
    v = fmaxf(v, swz_xor<1>(v)); v = fmaxf(v, swz_xor<2>(v)); v = fmaxf(v, swz_xor<4>(v)); v = fmaxf(v, swz_xor<8>(v)); v = fmaxf(v, swz_xor<16>(v)); return xor32_max(v);
}
DI float sum_fq(float v) { return xor32_sum(v + swz_xor<16>(v)); }
DI float bperm(float v, int srclane) { return __int_as_float(__builtin_amdgcn_ds_bpermute(srclane << 2, __float_as_int(v))); }
DI float silu_f(float x) { return x / (1.f + expf(-x)); }
DI float sigmoid_f(float x) { return 1.f / (1.f + expf(-x)); }
DI float softplus_f(float x) { return x > 20.f ? x : log1pf(expf(x)); }
#define LDS_FENCE() asm volatile("s_waitcnt lgkmcnt(0)" ::: "memory")

__host__ __device__ inline int orig_col(int c) {
    if (c < 512) return 512 + c;
    if (c < 1024) return 1792 + (c - 512);
    if (c < 2048) return 2628 + (c - 1024);
    if (c < 2560) return c - 2048;
    if (c < 3072) return 1024 + (c - 2560);
    if (c < 3328) return 2304 + (c - 3072);
    if (c < 4864) return 3652 + (c - 3328);
    if (c < 5120) { const int cl = c - 4864, bj = cl >> 7, wc = (cl >> 5) & 3, j = cl & 31, d = 32 * bj + j; return (wc < 2 ? 1536 : 1664) + (wc & 1) * 64 + d; }
    const int cl = c - 5120;
    if (cl < 64) return 2560 + cl;
    if (cl < 68) return 2624 + (cl - 64);
    if (cl < 84) return 5188 + (cl - 68);
    return -1;
}
DI int sb_T(int sb) { return sb < NPB ? SEQ : DSEQ; }
DI int sb_P(int sb) { return sb < NPB ? 0 : PAST; }
DI int sb_row0(int sb) { return sb < NPB ? sb * SEQ : ROWS_P + (sb - NPB) * DSEQ; }
DI size_t kvb_off(int sb) { return sb < NPB ? (size_t)sb * SEQ * KVW : (size_t)NPB * SEQ * KVW + (size_t)(sb - NPB) * (PAST + DSEQ) * KVW; }
DI void row_sbt(int m, int& sb, int& t) { if (m < ROWS_P) { sb = m >> 11; t = m & 2047; } else { const int r = m - ROWS_P; sb = NPB + (r >> 6); t = r & 63; } }

typedef const float* cfp_t;
struct Args { const float* in[28]; float* out; unsigned char* ws; int ph_lo, ph_hi; };

struct Ctx {
    float* out; unsigned char* ws;
    LAS unsigned char* lds;
    DI const float* inp(int k) const { return (const float*)(const __attribute__((address_space(1))) float*)(((LAS unsigned long long*)(lds + LDS_BYTES - 256))[k]); }
    int tid, lane, wave, G, bid;
    DI bf16_t* win(int l) const { return (bf16_t*)(ws + WS_WIN) + (size_t)l * WIN_LAYER; }
    DI bf16_t* wout(int l) const { return (bf16_t*)(ws + WS_WOUT) + (size_t)l * WOUT_LAYER; }
    DI bf16_t* hb() const { return (bf16_t*)(ws + WS_HB); }
    DI float* rss() const { return (float*)(ws + WS_RSS); }
    DI float* wi() const { return (float*)(ws + WS_WI); }
    DI float* dtr() const { return (float*)(ws + WS_DTR); }
    DI float* ssq() const { return (float*)(ws + WS_SSQ); }
    DI bf16_t* kvb(int l) const { return (bf16_t*)(ws + WS_KVB) + (size_t)l * KVB_LAYER; }
    DI bf16_t* proj() const { return (bf16_t*)(ws + WS_PROJ); }
};
DI float* out_ak(const Ctx& C, int l, int sb) { return sb < NPB ? C.out + O_AKP + ((size_t)(l * NPB + sb) * SEQ) * 128 : C.out + O_AKS + ((size_t)(l * NSB_S + sb - NPB) * DSEQ) * 128; }
DI float* out_av(const Ctx& C, int l, int sb) { return sb < NPB ? C.out + O_AVP + ((size_t)(l * NPB + sb) * SEQ) * 128 : C.out + O_AVS + ((size_t)(l * NSB_S + sb - NPB) * DSEQ) * 128; }
DI float* out_ik(const Ctx& C, int l, int sb) { return sb < NPB ? C.out + O_IKP + ((size_t)(l * NPB + sb) * SEQ) * 64 : C.out + O_IKS + ((size_t)(l * NSB_S + sb - NPB) * DSEQ) * 64; }
DI float* out_lc(const Ctx& C, int l, int sb) { return sb < NPB ? C.out + O_LCP + (size_t)(l * NPB + sb) * 3 * 512 : C.out + O_LCS + (size_t)(l * NSB_S + sb - NPB) * 3 * 512; }
DI float* out_lh(const Ctx& C, int l, int sb) { return sb < NPB ? C.out + O_LHP + (size_t)(l * NPB + sb) * 512 : C.out + O_LHS + (size_t)(l * NSB_S + sb - NPB) * 512; }
DI float* out_sc(const Ctx& C, int l, int sb) { return sb < NPB ? C.out + O_SCP + (size_t)(l * NPB + sb) * 3 * 1536 : C.out + O_SCS + (size_t)(l * NSB_S + sb - NPB) * 3 * 1536; }
DI float* out_sh(const Ctx& C, int l, int sb) { return sb < NPB ? C.out + O_SHP + (size_t)(l * NPB + sb) * 16 * 64 * 128 : C.out + O_SHS + (size_t)(l * NSB_S + sb - NPB) * 16 * 64 * 128; }

#ifdef PROBE_SUB
#define PROBE_BEGIN(id) unsigned long long pb_##id = __builtin_amdgcn_s_memrealtime()
#define PROBE_END(id, Cx) do { if ((id) == PROBE_SUB && (Cx).tid == 0) *(LAS unsigned long long*)((Cx).lds + LDS_BYTES - 16) += __builtin_amdgcn_s_memrealtime() - pb_##id; } while (0)
#else
#define PROBE_BEGIN(id) do {} while (0)
#define PROBE_END(id, Cx) do {} while (0)
#endif
namespace pg8 {
#define PG8_LAS __attribute__((address_space(3)))
constexpr int BM = 256, BK = 64, HALF = 128, HTB = HALF * BK * 2  , STAGE_BYTES = 8 * HTB, NXCD = 8, WGM = 8;

__host__ __device__ __forceinline__ int lds_byte(int r, int c) { const int st = (r >> 4) * 2 + (c >> 5), rr = r & 15, cc = c & 31, ob = rr * 64 + cc * 2; return st * 1024 + (ob ^ (((ob >> 9) & 1) << 5)); }
__host__ __device__ __forceinline__ void stage_rc(int b, int& R, int& C) { const int st = b / 1024, sb = b % 1024, swz = sb ^ (((sb >> 9) & 1) << 5); R = (st >> 1) * 16 + swz / 64; C = (st & 1) * 32 + (swz % 64) / 2; }
__host__ __device__ __forceinline__ int perm32(int rho) { const int n = rho >> 4, i = rho & 15; return 8 * (i >> 2) + 4 * n + (i & 3); }

struct Unit { int pm, pn; };
struct Gemm { const bf16_t* A; const bf16_t* Bt; int M, N, K, lda; };

struct StaticOrder {
    int nM, nN, nwg, G, c;
    __host__ __device__ void init(int M, int N, int G_, int c_) { nM = M / BM; nN = N / BM; nwg = nM * nN; G = G_; c = c_; }
    __host__ __device__ bool next(int i, Unit& u) const {
        const long L = (long)i * G + c; if (L >= nwg) return false;
        int wgid = (int)L; { const int q = nwg / NXCD, r = nwg % NXCD, xcd = wgid % NXCD, off = wgid / NXCD; wgid = (xcd < r ? xcd * (q + 1) : r * (q + 1) + (xcd - r) * q) + off; }
        const int nig = WGM * nN, gid = wgid / nig, fm = gid * WGM, gsz = (nM - fm) < WGM ? (nM - fm) : WGM;
        u.pm = fm + ((wgid % nig) % gsz); u.pn = (wgid % nig) / gsz; return true;
    }
    __device__ __forceinline__ void a_ready(const Unit&) const {}
    __device__ __forceinline__ void done(const Unit&) const {}
};

template <class Epi, class Sched, bool ALIGN_EPI = false, bool SP2 = false>
__device__ __forceinline__ void gemm_phase(PG8_LAS unsigned char* lds, const Gemm g, const Sched& S, const Epi& E, const int tid) {
    const int wid = __builtin_amdgcn_readfirstlane(tid >> 6), lane = tid & 63, wr = wid >> 2, wc = wid & 3, fr = lane & 15, fq = lane >> 4;
    const int K = g.K, nt = K / BK;
    unsigned voffA[2], voffB[2];
#pragma unroll
    for (int i = 0; i < 2; ++i) { int R, C; stage_rc(tid * 16 + i * 8192, R, C); const int Rb = Epi::PERM ? ((R & ~31) + perm32(R & 31)) : R;
        voffA[i] = (unsigned)(R * g.lda + C) * 2u; voffB[i] = (unsigned)(Rb * K + C) * 2u; }
    const size_t kstep = (size_t)(BK * 2);
    const size_t hstepA = (size_t)HALF * g.lda * 2, hstepB = (size_t)HALF * K * 2;
    const size_t tstepA = 2 * hstepA, tstepB = 2 * hstepB;
    const unsigned ldsw = (unsigned)wid * 1024u;
    const int aoff = lds_byte(wr * 64 + fr, fq * 8), boff = lds_byte(wc * 32 + fr, fq * 8);
#define PG8_SA(b, h) (((b) * 2 + (h)) * HTB)
#define PG8_SB(b, h) ((4 + (b) * 2 + (h)) * HTB)
#define PG8_STAGE(bufoff, gbase, voff) do { _Pragma("unroll") for (int _i = 0; _i < 2; ++_i) \
        __builtin_amdgcn_global_load_lds((const unsigned*)((const char*)(gbase) + (voff)[_i]), (PG8_LAS unsigned*)(lds + (bufoff) + ldsw + _i * 8192), 16, 0, 0); } while (0)
#define PG8_LDA(dst, b, h) do { _Pragma("unroll") for (int m = 0; m < 4; ++m) _Pragma("unroll") for (int k = 0; k < 2; ++k) dst[m][k] = *(const PG8_LAS bf16x8*)(lds + PG8_SA(b, h) + aoff + m * 2048 + k * 1024); } while (0)
#define PG8_LDB(dst, b, h) do { _Pragma("unroll") for (int n = 0; n < 2; ++n) _Pragma("unroll") for (int k = 0; k < 2; ++k) dst[n][k] = *(const PG8_LAS bf16x8*)(lds + PG8_SB(b, h) + boff + n * 2048 + k * 1024); } while (0)
#define PG8_MMA(ai, bj, At, Bt) do { __builtin_amdgcn_s_setprio(1); _Pragma("unroll") for (int m = 0; m < 4; ++m) _Pragma("unroll") for (int n = 0; n < 2; ++n) _Pragma("unroll") for (int k = 0; k < 2; ++k) \
        acc[ai][bj][m][n] = __builtin_amdgcn_mfma_f32_16x16x32_bf16(Bt[n][k], At[m][k], acc[ai][bj][m][n], 0, 0, 0); __builtin_amdgcn_s_setprio(0); } while (0)
#define PG8_WAIT_V(n) asm volatile("s_waitcnt vmcnt(" #n ")" ::: "memory")
#define PG8_WAIT_L(n) asm volatile("s_waitcnt lgkmcnt(" #n ")" ::: "memory")
#define PG8_BAR __builtin_amdgcn_s_barrier()
#define PG8_SCHED __builtin_amdgcn_sched_barrier(0)
    Unit cur, nxt; int ui = 0;
    if (!S.next(0, cur)) return;
    f32x4 acc[2][2][4][2];
#pragma unroll
    for (int a = 0; a < 2; ++a)
#pragma unroll
        for (int b = 0; b < 2; ++b)
#pragma unroll
            for (int m = 0; m < 4; ++m)
#pragma unroll
                for (int n = 0; n < 2; ++n) acc[a][b][m][n] = (f32x4){0.f, 0.f, 0.f, 0.f};
    bf16x8 At[4][2], B0[2][2], B1[2][2];
    const char* cA = (const char*)g.A + (size_t)cur.pm * tstepA; const char* cB = (const char*)g.Bt + (size_t)cur.pn * tstepB;
    S.a_ready(cur);
    if constexpr (SP2) {
        PG8_STAGE(PG8_SB(0, 0), cB, voffB); PG8_STAGE(PG8_SB(0, 1), cB + hstepB, voffB); PG8_STAGE(PG8_SA(0, 0), cA, voffA); PG8_STAGE(PG8_SA(0, 1), cA + hstepA, voffA);
        if (wr == 1) PG8_BAR;
        PG8_WAIT_V(2); PG8_BAR;
        PG8_STAGE(PG8_SB(1, 0), cB + kstep, voffB); PG8_STAGE(PG8_SA(1, 0), cA + kstep, voffA); PG8_STAGE(PG8_SB(1, 1), cB + hstepB + kstep, voffB);
        PG8_WAIT_V(6); PG8_BAR;
    } else {
        PG8_STAGE(PG8_SB(0, 0), cB, voffB); PG8_STAGE(PG8_SA(0, 0), cA, voffA); PG8_STAGE(PG8_SB(0, 1), cB + hstepB, voffB); PG8_STAGE(PG8_SA(0, 1), cA + hstepA, voffA);
        if (wr == 1) PG8_BAR;
        PG8_WAIT_V(4); PG8_BAR;
        PG8_STAGE(PG8_SB(1, 0), cB + kstep, voffB); PG8_STAGE(PG8_SA(1, 0), cA + kstep, voffA); PG8_STAGE(PG8_SB(1, 1), cB + hstepB + kstep, voffB);
        PG8_WAIT_V(6); PG8_BAR;
    }
    for (;;) {
        const bool has_next = S.next(ui + 1, nxt);
        const char* nA = has_next ? (const char*)g.A + (size_t)nxt.pm * tstepA : cA; const char* nB = has_next ? (const char*)g.Bt + (size_t)nxt.pn * tstepB : cB;
        for (int t = 0; t < nt; t += 2) {
            const bool last = (t == nt - 2);
            const char* a1 = cA + (size_t)(t + 1) * kstep;
            const char* a2 = last ? nA : cA + (size_t)(t + 2) * kstep; const char* b2 = last ? nB : cB + (size_t)(t + 2) * kstep;
            const char* a3 = a2 + kstep; const char* b3 = b2 + kstep;
            if (last && has_next) S.a_ready(nxt);
            if constexpr (SP2) {
            PG8_LDB(B0, 0, 0); PG8_LDB(B1, 0, 1); PG8_SCHED; PG8_LDA(At, 0, 0); PG8_STAGE(PG8_SA(1, 1), a1 + hstepA, voffA);
            PG8_WAIT_V(8); PG8_WAIT_L(0); PG8_BAR; PG8_MMA(0, 0, At, B0); PG8_MMA(0, 1, At, B1); PG8_BAR; PG8_SCHED;
            PG8_LDA(At, 0, 1); PG8_STAGE(PG8_SB(0, 0), b2, voffB); PG8_STAGE(PG8_SB(0, 1), b2 + hstepB, voffB); PG8_STAGE(PG8_SA(0, 0), a2, voffA);
            PG8_WAIT_V(8); PG8_WAIT_L(0); PG8_BAR; PG8_MMA(1, 0, At, B0); PG8_MMA(1, 1, At, B1); PG8_BAR; PG8_SCHED;
            PG8_LDB(B0, 1, 0); PG8_LDB(B1, 1, 1); PG8_SCHED; PG8_LDA(At, 1, 0); PG8_STAGE(PG8_SA(0, 1), a2 + hstepA, voffA);
            PG8_WAIT_V(8); PG8_WAIT_L(0); PG8_BAR; PG8_MMA(0, 0, At, B0); PG8_MMA(0, 1, At, B1); PG8_BAR; PG8_SCHED;
            PG8_LDA(At, 1, 1); PG8_STAGE(PG8_SB(1, 0), b3, voffB); PG8_STAGE(PG8_SB(1, 1), b3 + hstepB, voffB); PG8_STAGE(PG8_SA(1, 0), a3, voffA);
            PG8_WAIT_V(8); PG8_WAIT_L(0); PG8_BAR; PG8_MMA(1, 0, At, B0); PG8_MMA(1, 1, At, B1); PG8_BAR; PG8_SCHED;
            } else {
            PG8_LDB(B0, 0, 0); PG8_SCHED; PG8_LDA(At, 0, 0); PG8_STAGE(PG8_SA(1, 1), a1 + hstepA, voffA);
            PG8_WAIT_L(8); PG8_BAR; PG8_WAIT_L(0); PG8_MMA(0, 0, At, B0); PG8_BAR; PG8_SCHED;
            PG8_LDB(B1, 0, 1); PG8_STAGE(PG8_SB(0, 0), b2, voffB);
            PG8_BAR; PG8_WAIT_L(0); PG8_MMA(0, 1, At, B1); PG8_BAR;
            PG8_LDA(At, 0, 1); PG8_STAGE(PG8_SA(0, 0), a2, voffA);
            PG8_BAR; PG8_WAIT_L(0); PG8_MMA(1, 0, At, B0); PG8_BAR; PG8_SCHED;
            PG8_STAGE(PG8_SB(0, 1), b2 + hstepB, voffB);
            PG8_WAIT_V(6); PG8_BAR; PG8_MMA(1, 1, At, B1); PG8_BAR;
            PG8_LDB(B0, 1, 0); PG8_SCHED; PG8_LDA(At, 1, 0); PG8_STAGE(PG8_SA(0, 1), a2 + hstepA, voffA);
            PG8_WAIT_L(8); PG8_BAR; PG8_WAIT_L(0); PG8_MMA(0, 0, At, B0); PG8_BAR; PG8_SCHED;
            PG8_LDB(B1, 1, 1); PG8_STAGE(PG8_SB(1, 0), b3, voffB);
            PG8_BAR; PG8_WAIT_L(0); PG8_MMA(0, 1, At, B1); PG8_BAR;
            PG8_LDA(At, 1, 1); PG8_STAGE(PG8_SA(1, 0), a3, voffA);
            PG8_BAR; PG8_WAIT_L(0); PG8_MMA(1, 0, At, B0); PG8_BAR; PG8_SCHED;
            PG8_STAGE(PG8_SB(1, 1), b3 + hstepB, voffB);
            PG8_WAIT_V(6); PG8_BAR; PG8_MMA(1, 1, At, B1); PG8_BAR;
            }
        }
        if constexpr (ALIGN_EPI) { if (wr == 0) PG8_BAR; }
        if constexpr (!Epi::AFTER_DRAIN) { E(acc, cur, wr, wc, fr, fq); S.done(cur); }
        if (!has_next) break;
#pragma unroll
        for (int a = 0; a < 2; ++a)
#pragma unroll
            for (int b = 0; b < 2; ++b)
#pragma unroll
                for (int m = 0; m < 4; ++m)
#pragma unroll
                    for (int n = 0; n < 2; ++n) acc[a][b][m][n] = (f32x4){0.f, 0.f, 0.f, 0.f};
        cur = nxt; cA = nA; cB = nB; ++ui;
        if constexpr (ALIGN_EPI) { if (wr == 1) PG8_BAR; }
    }
    PG8_WAIT_V(0);
    if constexpr (!ALIGN_EPI) { if (wr == 0) PG8_BAR; }
    PG8_BAR;
    if constexpr (Epi::AFTER_DRAIN) { E.fused(acc, cur, wr, wc, fr, fq, lds, wid, lane); S.done(cur); }
#undef PG8_SA
#undef PG8_SB
#undef PG8_STAGE
#undef PG8_LDA
#undef PG8_LDB
#undef PG8_MMA
#undef PG8_WAIT_V
#undef PG8_WAIT_L
#undef PG8_BAR
#undef PG8_SCHED
}
}

typedef float f32x2_t __attribute__((ext_vector_type(2))); typedef __bf16 bf16x2_t __attribute__((ext_vector_type(2)));
DI unsigned cvt_pk_bf16(float lo, float hi) { const f32x2_t v = {lo, hi}; const bf16x2_t b = __builtin_convertvector(v, bf16x2_t); return __builtin_bit_cast(unsigned, b); }
DI u32x4 pack8(const f32x4 a, const f32x4 b) { u32x4 w; w.x = cvt_pk_bf16(a[0], a[1]); w.y = cvt_pk_bf16(a[2], a[3]); w.z = cvt_pk_bf16(b[0], b[1]); w.w = cvt_pk_bf16(b[2], b[3]); return w; }
struct EpiIn {
    static constexpr bool PERM = true, AFTER_DRAIN = false;
    Ctx C; int l;
    DI void operator()(const f32x4 (&acc)[2][2][4][2], const pg8::Unit& u, int wr, int wc, int fr, int fq) const {
        const int row0 = u.pm * 256 + wr * 64 + fr;
        float rs[2][4];
#pragma unroll
        for (int ai = 0; ai < 2; ++ai)
#pragma unroll
            for (int m = 0; m < 4; ++m) {
                const f32x4 p = *(const f32x4*)(C.rss() + (size_t)(row0 + ai * 128 + m * 16) * 16 + 4 * fq);
                float s = sum_fq((p[0] + p[1]) + (p[2] + p[3]));
                rs[ai][m] = rsqrtf(s * (1.f / DM) + EPS);
            }
        if (u.pn < 19) {
            bf16_t* base = C.proj() + (size_t)row0 * PJW + u.pn * 256 + wc * 32 + 8 * fq;
#pragma unroll
            for (int ai = 0; ai < 2; ++ai)
#pragma unroll
                for (int m = 0; m < 4; ++m) {
                    bf16_t* rowp = base + (size_t)(ai * 128 + m * 16) * PJW; const float sc = rs[ai][m];
#pragma unroll
                    for (int bj = 0; bj < 2; ++bj) *(u32x4*)(rowp + bj * 128) = pack8(acc[ai][bj][m][0] * sc, acc[ai][bj][m][1] * sc);
                }
        } else if (u.pn == 19) {
            if (wc < 2) {
                const float* kw = C.inp(19) + l * 64 + 8 * fq;
                const f32x4 k00 = *(const f32x4*)(kw), k01 = *(const f32x4*)(kw + 4), k10 = *(const f32x4*)(kw + 32), k11 = *(const f32x4*)(kw + 36);
#pragma unroll
                for (int ai = 0; ai < 2; ++ai)
#pragma unroll
                    for (int m = 0; m < 4; ++m) {
                        const int row = row0 + ai * 128 + m * 16; int sb, t; row_sbt(row, sb, t);
                        const float sc = rs[ai][m];
                        f32x4 a0 = acc[ai][0][m][0] * sc, a1 = acc[ai][0][m][1] * sc, b0 = acc[ai][1][m][0] * sc, b1 = acc[ai][1][m][1] * sc;
                        float ss = 0.f;
#pragma unroll
                        for (int i = 0; i < 4; ++i) ss += (a0[i] * a0[i] + a1[i] * a1[i]) + (b0[i] * b0[i] + b1[i] * b1[i]);
                        ss = sum_fq(ss);
                        const float rn = rsqrtf(ss * (1.f / 64.f) + EPS);
                        a0 = a0 * rn * k00; a1 = a1 * rn * k01; b0 = b0 * rn * k10; b1 = b1 * rn * k11;
                        float* o = out_ak(C, l, sb) + (size_t)t * 128 + wc * 64 + 8 * fq;
                        *(f32x4*)(o) = a0; *(f32x4*)(o + 4) = a1; *(f32x4*)(o + 32) = b0; *(f32x4*)(o + 36) = b1;
                        bf16_t* kv = C.kvb(l) + kvb_off(sb) + (size_t)(sb_P(sb) + t) * KVW + wc * 64 + 8 * fq;
                        *(u32x4*)(kv) = pack8(a0, a1); *(u32x4*)(kv + 32) = pack8(b0, b1);
                    }
            } else {
                const int kvh = wc - 2;
#pragma unroll
                for (int ai = 0; ai < 2; ++ai)
#pragma unroll
                    for (int m = 0; m < 4; ++m) {
                        const int row = row0 + ai * 128 + m * 16; int sb, t; row_sbt(row, sb, t);
                        const float sc = rs[ai][m];
                        const f32x4 a0 = acc[ai][0][m][0] * sc, a1 = acc[ai][0][m][1] * sc, b0 = acc[ai][1][m][0] * sc, b1 = acc[ai][1][m][1] * sc;
                        float* o = out_av(C, l, sb) + (size_t)t * 128 + kvh * 64 + 8 * fq;
                        *(f32x4*)(o) = a0; *(f32x4*)(o + 4) = a1; *(f32x4*)(o + 32) = b0; *(f32x4*)(o + 36) = b1;
                        bf16_t* kv = C.kvb(l) + kvb_off(sb) + (size_t)(sb_P(sb) + t) * KVW + 128 + kvh * 64 + 8 * fq;
                        *(u32x4*)(kv) = pack8(a0, a1); *(u32x4*)(kv + 32) = pack8(b0, b1);
                    }
            }
        } else {
#pragma unroll
            for (int ai = 0; ai < 2; ++ai)
#pragma unroll
                for (int m = 0; m < 4; ++m) {
                    const int row = row0 + ai * 128 + m * 16; int sb, t; row_sbt(row, sb, t);
                    const float sc = rs[ai][m];
                    const f32x4 a0 = acc[ai][0][m][0] * sc, a1 = acc[ai][0][m][1] * sc;
                    if (wc < 2) {
                        const int d = 32 * wc + 8 * fq;
                        float* o = out_ik(C, l, sb) + (size_t)t * 64 + d;
                        *(f32x4*)(o) = a0; *(f32x4*)(o + 4) = a1;
                        *(u32x4*)(C.kvb(l) + kvb_off(sb) + (size_t)(sb_P(sb) + t) * KVW + 256 + d) = pack8(a0, a1);
                    } else if (wc == 2) {
                        if (fq == 0) { *(f32x4*)(C.wi() + (size_t)row * 4) = a0; *(f32x4*)(C.dtr() + (size_t)row * 16) = a1; }
                        else if (fq == 1) { *(f32x4*)(C.dtr() + (size_t)row * 16 + 4) = a0; *(f32x4*)(C.dtr() + (size_t)row * 16 + 8) = a1; }
                        else if (fq == 2) { *(f32x4*)(C.dtr() + (size_t)row * 16 + 12) = a0; }
                    }
                }
        }
    }
};
struct EpiOut {
    static constexpr bool PERM = false, AFTER_DRAIN = false;
    Ctx C; int l;
    DI void operator()(const f32x4 (&acc)[2][2][4][2], const pg8::Unit& u, int wr, int wc, int fr, int fq) const {
        const int row0 = u.pm * 256 + wr * 64 + fr, col0 = u.pn * 256 + wc * 32 + 4 * fq;
#pragma unroll
        for (int ai = 0; ai < 2; ++ai)
#pragma unroll
            for (int m = 0; m < 4; ++m) {
                const int row = row0 + ai * 128 + m * 16;
                const float* xres = (l == 0) ? ((row < ROWS_P) ? C.inp(0) + (size_t)row * DM : C.inp(1) + (size_t)(row - ROWS_P) * DM) : C.out + (size_t)row * DM;
                float ss = 0.f;
#pragma unroll
                for (int bj = 0; bj < 2; ++bj)
#pragma unroll
                    for (int n = 0; n < 2; ++n) {
                        const int col = col0 + bj * 128 + n * 16;
                        const f32x4 v = *(const f32x4*)(xres + col) + acc[ai][bj][m][n];
                        *(f32x4*)(C.out + (size_t)row * DM + col) = v;
                        if (l == 0) {
                            u32x2 w; w.x = cvt_pk_bf16(v[0], v[1]); w.y = cvt_pk_bf16(v[2], v[3]);
                            *(u32x2*)(C.hb() + (size_t)row * DM + col) = w;
                            ss += (v[0] * v[0] + v[1] * v[1]) + (v[2] * v[2] + v[3] * v[3]);
                        }
                    }
                if (l == 0) {
                    ss = sum_fq(ss);
                    if (fq == 0) C.rss()[(size_t)row * 16 + u.pn * 4 + wc] = ss;
                }
            }
    }
};
DI void phase_inproj_gemm(const Ctx& C, int l) {
    pg8::Gemm g{C.hb(), C.win(l), ROWS, NPAD, DM, DM};
    pg8::StaticOrder S; S.init(ROWS, NPAD, C.G, C.bid);
    EpiIn E{C, l};
    pg8::gemm_phase<EpiIn, pg8::StaticOrder, true, true>(C.lds, g, S, E, C.tid);
}
DI void phase_outproj_gemm(const Ctx& C, int l) {
    pg8::Gemm g{C.proj(), C.wout(l), ROWS_P, DM, DMIX, PJW};
    pg8::StaticOrder S; S.init(ROWS_P, DM, C.G, C.bid);
    EpiOut E{C, l};
    pg8::gemm_phase<EpiOut, pg8::StaticOrder, true, true>(C.lds, g, S, E, C.tid);
}
DI void outproj_tail_item(const Ctx& C, int l, int rt, int g);
DI void phase_ycnorm(const Ctx& C, int l) {
    const int gw = C.bid * NWAVES + C.wave, NGW = C.G * NWAVES, lane = C.lane;
#if USE_SSD_OPT
    for (int i = C.bid * NTHREADS + C.tid; i < NSB * 3 * 1536; i += C.G * NTHREADS) {
        const int sb = i / (3 * 1536), j = (i / 1536) % 3, ch = i % 1536;
        out_sc(C, l, sb)[j * 1536 + ch] = bf2f(C.proj()[(size_t)(sb_row0(sb) + sb_T(sb) - 3 + j) * PJW + C_XBC + ch]);
    }
#endif
#if USE_LRU_OPT
    for (int i = C.bid * NTHREADS + C.tid; i < NSB * 3 * 512; i += C.G * NTHREADS) {
        const int sb = i / (3 * 512), j = (i / 512) % 3, ch = i % 512;
        out_lc(C, l, sb)[j * 512 + ch] = bf2f(C.proj()[(size_t)(sb_row0(sb) + sb_T(sb) - 3 + j) * PJW + C_XL + ch]);
    }
#endif
    if (C.bid < 256) outproj_tail_item(C, l, ROWS_P / 32 + (C.bid >> 4), C.bid & 15);
    for (int m = gw; m < ROWS_P; m += NGW) {
        const float s = C.ssq()[(size_t)m * 64 + lane];
        float h = s;
        h = half_sum32(h);
        const float rg = rsqrtf(h * (1.f / 512.f) + EPS);
        const float r0 = bperm(rg, 0), r1 = bperm(rg, 32);
        bf16_t* p = C.proj() + (size_t)m * PJW + C_Z;
#pragma unroll
        for (int j = 0; j < 2; ++j) {
            const int c = 8 * lane + 512 * j;
            const u32x4 v = *(const u32x4*)(p + c); const float r = j == 0 ? r0 : r1; u32x4 o;
            o.x = cvt_pk_bf16(__uint_as_float(v.x << 16) * r, __uint_as_float(v.x & 0xffff0000u) * r);
            o.y = cvt_pk_bf16(__uint_as_float(v.y << 16) * r, __uint_as_float(v.y & 0xffff0000u) * r);
            o.z = cvt_pk_bf16(__uint_as_float(v.z << 16) * r, __uint_as_float(v.z & 0xffff0000u) * r);
            o.w = cvt_pk_bf16(__uint_as_float(v.w << 16) * r, __uint_as_float(v.w & 0xffff0000u) * r);
            *(u32x4*)(p + c) = o;
        }
    }
}

template <int MODE>
DI void p0_transpose_item(const Ctx& C, const float* W, const float* scale, int K, int Nsrc, int Ndst, bf16_t* WT, LAS float* scr, int item) {
    const int lane = C.lane, nblk = Ndst / 64, kb = item / nblk, nb = item % nblk, k0 = 64 * kb, n0 = 64 * nb;
    const int cgp = lane & 15, kq = lane >> 4;
    const int ncol = n0 + 4 * cgp;
    const int src = (MODE == 0) ? orig_col(ncol) : ncol;
#pragma unroll 8
    for (int i = 0; i < 16; ++i) {
        const int kk = 4 * i + kq, k = k0 + kk;
        f32x4 v = (f32x4){0.f, 0.f, 0.f, 0.f};
        if (src >= 0) {
            v = *(const f32x4*)(W + (size_t)k * Nsrc + src);
            const float sc = (MODE == 0) ? scale[k] : (k >= 1024 ? scale[k - 1024] : 1.f);
            v = v * sc;
        }
        scr[(4 * cgp + 0) * 65 + kk] = v[0]; scr[(4 * cgp + 1) * 65 + kk] = v[1]; scr[(4 * cgp + 2) * 65 + kk] = v[2]; scr[(4 * cgp + 3) * 65 + kk] = v[3];
    }
    LDS_FENCE();
    const LAS float* sr = scr + lane * 65;
    bf16_t* orow = WT + (size_t)(n0 + lane) * K + k0;
#pragma unroll
    for (int j = 0; j < 8; ++j) {
        u32x4 o; o.x = cvt_pk_bf16(sr[8 * j], sr[8 * j + 1]); o.y = cvt_pk_bf16(sr[8 * j + 2], sr[8 * j + 3]); o.z = cvt_pk_bf16(sr[8 * j + 4], sr[8 * j + 5]); o.w = cvt_pk_bf16(sr[8 * j + 6], sr[8 * j + 7]);
        *(u32x4*)(orow + 8 * j) = o;
    }
    LDS_FENCE();
}
DI void prep_layer(const Ctx& C, int l) {
    LAS float* scr = (LAS float*)(C.lds + C.wave * 16640);
    const int gw = C.bid * NWAVES + C.wave, NGW = C.G * NWAVES;
    constexpr int I_IN = (DM / 64) * (NPAD / 64), I_OUT = (DMIX / 64) * (DM / 64);
    for (int it = gw; it < I_IN + I_OUT; it += NGW) {
        if (it < I_IN) p0_transpose_item<0>(C, C.inp(10) + (size_t)l * DM * DINP, C.inp(9) + l * DM, DM, DINP, NPAD, C.win(l), scr, it);
        else p0_transpose_item<1>(C, C.inp(27) + (size_t)l * DMIX * DM, C.inp(26) + l * 1024, DMIX, DM, DM, C.wout(l), scr, it - I_IN);
    }
    for (int it = gw; it < NSB_S * PAST / 4; it += NGW) {
        const int b = it / (PAST / 4), pos0 = 4 * (it % (PAST / 4));
#pragma unroll
        for (int j = 0; j < 5; ++j) {
            const int pc = C.lane + 64 * j, pp = pc / 80, q = pc % 80, pos = pos0 + pp;
            const size_t base = ((size_t)(l * NSB_S + b) * PAST + pos);
            const f32x4 v = (q < 32) ? *(const f32x4*)(C.inp(2) + base * 128 + 4 * q) : (q < 64 ? *(const f32x4*)(C.inp(3) + base * 128 + 4 * (q - 32)) : *(const f32x4*)(C.inp(4) + base * 64 + 4 * (q - 64)));
            u32x2 o; o.x = cvt_pk_bf16(v[0], v[1]); o.y = cvt_pk_bf16(v[2], v[3]);
            *(u32x2*)(C.kvb(l) + kvb_off(NPB + b) + (size_t)pos * KVW + 4 * q) = o;
        }
    }
}
DI void phase_prologue(const Ctx& C) {
    prep_layer(C, 0);
    const int gw = C.bid * NWAVES + C.wave, NGW = C.G * NWAVES;
    for (int m0 = 4 * gw; m0 < ROWS; m0 += 4 * NGW) {
        f32x4 v[4][4];
#pragma unroll
        for (int rr = 0; rr < 4; ++rr) { const int m = m0 + rr; const float* xr = (m < ROWS_P) ? C.inp(0) + (size_t)m * DM : C.inp(1) + (size_t)(m - ROWS_P) * DM;
#pragma unroll
            for (int j = 0; j < 4; ++j) v[rr][j] = *(const f32x4*)(xr + 4 * C.lane + 256 * j); }
#pragma unroll
        for (int rr = 0; rr < 4; ++rr) { const int m = m0 + rr; float ss = 0.f;
#pragma unroll
            for (int j = 0; j < 4; ++j) { const f32x4 x = v[rr][j]; ss += (x[0] * x[0] + x[1] * x[1]) + (x[2] * x[2] + x[3] * x[3]);
                u32x2 o; o.x = cvt_pk_bf16(x[0], x[1]); o.y = cvt_pk_bf16(x[2], x[3]); *(u32x2*)(C.hb() + (size_t)m * DM + 4 * C.lane + 256 * j) = o; }
            ss = wave_sum(ss);
            if (C.lane < 16) C.rss()[(size_t)m * 16 + C.lane] = (C.lane == 0) ? ss : 0.f; }
    }
}

#define MFMA32(a, b, c) __builtin_amdgcn_mfma_f32_32x32x16_bf16((a), (b), (c), 0, 0, 0)
DI void phase_inproj_simple(const Ctx& C, int l) {
    const int gw = C.bid * NWAVES + C.wave, NGW = C.G * NWAVES, lane = C.lane, r = lane & 31, h = lane >> 5;
    constexpr int NG = 82, NRT = ROWS / 32;
    const bf16_t* WIN = C.win(l); const bf16_t* HB = C.hb(); bf16_t* PJ = C.proj();
    for (int it = gw; it < NRT * NG; it += NGW) {
        const int rt = it / NG, g = it % NG, m0 = rt * 32;
        int c0, c1, type;
        if (g < 76) { c0 = 64 * g; c1 = c0 + 32; type = 0; }
        else if (g < 80) { const int hs = g - 76; c0 = C_T19 + 32 * hs; c1 = c0 + 128; type = hs < 2 ? 1 : 2; }
        else if (g == 80) { c0 = C_T20; c1 = C_T20 + 32; type = 3; }
        else { c0 = C_T20 + 64; c1 = C_T20 + 96; type = 4; }
        f32x16 acc0, acc1;
#pragma unroll
        for (int i = 0; i < 16; ++i) { acc0[i] = 0.f; acc1[i] = 0.f; }
        const bf16_t* Ap = HB + (size_t)(m0 + r) * DM + 8 * h;
        const bf16_t* B0 = WIN + (size_t)(c0 + r) * DM + 8 * h;
        const bf16_t* B1 = WIN + (size_t)(c1 + r) * DM + 8 * h;
#pragma unroll 4
        for (int k0 = 0; k0 < DM; k0 += 16) {
            const bf16x8 a = *(const bf16x8*)(Ap + k0), b0 = *(const bf16x8*)(B0 + k0), b1 = *(const bf16x8*)(B1 + k0);
            acc0 = MFMA32(a, b0, acc0); acc1 = MFMA32(a, b1, acc1);
        }
        float rsc; { const float* p = C.rss() + (size_t)(m0 + r) * 16; float s = 0.f;
#pragma unroll
            for (int j = 0; j < 16; ++j) s += p[j];
            rsc = rsqrtf(s * (1.f / DM) + EPS); }
        const float kn0 = (type == 1) ? C.inp(19)[l * 64 + r] : 1.f, kn1 = (type == 1) ? C.inp(19)[l * 64 + 32 + r] : 1.f;
#pragma unroll
        for (int reg = 0; reg < 16; ++reg) {
            const int rowl = crow(reg, h), m = m0 + rowl;
            const float sc = bperm(rsc, rowl);
            float v0 = acc0[reg] * sc, v1 = acc1[reg] * sc;
            if (type == 0) { PJ[(size_t)m * PJW + c0 + r] = f2bf(v0); PJ[(size_t)m * PJW + c1 + r] = f2bf(v1); }
            else {
                int sb, t; row_sbt(m, sb, t); const int pos = sb_P(sb) + t;
                bf16_t* kv = C.kvb(l) + kvb_off(sb) + (size_t)pos * KVW;
                if (type == 1) {
                    const int kvh = g - 76;
                    const float ss = half_sum32(v0 * v0 + v1 * v1), rn = rsqrtf(ss * (1.f / 64.f) + EPS);
                    v0 = v0 * rn * kn0; v1 = v1 * rn * kn1;
                    float* o = out_ak(C, l, sb) + (size_t)t * 128 + kvh * 64;
                    o[r] = v0; o[32 + r] = v1; kv[kvh * 64 + r] = f2bf(v0); kv[kvh * 64 + 32 + r] = f2bf(v1);
                } else if (type == 2) {
                    const int kvh = g - 78;
                    float* o = out_av(C, l, sb) + (size_t)t * 128 + kvh * 64;
                    o[r] = v0; o[32 + r] = v1; kv[128 + kvh * 64 + r] = f2bf(v0); kv[128 + kvh * 64 + 32 + r] = f2bf(v1);
                } else if (type == 3) {
                    float* o = out_ik(C, l, sb) + (size_t)t * 64;
                    o[r] = v0; o[32 + r] = v1; kv[256 + r] = f2bf(v0); kv[256 + 32 + r] = f2bf(v1);
                } else {
                    if (r < 4) C.wi()[(size_t)m * 4 + r] = v0; else if (r < 20) C.dtr()[(size_t)m * 16 + (r - 4)] = v0;
                }
            }
        }
    }
}

DI void outproj_tail_item(const Ctx& C, int l, int rt, int g) {
    const int lane = C.lane, wave = C.wave, r = lane & 31, h = lane >> 5;
    const bf16_t* WO = C.wout(l); const bf16_t* PJ = C.proj();
    const int m0 = rt * 32, c0 = 64 * g, c1 = c0 + 32, kbeg = 256 * wave;
    f32x16 a0, a1;
#pragma unroll
    for (int i = 0; i < 16; ++i) { a0[i] = 0.f; a1[i] = 0.f; }
    const bf16_t* Ap = PJ + (size_t)(m0 + r) * PJW + 8 * h + kbeg;
    const bf16_t* B0 = WO + (size_t)(c0 + r) * DMIX + 8 * h + kbeg;
    const bf16_t* B1 = WO + (size_t)(c1 + r) * DMIX + 8 * h + kbeg;
#pragma unroll 8
    for (int k0 = 0; k0 < 256; k0 += 16) { const bf16x8 a = *(const bf16x8*)(Ap + k0); a0 = MFMA32(a, *(const bf16x8*)(B0 + k0), a0); a1 = MFMA32(a, *(const bf16x8*)(B1 + k0), a1); }
    LAS float* part = (LAS float*)C.lds;
#pragma unroll
    for (int i = 0; i < 16; ++i) { part[((wave * 2 + 0) * 16 + i) * 64 + lane] = a0[i]; part[((wave * 2 + 1) * 16 + i) * 64 + lane] = a1[i]; }
    __syncthreads();
    if (wave == 0) {
        float r0, r1; { const float* p = C.ssq() + (size_t)(m0 + r) * 64; float s0 = 0.f, s1 = 0.f;
#pragma unroll
            for (int j = 0; j < 32; ++j) { s0 += p[j]; s1 += p[32 + j]; }
            r0 = rsqrtf(s0 * (1.f / 512.f) + EPS); r1 = rsqrtf(s1 * (1.f / 512.f) + EPS); }
#pragma unroll
        for (int reg = 0; reg < 16; ++reg) {
            const int rowl = crow(reg, h), m = m0 + rowl;
            const float g0 = bperm(r0, rowl), g1 = bperm(r1, rowl);
            float sab[2], sc0[2], sc1[2];
#pragma unroll
            for (int t = 0; t < 2; ++t) {
                sab[t] = (part[((0 * 2 + t) * 16 + reg) * 64 + lane] + part[((1 * 2 + t) * 16 + reg) * 64 + lane]) + (part[((2 * 2 + t) * 16 + reg) * 64 + lane] + part[((3 * 2 + t) * 16 + reg) * 64 + lane]);
                sc0[t] = part[((4 * 2 + t) * 16 + reg) * 64 + lane] + part[((5 * 2 + t) * 16 + reg) * 64 + lane];
                sc1[t] = part[((6 * 2 + t) * 16 + reg) * 64 + lane] + part[((7 * 2 + t) * 16 + reg) * 64 + lane];
            }
            const float* xres = (l == 0) ? ((m < ROWS_P) ? C.inp(0) + (size_t)m * DM : C.inp(1) + (size_t)(m - ROWS_P) * DM) : C.out + (size_t)m * DM;
            const float v0 = xres[c0 + r] + sab[0] + g0 * sc0[0] + g1 * sc1[0];
            const float v1 = xres[c1 + r] + sab[1] + g0 * sc0[1] + g1 * sc1[1];
            C.out[(size_t)m * DM + c0 + r] = v0; C.out[(size_t)m * DM + c1 + r] = v1;
            if (l == 0) {
                C.hb()[(size_t)m * DM + c0 + r] = f2bf(v0); C.hb()[(size_t)m * DM + c1 + r] = f2bf(v1);
                const float ss = half_sum32(v0 * v0 + v1 * v1);
                if (r == 0) C.rss()[(size_t)m * 16 + g] = ss;
            }
        }
    }
    __syncthreads();
}

DI void phase_conv_naive(const Ctx& C, int l) {
    const int gt = C.bid * NTHREADS + C.tid, NGT = C.G * NTHREADS;
    bf16_t* PJ = C.proj();
    for (int i = gt; i < NSB * 1536; i += NGT) {
        const int sb = i / 1536, ch = i % 1536, T = sb_T(sb), row0 = sb_row0(sb);
        const float* cw = C.inp(21) + (size_t)l * 4 * 1536; const float w0 = cw[ch], w1 = cw[1536 + ch], w2 = cw[2 * 1536 + ch], w3 = cw[3 * 1536 + ch], bias = C.inp(22)[l * 1536 + ch];
        float h0 = 0.f, h1 = 0.f, h2 = 0.f;
        if (sb >= NPB) { const float* st = C.inp(7) + ((size_t)(l * NSB_S + sb - NPB) * 3) * 1536; h0 = st[ch]; h1 = st[1536 + ch]; h2 = st[2 * 1536 + ch]; }
        bf16_t* p = PJ + (size_t)row0 * PJW + C_XBC + ch;
        for (int t = 0; t < T; ++t) {
            const float x = bf2f(p[(size_t)t * PJW]);
            const float y = bias + w0 * h0 + w1 * h1 + w2 * h2 + w3 * x;
            p[(size_t)t * PJW] = f2bf(silu_f(y));
            h0 = h1; h1 = h2; h2 = x;
        }
        float* o = out_sc(C, l, sb); o[ch] = h0; o[1536 + ch] = h1; o[2 * 1536 + ch] = h2;
    }
}

DI void lru_item_naive(const Ctx& C, int l, int sb, int blk, LAS unsigned char* scr) {
    const int lane = C.lane, ch = blk * 64 + lane, T = sb_T(sb), row0 = sb_row0(sb);
    bf16_t* PJ = C.proj();
    LAS unsigned* wl = (LAS unsigned*)scr;
    { const float* pa = C.inp(13) + (size_t)(l * 8 + blk) * 4096 + lane; const float* px = C.inp(15) + (size_t)(l * 8 + blk) * 4096 + lane;
      for (int c = 0; c < 64; ++c) wl[c * 64 + lane] = pk2(pa[c * 64], px[c * 64]); }
    LDS_FENCE();
    const float ba = C.inp(14)[l * 512 + ch], bx = C.inp(16)[l * 512 + ch];
    const float spl = softplus_f(-C.inp(17)[l * 512 + ch]);
    const float* cw = C.inp(11) + (size_t)l * 4 * 512; const float w0 = cw[ch], w1 = cw[512 + ch], w2 = cw[1024 + ch], w3 = cw[1536 + ch], cb = C.inp(12)[l * 512 + ch];
    float h0 = 0.f, h1 = 0.f, h2 = 0.f, hs = 0.f;
    if (sb >= NPB) { const float* st = C.inp(5) + ((size_t)(l * NSB_S + sb - NPB) * 3) * 512; h0 = st[ch]; h1 = st[512 + ch]; h2 = st[1024 + ch]; hs = C.inp(6)[(size_t)(l * NSB_S + sb - NPB) * 512 + ch]; }
    for (int t = 0; t < T; ++t) {
        const size_t rb = (size_t)(row0 + t) * PJW;
        const float x = bf2f(PJ[rb + C_XL + ch]);
        const float xc = cb + w0 * h0 + w1 * h1 + w2 * h2 + w3 * x;
        h0 = h1; h1 = h2; h2 = x;
        float ga = ba, gx = bx;
#pragma unroll 8
        for (int c = 0; c < 64; ++c) { const float xv = __int_as_float(__builtin_amdgcn_readlane(__float_as_int(xc), c)); const unsigned w = wl[c * 64 + lane]; ga += xv * __uint_as_float(w << 16); gx += xv * __uint_as_float(w & 0xffff0000u); }
        const float rg = sigmoid_f(ga), ig = sigmoid_f(gx);
        const float log_a = -8.f * rg * spl, a = expf(log_a), mult = sqrtf(-expm1f(2.f * log_a));
        hs = a * hs + mult * (ig * xc);
        const float gl = bf2f(PJ[rb + C_GL + ch]);
        PJ[rb + C_GL + ch] = f2bf(hs * silu_f(gl));
    }
    float* oc = out_lc(C, l, sb); oc[ch] = h0; oc[512 + ch] = h1; oc[1024 + ch] = h2;
    out_lh(C, l, sb)[ch] = hs;
}

DI void ssd_item_naive(const Ctx& C, int l, int sb, int hd, int pq) {
    const int lane = C.lane, T = sb_T(sb), row0 = sb_row0(sb), g = hd >> 3;
    const int p = 16 * pq + (lane & 15), nq = lane >> 4, n0 = 32 * nq;
    bf16_t* PJ = C.proj();
    float hst[32];
    if (sb >= NPB) { const float* st = C.inp(8) + (((size_t)(l * NSB_S + sb - NPB) * 16 + hd) * 64 + p) * 128 + n0;
#pragma unroll
        for (int n = 0; n < 32; n += 4) { const f32x4 v = *(const f32x4*)(st + n); hst[n] = v.x; hst[n + 1] = v.y; hst[n + 2] = v.z; hst[n + 3] = v.w; } }
    else {
#pragma unroll
        for (int n = 0; n < 32; ++n) hst[n] = 0.f; }
    const float aneg = -expf(C.inp(24)[l * 16 + hd]), dtb = C.inp(23)[l * 16 + hd], Dh = C.inp(25)[l * 16 + hd];
    for (int t = 0; t < T; ++t) {
        const size_t rb = (size_t)(row0 + t) * PJW;
        const float dt = softplus_f(C.dtr()[(size_t)(row0 + t) * 16 + hd] + dtb), da = expf(dt * aneg);
        const float xs = bf2f(PJ[rb + C_XBC + hd * 64 + p]), dtx = dt * xs;
        const bf16_t* Bp = PJ + rb + C_XBC + 1024 + g * 128 + n0; const bf16_t* Cp = PJ + rb + C_XBC + 1280 + g * 128 + n0;
        float y = 0.f;
#pragma unroll
        for (int n = 0; n < 32; n += 8) {
            const bf16x8 bv = *(const bf16x8*)(Bp + n), cv = *(const bf16x8*)(Cp + n);
#pragma unroll
            for (int j = 0; j < 8; ++j) { hst[n + j] = da * hst[n + j] + dtx * bf2f((bf16_t)bv[j]); y += bf2f((bf16_t)cv[j]) * hst[n + j]; }
        }
        y = sum_fq(y);
        y += Dh * xs;
        const float z = bf2f(PJ[rb + C_Z + hd * 64 + p]);
        y *= silu_f(z);
        if (nq == 0) PJ[rb + C_Z + hd * 64 + p] = f2bf(y);
        const float ss = wave_sum(nq == 0 ? y * y : 0.f);
        if (lane == 0) C.ssq()[(size_t)(row0 + t) * 64 + hd * 4 + pq] = ss;
    }
    float* o = out_sh(C, l, sb) + ((size_t)hd * 64 + p) * 128 + n0;
#pragma unroll
    for (int n = 0; n < 32; n += 4) { f32x4 v; v.x = hst[n]; v.y = hst[n + 1]; v.z = hst[n + 2]; v.w = hst[n + 3]; *(f32x4*)(o + n) = v; }
}

constexpr int SS_XST = 0;
constexpr int SS_BM = SS_XST + 64 * 144;
constexpr int SS_CM = SS_BM + 64 * 272;
constexpr int SS_BWT = SS_CM + 64 * 272;
constexpr int SS_HA = SS_BWT + 128 * 144;
constexpr int SS_SCAL = SS_HA + 2 * 64 * 272;
constexpr int SS_CW = SS_SCAL + 2 * 1024;
constexpr int SS_RAW = SS_CW + 5 * 320 * 4;
constexpr int SS_Z = SS_RAW + 67 * 640;
constexpr int SS_END = SS_Z + 8192;
static_assert(SS_END <= LDS_BYTES - 256, "SSD LDS map");
typedef short s16x4 __attribute__((ext_vector_type(4)));
DI float fast_silu(float x) { return x * __builtin_amdgcn_rcpf(1.f + __builtin_amdgcn_exp2f(-1.4426950408889634f * x)); }
DI bf16x8 lds_frag(const LAS unsigned char* base, int row, int rowbytes, int col) { return *(const LAS bf16x8*)(base + row * rowbytes + col * 2); }

DI void ssd_item(const Ctx& C, int l, int sb, int hd) {
    const int tid = C.tid, lane = C.lane, wave = C.wave, r = lane & 31, h = lane >> 5;
    const int T = sb_T(sb), row0 = sb_row0(sb), g = hd >> 3, NC = T / 64;
    LAS unsigned char* L = C.lds;
    bf16_t* PJ = C.proj();
    const float aneg = -expf(C.inp(24)[l * 16 + hd]), dtb = C.inp(23)[l * 16 + hd], Dh = C.inp(25)[l * 16 + hd];
    const bool stager = tid < 320;
    const int gp = 32 * wave + (lane & 31), sth = lane >> 5;
    const int cg = 0, seg = 0; (void)cg; (void)seg;
    int colbase, cch;
    if (cg < 8) { cch = hd * 64 + 8 * cg; } else if (cg < 24) { cch = 1024 + g * 128 + 8 * (cg - 8); } else { cch = 1280 + g * 128 + 8 * (cg - 24); }
    colbase = C_XBC + cch;
    for (int i = tid; i < 5 * 320; i += NTHREADS) {
        const int j = i / 320, c = i % 320, cg2 = c >> 3, e = c & 7;
        const int ch = (cg2 < 8) ? hd * 64 + 8 * cg2 + e : (cg2 < 24 ? 1024 + g * 128 + 8 * (cg2 - 8) + e : 1280 + g * 128 + 8 * (cg2 - 24) + e);
        ((LAS float*)(L + SS_CW))[i] = (j < 4) ? C.inp(21)[((size_t)l * 4 + j) * 1536 + ch] : C.inp(22)[l * 1536 + ch];
    }
    const int sj = wave - 4, sph = sj & 1, nq0 = 2 * (sj >> 1);
    f32x16 hacc0, hacc1;
#pragma unroll
    for (int i = 0; i < 16; ++i) { hacc0[i] = 0.f; hacc1[i] = 0.f; }
    if (wave >= 4) {
        if (sb >= NPB) {
            const float* st = C.inp(8) + (((size_t)(l * NSB_S + sb - NPB) * 16 + hd) * 64 + 32 * sph + r) * 128;
#pragma unroll
            for (int gq = 0; gq < 4; ++gq) {
                const f32x4 v0 = *(const f32x4*)(st + 32 * nq0 + 8 * gq + 4 * h), v1 = *(const f32x4*)(st + 32 * (nq0 + 1) + 8 * gq + 4 * h);
#pragma unroll
                for (int e = 0; e < 4; ++e) { hacc0[4 * gq + e] = v0[e]; hacc1[4 * gq + e] = v1[e]; }
            }
        }
#pragma unroll
        for (int gq = 0; gq < 4; ++gq) {
            u32x2 w0, w1; w0.x = cvt_pk_bf16(hacc0[4 * gq], hacc0[4 * gq + 1]); w0.y = cvt_pk_bf16(hacc0[4 * gq + 2], hacc0[4 * gq + 3]);
            w1.x = cvt_pk_bf16(hacc1[4 * gq], hacc1[4 * gq + 1]); w1.y = cvt_pk_bf16(hacc1[4 * gq + 2], hacc1[4 * gq + 3]);
            *(LAS u32x2*)(L + SS_HA + (32 * sph + r) * 272 + (32 * nq0 + 8 * gq + 4 * h) * 2) = w0;
            *(LAS u32x2*)(L + SS_HA + (32 * sph + r) * 272 + (32 * (nq0 + 1) + 8 * gq + 4 * h) * 2) = w1;
        }
    }
    const int yph = wave & 1, ylh = (wave >> 1) & 1;
#define SSD_DMA_RAW(cc) do { const int t0_ = 64 * (cc); \
        for (int k_ = wave; k_ < 42; k_ += NWAVES) { \
            const int q_ = 64 * k_ + lane, rr_ = q_ / 40, pc_ = q_ - 40 * rr_, t_ = t0_ - 3 + rr_; \
            const int col_ = C_XBC + ((pc_ < 8) ? hd * 64 + 8 * pc_ : (pc_ < 24 ? 1024 + g * 128 + 8 * (pc_ - 8) : 1280 + g * 128 + 8 * (pc_ - 24))); \
            if (q_ < 2680 && t_ >= 0) __builtin_amdgcn_global_load_lds((const unsigned*)(PJ + (size_t)(row0 + t_) * PJW + col_), (LAS unsigned*)(L + SS_RAW + k_ * 1024), 16, 0, 0); } \
    } while (0)
#define SSD_DMA_Z(cc) do { const int t0_ = 64 * (cc); \
        if (wave < 4) { _Pragma("unroll") for (int k_ = 0; k_ < 2; ++k_) { const int rr_ = 16 * k_ + (lane >> 2), pc_ = lane & 3; \
            __builtin_amdgcn_global_load_lds((const unsigned*)(PJ + (size_t)(row0 + t0_ + 32 * ylh + rr_) * PJW + C_Z + hd * 64 + 32 * yph + 8 * pc_), \
                                             (LAS unsigned*)(L + SS_Z + (2 * yph + ylh) * 2048 + k_ * 1024), 16, 0, 0); } } \
    } while (0)
    if (tid < 120) {
        const int rr = tid / 40, pc = tid % 40;
        const int ch = (pc < 8) ? hd * 64 + 8 * pc : (pc < 24 ? 1024 + g * 128 + 8 * (pc - 8) : 1280 + g * 128 + 8 * (pc - 24));
        u32x4 v = (u32x4){0u, 0u, 0u, 0u};
        if (sb >= NPB) { const float* st = C.inp(7) + ((size_t)(l * NSB_S + sb - NPB) * 3 + rr) * 1536 + ch; v = pack8(*(const f32x4*)st, *(const f32x4*)(st + 4)); }
        *(LAS u32x4*)(L + SS_RAW + rr * 640 + pc * 16) = v;
    }
#define SSD_S0(cc) do { LAS float* SC_ = (LAS float*)(L + SS_SCAL + ((cc) & 1) * 1024); \
        const float dt_ = softplus_f(C.dtr()[(size_t)(row0 + 64 * (cc) + lane) * 16 + hd] + dtb); float x_ = dt_ * aneg; \
        _Pragma("unroll") for (int o_ = 1; o_ < 64; o_ <<= 1) { const float y_ = bperm(x_, lane - o_); if (lane >= o_) x_ += y_; } \
        const float c63_ = __int_as_float(__builtin_amdgcn_readlane(__float_as_int(x_), 63)); \
        SC_[lane] = x_; SC_[64 + lane] = dt_; SC_[128 + lane] = __builtin_amdgcn_exp2f(1.4426950408889634f * (c63_ - x_)) * dt_; SC_[192 + lane] = __builtin_amdgcn_exp2f(1.4426950408889634f * x_); } while (0)
    if (wave == 7) SSD_S0(0);
    SSD_DMA_RAW(0); SSD_DMA_Z(0);
    asm volatile("s_waitcnt vmcnt(0)" ::: "memory");
    __syncthreads();
    for (int c = 0; c < NC; ++c) {
        const int t0 = 64 * c, par = c & 1;
        LAS float* SC = (LAS float*)(L + SS_SCAL + par * 1024);
        PROBE_BEGIN(12);
        asm volatile("s_waitcnt vmcnt(0)" ::: "memory"); LDS_FENCE(); __syncthreads();
        if (l == 0) PROBE_END(12, C);
        PROBE_BEGIN(10);
        if (stager) {
            const LAS float* CW = (const LAS float*)(L + SS_CW) + 2 * gp;
            const float a0 = CW[0], a1 = CW[320], a2 = CW[640], a3 = CW[960], ab = CW[1280];
            const float b0 = CW[1], b1 = CW[321], b2 = CW[641], b3 = CW[961], bb = CW[1281];
            const bool isB = (gp >= 32 && gp < 96);
#pragma unroll
            for (int tb = 0; tb < 4; ++tb) {
                const int tk0 = 32 * sth + 8 * tb;
                float xa[11], xb[11];
#pragma unroll
                for (int i = 0; i < 11; ++i) { const unsigned w = *(const LAS unsigned*)(L + SS_RAW + (tk0 + i) * 640 + 4 * gp); xa[i] = __uint_as_float(w << 16); xb[i] = __uint_as_float(w & 0xffff0000u); }
                float ta[8], tc[8];
#pragma unroll
                for (int j = 0; j < 8; ++j) {
                    ta[j] = fast_silu(ab + a0 * xa[j] + a1 * xa[j + 1] + a2 * xa[j + 2] + a3 * xa[j + 3]);
                    tc[j] = fast_silu(bb + b0 * xb[j] + b1 * xb[j + 1] + b2 * xb[j + 2] + b3 * xb[j + 3]);
                }
                if (gp < 32) {
                    u32x4 wa, wb;
                    wa.x = cvt_pk_bf16(ta[0], ta[1]); wa.y = cvt_pk_bf16(ta[2], ta[3]); wa.z = cvt_pk_bf16(ta[4], ta[5]); wa.w = cvt_pk_bf16(ta[6], ta[7]);
                    wb.x = cvt_pk_bf16(tc[0], tc[1]); wb.y = cvt_pk_bf16(tc[2], tc[3]); wb.z = cvt_pk_bf16(tc[4], tc[5]); wb.w = cvt_pk_bf16(tc[6], tc[7]);
                    *(LAS u32x4*)(L + SS_XST + (2 * gp) * 144 + tk0 * 2) = wa; *(LAS u32x4*)(L + SS_XST + (2 * gp + 1) * 144 + tk0 * 2) = wb;
                } else {
                    const int n0 = isB ? 2 * (gp - 32) : 2 * (gp - 96);
                    LAS unsigned char* img = L + (isB ? SS_BM : SS_CM);
#pragma unroll
                    for (int j = 0; j < 8; ++j) *(LAS unsigned*)(img + (tk0 + j) * 272 + n0 * 2) = cvt_pk_bf16(ta[j], tc[j]);
                    if (isB) {
                        float te[8];
#pragma unroll
                        for (int j = 0; j < 8; ++j) te[j] = SC[128 + tk0 + j];
                        u32x4 wa, wb;
                        wa.x = cvt_pk_bf16(ta[0] * te[0], ta[1] * te[1]); wa.y = cvt_pk_bf16(ta[2] * te[2], ta[3] * te[3]); wa.z = cvt_pk_bf16(ta[4] * te[4], ta[5] * te[5]); wa.w = cvt_pk_bf16(ta[6] * te[6], ta[7] * te[7]);
                        wb.x = cvt_pk_bf16(tc[0] * te[0], tc[1] * te[1]); wb.y = cvt_pk_bf16(tc[2] * te[2], tc[3] * te[3]); wb.z = cvt_pk_bf16(tc[4] * te[4], tc[5] * te[5]); wb.w = cvt_pk_bf16(tc[6] * te[6], tc[7] * te[7]);
                        *(LAS u32x4*)(L + SS_BWT + n0 * 144 + tk0 * 2) = wa; *(LAS u32x4*)(L + SS_BWT + (n0 + 1) * 144 + tk0 * 2) = wb;
                    }
                }
            }
        }
        if (l == 0) PROBE_END(10, C);
        PROBE_BEGIN(13);
        LDS_FENCE(); __syncthreads();
        if (l == 0) PROBE_END(13, C);
        PROBE_BEGIN(11);
        if (c + 1 < NC) SSD_DMA_RAW(c + 1);
        if (wave < 4) {
            const LAS unsigned char* HAc = L + SS_HA + par * (64 * 272);
            bf16x8 cf[8];
#pragma unroll
            for (int ks = 0; ks < 8; ++ks) cf[ks] = lds_frag(L + SS_CM, 32 * ylh + r, 272, 16 * ks + 8 * h);
            const float cuml = SC[32 * ylh + r], ecl = SC[192 + 32 * ylh + r];
            bf16x8 wf[2][2];
#pragma unroll
            for (int sh = 0; sh < 2; ++sh) {
                if (sh <= ylh) {
                    f32x16 ga;
#pragma unroll
                    for (int i = 0; i < 16; ++i) ga[i] = 0.f;
#pragma unroll
                    for (int ks = 0; ks < 8; ++ks) ga = MFMA32(lds_frag(L + SS_BM, 32 * sh + r, 272, 16 * ks + 8 * h), cf[ks], ga);
                    float wv[16];
#pragma unroll
                    for (int reg = 0; reg < 16; ++reg) {
                        const int s = 32 * sh + crow(reg, h), ll = 32 * ylh + r;
                        const float cs = SC[s], ds = SC[64 + s];
                        float w = (s <= ll) ? ga[reg] * __builtin_amdgcn_exp2f(1.4426950408889634f * (cuml - cs)) * ds : 0.f;
                        if (s == ll) w += Dh;
                        wv[reg] = w;
                    }
#pragma unroll
                    for (int s2 = 0; s2 < 2; ++s2) {
                        u32x4 p; p.x = cvt_pk_bf16(wv[8 * s2], wv[8 * s2 + 1]); p.y = cvt_pk_bf16(wv[8 * s2 + 2], wv[8 * s2 + 3]); p.z = cvt_pk_bf16(wv[8 * s2 + 4], wv[8 * s2 + 5]); p.w = cvt_pk_bf16(wv[8 * s2 + 6], wv[8 * s2 + 7]);
                        wf[sh][s2] = __builtin_bit_cast(bf16x8, p);
                    }
                }
            }
            f32x16 ya;
#pragma unroll
            for (int i = 0; i < 16; ++i) ya[i] = 0.f;
#pragma unroll
            for (int ks = 0; ks < 8; ++ks) ya = MFMA32(lds_frag(HAc, 32 * yph + r, 272, 16 * ks + 8 * h), cf[ks], ya);
#pragma unroll
            for (int i = 0; i < 16; ++i) ya[i] *= ecl;
#pragma unroll
            for (int sh = 0; sh < 2; ++sh) {
                if (sh <= ylh) {
#pragma unroll
                    for (int s2 = 0; s2 < 2; ++s2) {
                        const LAS unsigned char* xp = L + SS_XST + (32 * yph + r) * 144 + (32 * sh + 16 * s2 + 4 * h) * 2;
                        const u32x2 lo = *(const LAS u32x2*)(xp), hi = *(const LAS u32x2*)(xp + 16);
                        u32x4 a; a.x = lo.x; a.y = lo.y; a.z = hi.x; a.w = hi.y;
                        ya = MFMA32(__builtin_bit_cast(bf16x8, a), wf[sh][s2], ya);
                    }
                }
            }
            float ss = 0.f;
            bf16_t* zp = PJ + (size_t)(row0 + t0 + 32 * ylh + r) * PJW + C_Z + hd * 64 + 32 * yph + 4 * h;
#pragma unroll
            for (int gq = 0; gq < 4; ++gq) {
                const u32x2 zz = *(const LAS u32x2*)(L + SS_Z + (2 * yph + ylh) * 2048 + r * 64 + (8 * gq + 4 * h) * 2);
                const float z0 = __uint_as_float(zz.x << 16), z1 = __uint_as_float(zz.x & 0xffff0000u), z2 = __uint_as_float(zz.y << 16), z3 = __uint_as_float(zz.y & 0xffff0000u);
                const float y0 = ya[4 * gq] * fast_silu(z0), y1 = ya[4 * gq + 1] * fast_silu(z1), y2 = ya[4 * gq + 2] * fast_silu(z2), y3 = ya[4 * gq + 3] * fast_silu(z3);
                ss += (y0 * y0 + y1 * y1) + (y2 * y2 + y3 * y3);
                u32x2 w; w.x = cvt_pk_bf16(y0, y1); w.y = cvt_pk_bf16(y2, y3);
                *(u32x2*)(zp + 8 * gq) = w;
            }
            ss = xor32_sum(ss);
            if (h == 0) { float* q = C.ssq() + (size_t)(row0 + t0 + 32 * ylh + r) * 64 + hd * 4 + yph; q[0] = ss; q[2] = 0.f; }
            LDS_FENCE();
            if (c + 1 < NC) SSD_DMA_Z(c + 1);
        } else {
            if (wave == 7 && c + 1 < NC) SSD_S0(c + 1);
            const float decay = SC[192 + 63];
#pragma unroll
            for (int i = 0; i < 16; ++i) { hacc0[i] *= decay; hacc1[i] *= decay; }
#pragma unroll
            for (int ks = 0; ks < 4; ++ks) {
                const bf16x8 xb = lds_frag(L + SS_XST, 32 * sph + r, 144, 16 * ks + 8 * h);
                hacc0 = MFMA32(lds_frag(L + SS_BWT, 32 * nq0 + r, 144, 16 * ks + 8 * h), xb, hacc0);
                hacc1 = MFMA32(lds_frag(L + SS_BWT, 32 * (nq0 + 1) + r, 144, 16 * ks + 8 * h), xb, hacc1);
            }
            LAS unsigned char* HAn = L + SS_HA + (par ^ 1) * (64 * 272);
#pragma unroll
            for (int gq = 0; gq < 4; ++gq) {
                u32x2 w0, w1; w0.x = cvt_pk_bf16(hacc0[4 * gq], hacc0[4 * gq + 1]); w0.y = cvt_pk_bf16(hacc0[4 * gq + 2], hacc0[4 * gq + 3]);
                w1.x = cvt_pk_bf16(hacc1[4 * gq], hacc1[4 * gq + 1]); w1.y = cvt_pk_bf16(hacc1[4 * gq + 2], hacc1[4 * gq + 3]);
                *(LAS u32x2*)(HAn + (32 * sph + r) * 272 + (32 * nq0 + 8 * gq + 4 * h) * 2) = w0;
                *(LAS u32x2*)(HAn + (32 * sph + r) * 272 + (32 * (nq0 + 1) + 8 * gq + 4 * h) * 2) = w1;
            }
        }
        if (l == 0) PROBE_END(11, C);
    }
    if (wave >= 4) {
        float* o = out_sh(C, l, sb) + ((size_t)hd * 64 + 32 * sph + r) * 128;
#pragma unroll
        for (int gq = 0; gq < 4; ++gq) {
            f32x4 v0, v1;
#pragma unroll
            for (int e = 0; e < 4; ++e) { v0[e] = hacc0[4 * gq + e]; v1[e] = hacc1[4 * gq + e]; }
            *(f32x4*)(o + 32 * nq0 + 8 * gq + 4 * h) = v0; *(f32x4*)(o + 32 * (nq0 + 1) + 8 * gq + 4 * h) = v1;
        }
    }
    __syncthreads();
#undef SSD_DMA_RAW
#undef SSD_DMA_Z
#undef SSD_S0
}

DI unsigned mono_key(float f) { const unsigned u = __float_as_uint(f); return (u & 0x80000000u) ? ~u : (u | 0x80000000u); }
DI int t5_bucket(int rel) {
    const int n = rel < 0 ? -rel : rel; int b;
    if (n < 8) b = n; else if (n < 12) b = 8; else if (n < 16) b = 9; else if (n < 23) b = 10; else if (n < 32) b = 11; else if (n < 46) b = 12; else if (n < 64) b = 13; else if (n < 91) b = 14; else b = 15;
    return b + (rel > 0 ? 16 : 0);
}
DI void attn_item_naive(const Ctx& C, int l, int m, LAS unsigned char* scr) {
    const int lane = C.lane;
    int sb, t; row_sbt(m, sb, t);
    const int P = sb_P(sb), posq = P + t, Ladm = 64 * ((posq >> 6) + 1), nsel = Ladm < 256 ? Ladm : 256;
    LAS unsigned* keys = (LAS unsigned*)scr; LAS unsigned* sel = keys + 2048; LAS float* qs = (LAS float*)(sel + 256); LAS float* ps = qs + 64; LAS float* qis = ps + 256;
    bf16_t* PJ = C.proj(); const bf16_t* KV = C.kvb(l) + kvb_off(sb);
    const size_t rb = (size_t)m * PJW;
#pragma unroll
    for (int j = 0; j < 4; ++j) qis[64 * j + lane] = bf2f(PJ[rb + C_QI + 64 * j + lane]);
    LDS_FENCE();
    const float w0 = C.wi()[(size_t)m * 4 + 0], w1 = C.wi()[(size_t)m * 4 + 1], w2 = C.wi()[(size_t)m * 4 + 2], w3 = C.wi()[(size_t)m * 4 + 3];
    for (int s = lane; s < Ladm; s += 64) {
        asm volatile("" ::: "memory");
        const bf16_t* kp = KV + (size_t)s * KVW + 256;
        float d0 = 0.f, d1 = 0.f, d2 = 0.f, d3 = 0.f;
#pragma unroll
        for (int d = 0; d < 64; d += 8) {
            const bf16x8 kv8 = *(const bf16x8*)(kp + d);
#pragma unroll
            for (int j = 0; j < 8; ++j) { const float kf = bf2f((bf16_t)kv8[j]); d0 += qis[d + j] * kf; d1 += qis[64 + d + j] * kf; d2 += qis[128 + d + j] * kf; d3 += qis[192 + d + j] * kf; }
            asm volatile("" ::: "memory");
        }
        const float score = ((w0 * fmaxf(d0, 0.f) + w1 * fmaxf(d1, 0.f)) + w2 * fmaxf(d2, 0.f)) + w3 * fmaxf(d3, 0.f);
        keys[s] = mono_key(score);
    }
    LDS_FENCE();
    for (int s = lane; s < Ladm; s += 64) {
        const unsigned km = keys[s]; int cnt = 0;
        for (int sp = 0; sp < Ladm; sp += 4) {
            const u32x4 kq = *(const LAS u32x4*)(keys + sp);
            cnt += (kq.x > km) | ((kq.x == km) & (sp < s));
            cnt += (kq.y > km) | ((kq.y == km) & (sp + 1 < s));
            cnt += (kq.z > km) | ((kq.z == km) & (sp + 2 < s));
            cnt += (kq.w > km) | ((kq.w == km) & (sp + 3 < s));
        }
        if (cnt < 256) sel[cnt] = (unsigned)s;
    }
    LDS_FENCE();
    for (int hq = 0; hq < 8; ++hq) {
        const int kvh = hq >> 2;
        { const float raw = bf2f(PJ[rb + C_Q + hq * 64 + lane]); const float ss = wave_sum(raw * raw);
          qs[lane] = raw * rsqrtf(ss * (1.f / 64.f) + EPS) * C.inp(18)[l * 64 + lane]; }
        LDS_FENCE();
        float lg[4]; float mx = -INFINITY;
#pragma unroll
        for (int i = 0; i < 4; ++i) {
            const int j = lane + 64 * i; lg[i] = -INFINITY;
            asm volatile("" ::: "memory");
            if (j < nsel) {
                const int s = (int)sel[j]; const bf16_t* kp = KV + (size_t)s * KVW + kvh * 64; float dot = 0.f;
#pragma unroll
                for (int d = 0; d < 64; d += 8) { const bf16x8 kv8 = *(const bf16x8*)(kp + d);
#pragma unroll
                    for (int jj = 0; jj < 8; ++jj) dot += qs[d + jj] * bf2f((bf16_t)kv8[jj]); }
                lg[i] = dot * 0.125f + C.inp(20)[t5_bucket(s - posq) * 8 + hq];
                mx = fmaxf(mx, lg[i]);
            }
        }
        mx = wave_max(mx);
        float sum = 0.f;
#pragma unroll
        for (int i = 0; i < 4; ++i) { const int j = lane + 64 * i; if (j < nsel) { lg[i] = expf(lg[i] - mx); sum += lg[i]; } }
        sum = wave_sum(sum); const float inv = 1.f / sum;
#pragma unroll
        for (int i = 0; i < 4; ++i) { const int j = lane + 64 * i; if (j < nsel) ps[j] = lg[i] * inv; }
        LDS_FENCE();
        float o = 0.f;
        for (int j = 0; j < nsel; ++j) o += ps[j] * bf2f(KV[(size_t)sel[j] * KVW + 128 + kvh * 64 + lane]);
        const float ga = bf2f(PJ[rb + C_GA + hq * 64 + lane]);
        PJ[rb + C_GA + hq * 64 + lane] = f2bf(o * silu_f(ga));
        LDS_FENCE();
    }
}

constexpr int AT_MASK = 0;
constexpr int AT_TMASK = AT_MASK + 64 * 65 * 4;
constexpr int AT_QST = AT_TMASK + 64 * 65 * 4;
constexpr int AT_MISC = AT_QST + 1024;
constexpr int AT_LUT = AT_MISC + 64;
constexpr int AT_HIST = AT_LUT + 8192;
constexpr int AT_RING = AT_HIST;
constexpr int AT_QI = AT_HIST + 65792;
constexpr int AT_END = AT_QI + 64 * 528;
static_assert(AT_END <= LDS_BYTES - 256 && AT_RING + 65536 <= AT_END, "attention LDS map");
typedef short v4i16_t __attribute__((ext_vector_type(4)));
#define AT_WAIT_V(n) asm volatile("s_waitcnt vmcnt(" #n ")" ::: "memory")
#define AT_BAR() do { asm volatile("s_waitcnt lgkmcnt(0)" ::: "memory"); __builtin_amdgcn_s_barrier(); asm volatile("" ::: "memory"); } while (0)

template <int MODE>
DI void idx_pass(const Ctx& C, const bf16_t* KV, const float (&w4)[4], int ntiles, int tq4, int q, int r, int h) {
    LAS unsigned char* L = C.lds;
    const LAS unsigned* QS = (const LAS unsigned*)(L + AT_QST) + 4 * q;
    const unsigned pfx = QS[0], info = QS[1];
    const int lvl = info & 15; const bool done = (info >> 4) & 1, tie = (info >> 5) & 1;
    const int sh = (MODE == 0) ? (lvl == 0 ? 23 : (lvl == 1 ? 14 : (lvl == 2 ? 5 : 0))) : (int)(info >> 8);
    const unsigned bmask = (lvl == 3) ? 31u : 511u;
    const int psh = (lvl == 1) ? 23 : (lvl == 2 ? 14 : 5);
    bf16x8 an[2][4];
    if (tq4 < ntiles) {
#pragma unroll
        for (int kh = 0; kh < 2; ++kh)
#pragma unroll
            for (int ks = 0; ks < 4; ++ks) an[kh][ks] = *(const bf16x8*)(KV + (size_t)(64 * tq4 + 32 * kh + r) * KVW + 256 + 8 * h + 16 * ks);
    }
    for (int t = tq4; t < ntiles; t += 4) {
        bf16x8 ac[2][4];
#pragma unroll
        for (int kh = 0; kh < 2; ++kh)
#pragma unroll
            for (int ks = 0; ks < 4; ++ks) ac[kh][ks] = an[kh][ks];
        if (t + 4 < ntiles) {
#pragma unroll
            for (int kh = 0; kh < 2; ++kh)
#pragma unroll
                for (int ks = 0; ks < 4; ++ks) an[kh][ks] = *(const bf16x8*)(KV + (size_t)(64 * (t + 4) + 32 * kh + r) * KVW + 256 + 8 * h + 16 * ks);
        }
#pragma unroll
        for (int kh = 0; kh < 2; ++kh) {
            bf16x8 a[4];
#pragma unroll
            for (int ks = 0; ks < 4; ++ks) a[ks] = ac[kh][ks];
            float sc[16];
#pragma unroll
            for (int i = 0; i < 16; ++i) sc[i] = 0.f;
#pragma unroll
            for (int hh = 0; hh < 4; ++hh) {
                f32x16 acc;
#pragma unroll
                for (int i = 0; i < 16; ++i) acc[i] = 0.f;
#pragma unroll
                for (int ks = 0; ks < 4; ++ks) acc = MFMA32(a[ks], *(const LAS bf16x8*)(L + AT_QI + q * 528 + (64 * hh + 16 * ks + 8 * h) * 2), acc);
#pragma unroll
                for (int i = 0; i < 16; ++i) sc[i] += w4[hh] * fmaxf(acc[i], 0.f);
            }
            if (MODE == 0) {
                if (!done) {
                    LAS unsigned* HR = (LAS unsigned*)(L + AT_HIST) + 257 * q;
#pragma unroll
                    for (int i = 0; i < 16; ++i) {
                        const unsigned key = mono_key(sc[i]);
                        const bool part = (lvl == 0) || ((key >> psh) == pfx);
                        if (part) { const unsigned bin = (key >> sh) & bmask; atomicAdd((unsigned*)(HR + (bin >> 1)), 1u << ((bin & 1u) << 4)); }
                    }
                }
            } else {
                unsigned mw = 0u, tw = 0u;
#pragma unroll
                for (int i = 15; i >= 0; --i) {
                    const unsigned key = mono_key(sc[i]);
                    const bool sel = tie ? (key > pfx) : ((key >> sh) >= pfx);
                    const bool tb = tie && (key == pfx);
                    mw = (mw << 1) | (sel ? 1u : 0u); tw = (tw << 1) | (tb ? 1u : 0u);
                    if ((i & 3) == 0 && i > 0) { mw <<= 4; tw <<= 4; }
                }
                mw <<= 4 * h; tw <<= 4 * h;
                if (mw) atomicOr((unsigned*)((LAS unsigned*)(L + AT_MASK) + 65 * q + 2 * t + kh), mw);
                if (tw) atomicOr((unsigned*)((LAS unsigned*)(L + AT_TMASK) + 65 * q + 2 * t + kh), tw);
            }
        }
    }
}

DI void attn_item(const Ctx& C, int l, int sb, int qb) {
    const int tid = C.tid, lane = C.lane, wave = C.wave, r = lane & 31, h = lane >> 5;
    LAS unsigned char* L = C.lds;
    const int P = sb_P(sb), row0 = sb_row0(sb), t0 = 64 * qb, pos0 = P + t0;
    const int ntiles = (pos0 >> 6) + 1, Ladm = 64 * ntiles;
    bf16_t* PJ = C.proj(); const bf16_t* KV = C.kvb(l) + kvb_off(sb);
    LAS unsigned* MASK = (LAS unsigned*)(L + AT_MASK); LAS unsigned* TMASK = (LAS unsigned*)(L + AT_TMASK);
    LAS unsigned* QST = (LAS unsigned*)(L + AT_QST); LAS unsigned* MISC = (LAS unsigned*)(L + AT_MISC);
#ifdef PROBE_QB
    const bool pcond = (l == 0 && sb == 0 && qb == PROBE_QB);
#else
    const bool pcond = false;
#endif
    PROBE_BEGIN(40); PROBE_BEGIN(41);
    for (int i = tid; i < 64 * 65; i += NTHREADS) { const int w = i % 65; MASK[i] = (Ladm <= 256 && w < 2 * ntiles) ? 0xffffffffu : 0u; TMASK[i] = 0u; }
    for (int i = tid; i < 64 * 257; i += NTHREADS) ((LAS unsigned*)(L + AT_HIST))[i] = 0u;
    if (tid < 64) { unsigned k256 = 256u; asm volatile("" : "+v"(k256)); QST[4 * tid] = 0u; QST[4 * tid + 1] = 0u; QST[4 * tid + 2] = k256; QST[4 * tid + 3] = 0u; }
    for (int i = tid; i < 8 * 256; i += NTHREADS) { const int hq = i >> 8, rel = (i & 255) - 191; ((LAS float*)(L + AT_LUT))[i] = 1.4426950408889634f * C.inp(20)[t5_bucket(rel) * 8 + hq]; }
    if (tid == 0) MISC[0] = 0u;
    __syncthreads();
    if (pcond) PROBE_END(41, C);
    PROBE_BEGIN(4); PROBE_BEGIN(42);
    if (Ladm > 256) {
        const int qh = wave & 1, tq4 = wave >> 1, q = 32 * qh + r;
        float w4[4];
        { const f32x4 wv = *(const f32x4*)(C.wi() + (size_t)(row0 + t0 + q) * 4); w4[0] = wv[0]; w4[1] = wv[1]; w4[2] = wv[2]; w4[3] = wv[3]; }
        for (int i = tid; i < 2048; i += NTHREADS) { const int qq = i >> 5, pc = i & 31;
            *(LAS u32x4*)(L + AT_QI + qq * 528 + pc * 16) = *(const u32x4*)(PJ + (size_t)(row0 + t0 + qq) * PJW + C_QI + 8 * pc); }
        __syncthreads();
        for (int lvl = 0; lvl < 4; ++lvl) {
            PROBE_BEGIN(20);
            idx_pass<0>(C, KV, w4, ntiles, tq4, q, r, h);
            if (tid == 0) MISC[0] = 0u;
            __syncthreads();
            if (l == 0) PROBE_END(20, C);
            PROBE_BEGIN(21);
            int ln = lane; asm volatile("" : "+v"(ln));
            for (int qq = 8 * wave; qq < 8 * wave + 8; ++qq) {
                const unsigned pfx = QST[4 * qq], info = QST[4 * qq + 1], need = QST[4 * qq + 2];
                if ((info >> 4) & 1) continue;
                LAS unsigned* HR = (LAS unsigned*)(L + AT_HIST) + 257 * qq + 4 * ln;
                unsigned c[8];
#pragma unroll
                for (int j = 0; j < 4; ++j) { const unsigned wv = HR[j]; c[2 * j] = wv & 0xffffu; c[2 * j + 1] = wv >> 16; HR[j] = 0u; }
                unsigned ct = 0u;
#pragma unroll
                for (int j = 0; j < 8; ++j) ct += c[j];
                unsigned S = ct;
#pragma unroll
                for (int o = 1; o < 64; o <<= 1) { const unsigned y = (unsigned)__builtin_amdgcn_ds_bpermute((ln + o) << 2, (int)S); if (ln + o < 64) S += y; }
                if (S >= need && (S - ct) < need) {
                    unsigned rem = need - (S - ct), cum = 0u; int b = 0; unsigned cb = 0u;
                    bool found = false;
#pragma unroll
                    for (int j = 7; j >= 0; --j) { if (!found) { if (cum + c[j] >= rem) { b = j; cb = c[j]; found = true; } else cum += c[j]; } }
                    const unsigned need2 = rem - cum, binidx = 8u * ln + (unsigned)b;
                    const int bits = (lvl == 3) ? 5 : 9, shc = (lvl == 0) ? 23 : (lvl == 1 ? 14 : (lvl == 2 ? 5 : 0));
                    const unsigned npfx = (lvl == 0) ? binidx : ((pfx << bits) | binidx);
                    unsigned ninfo, nneed = need2, opfx = npfx;
                    if (need2 == cb) ninfo = (unsigned)lvl | 16u | ((unsigned)shc << 8);
                    else if (lvl == 0 && (binidx == 256u || binidx == 255u)) { ninfo = 16u | 32u; opfx = (binidx == 256u) ? 0x80000000u : 0x7fffffffu; }
                    else if (lvl == 3) ninfo = 16u | 32u;
                    else { ninfo = (unsigned)(lvl + 1); atomicAdd((unsigned*)MISC, 1u); }
                    QST[4 * qq] = opfx; QST[4 * qq + 1] = ninfo; QST[4 * qq + 2] = nneed;
                }
            }
            __syncthreads();
            if (l == 0) PROBE_END(21, C);
            if (MISC[0] == 0u) break;
            __syncthreads();
        }
        PROBE_BEGIN(22);
        idx_pass<1>(C, KV, w4, ntiles, tq4, q, r, h);
        __syncthreads();
        if (l == 0) PROBE_END(22, C);
        PROBE_BEGIN(23);
        int ln2 = lane; asm volatile("" : "+v"(ln2));
        for (int qq = 8 * wave; qq < 8 * wave + 8; ++qq) {
            if (!((QST[4 * qq + 1] >> 5) & 1)) continue;
            const unsigned mwd = (ln2 < 2 * ntiles) ? MASK[65 * qq + ln2] : 0u, twd = (ln2 < 2 * ntiles) ? TMASK[65 * qq + ln2] : 0u;
            int have = __popc(mwd);
#pragma unroll
            for (int o = 1; o < 64; o <<= 1) have += __builtin_amdgcn_ds_bpermute((ln2 ^ o) << 2, have);
            const int want = 256 - have, pc = __popc(twd);
            int incl = pc;
#pragma unroll
            for (int o = 1; o < 64; o <<= 1) { const int y = __builtin_amdgcn_ds_bpermute((ln2 - o) << 2, incl); if (ln2 >= o) incl += y; }
            int take = want - (incl - pc); take = take < 0 ? 0 : (take > pc ? pc : take);
            unsigned wrem = twd, add = 0u;
            for (int k = 0; k < take; ++k) { add |= wrem & (0u - wrem); wrem &= wrem - 1u; }
            if (add) MASK[65 * qq + ln2] = mwd | add;
        }
        __syncthreads();
        if (l == 0) PROBE_END(23, C);
    }
    if (l == 0) PROBE_END(4, C);
    if (pcond) PROBE_END(42, C);
    PROBE_BEGIN(43);
    PROBE_BEGIN(5);
    const int hq = wave, kvh = wave >> 2;
    const unsigned ring = (unsigned)(size_t)(L + AT_RING);
    const float* LUT = nullptr; (void)LUT;
    const LAS float* lut = (const LAS float*)(L + AT_LUT) + 256 * hq;
    const float cfar = lut[0];
#define AT_DMA(tt, slot) do { const bf16_t* src_ = KV + (size_t)(64 * (tt)) * KVW; \
        _Pragma("unroll") for (int i_ = 0; i_ < 2; ++i_) { const int k_ = wave * 2 + i_, row_ = 4 * k_ + (lane >> 4), pc_ = lane & 15; \
            __builtin_amdgcn_global_load_lds((const unsigned*)(src_ + (size_t)row_ * KVW + 8 * (pc_ ^ (row_ & 15))), (LAS unsigned*)(L + AT_RING + (slot) * 32768 + k_ * 1024), 16, 0, 0); \
            __builtin_amdgcn_global_load_lds((const unsigned*)(src_ + (size_t)row_ * KVW + 128 + 8 * pc_), (LAS unsigned*)(L + AT_RING + (slot) * 32768 + 16384 + k_ * 1024), 16, 0, 0); } \
    } while (0)
    for (int qh = 0; qh < 2; ++qh) {
        const int q = 32 * qh + r, qrow = row0 + t0 + q;
        bf16x8 qf[4];
        { const bf16_t* qp = PJ + (size_t)qrow * PJW + C_Q + hq * 64 + 8 * h; float qv[4][8]; float ss = 0.f;
#pragma unroll
          for (int ks = 0; ks < 4; ++ks) { const u32x4 v = *(const u32x4*)(qp + 16 * ks);
              qv[ks][0] = __uint_as_float(v.x << 16); qv[ks][1] = __uint_as_float(v.x & 0xffff0000u); qv[ks][2] = __uint_as_float(v.y << 16); qv[ks][3] = __uint_as_float(v.y & 0xffff0000u);
              qv[ks][4] = __uint_as_float(v.z << 16); qv[ks][5] = __uint_as_float(v.z & 0xffff0000u); qv[ks][6] = __uint_as_float(v.w << 16); qv[ks][7] = __uint_as_float(v.w & 0xffff0000u);
#pragma unroll
              for (int j = 0; j < 8; ++j) ss += qv[ks][j] * qv[ks][j]; }
          ss = xor32_sum(ss);
          const float sc = rsqrtf(ss * (1.f / 64.f) + EPS) * (0.125f * 1.4426950408889634f);
          const float* qn = C.inp(18) + l * 64 + 8 * h;
#pragma unroll
          for (int ks = 0; ks < 4; ++ks) { const f32x4 n0 = *(const f32x4*)(qn + 16 * ks), n1 = *(const f32x4*)(qn + 16 * ks + 4);
              u32x4 p; p.x = cvt_pk_bf16(qv[ks][0] * sc * n0[0], qv[ks][1] * sc * n0[1]); p.y = cvt_pk_bf16(qv[ks][2] * sc * n0[2], qv[ks][3] * sc * n0[3]);
              p.z = cvt_pk_bf16(qv[ks][4] * sc * n1[0], qv[ks][5] * sc * n1[1]); p.w = cvt_pk_bf16(qv[ks][6] * sc * n1[2], qv[ks][7] * sc * n1[3]);
              qf[ks] = __builtin_bit_cast(bf16x8, p); } }
        f32x16 o0, o1;
#pragma unroll
        for (int i = 0; i < 16; ++i) { o0[i] = 0.f; o1[i] = 0.f; }
        float mrun = -1e30f, lrun = 0.f;
        AT_WAIT_V(0);
        AT_DMA(0, 0);
        for (int t = 0; t < ntiles; ++t) {
            const int slot = t & 1;
            if (t + 1 < ntiles) { AT_DMA(t + 1, slot ^ 1); AT_WAIT_V(4); } else { AT_WAIT_V(0); }
            AT_BAR();
            const LAS unsigned char* Kt = L + AT_RING + slot * 32768; const LAS unsigned char* Vt = Kt + 16384;
            f32x16 s0, s1;
#pragma unroll
            for (int i = 0; i < 16; ++i) { s0[i] = 0.f; s1[i] = 0.f; }
#pragma unroll
            for (int ks = 0; ks < 4; ++ks) {
                const int pc = kvh * 8 + 2 * ks + h;
                const bf16x8 k0 = *(const LAS bf16x8*)(Kt + r * 256 + ((pc ^ (r & 15)) << 4));
                const bf16x8 k1 = *(const LAS bf16x8*)(Kt + (32 + r) * 256 + ((pc ^ (r & 15)) << 4));
                s0 = MFMA32(k0, qf[ks], s0); s1 = MFMA32(k1, qf[ks], s1);
            }
            const unsigned m0 = MASK[65 * q + 2 * t] >> (4 * h), m1 = MASK[65 * q + 2 * t + 1] >> (4 * h);
            const bool nearb = (t + 3 > ntiles - 1);
            float tmax = -1e30f;
#pragma unroll
            for (int i = 0; i < 16; ++i) {
                const int kl = (i & 3) + 8 * (i >> 2);
                float b0 = cfar, b1 = cfar;
                if (nearb) { const int rel = 64 * t + kl + 4 * h - (pos0 + q); b0 = lut[rel + 191]; b1 = lut[rel + 32 + 191]; }
                s0[i] += b0; s1[i] += b1;
                if ((m0 >> kl) & 1u) tmax = fmaxf(tmax, s0[i]);
                if ((m1 >> kl) & 1u) tmax = fmaxf(tmax, s1[i]);
            }
            tmax = xor32_max(tmax);
            const float mnew = fmaxf(mrun, tmax), alpha = __builtin_amdgcn_exp2f(mrun - mnew);
            mrun = mnew;
            float psum = 0.f;
#pragma unroll
            for (int i = 0; i < 16; ++i) {
                const int kl = (i & 3) + 8 * (i >> 2);
                const float p0 = ((m0 >> kl) & 1u) ? __builtin_amdgcn_exp2f(s0[i] - mnew) : 0.f, p1 = ((m1 >> kl) & 1u) ? __builtin_amdgcn_exp2f(s1[i] - mnew) : 0.f;
                s0[i] = p0; s1[i] = p1; psum += p0 + p1;
            }
            lrun = lrun * alpha + psum;
#pragma unroll
            for (int i = 0; i < 16; ++i) { o0[i] *= alpha; o1[i] *= alpha; }
#pragma unroll
            for (int kk = 0; kk < 4; ++kk) {
                u32x4 pw;
                if (kk == 0) { pw.x = cvt_pk_bf16(s0[0], s0[1]); pw.y = cvt_pk_bf16(s0[2], s0[3]); pw.z = cvt_pk_bf16(s0[4], s0[5]); pw.w = cvt_pk_bf16(s0[6], s0[7]); }
                else if (kk == 1) { pw.x = cvt_pk_bf16(s0[8], s0[9]); pw.y = cvt_pk_bf16(s0[10], s0[11]); pw.z = cvt_pk_bf16(s0[12], s0[13]); pw.w = cvt_pk_bf16(s0[14], s0[15]); }
                else if (kk == 2) { pw.x = cvt_pk_bf16(s1[0], s1[1]); pw.y = cvt_pk_bf16(s1[2], s1[3]); pw.z = cvt_pk_bf16(s1[4], s1[5]); pw.w = cvt_pk_bf16(s1[6], s1[7]); }
                else { pw.x = cvt_pk_bf16(s1[8], s1[9]); pw.y = cvt_pk_bf16(s1[10], s1[11]); pw.z = cvt_pk_bf16(s1[12], s1[13]); pw.w = cvt_pk_bf16(s1[14], s1[15]); }
                const bf16x8 pb = __builtin_bit_cast(bf16x8, pw);
                const int i16 = lane & 15, key0 = 16 * kk + 4 * h + (i16 >> 2);
#pragma unroll
                for (int dh = 0; dh < 2; ++dh) {
                    const int dcol = kvh * 64 + 32 * dh + 16 * ((lane >> 4) & 1) + 4 * (i16 & 3);
                    const v4i16_t lo = __builtin_amdgcn_ds_read_tr16_b64_v4i16((LAS v4i16_t*)(Vt + key0 * 256 + dcol * 2));
                    const v4i16_t hi = __builtin_amdgcn_ds_read_tr16_b64_v4i16((LAS v4i16_t*)(Vt + (key0 + 8) * 256 + dcol * 2));
                    const bf16x8 va = (bf16x8){lo[0], lo[1], lo[2], lo[3], hi[0], hi[1], hi[2], hi[3]};
                    if (dh == 0) o0 = MFMA32(va, pb, o0); else o1 = MFMA32(va, pb, o1);
                }
            }
            AT_BAR();
        }
        lrun = xor32_sum(lrun);
        const float inv = 1.f / lrun;
        bf16_t* gp = PJ + (size_t)qrow * PJW + C_GA + hq * 64 + 4 * h;
#pragma unroll
        for (int dh = 0; dh < 2; ++dh)
#pragma unroll
            for (int gq = 0; gq < 4; ++gq) {
                const u32x2 gg = *(const u32x2*)(gp + 32 * dh + 8 * gq);
                const float g0 = __uint_as_float(gg.x << 16), g1 = __uint_as_float(gg.x & 0xffff0000u), g2 = __uint_as_float(gg.y << 16), g3 = __uint_as_float(gg.y & 0xffff0000u);
                const float a0 = (dh == 0 ? o0[4 * gq] : o1[4 * gq]) * inv, a1 = (dh == 0 ? o0[4 * gq + 1] : o1[4 * gq + 1]) * inv, a2 = (dh == 0 ? o0[4 * gq + 2] : o1[4 * gq + 2]) * inv, a3 = (dh == 0 ? o0[4 * gq + 3] : o1[4 * gq + 3]) * inv;
                u32x2 w; w.x = cvt_pk_bf16(a0 * fast_silu(g0), a1 * fast_silu(g1)); w.y = cvt_pk_bf16(a2 * fast_silu(g2), a3 * fast_silu(g3));
                *(u32x2*)(gp + 32 * dh + 8 * gq) = w;
            }
    }
#undef AT_DMA
    AT_WAIT_V(0);
    __syncthreads();
    if (l == 0) PROBE_END(5, C);
    if (pcond) { PROBE_END(43, C); PROBE_END(40, C); }
}

constexpr int LR_RAW = 0;
constexpr int LR_GL = LR_RAW + 67 * 128;
constexpr int LR_XC = LR_GL + 2 * 8192;
constexpr int LR_XCF = LR_XC + 64 * 144;
constexpr int LR_SEG = LR_XCF + 64 * 256;
constexpr int LR_YS = LR_SEG + 2048;
constexpr int LR_END = LR_YS + 8192;
static_assert(LR_END <= LDS_BYTES - 256, "LRU LDS map");
typedef float f32x4v __attribute__((ext_vector_type(4)));
#define MFMA16(a, b, c) __builtin_amdgcn_mfma_f32_16x16x32_bf16((a), (b), (c), 0, 0, 0)
DI float fast_sigmoid(float x) { return __builtin_amdgcn_rcpf(1.f + __builtin_amdgcn_exp2f(-1.4426950408889634f * x)); }

DI void lru_item(const Ctx& C, int l, int sb, int blk) {
    const int tid = C.tid, lane = C.lane, wave = C.wave, fr = lane & 15, fq = lane >> 4;
    const int T = sb_T(sb), row0 = sb_row0(sb), NC = T / 64;
    LAS unsigned char* L = C.lds;
    bf16_t* PJ = C.proj();
    const int ts = wave >> 1, dh = wave & 1;
    bf16x8 wf[2][2][2];
#pragma unroll
    for (int gt = 0; gt < 2; ++gt)
#pragma unroll
        for (int db = 0; db < 2; ++db)
#pragma unroll
            for (int kb = 0; kb < 2; ++kb) {
                const float* wp = (gt == 0 ? C.inp(13) : C.inp(15)) + ((size_t)(l * 8 + blk) * 64 + 32 * kb + 8 * fq) * 64 + 32 * dh + 16 * db + fr;
                u32x4 p; p.x = cvt_pk_bf16(wp[0], wp[64]); p.y = cvt_pk_bf16(wp[128], wp[192]); p.z = cvt_pk_bf16(wp[256], wp[320]); p.w = cvt_pk_bf16(wp[384], wp[448]);
                wf[gt][db][kb] = __builtin_bit_cast(bf16x8, p);
            }
    float ba[2], bx[2], spl[2], hc[2];
#pragma unroll
    for (int db = 0; db < 2; ++db) {
        const int ch = blk * 64 + 32 * dh + 16 * db + fr;
        ba[db] = C.inp(14)[l * 512 + ch]; bx[db] = C.inp(16)[l * 512 + ch]; spl[db] = 8.f * 1.4426950408889634f * softplus_f(-C.inp(17)[l * 512 + ch]);
        hc[db] = (sb >= NPB) ? C.inp(6)[(size_t)(l * NSB_S + sb - NPB) * 512 + ch] : 0.f;
    }
    const int cp = tid & 31, sg = tid >> 5;
    float cw[2][5];
#pragma unroll
    for (int e = 0; e < 2; ++e) { const int ch = blk * 64 + 2 * cp + e;
#pragma unroll
        for (int j = 0; j < 4; ++j) cw[e][j] = C.inp(11)[((size_t)l * 4 + j) * 512 + ch];
        cw[e][4] = C.inp(12)[l * 512 + ch]; }
#define LRU_DMA(cc) do { const int t0_ = 64 * (cc); \
        for (int k_ = wave; k_ < 9; k_ += NWAVES) { const int q_ = 64 * k_ + lane, rr_ = q_ >> 3, pc_ = q_ & 7, t_ = t0_ - 3 + rr_; \
            if (q_ < 536 && t_ >= 0) __builtin_amdgcn_global_load_lds((const unsigned*)(PJ + (size_t)(row0 + t_) * PJW + C_XL + blk * 64 + 8 * pc_), (LAS unsigned*)(L + LR_RAW + k_ * 1024), 16, 0, 0); } \
        { const int rr_ = 8 * wave + (lane >> 3), pc_ = lane & 7; \
          __builtin_amdgcn_global_load_lds((const unsigned*)(PJ + (size_t)(row0 + t0_ + rr_) * PJW + C_GL + blk * 64 + 8 * pc_), (LAS unsigned*)(L + LR_GL + ((cc) & 1) * 8192 + wave * 1024), 16, 0, 0); } \
    } while (0)
    if (tid < 24) {
        const int rr = tid >> 3, pc = tid & 7; u32x4 v = (u32x4){0u, 0u, 0u, 0u};
        if (sb >= NPB) { const float* st = C.inp(5) + ((size_t)(l * NSB_S + sb - NPB) * 3 + rr) * 512 + blk * 64 + 8 * pc; v = pack8(*(const f32x4*)st, *(const f32x4*)(st + 4)); }
        *(LAS u32x4*)(L + LR_RAW + rr * 128 + pc * 16) = v;
    }
    LRU_DMA(0);
    asm volatile("s_waitcnt vmcnt(0)" ::: "memory");
    __syncthreads();
    for (int c = 0; c < NC; ++c) {
        const int t0 = 64 * c;
        {
            float xa[7], xb[7];
#pragma unroll
            for (int i = 0; i < 7; ++i) { const unsigned w = *(const LAS unsigned*)(L + LR_RAW + (4 * sg + i) * 128 + 4 * cp); xa[i] = __uint_as_float(w << 16); xb[i] = __uint_as_float(w & 0xffff0000u); }
#pragma unroll
            for (int j = 0; j < 4; ++j) {
                const float ya = cw[0][4] + cw[0][0] * xa[j] + cw[0][1] * xa[j + 1] + cw[0][2] * xa[j + 2] + cw[0][3] * xa[j + 3];
                const float yb = cw[1][4] + cw[1][0] * xb[j] + cw[1][1] * xb[j + 1] + cw[1][2] * xb[j + 2] + cw[1][3] * xb[j + 3];
                *(LAS unsigned*)(L + LR_XC + (4 * sg + j) * 144 + 4 * cp) = cvt_pk_bf16(ya, yb);
                f32x2_t v2 = {ya, yb}; *(LAS f32x2_t*)(L + LR_XCF + (4 * sg + j) * 256 + 8 * cp) = v2;
            }
        }
        LDS_FENCE(); __syncthreads();
        if (c + 1 < NC) LRU_DMA(c + 1);
        f32x4v ga[2], gx[2];
#pragma unroll
        for (int db = 0; db < 2; ++db) { ga[db] = (f32x4v){0.f, 0.f, 0.f, 0.f}; gx[db] = (f32x4v){0.f, 0.f, 0.f, 0.f}; }
#pragma unroll
        for (int kb = 0; kb < 2; ++kb) {
            const bf16x8 af = *(const LAS bf16x8*)(L + LR_XC + (16 * ts + fr) * 144 + (32 * kb + 8 * fq) * 2);
#pragma unroll
            for (int db = 0; db < 2; ++db) { ga[db] = MFMA16(af, wf[0][db][kb], ga[db]); gx[db] = MFMA16(af, wf[1][db][kb], gx[db]); }
        }
        float Pk[2][4], Hk[2][4], Pq[2], Hq[2];
#pragma unroll
        for (int db = 0; db < 2; ++db) {
            float P = 1.f, H = 0.f;
#pragma unroll
            for (int reg = 0; reg < 4; ++reg) {
                const float xc = *(const LAS float*)(L + LR_XCF + (16 * ts + 4 * fq + reg) * 256 + (32 * dh + 16 * db + fr) * 4);
                const float rg = fast_sigmoid(ga[db][reg] + ba[db]), ig = fast_sigmoid(gx[db][reg] + bx[db]);
                const float a = __builtin_amdgcn_exp2f(-rg * spl[db]);
                const float b = sqrtf(fmaxf(1.f - a * a, 0.f)) * (ig * xc);
                H = a * H + b; P = a * P; Pk[db][reg] = P; Hk[db][reg] = H;
            }
            float Pi = P, Hi = H;
            { const float Pp = bperm(Pi, lane - 16), Hp = bperm(Hi, lane - 16); if (fq >= 1) { Hi = Pi * Hp + Hi; Pi = Pi * Pp; } }
            { const float Pp = bperm(Pi, lane - 32), Hp = bperm(Hi, lane - 32); if (fq >= 2) { Hi = Pi * Hp + Hi; Pi = Pi * Pp; } }
            if (fq == 3) { f32x2_t v2 = {Pi, Hi}; *(LAS f32x2_t*)(L + LR_SEG + (ts * 64 + 32 * dh + 16 * db + fr) * 8) = v2; }
            const float Pe = bperm(Pi, lane - 16), He = bperm(Hi, lane - 16);
            Pq[db] = (fq >= 1) ? Pe : 1.f; Hq[db] = (fq >= 1) ? He : 0.f;
        }
        LDS_FENCE(); __syncthreads();
#pragma unroll
        for (int db = 0; db < 2; ++db) {
            float s = hc[db], sin = hc[db];
#pragma unroll
            for (int k = 0; k < 4; ++k) { const f32x2_t m = *(const LAS f32x2_t*)(L + LR_SEG + (k * 64 + 32 * dh + 16 * db + fr) * 8); if (k == ts) sin = s; s = m[0] * s + m[1]; }
            hc[db] = s;
            const float hin = Pq[db] * sin + Hq[db];
            const bf16_t* glp = nullptr; (void)glp;
#pragma unroll
            for (int reg = 0; reg < 4; ++reg) {
                const float hval = Pk[db][reg] * hin + Hk[db][reg];
                const int t = 16 * ts + 4 * fq + reg, d = 32 * dh + 16 * db + fr;
                const float glv = bf2f(*(const LAS bf16_t*)(L + LR_GL + (c & 1) * 8192 + t * 128 + d * 2));
                *(LAS bf16_t*)(L + LR_YS + t * 128 + d * 2) = f2bf(hval * fast_silu(glv));
            }
        }
        asm volatile("s_waitcnt vmcnt(0)" ::: "memory");
        LDS_FENCE(); __syncthreads();
        { const int rr = tid >> 3, pc = tid & 7;
          *(u32x4*)(PJ + (size_t)(row0 + t0 + rr) * PJW + C_GL + blk * 64 + 8 * pc) = *(const LAS u32x4*)(L + LR_YS + rr * 128 + pc * 16); }
    }
    if (ts == 0 && fq == 0) {
#pragma unroll
        for (int db = 0; db < 2; ++db) out_lh(C, l, sb)[blk * 64 + 32 * dh + 16 * db + fr] = hc[db];
    }
#undef LRU_DMA
    asm volatile("s_waitcnt vmcnt(0)" ::: "memory");
    __syncthreads();
}

DI Ctx relaunder(const Ctx& C0) {
    Ctx C = C0; int ln; asm volatile("v_mbcnt_lo_u32_b32 %0, -1, 0\n\tv_mbcnt_hi_u32_b32 %0, -1, %0" : "=v"(ln)); C.lane = ln; C.tid = C.wave * 64 + ln;
    { unsigned long long w = (unsigned long long)C.ws, o = (unsigned long long)C.out; asm volatile("" : "+s"(w), "+s"(o));
      C.ws = (unsigned char*)(__attribute__((address_space(1))) unsigned char*)w; C.out = (float*)(__attribute__((address_space(1))) float*)o; }
    asm volatile("" : "+s"(C.G), "+s"(C.bid));
    return C;
}
constexpr int CW_QUEUE = 8192;
constexpr int MX_A = 144, MX_B = MX_A + 256, MX_C0 = MX_B + 8, MX_C = MX_C0 + 240, MX_D = MX_C + 128, MX_E = MX_D + 128, MX_F = MX_E + 128, MX_N = MX_F + 64;
DI void phase_mixers(const Ctx& Cin, int l) {
    unsigned* head = (unsigned*)(Cin.ws + WS_CTL) + CW_QUEUE + 64 * l;
    volatile LAS int* slot = (volatile LAS int*)(Cin.lds + LDS_BYTES - 24);
    for (;;) {
        __syncthreads();
        if (Cin.tid == 0) *slot = (int)__hip_atomic_fetch_add(head, 1u, __ATOMIC_RELAXED, __HIP_MEMORY_SCOPE_AGENT);
        __syncthreads();
        const int i = __builtin_amdgcn_readfirstlane(*slot);
        if (i >= MX_N) break;
        const Ctx C = relaunder(Cin);
        int kind, sb, sub;
        if (i < MX_A) { kind = 0; sb = i & 15; sub = 31 - (i >> 4); }
        else if (i < MX_B) { const int j = i - MX_A; kind = 1; sb = j >> 4; sub = j & 15; }
        else if (i < MX_C0) { kind = 0; sb = NPB + (i - MX_B); sub = 0; }
        else if (i < MX_C) { const int j = i - MX_C0; kind = 0; sb = j & 15; sub = 22 - (j >> 4); }
        else if (i < MX_D) { const int j = i - MX_C; kind = 2; sb = j >> 3; sub = j & 7; }
        else if (i < MX_E) { const int j = i - MX_D; kind = 0; sb = j & 15; sub = 7 - (j >> 4); }
        else if (i < MX_F) { const int j = i - MX_E; kind = 1; sb = NPB + (j >> 4); sub = j & 15; }
        else { const int j = i - MX_F; kind = 2; sb = NPB + (j >> 3); sub = j & 7; }
        if (kind == 0) attn_item(C, l, sb, sub);
        else if (kind == 1) ssd_item(C, l, sb, sub);
        else lru_item(C, l, sb, sub);
    }
}

#define XB_TMO      128
#define XB_XCNT(j)  (256  + 64 * (j))
#define XB_XSUB(j)  (1280 + 64 * (j))
#define XB_XGEN(j)  (2304 + 64 * (j))
#define XB_TOP      3328
#define XB_TOPGEN   3392
#define XCD_BAR_WORDS 3456
#define XB_SPIN_CAP (1u << 22)

__device__ __forceinline__ unsigned xb_ld(unsigned* p)              { return __hip_atomic_load(p, __ATOMIC_RELAXED, __HIP_MEMORY_SCOPE_AGENT); }
__device__ __forceinline__ unsigned xb_add(unsigned* p, unsigned v) { return __hip_atomic_fetch_add(p, v, __ATOMIC_RELAXED, __HIP_MEMORY_SCOPE_AGENT); }
__device__ __forceinline__ unsigned xb_xcc_id() { return (unsigned)__builtin_amdgcn_s_getreg((3 << 11) | 20) & 0xFu; }
#define XB_SPIN(cond, bar) do { unsigned _sp = 0; while (cond) { __builtin_amdgcn_s_sleep(1); \
    if ((++_sp & 255u) == 0u) { if (xb_ld(&(bar)[XB_TMO])) break; if (_sp > XB_SPIN_CAP) { atomicAdd(&(bar)[XB_TMO], 1u); break; } } } } while (0)

struct XcdBarrier {
    unsigned* bar; unsigned x;
    volatile LAS unsigned* st;
};

__device__ __forceinline__ XcdBarrier xcd_barrier_post(unsigned* bar, volatile LAS unsigned* st) {
    XcdBarrier b; b.bar = bar; b.x = xb_xcc_id(); b.st = st;
    if (threadIdx.x == 0) (void)xb_add(&bar[XB_XCNT(b.x)], 1u);
    return b;
}
__device__ __forceinline__ void xcd_barrier_complete(unsigned* bar, unsigned x, unsigned& nloc, unsigned& nx) {
    const unsigned G = gridDim.x * gridDim.y * gridDim.z;
    unsigned sum, cnt, mine, sp = 0u;
    for (;;) {
        sum = 0u; cnt = 0u; mine = 0u;
#pragma unroll
        for (unsigned j = 0; j < 16; ++j) { const unsigned c = xb_ld(&bar[XB_XCNT(j)]); sum += c; cnt += (c > 0u) ? 1u : 0u; mine = (j == x) ? c : mine; }
        if (sum == G) break;
        __builtin_amdgcn_s_sleep(1);
        if ((++sp & 255u) == 0u) { if (xb_ld(&bar[XB_TMO])) break; if (sp > XB_SPIN_CAP) { atomicAdd(&bar[XB_TMO], 1u); break; } }
    }
    nloc = mine > 0u ? mine : 1u; nx = cnt > 0u ? cnt : 1u;
}

__device__ __forceinline__ void xcd_barrier(const XcdBarrier& b) {
    asm volatile("s_waitcnt vmcnt(0)" ::: "memory");
    __syncthreads();
    if (threadIdx.x == 0) {
        unsigned* bar = b.bar;
        __builtin_amdgcn_s_waitcnt(0);
        unsigned nloc = b.st[0], nx = b.st[1];
        if (nloc == 0u) { xcd_barrier_complete(bar, b.x, nloc, nx); b.st[0] = nloc; b.st[1] = nx; }
        const unsigned old = xb_add(&bar[XB_XSUB(b.x)], 1u);
        const unsigned gen = old / nloc;
        if (old + 1u == (gen + 1u) * nloc) {
            __builtin_amdgcn_fence(__ATOMIC_RELEASE, "agent");
            asm volatile("s_waitcnt vmcnt(0)" ::: "memory");
            const unsigned og = xb_add(&bar[XB_TOP], 1u);
            const unsigned tg = og / nx;
            if (og + 1u == (tg + 1u) * nx) xb_add(&bar[XB_TOPGEN], 1u);
            else XB_SPIN(xb_ld(&bar[XB_TOPGEN]) == tg, bar);
            __builtin_amdgcn_fence(__ATOMIC_ACQUIRE, "agent");
            xb_add(&bar[XB_XGEN(b.x)], 1u);
            asm volatile("s_waitcnt vmcnt(0)" ::: "memory");
        } else {
            XB_SPIN(xb_ld(&bar[XB_XGEN(b.x)]) == gen, bar);
            __builtin_amdgcn_fence(__ATOMIC_ACQUIRE, "agent");
            asm volatile("s_waitcnt vmcnt(0)" ::: "memory");
        }
    }
    __syncthreads();
}


constexpr int PH_PER_LAYER = 4;
constexpr int N_PHASES = 1 + 2 * PH_PER_LAYER;
constexpr int CW_BAR = 4096;
__global__ void __launch_bounds__(NTHREADS, 2) mk_fwd(Args a) {
    extern __shared__ __attribute__((aligned(16))) unsigned char lds_raw[];
    Ctx C; C.out = a.out; C.ws = a.ws; C.lds = (LAS unsigned char*)lds_raw;
    C.tid = threadIdx.x; C.lane = C.tid & 63; C.wave = __builtin_amdgcn_readfirstlane(C.tid >> 6); C.G = gridDim.x; C.bid = blockIdx.x;
    if (C.tid == 0) {
#pragma unroll
        for (int i = 0; i < 28; ++i) ((LAS cfp_t*)(C.lds + LDS_BYTES - 256))[i] = a.in[i];
        ((volatile LAS unsigned*)(C.lds + LDS_BYTES - 32))[0] = 0u; ((volatile LAS unsigned*)(C.lds + LDS_BYTES - 32))[1] = 0u;
        *(LAS unsigned long long*)(C.lds + LDS_BYTES - 16) = 0ull;
    }
    __syncthreads();
    const XcdBarrier bar = xcd_barrier_post((unsigned*)(a.ws + WS_CTL) + CW_BAR, (volatile LAS unsigned*)(C.lds + LDS_BYTES - 32));
    const Ctx C0 = C;
#define LAUNDER() const Ctx C = relaunder(C0)
#ifdef PROBE_PHASE
    unsigned long long pr_t0 = 0, pr_t1 = 0;
#endif
    for (int ph = a.ph_lo; ph < a.ph_hi; ++ph) {
#ifdef PROBE_PHASE
        if (ph == PROBE_PHASE) pr_t0 = __builtin_amdgcn_s_memrealtime();
#endif
        if (ph == 0) { LAUNDER(); phase_prologue(C); }
        else {
            const int l = (ph - 1) / PH_PER_LAYER, k = (ph - 1) % PH_PER_LAYER;
            if (k == 0) { LAUNDER(); phase_inproj_gemm(C, l); }
            else if (k == 1) { LAUNDER(); phase_mixers(C, l); }
            else if (k == 2) { LAUNDER(); phase_ycnorm(C, l); if (l == 0) prep_layer(C, 1); }
            else { LAUNDER(); phase_outproj_gemm(C, l); }
        }
        if (ph + 1 < a.ph_hi) { if (ph == 0) cg::this_grid().sync(); else xcd_barrier(bar); }
#ifdef PROBE_PHASE
        if (ph == PROBE_PHASE) pr_t1 = __builtin_amdgcn_s_memrealtime();
#endif
    }
#ifdef PROBE_PHASE
#ifdef PROBE_SUB
    pr_t0 = 0; pr_t1 = *(LAS unsigned long long*)(C0.lds + LDS_BYTES - 16);
#endif
#ifndef PROBE_BLOCK
#define PROBE_BLOCK 0
#endif
    if (PROBE_BLOCK < 0 || (int)blockIdx.x == PROBE_BLOCK) { const unsigned long long te = __builtin_amdgcn_s_memrealtime(), span = 4ull * (pr_t1 - pr_t0); while (__builtin_amdgcn_s_memrealtime() - te < span) __builtin_amdgcn_s_sleep(8); }
#endif
}

extern "C" void kernel_launch(void* const* d_in, const int* in_sizes, int n_in, void* d_out, int out_size, void* d_ws, size_t ws_size, hipStream_t stream) {
    static int grid = 0;
    if (grid == 0) {
        if (n_in != 28 || (size_t)out_size != O_END || ws_size < WS_END) { fprintf(stderr, "kernel_launch: unexpected shapes n_in %d out %d ws %zu\n", n_in, out_size, ws_size); grid = -1; return; }
        int dev = 0, cus = 0, per_cu = 0;
        hipGetDevice(&dev); hipDeviceGetAttribute(&cus, hipDeviceAttributeMultiprocessorCount, dev);
        hipFuncSetAttribute((const void*)mk_fwd, hipFuncAttributeMaxDynamicSharedMemorySize, LDS_BYTES);
        hipOccupancyMaxActiveBlocksPerMultiprocessor(&per_cu, (const void*)mk_fwd, NTHREADS, LDS_BYTES);
        if (per_cu < 1) per_cu = 1;
        grid = cus * 1;
        (void)hipGetLastError();
    }
    if (grid < 0) return;
    hipMemsetAsync((char*)d_ws + WS_CTL, 0, CTL_BYTES, stream);
    Args a{};
    for (int i = 0; i < 28; ++i) a.in[i] = (const float*)d_in[i];
    a.out = (float*)d_out; a.ws = (unsigned char*)d_ws;
    a.ph_lo = 0; a.ph_hi = N_PHASES;
    void* args[] = {&a};
    hipError_t e = hipLaunchCooperativeKernel((const void*)mk_fwd, dim3(grid), dim3(NTHREADS), args, LDS_BYTES, stream);
    if (e != hipSuccess) fprintf(stderr, "cooperative launch failed: %s (grid %d)\n", hipGetErrorString(e), grid);
}
```

```cpp
#include <hip/hip_runtime.h>
#include <hip/hip_cooperative_groups.h>
#include <cstdio>
#include <cstdint>
namespace cg = cooperative_groups;

#ifndef ONLY
#define ONLY 0xffff
#endif
#ifndef USE_LRU_OPT
#define USE_LRU_OPT 1
#endif
#ifndef USE_ATTN_OPT
#define USE_ATTN_OPT 1
#endif
#ifndef USE_SSD_OPT
#define USE_SSD_OPT 1
#endif
#ifndef USE_GEMM_IN
#define USE_GEMM_IN 1
#endif
#ifndef USE_GEMM_OUT
#define USE_GEMM_OUT 1
#endif
#ifndef MK_ONE_LAUNCH
#define MK_ONE_LAUNCH 1
#endif

typedef unsigned short bf16_t;
typedef short bf16x8 __attribute__((ext_vector_type(8)));
typedef float f32x4 __attribute__((ext_vector_type(4)));
typedef float f32x16 __attribute__((ext_vector_type(16)));
typedef unsigned u32x4 __attribute__((ext_vector_type(4)));
typedef unsigned u32x2 __attribute__((ext_vector_type(2)));
#define LAS __attribute__((address_space(3)))
#define DI __device__ __forceinline__

constexpr int DM = 1024, NPB = 16, SEQ = 2048, NSB_S = 8, DSEQ = 64, PAST = 1024;
constexpr int ROWS_P = NPB * SEQ;
constexpr int ROWS = ROWS_P + NSB_S * DSEQ;
constexpr int NSB = NPB + NSB_S;
constexpr int DINP = 5204, NPAD = 5376;
constexpr int PJW = 4864;
constexpr int DMIX = 2048;
constexpr float EPS = 1e-6f;
constexpr int C_GL = 0, C_GA = 512, C_Z = 1024, C_XL = 2048, C_Q = 2560, C_QI = 3072, C_XBC = 3328, C_T19 = 4864, C_T20 = 5120;
constexpr int KVW = 320;
constexpr size_t KVB_LAYER = (size_t)NPB * SEQ * KVW + (size_t)NSB_S * (PAST + DSEQ) * KVW;

constexpr size_t O_YP = 0;
constexpr size_t O_YS = O_YP + (size_t)NPB * SEQ * DM;
constexpr size_t O_AKP = O_YS + (size_t)NSB_S * DSEQ * DM;
constexpr size_t O_AVP = O_AKP + (size_t)2 * NPB * SEQ * 128;
constexpr size_t O_IKP = O_AVP + (size_t)2 * NPB * SEQ * 128;
constexpr size_t O_LCP = O_IKP + (size_t)2 * NPB * SEQ * 64;
constexpr size_t O_LHP = O_LCP + (size_t)2 * NPB * 3 * 512;
constexpr size_t O_SCP = O_LHP + (size_t)2 * NPB * 512;
constexpr size_t O_SHP = O_SCP + (size_t)2 * NPB * 3 * 1536;
constexpr size_t O_AKS = O_SHP + (size_t)2 * NPB * 16 * 64 * 128;
constexpr size_t O_AVS = O_AKS + (size_t)2 * NSB_S * DSEQ * 128;
constexpr size_t O_IKS = O_AVS + (size_t)2 * NSB_S * DSEQ * 128;
constexpr size_t O_LCS = O_IKS + (size_t)2 * NSB_S * DSEQ * 64;
constexpr size_t O_LHS = O_LCS + (size_t)2 * NSB_S * 3 * 512;
constexpr size_t O_SCS = O_LHS + (size_t)2 * NSB_S * 512;
constexpr size_t O_SHS = O_SCS + (size_t)2 * NSB_S * 3 * 1536;
constexpr size_t O_END = O_SHS + (size_t)2 * NSB_S * 16 * 64 * 128;

constexpr size_t MiB = 1u << 20;
constexpr size_t WS_CTL = 0, CTL_BYTES = 1 * MiB;
constexpr size_t WS_WIN = 1 * MiB;
constexpr size_t WIN_LAYER = (size_t)NPAD * DM;
constexpr size_t WS_WOUT = 22 * MiB;
constexpr size_t WOUT_LAYER = (size_t)DM * DMIX;
constexpr size_t WS_HB = 30 * MiB;
constexpr size_t WS_RSS = 95 * MiB;
constexpr size_t WS_WI = 98 * MiB;
constexpr size_t WS_DTR = 99 * MiB;
constexpr size_t WS_SSQ = 102 * MiB;
constexpr size_t WS_KVB = 112 * MiB;
constexpr size_t WS_PROJ = 138 * MiB;
constexpr size_t WS_KEYS_B = 447 * MiB;
constexpr size_t KEYS_PER_WG = 512 * 1024;
constexpr size_t WS_END = WS_KEYS_B + 128 * KEYS_PER_WG;
static_assert(WS_KVB + KVB_LAYER * 2 <= WS_PROJ && WS_PROJ + (size_t)ROWS * PJW * 2 <= WS_KEYS_B && 128 * KEYS_PER_WG <= 65 * MiB, "ws map");
static_assert(WS_END <= 512 * MiB, "ws map");

constexpr int NTHREADS = 512, NWAVES = 8;
constexpr int LDS_BYTES = 163840;

DI float bf2f(bf16_t v) { return __uint_as_float(((unsigned)v) << 16); }
DI bf16_t f2bf(float f) { unsigned u = __float_as_uint(f); return (bf16_t)((u + 0x7fffu + ((u >> 16) & 1u)) >> 16); }
DI unsigned pk2(float lo, float hi) { return (unsigned)f2bf(lo) | ((unsigned)f2bf(hi) << 16); }
DI int crow(int reg, int h) { return (reg & 3) + 8 * (reg >> 2) + 4 * h; }
template <int O> DI float swz_xor(float v) { return __int_as_float(__builtin_amdgcn_ds_swizzle(__float_as_int(v), (O << 10) | 0x1f)); }
DI float xor32_sum(float v) { auto rr = __builtin_amdgcn_permlane32_swap(__float_as_uint(v), __float_as_uint(v), false, false); return __uint_as_float(rr[0]) + __uint_as_float(rr[1]); }
DI float xor32_max(float v) { auto rr = __builtin_amdgcn_permlane32_swap(__float_as_uint(v), __float_as_uint(v), false, false); return fmaxf(__uint_as_float(rr[0]), __uint_as_float(rr[1])); }
DI float half_sum32(float v) {
    v += swz_xor<1>(v); v += swz_xor<2>(v); v += swz_xor<4>(v); v += swz_xor<8>(v); v += swz_xor<16>(v); return v;
}
DI float wave_sum(float v) { return xor32_sum(half_sum32(v)); }
DI float wave_max(float v) {
    v = fmaxf(v, swz_xor<1>(v)); v = fmaxf(v, swz_xor<2>(v)); v = fmaxf(v, swz_xor<4>(v)); v = fmaxf(v, swz_xor<8>(v)); v = fmaxf(v, swz_xor<16>(v)); return xor32_max(v);
}
DI float sum_fq(float v) { return xor32_sum(v + swz_xor<16>(v)); }
DI float bperm(float v, int srclane) { return __int_as_float(__builtin_amdgcn_ds_bpermute(srclane << 2, __float_as_int(v))); }
DI float silu_f(float x) { return x / (1.f + expf(-x)); }
DI float sigmoid_f(float x) { return 1.f / (1.f + expf(-x)); }
DI float softplus_f(float x) { return x > 20.f ? x : log1pf(expf(x)); }
#define LDS_FENCE() asm volatile("s_waitcnt lgkmcnt(0)" ::: "memory")

__host__ __device__ inline int orig_col(int c) {
    if (c < 512) return 512 + c;
    if (c < 1024) return 1792 + (c - 512);
    if (c < 2048) return 2628 + (c - 1024);
    if (c < 2560) return c - 2048;
    if (c < 3072) return 1024 + (c - 2560);
    if (c < 3328) return 2304 + (c - 3072);
    if (c < 4864) return 3652 + (c - 3328);
    if (c < 5120) { const int cl = c - 4864, bj = cl >> 7, wc = (cl >> 5) & 3, j = cl & 31, d = 32 * bj + j; return (wc < 2 ? 1536 : 1664) + (wc & 1) * 64 + d; }
    const int cl = c - 5120;
    if (cl < 64) return 2560 + cl;
    if (cl < 68) return 2624 + (cl - 64);
    if (cl < 84) return 5188 + (cl - 68);
    return -1;
}
DI int sb_T(int sb) { return sb < NPB ? SEQ : DSEQ; }
DI int sb_P(int sb) { return sb < NPB ? 0 : PAST; }
DI int sb_row0(int sb) { return sb < NPB ? sb * SEQ : ROWS_P + (sb - NPB) * DSEQ; }
DI size_t kvb_off(int sb) { return sb < NPB ? (size_t)sb * SEQ * KVW : (size_t)NPB * SEQ * KVW + (size_t)(sb - NPB) * (PAST + DSEQ) * KVW; }
DI void row_sbt(int m, int& sb, int& t) { if (m < ROWS_P) { sb = m >> 11; t = m & 2047; } else { const int r = m - ROWS_P; sb = NPB + (r >> 6); t = r & 63; } }

typedef const float* cfp_t;
struct Args { const float* in[28]; float* out; unsigned char* ws; int ph_lo, ph_hi; };

struct Ctx {
    float* out; unsigned char* ws;
    LAS unsigned char* lds;
    DI const float* inp(int k) const { return (const float*)(const __attribute__((address_space(1))) float*)(((LAS unsigned long long*)(lds + LDS_BYTES - 256))[k]); }
    int tid, lane, wave, G, bid;
    DI bf16_t* win(int l) const { return (bf16_t*)(ws + WS_WIN) + (size_t)l * WIN_LAYER; }
    DI bf16_t* wout(int l) const { return (bf16_t*)(ws + WS_WOUT) + (size_t)l * WOUT_LAYER; }
    DI bf16_t* hb() const { return (bf16_t*)(ws + WS_HB); }
    DI float* rss() const { return (float*)(ws + WS_RSS); }
    DI float* wi() const { return (float*)(ws + WS_WI); }
    DI float* dtr() const { return (float*)(ws + WS_DTR); }
    DI float* ssq() const { return (float*)(ws + WS_SSQ); }
    DI bf16_t* kvb(int) const { return (bf16_t*)(ws + WS_KVB); }
    DI unsigned* keys() const { return (unsigned*)(bid < 128 ? ws + WS_HB + (size_t)bid * KEYS_PER_WG : ws + WS_KEYS_B + (size_t)(bid - 128) * KEYS_PER_WG); }
    DI bf16_t* proj() const { return (bf16_t*)(ws + WS_PROJ); }
};
DI float* out_ak(const Ctx& C, int l, int sb) { return sb < NPB ? C.out + O_AKP + ((size_t)(l * NPB + sb) * SEQ) * 128 : C.out + O_AKS + ((size_t)(l * NSB_S + sb - NPB) * DSEQ) * 128; }
DI float* out_av(const Ctx& C, int l, int sb) { return sb < NPB ? C.out + O_AVP + ((size_t)(l * NPB + sb) * SEQ) * 128 : C.out + O_AVS + ((size_t)(l * NSB_S + sb - NPB) * DSEQ) * 128; }
DI float* out_ik(const Ctx& C, int l, int sb) { return sb < NPB ? C.out + O_IKP + ((size_t)(l * NPB + sb) * SEQ) * 64 : C.out + O_IKS + ((size_t)(l * NSB_S + sb - NPB) * DSEQ) * 64; }
DI float* out_lc(const Ctx& C, int l, int sb) { return sb < NPB ? C.out + O_LCP + (size_t)(l * NPB + sb) * 3 * 512 : C.out + O_LCS + (size_t)(l * NSB_S + sb - NPB) * 3 * 512; }
DI float* out_lh(const Ctx& C, int l, int sb) { return sb < NPB ? C.out + O_LHP + (size_t)(l * NPB + sb) * 512 : C.out + O_LHS + (size_t)(l * NSB_S + sb - NPB) * 512; }
DI float* out_sc(const Ctx& C, int l, int sb) { return sb < NPB ? C.out + O_SCP + (size_t)(l * NPB + sb) * 3 * 1536 : C.out + O_SCS + (size_t)(l * NSB_S + sb - NPB) * 3 * 1536; }
DI float* out_sh(const Ctx& C, int l, int sb) { return sb < NPB ? C.out + O_SHP + (size_t)(l * NPB + sb) * 16 * 64 * 128 : C.out + O_SHS + (size_t)(l * NSB_S + sb - NPB) * 16 * 64 * 128; }

#ifdef PROBE_SUB
#define PROBE_BEGIN(id) unsigned long long pb_##id = __builtin_amdgcn_s_memrealtime()
#define PROBE_END(id, Cx) do { if ((id) == PROBE_SUB && (Cx).tid == 0) *(LAS unsigned long long*)((Cx).lds + LDS_BYTES - 16) += __builtin_amdgcn_s_memrealtime() - pb_##id; } while (0)
#else
#define PROBE_BEGIN(id) do {} while (0)
#define PROBE_END(id, Cx) do {} while (0)
#endif
namespace pg8 {
#define PG8_LAS __attribute__((address_space(3)))
constexpr int BM = 256, BK = 64, HALF = 128, HTB = HALF * BK * 2  , STAGE_BYTES = 8 * HTB, NXCD = 8, WGM = 8;

__host__ __device__ __forceinline__ int lds_byte(int r, int c) { const int st = (r >> 4) * 2 + (c >> 5), rr = r & 15, cc = c & 31, ob = rr * 64 + cc * 2; return st * 1024 + (ob ^ (((ob >> 9) & 1) << 5)); }
__host__ __device__ __forceinline__ void stage_rc(int b, int& R, int& C) { const int st = b / 1024, sb = b % 1024, swz = sb ^ (((sb >> 9) & 1) << 5); R = (st >> 1) * 16 + swz / 64; C = (st & 1) * 32 + (swz % 64) / 2; }
__host__ __device__ __forceinline__ int perm32(int rho) { const int n = rho >> 4, i = rho & 15; return 8 * (i >> 2) + 4 * n + (i & 3); }

struct Unit { int pm, pn; };
struct Gemm { const bf16_t* A; const bf16_t* Bt; int M, N, K, lda; };

struct StaticOrder {
    int nM, nN, nwg, G, c;
    __host__ __device__ void init(int M, int N, int G_, int c_) { nM = M / BM; nN = N / BM; nwg = nM * nN; G = G_; c = c_; }
    __host__ __device__ bool next(int i, Unit& u) const {
        const long L = (long)i * G + c; if (L >= nwg) return false;
        int wgid = (int)L; { const int q = nwg / NXCD, r = nwg % NXCD, xcd = wgid % NXCD, off = wgid / NXCD; wgid = (xcd < r ? xcd * (q + 1) : r * (q + 1) + (xcd - r) * q) + off; }
        const int nig = WGM * nN, gid = wgid / nig, fm = gid * WGM, gsz = (nM - fm) < WGM ? (nM - fm) : WGM;
        u.pm = fm + ((wgid % nig) % gsz); u.pn = (wgid % nig) / gsz; return true;
    }
    __device__ __forceinline__ void a_ready(const Unit&) const {}
    __device__ __forceinline__ void done(const Unit&) const {}
};

template <class Epi, class Sched, bool ALIGN_EPI = false, bool SP2 = false>
__device__ __forceinline__ void gemm_phase(PG8_LAS unsigned char* lds, const Gemm g, const Sched& S, const Epi& E, const int tid) {
    const int wid = __builtin_amdgcn_readfirstlane(tid >> 6), lane = tid & 63, wr = wid >> 2, wc = wid & 3, fr = lane & 15, fq = lane >> 4;
    const int K = g.K, nt = K / BK;
    unsigned voffA[2], voffB[2];
#pragma unroll
    for (int i = 0; i < 2; ++i) { int R, C; stage_rc(tid * 16 + i * 8192, R, C); const int Rb = Epi::PERM ? ((R & ~31) + perm32(R & 31)) : R;
        voffA[i] = (unsigned)(R * g.lda + C) * 2u; voffB[i] = (unsigned)(Rb * K + C) * 2u; }
    const size_t kstep = (size_t)(BK * 2);
    const size_t hstepA = (size_t)HALF * g.lda * 2, hstepB = (size_t)HALF * K * 2;
    const size_t tstepA = 2 * hstepA, tstepB = 2 * hstepB;
    const unsigned ldsw = (unsigned)wid * 1024u;
    const int aoff = lds_byte(wr * 64 + fr, fq * 8), boff = lds_byte(wc * 32 + fr, fq * 8);
#define PG8_SA(b, h) (((b) * 2 + (h)) * HTB)
#define PG8_SB(b, h) ((4 + (b) * 2 + (h)) * HTB)
#define PG8_STAGE(bufoff, gbase, voff) do { _Pragma("unroll") for (int _i = 0; _i < 2; ++_i) \
        __builtin_amdgcn_global_load_lds((const unsigned*)((const char*)(gbase) + (voff)[_i]), (PG8_LAS unsigned*)(lds + (bufoff) + ldsw + _i * 8192), 16, 0, 0); } while (0)
#define PG8_LDA(dst, b, h) do { _Pragma("unroll") for (int m = 0; m < 4; ++m) _Pragma("unroll") for (int k = 0; k < 2; ++k) dst[m][k] = *(const PG8_LAS bf16x8*)(lds + PG8_SA(b, h) + aoff + m * 2048 + k * 1024); } while (0)
#define PG8_LDB(dst, b, h) do { _Pragma("unroll") for (int n = 0; n < 2; ++n) _Pragma("unroll") for (int k = 0; k < 2; ++k) dst[n][k] = *(const PG8_LAS bf16x8*)(lds + PG8_SB(b, h) + boff + n * 2048 + k * 1024); } while (0)
#define PG8_MMA(ai, bj, At, Bt) do { __builtin_amdgcn_s_setprio(1); _Pragma("unroll") for (int m = 0; m < 4; ++m) _Pragma("unroll") for (int n = 0; n < 2; ++n) _Pragma("unroll") for (int k = 0; k < 2; ++k) \
        acc[ai][bj][m][n] = __builtin_amdgcn_mfma_f32_16x16x32_bf16(Bt[n][k], At[m][k], acc[ai][bj][m][n], 0, 0, 0); __builtin_amdgcn_s_setprio(0); } while (0)
#define PG8_WAIT_V(n) asm volatile("s_waitcnt vmcnt(" #n ")" ::: "memory")
#define PG8_WAIT_L(n) asm volatile("s_waitcnt lgkmcnt(" #n ")" ::: "memory")
#define PG8_BAR __builtin_amdgcn_s_barrier()
#define PG8_SCHED __builtin_amdgcn_sched_barrier(0)
    Unit cur, nxt; int ui = 0;
    if (!S.next(0, cur)) return;
    f32x4 acc[2][2][4][2];
#pragma unroll
    for (int a = 0; a < 2; ++a)
#pragma unroll
        for (int b = 0; b < 2; ++b)
#pragma unroll
            for (int m = 0; m < 4; ++m)
#pragma unroll
                for (int n = 0; n < 2; ++n) acc[a][b][m][n] = (f32x4){0.f, 0.f, 0.f, 0.f};
    bf16x8 At[4][2], B0[2][2], B1[2][2];
    const char* cA = (const char*)g.A + (size_t)cur.pm * tstepA; const char* cB = (const char*)g.Bt + (size_t)cur.pn * tstepB;
    S.a_ready(cur);
    if constexpr (SP2) {
        PG8_STAGE(PG8_SB(0, 0), cB, voffB); PG8_STAGE(PG8_SB(0, 1), cB + hstepB, voffB); PG8_STAGE(PG8_SA(0, 0), cA, voffA); PG8_STAGE(PG8_SA(0, 1), cA + hstepA, voffA);
        if (wr == 1) PG8_BAR;
        PG8_WAIT_V(2); PG8_BAR;
        PG8_STAGE(PG8_SB(1, 0), cB + kstep, voffB); PG8_STAGE(PG8_SA(1, 0), cA + kstep, voffA); PG8_STAGE(PG8_SB(1, 1), cB + hstepB + kstep, voffB);
        PG8_WAIT_V(6); PG8_BAR;
    } else {
        PG8_STAGE(PG8_SB(0, 0), cB, voffB); PG8_STAGE(PG8_SA(0, 0), cA, voffA); PG8_STAGE(PG8_SB(0, 1), cB + hstepB, voffB); PG8_STAGE(PG8_SA(0, 1), cA + hstepA, voffA);
        if (wr == 1) PG8_BAR;
        PG8_WAIT_V(4); PG8_BAR;
        PG8_STAGE(PG8_SB(1, 0), cB + kstep, voffB); PG8_STAGE(PG8_SA(1, 0), cA + kstep, voffA); PG8_STAGE(PG8_SB(1, 1), cB + hstepB + kstep, voffB);
        PG8_WAIT_V(6); PG8_BAR;
    }
    for (;;) {
        const bool has_next = S.next(ui + 1, nxt);
        const char* nA = has_next ? (const char*)g.A + (size_t)nxt.pm * tstepA : cA; const char* nB = has_next ? (const char*)g.Bt + (size_t)nxt.pn * tstepB : cB;
        for (int t = 0; t < nt; t += 2) {
            const bool last = (t == nt - 2);
            const char* a1 = cA + (size_t)(t + 1) * kstep;
            const char* a2 = last ? nA : cA + (size_t)(t + 2) * kstep; const char* b2 = last ? nB : cB + (size_t)(t + 2) * kstep;
            const char* a3 = a2 + kstep; const char* b3 = b2 + kstep;
            if (last && has_next) S.a_ready(nxt);
            if constexpr (SP2) {
            PG8_LDB(B0, 0, 0); PG8_LDB(B1, 0, 1); PG8_SCHED; PG8_LDA(At, 0, 0); PG8_STAGE(PG8_SA(1, 1), a1 + hstepA, voffA);
            PG8_WAIT_V(8); PG8_WAIT_L(0); PG8_BAR; PG8_MMA(0, 0, At, B0); PG8_MMA(0, 1, At, B1); PG8_BAR; PG8_SCHED;
            PG8_LDA(At, 0, 1); PG8_STAGE(PG8_SB(0, 0), b2, voffB); PG8_STAGE(PG8_SB(0, 1), b2 + hstepB, voffB); PG8_STAGE(PG8_SA(0, 0), a2, voffA);
            PG8_WAIT_V(8); PG8_WAIT_L(0); PG8_BAR; PG8_MMA(1, 0, At, B0); PG8_MMA(1, 1, At, B1); PG8_BAR; PG8_SCHED;
            PG8_LDB(B0, 1, 0); PG8_LDB(B1, 1, 1); PG8_SCHED; PG8_LDA(At, 1, 0); PG8_STAGE(PG8_SA(0, 1), a2 + hstepA, voffA);
            PG8_WAIT_V(8); PG8_WAIT_L(0); PG8_BAR; PG8_MMA(0, 0, At, B0); PG8_MMA(0, 1, At, B1); PG8_BAR; PG8_SCHED;
            PG8_LDA(At, 1, 1); PG8_STAGE(PG8_SB(1, 0), b3, voffB); PG8_STAGE(PG8_SB(1, 1), b3 + hstepB, voffB); PG8_STAGE(PG8_SA(1, 0), a3, voffA);
            PG8_WAIT_V(8); PG8_WAIT_L(0); PG8_BAR; PG8_MMA(1, 0, At, B0); PG8_MMA(1, 1, At, B1); PG8_BAR; PG8_SCHED;
            } else {
            PG8_LDB(B0, 0, 0); PG8_SCHED; PG8_LDA(At, 0, 0); PG8_STAGE(PG8_SA(1, 1), a1 + hstepA, voffA);
            PG8_WAIT_L(8); PG8_BAR; PG8_WAIT_L(0); PG8_MMA(0, 0, At, B0); PG8_BAR; PG8_SCHED;
            PG8_LDB(B1, 0, 1); PG8_STAGE(PG8_SB(0, 0), b2, voffB);
            PG8_BAR; PG8_WAIT_L(0); PG8_MMA(0, 1, At, B1); PG8_BAR;
            PG8_LDA(At, 0, 1); PG8_STAGE(PG8_SA(0, 0), a2, voffA);
            PG8_BAR; PG8_WAIT_L(0); PG8_MMA(1, 0, At, B0); PG8_BAR; PG8_SCHED;
            PG8_STAGE(PG8_SB(0, 1), b2 + hstepB, voffB);
            PG8_WAIT_V(6); PG8_BAR; PG8_MMA(1, 1, At, B1); PG8_BAR;
            PG8_LDB(B0, 1, 0); PG8_SCHED; PG8_LDA(At, 1, 0); PG8_STAGE(PG8_SA(0, 1), a2 + hstepA, voffA);
            PG8_WAIT_L(8); PG8_BAR; PG8_WAIT_L(0); PG8_MMA(0, 0, At, B0); PG8_BAR; PG8_SCHED;
            PG8_LDB(B1, 1, 1); PG8_STAGE(PG8_SB(1, 0), b3, voffB);
            PG8_BAR; PG8_WAIT_L(0); PG8_MMA(0, 1, At, B1); PG8_BAR;
            PG8_LDA(At, 1, 1); PG8_STAGE(PG8_SA(1, 0), a3, voffA);
            PG8_BAR; PG8_WAIT_L(0); PG8_MMA(1, 0, At, B0); PG8_BAR; PG8_SCHED;
            PG8_STAGE(PG8_SB(1, 1), b3 + hstepB, voffB);
            PG8_WAIT_V(6); PG8_BAR; PG8_MMA(1, 1, At, B1); PG8_BAR;
            }
        }
        if constexpr (ALIGN_EPI) { if (wr == 0) PG8_BAR; }
        if constexpr (!Epi::AFTER_DRAIN) { E(acc, cur, wr, wc, fr, fq); S.done(cur); }
        if (!has_next) break;
#pragma unroll
        for (int a = 0; a < 2; ++a)
#pragma unroll
            for (int b = 0; b < 2; ++b)
#pragma unroll
                for (int m = 0; m < 4; ++m)
#pragma unroll
                    for (int n = 0; n < 2; ++n) acc[a][b][m][n] = (f32x4){0.f, 0.f, 0.f, 0.f};
        cur = nxt; cA = nA; cB = nB; ++ui;
        if constexpr (ALIGN_EPI) { if (wr == 1) PG8_BAR; }
    }
    PG8_WAIT_V(0);
    if constexpr (!ALIGN_EPI) { if (wr == 0) PG8_BAR; }
    PG8_BAR;
    if constexpr (Epi::AFTER_DRAIN) { E.fused(acc, cur, wr, wc, fr, fq, lds, wid, lane); S.done(cur); }
#undef PG8_SA
#undef PG8_SB
#undef PG8_STAGE
#undef PG8_LDA
#undef PG8_LDB
#undef PG8_MMA
#undef PG8_WAIT_V
#undef PG8_WAIT_L
#undef PG8_BAR
#undef PG8_SCHED
}
}

typedef float f32x2_t __attribute__((ext_vector_type(2))); typedef __bf16 bf16x2_t __attribute__((ext_vector_type(2)));
DI unsigned cvt_pk_bf16(float lo, float hi) { const f32x2_t v = {lo, hi}; const bf16x2_t b = __builtin_convertvector(v, bf16x2_t); return __builtin_bit_cast(unsigned, b); }
DI u32x4 pack8(const f32x4 a, const f32x4 b) { u32x4 w; w.x = cvt_pk_bf16(a[0], a[1]); w.y = cvt_pk_bf16(a[2], a[3]); w.z = cvt_pk_bf16(b[0], b[1]); w.w = cvt_pk_bf16(b[2], b[3]); return w; }
struct EpiIn {
    static constexpr bool PERM = true, AFTER_DRAIN = false;
    Ctx C; int l;
    DI void operator()(const f32x4 (&acc)[2][2][4][2], const pg8::Unit& u, int wr, int wc, int fr, int fq) const {
        const int row0 = u.pm * 256 + wr * 64 + fr;
        float rs[2][4];
#pragma unroll
        for (int ai = 0; ai < 2; ++ai)
#pragma unroll
            for (int m = 0; m < 4; ++m) {
                const f32x4 p = *(const f32x4*)(C.rss() + (size_t)(row0 + ai * 128 + m * 16) * 16 + 4 * fq);
                float s = sum_fq((p[0] + p[1]) + (p[2] + p[3]));
                rs[ai][m] = rsqrtf(s * (1.f / DM) + EPS);
            }
        if (u.pn < 19) {
            bf16_t* base = C.proj() + (size_t)row0 * PJW + u.pn * 256 + wc * 32 + 8 * fq;
#pragma unroll
            for (int ai = 0; ai < 2; ++ai)
#pragma unroll
                for (int m = 0; m < 4; ++m) {
                    bf16_t* rowp = base + (size_t)(ai * 128 + m * 16) * PJW; const float sc = rs[ai][m];
#pragma unroll
                    for (int bj = 0; bj < 2; ++bj) *(u32x4*)(rowp + bj * 128) = pack8(acc[ai][bj][m][0] * sc, acc[ai][bj][m][1] * sc);
                }
        } else if (u.pn == 19) {
            if (wc < 2) {
                const float* kw = C.inp(19) + l * 64 + 8 * fq;
                const f32x4 k00 = *(const f32x4*)(kw), k01 = *(const f32x4*)(kw + 4), k10 = *(const f32x4*)(kw + 32), k11 = *(const f32x4*)(kw + 36);
#pragma unroll
                for (int ai = 0; ai < 2; ++ai)
#pragma unroll
                    for (int m = 0; m < 4; ++m) {
                        const int row = row0 + ai * 128 + m * 16; int sb, t; row_sbt(row, sb, t);
                        const float sc = rs[ai][m];
                        f32x4 a0 = acc[ai][0][m][0] * sc, a1 = acc[ai][0][m][1] * sc, b0 = acc[ai][1][m][0] * sc, b1 = acc[ai][1][m][1] * sc;
                        float ss = 0.f;
#pragma unroll
                        for (int i = 0; i < 4; ++i) ss += (a0[i] * a0[i] + a1[i] * a1[i]) + (b0[i] * b0[i] + b1[i] * b1[i]);
                        ss = sum_fq(ss);
                        const float rn = rsqrtf(ss * (1.f / 64.f) + EPS);
                        a0 = a0 * rn * k00; a1 = a1 * rn * k01; b0 = b0 * rn * k10; b1 = b1 * rn * k11;
                        float* o = out_ak(C, l, sb) + (size_t)t * 128 + wc * 64 + 8 * fq;
                        *(f32x4*)(o) = a0; *(f32x4*)(o + 4) = a1; *(f32x4*)(o + 32) = b0; *(f32x4*)(o + 36) = b1;
                        bf16_t* kv = C.kvb(l) + kvb_off(sb) + (size_t)(sb_P(sb) + t) * KVW + wc * 64 + 8 * fq;
                        *(u32x4*)(kv) = pack8(a0, a1); *(u32x4*)(kv + 32) = pack8(b0, b1);
                    }
            } else {
                const int kvh = wc - 2;
#pragma unroll
                for (int ai = 0; ai < 2; ++ai)
#pragma unroll
                    for (int m = 0; m < 4; ++m) {
                        const int row = row0 + ai * 128 + m * 16; int sb, t; row_sbt(row, sb, t);
                        const float sc = rs[ai][m];
                        const f32x4 a0 = acc[ai][0][m][0] * sc, a1 = acc[ai][0][m][1] * sc, b0 = acc[ai][1][m][0] * sc, b1 = acc[ai][1][m][1] * sc;
                        float* o = out_av(C, l, sb) + (size_t)t * 128 + kvh * 64 + 8 * fq;
                        *(f32x4*)(o) = a0; *(f32x4*)(o + 4) = a1; *(f32x4*)(o + 32) = b0; *(f32x4*)(o + 36) = b1;
                        bf16_t* kv = C.kvb(l) + kvb_off(sb) + (size_t)(sb_P(sb) + t) * KVW + 128 + kvh * 64 + 8 * fq;
                        *(u32x4*)(kv) = pack8(a0, a1); *(u32x4*)(kv + 32) = pack8(b0, b1);
                    }
            }
        } else {
#pragma unroll
            for (int ai = 0; ai < 2; ++ai)
#pragma unroll
                for (int m = 0; m < 4; ++m) {
                    const int row = row0 + ai * 128 + m * 16; int sb, t; row_sbt(row, sb, t);
                    const float sc = rs[ai][m];
                    const f32x4 a0 = acc[ai][0][m][0] * sc, a1 = acc[ai][0][m][1] * sc;
                    if (wc < 2) {
                        const int d = 32 * wc + 8 * fq;
                        float* o = out_ik(C, l, sb) + (size_t)t * 64 + d;
                        *(f32x4*)(o) = a0; *(f32x4*)(o + 4) = a1;
                        *(u32x4*)(C.kvb(l) + kvb_off(sb) + (size_t)(sb_P(sb) + t) * KVW + 256 + d) = pack8(a0, a1);
                    } else if (wc == 2) {
                        if (fq == 0) { *(f32x4*)(C.wi() + (size_t)row * 4) = a0; *(f32x4*)(C.dtr() + (size_t)row * 16) = a1; }
                        else if (fq == 1) { *(f32x4*)(C.dtr() + (size_t)row * 16 + 4) = a0; *(f32x4*)(C.dtr() + (size_t)row * 16 + 8) = a1; }
                        else if (fq == 2) { *(f32x4*)(C.dtr() + (size_t)row * 16 + 12) = a0; }
                    }
                }
        }
    }
};
struct EpiOut {
    static constexpr bool PERM = false, AFTER_DRAIN = false;
    Ctx C; int l;
    DI void operator()(const f32x4 (&acc)[2][2][4][2], const pg8::Unit& u, int wr, int wc, int fr, int fq) const {
        const int row0 = u.pm * 256 + wr * 64 + fr, col0 = u.pn * 256 + wc * 32 + 4 * fq;
#pragma unroll
        for (int ai = 0; ai < 2; ++ai)
#pragma unroll
            for (int m = 0; m < 4; ++m) {
                const int row = row0 + ai * 128 + m * 16;
                const float* xres = (l == 0) ? ((row < ROWS_P) ? C.inp(0) + (size_t)row * DM : C.inp(1) + (size_t)(row - ROWS_P) * DM) : C.out + (size_t)row * DM;
                float ss = 0.f;
#pragma unroll
                for (int bj = 0; bj < 2; ++bj)
#pragma unroll
                    for (int n = 0; n < 2; ++n) {
                        const int col = col0 + bj * 128 + n * 16;
                        const f32x4 v = *(const f32x4*)(xres + col) + acc[ai][bj][m][n];
                        *(f32x4*)(C.out + (size_t)row * DM + col) = v;
                        if (l == 0) {
                            u32x2 w; w.x = cvt_pk_bf16(v[0], v[1]); w.y = cvt_pk_bf16(v[2], v[3]);
                            *(u32x2*)(C.hb() + (size_t)row * DM + col) = w;
                            ss += (v[0] * v[0] + v[1] * v[1]) + (v[2] * v[2] + v[3] * v[3]);
                        }
                    }
                if (l == 0) {
                    ss = sum_fq(ss);
                    if (fq == 0) C.rss()[(size_t)row * 16 + u.pn * 4 + wc] = ss;
                }
            }
    }
};
DI void phase_inproj_gemm(const Ctx& C, int l) {
    pg8::Gemm g{C.hb(), C.win(l), ROWS, NPAD, DM, DM};
    pg8::StaticOrder S; S.init(ROWS, NPAD, C.G, C.bid);
    EpiIn E{C, l};
    pg8::gemm_phase<EpiIn, pg8::StaticOrder, true, true>(C.lds, g, S, E, C.tid);
}
DI void phase_outproj_gemm(const Ctx& C, int l) {
    pg8::Gemm g{C.proj(), C.wout(l), ROWS_P, DM, DMIX, PJW};
    pg8::StaticOrder S; S.init(ROWS_P, DM, C.G, C.bid);
    EpiOut E{C, l};
    pg8::gemm_phase<EpiOut, pg8::StaticOrder, true, true>(C.lds, g, S, E, C.tid);
}
DI void outproj_tail_item(const Ctx& C, int l, int rt, int g);
DI void phase_ycnorm(const Ctx& C, int l) {
    const int gw = C.bid * NWAVES + C.wave, NGW = C.G * NWAVES, lane = C.lane;
#if USE_SSD_OPT
    for (int i = C.bid * NTHREADS + C.tid; i < NSB * 3 * 1536; i += C.G * NTHREADS) {
        const int sb = i / (3 * 1536), j = (i / 1536) % 3, ch = i % 1536;
        out_sc(C, l, sb)[j * 1536 + ch] = bf2f(C.proj()[(size_t)(sb_row0(sb) + sb_T(sb) - 3 + j) * PJW + C_XBC + ch]);
    }
#endif
#if USE_LRU_OPT
    for (int i = C.bid * NTHREADS + C.tid; i < NSB * 3 * 512; i += C.G * NTHREADS) {
        const int sb = i / (3 * 512), j = (i / 512) % 3, ch = i % 512;
        out_lc(C, l, sb)[j * 512 + ch] = bf2f(C.proj()[(size_t)(sb_row0(sb) + sb_T(sb) - 3 + j) * PJW + C_XL + ch]);
    }
#endif
    if (C.bid < 256) outproj_tail_item(C, l, ROWS_P / 32 + (C.bid >> 4), C.bid & 15);
    for (int m = gw; m < ROWS_P; m += NGW) {
        const float s = C.ssq()[(size_t)m * 64 + lane];
        float h = s;
        h = half_sum32(h);
        const float rg = rsqrtf(h * (1.f / 512.f) + EPS);
        const float r0 = bperm(rg, 0), r1 = bperm(rg, 32);
        bf16_t* p = C.proj() + (size_t)m * PJW + C_Z;
#pragma unroll
        for (int j = 0; j < 2; ++j) {
            const int c = 8 * lane + 512 * j;
            const u32x4 v = *(const u32x4*)(p + c); const float r = j == 0 ? r0 : r1; u32x4 o;
            o.x = cvt_pk_bf16(__uint_as_float(v.x << 16) * r, __uint_as_float(v.x & 0xffff0000u) * r);
            o.y = cvt_pk_bf16(__uint_as_float(v.y << 16) * r, __uint_as_float(v.y & 0xffff0000u) * r);
            o.z = cvt_pk_bf16(__uint_as_float(v.z << 16) * r, __uint_as_float(v.z & 0xffff0000u) * r);
            o.w = cvt_pk_bf16(__uint_as_float(v.w << 16) * r, __uint_as_float(v.w & 0xffff0000u) * r);
            *(u32x4*)(p + c) = o;
        }
    }
}

template <int MODE>
DI void p0_transpose_item(const Ctx& C, const float* W, const float* scale, int K, int Nsrc, int Ndst, bf16_t* WT, LAS float* scr, int item) {
    const int lane = C.lane, nblk = Ndst / 64, kb = item / nblk, nb = item % nblk, k0 = 64 * kb, n0 = 64 * nb;
    const int cgp = lane & 15, kq = lane >> 4;
    const int ncol = n0 + 4 * cgp;
    const int src = (MODE == 0) ? orig_col(ncol) : ncol;
#pragma unroll 8
    for (int i = 0; i < 16; ++i) {
        const int kk = 4 * i + kq, k = k0 + kk;
        f32x4 v = (f32x4){0.f, 0.f, 0.f, 0.f};
        if (src >= 0) {
            v = *(const f32x4*)(W + (size_t)k * Nsrc + src);
            const float sc = (MODE == 0) ? scale[k] : (k >= 1024 ? scale[k - 1024] : 1.f);
            v = v * sc;
        }
        scr[(4 * cgp + 0) * 65 + kk] = v[0]; scr[(4 * cgp + 1) * 65 + kk] = v[1]; scr[(4 * cgp + 2) * 65 + kk] = v[2]; scr[(4 * cgp + 3) * 65 + kk] = v[3];
    }
    LDS_FENCE();
    const LAS float* sr = scr + lane * 65;
    bf16_t* orow = WT + (size_t)(n0 + lane) * K + k0;
#pragma unroll
    for (int j = 0; j < 8; ++j) {
        u32x4 o; o.x = cvt_pk_bf16(sr[8 * j], sr[8 * j + 1]); o.y = cvt_pk_bf16(sr[8 * j + 2], sr[8 * j + 3]); o.z = cvt_pk_bf16(sr[8 * j + 4], sr[8 * j + 5]); o.w = cvt_pk_bf16(sr[8 * j + 6], sr[8 * j + 7]);
        *(u32x4*)(orow + 8 * j) = o;
    }
    LDS_FENCE();
}
DI void prep_layer(const Ctx& C, int l) {
    LAS float* scr = (LAS float*)(C.lds + C.wave * 16640);
    const int gw = C.bid * NWAVES + C.wave, NGW = C.G * NWAVES;
    constexpr int I_IN = (DM / 64) * (NPAD / 64), I_OUT = (DMIX / 64) * (DM / 64);
    for (int it = gw; it < I_IN + I_OUT; it += NGW) {
        if (it < I_IN) p0_transpose_item<0>(C, C.inp(10) + (size_t)l * DM * DINP, C.inp(9) + l * DM, DM, DINP, NPAD, C.win(l), scr, it);
        else p0_transpose_item<1>(C, C.inp(27) + (size_t)l * DMIX * DM, C.inp(26) + l * 1024, DMIX, DM, DM, C.wout(l), scr, it - I_IN);
    }
    for (int it = gw; it < NSB_S * PAST / 4; it += NGW) {
        const int b = it / (PAST / 4), pos0 = 4 * (it % (PAST / 4));
#pragma unroll
        for (int j = 0; j < 5; ++j) {
            const int pc = C.lane + 64 * j, pp = pc / 80, q = pc % 80, pos = pos0 + pp;
            const size_t base = ((size_t)(l * NSB_S + b) * PAST + pos);
            const f32x4 v = (q < 32) ? *(const f32x4*)(C.inp(2) + base * 128 + 4 * q) : (q < 64 ? *(const f32x4*)(C.inp(3) + base * 128 + 4 * (q - 32)) : *(const f32x4*)(C.inp(4) + base * 64 + 4 * (q - 64)));
            u32x2 o; o.x = cvt_pk_bf16(v[0], v[1]); o.y = cvt_pk_bf16(v[2], v[3]);
            *(u32x2*)(C.kvb(l) + kvb_off(NPB + b) + (size_t)pos * KVW + 4 * q) = o;
        }
    }
}
DI void phase_prologue(const Ctx& C) {
    prep_layer(C, 0);
    const int gw = C.bid * NWAVES + C.wave, NGW = C.G * NWAVES;
    for (int m0 = 4 * gw; m0 < ROWS; m0 += 4 * NGW) {
        f32x4 v[4][4];
#pragma unroll
        for (int rr = 0; rr < 4; ++rr) { const int m = m0 + rr; const float* xr = (m < ROWS_P) ? C.inp(0) + (size_t)m * DM : C.inp(1) + (size_t)(m - ROWS_P) * DM;
#pragma unroll
            for (int j = 0; j < 4; ++j) v[rr][j] = *(const f32x4*)(xr + 4 * C.lane + 256 * j); }
#pragma unroll
        for (int rr = 0; rr < 4; ++rr) { const int m = m0 + rr; float ss = 0.f;
#pragma unroll
            for (int j = 0; j < 4; ++j) { const f32x4 x = v[rr][j]; ss += (x[0] * x[0] + x[1] * x[1]) + (x[2] * x[2] + x[3] * x[3]);
                u32x2 o; o.x = cvt_pk_bf16(x[0], x[1]); o.y = cvt_pk_bf16(x[2], x[3]); *(u32x2*)(C.hb() + (size_t)m * DM + 4 * C.lane + 256 * j) = o; }
            ss = wave_sum(ss);
            if (C.lane < 16) C.rss()[(size_t)m * 16 + C.lane] = (C.lane == 0) ? ss : 0.f; }
    }
}

#define MFMA32(a, b, c) __builtin_amdgcn_mfma_f32_32x32x16_bf16((a), (b), (c), 0, 0, 0)
DI void phase_inproj_simple(const Ctx& C, int l) {
    const int gw = C.bid * NWAVES + C.wave, NGW = C.G * NWAVES, lane = C.lane, r = lane & 31, h = lane >> 5;
    constexpr int NG = 82, NRT = ROWS / 32;
    const bf16_t* WIN = C.win(l); const bf16_t* HB = C.hb(); bf16_t* PJ = C.proj();
    for (int it = gw; it < NRT * NG; it += NGW) {
        const int rt = it / NG, g = it % NG, m0 = rt * 32;
        int c0, c1, type;
        if (g < 76) { c0 = 64 * g; c1 = c0 + 32; type = 0; }
        else if (g < 80) { const int hs = g - 76; c0 = C_T19 + 32 * hs; c1 = c0 + 128; type = hs < 2 ? 1 : 2; }
        else if (g == 80) { c0 = C_T20; c1 = C_T20 + 32; type = 3; }
        else { c0 = C_T20 + 64; c1 = C_T20 + 96; type = 4; }
        f32x16 acc0, acc1;
#pragma unroll
        for (int i = 0; i < 16; ++i) { acc0[i] = 0.f; acc1[i] = 0.f; }
        const bf16_t* Ap = HB + (size_t)(m0 + r) * DM + 8 * h;
        const bf16_t* B0 = WIN + (size_t)(c0 + r) * DM + 8 * h;
        const bf16_t* B1 = WIN + (size_t)(c1 + r) * DM + 8 * h;
#pragma unroll 4
        for (int k0 = 0; k0 < DM; k0 += 16) {
            const bf16x8 a = *(const bf16x8*)(Ap + k0), b0 = *(const bf16x8*)(B0 + k0), b1 = *(const bf16x8*)(B1 + k0);
            acc0 = MFMA32(a, b0, acc0); acc1 = MFMA32(a, b1, acc1);
        }
        float rsc; { const float* p = C.rss() + (size_t)(m0 + r) * 16; float s = 0.f;
#pragma unroll
            for (int j = 0; j < 16; ++j) s += p[j];
            rsc = rsqrtf(s * (1.f / DM) + EPS); }
        const float kn0 = (type == 1) ? C.inp(19)[l * 64 + r] : 1.f, kn1 = (type == 1) ? C.inp(19)[l * 64 + 32 + r] : 1.f;
#pragma unroll
        for (int reg = 0; reg < 16; ++reg) {
            const int rowl = crow(reg, h), m = m0 + rowl;
            const float sc = bperm(rsc, rowl);
            float v0 = acc0[reg] * sc, v1 = acc1[reg] * sc;
            if (type == 0) { PJ[(size_t)m * PJW + c0 + r] = f2bf(v0); PJ[(size_t)m * PJW + c1 + r] = f2bf(v1); }
            else {
                int sb, t; row_sbt(m, sb, t); const int pos = sb_P(sb) + t;
                bf16_t* kv = C.kvb(l) + kvb_off(sb) + (size_t)pos * KVW;
                if (type == 1) {
                    const int kvh = g - 76;
                    const float ss = half_sum32(v0 * v0 + v1 * v1), rn = rsqrtf(ss * (1.f / 64.f) + EPS);
                    v0 = v0 * rn * kn0; v1 = v1 * rn * kn1;
                    float* o = out_ak(C, l, sb) + (size_t)t * 128 + kvh * 64;
                    o[r] = v0; o[32 + r] = v1; kv[kvh * 64 + r] = f2bf(v0); kv[kvh * 64 + 32 + r] = f2bf(v1);
                } else if (type == 2) {
                    const int kvh = g - 78;
                    float* o = out_av(C, l, sb) + (size_t)t * 128 + kvh * 64;
                    o[r] = v0; o[32 + r] = v1; kv[128 + kvh * 64 + r] = f2bf(v0); kv[128 + kvh * 64 + 32 + r] = f2bf(v1);
                } else if (type == 3) {
                    float* o = out_ik(C, l, sb) + (size_t)t * 64;
                    o[r] = v0; o[32 + r] = v1; kv[256 + r] = f2bf(v0); kv[256 + 32 + r] = f2bf(v1);
                } else {
                    if (r < 4) C.wi()[(size_t)m * 4 + r] = v0; else if (r < 20) C.dtr()[(size_t)m * 16 + (r - 4)] = v0;
                }
            }
        }
    }
}

DI void outproj_tail_item(const Ctx& C, int l, int rt, int g) {
    const int lane = C.lane, wave = C.wave, r = lane & 31, h = lane >> 5;
    const bf16_t* WO = C.wout(l); const bf16_t* PJ = C.proj();
    const int m0 = rt * 32, c0 = 64 * g, c1 = c0 + 32, kbeg = 256 * wave;
    f32x16 a0, a1;
#pragma unroll
    for (int i = 0; i < 16; ++i) { a0[i] = 0.f; a1[i] = 0.f; }
    const bf16_t* Ap = PJ + (size_t)(m0 + r) * PJW + 8 * h + kbeg;
    const bf16_t* B0 = WO + (size_t)(c0 + r) * DMIX + 8 * h + kbeg;
    const bf16_t* B1 = WO + (size_t)(c1 + r) * DMIX + 8 * h + kbeg;
#pragma unroll 8
    for (int k0 = 0; k0 < 256; k0 += 16) { const bf16x8 a = *(const bf16x8*)(Ap + k0); a0 = MFMA32(a, *(const bf16x8*)(B0 + k0), a0); a1 = MFMA32(a, *(const bf16x8*)(B1 + k0), a1); }
    LAS float* part = (LAS float*)C.lds;
#pragma unroll
    for (int i = 0; i < 16; ++i) { part[((wave * 2 + 0) * 16 + i) * 64 + lane] = a0[i]; part[((wave * 2 + 1) * 16 + i) * 64 + lane] = a1[i]; }
    __syncthreads();
    if (wave == 0) {
        float r0, r1; { const float* p = C.ssq() + (size_t)(m0 + r) * 64; float s0 = 0.f, s1 = 0.f;
#pragma unroll
            for (int j = 0; j < 32; ++j) { s0 += p[j]; s1 += p[32 + j]; }
            r0 = rsqrtf(s0 * (1.f / 512.f) + EPS); r1 = rsqrtf(s1 * (1.f / 512.f) + EPS); }
#pragma unroll
        for (int reg = 0; reg < 16; ++reg) {
            const int rowl = crow(reg, h), m = m0 + rowl;
            const float g0 = bperm(r0, rowl), g1 = bperm(r1, rowl);
            float sab[2], sc0[2], sc1[2];
#pragma unroll
            for (int t = 0; t < 2; ++t) {
                sab[t] = (part[((0 * 2 + t) * 16 + reg) * 64 + lane] + part[((1 * 2 + t) * 16 + reg) * 64 + lane]) + (part[((2 * 2 + t) * 16 + reg) * 64 + lane] + part[((3 * 2 + t) * 16 + reg) * 64 + lane]);
                sc0[t] = part[((4 * 2 + t) * 16 + reg) * 64 + lane] + part[((5 * 2 + t) * 16 + reg) * 64 + lane];
                sc1[t] = part[((6 * 2 + t) * 16 + reg) * 64 + lane] + part[((7 * 2 + t) * 16 + reg) * 64 + lane];
            }
            const float* xres = (l == 0) ? ((m < ROWS_P) ? C.inp(0) + (size_t)m * DM : C.inp(1) + (size_t)(m - ROWS_P) * DM) : C.out + (size_t)m * DM;
            const float v0 = xres[c0 + r] + sab[0] + g0 * sc0[0] + g1 * sc1[0];
            const float v1 = xres[c1 + r] + sab[1] + g0 * sc0[1] + g1 * sc1[1];
            C.out[(size_t)m * DM + c0 + r] = v0; C.out[(size_t)m * DM + c1 + r] = v1;
            if (l == 0) {
                C.hb()[(size_t)m * DM + c0 + r] = f2bf(v0); C.hb()[(size_t)m * DM + c1 + r] = f2bf(v1);
                const float ss = half_sum32(v0 * v0 + v1 * v1);
                if (r == 0) C.rss()[(size_t)m * 16 + g] = ss;
            }
        }
    }
    __syncthreads();
}

DI void phase_conv_naive(const Ctx& C, int l) {
    const int gt = C.bid * NTHREADS + C.tid, NGT = C.G * NTHREADS;
    bf16_t* PJ = C.proj();
    for (int i = gt; i < NSB * 1536; i += NGT) {
        const int sb = i / 1536, ch = i % 1536, T = sb_T(sb), row0 = sb_row0(sb);
        const float* cw = C.inp(21) + (size_t)l * 4 * 1536; const float w0 = cw[ch], w1 = cw[1536 + ch], w2 = cw[2 * 1536 + ch], w3 = cw[3 * 1536 + ch], bias = C.inp(22)[l * 1536 + ch];
        float h0 = 0.f, h1 = 0.f, h2 = 0.f;
        if (sb >= NPB) { const float* st = C.inp(7) + ((size_t)(l * NSB_S + sb - NPB) * 3) * 1536; h0 = st[ch]; h1 = st[1536 + ch]; h2 = st[2 * 1536 + ch]; }
        bf16_t* p = PJ + (size_t)row0 * PJW + C_XBC + ch;
        for (int t = 0; t < T; ++t) {
            const float x = bf2f(p[(size_t)t * PJW]);
            const float y = bias + w0 * h0 + w1 * h1 + w2 * h2 + w3 * x;
            p[(size_t)t * PJW] = f2bf(silu_f(y));
            h0 = h1; h1 = h2; h2 = x;
        }
        float* o = out_sc(C, l, sb); o[ch] = h0; o[1536 + ch] = h1; o[2 * 1536 + ch] = h2;
    }
}

DI void lru_item_naive(const Ctx& C, int l, int sb, int blk, LAS unsigned char* scr) {
    const int lane = C.lane, ch = blk * 64 + lane, T = sb_T(sb), row0 = sb_row0(sb);
    bf16_t* PJ = C.proj();
    LAS unsigned* wl = (LAS unsigned*)scr;
    { const float* pa = C.inp(13) + (size_t)(l * 8 + blk) * 4096 + lane; const float* px = C.inp(15) + (size_t)(l * 8 + blk) * 4096 + lane;
      for (int c = 0; c < 64; ++c) wl[c * 64 + lane] = pk2(pa[c * 64], px[c * 64]); }
    LDS_FENCE();
    const float ba = C.inp(14)[l * 512 + ch], bx = C.inp(16)[l * 512 + ch];
    const float spl = softplus_f(-C.inp(17)[l * 512 + ch]);
    const float* cw = C.inp(11) + (size_t)l * 4 * 512; const float w0 = cw[ch], w1 = cw[512 + ch], w2 = cw[1024 + ch], w3 = cw[1536 + ch], cb = C.inp(12)[l * 512 + ch];
    float h0 = 0.f, h1 = 0.f, h2 = 0.f, hs = 0.f;
    if (sb >= NPB) { const float* st = C.inp(5) + ((size_t)(l * NSB_S + sb - NPB) * 3) * 512; h0 = st[ch]; h1 = st[512 + ch]; h2 = st[1024 + ch]; hs = C.inp(6)[(size_t)(l * NSB_S + sb - NPB) * 512 + ch]; }
    for (int t = 0; t < T; ++t) {
        const size_t rb = (size_t)(row0 + t) * PJW;
        const float x = bf2f(PJ[rb + C_XL + ch]);
        const float xc = cb + w0 * h0 + w1 * h1 + w2 * h2 + w3 * x;
        h0 = h1; h1 = h2; h2 = x;
        float ga = ba, gx = bx;
#pragma unroll 8
        for (int c = 0; c < 64; ++c) { const float xv = __int_as_float(__builtin_amdgcn_readlane(__float_as_int(xc), c)); const unsigned w = wl[c * 64 + lane]; ga += xv * __uint_as_float(w << 16); gx += xv * __uint_as_float(w & 0xffff0000u); }
        const float rg = sigmoid_f(ga), ig = sigmoid_f(gx);
        const float log_a = -8.f * rg * spl, a = expf(log_a), mult = sqrtf(-expm1f(2.f * log_a));
        hs = a * hs + mult * (ig * xc);
        const float gl = bf2f(PJ[rb + C_GL + ch]);
        PJ[rb + C_GL + ch] = f2bf(hs * silu_f(gl));
    }
    float* oc = out_lc(C, l, sb); oc[ch] = h0; oc[512 + ch] = h1; oc[1024 + ch] = h2;
    out_lh(C, l, sb)[ch] = hs;
}

DI void ssd_item_naive(const Ctx& C, int l, int sb, int hd, int pq) {
    const int lane = C.lane, T = sb_T(sb), row0 = sb_row0(sb), g = hd >> 3;
    const int p = 16 * pq + (lane & 15), nq = lane >> 4, n0 = 32 * nq;
    bf16_t* PJ = C.proj();
    float hst[32];
    if (sb >= NPB) { const float* st = C.inp(8) + (((size_t)(l * NSB_S + sb - NPB) * 16 + hd) * 64 + p) * 128 + n0;
#pragma unroll
        for (int n = 0; n < 32; n += 4) { const f32x4 v = *(const f32x4*)(st + n); hst[n] = v.x; hst[n + 1] = v.y; hst[n + 2] = v.z; hst[n + 3] = v.w; } }
    else {
#pragma unroll
        for (int n = 0; n < 32; ++n) hst[n] = 0.f; }
    const float aneg = -expf(C.inp(24)[l * 16 + hd]), dtb = C.inp(23)[l * 16 + hd], Dh = C.inp(25)[l * 16 + hd];
    for (int t = 0; t < T; ++t) {
        const size_t rb = (size_t)(row0 + t) * PJW;
        const float dt = softplus_f(C.dtr()[(size_t)(row0 + t) * 16 + hd] + dtb), da = expf(dt * aneg);
        const float xs = bf2f(PJ[rb + C_XBC + hd * 64 + p]), dtx = dt * xs;
        const bf16_t* Bp = PJ + rb + C_XBC + 1024 + g * 128 + n0; const bf16_t* Cp = PJ + rb + C_XBC + 1280 + g * 128 + n0;
        float y = 0.f;
#pragma unroll
        for (int n = 0; n < 32; n += 8) {
            const bf16x8 bv = *(const bf16x8*)(Bp + n), cv = *(const bf16x8*)(Cp + n);
#pragma unroll
            for (int j = 0; j < 8; ++j) { hst[n + j] = da * hst[n + j] + dtx * bf2f((bf16_t)bv[j]); y += bf2f((bf16_t)cv[j]) * hst[n + j]; }
        }
        y = sum_fq(y);
        y += Dh * xs;
        const float z = bf2f(PJ[rb + C_Z + hd * 64 + p]);
        y *= silu_f(z);
        if (nq == 0) PJ[rb + C_Z + hd * 64 + p] = f2bf(y);
        const float ss = wave_sum(nq == 0 ? y * y : 0.f);
        if (lane == 0) C.ssq()[(size_t)(row0 + t) * 64 + hd * 4 + pq] = ss;
    }
    float* o = out_sh(C, l, sb) + ((size_t)hd * 64 + p) * 128 + n0;
#pragma unroll
    for (int n = 0; n < 32; n += 4) { f32x4 v; v.x = hst[n]; v.y = hst[n + 1]; v.z = hst[n + 2]; v.w = hst[n + 3]; *(f32x4*)(o + n) = v; }
}

constexpr int SS_XST = 0;
constexpr int SS_BM = SS_XST + 64 * 144;
constexpr int SS_CM = SS_BM + 64 * 272;
constexpr int SS_BWT = SS_CM + 64 * 272;
constexpr int SS_HA = SS_BWT + 128 * 144;
constexpr int SS_SCAL = SS_HA + 2 * 64 * 272;
constexpr int SS_CW = SS_SCAL + 2 * 1024;
constexpr int SS_RAW = SS_CW + 5 * 320 * 4;
constexpr int SS_Z = SS_RAW + 67 * 640;
constexpr int SS_END = SS_Z + 8192;
static_assert(SS_END <= LDS_BYTES - 256, "SSD LDS map");
typedef short s16x4 __attribute__((ext_vector_type(4)));
DI float fast_silu(float x) { return x * __builtin_amdgcn_rcpf(1.f + __builtin_amdgcn_exp2f(-1.4426950408889634f * x)); }
DI bf16x8 lds_frag(const LAS unsigned char* base, int row, int rowbytes, int col) { return *(const LAS bf16x8*)(base + row * rowbytes + col * 2); }

DI void ssd_item(const Ctx& C, int l, int sb, int hd) {
    const int tid = C.tid, lane = C.lane, wave = C.wave, r = lane & 31, h = lane >> 5;
    const int T = sb_T(sb), row0 = sb_row0(sb), g = hd >> 3, NC = T / 64;
    LAS unsigned char* L = C.lds;
    bf16_t* PJ = C.proj();
    const float aneg = -expf(C.inp(24)[l * 16 + hd]), dtb = C.inp(23)[l * 16 + hd], Dh = C.inp(25)[l * 16 + hd];
    const bool stager = tid < 320;
    const int gp = 32 * wave + (lane & 31), sth = lane >> 5;
    const int cg = 0, seg = 0; (void)cg; (void)seg;
    int colbase, cch;
    if (cg < 8) { cch = hd * 64 + 8 * cg; } else if (cg < 24) { cch = 1024 + g * 128 + 8 * (cg - 8); } else { cch = 1280 + g * 128 + 8 * (cg - 24); }
    colbase = C_XBC + cch;
    for (int i = tid; i < 5 * 320; i += NTHREADS) {
        const int j = i / 320, c = i % 320, cg2 = c >> 3, e = c & 7;
        const int ch = (cg2 < 8) ? hd * 64 + 8 * cg2 + e : (cg2 < 24 ? 1024 + g * 128 + 8 * (cg2 - 8) + e : 1280 + g * 128 + 8 * (cg2 - 24) + e);
        ((LAS float*)(L + SS_CW))[i] = (j < 4) ? C.inp(21)[((size_t)l * 4 + j) * 1536 + ch] : C.inp(22)[l * 1536 + ch];
    }
    const int sj = wave - 4, sph = sj & 1, nq0 = 2 * (sj >> 1);
    f32x16 hacc0, hacc1;
#pragma unroll
    for (int i = 0; i < 16; ++i) { hacc0[i] = 0.f; hacc1[i] = 0.f; }
    if (wave >= 4) {
        if (sb >= NPB) {
            const float* st = C.inp(8) + (((size_t)(l * NSB_S + sb - NPB) * 16 + hd) * 64 + 32 * sph + r) * 128;
#pragma unroll
            for (int gq = 0; gq < 4; ++gq) {
                const f32x4 v0 = *(const f32x4*)(st + 32 * nq0 + 8 * gq + 4 * h), v1 = *(const f32x4*)(st + 32 * (nq0 + 1) + 8 * gq + 4 * h);
#pragma unroll
                for (int e = 0; e < 4; ++e) { hacc0[4 * gq + e] = v0[e]; hacc1[4 * gq + e] = v1[e]; }
            }
        }
#pragma unroll
        for (int gq = 0; gq < 4; ++gq) {
            u32x2 w0, w1; w0.x = cvt_pk_bf16(hacc0[4 * gq], hacc0[4 * gq + 1]); w0.y = cvt_pk_bf16(hacc0[4 * gq + 2], hacc0[4 * gq + 3]);
            w1.x = cvt_pk_bf16(hacc1[4 * gq], hacc1[4 * gq + 1]); w1.y = cvt_pk_bf16(hacc1[4 * gq + 2], hacc1[4 * gq + 3]);
            *(LAS u32x2*)(L + SS_HA + (32 * sph + r) * 272 + (32 * nq0 + 8 * gq + 4 * h) * 2) = w0;
            *(LAS u32x2*)(L + SS_HA + (32 * sph + r) * 272 + (32 * (nq0 + 1) + 8 * gq + 4 * h) * 2) = w1;
        }
    }
    const int yph = wave & 1, ylh = (wave >> 1) & 1;
#define SSD_DMA_RAW(cc) do { const int t0_ = 64 * (cc); \
        for (int k_ = wave; k_ < 42; k_ += NWAVES) { \
            const int q_ = 64 * k_ + lane, rr_ = q_ / 40, pc_ = q_ - 40 * rr_, t_ = t0_ - 3 + rr_; \
            const int col_ = C_XBC + ((pc_ < 8) ? hd * 64 + 8 * pc_ : (pc_ < 24 ? 1024 + g * 128 + 8 * (pc_ - 8) : 1280 + g * 128 + 8 * (pc_ - 24))); \
            if (q_ < 2680 && t_ >= 0) __builtin_amdgcn_global_load_lds((const unsigned*)(PJ + (size_t)(row0 + t_) * PJW + col_), (LAS unsigned*)(L + SS_RAW + k_ * 1024), 16, 0, 0); } \
    } while (0)
#define SSD_DMA_Z(cc) do { const int t0_ = 64 * (cc); \
        if (wave < 4) { _Pragma("unroll") for (int k_ = 0; k_ < 2; ++k_) { const int rr_ = 16 * k_ + (lane >> 2), pc_ = lane & 3; \
            __builtin_amdgcn_global_load_lds((const unsigned*)(PJ + (size_t)(row0 + t0_ + 32 * ylh + rr_) * PJW + C_Z + hd * 64 + 32 * yph + 8 * pc_), \
                                             (LAS unsigned*)(L + SS_Z + (2 * yph + ylh) * 2048 + k_ * 1024), 16, 0, 0); } } \
    } while (0)
    if (tid < 120) {
        const int rr = tid / 40, pc = tid % 40;
        const int ch = (pc < 8) ? hd * 64 + 8 * pc : (pc < 24 ? 1024 + g * 128 + 8 * (pc - 8) : 1280 + g * 128 + 8 * (pc - 24));
        u32x4 v = (u32x4){0u, 0u, 0u, 0u};
        if (sb >= NPB) { const float* st = C.inp(7) + ((size_t)(l * NSB_S + sb - NPB) * 3 + rr) * 1536 + ch; v = pack8(*(const f32x4*)st, *(const f32x4*)(st + 4)); }
        *(LAS u32x4*)(L + SS_RAW + rr * 640 + pc * 16) = v;
    }
#define SSD_S0(cc) do { LAS float* SC_ = (LAS float*)(L + SS_SCAL + ((cc) & 1) * 1024); \
        const float dt_ = softplus_f(C.dtr()[(size_t)(row0 + 64 * (cc) + lane) * 16 + hd] + dtb); float x_ = dt_ * aneg; \
        _Pragma("unroll") for (int o_ = 1; o_ < 64; o_ <<= 1) { const float y_ = bperm(x_, lane - o_); if (lane >= o_) x_ += y_; } \
        const float c63_ = __int_as_float(__builtin_amdgcn_readlane(__float_as_int(x_), 63)); \
        SC_[lane] = x_; SC_[64 + lane] = dt_; SC_[128 + lane] = __builtin_amdgcn_exp2f(1.4426950408889634f * (c63_ - x_)) * dt_; SC_[192 + lane] = __builtin_amdgcn_exp2f(1.4426950408889634f * x_); } while (0)
    if (wave == 7) SSD_S0(0);
    SSD_DMA_RAW(0); SSD_DMA_Z(0);
    asm volatile("s_waitcnt vmcnt(0)" ::: "memory");
    __syncthreads();
    for (int c = 0; c < NC; ++c) {
        const int t0 = 64 * c, par = c & 1;
        LAS float* SC = (LAS float*)(L + SS_SCAL + par * 1024);
        PROBE_BEGIN(12);
        asm volatile("s_waitcnt vmcnt(0)" ::: "memory"); LDS_FENCE(); __syncthreads();
        if (l == 0) PROBE_END(12, C);
        PROBE_BEGIN(10);
        if (stager) {
            const LAS float* CW = (const LAS float*)(L + SS_CW) + 2 * gp;
            const float a0 = CW[0], a1 = CW[320], a2 = CW[640], a3 = CW[960], ab = CW[1280];
            const float b0 = CW[1], b1 = CW[321], b2 = CW[641], b3 = CW[961], bb = CW[1281];
            const bool isB = (gp >= 32 && gp < 96);
#pragma unroll
            for (int tb = 0; tb < 4; ++tb) {
                const int tk0 = 32 * sth + 8 * tb;
                float xa[11], xb[11];
#pragma unroll
                for (int i = 0; i < 11; ++i) { const unsigned w = *(const LAS unsigned*)(L + SS_RAW + (tk0 + i) * 640 + 4 * gp); xa[i] = __uint_as_float(w << 16); xb[i] = __uint_as_float(w & 0xffff0000u); }
                float ta[8], tc[8];
#pragma unroll
                for (int j = 0; j < 8; ++j) {
                    ta[j] = fast_silu(ab + a0 * xa[j] + a1 * xa[j + 1] + a2 * xa[j + 2] + a3 * xa[j + 3]);
                    tc[j] = fast_silu(bb + b0 * xb[j] + b1 * xb[j + 1] + b2 * xb[j + 2] + b3 * xb[j + 3]);
                }
                if (gp < 32) {
                    u32x4 wa, wb;
                    wa.x = cvt_pk_bf16(ta[0], ta[1]); wa.y = cvt_pk_bf16(ta[2], ta[3]); wa.z = cvt_pk_bf16(ta[4], ta[5]); wa.w = cvt_pk_bf16(ta[6], ta[7]);
                    wb.x = cvt_pk_bf16(tc[0], tc[1]); wb.y = cvt_pk_bf16(tc[2], tc[3]); wb.z = cvt_pk_bf16(tc[4], tc[5]); wb.w = cvt_pk_bf16(tc[6], tc[7]);
                    *(LAS u32x4*)(L + SS_XST + (2 * gp) * 144 + tk0 * 2) = wa; *(LAS u32x4*)(L + SS_XST + (2 * gp + 1) * 144 + tk0 * 2) = wb;
                } else {
                    const int n0 = isB ? 2 * (gp - 32) : 2 * (gp - 96);
                    LAS unsigned char* img = L + (isB ? SS_BM : SS_CM);
#pragma unroll
                    for (int j = 0; j < 8; ++j) *(LAS unsigned*)(img + (tk0 + j) * 272 + n0 * 2) = cvt_pk_bf16(ta[j], tc[j]);
                    if (isB) {
                        float te[8];
#pragma unroll
                        for (int j = 0; j < 8; ++j) te[j] = SC[128 + tk0 + j];
                        u32x4 wa, wb;
                        wa.x = cvt_pk_bf16(ta[0] * te[0], ta[1] * te[1]); wa.y = cvt_pk_bf16(ta[2] * te[2], ta[3] * te[3]); wa.z = cvt_pk_bf16(ta[4] * te[4], ta[5] * te[5]); wa.w = cvt_pk_bf16(ta[6] * te[6], ta[7] * te[7]);
                        wb.x = cvt_pk_bf16(tc[0] * te[0], tc[1] * te[1]); wb.y = cvt_pk_bf16(tc[2] * te[2], tc[3] * te[3]); wb.z = cvt_pk_bf16(tc[4] * te[4], tc[5] * te[5]); wb.w = cvt_pk_bf16(tc[6] * te[6], tc[7] * te[7]);
                        *(LAS u32x4*)(L + SS_BWT + n0 * 144 + tk0 * 2) = wa; *(LAS u32x4*)(L + SS_BWT + (n0 + 1) * 144 + tk0 * 2) = wb;
                    }
                }
            }
        }
        if (l == 0) PROBE_END(10, C);
        PROBE_BEGIN(13);
        LDS_FENCE(); __syncthreads();
        if (l == 0) PROBE_END(13, C);
        PROBE_BEGIN(11);
        if (c + 1 < NC) SSD_DMA_RAW(c + 1);
        if (wave < 4) {
            const LAS unsigned char* HAc = L + SS_HA + par * (64 * 272);
            bf16x8 cf[8];
#pragma unroll
            for (int ks = 0; ks < 8; ++ks) cf[ks] = lds_frag(L + SS_CM, 32 * ylh + r, 272, 16 * ks + 8 * h);
            const float cuml = SC[32 * ylh + r], ecl = SC[192 + 32 * ylh + r];
            bf16x8 wf[2][2];
#pragma unroll
            for (int sh = 0; sh < 2; ++sh) {
                if (sh <= ylh) {
                    f32x16 ga;
#pragma unroll
                    for (int i = 0; i < 16; ++i) ga[i] = 0.f;
#pragma unroll
                    for (int ks = 0; ks < 8; ++ks) ga = MFMA32(lds_frag(L + SS_BM, 32 * sh + r, 272, 16 * ks + 8 * h), cf[ks], ga);
                    float wv[16];
#pragma unroll
                    for (int reg = 0; reg < 16; ++reg) {
                        const int s = 32 * sh + crow(reg, h), ll = 32 * ylh + r;
                        const float cs = SC[s], ds = SC[64 + s];
                        float w = (s <= ll) ? ga[reg] * __builtin_amdgcn_exp2f(1.4426950408889634f * (cuml - cs)) * ds : 0.f;
                        if (s == ll) w += Dh;
                        wv[reg] = w;
                    }
#pragma unroll
                    for (int s2 = 0; s2 < 2; ++s2) {
                        u32x4 p; p.x = cvt_pk_bf16(wv[8 * s2], wv[8 * s2 + 1]); p.y = cvt_pk_bf16(wv[8 * s2 + 2], wv[8 * s2 + 3]); p.z = cvt_pk_bf16(wv[8 * s2 + 4], wv[8 * s2 + 5]); p.w = cvt_pk_bf16(wv[8 * s2 + 6], wv[8 * s2 + 7]);
                        wf[sh][s2] = __builtin_bit_cast(bf16x8, p);
                    }
                }
            }
            f32x16 ya;
#pragma unroll
            for (int i = 0; i < 16; ++i) ya[i] = 0.f;
#pragma unroll
            for (int ks = 0; ks < 8; ++ks) ya = MFMA32(lds_frag(HAc, 32 * yph + r, 272, 16 * ks + 8 * h), cf[ks], ya);
#pragma unroll
            for (int i = 0; i < 16; ++i) ya[i] *= ecl;
#pragma unroll
            for (int sh = 0; sh < 2; ++sh) {
                if (sh <= ylh) {
#pragma unroll
                    for (int s2 = 0; s2 < 2; ++s2) {
                        const LAS unsigned char* xp = L + SS_XST + (32 * yph + r) * 144 + (32 * sh + 16 * s2 + 4 * h) * 2;
                        const u32x2 lo = *(const LAS u32x2*)(xp), hi = *(const LAS u32x2*)(xp + 16);
                        u32x4 a; a.x = lo.x; a.y = lo.y; a.z = hi.x; a.w = hi.y;
                        ya = MFMA32(__builtin_bit_cast(bf16x8, a), wf[sh][s2], ya);
                    }
                }
            }
            float ss = 0.f;
            bf16_t* zp = PJ + (size_t)(row0 + t0 + 32 * ylh + r) * PJW + C_Z + hd * 64 + 32 * yph + 4 * h;
#pragma unroll
            for (int gq = 0; gq < 4; ++gq) {
                const u32x2 zz = *(const LAS u32x2*)(L + SS_Z + (2 * yph + ylh) * 2048 + r * 64 + (8 * gq + 4 * h) * 2);
                const float z0 = __uint_as_float(zz.x << 16), z1 = __uint_as_float(zz.x & 0xffff0000u), z2 = __uint_as_float(zz.y << 16), z3 = __uint_as_float(zz.y & 0xffff0000u);
                const float y0 = ya[4 * gq] * fast_silu(z0), y1 = ya[4 * gq + 1] * fast_silu(z1), y2 = ya[4 * gq + 2] * fast_silu(z2), y3 = ya[4 * gq + 3] * fast_silu(z3);
                ss += (y0 * y0 + y1 * y1) + (y2 * y2 + y3 * y3);
                u32x2 w; w.x = cvt_pk_bf16(y0, y1); w.y = cvt_pk_bf16(y2, y3);
                *(u32x2*)(zp + 8 * gq) = w;
            }
            ss = xor32_sum(ss);
            if (h == 0) { float* q = C.ssq() + (size_t)(row0 + t0 + 32 * ylh + r) * 64 + hd * 4 + yph; q[0] = ss; q[2] = 0.f; }
            LDS_FENCE();
            if (c + 1 < NC) SSD_DMA_Z(c + 1);
        } else {
            if (wave == 7 && c + 1 < NC) SSD_S0(c + 1);
            const float decay = SC[192 + 63];
#pragma unroll
            for (int i = 0; i < 16; ++i) { hacc0[i] *= decay; hacc1[i] *= decay; }
#pragma unroll
            for (int ks = 0; ks < 4; ++ks) {
                const bf16x8 xb = lds_frag(L + SS_XST, 32 * sph + r, 144, 16 * ks + 8 * h);
                hacc0 = MFMA32(lds_frag(L + SS_BWT, 32 * nq0 + r, 144, 16 * ks + 8 * h), xb, hacc0);
                hacc1 = MFMA32(lds_frag(L + SS_BWT, 32 * (nq0 + 1) + r, 144, 16 * ks + 8 * h), xb, hacc1);
            }
            LAS unsigned char* HAn = L + SS_HA + (par ^ 1) * (64 * 272);
#pragma unroll
            for (int gq = 0; gq < 4; ++gq) {
                u32x2 w0, w1; w0.x = cvt_pk_bf16(hacc0[4 * gq], hacc0[4 * gq + 1]); w0.y = cvt_pk_bf16(hacc0[4 * gq + 2], hacc0[4 * gq + 3]);
                w1.x = cvt_pk_bf16(hacc1[4 * gq], hacc1[4 * gq + 1]); w1.y = cvt_pk_bf16(hacc1[4 * gq + 2], hacc1[4 * gq + 3]);
                *(LAS u32x2*)(HAn + (32 * sph + r) * 272 + (32 * nq0 + 8 * gq + 4 * h) * 2) = w0;
                *(LAS u32x2*)(HAn + (32 * sph + r) * 272 + (32 * (nq0 + 1) + 8 * gq + 4 * h) * 2) = w1;
            }
        }
        if (l == 0) PROBE_END(11, C);
    }
    if (wave >= 4) {
        float* o = out_sh(C, l, sb) + ((size_t)hd * 64 + 32 * sph + r) * 128;
#pragma unroll
        for (int gq = 0; gq < 4; ++gq) {
            f32x4 v0, v1;
#pragma unroll
            for (int e = 0; e < 4; ++e) { v0[e] = hacc0[4 * gq + e]; v1[e] = hacc1[4 * gq + e]; }
            *(f32x4*)(o + 32 * nq0 + 8 * gq + 4 * h) = v0; *(f32x4*)(o + 32 * (nq0 + 1) + 8 * gq + 4 * h) = v1;
        }
    }
    __syncthreads();
#undef SSD_DMA_RAW
#undef SSD_DMA_Z
#undef SSD_S0
}

DI unsigned mono_key(float f) { const unsigned u = __float_as_uint(f); return (u & 0x80000000u) ? ~u : (u | 0x80000000u); }
DI int t5_bucket(int rel) {
    const int n = rel < 0 ? -rel : rel; int b;
    if (n < 8) b = n; else if (n < 12) b = 8; else if (n < 16) b = 9; else if (n < 23) b = 10; else if (n < 32) b = 11; else if (n < 46) b = 12; else if (n < 64) b = 13; else if (n < 91) b = 14; else b = 15;
    return b + (rel > 0 ? 16 : 0);
}
DI void attn_item_naive(const Ctx& C, int l, int m, LAS unsigned char* scr) {
    const int lane = C.lane;
    int sb, t; row_sbt(m, sb, t);
    const int P = sb_P(sb), posq = P + t, Ladm = 64 * ((posq >> 6) + 1), nsel = Ladm < 256 ? Ladm : 256;
    LAS unsigned* keys = (LAS unsigned*)scr; LAS unsigned* sel = keys + 2048; LAS float* qs = (LAS float*)(sel + 256); LAS float* ps = qs + 64; LAS float* qis = ps + 256;
    bf16_t* PJ = C.proj(); const bf16_t* KV = C.kvb(l) + kvb_off(sb);
    const size_t rb = (size_t)m * PJW;
#pragma unroll
    for (int j = 0; j < 4; ++j) qis[64 * j + lane] = bf2f(PJ[rb + C_QI + 64 * j + lane]);
    LDS_FENCE();
    const float w0 = C.wi()[(size_t)m * 4 + 0], w1 = C.wi()[(size_t)m * 4 + 1], w2 = C.wi()[(size_t)m * 4 + 2], w3 = C.wi()[(size_t)m * 4 + 3];
    for (int s = lane; s < Ladm; s += 64) {
        asm volatile("" ::: "memory");
        const bf16_t* kp = KV + (size_t)s * KVW + 256;
        float d0 = 0.f, d1 = 0.f, d2 = 0.f, d3 = 0.f;
#pragma unroll
        for (int d = 0; d < 64; d += 8) {
            const bf16x8 kv8 = *(const bf16x8*)(kp + d);
#pragma unroll
            for (int j = 0; j < 8; ++j) { const float kf = bf2f((bf16_t)kv8[j]); d0 += qis[d + j] * kf; d1 += qis[64 + d + j] * kf; d2 += qis[128 + d + j] * kf; d3 += qis[192 + d + j] * kf; }
            asm volatile("" ::: "memory");
        }
        const float score = ((w0 * fmaxf(d0, 0.f) + w1 * fmaxf(d1, 0.f)) + w2 * fmaxf(d2, 0.f)) + w3 * fmaxf(d3, 0.f);
        keys[s] = mono_key(score);
    }
    LDS_FENCE();
    for (int s = lane; s < Ladm; s += 64) {
        const unsigned km = keys[s]; int cnt = 0;
        for (int sp = 0; sp < Ladm; sp += 4) {
            const u32x4 kq = *(const LAS u32x4*)(keys + sp);
            cnt += (kq.x > km) | ((kq.x == km) & (sp < s));
            cnt += (kq.y > km) | ((kq.y == km) & (sp + 1 < s));
            cnt += (kq.z > km) | ((kq.z == km) & (sp + 2 < s));
            cnt += (kq.w > km) | ((kq.w == km) & (sp + 3 < s));
        }
        if (cnt < 256) sel[cnt] = (unsigned)s;
    }
    LDS_FENCE();
    for (int hq = 0; hq < 8; ++hq) {
        const int kvh = hq >> 2;
        { const float raw = bf2f(PJ[rb + C_Q + hq * 64 + lane]); const float ss = wave_sum(raw * raw);
          qs[lane] = raw * rsqrtf(ss * (1.f / 64.f) + EPS) * C.inp(18)[l * 64 + lane]; }
        LDS_FENCE();
        float lg[4]; float mx = -INFINITY;
#pragma unroll
        for (int i = 0; i < 4; ++i) {
            const int j = lane + 64 * i; lg[i] = -INFINITY;
            asm volatile("" ::: "memory");
            if (j < nsel) {
                const int s = (int)sel[j]; const bf16_t* kp = KV + (size_t)s * KVW + kvh * 64; float dot = 0.f;
#pragma unroll
                for (int d = 0; d < 64; d += 8) { const bf16x8 kv8 = *(const bf16x8*)(kp + d);
#pragma unroll
                    for (int jj = 0; jj < 8; ++jj) dot += qs[d + jj] * bf2f((bf16_t)kv8[jj]); }
                lg[i] = dot * 0.125f + C.inp(20)[t5_bucket(s - posq) * 8 + hq];
                mx = fmaxf(mx, lg[i]);
            }
        }
        mx = wave_max(mx);
        float sum = 0.f;
#pragma unroll
        for (int i = 0; i < 4; ++i) { const int j = lane + 64 * i; if (j < nsel) { lg[i] = expf(lg[i] - mx); sum += lg[i]; } }
        sum = wave_sum(sum); const float inv = 1.f / sum;
#pragma unroll
        for (int i = 0; i < 4; ++i) { const int j = lane + 64 * i; if (j < nsel) ps[j] = lg[i] * inv; }
        LDS_FENCE();
        float o = 0.f;
        for (int j = 0; j < nsel; ++j) o += ps[j] * bf2f(KV[(size_t)sel[j] * KVW + 128 + kvh * 64 + lane]);
        const float ga = bf2f(PJ[rb + C_GA + hq * 64 + lane]);
        PJ[rb + C_GA + hq * 64 + lane] = f2bf(o * silu_f(ga));
        LDS_FENCE();
    }
}

constexpr int AT_MASK = 0;
constexpr int AT_TMASK = AT_MASK + 64 * 65 * 4;
constexpr int AT_QST = AT_TMASK + 64 * 65 * 4;
constexpr int AT_MISC = AT_QST + 1024;
constexpr int AT_LUT = AT_MISC + 64;
constexpr int AT_HIST = AT_LUT + 8192;
constexpr int AT_RING = AT_HIST;
constexpr int AT_QI = AT_HIST + 65792;
constexpr int AT_END = AT_QI + 64 * 528;
static_assert(AT_END <= LDS_BYTES - 256 && AT_RING + 65536 <= AT_END, "attention LDS map");
typedef short v4i16_t __attribute__((ext_vector_type(4)));
DI float max3f(float a, float b, float c) { float r; asm("v_max3_f32 %0, %1, %2, %3" : "=v"(r) : "v"(a), "v"(b), "v"(c)); return r; }
#define AT_WAIT_V(n) asm volatile("s_waitcnt vmcnt(" #n ")" ::: "memory")
#define AT_BAR() do { asm volatile("s_waitcnt lgkmcnt(0)" ::: "memory"); __builtin_amdgcn_s_barrier(); asm volatile("" ::: "memory"); } while (0)

template <int MODE, bool FIRST>
DI void idx_pass(const Ctx& C, const bf16_t* KV, const float (&w4)[4], int ntiles, int tq4, int qh, int r, int h) {
    LAS unsigned char* L = C.lds;
    const int q = 32 * qh + r, lane = 32 * h + r;
    const LAS unsigned* QS = (const LAS unsigned*)(L + AT_QST) + 4 * q;
    const unsigned pfx = QS[0], info = QS[1];
    const int lvl = info & 15; const bool done = (info >> 4) & 1, tie = (info >> 5) & 1;
    const int sh = (MODE == 0) ? (lvl == 0 ? 23 : (lvl == 1 ? 14 : (lvl == 2 ? 5 : 0))) : (int)(info >> 8);
    const unsigned bmask = (lvl == 3) ? 31u : 511u;
    const int psh = (lvl == 1) ? 23 : (lvl == 2 ? 14 : 5);
    unsigned* KS = C.keys();
    bf16x8 an[2][4];
    if (FIRST && tq4 < ntiles) {
#pragma unroll
        for (int kh = 0; kh < 2; ++kh)
#pragma unroll
            for (int ks = 0; ks < 4; ++ks) an[kh][ks] = *(const bf16x8*)(KV + (size_t)(64 * tq4 + 32 * kh + r) * KVW + 256 + 8 * h + 16 * ks);
    }
    for (int t = tq4; t < ntiles; t += 4) {
        bf16x8 ac[2][4];
        if (FIRST) {
#pragma unroll
            for (int kh = 0; kh < 2; ++kh)
#pragma unroll
                for (int ks = 0; ks < 4; ++ks) ac[kh][ks] = an[kh][ks];
            if (t + 4 < ntiles) {
#pragma unroll
                for (int kh = 0; kh < 2; ++kh)
#pragma unroll
                    for (int ks = 0; ks < 4; ++ks) an[kh][ks] = *(const bf16x8*)(KV + (size_t)(64 * (t + 4) + 32 * kh + r) * KVW + 256 + 8 * h + 16 * ks);
            }
        }
#pragma unroll
        for (int kh = 0; kh < 2; ++kh) {
            unsigned* kslot = KS + (size_t)((t * 2 + kh) * 2 + qh) * 1024 + lane;
            unsigned key[16];
            if (FIRST) {
                float sc[16];
#pragma unroll
                for (int i = 0; i < 16; ++i) sc[i] = 0.f;
#pragma unroll
                for (int hh = 0; hh < 4; ++hh) {
                    f32x16 acc;
#pragma unroll
                    for (int i = 0; i < 16; ++i) acc[i] = 0.f;
#pragma unroll
                    for (int ks = 0; ks < 4; ++ks) acc = MFMA32(ac[kh][ks], *(const LAS bf16x8*)(L + AT_QI + q * 528 + (64 * hh + 16 * ks + 8 * h) * 2), acc);
#pragma unroll
                    for (int i = 0; i < 16; ++i) sc[i] += w4[hh] * fmaxf(acc[i], 0.f);
                }
#pragma unroll
                for (int i = 0; i < 16; ++i) { key[i] = mono_key(sc[i]); kslot[64 * i] = key[i]; }
            } else {
#pragma unroll
                for (int i = 0; i < 16; ++i) key[i] = __hip_atomic_load(kslot + 64 * i, __ATOMIC_RELAXED, __HIP_MEMORY_SCOPE_AGENT);
            }
            if (MODE == 0) {
                if (!done) {
                    LAS unsigned* HR = (LAS unsigned*)(L + AT_HIST) + 257 * q;
#pragma unroll
                    for (int i = 0; i < 16; ++i) {
                        const bool part = (lvl == 0) || ((key[i] >> psh) == pfx);
                        if (part) { const unsigned bin = (key[i] >> sh) & bmask; atomicAdd((unsigned*)(HR + (bin >> 1)), 1u << ((bin & 1u) << 4)); }
                    }
                }
            } else {
                unsigned mw = 0u, tw = 0u;
#pragma unroll
                for (int i = 15; i >= 0; --i) {
                    const bool sel = tie ? (key[i] > pfx) : ((key[i] >> sh) >= pfx);
                    const bool tb = tie && (key[i] == pfx);
                    mw = (mw << 1) | (sel ? 1u : 0u); tw = (tw << 1) | (tb ? 1u : 0u);
                    if ((i & 3) == 0 && i > 0) { mw <<= 4; tw <<= 4; }
                }
                mw <<= 4 * h; tw <<= 4 * h;
                if (mw) atomicOr((unsigned*)((LAS unsigned*)(L + AT_MASK) + 65 * q + 2 * t + kh), mw);
                if (tw) atomicOr((unsigned*)((LAS unsigned*)(L + AT_TMASK) + 65 * q + 2 * t + kh), tw);
            }
        }
    }
    if (FIRST) asm volatile("s_waitcnt vmcnt(0)" ::: "memory");
}

DI void attn_item(const Ctx& C, int l, int sb, int qb) {
    const int tid = C.tid, lane = C.lane, wave = C.wave, r = lane & 31, h = lane >> 5;
    LAS unsigned char* L = C.lds;
    const int P = sb_P(sb), row0 = sb_row0(sb), t0 = 64 * qb, pos0 = P + t0;
    const int ntiles = (pos0 >> 6) + 1, Ladm = 64 * ntiles;
    bf16_t* PJ = C.proj(); const bf16_t* KV = C.kvb(l) + kvb_off(sb);
    LAS unsigned* MASK = (LAS unsigned*)(L + AT_MASK); LAS unsigned* TMASK = (LAS unsigned*)(L + AT_TMASK);
    LAS unsigned* QST = (LAS unsigned*)(L + AT_QST); LAS unsigned* MISC = (LAS unsigned*)(L + AT_MISC);
#ifdef PROBE_QB
    const bool pcond = (l == 0 && sb == 0 && qb == PROBE_QB);
#else
    const bool pcond = false;
#endif
    PROBE_BEGIN(40); PROBE_BEGIN(41);
    for (int i = tid; i < 64 * 65; i += NTHREADS) { const int w = i % 65; MASK[i] = (Ladm <= 256 && w < 2 * ntiles) ? 0xffffffffu : 0u; TMASK[i] = 0u; }
    for (int i = tid; i < 64 * 257; i += NTHREADS) ((LAS unsigned*)(L + AT_HIST))[i] = 0u;
    if (tid < 64) { unsigned k256 = 256u; asm volatile("" : "+v"(k256)); QST[4 * tid] = 0u; QST[4 * tid + 1] = 0u; QST[4 * tid + 2] = k256; QST[4 * tid + 3] = 0u; }
    for (int i = tid; i < 8 * 256; i += NTHREADS) { const int hq = i >> 8, rel = (i & 255) - 191; ((LAS float*)(L + AT_LUT))[i] = 1.4426950408889634f * (C.inp(20)[t5_bucket(rel) * 8 + hq] - C.inp(20)[15 * 8 + hq]); }
    if (tid == 0) MISC[0] = 0u;
    __syncthreads();
    if (pcond) PROBE_END(41, C);
    PROBE_BEGIN(4); PROBE_BEGIN(42);
    if (Ladm > 256) {
        const int qh = wave & 1, tq4 = wave >> 1, q = 32 * qh + r;
        float w4[4];
        { const f32x4 wv = *(const f32x4*)(C.wi() + (size_t)(row0 + t0 + q) * 4); w4[0] = wv[0]; w4[1] = wv[1]; w4[2] = wv[2]; w4[3] = wv[3]; }
        for (int i = tid; i < 2048; i += NTHREADS) { const int qq = i >> 5, pc = i & 31;
            *(LAS u32x4*)(L + AT_QI + qq * 528 + pc * 16) = *(const u32x4*)(PJ + (size_t)(row0 + t0 + qq) * PJW + C_QI + 8 * pc); }
        __syncthreads();
        for (int lvl = 0; lvl < 4; ++lvl) {
            PROBE_BEGIN(20);
            if (lvl == 0) idx_pass<0, true>(C, KV, w4, ntiles, tq4, qh, r, h); else idx_pass<0, false>(C, KV, w4, ntiles, tq4, qh, r, h);
            if (tid == 0) MISC[0] = 0u;
            __syncthreads();
            if (l == 0) PROBE_END(20, C);
            PROBE_BEGIN(21);
            int ln = lane; asm volatile("" : "+v"(ln));
            for (int qq = 8 * wave; qq < 8 * wave + 8; ++qq) {
                const unsigned pfx = QST[4 * qq], info = QST[4 * qq + 1], need = QST[4 * qq + 2];
                if ((info >> 4) & 1) continue;
                LAS unsigned* HR = (LAS unsigned*)(L + AT_HIST) + 257 * qq + 4 * ln;
                unsigned c[8];
#pragma unroll
                for (int j = 0; j < 4; ++j) { const unsigned wv = HR[j]; c[2 * j] = wv & 0xffffu; c[2 * j + 1] = wv >> 16; HR[j] = 0u; }
                unsigned ct = 0u;
#pragma unroll
                for (int j = 0; j < 8; ++j) ct += c[j];
                unsigned S = ct;
#pragma unroll
                for (int o = 1; o < 64; o <<= 1) { const unsigned y = (unsigned)__builtin_amdgcn_ds_bpermute((ln + o) << 2, (int)S); if (ln + o < 64) S += y; }
                if (S >= need && (S - ct) < need) {
                    unsigned rem = need - (S - ct), cum = 0u; int b = 0; unsigned cb = 0u;
                    bool found = false;
#pragma unroll
                    for (int j = 7; j >= 0; --j) { if (!found) { if (cum + c[j] >= rem) { b = j; cb = c[j]; found = true; } else cum += c[j]; } }
                    const unsigned need2 = rem - cum, binidx = 8u * ln + (unsigned)b;
                    const int bits = (lvl == 3) ? 5 : 9, shc = (lvl == 0) ? 23 : (lvl == 1 ? 14 : (lvl == 2 ? 5 : 0));
                    const unsigned npfx = (lvl == 0) ? binidx : ((pfx << bits) | binidx);
                    unsigned ninfo, nneed = need2, opfx = npfx;
                    if (need2 == cb) ninfo = (unsigned)lvl | 16u | ((unsigned)shc << 8);
                    else if (lvl == 0 && (binidx == 256u || binidx == 255u)) { ninfo = 16u | 32u; opfx = (binidx == 256u) ? 0x80000000u : 0x7fffffffu; }
                    else if (lvl == 3) ninfo = 16u | 32u;
                    else { ninfo = (unsigned)(lvl + 1); atomicAdd((unsigned*)MISC, 1u); }
                    QST[4 * qq] = opfx; QST[4 * qq + 1] = ninfo; QST[4 * qq + 2] = nneed;
                }
            }
            __syncthreads();
            if (l == 0) PROBE_END(21, C);
            if (MISC[0] == 0u) break;
            __syncthreads();
        }
        PROBE_BEGIN(22);
        idx_pass<1, false>(C, KV, w4, ntiles, tq4, qh, r, h);
        __syncthreads();
        if (l == 0) PROBE_END(22, C);
        PROBE_BEGIN(23);
        int ln2 = lane; asm volatile("" : "+v"(ln2));
        for (int qq = 8 * wave; qq < 8 * wave + 8; ++qq) {
            if (!((QST[4 * qq + 1] >> 5) & 1)) continue;
            const unsigned mwd = (ln2 < 2 * ntiles) ? MASK[65 * qq + ln2] : 0u, twd = (ln2 < 2 * ntiles) ? TMASK[65 * qq + ln2] : 0u;
            int have = __popc(mwd);
#pragma unroll
            for (int o = 1; o < 64; o <<= 1) have += __builtin_amdgcn_ds_bpermute((ln2 ^ o) << 2, have);
            const int want = 256 - have, pc = __popc(twd);
            int incl = pc;
#pragma unroll
            for (int o = 1; o < 64; o <<= 1) { const int y = __builtin_amdgcn_ds_bpermute((ln2 - o) << 2, incl); if (ln2 >= o) incl += y; }
            int take = want - (incl - pc); take = take < 0 ? 0 : (take > pc ? pc : take);
            unsigned wrem = twd, add = 0u;
            for (int k = 0; k < take; ++k) { add |= wrem & (0u - wrem); wrem &= wrem - 1u; }
            if (add) MASK[65 * qq + ln2] = mwd | add;
        }
        __syncthreads();
        if (l == 0) PROBE_END(23, C);
    }
    if (l == 0) PROBE_END(4, C);
    if (pcond) PROBE_END(42, C);
    PROBE_BEGIN(43);
    PROBE_BEGIN(5);
    const int hq = wave, kvh = wave >> 2;
    const unsigned ring = (unsigned)(size_t)(L + AT_RING);
    const float* LUT = nullptr; (void)LUT;
    const LAS float* lut = (const LAS float*)(L + AT_LUT) + 256 * hq;
    const float cfar = 1.4426950408889634f * C.inp(20)[15 * 8 + hq];
#define AT_DMA(tt, slot) do { const bf16_t* src_ = KV + (size_t)(64 * (tt)) * KVW; \
        _Pragma("unroll") for (int i_ = 0; i_ < 2; ++i_) { const int k_ = wave * 2 + i_, row_ = 4 * k_ + (lane >> 4), pc_ = lane & 15; \
            __builtin_amdgcn_global_load_lds((const unsigned*)(src_ + (size_t)row_ * KVW + 8 * (pc_ ^ (row_ & 15))), (LAS unsigned*)(L + AT_RING + (slot) * 32768 + k_ * 1024), 16, 0, 0); \
            __builtin_amdgcn_global_load_lds((const unsigned*)(src_ + (size_t)row_ * KVW + 128 + 8 * pc_), (LAS unsigned*)(L + AT_RING + (slot) * 32768 + 16384 + k_ * 1024), 16, 0, 0); } \
    } while (0)
    bf16x8 qfA[4], qfB[4];
#pragma unroll
    for (int qh = 0; qh < 2; ++qh) {
        const bf16_t* qp = PJ + (size_t)(row0 + t0 + 32 * qh + r) * PJW + C_Q + hq * 64 + 8 * h; float qv[4][8]; float ss = 0.f;
#pragma unroll
        for (int ks = 0; ks < 4; ++ks) { const u32x4 v = *(const u32x4*)(qp + 16 * ks);
            qv[ks][0] = __uint_as_float(v.x << 16); qv[ks][1] = __uint_as_float(v.x & 0xffff0000u); qv[ks][2] = __uint_as_float(v.y << 16); qv[ks][3] = __uint_as_float(v.y & 0xffff0000u);
            qv[ks][4] = __uint_as_float(v.z << 16); qv[ks][5] = __uint_as_float(v.z & 0xffff0000u); qv[ks][6] = __uint_as_float(v.w << 16); qv[ks][7] = __uint_as_float(v.w & 0xffff0000u);
#pragma unroll
            for (int j = 0; j < 8; ++j) ss += qv[ks][j] * qv[ks][j]; }
        ss = xor32_sum(ss);
        const float sc = rsqrtf(ss * (1.f / 64.f) + EPS) * (0.125f * 1.4426950408889634f);
        const float* qn = C.inp(18) + l * 64 + 8 * h;
#pragma unroll
        for (int ks = 0; ks < 4; ++ks) { const f32x4 n0 = *(const f32x4*)(qn + 16 * ks), n1 = *(const f32x4*)(qn + 16 * ks + 4);
            u32x4 p; p.x = cvt_pk_bf16(qv[ks][0] * sc * n0[0], qv[ks][1] * sc * n0[1]); p.y = cvt_pk_bf16(qv[ks][2] * sc * n0[2], qv[ks][3] * sc * n0[3]);
            p.z = cvt_pk_bf16(qv[ks][4] * sc * n1[0], qv[ks][5] * sc * n1[1]); p.w = cvt_pk_bf16(qv[ks][6] * sc * n1[2], qv[ks][7] * sc * n1[3]);
            if (qh == 0) qfA[ks] = __builtin_bit_cast(bf16x8, p); else qfB[ks] = __builtin_bit_cast(bf16x8, p); }
    }
    f32x16 oA0, oA1, oB0, oB1;
#pragma unroll
    for (int i = 0; i < 16; ++i) { oA0[i] = 0.f; oA1[i] = 0.f; oB0[i] = 0.f; oB1[i] = 0.f; }
    float mrefA = 0.f, lrunA = 0.f, mrefB = 0.f, lrunB = 0.f;
#define AT_HALF(QF, QQ, MREF, LRUN, O0, O1, PW) do { \
        f32x16 s0, s1; { const float ini = cfar - MREF; _Pragma("unroll") for (int i = 0; i < 16; ++i) { s0[i] = ini; s1[i] = ini; } } \
        _Pragma("unroll") for (int ks = 0; ks < 4; ++ks) { s0 = MFMA32(kf0[ks], QF[ks], s0); s1 = MFMA32(kf1[ks], QF[ks], s1); } \
        const int nm0 = (int)(~(MASK[65 * (QQ) + 2 * t] >> (4 * h))), nm1 = (int)(~(MASK[65 * (QQ) + 2 * t + 1] >> (4 * h))); \
        if (nearb) { _Pragma("unroll") for (int i = 0; i < 16; ++i) { const int kl = (i & 3) + 8 * (i >> 2), rel = 64 * t + kl + 4 * h - (pos0 + (QQ)); s0[i] += lut[rel + 191]; s1[i] += lut[rel + 32 + 191]; } } \
        _Pragma("unroll") for (int i = 0; i < 16; ++i) { const int kl = (i & 3) + 8 * (i >> 2); \
            s0[i] += __int_as_float(__builtin_amdgcn_sbfe(nm0, kl, 1) & (int)0xff800000u); s1[i] += __int_as_float(__builtin_amdgcn_sbfe(nm1, kl, 1) & (int)0xff800000u); } \
        float tm; { float a = max3f(s0[0], s0[1], s1[0]), b = max3f(s0[2], s0[3], s1[1]); a = max3f(a, s1[2], s1[3]); \
            _Pragma("unroll") for (int i = 4; i < 16; i += 4) { a = max3f(a, s0[i], s0[i + 1]); b = max3f(b, s0[i + 2], s0[i + 3]); a = max3f(a, s1[i], s1[i + 1]); b = max3f(b, s1[i + 2], s1[i + 3]); } \
            tm = xor32_max(fmaxf(a, b)); } \
        if (__builtin_amdgcn_ballot_w64(tm > 0.f) != 0ull) { const float dl = fmaxf(tm, 0.f), al = __builtin_amdgcn_exp2f(-dl); MREF += dl; LRUN *= al; \
            _Pragma("unroll") for (int i = 0; i < 16; ++i) { s0[i] -= dl; s1[i] -= dl; O0[i] *= al; O1[i] *= al; } } \
        float psum = 0.f; \
        _Pragma("unroll") for (int i = 0; i < 16; ++i) { s0[i] = __builtin_amdgcn_exp2f(s0[i]); s1[i] = __builtin_amdgcn_exp2f(s1[i]); psum += s0[i] + s1[i]; } \
        LRUN += psum; \
        _Pragma("unroll") for (int kk = 0; kk < 2; ++kk) { u32x4 w0, w1; \
            w0.x = cvt_pk_bf16(s0[8 * kk], s0[8 * kk + 1]); w0.y = cvt_pk_bf16(s0[8 * kk + 2], s0[8 * kk + 3]); w0.z = cvt_pk_bf16(s0[8 * kk + 4], s0[8 * kk + 5]); w0.w = cvt_pk_bf16(s0[8 * kk + 6], s0[8 * kk + 7]); \
            w1.x = cvt_pk_bf16(s1[8 * kk], s1[8 * kk + 1]); w1.y = cvt_pk_bf16(s1[8 * kk + 2], s1[8 * kk + 3]); w1.z = cvt_pk_bf16(s1[8 * kk + 4], s1[8 * kk + 5]); w1.w = cvt_pk_bf16(s1[8 * kk + 6], s1[8 * kk + 7]); \
            PW[kk] = __builtin_bit_cast(bf16x8, w0); PW[2 + kk] = __builtin_bit_cast(bf16x8, w1); } \
    } while (0)
    AT_WAIT_V(0);
    AT_DMA(0, 0);
    if (ntiles > 1) AT_DMA(1, 1);
    int sl = 0, sl2 = 2;
    for (int t = 0; t < ntiles; ++t) {
        if (t + 1 < ntiles) { AT_WAIT_V(4); } else { AT_WAIT_V(0); }
        AT_BAR();
        if (t + 2 < ntiles) AT_DMA(t + 2, sl2);
        const LAS unsigned char* Kt = L + AT_RING + sl * 32768; const LAS unsigned char* Vt = Kt + 16384;
        bf16x8 kf0[4], kf1[4];
#pragma unroll
        for (int ks = 0; ks < 4; ++ks) { const int pc = kvh * 8 + 2 * ks + h;
            kf0[ks] = *(const LAS bf16x8*)(Kt + r * 256 + ((pc ^ (r & 15)) << 4)); kf1[ks] = *(const LAS bf16x8*)(Kt + (32 + r) * 256 + ((pc ^ (r & 15)) << 4)); }
        const bool nearb = (t + 3 > ntiles - 1);
        bf16x8 pA[4], pB[4];
        AT_HALF(qfA, r, mrefA, lrunA, oA0, oA1, pA);
        AT_HALF(qfB, 32 + r, mrefB, lrunB, oB0, oB1, pB);
#pragma unroll
        for (int kk = 0; kk < 4; ++kk) {
            const int i16 = lane & 15, key0 = 16 * kk + 4 * h + (i16 >> 2);
#pragma unroll
            for (int dh = 0; dh < 2; ++dh) {
                const int dcol = kvh * 64 + 32 * dh + 16 * ((lane >> 4) & 1) + 4 * (i16 & 3);
                const v4i16_t lo = __builtin_amdgcn_ds_read_tr16_b64_v4i16((LAS v4i16_t*)(Vt + key0 * 256 + dcol * 2));
                const v4i16_t hi = __builtin_amdgcn_ds_read_tr16_b64_v4i16((LAS v4i16_t*)(Vt + (key0 + 8) * 256 + dcol * 2));
                const bf16x8 va = (bf16x8){lo[0], lo[1], lo[2], lo[3], hi[0], hi[1], hi[2], hi[3]};
                if (dh == 0) { oA0 = MFMA32(va, pA[kk], oA0); oB0 = MFMA32(va, pB[kk], oB0); } else { oA1 = MFMA32(va, pA[kk], oA1); oB1 = MFMA32(va, pB[kk], oB1); }
            }
        }
        sl2 = sl; sl = (sl == 2) ? 0 : sl + 1; sl2 = (sl == 0) ? 2 : sl - 1;
    }
#undef AT_HALF
#pragma unroll
    for (int qh = 0; qh < 2; ++qh) {
        const float inv = 1.f / xor32_sum(qh == 0 ? lrunA : lrunB);
        bf16_t* gp = PJ + (size_t)(row0 + t0 + 32 * qh + r) * PJW + C_GA + hq * 64 + 4 * h;
#pragma unroll
        for (int dh = 0; dh < 2; ++dh)
#pragma unroll
            for (int gq = 0; gq < 4; ++gq) {
                const u32x2 gg = *(const u32x2*)(gp + 32 * dh + 8 * gq);
                const float g0 = __uint_as_float(gg.x << 16), g1 = __uint_as_float(gg.x & 0xffff0000u), g2 = __uint_as_float(gg.y << 16), g3 = __uint_as_float(gg.y & 0xffff0000u);
                const f32x16& oo = (qh == 0) ? (dh == 0 ? oA0 : oA1) : (dh == 0 ? oB0 : oB1);
                const float a0 = oo[4 * gq] * inv, a1 = oo[4 * gq + 1] * inv, a2 = oo[4 * gq + 2] * inv, a3 = oo[4 * gq + 3] * inv;
                u32x2 w; w.x = cvt_pk_bf16(a0 * fast_silu(g0), a1 * fast_silu(g1)); w.y = cvt_pk_bf16(a2 * fast_silu(g2), a3 * fast_silu(g3));
                *(u32x2*)(gp + 32 * dh + 8 * gq) = w;
            }
    }
#undef AT_DMA
    AT_WAIT_V(0);
    __syncthreads();
    if (l == 0) PROBE_END(5, C);
    if (pcond) { PROBE_END(43, C); PROBE_END(40, C); }
}

constexpr int LR_RAW = 0;
constexpr int LR_GL = LR_RAW + 67 * 128;
constexpr int LR_XC = LR_GL + 2 * 8192;
constexpr int LR_XCF = LR_XC + 64 * 144;
constexpr int LR_SEG = LR_XCF + 64 * 256;
constexpr int LR_YS = LR_SEG + 2048;
constexpr int LR_END = LR_YS + 8192;
static_assert(LR_END <= LDS_BYTES - 256, "LRU LDS map");
typedef float f32x4v __attribute__((ext_vector_type(4)));
#define MFMA16(a, b, c) __builtin_amdgcn_mfma_f32_16x16x32_bf16((a), (b), (c), 0, 0, 0)
DI float fast_sigmoid(float x) { return __builtin_amdgcn_rcpf(1.f + __builtin_amdgcn_exp2f(-1.4426950408889634f * x)); }

DI void lru_item(const Ctx& C, int l, int sb, int blk) {
    const int tid = C.tid, lane = C.lane, wave = C.wave, fr = lane & 15, fq = lane >> 4;
    const int T = sb_T(sb), row0 = sb_row0(sb), NC = T / 64;
    LAS unsigned char* L = C.lds;
    bf16_t* PJ = C.proj();
    const int ts = wave >> 1, dh = wave & 1;
    bf16x8 wf[2][2][2];
#pragma unroll
    for (int gt = 0; gt < 2; ++gt)
#pragma unroll
        for (int db = 0; db < 2; ++db)
#pragma unroll
            for (int kb = 0; kb < 2; ++kb) {
                const float* wp = (gt == 0 ? C.inp(13) : C.inp(15)) + ((size_t)(l * 8 + blk) * 64 + 32 * kb + 8 * fq) * 64 + 32 * dh + 16 * db + fr;
                u32x4 p; p.x = cvt_pk_bf16(wp[0], wp[64]); p.y = cvt_pk_bf16(wp[128], wp[192]); p.z = cvt_pk_bf16(wp[256], wp[320]); p.w = cvt_pk_bf16(wp[384], wp[448]);
                wf[gt][db][kb] = __builtin_bit_cast(bf16x8, p);
            }
    float ba[2], bx[2], spl[2], hc[2];
#pragma unroll
    for (int db = 0; db < 2; ++db) {
        const int ch = blk * 64 + 32 * dh + 16 * db + fr;
        ba[db] = C.inp(14)[l * 512 + ch]; bx[db] = C.inp(16)[l * 512 + ch]; spl[db] = 8.f * 1.4426950408889634f * softplus_f(-C.inp(17)[l * 512 + ch]);
        hc[db] = (sb >= NPB) ? C.inp(6)[(size_t)(l * NSB_S + sb - NPB) * 512 + ch] : 0.f;
    }
    const int cp = tid & 31, sg = tid >> 5;
    float cw[2][5];
#pragma unroll
    for (int e = 0; e < 2; ++e) { const int ch = blk * 64 + 2 * cp + e;
#pragma unroll
        for (int j = 0; j < 4; ++j) cw[e][j] = C.inp(11)[((size_t)l * 4 + j) * 512 + ch];
        cw[e][4] = C.inp(12)[l * 512 + ch]; }
#define LRU_DMA(cc) do { const int t0_ = 64 * (cc); \
        for (int k_ = wave; k_ < 9; k_ += NWAVES) { const int q_ = 64 * k_ + lane, rr_ = q_ >> 3, pc_ = q_ & 7, t_ = t0_ - 3 + rr_; \
            if (q_ < 536 && t_ >= 0) __builtin_amdgcn_global_load_lds((const unsigned*)(PJ + (size_t)(row0 + t_) * PJW + C_XL + blk * 64 + 8 * pc_), (LAS unsigned*)(L + LR_RAW + k_ * 1024), 16, 0, 0); } \
        { const int rr_ = 8 * wave + (lane >> 3), pc_ = lane & 7; \
          __builtin_amdgcn_global_load_lds((const unsigned*)(PJ + (size_t)(row0 + t0_ + rr_) * PJW + C_GL + blk * 64 + 8 * pc_), (LAS unsigned*)(L + LR_GL + ((cc) & 1) * 8192 + wave * 1024), 16, 0, 0); } \
    } while (0)
    if (tid < 24) {
        const int rr = tid >> 3, pc = tid & 7; u32x4 v = (u32x4){0u, 0u, 0u, 0u};
        if (sb >= NPB) { const float* st = C.inp(5) + ((size_t)(l * NSB_S + sb - NPB) * 3 + rr) * 512 + blk * 64 + 8 * pc; v = pack8(*(const f32x4*)st, *(const f32x4*)(st + 4)); }
        *(LAS u32x4*)(L + LR_RAW + rr * 128 + pc * 16) = v;
    }
    LRU_DMA(0);
    asm volatile("s_waitcnt vmcnt(0)" ::: "memory");
    __syncthreads();
    for (int c = 0; c < NC; ++c) {
        const int t0 = 64 * c;
        {
            float xa[7], xb[7];
#pragma unroll
            for (int i = 0; i < 7; ++i) { const unsigned w = *(const LAS unsigned*)(L + LR_RAW + (4 * sg + i) * 128 + 4 * cp); xa[i] = __uint_as_float(w << 16); xb[i] = __uint_as_float(w & 0xffff0000u); }
#pragma unroll
            for (int j = 0; j < 4; ++j) {
                const float ya = cw[0][4] + cw[0][0] * xa[j] + cw[0][1] * xa[j + 1] + cw[0][2] * xa[j + 2] + cw[0][3] * xa[j + 3];
                const float yb = cw[1][4] + cw[1][0] * xb[j] + cw[1][1] * xb[j + 1] + cw[1][2] * xb[j + 2] + cw[1][3] * xb[j + 3];
                *(LAS unsigned*)(L + LR_XC + (4 * sg + j) * 144 + 4 * cp) = cvt_pk_bf16(ya, yb);
                f32x2_t v2 = {ya, yb}; *(LAS f32x2_t*)(L + LR_XCF + (4 * sg + j) * 256 + 8 * cp) = v2;
            }
        }
        LDS_FENCE(); __syncthreads();
        if (c + 1 < NC) LRU_DMA(c + 1);
        f32x4v ga[2], gx[2];
#pragma unroll
        for (int db = 0; db < 2; ++db) { ga[db] = (f32x4v){0.f, 0.f, 0.f, 0.f}; gx[db] = (f32x4v){0.f, 0.f, 0.f, 0.f}; }
#pragma unroll
        for (int kb = 0; kb < 2; ++kb) {
            const bf16x8 af = *(const LAS bf16x8*)(L + LR_XC + (16 * ts + fr) * 144 + (32 * kb + 8 * fq) * 2);
#pragma unroll
            for (int db = 0; db < 2; ++db) { ga[db] = MFMA16(af, wf[0][db][kb], ga[db]); gx[db] = MFMA16(af, wf[1][db][kb], gx[db]); }
        }
        float Pk[2][4], Hk[2][4], Pq[2], Hq[2];
#pragma unroll
        for (int db = 0; db < 2; ++db) {
            float P = 1.f, H = 0.f;
#pragma unroll
            for (int reg = 0; reg < 4; ++reg) {
                const float xc = *(const LAS float*)(L + LR_XCF + (16 * ts + 4 * fq + reg) * 256 + (32 * dh + 16 * db + fr) * 4);
                const float rg = fast_sigmoid(ga[db][reg] + ba[db]), ig = fast_sigmoid(gx[db][reg] + bx[db]);
                const float a = __builtin_amdgcn_exp2f(-rg * spl[db]);
                const float b = sqrtf(fmaxf(1.f - a * a, 0.f)) * (ig * xc);
                H = a * H + b; P = a * P; Pk[db][reg] = P; Hk[db][reg] = H;
            }
            float Pi = P, Hi = H;
            { const float Pp = bperm(Pi, lane - 16), Hp = bperm(Hi, lane - 16); if (fq >= 1) { Hi = Pi * Hp + Hi; Pi = Pi * Pp; } }
            { const float Pp = bperm(Pi, lane - 32), Hp = bperm(Hi, lane - 32); if (fq >= 2) { Hi = Pi * Hp + Hi; Pi = Pi * Pp; } }
            if (fq == 3) { f32x2_t v2 = {Pi, Hi}; *(LAS f32x2_t*)(L + LR_SEG + (ts * 64 + 32 * dh + 16 * db + fr) * 8) = v2; }
            const float Pe = bperm(Pi, lane - 16), He = bperm(Hi, lane - 16);
            Pq[db] = (fq >= 1) ? Pe : 1.f; Hq[db] = (fq >= 1) ? He : 0.f;
        }
        LDS_FENCE(); __syncthreads();
#pragma unroll
        for (int db = 0; db < 2; ++db) {
            float s = hc[db], sin = hc[db];
#pragma unroll
            for (int k = 0; k < 4; ++k) { const f32x2_t m = *(const LAS f32x2_t*)(L + LR_SEG + (k * 64 + 32 * dh + 16 * db + fr) * 8); if (k == ts) sin = s; s = m[0] * s + m[1]; }
            hc[db] = s;
            const float hin = Pq[db] * sin + Hq[db];
            const bf16_t* glp = nullptr; (void)glp;
#pragma unroll
            for (int reg = 0; reg < 4; ++reg) {
                const float hval = Pk[db][reg] * hin + Hk[db][reg];
                const int t = 16 * ts + 4 * fq + reg, d = 32 * dh + 16 * db + fr;
                const float glv = bf2f(*(const LAS bf16_t*)(L + LR_GL + (c & 1) * 8192 + t * 128 + d * 2));
                *(LAS bf16_t*)(L + LR_YS + t * 128 + d * 2) = f2bf(hval * fast_silu(glv));
            }
        }
        asm volatile("s_waitcnt vmcnt(0)" ::: "memory");
        LDS_FENCE(); __syncthreads();
        { const int rr = tid >> 3, pc = tid & 7;
          *(u32x4*)(PJ + (size_t)(row0 + t0 + rr) * PJW + C_GL + blk * 64 + 8 * pc) = *(const LAS u32x4*)(L + LR_YS + rr * 128 + pc * 16); }
    }
    if (ts == 0 && fq == 0) {
#pragma unroll
        for (int db = 0; db < 2; ++db) out_lh(C, l, sb)[blk * 64 + 32 * dh + 16 * db + fr] = hc[db];
    }
#undef LRU_DMA
    asm volatile("s_waitcnt vmcnt(0)" ::: "memory");
    __syncthreads();
}

DI Ctx relaunder(const Ctx& C0) {
    Ctx C = C0; int ln; asm volatile("v_mbcnt_lo_u32_b32 %0, -1, 0\n\tv_mbcnt_hi_u32_b32 %0, -1, %0" : "=v"(ln)); C.lane = ln; C.tid = C.wave * 64 + ln;
    { unsigned long long w = (unsigned long long)C.ws, o = (unsigned long long)C.out; asm volatile("" : "+s"(w), "+s"(o));
      C.ws = (unsigned char*)(__attribute__((address_space(1))) unsigned char*)w; C.out = (float*)(__attribute__((address_space(1))) float*)o; }
    asm volatile("" : "+s"(C.G), "+s"(C.bid));
    return C;
}
constexpr int CW_QUEUE = 8192;
constexpr int MX_A = 144, MX_B = MX_A + 256, MX_C0 = MX_B + 8, MX_C = MX_C0 + 240, MX_D = MX_C + 128, MX_E = MX_D + 128, MX_F = MX_E + 128, MX_N = MX_F + 64;
DI void phase_mixers(const Ctx& Cin, int l) {
    unsigned* head = (unsigned*)(Cin.ws + WS_CTL) + CW_QUEUE + 64 * l;
    volatile LAS int* slot = (volatile LAS int*)(Cin.lds + LDS_BYTES - 24);
    for (;;) {
        __syncthreads();
        if (Cin.tid == 0) *slot = (int)__hip_atomic_fetch_add(head, 1u, __ATOMIC_RELAXED, __HIP_MEMORY_SCOPE_AGENT);
        __syncthreads();
        const int i = __builtin_amdgcn_readfirstlane(*slot);
        if (i >= MX_N) break;
        const Ctx C = relaunder(Cin);
        int kind, sb, sub;
        if (i < MX_A) { kind = 0; sb = i & 15; sub = 31 - (i >> 4); }
        else if (i < MX_B) { const int j = i - MX_A; kind = 1; sb = j >> 4; sub = j & 15; }
        else if (i < MX_C0) { kind = 0; sb = NPB + (i - MX_B); sub = 0; }
        else if (i < MX_C) { const int j = i - MX_C0; kind = 0; sb = j & 15; sub = 22 - (j >> 4); }
        else if (i < MX_D) { const int j = i - MX_C; kind = 2; sb = j >> 3; sub = j & 7; }
        else if (i < MX_E) { const int j = i - MX_D; kind = 0; sb = j & 15; sub = 7 - (j >> 4); }
        else if (i < MX_F) { const int j = i - MX_E; kind = 1; sb = NPB + (j >> 4); sub = j & 15; }
        else { const int j = i - MX_F; kind = 2; sb = NPB + (j >> 3); sub = j & 7; }
        PROBE_BEGIN(50); PROBE_BEGIN(51); PROBE_BEGIN(52); PROBE_BEGIN(53);
        if (kind == 0) attn_item(C, l, sb, sub);
        else if (kind == 1) ssd_item(C, l, sb, sub);
        else lru_item(C, l, sb, sub);
        if (l == 0) { PROBE_END(50, C); if (kind == 0) PROBE_END(51, C); if (kind == 1) PROBE_END(52, C); if (kind == 2) PROBE_END(53, C); }
    }
}

#define XB_TMO      128
#define XB_XCNT(j)  (256  + 64 * (j))
#define XB_XSUB(j)  (1280 + 64 * (j))
#define XB_XGEN(j)  (2304 + 64 * (j))
#define XB_TOP      3328
#define XB_TOPGEN   3392
#define XCD_BAR_WORDS 3456
#define XB_SPIN_CAP (1u << 22)

__device__ __forceinline__ unsigned xb_ld(unsigned* p)              { return __hip_atomic_load(p, __ATOMIC_RELAXED, __HIP_MEMORY_SCOPE_AGENT); }
__device__ __forceinline__ unsigned xb_add(unsigned* p, unsigned v) { return __hip_atomic_fetch_add(p, v, __ATOMIC_RELAXED, __HIP_MEMORY_SCOPE_AGENT); }
__device__ __forceinline__ unsigned xb_xcc_id() { return (unsigned)__builtin_amdgcn_s_getreg((3 << 11) | 20) & 0xFu; }
#define XB_SPIN(cond, bar) do { unsigned _sp = 0; while (cond) { __builtin_amdgcn_s_sleep(1); \
    if ((++_sp & 255u) == 0u) { if (xb_ld(&(bar)[XB_TMO])) break; if (_sp > XB_SPIN_CAP) { atomicAdd(&(bar)[XB_TMO], 1u); break; } } } } while (0)

struct XcdBarrier {
    unsigned* bar; unsigned x;
    volatile LAS unsigned* st;
};

__device__ __forceinline__ XcdBarrier xcd_barrier_post(unsigned* bar, volatile LAS unsigned* st) {
    XcdBarrier b; b.bar = bar; b.x = xb_xcc_id(); b.st = st;
    if (threadIdx.x == 0) (void)xb_add(&bar[XB_XCNT(b.x)], 1u);
    return b;
}
__device__ __forceinline__ void xcd_barrier_complete(unsigned* bar, unsigned x, unsigned& nloc, unsigned& nx) {
    const unsigned G = gridDim.x * gridDim.y * gridDim.z;
    unsigned sum, cnt, mine, sp = 0u;
    for (;;) {
        sum = 0u; cnt = 0u; mine = 0u;
#pragma unroll
        for (unsigned j = 0; j < 16; ++j) { const unsigned c = xb_ld(&bar[XB_XCNT(j)]); sum += c; cnt += (c > 0u) ? 1u : 0u; mine = (j == x) ? c : mine; }
        if (sum == G) break;
        __builtin_amdgcn_s_sleep(1);
        if ((++sp & 255u) == 0u) { if (xb_ld(&bar[XB_TMO])) break; if (sp > XB_SPIN_CAP) { atomicAdd(&bar[XB_TMO], 1u); break; } }
    }
    nloc = mine > 0u ? mine : 1u; nx = cnt > 0u ? cnt : 1u;
}

__device__ __forceinline__ void xcd_barrier(const XcdBarrier& b) {
    asm volatile("s_waitcnt vmcnt(0)" ::: "memory");
    __syncthreads();
    if (threadIdx.x == 0) {
        unsigned* bar = b.bar;
        __builtin_amdgcn_s_waitcnt(0);
        unsigned nloc = b.st[0], nx = b.st[1];
        if (nloc == 0u) { xcd_barrier_complete(bar, b.x, nloc, nx); b.st[0] = nloc; b.st[1] = nx; }
        const unsigned old = xb_add(&bar[XB_XSUB(b.x)], 1u);
        const unsigned gen = old / nloc;
        if (old + 1u == (gen + 1u) * nloc) {
            __builtin_amdgcn_fence(__ATOMIC_RELEASE, "agent");
            asm volatile("s_waitcnt vmcnt(0)" ::: "memory");
            const unsigned og = xb_add(&bar[XB_TOP], 1u);
            const unsigned tg = og / nx;
            if (og + 1u == (tg + 1u) * nx) xb_add(&bar[XB_TOPGEN], 1u);
            else XB_SPIN(xb_ld(&bar[XB_TOPGEN]) == tg, bar);
            __builtin_amdgcn_fence(__ATOMIC_ACQUIRE, "agent");
            xb_add(&bar[XB_XGEN(b.x)], 1u);
            asm volatile("s_waitcnt vmcnt(0)" ::: "memory");
        } else {
            XB_SPIN(xb_ld(&bar[XB_XGEN(b.x)]) == gen, bar);
            __builtin_amdgcn_fence(__ATOMIC_ACQUIRE, "agent");
            asm volatile("s_waitcnt vmcnt(0)" ::: "memory");
        }
    }
    __syncthreads();
}


constexpr int PH_PER_LAYER = 4;
constexpr int N_PHASES = 1 + 2 * PH_PER_LAYER;
constexpr int CW_BAR = 4096;
__global__ void __launch_bounds__(NTHREADS, 2) mk_fwd(Args a) {
    extern __shared__ __attribute__((aligned(16))) unsigned char lds_raw[];
    Ctx C; C.out = a.out; C.ws = a.ws; C.lds = (LAS unsigned char*)lds_raw;
    C.tid = threadIdx.x; C.lane = C.tid & 63; C.wave = __builtin_amdgcn_readfirstlane(C.tid >> 6); C.G = gridDim.x; C.bid = blockIdx.x;
    if (C.tid == 0) {
#pragma unroll
        for (int i = 0; i < 28; ++i) ((LAS cfp_t*)(C.lds + LDS_BYTES - 256))[i] = a.in[i];
        ((volatile LAS unsigned*)(C.lds + LDS_BYTES - 32))[0] = 0u; ((volatile LAS unsigned*)(C.lds + LDS_BYTES - 32))[1] = 0u;
        *(LAS unsigned long long*)(C.lds + LDS_BYTES - 16) = 0ull;
    }
    __syncthreads();
    const XcdBarrier bar = xcd_barrier_post((unsigned*)(a.ws + WS_CTL) + CW_BAR, (volatile LAS unsigned*)(C.lds + LDS_BYTES - 32));
    const Ctx C0 = C;
#define LAUNDER() const Ctx C = relaunder(C0)
#ifdef PROBE_PHASE
    unsigned long long pr_t0 = 0, pr_t1 = 0;
#endif
    for (int ph = a.ph_lo; ph < a.ph_hi; ++ph) {
#ifdef PROBE_PHASE
        if (ph == PROBE_PHASE) pr_t0 = __builtin_amdgcn_s_memrealtime();
#endif
        if (ph == 0) { LAUNDER(); phase_prologue(C); }
        else {
            const int l = (ph - 1) / PH_PER_LAYER, k = (ph - 1) % PH_PER_LAYER;
            if (k == 0) { LAUNDER(); phase_inproj_gemm(C, l); }
            else if (k == 1) { LAUNDER(); phase_mixers(C, l); }
            else if (k == 2) { LAUNDER(); phase_ycnorm(C, l); if (l == 0) prep_layer(C, 1); }
            else { LAUNDER(); phase_outproj_gemm(C, l); }
        }
        if (ph + 1 < a.ph_hi) { if (ph == 0) cg::this_grid().sync(); else xcd_barrier(bar); }
#ifdef PROBE_PHASE
        if (ph == PROBE_PHASE) pr_t1 = __builtin_amdgcn_s_memrealtime();
#endif
    }
#ifdef PROBE_PHASE
#ifdef PROBE_SUB
    pr_t0 = 0; pr_t1 = *(LAS unsigned long long*)(C0.lds + LDS_BYTES - 16);
#endif
#ifndef PROBE_BLOCK
#define PROBE_BLOCK 0
#endif
    if (PROBE_BLOCK < 0 || (int)blockIdx.x == PROBE_BLOCK) { const unsigned long long te = __builtin_amdgcn_s_memrealtime(), span = 4ull * (pr_t1 - pr_t0); while (__builtin_amdgcn_s_memrealtime() - te < span) __builtin_amdgcn_s_sleep(8); }
#endif
}

extern "C" void kernel_launch(void* const* d_in, const int* in_sizes, int n_in, void* d_out, int out_size, void* d_ws, size_t ws_size, hipStream_t stream) {
    static int grid = 0;
    if (grid == 0) {
        if (n_in != 28 || (size_t)out_size != O_END || ws_size < WS_END) { fprintf(stderr, "kernel_launch: unexpected shapes n_in %d out %d ws %zu\n", n_in, out_size, ws_size); grid = -1; return; }
        int dev = 0, cus = 0, per_cu = 0;
        hipGetDevice(&dev); hipDeviceGetAttribute(&cus, hipDeviceAttributeMultiprocessorCount, dev);
        hipFuncSetAttribute((const void*)mk_fwd, hipFuncAttributeMaxDynamicSharedMemorySize, LDS_BYTES);
        hipOccupancyMaxActiveBlocksPerMultiprocessor(&per_cu, (const void*)mk_fwd, NTHREADS, LDS_BYTES);
        if (per_cu < 1) per_cu = 1;
        grid = cus * 1;
        (void)hipGetLastError();
    }
    if (grid < 0) return;
    hipMemsetAsync((char*)d_ws + WS_CTL, 0, CTL_BYTES, stream);
    Args a{};
    for (int i = 0; i < 28; ++i) a.in[i] = (const float*)d_in[i];
    a.out = (float*)d_out; a.ws = (unsigned char*)d_ws;
    a.ph_lo = 0; a.ph_hi = N_PHASES;
    void* args[] = {&a};
    hipError_t e = hipLaunchCooperativeKernel((const void*)mk_fwd, dim3(grid), dim3(NTHREADS), args, LDS_BYTES, stream);
    if (e != hipSuccess) fprintf(stderr, "cooperative launch failed: %s (grid %d)\n", hipGetErrorString(e), grid);
}
```

```cpp
#include <hip/hip_runtime.h>
#include <hip/hip_cooperative_groups.h>
#include <cstdio>
#include <cstdint>
namespace cg = cooperative_groups;

typedef unsigned short bf16_t;
typedef short bf16x8 __attribute__((ext_vector_type(8)));
typedef float f32x4 __attribute__((ext_vector_type(4)));
typedef float f32x16 __attribute__((ext_vector_type(16)));
typedef unsigned u32x4 __attribute__((ext_vector_type(4)));
typedef unsigned u32x2 __attribute__((ext_vector_type(2)));
#define LAS __attribute__((address_space(3)))
#define DI __device__ __forceinline__

constexpr int DM = 1024, NPB = 16, SEQ = 2048, NSB_S = 8, DSEQ = 64, PAST = 1024;
constexpr int ROWS_P = NPB * SEQ;
constexpr int ROWS = ROWS_P + NSB_S * DSEQ;
constexpr int NSB = NPB + NSB_S;
constexpr int DINP = 5204, NPAD = 5376;
constexpr int PJW = 4864;
constexpr int DMIX = 2048;
constexpr float EPS = 1e-6f;
constexpr int C_GL = 0, C_GA = 512, C_Z = 1024, C_XL = 2048, C_Q = 2560, C_QI = 3072, C_XBC = 3328, C_T19 = 4864, C_T20 = 5120;
constexpr int KVW = 320;
constexpr size_t KVB_LAYER = (size_t)NPB * SEQ * KVW + (size_t)NSB_S * (PAST + DSEQ) * KVW;

constexpr size_t O_YP = 0;
constexpr size_t O_YS = O_YP + (size_t)NPB * SEQ * DM;
constexpr size_t O_AKP = O_YS + (size_t)NSB_S * DSEQ * DM;
constexpr size_t O_AVP = O_AKP + (size_t)2 * NPB * SEQ * 128;
constexpr size_t O_IKP = O_AVP + (size_t)2 * NPB * SEQ * 128;
constexpr size_t O_LCP = O_IKP + (size_t)2 * NPB * SEQ * 64;
constexpr size_t O_LHP = O_LCP + (size_t)2 * NPB * 3 * 512;
constexpr size_t O_SCP = O_LHP + (size_t)2 * NPB * 512;
constexpr size_t O_SHP = O_SCP + (size_t)2 * NPB * 3 * 1536;
constexpr size_t O_AKS = O_SHP + (size_t)2 * NPB * 16 * 64 * 128;
constexpr size_t O_AVS = O_AKS + (size_t)2 * NSB_S * DSEQ * 128;
constexpr size_t O_IKS = O_AVS + (size_t)2 * NSB_S * DSEQ * 128;
constexpr size_t O_LCS = O_IKS + (size_t)2 * NSB_S * DSEQ * 64;
constexpr size_t O_LHS = O_LCS + (size_t)2 * NSB_S * 3 * 512;
constexpr size_t O_SCS = O_LHS + (size_t)2 * NSB_S * 512;
constexpr size_t O_SHS = O_SCS + (size_t)2 * NSB_S * 3 * 1536;
constexpr size_t O_END = O_SHS + (size_t)2 * NSB_S * 16 * 64 * 128;

constexpr size_t MiB = 1u << 20;
constexpr size_t WS_CTL = 0, CTL_BYTES = 1 * MiB;
constexpr size_t WS_WIN = 1 * MiB;
constexpr size_t WIN_LAYER = (size_t)NPAD * DM;
constexpr size_t WS_WOUT = 22 * MiB;
constexpr size_t WOUT_LAYER = (size_t)DM * DMIX;
constexpr size_t WS_HB = 30 * MiB;
constexpr size_t WS_RSS = 95 * MiB;
constexpr size_t WS_WI = 98 * MiB;
constexpr size_t WS_DTR = 99 * MiB;
constexpr size_t WS_SSQ = 102 * MiB;
constexpr size_t WS_KVB = 112 * MiB;
constexpr size_t WS_PROJ = 138 * MiB;
constexpr size_t WS_KEYS_B = 447 * MiB;
constexpr size_t KEYS_PER_WG = 512 * 1024;
constexpr size_t WS_END = WS_KEYS_B + 128 * KEYS_PER_WG;
static_assert(WS_KVB + KVB_LAYER * 2 <= WS_PROJ && WS_PROJ + (size_t)ROWS * PJW * 2 <= WS_KEYS_B && 128 * KEYS_PER_WG <= 65 * MiB, "ws map");
static_assert(WS_END <= 512 * MiB, "ws map");

constexpr int NTHREADS = 512, NWAVES = 8;
constexpr int LDS_BYTES = 163840;

DI float bf2f(bf16_t v) { return __uint_as_float(((unsigned)v) << 16); }
DI bf16_t f2bf(float f) { unsigned u = __float_as_uint(f); return (bf16_t)((u + 0x7fffu + ((u >> 16) & 1u)) >> 16); }
DI unsigned pk2(float lo, float hi) { return (unsigned)f2bf(lo) | ((unsigned)f2bf(hi) << 16); }
DI int crow(int reg, int h) { return (reg & 3) + 8 * (reg >> 2) + 4 * h; }
template <int O> DI float swz_xor(float v) { return __int_as_float(__builtin_amdgcn_ds_swizzle(__float_as_int(v), (O << 10) | 0x1f)); }
DI float xor32_sum(float v) { auto rr = __builtin_amdgcn_permlane32_swap(__float_as_uint(v), __float_as_uint(v), false, false); return __uint_as_float(rr[0]) + __uint_as_float(rr[1]); }
DI float xor32_max(float v) { auto rr = __builtin_amdgcn_permlane32_swap(__float_as_uint(v), __float_as_uint(v), false, false); return fmaxf(__uint_as_float(rr[0]), __uint_as_float(rr[1])); }
DI float half_sum32(float v) {
    v += swz_xor<1>(v); v += swz_xor<2>(v); v += swz_xor<4>(v); v += swz_xor<8>(v); v += swz_xor<16>(v); return v;
}
DI float wave_sum(float v) { return xor32_sum(half_sum32(v)); }
DI float wave_max(float v) {
    v = fmaxf(v, swz_xor<1>(v)); v = fmaxf(v, swz_xor<2>(v)); v = fmaxf(v, swz_xor<4>(v)); v = fmaxf(v, swz_xor<8>(v)); v = fmaxf(v, swz_xor<16>(v)); return xor32_max(v);
}
DI float sum_fq(float v) { return xor32_sum(v + swz_xor<16>(v)); }
DI float bperm(float v, int srclane) { return __int_as_float(__builtin_amdgcn_ds_bpermute(srclane << 2, __float_as_int(v))); }
DI float silu_f(float x) { return x / (1.f + expf(-x)); }
DI float sigmoid_f(float x) { return 1.f / (1.f + expf(-x)); }
DI float softplus_f(float x) { return x > 20.f ? x : log1pf(expf(x)); }
#define LDS_FENCE() asm volatile("s_waitcnt lgkmcnt(0)" ::: "memory")

__host__ __device__ inline int orig_col(int c) {
    if (c < 512) return 512 + c;
    if (c < 1024) return 1792 + (c - 512);
    if (c < 2048) return 2628 + (c - 1024);
    if (c < 2560) return c - 2048;
    if (c < 3072) return 1024 + (c - 2560);
    if (c < 3328) return 2304 + (c - 3072);
    if (c < 4864) return 3652 + (c - 3328);
    if (c < 5120) { const int cl = c - 4864, bj = cl >> 7, wc = (cl >> 5) & 3, j = cl & 31, d = 32 * bj + j; return (wc < 2 ? 1536 : 1664) + (wc & 1) * 64 + d; }
    const int cl = c - 5120;
    if (cl < 64) return 2560 + cl;
    if (cl < 68) return 2624 + (cl - 64);
    if (cl < 84) return 5188 + (cl - 68);
    return -1;
}
DI int sb_T(int sb) { return sb < NPB ? SEQ : DSEQ; }
DI int sb_P(int sb) { return sb < NPB ? 0 : PAST; }
DI int sb_row0(int sb) { return sb < NPB ? sb * SEQ : ROWS_P + (sb - NPB) * DSEQ; }
DI size_t kvb_off(int sb) { return sb < NPB ? (size_t)sb * SEQ * KVW : (size_t)NPB * SEQ * KVW + (size_t)(sb - NPB) * (PAST + DSEQ) * KVW; }
DI void row_sbt(int m, int& sb, int& t) { if (m < ROWS_P) { sb = m >> 11; t = m & 2047; } else { const int r = m - ROWS_P; sb = NPB + (r >> 6); t = r & 63; } }

typedef const float* cfp_t;
struct Args { const float* in[28]; float* out; unsigned char* ws; int ph_lo, ph_hi; };

struct Ctx {
    float* out; unsigned char* ws;
    LAS unsigned char* lds;
    DI const float* inp(int k) const { return (const float*)(const __attribute__((address_space(1))) float*)(((LAS unsigned long long*)(lds + LDS_BYTES - 256))[k]); }
    int tid, lane, wave, G, bid;
    DI bf16_t* win(int l) const { return (bf16_t*)(ws + WS_WIN) + (size_t)l * WIN_LAYER; }
    DI bf16_t* wout(int l) const { return (bf16_t*)(ws + WS_WOUT) + (size_t)l * WOUT_LAYER; }
    DI bf16_t* hb() const { return (bf16_t*)(ws + WS_HB); }
    DI float* rss() const { return (float*)(ws + WS_RSS); }
    DI float* wi() const { return (float*)(ws + WS_WI); }
    DI float* dtr() const { return (float*)(ws + WS_DTR); }
    DI float* ssq() const { return (float*)(ws + WS_SSQ); }
    DI bf16_t* kvb(int) const { return (bf16_t*)(ws + WS_KVB); }
    DI unsigned* keys() const { return (unsigned*)(bid < 128 ? ws + WS_HB + (size_t)bid * KEYS_PER_WG : ws + WS_KEYS_B + (size_t)(bid - 128) * KEYS_PER_WG); }
    DI bf16_t* proj() const { return (bf16_t*)(ws + WS_PROJ); }
};
DI float* out_ak(const Ctx& C, int l, int sb) { return sb < NPB ? C.out + O_AKP + ((size_t)(l * NPB + sb) * SEQ) * 128 : C.out + O_AKS + ((size_t)(l * NSB_S + sb - NPB) * DSEQ) * 128; }
DI float* out_av(const Ctx& C, int l, int sb) { return sb < NPB ? C.out + O_AVP + ((size_t)(l * NPB + sb) * SEQ) * 128 : C.out + O_AVS + ((size_t)(l * NSB_S + sb - NPB) * DSEQ) * 128; }
DI float* out_ik(const Ctx& C, int l, int sb) { return sb < NPB ? C.out + O_IKP + ((size_t)(l * NPB + sb) * SEQ) * 64 : C.out + O_IKS + ((size_t)(l * NSB_S + sb - NPB) * DSEQ) * 64; }
DI float* out_lc(const Ctx& C, int l, int sb) { return sb < NPB ? C.out + O_LCP + (size_t)(l * NPB + sb) * 3 * 512 : C.out + O_LCS + (size_t)(l * NSB_S + sb - NPB) * 3 * 512; }
DI float* out_lh(const Ctx& C, int l, int sb) { return sb < NPB ? C.out + O_LHP + (size_t)(l * NPB + sb) * 512 : C.out + O_LHS + (size_t)(l * NSB_S + sb - NPB) * 512; }
DI float* out_sc(const Ctx& C, int l, int sb) { return sb < NPB ? C.out + O_SCP + (size_t)(l * NPB + sb) * 3 * 1536 : C.out + O_SCS + (size_t)(l * NSB_S + sb - NPB) * 3 * 1536; }
DI float* out_sh(const Ctx& C, int l, int sb) { return sb < NPB ? C.out + O_SHP + (size_t)(l * NPB + sb) * 16 * 64 * 128 : C.out + O_SHS + (size_t)(l * NSB_S + sb - NPB) * 16 * 64 * 128; }

#ifdef PROBE_SUB
#define PROBE_BEGIN(id) unsigned long long pb_##id = __builtin_amdgcn_s_memrealtime()
#define PROBE_END(id, Cx) do { if ((id) == PROBE_SUB && (Cx).tid == 0) *(LAS unsigned long long*)((Cx).lds + LDS_BYTES - 16) += __builtin_amdgcn_s_memrealtime() - pb_##id; } while (0)
#else
#define PROBE_BEGIN(id) do {} while (0)
#define PROBE_END(id, Cx) do {} while (0)
#endif
namespace pg8 {
#define PG8_LAS __attribute__((address_space(3)))
constexpr int BM = 256, BK = 64, HALF = 128, HTB = HALF * BK * 2  , STAGE_BYTES = 8 * HTB, NXCD = 8, WGM = 8;

__host__ __device__ __forceinline__ int lds_byte(int r, int c) { const int st = (r >> 4) * 2 + (c >> 5), rr = r & 15, cc = c & 31, ob = rr * 64 + cc * 2; return st * 1024 + (ob ^ (((ob >> 9) & 1) << 5)); }
__host__ __device__ __forceinline__ void stage_rc(int b, int& R, int& C) { const int st = b / 1024, sb = b % 1024, swz = sb ^ (((sb >> 9) & 1) << 5); R = (st >> 1) * 16 + swz / 64; C = (st & 1) * 32 + (swz % 64) / 2; }
__host__ __device__ __forceinline__ int perm32(int rho) { const int n = rho >> 4, i = rho & 15; return 8 * (i >> 2) + 4 * n + (i & 3); }

struct Unit { int pm, pn; };
struct Gemm { const bf16_t* A; const bf16_t* Bt; int M, N, K, lda; };

struct StaticOrder {
    int nM, nN, nwg, G, c;
    __host__ __device__ void init(int M, int N, int G_, int c_) { nM = M / BM; nN = N / BM; nwg = nM * nN; G = G_; c = c_; }
    __host__ __device__ bool next(int i, Unit& u) const {
        const long L = (long)i * G + c; if (L >= nwg) return false;
        int wgid = (int)L; { const int q = nwg / NXCD, r = nwg % NXCD, xcd = wgid % NXCD, off = wgid / NXCD; wgid = (xcd < r ? xcd * (q + 1) : r * (q + 1) + (xcd - r) * q) + off; }
        const int nig = WGM * nN, gid = wgid / nig, fm = gid * WGM, gsz = (nM - fm) < WGM ? (nM - fm) : WGM;
        u.pm = fm + ((wgid % nig) % gsz); u.pn = (wgid % nig) / gsz; return true;
    }
    __device__ __forceinline__ void a_ready(const Unit&) const {}
    __device__ __forceinline__ void done(const Unit&) const {}
};

template <class Epi, class Sched, bool ALIGN_EPI = false, bool SP2 = false>
__device__ __forceinline__ void gemm_phase(PG8_LAS unsigned char* lds, const Gemm g, const Sched& S, const Epi& E, const int tid) {
    const int wid = __builtin_amdgcn_readfirstlane(tid >> 6), lane = tid & 63, wr = wid >> 2, wc = wid & 3, fr = lane & 15, fq = lane >> 4;
    const int K = g.K, nt = K / BK;
    unsigned voffA[2], voffB[2];
#pragma unroll
    for (int i = 0; i < 2; ++i) { int R, C; stage_rc(tid * 16 + i * 8192, R, C); const int Rb = Epi::PERM ? ((R & ~31) + perm32(R & 31)) : R;
        voffA[i] = (unsigned)(R * g.lda + C) * 2u; voffB[i] = (unsigned)(Rb * K + C) * 2u; }
    const size_t kstep = (size_t)(BK * 2);
    const size_t hstepA = (size_t)HALF * g.lda * 2, hstepB = (size_t)HALF * K * 2;
    const size_t tstepA = 2 * hstepA, tstepB = 2 * hstepB;
    const unsigned ldsw = (unsigned)wid * 1024u;
    const int aoff = lds_byte(wr * 64 + fr, fq * 8), boff = lds_byte(wc * 32 + fr, fq * 8);
#define PG8_SA(b, h) (((b) * 2 + (h)) * HTB)
#define PG8_SB(b, h) ((4 + (b) * 2 + (h)) * HTB)
#define PG8_STAGE(bufoff, gbase, voff) do { _Pragma("unroll") for (int _i = 0; _i < 2; ++_i) \
        __builtin_amdgcn_global_load_lds((const unsigned*)((const char*)(gbase) + (voff)[_i]), (PG8_LAS unsigned*)(lds + (bufoff) + ldsw + _i * 8192), 16, 0, 0); } while (0)
#define PG8_LDA(dst, b, h) do { _Pragma("unroll") for (int m = 0; m < 4; ++m) _Pragma("unroll") for (int k = 0; k < 2; ++k) dst[m][k] = *(const PG8_LAS bf16x8*)(lds + PG8_SA(b, h) + aoff + m * 2048 + k * 1024); } while (0)
#define PG8_LDB(dst, b, h) do { _Pragma("unroll") for (int n = 0; n < 2; ++n) _Pragma("unroll") for (int k = 0; k < 2; ++k) dst[n][k] = *(const PG8_LAS bf16x8*)(lds + PG8_SB(b, h) + boff + n * 2048 + k * 1024); } while (0)
#define PG8_MMA(ai, bj, At, Bt) do { __builtin_amdgcn_s_setprio(1); _Pragma("unroll") for (int m = 0; m < 4; ++m) _Pragma("unroll") for (int n = 0; n < 2; ++n) _Pragma("unroll") for (int k = 0; k < 2; ++k) \
        acc[ai][bj][m][n] = __builtin_amdgcn_mfma_f32_16x16x32_bf16(Bt[n][k], At[m][k], acc[ai][bj][m][n], 0, 0, 0); __builtin_amdgcn_s_setprio(0); } while (0)
#define PG8_WAIT_V(n) asm volatile("s_waitcnt vmcnt(" #n ")" ::: "memory")
#define PG8_WAIT_L(n) asm volatile("s_waitcnt lgkmcnt(" #n ")" ::: "memory")
#define PG8_BAR __builtin_amdgcn_s_barrier()
#define PG8_SCHED __builtin_amdgcn_sched_barrier(0)
    Unit cur, nxt; int ui = 0;
    if (!S.next(0, cur)) return;
    f32x4 acc[2][2][4][2];
#pragma unroll
    for (int a = 0; a < 2; ++a)
#pragma unroll
        for (int b = 0; b < 2; ++b)
#pragma unroll
            for (int m = 0; m < 4; ++m)
#pragma unroll
                for (int n = 0; n < 2; ++n) acc[a][b][m][n] = (f32x4){0.f, 0.f, 0.f, 0.f};
    bf16x8 At[4][2], B0[2][2], B1[2][2];
    const char* cA = (const char*)g.A + (size_t)cur.pm * tstepA; const char* cB = (const char*)g.Bt + (size_t)cur.pn * tstepB;
    S.a_ready(cur);
    if constexpr (SP2) {
        PG8_STAGE(PG8_SB(0, 0), cB, voffB); PG8_STAGE(PG8_SB(0, 1), cB + hstepB, voffB); PG8_STAGE(PG8_SA(0, 0), cA, voffA); PG8_STAGE(PG8_SA(0, 1), cA + hstepA, voffA);
        if (wr == 1) PG8_BAR;
        PG8_WAIT_V(2); PG8_BAR;
        PG8_STAGE(PG8_SB(1, 0), cB + kstep, voffB); PG8_STAGE(PG8_SA(1, 0), cA + kstep, voffA); PG8_STAGE(PG8_SB(1, 1), cB + hstepB + kstep, voffB);
        PG8_WAIT_V(6); PG8_BAR;
    } else {
        PG8_STAGE(PG8_SB(0, 0), cB, voffB); PG8_STAGE(PG8_SA(0, 0), cA, voffA); PG8_STAGE(PG8_SB(0, 1), cB + hstepB, voffB); PG8_STAGE(PG8_SA(0, 1), cA + hstepA, voffA);
        if (wr == 1) PG8_BAR;
        PG8_WAIT_V(4); PG8_BAR;
        PG8_STAGE(PG8_SB(1, 0), cB + kstep, voffB); PG8_STAGE(PG8_SA(1, 0), cA + kstep, voffA); PG8_STAGE(PG8_SB(1, 1), cB + hstepB + kstep, voffB);
        PG8_WAIT_V(6); PG8_BAR;
    }
    for (;;) {
        const bool has_next = S.next(ui + 1, nxt);
        const char* nA = has_next ? (const char*)g.A + (size_t)nxt.pm * tstepA : cA; const char* nB = has_next ? (const char*)g.Bt + (size_t)nxt.pn * tstepB : cB;
        for (int t = 0; t < nt; t += 2) {
            if constexpr (Epi::KSCALE) { if (t == Epi::KS_T0 || t == Epi::KS_T1) E.kscale(acc, ui, t, wr, fr); }
            const bool last = (t == nt - 2);
            const char* a1 = cA + (size_t)(t + 1) * kstep;
            const char* a2 = last ? nA : cA + (size_t)(t + 2) * kstep; const char* b2 = last ? nB : cB + (size_t)(t + 2) * kstep;
            const char* a3 = a2 + kstep; const char* b3 = b2 + kstep;
            if (last && has_next) S.a_ready(nxt);
            if constexpr (SP2) {
            PG8_LDB(B0, 0, 0); PG8_LDB(B1, 0, 1); PG8_SCHED; PG8_LDA(At, 0, 0); PG8_STAGE(PG8_SA(1, 1), a1 + hstepA, voffA);
            PG8_WAIT_V(8); PG8_WAIT_L(0); PG8_BAR; PG8_MMA(0, 0, At, B0); PG8_MMA(0, 1, At, B1); PG8_BAR; PG8_SCHED;
            PG8_LDA(At, 0, 1); PG8_STAGE(PG8_SB(0, 0), b2, voffB); PG8_STAGE(PG8_SB(0, 1), b2 + hstepB, voffB); PG8_STAGE(PG8_SA(0, 0), a2, voffA);
            PG8_WAIT_V(8); PG8_WAIT_L(0); PG8_BAR; PG8_MMA(1, 0, At, B0); PG8_MMA(1, 1, At, B1); PG8_BAR; PG8_SCHED;
            PG8_LDB(B0, 1, 0); PG8_LDB(B1, 1, 1); PG8_SCHED; PG8_LDA(At, 1, 0); PG8_STAGE(PG8_SA(0, 1), a2 + hstepA, voffA);
            PG8_WAIT_V(8); PG8_WAIT_L(0); PG8_BAR; PG8_MMA(0, 0, At, B0); PG8_MMA(0, 1, At, B1); PG8_BAR; PG8_SCHED;
            PG8_LDA(At, 1, 1); PG8_STAGE(PG8_SB(1, 0), b3, voffB); PG8_STAGE(PG8_SB(1, 1), b3 + hstepB, voffB); PG8_STAGE(PG8_SA(1, 0), a3, voffA);
            PG8_WAIT_V(8); PG8_WAIT_L(0); PG8_BAR; PG8_MMA(1, 0, At, B0); PG8_MMA(1, 1, At, B1); PG8_BAR; PG8_SCHED;
            } else {
            PG8_LDB(B0, 0, 0); PG8_SCHED; PG8_LDA(At, 0, 0); PG8_STAGE(PG8_SA(1, 1), a1 + hstepA, voffA);
            PG8_WAIT_L(8); PG8_BAR; PG8_WAIT_L(0); PG8_MMA(0, 0, At, B0); PG8_BAR; PG8_SCHED;
            PG8_LDB(B1, 0, 1); PG8_STAGE(PG8_SB(0, 0), b2, voffB);
            PG8_BAR; PG8_WAIT_L(0); PG8_MMA(0, 1, At, B1); PG8_BAR;
            PG8_LDA(At, 0, 1); PG8_STAGE(PG8_SA(0, 0), a2, voffA);
            PG8_BAR; PG8_WAIT_L(0); PG8_MMA(1, 0, At, B0); PG8_BAR; PG8_SCHED;
            PG8_STAGE(PG8_SB(0, 1), b2 + hstepB, voffB);
            PG8_WAIT_V(6); PG8_BAR; PG8_MMA(1, 1, At, B1); PG8_BAR;
            PG8_LDB(B0, 1, 0); PG8_SCHED; PG8_LDA(At, 1, 0); PG8_STAGE(PG8_SA(0, 1), a2 + hstepA, voffA);
            PG8_WAIT_L(8); PG8_BAR; PG8_WAIT_L(0); PG8_MMA(0, 0, At, B0); PG8_BAR; PG8_SCHED;
            PG8_LDB(B1, 1, 1); PG8_STAGE(PG8_SB(1, 0), b3, voffB);
            PG8_BAR; PG8_WAIT_L(0); PG8_MMA(0, 1, At, B1); PG8_BAR;
            PG8_LDA(At, 1, 1); PG8_STAGE(PG8_SA(1, 0), a3, voffA);
            PG8_BAR; PG8_WAIT_L(0); PG8_MMA(1, 0, At, B0); PG8_BAR; PG8_SCHED;
            PG8_STAGE(PG8_SB(1, 1), b3 + hstepB, voffB);
            PG8_WAIT_V(6); PG8_BAR; PG8_MMA(1, 1, At, B1); PG8_BAR;
            }
        }
        if constexpr (ALIGN_EPI) { if (wr == 0) PG8_BAR; }
        if constexpr (!Epi::AFTER_DRAIN) { E(acc, cur, wr, wc, fr, fq); S.done(cur); }
        if (!has_next) break;
#pragma unroll
        for (int a = 0; a < 2; ++a)
#pragma unroll
            for (int b = 0; b < 2; ++b)
#pragma unroll
                for (int m = 0; m < 4; ++m)
#pragma unroll
                    for (int n = 0; n < 2; ++n) acc[a][b][m][n] = (f32x4){0.f, 0.f, 0.f, 0.f};
        cur = nxt; cA = nA; cB = nB; ++ui;
        if constexpr (ALIGN_EPI) { if (wr == 1) PG8_BAR; }
    }
    PG8_WAIT_V(0);
    if constexpr (!ALIGN_EPI) { if (wr == 0) PG8_BAR; }
    PG8_BAR;
    if constexpr (Epi::AFTER_DRAIN) { E.fused(acc, cur, wr, wc, fr, fq, lds, wid, lane); S.done(cur); }
#undef PG8_SA
#undef PG8_SB
#undef PG8_STAGE
#undef PG8_LDA
#undef PG8_LDB
#undef PG8_MMA
#undef PG8_WAIT_V
#undef PG8_WAIT_L
#undef PG8_BAR
#undef PG8_SCHED
}
}

typedef float f32x2_t __attribute__((ext_vector_type(2))); typedef __bf16 bf16x2_t __attribute__((ext_vector_type(2)));
DI unsigned cvt_pk_bf16(float lo, float hi) { const f32x2_t v = {lo, hi}; const bf16x2_t b = __builtin_convertvector(v, bf16x2_t); return __builtin_bit_cast(unsigned, b); }
DI u32x4 pack8(const f32x4 a, const f32x4 b) { u32x4 w; w.x = cvt_pk_bf16(a[0], a[1]); w.y = cvt_pk_bf16(a[2], a[3]); w.z = cvt_pk_bf16(b[0], b[1]); w.w = cvt_pk_bf16(b[2], b[3]); return w; }
struct EpiIn {
    static constexpr bool PERM = true, AFTER_DRAIN = false, KSCALE = false; static constexpr int KS_T0 = -1, KS_T1 = -1;
    Ctx C; int l;
    DI void operator()(const f32x4 (&acc)[2][2][4][2], const pg8::Unit& u, int wr, int wc, int fr, int fq) const {
        const int row0 = u.pm * 256 + wr * 64 + fr;
        float rs[2][4];
#pragma unroll
        for (int ai = 0; ai < 2; ++ai)
#pragma unroll
            for (int m = 0; m < 4; ++m) {
                const f32x4 p = *(const f32x4*)(C.rss() + (size_t)(row0 + ai * 128 + m * 16) * 16 + 4 * fq);
                float s = sum_fq((p[0] + p[1]) + (p[2] + p[3]));
                rs[ai][m] = rsqrtf(s * (1.f / DM) + EPS);
            }
        if (u.pn < 19) {
            bf16_t* base = C.proj() + (size_t)row0 * PJW + u.pn * 256 + wc * 32 + 8 * fq;
#pragma unroll
            for (int ai = 0; ai < 2; ++ai)
#pragma unroll
                for (int m = 0; m < 4; ++m) {
                    bf16_t* rowp = base + (size_t)(ai * 128 + m * 16) * PJW; const float sc = rs[ai][m];
#pragma unroll
                    for (int bj = 0; bj < 2; ++bj) *(u32x4*)(rowp + bj * 128) = pack8(acc[ai][bj][m][0] * sc, acc[ai][bj][m][1] * sc);
                }
        } else if (u.pn == 19) {
            if (wc < 2) {
                const float* kw = C.inp(19) + l * 64 + 8 * fq;
                const f32x4 k00 = *(const f32x4*)(kw), k01 = *(const f32x4*)(kw + 4), k10 = *(const f32x4*)(kw + 32), k11 = *(const f32x4*)(kw + 36);
#pragma unroll
                for (int ai = 0; ai < 2; ++ai)
#pragma unroll
                    for (int m = 0; m < 4; ++m) {
                        const int row = row0 + ai * 128 + m * 16; int sb, t; row_sbt(row, sb, t);
                        const float sc = rs[ai][m];
                        f32x4 a0 = acc[ai][0][m][0] * sc, a1 = acc[ai][0][m][1] * sc, b0 = acc[ai][1][m][0] * sc, b1 = acc[ai][1][m][1] * sc;
                        float ss = 0.f;
#pragma unroll
                        for (int i = 0; i < 4; ++i) ss += (a0[i] * a0[i] + a1[i] * a1[i]) + (b0[i] * b0[i] + b1[i] * b1[i]);
                        ss = sum_fq(ss);
                        const float rn = rsqrtf(ss * (1.f / 64.f) + EPS);
                        a0 = a0 * rn * k00; a1 = a1 * rn * k01; b0 = b0 * rn * k10; b1 = b1 * rn * k11;
                        float* o = out_ak(C, l, sb) + (size_t)t * 128 + wc * 64 + 8 * fq;
                        *(f32x4*)(o) = a0; *(f32x4*)(o + 4) = a1; *(f32x4*)(o + 32) = b0; *(f32x4*)(o + 36) = b1;
                        bf16_t* kv = C.kvb(l) + kvb_off(sb) + (size_t)(sb_P(sb) + t) * KVW + wc * 64 + 8 * fq;
                        *(u32x4*)(kv) = pack8(a0, a1); *(u32x4*)(kv + 32) = pack8(b0, b1);
                    }
            } else {
                const int kvh = wc - 2;
#pragma unroll
                for (int ai = 0; ai < 2; ++ai)
#pragma unroll
                    for (int m = 0; m < 4; ++m) {
                        const int row = row0 + ai * 128 + m * 16; int sb, t; row_sbt(row, sb, t);
                        const float sc = rs[ai][m];
                        const f32x4 a0 = acc[ai][0][m][0] * sc, a1 = acc[ai][0][m][1] * sc, b0 = acc[ai][1][m][0] * sc, b1 = acc[ai][1][m][1] * sc;
                        float* o = out_av(C, l, sb) + (size_t)t * 128 + kvh * 64 + 8 * fq;
                        *(f32x4*)(o) = a0; *(f32x4*)(o + 4) = a1; *(f32x4*)(o + 32) = b0; *(f32x4*)(o + 36) = b1;
                        bf16_t* kv = C.kvb(l) + kvb_off(sb) + (size_t)(sb_P(sb) + t) * KVW + 128 + kvh * 64 + 8 * fq;
                        *(u32x4*)(kv) = pack8(a0, a1); *(u32x4*)(kv + 32) = pack8(b0, b1);
                    }
            }
        } else {
#pragma unroll
            for (int ai = 0; ai < 2; ++ai)
#pragma unroll
                for (int m = 0; m < 4; ++m) {
                    const int row = row0 + ai * 128 + m * 16; int sb, t; row_sbt(row, sb, t);
                    const float sc = rs[ai][m];
                    const f32x4 a0 = acc[ai][0][m][0] * sc, a1 = acc[ai][0][m][1] * sc;
                    if (wc < 2) {
                        const int d = 32 * wc + 8 * fq;
                        float* o = out_ik(C, l, sb) + (size_t)t * 64 + d;
                        *(f32x4*)(o) = a0; *(f32x4*)(o + 4) = a1;
                        *(u32x4*)(C.kvb(l) + kvb_off(sb) + (size_t)(sb_P(sb) + t) * KVW + 256 + d) = pack8(a0, a1);
                    } else if (wc == 2) {
                        if (fq == 0) { *(f32x4*)(C.wi() + (size_t)row * 4) = a0; *(f32x4*)(C.dtr() + (size_t)row * 16) = a1; }
                        else if (fq == 1) { *(f32x4*)(C.dtr() + (size_t)row * 16 + 4) = a0; *(f32x4*)(C.dtr() + (size_t)row * 16 + 8) = a1; }
                        else if (fq == 2) { *(f32x4*)(C.dtr() + (size_t)row * 16 + 12) = a0; }
                    }
                }
        }
    }
};
constexpr int LDS_GNT = 131072;
struct EpiOut {
    static constexpr bool PERM = false, AFTER_DRAIN = false, KSCALE = true; static constexpr int KS_T0 = 16, KS_T1 = 24;
    Ctx C; int l, pm0, pn0;
    DI void kscale(f32x4 (&acc)[2][2][4][2], int ui, int t, int wr, int fr) const {
        const LAS f32x4* tab = (const LAS f32x4*)(C.lds + LDS_GNT) + (ui & 1) * 256;
#pragma unroll
        for (int ai = 0; ai < 2; ++ai)
#pragma unroll
            for (int m = 0; m < 4; ++m) {
                const f32x4 f4 = tab[ai * 128 + wr * 64 + m * 16 + fr]; const float f = (t == KS_T0) ? f4[0] : f4[1];
#pragma unroll
                for (int bj = 0; bj < 2; ++bj)
#pragma unroll
                    for (int n = 0; n < 2; ++n) acc[ai][bj][m][n] = acc[ai][bj][m][n] * f;
            }
    }
    DI void operator()(const f32x4 (&acc)[2][2][4][2], const pg8::Unit& u, int wr, int wc, int fr, int fq) const {
        const int row0 = u.pm * 256 + wr * 64 + fr, col0 = u.pn * 256 + wc * 32 + 4 * fq;
        const LAS f32x4* tab = (const LAS f32x4*)(C.lds + LDS_GNT) + ((u.pm == pm0 && u.pn == pn0) ? 0 : 256);
#pragma unroll
        for (int ai = 0; ai < 2; ++ai)
#pragma unroll
            for (int m = 0; m < 4; ++m) {
                const int row = row0 + ai * 128 + m * 16;
                const float r1 = tab[ai * 128 + wr * 64 + m * 16 + fr][2];
                const float* xres = (l == 0) ? ((row < ROWS_P) ? C.inp(0) + (size_t)row * DM : C.inp(1) + (size_t)(row - ROWS_P) * DM) : C.out + (size_t)row * DM;
                float ss = 0.f;
#pragma unroll
                for (int bj = 0; bj < 2; ++bj)
#pragma unroll
                    for (int n = 0; n < 2; ++n) {
                        const int col = col0 + bj * 128 + n * 16;
                        const f32x4 v = *(const f32x4*)(xres + col) + acc[ai][bj][m][n] * r1;
                        *(f32x4*)(C.out + (size_t)row * DM + col) = v;
                        if (l == 0) {
                            u32x2 w; w.x = cvt_pk_bf16(v[0], v[1]); w.y = cvt_pk_bf16(v[2], v[3]);
                            *(u32x2*)(C.hb() + (size_t)row * DM + col) = w;
                            ss += (v[0] * v[0] + v[1] * v[1]) + (v[2] * v[2] + v[3] * v[3]);
                        }
                    }
                if (l == 0) {
                    ss = sum_fq(ss);
                    if (fq == 0) C.rss()[(size_t)row * 16 + u.pn * 4 + wc] = ss;
                }
            }
    }
};
DI void phase_inproj_gemm(const Ctx& C, int l) {
    pg8::Gemm g{C.hb(), C.win(l), ROWS, NPAD, DM, DM};
    pg8::StaticOrder S; S.init(ROWS, NPAD, C.G, C.bid);
    EpiIn E{C, l};
    pg8::gemm_phase<EpiIn, pg8::StaticOrder, true, true>(C.lds, g, S, E, C.tid);
}
DI void outproj_tail_item(const Ctx& C, int l, int rt, int g);
DI void prep_layer(const Ctx& C, int l, int part, int nparts);
DI void prep_cache(const Ctx& C, int l, int part, int nparts);
DI void phase_outproj_gemm(const Ctx& C, int l) {
    for (int i = C.bid * NTHREADS + C.tid; i < NSB * 3 * 1536; i += C.G * NTHREADS) {
        const int sb = i / (3 * 1536), j = (i / 1536) % 3, ch = i % 1536;
        out_sc(C, l, sb)[j * 1536 + ch] = bf2f(C.proj()[(size_t)(sb_row0(sb) + sb_T(sb) - 3 + j) * PJW + C_XBC + ch]);
    }
    for (int i = C.bid * NTHREADS + C.tid; i < NSB * 3 * 512; i += C.G * NTHREADS) {
        const int sb = i / (3 * 512), j = (i / 512) % 3, ch = i % 512;
        out_lc(C, l, sb)[j * 512 + ch] = bf2f(C.proj()[(size_t)(sb_row0(sb) + sb_T(sb) - 3 + j) * PJW + C_XL + ch]);
    }
    if (C.bid < 256) outproj_tail_item(C, l, ROWS_P / 32 + (C.bid >> 4), C.bid & 15);
    if (l == 0) prep_cache(C, 1, C.bid, C.G);
    __syncthreads();
    pg8::Gemm g{C.proj(), C.wout(l), ROWS_P, DM, DMIX, PJW};
    pg8::StaticOrder S; S.init(ROWS_P, DM, C.G, C.bid);
    pg8::Unit u0{0, 0}, uu;
    (void)S.next(0, u0);
    { const int ui = C.tid >> 8, row = C.tid & 255;
      if (S.next(ui, uu)) {
          const float* p = C.ssq() + (size_t)(uu.pm * 256 + row) * 64; float s0 = 0.f, s1 = 0.f;
#pragma unroll
          for (int j = 0; j < 8; ++j) { const f32x4 a = *(const f32x4*)(p + 4 * j), b = *(const f32x4*)(p + 32 + 4 * j); s0 += (a[0] + a[1]) + (a[2] + a[3]); s1 += (b[0] + b[1]) + (b[2] + b[3]); }
          const float q0 = s0 * (1.f / 512.f) + EPS, q1 = s1 * (1.f / 512.f) + EPS, r0 = rsqrtf(q0), r1 = rsqrtf(q1);
          f32x4 f; f[0] = sqrtf(q0); f[1] = r0 * sqrtf(q1); f[2] = r1; f[3] = 0.f;
          ((LAS f32x4*)(C.lds + LDS_GNT))[ui * 256 + row] = f;
      } }
    __syncthreads();
    EpiOut E{C, l, u0.pm, u0.pn};
    pg8::gemm_phase<EpiOut, pg8::StaticOrder, true, true>(C.lds, g, S, E, C.tid);
}
template <int MODE>
DI void p0_transpose_item(const Ctx& C, const float* W, const float* scale, int K, int Nsrc, int Ndst, bf16_t* WT, LAS float* scr, int item) {
    const int lane = C.lane, nblk = Ndst / 64, kb = item / nblk, nb = item % nblk, k0 = 64 * kb, n0 = 64 * nb;
    const int cgp = lane & 15, kq = lane >> 4;
    const int ncol = n0 + 4 * cgp;
    const int src = (MODE == 0) ? orig_col(ncol) : ncol;
#pragma unroll 8
    for (int i = 0; i < 16; ++i) {
        const int kk = 4 * i + kq, k = k0 + kk;
        f32x4 v = (f32x4){0.f, 0.f, 0.f, 0.f};
        if (src >= 0) {
            v = *(const f32x4*)(W + (size_t)k * Nsrc + src);
            const float sc = (MODE == 0) ? scale[k] : (k >= 1024 ? scale[k - 1024] : 1.f);
            v = v * sc;
        }
        scr[(4 * cgp + 0) * 65 + kk] = v[0]; scr[(4 * cgp + 1) * 65 + kk] = v[1]; scr[(4 * cgp + 2) * 65 + kk] = v[2]; scr[(4 * cgp + 3) * 65 + kk] = v[3];
    }
    LDS_FENCE();
    const LAS float* sr = scr + lane * 65;
    bf16_t* orow = WT + (size_t)(n0 + lane) * K + k0;
#pragma unroll
    for (int j = 0; j < 8; ++j) {
        u32x4 o; o.x = cvt_pk_bf16(sr[8 * j], sr[8 * j + 1]); o.y = cvt_pk_bf16(sr[8 * j + 2], sr[8 * j + 3]); o.z = cvt_pk_bf16(sr[8 * j + 4], sr[8 * j + 5]); o.w = cvt_pk_bf16(sr[8 * j + 6], sr[8 * j + 7]);
        *(u32x4*)(orow + 8 * j) = o;
    }
    LDS_FENCE();
}
DI void prep_layer(const Ctx& C, int l, int part, int nparts) {
    LAS float* scr = (LAS float*)(C.lds + C.wave * 16640);
    const int gw = part * NWAVES + C.wave, NGW = nparts * NWAVES;
    constexpr int I_IN = (DM / 64) * (NPAD / 64), I_OUT = (DMIX / 64) * (DM / 64);
    for (int it = gw; it < I_IN + I_OUT; it += NGW) {
        if (it < I_IN) p0_transpose_item<0>(C, C.inp(10) + (size_t)l * DM * DINP, C.inp(9) + l * DM, DM, DINP, NPAD, C.win(l), scr, it);
        else p0_transpose_item<1>(C, C.inp(27) + (size_t)l * DMIX * DM, C.inp(26) + l * 1024, DMIX, DM, DM, C.wout(l), scr, it - I_IN);
    }
}
DI void prep_cache(const Ctx& C, int l, int part, int nparts) {
    const int gw = part * NWAVES + C.wave, NGW = nparts * NWAVES;
    for (int it = gw; it < NSB_S * PAST / 4; it += NGW) {
        const int b = it / (PAST / 4), pos0 = 4 * (it % (PAST / 4));
#pragma unroll
        for (int j = 0; j < 5; ++j) {
            const int pc = C.lane + 64 * j, pp = pc / 80, q = pc % 80, pos = pos0 + pp;
            const size_t base = ((size_t)(l * NSB_S + b) * PAST + pos);
            const f32x4 v = (q < 32) ? *(const f32x4*)(C.inp(2) + base * 128 + 4 * q) : (q < 64 ? *(const f32x4*)(C.inp(3) + base * 128 + 4 * (q - 32)) : *(const f32x4*)(C.inp(4) + base * 64 + 4 * (q - 64)));
            u32x2 o; o.x = cvt_pk_bf16(v[0], v[1]); o.y = cvt_pk_bf16(v[2], v[3]);
            *(u32x2*)(C.kvb(l) + kvb_off(NPB + b) + (size_t)pos * KVW + 4 * q) = o;
        }
    }
}
DI void phase_prologue(const Ctx& C) {
    prep_layer(C, 0, C.bid, C.G); prep_cache(C, 0, C.bid, C.G);
    const int gw = C.bid * NWAVES + C.wave, NGW = C.G * NWAVES;
    for (int m0 = 4 * gw; m0 < ROWS; m0 += 4 * NGW) {
        f32x4 v[4][4];
#pragma unroll
        for (int rr = 0; rr < 4; ++rr) { const int m = m0 + rr; const float* xr = (m < ROWS_P) ? C.inp(0) + (size_t)m * DM : C.inp(1) + (size_t)(m - ROWS_P) * DM;
#pragma unroll
            for (int j = 0; j < 4; ++j) v[rr][j] = *(const f32x4*)(xr + 4 * C.lane + 256 * j); }
#pragma unroll
        for (int rr = 0; rr < 4; ++rr) { const int m = m0 + rr; float ss = 0.f;
#pragma unroll
            for (int j = 0; j < 4; ++j) { const f32x4 x = v[rr][j]; ss += (x[0] * x[0] + x[1] * x[1]) + (x[2] * x[2] + x[3] * x[3]);
                u32x2 o; o.x = cvt_pk_bf16(x[0], x[1]); o.y = cvt_pk_bf16(x[2], x[3]); *(u32x2*)(C.hb() + (size_t)m * DM + 4 * C.lane + 256 * j) = o; }
            ss = wave_sum(ss);
            if (C.lane < 16) C.rss()[(size_t)m * 16 + C.lane] = (C.lane == 0) ? ss : 0.f; }
    }
}

#define MFMA32(a, b, c) __builtin_amdgcn_mfma_f32_32x32x16_bf16((a), (b), (c), 0, 0, 0)
DI void outproj_tail_item(const Ctx& C, int l, int rt, int g) {
    const int lane = C.lane, wave = C.wave, r = lane & 31, h = lane >> 5;
    const bf16_t* WO = C.wout(l); const bf16_t* PJ = C.proj();
    const int m0 = rt * 32, c0 = 64 * g, c1 = c0 + 32, kbeg = 256 * wave;
    f32x16 a0, a1;
#pragma unroll
    for (int i = 0; i < 16; ++i) { a0[i] = 0.f; a1[i] = 0.f; }
    const bf16_t* Ap = PJ + (size_t)(m0 + r) * PJW + 8 * h + kbeg;
    const bf16_t* B0 = WO + (size_t)(c0 + r) * DMIX + 8 * h + kbeg;
    const bf16_t* B1 = WO + (size_t)(c1 + r) * DMIX + 8 * h + kbeg;
#pragma unroll 8
    for (int k0 = 0; k0 < 256; k0 += 16) { const bf16x8 a = *(const bf16x8*)(Ap + k0); a0 = MFMA32(a, *(const bf16x8*)(B0 + k0), a0); a1 = MFMA32(a, *(const bf16x8*)(B1 + k0), a1); }
    LAS float* part = (LAS float*)C.lds;
#pragma unroll
    for (int i = 0; i < 16; ++i) { part[((wave * 2 + 0) * 16 + i) * 64 + lane] = a0[i]; part[((wave * 2 + 1) * 16 + i) * 64 + lane] = a1[i]; }
    __syncthreads();
    if (wave == 0) {
        float r0, r1; { const float* p = C.ssq() + (size_t)(m0 + r) * 64; float s0 = 0.f, s1 = 0.f;
#pragma unroll
            for (int j = 0; j < 32; ++j) { s0 += p[j]; s1 += p[32 + j]; }
            r0 = rsqrtf(s0 * (1.f / 512.f) + EPS); r1 = rsqrtf(s1 * (1.f / 512.f) + EPS); }
#pragma unroll
        for (int reg = 0; reg < 16; ++reg) {
            const int rowl = crow(reg, h), m = m0 + rowl;
            const float g0 = bperm(r0, rowl), g1 = bperm(r1, rowl);
            float sab[2], sc0[2], sc1[2];
#pragma unroll
            for (int t = 0; t < 2; ++t) {
                sab[t] = (part[((0 * 2 + t) * 16 + reg) * 64 + lane] + part[((1 * 2 + t) * 16 + reg) * 64 + lane]) + (part[((2 * 2 + t) * 16 + reg) * 64 + lane] + part[((3 * 2 + t) * 16 + reg) * 64 + lane]);
                sc0[t] = part[((4 * 2 + t) * 16 + reg) * 64 + lane] + part[((5 * 2 + t) * 16 + reg) * 64 + lane];
                sc1[t] = part[((6 * 2 + t) * 16 + reg) * 64 + lane] + part[((7 * 2 + t) * 16 + reg) * 64 + lane];
            }
            const float* xres = (l == 0) ? ((m < ROWS_P) ? C.inp(0) + (size_t)m * DM : C.inp(1) + (size_t)(m - ROWS_P) * DM) : C.out + (size_t)m * DM;
            const float v0 = xres[c0 + r] + sab[0] + g0 * sc0[0] + g1 * sc1[0];
            const float v1 = xres[c1 + r] + sab[1] + g0 * sc0[1] + g1 * sc1[1];
            C.out[(size_t)m * DM + c0 + r] = v0; C.out[(size_t)m * DM + c1 + r] = v1;
            if (l == 0) {
                C.hb()[(size_t)m * DM + c0 + r] = f2bf(v0); C.hb()[(size_t)m * DM + c1 + r] = f2bf(v1);
                const float ss = half_sum32(v0 * v0 + v1 * v1);
                if (r == 0) C.rss()[(size_t)m * 16 + g] = ss;
            }
        }
    }
    __syncthreads();
}

constexpr int SS_XST = 0;
constexpr int SS_BM = SS_XST + 64 * 144;
constexpr int SS_CM = SS_BM + 64 * 272;
constexpr int SS_BWT = SS_CM + 64 * 272;
constexpr int SS_HA = SS_BWT + 128 * 144;
constexpr int SS_SCAL = SS_HA + 2 * 64 * 272;
constexpr int SS_CW = SS_SCAL + 2 * 1024;
constexpr int SS_RAW = SS_CW + 5 * 320 * 4;
constexpr int SS_Z = SS_RAW + 67 * 640;
constexpr int SS_END = SS_Z + 8192;
static_assert(SS_END <= LDS_BYTES - 256, "SSD LDS map");
typedef short s16x4 __attribute__((ext_vector_type(4)));
DI float fast_silu(float x) { return x * __builtin_amdgcn_rcpf(1.f + __builtin_amdgcn_exp2f(-1.4426950408889634f * x)); }
DI bf16x8 lds_frag(const LAS unsigned char* base, int row, int rowbytes, int col) { return *(const LAS bf16x8*)(base + row * rowbytes + col * 2); }

DI void ssd_item(const Ctx& C, int l, int sb, int hd) {
    const int tid = C.tid, lane = C.lane, wave = C.wave, r = lane & 31, h = lane >> 5;
    const int T = sb_T(sb), row0 = sb_row0(sb), g = hd >> 3, NC = T / 64;
    LAS unsigned char* L = C.lds;
    bf16_t* PJ = C.proj();
    const float aneg = -expf(C.inp(24)[l * 16 + hd]), dtb = C.inp(23)[l * 16 + hd], Dh = C.inp(25)[l * 16 + hd];
    const bool stager = tid < 320;
    const int gp = 32 * wave + (lane & 31), sth = lane >> 5;
    const int cg = 0, seg = 0; (void)cg; (void)seg;
    int colbase, cch;
    if (cg < 8) { cch = hd * 64 + 8 * cg; } else if (cg < 24) { cch = 1024 + g * 128 + 8 * (cg - 8); } else { cch = 1280 + g * 128 + 8 * (cg - 24); }
    colbase = C_XBC + cch;
    for (int i = tid; i < 5 * 320; i += NTHREADS) {
        const int j = i / 320, c = i % 320, cg2 = c >> 3, e = c & 7;
        const int ch = (cg2 < 8) ? hd * 64 + 8 * cg2 + e : (cg2 < 24 ? 1024 + g * 128 + 8 * (cg2 - 8) + e : 1280 + g * 128 + 8 * (cg2 - 24) + e);
        ((LAS float*)(L + SS_CW))[i] = (j < 4) ? C.inp(21)[((size_t)l * 4 + j) * 1536 + ch] : C.inp(22)[l * 1536 + ch];
    }
    const int sj = wave - 4, sph = sj & 1, nq0 = 2 * (sj >> 1);
    f32x16 hacc0, hacc1;
#pragma unroll
    for (int i = 0; i < 16; ++i) { hacc0[i] = 0.f; hacc1[i] = 0.f; }
    if (wave >= 4) {
        if (sb >= NPB) {
            const float* st = C.inp(8) + (((size_t)(l * NSB_S + sb - NPB) * 16 + hd) * 64 + 32 * sph + r) * 128;
#pragma unroll
            for (int gq = 0; gq < 4; ++gq) {
                const f32x4 v0 = *(const f32x4*)(st + 32 * nq0 + 8 * gq + 4 * h), v1 = *(const f32x4*)(st + 32 * (nq0 + 1) + 8 * gq + 4 * h);
#pragma unroll
                for (int e = 0; e < 4; ++e) { hacc0[4 * gq + e] = v0[e]; hacc1[4 * gq + e] = v1[e]; }
            }
        }
#pragma unroll
        for (int gq = 0; gq < 4; ++gq) {
            u32x2 w0, w1; w0.x = cvt_pk_bf16(hacc0[4 * gq], hacc0[4 * gq + 1]); w0.y = cvt_pk_bf16(hacc0[4 * gq + 2], hacc0[4 * gq + 3]);
            w1.x = cvt_pk_bf16(hacc1[4 * gq], hacc1[4 * gq + 1]); w1.y = cvt_pk_bf16(hacc1[4 * gq + 2], hacc1[4 * gq + 3]);
            *(LAS u32x2*)(L + SS_HA + (32 * sph + r) * 272 + (32 * nq0 + 8 * gq + 4 * h) * 2) = w0;
            *(LAS u32x2*)(L + SS_HA + (32 * sph + r) * 272 + (32 * (nq0 + 1) + 8 * gq + 4 * h) * 2) = w1;
        }
    }
    const int yph = wave & 1, ylh = (wave >> 1) & 1;
#define SSD_DMA_RAW(cc) do { const int t0_ = 64 * (cc); \
        for (int k_ = wave; k_ < 42; k_ += NWAVES) { \
            const int q_ = 64 * k_ + lane, rr_ = q_ / 40, pc_ = q_ - 40 * rr_, t_ = t0_ - 3 + rr_; \
            const int col_ = C_XBC + ((pc_ < 8) ? hd * 64 + 8 * pc_ : (pc_ < 24 ? 1024 + g * 128 + 8 * (pc_ - 8) : 1280 + g * 128 + 8 * (pc_ - 24))); \
            if (q_ < 2680 && t_ >= 0) __builtin_amdgcn_global_load_lds((const unsigned*)(PJ + (size_t)(row0 + t_) * PJW + col_), (LAS unsigned*)(L + SS_RAW + k_ * 1024), 16, 0, 0); } \
    } while (0)
#define SSD_DMA_Z(cc) do { const int t0_ = 64 * (cc); \
        if (wave < 4) { _Pragma("unroll") for (int k_ = 0; k_ < 2; ++k_) { const int rr_ = 16 * k_ + (lane >> 2), pc_ = lane & 3; \
            __builtin_amdgcn_global_load_lds((const unsigned*)(PJ + (size_t)(row0 + t0_ + 32 * ylh + rr_) * PJW + C_Z + hd * 64 + 32 * yph + 8 * pc_), \
                                             (LAS unsigned*)(L + SS_Z + (2 * yph + ylh) * 2048 + k_ * 1024), 16, 0, 0); } } \
    } while (0)
    if (tid < 120) {
        const int rr = tid / 40, pc = tid % 40;
        const int ch = (pc < 8) ? hd * 64 + 8 * pc : (pc < 24 ? 1024 + g * 128 + 8 * (pc - 8) : 1280 + g * 128 + 8 * (pc - 24));
        u32x4 v = (u32x4){0u, 0u, 0u, 0u};
        if (sb >= NPB) { const float* st = C.inp(7) + ((size_t)(l * NSB_S + sb - NPB) * 3 + rr) * 1536 + ch; v = pack8(*(const f32x4*)st, *(const f32x4*)(st + 4)); }
        *(LAS u32x4*)(L + SS_RAW + rr * 640 + pc * 16) = v;
    }
#define SSD_S0(cc) do { LAS float* SC_ = (LAS float*)(L + SS_SCAL + ((cc) & 1) * 1024); \
        const float dt_ = softplus_f(C.dtr()[(size_t)(row0 + 64 * (cc) + lane) * 16 + hd] + dtb); float x_ = dt_ * aneg; \
        _Pragma("unroll") for (int o_ = 1; o_ < 64; o_ <<= 1) { const float y_ = bperm(x_, lane - o_); if (lane >= o_) x_ += y_; } \
        const float c63_ = __int_as_float(__builtin_amdgcn_readlane(__float_as_int(x_), 63)); \
        SC_[lane] = x_; SC_[64 + lane] = dt_; SC_[128 + lane] = __builtin_amdgcn_exp2f(1.4426950408889634f * (c63_ - x_)) * dt_; SC_[192 + lane] = __builtin_amdgcn_exp2f(1.4426950408889634f * x_); } while (0)
    if (wave == 7) SSD_S0(0);
    SSD_DMA_RAW(0); SSD_DMA_Z(0);
    asm volatile("s_waitcnt vmcnt(0)" ::: "memory");
    __syncthreads();
    for (int c = 0; c < NC; ++c) {
        const int t0 = 64 * c, par = c & 1;
        LAS float* SC = (LAS float*)(L + SS_SCAL + par * 1024);
        PROBE_BEGIN(12);
        asm volatile("s_waitcnt vmcnt(0)" ::: "memory"); LDS_FENCE(); __syncthreads();
        if (l == 0) PROBE_END(12, C);
        PROBE_BEGIN(10);
        if (stager) {
            const LAS float* CW = (const LAS float*)(L + SS_CW) + 2 * gp;
            const float a0 = CW[0], a1 = CW[320], a2 = CW[640], a3 = CW[960], ab = CW[1280];
            const float b0 = CW[1], b1 = CW[321], b2 = CW[641], b3 = CW[961], bb = CW[1281];
            const bool isB = (gp >= 32 && gp < 96);
#pragma unroll
            for (int tb = 0; tb < 4; ++tb) {
                const int tk0 = 32 * sth + 8 * tb;
                float xa[11], xb[11];
#pragma unroll
                for (int i = 0; i < 11; ++i) { const unsigned w = *(const LAS unsigned*)(L + SS_RAW + (tk0 + i) * 640 + 4 * gp); xa[i] = __uint_as_float(w << 16); xb[i] = __uint_as_float(w & 0xffff0000u); }
                float ta[8], tc[8];
#pragma unroll
                for (int j = 0; j < 8; ++j) {
                    ta[j] = fast_silu(ab + a0 * xa[j] + a1 * xa[j + 1] + a2 * xa[j + 2] + a3 * xa[j + 3]);
                    tc[j] = fast_silu(bb + b0 * xb[j] + b1 * xb[j + 1] + b2 * xb[j + 2] + b3 * xb[j + 3]);
                }
                if (gp < 32) {
                    u32x4 wa, wb;
                    wa.x = cvt_pk_bf16(ta[0], ta[1]); wa.y = cvt_pk_bf16(ta[2], ta[3]); wa.z = cvt_pk_bf16(ta[4], ta[5]); wa.w = cvt_pk_bf16(ta[6], ta[7]);
                    wb.x = cvt_pk_bf16(tc[0], tc[1]); wb.y = cvt_pk_bf16(tc[2], tc[3]); wb.z = cvt_pk_bf16(tc[4], tc[5]); wb.w = cvt_pk_bf16(tc[6], tc[7]);
                    *(LAS u32x4*)(L + SS_XST + (2 * gp) * 144 + tk0 * 2) = wa; *(LAS u32x4*)(L + SS_XST + (2 * gp + 1) * 144 + tk0 * 2) = wb;
                } else {
                    const int n0 = isB ? 2 * (gp - 32) : 2 * (gp - 96);
                    LAS unsigned char* img = L + (isB ? SS_BM : SS_CM);
#pragma unroll
                    for (int j = 0; j < 8; ++j) *(LAS unsigned*)(img + (tk0 + j) * 272 + n0 * 2) = cvt_pk_bf16(ta[j], tc[j]);
                    if (isB) {
                        float te[8];
#pragma unroll
                        for (int j = 0; j < 8; ++j) te[j] = SC[128 + tk0 + j];
                        u32x4 wa, wb;
                        wa.x = cvt_pk_bf16(ta[0] * te[0], ta[1] * te[1]); wa.y = cvt_pk_bf16(ta[2] * te[2], ta[3] * te[3]); wa.z = cvt_pk_bf16(ta[4] * te[4], ta[5] * te[5]); wa.w = cvt_pk_bf16(ta[6] * te[6], ta[7] * te[7]);
                        wb.x = cvt_pk_bf16(tc[0] * te[0], tc[1] * te[1]); wb.y = cvt_pk_bf16(tc[2] * te[2], tc[3] * te[3]); wb.z = cvt_pk_bf16(tc[4] * te[4], tc[5] * te[5]); wb.w = cvt_pk_bf16(tc[6] * te[6], tc[7] * te[7]);
                        *(LAS u32x4*)(L + SS_BWT + n0 * 144 + tk0 * 2) = wa; *(LAS u32x4*)(L + SS_BWT + (n0 + 1) * 144 + tk0 * 2) = wb;
                    }
                }
            }
        }
        if (l == 0) PROBE_END(10, C);
        PROBE_BEGIN(13);
        LDS_FENCE(); __syncthreads();
        if (l == 0) PROBE_END(13, C);
        PROBE_BEGIN(11);
        if (c + 1 < NC) SSD_DMA_RAW(c + 1);
        if (wave < 4) {
            const LAS unsigned char* HAc = L + SS_HA + par * (64 * 272);
            bf16x8 cf[8];
#pragma unroll
            for (int ks = 0; ks < 8; ++ks) cf[ks] = lds_frag(L + SS_CM, 32 * ylh + r, 272, 16 * ks + 8 * h);
            const float cuml = SC[32 * ylh + r], ecl = SC[192 + 32 * ylh + r];
            bf16x8 wf[2][2];
#pragma unroll
            for (int sh = 0; sh < 2; ++sh) {
                if (sh <= ylh) {
                    f32x16 ga;
#pragma unroll
                    for (int i = 0; i < 16; ++i) ga[i] = 0.f;
#pragma unroll
                    for (int ks = 0; ks < 8; ++ks) ga = MFMA32(lds_frag(L + SS_BM, 32 * sh + r, 272, 16 * ks + 8 * h), cf[ks], ga);
                    float wv[16];
#pragma unroll
                    for (int reg = 0; reg < 16; ++reg) {
                        const int s = 32 * sh + crow(reg, h), ll = 32 * ylh + r;
                        const float cs = SC[s], ds = SC[64 + s];
                        float w = (s <= ll) ? ga[reg] * __builtin_amdgcn_exp2f(1.4426950408889634f * (cuml - cs)) * ds : 0.f;
                        if (s == ll) w += Dh;
                        wv[reg] = w;
                    }
#pragma unroll
                    for (int s2 = 0; s2 < 2; ++s2) {
                        u32x4 p; p.x = cvt_pk_bf16(wv[8 * s2], wv[8 * s2 + 1]); p.y = cvt_pk_bf16(wv[8 * s2 + 2], wv[8 * s2 + 3]); p.z = cvt_pk_bf16(wv[8 * s2 + 4], wv[8 * s2 + 5]); p.w = cvt_pk_bf16(wv[8 * s2 + 6], wv[8 * s2 + 7]);
                        wf[sh][s2] = __builtin_bit_cast(bf16x8, p);
                    }
                }
            }
            f32x16 ya;
#pragma unroll
            for (int i = 0; i < 16; ++i) ya[i] = 0.f;
#pragma unroll
            for (int ks = 0; ks < 8; ++ks) ya = MFMA32(lds_frag(HAc, 32 * yph + r, 272, 16 * ks + 8 * h), cf[ks], ya);
#pragma unroll
            for (int i = 0; i < 16; ++i) ya[i] *= ecl;
#pragma unroll
            for (int sh = 0; sh < 2; ++sh) {
                if (sh <= ylh) {
#pragma unroll
                    for (int s2 = 0; s2 < 2; ++s2) {
                        const LAS unsigned char* xp = L + SS_XST + (32 * yph + r) * 144 + (32 * sh + 16 * s2 + 4 * h) * 2;
                        const u32x2 lo = *(const LAS u32x2*)(xp), hi = *(const LAS u32x2*)(xp + 16);
                        u32x4 a; a.x = lo.x; a.y = lo.y; a.z = hi.x; a.w = hi.y;
                        ya = MFMA32(__builtin_bit_cast(bf16x8, a), wf[sh][s2], ya);
                    }
                }
            }
            float ss = 0.f;
            bf16_t* zp = PJ + (size_t)(row0 + t0 + 32 * ylh + r) * PJW + C_Z + hd * 64 + 32 * yph + 4 * h;
#pragma unroll
            for (int gq = 0; gq < 4; ++gq) {
                const u32x2 zz = *(const LAS u32x2*)(L + SS_Z + (2 * yph + ylh) * 2048 + r * 64 + (8 * gq + 4 * h) * 2);
                const float z0 = __uint_as_float(zz.x << 16), z1 = __uint_as_float(zz.x & 0xffff0000u), z2 = __uint_as_float(zz.y << 16), z3 = __uint_as_float(zz.y & 0xffff0000u);
                const float y0 = ya[4 * gq] * fast_silu(z0), y1 = ya[4 * gq + 1] * fast_silu(z1), y2 = ya[4 * gq + 2] * fast_silu(z2), y3 = ya[4 * gq + 3] * fast_silu(z3);
                ss += (y0 * y0 + y1 * y1) + (y2 * y2 + y3 * y3);
                u32x2 w; w.x = cvt_pk_bf16(y0, y1); w.y = cvt_pk_bf16(y2, y3);
                *(u32x2*)(zp + 8 * gq) = w;
            }
            ss = xor32_sum(ss);
            if (h == 0) { float* q = C.ssq() + (size_t)(row0 + t0 + 32 * ylh + r) * 64 + hd * 4 + yph; q[0] = ss; q[2] = 0.f; }
            LDS_FENCE();
            if (c + 1 < NC) SSD_DMA_Z(c + 1);
        } else {
            if (wave == 7 && c + 1 < NC) SSD_S0(c + 1);
            const float decay = SC[192 + 63];
#pragma unroll
            for (int i = 0; i < 16; ++i) { hacc0[i] *= decay; hacc1[i] *= decay; }
#pragma unroll
            for (int ks = 0; ks < 4; ++ks) {
                const bf16x8 xb = lds_frag(L + SS_XST, 32 * sph + r, 144, 16 * ks + 8 * h);
                hacc0 = MFMA32(lds_frag(L + SS_BWT, 32 * nq0 + r, 144, 16 * ks + 8 * h), xb, hacc0);
                hacc1 = MFMA32(lds_frag(L + SS_BWT, 32 * (nq0 + 1) + r, 144, 16 * ks + 8 * h), xb, hacc1);
            }
            LAS unsigned char* HAn = L + SS_HA + (par ^ 1) * (64 * 272);
#pragma unroll
            for (int gq = 0; gq < 4; ++gq) {
                u32x2 w0, w1; w0.x = cvt_pk_bf16(hacc0[4 * gq], hacc0[4 * gq + 1]); w0.y = cvt_pk_bf16(hacc0[4 * gq + 2], hacc0[4 * gq + 3]);
                w1.x = cvt_pk_bf16(hacc1[4 * gq], hacc1[4 * gq + 1]); w1.y = cvt_pk_bf16(hacc1[4 * gq + 2], hacc1[4 * gq + 3]);
                *(LAS u32x2*)(HAn + (32 * sph + r) * 272 + (32 * nq0 + 8 * gq + 4 * h) * 2) = w0;
                *(LAS u32x2*)(HAn + (32 * sph + r) * 272 + (32 * (nq0 + 1) + 8 * gq + 4 * h) * 2) = w1;
            }
        }
        if (l == 0) PROBE_END(11, C);
    }
    if (wave >= 4) {
        float* o = out_sh(C, l, sb) + ((size_t)hd * 64 + 32 * sph + r) * 128;
#pragma unroll
        for (int gq = 0; gq < 4; ++gq) {
            f32x4 v0, v1;
#pragma unroll
            for (int e = 0; e < 4; ++e) { v0[e] = hacc0[4 * gq + e]; v1[e] = hacc1[4 * gq + e]; }
            *(f32x4*)(o + 32 * nq0 + 8 * gq + 4 * h) = v0; *(f32x4*)(o + 32 * (nq0 + 1) + 8 * gq + 4 * h) = v1;
        }
    }
    __syncthreads();
#undef SSD_DMA_RAW
#undef SSD_DMA_Z
#undef SSD_S0
}

DI unsigned mono_key(float f) { const unsigned u = __float_as_uint(f); return (u & 0x80000000u) ? ~u : (u | 0x80000000u); }
DI int t5_bucket(int rel) {
    const int n = rel < 0 ? -rel : rel; int b;
    if (n < 8) b = n; else if (n < 12) b = 8; else if (n < 16) b = 9; else if (n < 23) b = 10; else if (n < 32) b = 11; else if (n < 46) b = 12; else if (n < 64) b = 13; else if (n < 91) b = 14; else b = 15;
    return b + (rel > 0 ? 16 : 0);
}
constexpr int AT_MASK = 0;
constexpr int AT_TMASK = AT_MASK + 64 * 65 * 4;
constexpr int AT_QST = AT_TMASK + 64 * 65 * 4;
constexpr int AT_MISC = AT_QST + 1024;
constexpr int AT_LUT = AT_MISC + 64;
constexpr int AT_HIST = AT_LUT + 8192;
constexpr int AT_RING = AT_HIST;
constexpr int AT_QI = AT_HIST + 65792;
constexpr int AT_END = AT_QI + 64 * 528;
static_assert(AT_END <= LDS_BYTES - 256 && AT_RING + 65536 <= AT_END, "attention LDS map");
typedef short v4i16_t __attribute__((ext_vector_type(4)));
DI float max3f(float a, float b, float c) { float r; asm("v_max3_f32 %0, %1, %2, %3" : "=v"(r) : "v"(a), "v"(b), "v"(c)); return r; }
#define AT_WAIT_V(n) asm volatile("s_waitcnt vmcnt(" #n ")" ::: "memory")
#define AT_BAR() do { asm volatile("s_waitcnt lgkmcnt(0)" ::: "memory"); __builtin_amdgcn_s_barrier(); asm volatile("" ::: "memory"); } while (0)

template <int MODE, bool FIRST>
DI void idx_pass(const Ctx& C, const bf16_t* KV, const float (&w4)[4], int ntiles, int tq4, int qh, int r, int h) {
    LAS unsigned char* L = C.lds;
    const int q = 32 * qh + r, lane = 32 * h + r;
    const LAS unsigned* QS = (const LAS unsigned*)(L + AT_QST) + 4 * q;
    const unsigned pfx = QS[0], info = QS[1];
    const int lvl = info & 15; const bool done = (info >> 4) & 1, tie = (info >> 5) & 1;
    const int sh = (MODE == 0) ? (lvl == 0 ? 23 : (lvl == 1 ? 14 : (lvl == 2 ? 5 : 0))) : (int)(info >> 8);
    const unsigned bmask = (lvl == 3) ? 31u : 511u;
    const int psh = (lvl == 1) ? 23 : (lvl == 2 ? 14 : 5);
    unsigned* KS = C.keys();
    bf16x8 an[2][4];
    if (FIRST && tq4 < ntiles) {
#pragma unroll
        for (int kh = 0; kh < 2; ++kh)
#pragma unroll
            for (int ks = 0; ks < 4; ++ks) an[kh][ks] = *(const bf16x8*)(KV + (size_t)(64 * tq4 + 32 * kh + r) * KVW + 256 + 8 * h + 16 * ks);
    }
    for (int t = tq4; t < ntiles; t += 4) {
        bf16x8 ac[2][4];
        if (FIRST) {
#pragma unroll
            for (int kh = 0; kh < 2; ++kh)
#pragma unroll
                for (int ks = 0; ks < 4; ++ks) ac[kh][ks] = an[kh][ks];
            if (t + 4 < ntiles) {
#pragma unroll
                for (int kh = 0; kh < 2; ++kh)
#pragma unroll
                    for (int ks = 0; ks < 4; ++ks) an[kh][ks] = *(const bf16x8*)(KV + (size_t)(64 * (t + 4) + 32 * kh + r) * KVW + 256 + 8 * h + 16 * ks);
            }
        }
#pragma unroll
        for (int kh = 0; kh < 2; ++kh) {
            unsigned* kslot = KS + (size_t)((t * 2 + kh) * 2 + qh) * 1024 + lane;
            unsigned key[16];
            if (FIRST) {
                float sc[16];
#pragma unroll
                for (int i = 0; i < 16; ++i) sc[i] = 0.f;
#pragma unroll
                for (int hh = 0; hh < 4; ++hh) {
                    f32x16 acc;
#pragma unroll
                    for (int i = 0; i < 16; ++i) acc[i] = 0.f;
#pragma unroll
                    for (int ks = 0; ks < 4; ++ks) acc = MFMA32(ac[kh][ks], *(const LAS bf16x8*)(L + AT_QI + q * 528 + (64 * hh + 16 * ks + 8 * h) * 2), acc);
#pragma unroll
                    for (int i = 0; i < 16; ++i) sc[i] += w4[hh] * fmaxf(acc[i], 0.f);
                }
#pragma unroll
                for (int i = 0; i < 16; ++i) { key[i] = mono_key(sc[i]); kslot[64 * i] = key[i]; }
            } else {
#pragma unroll
                for (int i = 0; i < 16; ++i) key[i] = __hip_atomic_load(kslot + 64 * i, __ATOMIC_RELAXED, __HIP_MEMORY_SCOPE_AGENT);
            }
            if (MODE == 0) {
                if (!done) {
                    LAS unsigned* HR = (LAS unsigned*)(L + AT_HIST) + 257 * q;
#pragma unroll
                    for (int i = 0; i < 16; ++i) {
                        const bool part = (lvl == 0) || ((key[i] >> psh) == pfx);
                        if (part) { const unsigned bin = (key[i] >> sh) & bmask; atomicAdd((unsigned*)(HR + (bin >> 1)), 1u << ((bin & 1u) << 4)); }
                    }
                }
            } else {
                unsigned mw = 0u, tw = 0u;
#pragma unroll
                for (int i = 15; i >= 0; --i) {
                    const bool sel = tie ? (key[i] > pfx) : ((key[i] >> sh) >= pfx);
                    const bool tb = tie && (key[i] == pfx);
                    mw = (mw << 1) | (sel ? 1u : 0u); tw = (tw << 1) | (tb ? 1u : 0u);
                    if ((i & 3) == 0 && i > 0) { mw <<= 4; tw <<= 4; }
                }
                mw <<= 4 * h; tw <<= 4 * h;
                if (mw) atomicOr((unsigned*)((LAS unsigned*)(L + AT_MASK) + 65 * q + 2 * t + kh), mw);
                if (tw) atomicOr((unsigned*)((LAS unsigned*)(L + AT_TMASK) + 65 * q + 2 * t + kh), tw);
            }
        }
    }
    if (FIRST) asm volatile("s_waitcnt vmcnt(0)" ::: "memory");
}

DI void attn_item(const Ctx& C, int l, int sb, int qb) {
    const int tid = C.tid, lane = C.lane, wave = C.wave, r = lane & 31, h = lane >> 5;
    LAS unsigned char* L = C.lds;
    const int P = sb_P(sb), row0 = sb_row0(sb), t0 = 64 * qb, pos0 = P + t0;
    const int ntiles = (pos0 >> 6) + 1, Ladm = 64 * ntiles;
    bf16_t* PJ = C.proj(); const bf16_t* KV = C.kvb(l) + kvb_off(sb);
    LAS unsigned* MASK = (LAS unsigned*)(L + AT_MASK); LAS unsigned* TMASK = (LAS unsigned*)(L + AT_TMASK);
    LAS unsigned* QST = (LAS unsigned*)(L + AT_QST); LAS unsigned* MISC = (LAS unsigned*)(L + AT_MISC);
#ifdef PROBE_QB
    const bool pcond = (l == 0 && sb == 0 && qb == PROBE_QB);
#else
    const bool pcond = false;
#endif
    PROBE_BEGIN(40); PROBE_BEGIN(41);
    for (int i = tid; i < 64 * 65; i += NTHREADS) { const int w = i % 65; MASK[i] = (Ladm <= 256 && w < 2 * ntiles) ? 0xffffffffu : 0u; TMASK[i] = 0u; }
    for (int i = tid; i < 64 * 257; i += NTHREADS) ((LAS unsigned*)(L + AT_HIST))[i] = 0u;
    if (tid < 64) { unsigned k256 = 256u; asm volatile("" : "+v"(k256)); QST[4 * tid] = 0u; QST[4 * tid + 1] = 0u; QST[4 * tid + 2] = k256; QST[4 * tid + 3] = 0u; }
    for (int i = tid; i < 8 * 256; i += NTHREADS) { const int hq = i >> 8, rel = (i & 255) - 191; ((LAS float*)(L + AT_LUT))[i] = 1.4426950408889634f * (C.inp(20)[t5_bucket(rel) * 8 + hq] - C.inp(20)[15 * 8 + hq]); }
    if (tid == 0) MISC[0] = 0u;
    __syncthreads();
    if (pcond) PROBE_END(41, C);
    PROBE_BEGIN(4); PROBE_BEGIN(42);
    if (Ladm > 256) {
        const int qh = wave & 1, tq4 = wave >> 1, q = 32 * qh + r;
        float w4[4];
        { const f32x4 wv = *(const f32x4*)(C.wi() + (size_t)(row0 + t0 + q) * 4); w4[0] = wv[0]; w4[1] = wv[1]; w4[2] = wv[2]; w4[3] = wv[3]; }
        for (int i = tid; i < 2048; i += NTHREADS) { const int qq = i >> 5, pc = i & 31;
            *(LAS u32x4*)(L + AT_QI + qq * 528 + pc * 16) = *(const u32x4*)(PJ + (size_t)(row0 + t0 + qq) * PJW + C_QI + 8 * pc); }
        __syncthreads();
        for (int lvl = 0; lvl < 4; ++lvl) {
            PROBE_BEGIN(20);
            if (lvl == 0) idx_pass<0, true>(C, KV, w4, ntiles, tq4, qh, r, h); else idx_pass<0, false>(C, KV, w4, ntiles, tq4, qh, r, h);
            if (tid == 0) MISC[0] = 0u;
            __syncthreads();
            if (l == 0) PROBE_END(20, C);
            PROBE_BEGIN(21);
            int ln = lane; asm volatile("" : "+v"(ln));
            for (int qq = 8 * wave; qq < 8 * wave + 8; ++qq) {
                const unsigned pfx = QST[4 * qq], info = QST[4 * qq + 1], need = QST[4 * qq + 2];
                if ((info >> 4) & 1) continue;
                LAS unsigned* HR = (LAS unsigned*)(L + AT_HIST) + 257 * qq + 4 * ln;
                unsigned c[8];
#pragma unroll
                for (int j = 0; j < 4; ++j) { const unsigned wv = HR[j]; c[2 * j] = wv & 0xffffu; c[2 * j + 1] = wv >> 16; HR[j] = 0u; }
                unsigned ct = 0u;
#pragma unroll
                for (int j = 0; j < 8; ++j) ct += c[j];
                unsigned S = ct;
#pragma unroll
                for (int o = 1; o < 64; o <<= 1) { const unsigned y = (unsigned)__builtin_amdgcn_ds_bpermute((ln + o) << 2, (int)S); if (ln + o < 64) S += y; }
                if (S >= need && (S - ct) < need) {
                    unsigned rem = need - (S - ct), cum = 0u; int b = 0; unsigned cb = 0u;
                    bool found = false;
#pragma unroll
                    for (int j = 7; j >= 0; --j) { if (!found) { if (cum + c[j] >= rem) { b = j; cb = c[j]; found = true; } else cum += c[j]; } }
                    const unsigned need2 = rem - cum, binidx = 8u * ln + (unsigned)b;
                    const int bits = (lvl == 3) ? 5 : 9, shc = (lvl == 0) ? 23 : (lvl == 1 ? 14 : (lvl == 2 ? 5 : 0));
                    const unsigned npfx = (lvl == 0) ? binidx : ((pfx << bits) | binidx);
                    unsigned ninfo, nneed = need2, opfx = npfx;
                    if (need2 == cb) ninfo = (unsigned)lvl | 16u | ((unsigned)shc << 8);
                    else if (lvl == 0 && (binidx == 256u || binidx == 255u)) { ninfo = 16u | 32u; opfx = (binidx == 256u) ? 0x80000000u : 0x7fffffffu; }
                    else if (lvl == 3) ninfo = 16u | 32u;
                    else { ninfo = (unsigned)(lvl + 1); atomicAdd((unsigned*)MISC, 1u); }
                    QST[4 * qq] = opfx; QST[4 * qq + 1] = ninfo; QST[4 * qq + 2] = nneed;
                }
            }
            __syncthreads();
            if (l == 0) PROBE_END(21, C);
            if (MISC[0] == 0u) break;
            __syncthreads();
        }
        PROBE_BEGIN(22);
        idx_pass<1, false>(C, KV, w4, ntiles, tq4, qh, r, h);
        __syncthreads();
        if (l == 0) PROBE_END(22, C);
        PROBE_BEGIN(23);
        int ln2 = lane; asm volatile("" : "+v"(ln2));
        for (int qq = 8 * wave; qq < 8 * wave + 8; ++qq) {
            if (!((QST[4 * qq + 1] >> 5) & 1)) continue;
            const unsigned mwd = (ln2 < 2 * ntiles) ? MASK[65 * qq + ln2] : 0u, twd = (ln2 < 2 * ntiles) ? TMASK[65 * qq + ln2] : 0u;
            int have = __popc(mwd);
#pragma unroll
            for (int o = 1; o < 64; o <<= 1) have += __builtin_amdgcn_ds_bpermute((ln2 ^ o) << 2, have);
            const int want = 256 - have, pc = __popc(twd);
            int incl = pc;
#pragma unroll
            for (int o = 1; o < 64; o <<= 1) { const int y = __builtin_amdgcn_ds_bpermute((ln2 - o) << 2, incl); if (ln2 >= o) incl += y; }
            int take = want - (incl - pc); take = take < 0 ? 0 : (take > pc ? pc : take);
            unsigned wrem = twd, add = 0u;
            for (int k = 0; k < take; ++k) { add |= wrem & (0u - wrem); wrem &= wrem - 1u; }
            if (add) MASK[65 * qq + ln2] = mwd | add;
        }
        __syncthreads();
        if (l == 0) PROBE_END(23, C);
    }
    if (l == 0) PROBE_END(4, C);
    if (pcond) PROBE_END(42, C);
    PROBE_BEGIN(43);
    PROBE_BEGIN(5);
    const int hq = wave, kvh = wave >> 2;
    const unsigned ring = (unsigned)(size_t)(L + AT_RING);
    const float* LUT = nullptr; (void)LUT;
    const LAS float* lut = (const LAS float*)(L + AT_LUT) + 256 * hq;
    const float cfar = 1.4426950408889634f * C.inp(20)[15 * 8 + hq];
#define AT_DMA(tt, slot) do { const bf16_t* src_ = KV + (size_t)(64 * (tt)) * KVW; \
        _Pragma("unroll") for (int i_ = 0; i_ < 2; ++i_) { const int k_ = wave * 2 + i_, row_ = 4 * k_ + (lane >> 4), pc_ = lane & 15; \
            __builtin_amdgcn_global_load_lds((const unsigned*)(src_ + (size_t)row_ * KVW + 8 * (pc_ ^ (row_ & 15))), (LAS unsigned*)(L + AT_RING + (slot) * 32768 + k_ * 1024), 16, 0, 0); \
            __builtin_amdgcn_global_load_lds((const unsigned*)(src_ + (size_t)row_ * KVW + 128 + 8 * pc_), (LAS unsigned*)(L + AT_RING + (slot) * 32768 + 16384 + k_ * 1024), 16, 0, 0); } \
    } while (0)
    bf16x8 qfA[4], qfB[4];
#pragma unroll
    for (int qh = 0; qh < 2; ++qh) {
        const bf16_t* qp = PJ + (size_t)(row0 + t0 + 32 * qh + r) * PJW + C_Q + hq * 64 + 8 * h; float qv[4][8]; float ss = 0.f;
#pragma unroll
        for (int ks = 0; ks < 4; ++ks) { const u32x4 v = *(const u32x4*)(qp + 16 * ks);
            qv[ks][0] = __uint_as_float(v.x << 16); qv[ks][1] = __uint_as_float(v.x & 0xffff0000u); qv[ks][2] = __uint_as_float(v.y << 16); qv[ks][3] = __uint_as_float(v.y & 0xffff0000u);
            qv[ks][4] = __uint_as_float(v.z << 16); qv[ks][5] = __uint_as_float(v.z & 0xffff0000u); qv[ks][6] = __uint_as_float(v.w << 16); qv[ks][7] = __uint_as_float(v.w & 0xffff0000u);
#pragma unroll
            for (int j = 0; j < 8; ++j) ss += qv[ks][j] * qv[ks][j]; }
        ss = xor32_sum(ss);
        const float sc = rsqrtf(ss * (1.f / 64.f) + EPS) * (0.125f * 1.4426950408889634f);
        const float* qn = C.inp(18) + l * 64 + 8 * h;
#pragma unroll
        for (int ks = 0; ks < 4; ++ks) { const f32x4 n0 = *(const f32x4*)(qn + 16 * ks), n1 = *(const f32x4*)(qn + 16 * ks + 4);
            u32x4 p; p.x = cvt_pk_bf16(qv[ks][0] * sc * n0[0], qv[ks][1] * sc * n0[1]); p.y = cvt_pk_bf16(qv[ks][2] * sc * n0[2], qv[ks][3] * sc * n0[3]);
            p.z = cvt_pk_bf16(qv[ks][4] * sc * n1[0], qv[ks][5] * sc * n1[1]); p.w = cvt_pk_bf16(qv[ks][6] * sc * n1[2], qv[ks][7] * sc * n1[3]);
            if (qh == 0) qfA[ks] = __builtin_bit_cast(bf16x8, p); else qfB[ks] = __builtin_bit_cast(bf16x8, p); }
    }
    f32x16 oA0, oA1, oB0, oB1;
#pragma unroll
    for (int i = 0; i < 16; ++i) { oA0[i] = 0.f; oA1[i] = 0.f; oB0[i] = 0.f; oB1[i] = 0.f; }
    float mrefA = 0.f, lrunA = 0.f, mrefB = 0.f, lrunB = 0.f;
#define AT_HALF(QF, QQ, MREF, LRUN, O0, O1, PW) do { \
        f32x16 s0, s1; { const float ini = cfar - MREF; _Pragma("unroll") for (int i = 0; i < 16; ++i) { s0[i] = ini; s1[i] = ini; } } \
        _Pragma("unroll") for (int ks = 0; ks < 4; ++ks) { s0 = MFMA32(kf0[ks], QF[ks], s0); s1 = MFMA32(kf1[ks], QF[ks], s1); } \
        const int nm0 = (int)(~(MASK[65 * (QQ) + 2 * t] >> (4 * h))), nm1 = (int)(~(MASK[65 * (QQ) + 2 * t + 1] >> (4 * h))); \
        if (nearb) { _Pragma("unroll") for (int i = 0; i < 16; ++i) { const int kl = (i & 3) + 8 * (i >> 2), rel = 64 * t + kl + 4 * h - (pos0 + (QQ)); s0[i] += lut[rel + 191]; s1[i] += lut[rel + 32 + 191]; } } \
        _Pragma("unroll") for (int i = 0; i < 16; ++i) { const int kl = (i & 3) + 8 * (i >> 2); \
            s0[i] += __int_as_float(__builtin_amdgcn_sbfe(nm0, kl, 1) & (int)0xff800000u); s1[i] += __int_as_float(__builtin_amdgcn_sbfe(nm1, kl, 1) & (int)0xff800000u); } \
        float tm; { float a = max3f(s0[0], s0[1], s1[0]), b = max3f(s0[2], s0[3], s1[1]); a = max3f(a, s1[2], s1[3]); \
            _Pragma("unroll") for (int i = 4; i < 16; i += 4) { a = max3f(a, s0[i], s0[i + 1]); b = max3f(b, s0[i + 2], s0[i + 3]); a = max3f(a, s1[i], s1[i + 1]); b = max3f(b, s1[i + 2], s1[i + 3]); } \
            tm = xor32_max(fmaxf(a, b)); } \
        if (__builtin_amdgcn_ballot_w64(tm > 0.f) != 0ull) { const float dl = fmaxf(tm, 0.f), al = __builtin_amdgcn_exp2f(-dl); MREF += dl; LRUN *= al; \
            _Pragma("unroll") for (int i = 0; i < 16; ++i) { s0[i] -= dl; s1[i] -= dl; O0[i] *= al; O1[i] *= al; } } \
        float psum = 0.f; \
        _Pragma("unroll") for (int i = 0; i < 16; ++i) { s0[i] = __builtin_amdgcn_exp2f(s0[i]); s1[i] = __builtin_amdgcn_exp2f(s1[i]); psum += s0[i] + s1[i]; } \
        LRUN += psum; \
        _Pragma("unroll") for (int kk = 0; kk < 2; ++kk) { u32x4 w0, w1; \
            w0.x = cvt_pk_bf16(s0[8 * kk], s0[8 * kk + 1]); w0.y = cvt_pk_bf16(s0[8 * kk + 2], s0[8 * kk + 3]); w0.z = cvt_pk_bf16(s0[8 * kk + 4], s0[8 * kk + 5]); w0.w = cvt_pk_bf16(s0[8 * kk + 6], s0[8 * kk + 7]); \
            w1.x = cvt_pk_bf16(s1[8 * kk], s1[8 * kk + 1]); w1.y = cvt_pk_bf16(s1[8 * kk + 2], s1[8 * kk + 3]); w1.z = cvt_pk_bf16(s1[8 * kk + 4], s1[8 * kk + 5]); w1.w = cvt_pk_bf16(s1[8 * kk + 6], s1[8 * kk + 7]); \
            PW[kk] = __builtin_bit_cast(bf16x8, w0); PW[2 + kk] = __builtin_bit_cast(bf16x8, w1); } \
    } while (0)
    AT_WAIT_V(0);
    AT_DMA(0, 0);
    if (ntiles > 1) AT_DMA(1, 1);
    int sl = 0, sl2 = 2;
    for (int t = 0; t < ntiles; ++t) {
        if (t + 1 < ntiles) { AT_WAIT_V(4); } else { AT_WAIT_V(0); }
        AT_BAR();
        if (t + 2 < ntiles) AT_DMA(t + 2, sl2);
        const LAS unsigned char* Kt = L + AT_RING + sl * 32768; const LAS unsigned char* Vt = Kt + 16384;
        bf16x8 kf0[4], kf1[4];
#pragma unroll
        for (int ks = 0; ks < 4; ++ks) { const int pc = kvh * 8 + 2 * ks + h;
            kf0[ks] = *(const LAS bf16x8*)(Kt + r * 256 + ((pc ^ (r & 15)) << 4)); kf1[ks] = *(const LAS bf16x8*)(Kt + (32 + r) * 256 + ((pc ^ (r & 15)) << 4)); }
        const bool nearb = (t + 3 > ntiles - 1);
        bf16x8 pA[4], pB[4];
        AT_HALF(qfA, r, mrefA, lrunA, oA0, oA1, pA);
        AT_HALF(qfB, 32 + r, mrefB, lrunB, oB0, oB1, pB);
#pragma unroll
        for (int kk = 0; kk < 4; ++kk) {
            const int i16 = lane & 15, key0 = 16 * kk + 4 * h + (i16 >> 2);
#pragma unroll
            for (int dh = 0; dh < 2; ++dh) {
                const int dcol = kvh * 64 + 32 * dh + 16 * ((lane >> 4) & 1) + 4 * (i16 & 3);
                const v4i16_t lo = __builtin_amdgcn_ds_read_tr16_b64_v4i16((LAS v4i16_t*)(Vt + key0 * 256 + dcol * 2));
                const v4i16_t hi = __builtin_amdgcn_ds_read_tr16_b64_v4i16((LAS v4i16_t*)(Vt + (key0 + 8) * 256 + dcol * 2));
                const bf16x8 va = (bf16x8){lo[0], lo[1], lo[2], lo[3], hi[0], hi[1], hi[2], hi[3]};
                if (dh == 0) { oA0 = MFMA32(va, pA[kk], oA0); oB0 = MFMA32(va, pB[kk], oB0); } else { oA1 = MFMA32(va, pA[kk], oA1); oB1 = MFMA32(va, pB[kk], oB1); }
            }
        }
        sl2 = sl; sl = (sl == 2) ? 0 : sl + 1; sl2 = (sl == 0) ? 2 : sl - 1;
    }
#undef AT_HALF
#pragma unroll
    for (int qh = 0; qh < 2; ++qh) {
        const float inv = 1.f / xor32_sum(qh == 0 ? lrunA : lrunB);
        bf16_t* gp = PJ + (size_t)(row0 + t0 + 32 * qh + r) * PJW + C_GA + hq * 64 + 4 * h;
#pragma unroll
        for (int dh = 0; dh < 2; ++dh)
#pragma unroll
            for (int gq = 0; gq < 4; ++gq) {
                const u32x2 gg = *(const u32x2*)(gp + 32 * dh + 8 * gq);
                const float g0 = __uint_as_float(gg.x << 16), g1 = __uint_as_float(gg.x & 0xffff0000u), g2 = __uint_as_float(gg.y << 16), g3 = __uint_as_float(gg.y & 0xffff0000u);
                const f32x16& oo = (qh == 0) ? (dh == 0 ? oA0 : oA1) : (dh == 0 ? oB0 : oB1);
                const float a0 = oo[4 * gq] * inv, a1 = oo[4 * gq + 1] * inv, a2 = oo[4 * gq + 2] * inv, a3 = oo[4 * gq + 3] * inv;
                u32x2 w; w.x = cvt_pk_bf16(a0 * fast_silu(g0), a1 * fast_silu(g1)); w.y = cvt_pk_bf16(a2 * fast_silu(g2), a3 * fast_silu(g3));
                *(u32x2*)(gp + 32 * dh + 8 * gq) = w;
            }
    }
#undef AT_DMA
    AT_WAIT_V(0);
    __syncthreads();
    if (l == 0) PROBE_END(5, C);
    if (pcond) { PROBE_END(43, C); PROBE_END(40, C); }
}

constexpr int LR_RAW = 0;
constexpr int LR_GL = LR_RAW + 67 * 128;
constexpr int LR_XC = LR_GL + 2 * 8192;
constexpr int LR_XCF = LR_XC + 64 * 144;
constexpr int LR_SEG = LR_XCF + 64 * 256;
constexpr int LR_YS = LR_SEG + 2048;
constexpr int LR_END = LR_YS + 8192;
static_assert(LR_END <= LDS_BYTES - 256, "LRU LDS map");
typedef float f32x4v __attribute__((ext_vector_type(4)));
#define MFMA16(a, b, c) __builtin_amdgcn_mfma_f32_16x16x32_bf16((a), (b), (c), 0, 0, 0)
DI float fast_sigmoid(float x) { return __builtin_amdgcn_rcpf(1.f + __builtin_amdgcn_exp2f(-1.4426950408889634f * x)); }

DI void lru_item(const Ctx& C, int l, int sb, int blk) {
    const int tid = C.tid, lane = C.lane, wave = C.wave, fr = lane & 15, fq = lane >> 4;
    const int T = sb_T(sb), row0 = sb_row0(sb), NC = T / 64;
    LAS unsigned char* L = C.lds;
    bf16_t* PJ = C.proj();
    const int ts = wave >> 1, dh = wave & 1;
    bf16x8 wf[2][2][2];
#pragma unroll
    for (int gt = 0; gt < 2; ++gt)
#pragma unroll
        for (int db = 0; db < 2; ++db)
#pragma unroll
            for (int kb = 0; kb < 2; ++kb) {
                const float* wp = (gt == 0 ? C.inp(13) : C.inp(15)) + ((size_t)(l * 8 + blk) * 64 + 32 * kb + 8 * fq) * 64 + 32 * dh + 16 * db + fr;
                u32x4 p; p.x = cvt_pk_bf16(wp[0], wp[64]); p.y = cvt_pk_bf16(wp[128], wp[192]); p.z = cvt_pk_bf16(wp[256], wp[320]); p.w = cvt_pk_bf16(wp[384], wp[448]);
                wf[gt][db][kb] = __builtin_bit_cast(bf16x8, p);
            }
    float ba[2], bx[2], spl[2], hc[2];
#pragma unroll
    for (int db = 0; db < 2; ++db) {
        const int ch = blk * 64 + 32 * dh + 16 * db + fr;
        ba[db] = C.inp(14)[l * 512 + ch]; bx[db] = C.inp(16)[l * 512 + ch]; spl[db] = 8.f * 1.4426950408889634f * softplus_f(-C.inp(17)[l * 512 + ch]);
        hc[db] = (sb >= NPB) ? C.inp(6)[(size_t)(l * NSB_S + sb - NPB) * 512 + ch] : 0.f;
    }
    const int cp = tid & 31, sg = tid >> 5;
    float cw[2][5];
#pragma unroll
    for (int e = 0; e < 2; ++e) { const int ch = blk * 64 + 2 * cp + e;
#pragma unroll
        for (int j = 0; j < 4; ++j) cw[e][j] = C.inp(11)[((size_t)l * 4 + j) * 512 + ch];
        cw[e][4] = C.inp(12)[l * 512 + ch]; }
#define LRU_DMA(cc) do { const int t0_ = 64 * (cc); \
        for (int k_ = wave; k_ < 9; k_ += NWAVES) { const int q_ = 64 * k_ + lane, rr_ = q_ >> 3, pc_ = q_ & 7, t_ = t0_ - 3 + rr_; \
            if (q_ < 536 && t_ >= 0) __builtin_amdgcn_global_load_lds((const unsigned*)(PJ + (size_t)(row0 + t_) * PJW + C_XL + blk * 64 + 8 * pc_), (LAS unsigned*)(L + LR_RAW + k_ * 1024), 16, 0, 0); } \
        { const int rr_ = 8 * wave + (lane >> 3), pc_ = lane & 7; \
          __builtin_amdgcn_global_load_lds((const unsigned*)(PJ + (size_t)(row0 + t0_ + rr_) * PJW + C_GL + blk * 64 + 8 * pc_), (LAS unsigned*)(L + LR_GL + ((cc) & 1) * 8192 + wave * 1024), 16, 0, 0); } \
    } while (0)
    if (tid < 24) {
        const int rr = tid >> 3, pc = tid & 7; u32x4 v = (u32x4){0u, 0u, 0u, 0u};
        if (sb >= NPB) { const float* st = C.inp(5) + ((size_t)(l * NSB_S + sb - NPB) * 3 + rr) * 512 + blk * 64 + 8 * pc; v = pack8(*(const f32x4*)st, *(const f32x4*)(st + 4)); }
        *(LAS u32x4*)(L + LR_RAW + rr * 128 + pc * 16) = v;
    }
    LRU_DMA(0);
    asm volatile("s_waitcnt vmcnt(0)" ::: "memory");
    __syncthreads();
    for (int c = 0; c < NC; ++c) {
        const int t0 = 64 * c;
        {
            float xa[7], xb[7];
#pragma unroll
            for (int i = 0; i < 7; ++i) { const unsigned w = *(const LAS unsigned*)(L + LR_RAW + (4 * sg + i) * 128 + 4 * cp); xa[i] = __uint_as_float(w << 16); xb[i] = __uint_as_float(w & 0xffff0000u); }
#pragma unroll
            for (int j = 0; j < 4; ++j) {
                const float ya = cw[0][4] + cw[0][0] * xa[j] + cw[0][1] * xa[j + 1] + cw[0][2] * xa[j + 2] + cw[0][3] * xa[j + 3];
                const float yb = cw[1][4] + cw[1][0] * xb[j] + cw[1][1] * xb[j + 1] + cw[1][2] * xb[j + 2] + cw[1][3] * xb[j + 3];
                *(LAS unsigned*)(L + LR_XC + (4 * sg + j) * 144 + 4 * cp) = cvt_pk_bf16(ya, yb);
                f32x2_t v2 = {ya, yb}; *(LAS f32x2_t*)(L + LR_XCF + (4 * sg + j) * 256 + 8 * cp) = v2;
            }
        }
        LDS_FENCE(); __syncthreads();
        if (c + 1 < NC) LRU_DMA(c + 1);
        f32x4v ga[2], gx[2];
#pragma unroll
        for (int db = 0; db < 2; ++db) { ga[db] = (f32x4v){0.f, 0.f, 0.f, 0.f}; gx[db] = (f32x4v){0.f, 0.f, 0.f, 0.f}; }
#pragma unroll
        for (int kb = 0; kb < 2; ++kb) {
            const bf16x8 af = *(const LAS bf16x8*)(L + LR_XC + (16 * ts + fr) * 144 + (32 * kb + 8 * fq) * 2);
#pragma unroll
            for (int db = 0; db < 2; ++db) { ga[db] = MFMA16(af, wf[0][db][kb], ga[db]); gx[db] = MFMA16(af, wf[1][db][kb], gx[db]); }
        }
        float Pk[2][4], Hk[2][4], Pq[2], Hq[2];
#pragma unroll
        for (int db = 0; db < 2; ++db) {
            float P = 1.f, H = 0.f;
#pragma unroll
            for (int reg = 0; reg < 4; ++reg) {
                const float xc = *(const LAS float*)(L + LR_XCF + (16 * ts + 4 * fq + reg) * 256 + (32 * dh + 16 * db + fr) * 4);
                const float rg = fast_sigmoid(ga[db][reg] + ba[db]), ig = fast_sigmoid(gx[db][reg] + bx[db]);
                const float a = __builtin_amdgcn_exp2f(-rg * spl[db]);
                const float b = sqrtf(fmaxf(1.f - a * a, 0.f)) * (ig * xc);
                H = a * H + b; P = a * P; Pk[db][reg] = P; Hk[db][reg] = H;
            }
            float Pi = P, Hi = H;
            { const float Pp = bperm(Pi, lane - 16), Hp = bperm(Hi, lane - 16); if (fq >= 1) { Hi = Pi * Hp + Hi; Pi = Pi * Pp; } }
            { const float Pp = bperm(Pi, lane - 32), Hp = bperm(Hi, lane - 32); if (fq >= 2) { Hi = Pi * Hp + Hi; Pi = Pi * Pp; } }
            if (fq == 3) { f32x2_t v2 = {Pi, Hi}; *(LAS f32x2_t*)(L + LR_SEG + (ts * 64 + 32 * dh + 16 * db + fr) * 8) = v2; }
            const float Pe = bperm(Pi, lane - 16), He = bperm(Hi, lane - 16);
            Pq[db] = (fq >= 1) ? Pe : 1.f; Hq[db] = (fq >= 1) ? He : 0.f;
        }
        LDS_FENCE(); __syncthreads();
#pragma unroll
        for (int db = 0; db < 2; ++db) {
            float s = hc[db], sin = hc[db];
#pragma unroll
            for (int k = 0; k < 4; ++k) { const f32x2_t m = *(const LAS f32x2_t*)(L + LR_SEG + (k * 64 + 32 * dh + 16 * db + fr) * 8); if (k == ts) sin = s; s = m[0] * s + m[1]; }
            hc[db] = s;
            const float hin = Pq[db] * sin + Hq[db];
            const bf16_t* glp = nullptr; (void)glp;
#pragma unroll
            for (int reg = 0; reg < 4; ++reg) {
                const float hval = Pk[db][reg] * hin + Hk[db][reg];
                const int t = 16 * ts + 4 * fq + reg, d = 32 * dh + 16 * db + fr;
                const float glv = bf2f(*(const LAS bf16_t*)(L + LR_GL + (c & 1) * 8192 + t * 128 + d * 2));
                *(LAS bf16_t*)(L + LR_YS + t * 128 + d * 2) = f2bf(hval * fast_silu(glv));
            }
        }
        asm volatile("s_waitcnt vmcnt(0)" ::: "memory");
        LDS_FENCE(); __syncthreads();
        { const int rr = tid >> 3, pc = tid & 7;
          *(u32x4*)(PJ + (size_t)(row0 + t0 + rr) * PJW + C_GL + blk * 64 + 8 * pc) = *(const LAS u32x4*)(L + LR_YS + rr * 128 + pc * 16); }
    }
    if (ts == 0 && fq == 0) {
#pragma unroll
        for (int db = 0; db < 2; ++db) out_lh(C, l, sb)[blk * 64 + 32 * dh + 16 * db + fr] = hc[db];
    }
#undef LRU_DMA
    asm volatile("s_waitcnt vmcnt(0)" ::: "memory");
    __syncthreads();
}

DI Ctx relaunder(const Ctx& C0) {
    Ctx C = C0; int ln; asm volatile("v_mbcnt_lo_u32_b32 %0, -1, 0\n\tv_mbcnt_hi_u32_b32 %0, -1, %0" : "=v"(ln)); C.lane = ln; C.tid = C.wave * 64 + ln;
    { unsigned long long w = (unsigned long long)C.ws, o = (unsigned long long)C.out; asm volatile("" : "+s"(w), "+s"(o));
      C.ws = (unsigned char*)(__attribute__((address_space(1))) unsigned char*)w; C.out = (float*)(__attribute__((address_space(1))) float*)o; }
    asm volatile("" : "+s"(C.G), "+s"(C.bid));
    return C;
}
constexpr int CW_QUEUE = 8192;
constexpr int MX_PREP = 64;
constexpr int MX_A = 144, MX_B = MX_A + 256, MX_C0 = MX_B + 8, MX_C = MX_C0 + 240, MX_D = MX_C + 128, MX_E = MX_D + 128, MX_F = MX_E + 128, MX_N = MX_F + 64;
DI void phase_mixers(const Ctx& Cin, int l) {
    unsigned* head = (unsigned*)(Cin.ws + WS_CTL) + CW_QUEUE + 64 * l;
    volatile LAS int* slot = (volatile LAS int*)(Cin.lds + LDS_BYTES - 24);
    for (;;) {
        __syncthreads();
        if (Cin.tid == 0) *slot = (int)__hip_atomic_fetch_add(head, 1u, __ATOMIC_RELAXED, __HIP_MEMORY_SCOPE_AGENT);
        __syncthreads();
        const int i = __builtin_amdgcn_readfirstlane(*slot);
        if (i >= MX_N + (l == 0 ? MX_PREP : 0)) break;
        const Ctx C = relaunder(Cin);
        if (i >= MX_N) { prep_layer(C, 1, i - MX_N, MX_PREP); continue; }
        int kind, sb, sub;
        if (i < MX_A) { kind = 0; sb = i & 15; sub = 31 - (i >> 4); }
        else if (i < MX_B) { const int j = i - MX_A; kind = 1; sb = j >> 4; sub = j & 15; }
        else if (i < MX_C0) { kind = 0; sb = NPB + (i - MX_B); sub = 0; }
        else if (i < MX_C) { const int j = i - MX_C0; kind = 0; sb = j & 15; sub = 22 - (j >> 4); }
        else if (i < MX_D) { const int j = i - MX_C; kind = 2; sb = j >> 3; sub = j & 7; }
        else if (i < MX_E) { const int j = i - MX_D; kind = 0; sb = j & 15; sub = 7 - (j >> 4); }
        else if (i < MX_F) { const int j = i - MX_E; kind = 1; sb = NPB + (j >> 4); sub = j & 15; }
        else { const int j = i - MX_F; kind = 2; sb = NPB + (j >> 3); sub = j & 7; }
        PROBE_BEGIN(50); PROBE_BEGIN(51); PROBE_BEGIN(52); PROBE_BEGIN(53);
        if (kind == 0) attn_item(C, l, sb, sub);
        else if (kind == 1) ssd_item(C, l, sb, sub);
        else lru_item(C, l, sb, sub);
        if (l == 0) { PROBE_END(50, C); if (kind == 0) PROBE_END(51, C); if (kind == 1) PROBE_END(52, C); if (kind == 2) PROBE_END(53, C); }
    }
}

#define XB_TMO      128
#define XB_XCNT(j)  (256  + 64 * (j))
#define XB_XSUB(j)  (1280 + 64 * (j))
#define XB_XGEN(j)  (2304 + 64 * (j))
#define XB_TOP      3328
#define XB_TOPGEN   3392
#define XCD_BAR_WORDS 3456
#define XB_SPIN_CAP (1u << 22)

__device__ __forceinline__ unsigned xb_ld(unsigned* p)              { return __hip_atomic_load(p, __ATOMIC_RELAXED, __HIP_MEMORY_SCOPE_AGENT); }
__device__ __forceinline__ unsigned xb_add(unsigned* p, unsigned v) { return __hip_atomic_fetch_add(p, v, __ATOMIC_RELAXED, __HIP_MEMORY_SCOPE_AGENT); }
__device__ __forceinline__ unsigned xb_xcc_id() { return (unsigned)__builtin_amdgcn_s_getreg((3 << 11) | 20) & 0xFu; }
#define XB_SPIN(cond, bar) do { unsigned _sp = 0; while (cond) { __builtin_amdgcn_s_sleep(1); \
    if ((++_sp & 255u) == 0u) { if (xb_ld(&(bar)[XB_TMO])) break; if (_sp > XB_SPIN_CAP) { atomicAdd(&(bar)[XB_TMO], 1u); break; } } } } while (0)

struct XcdBarrier {
    unsigned* bar; unsigned x;
    volatile LAS unsigned* st;
};

__device__ __forceinline__ XcdBarrier xcd_barrier_post(unsigned* bar, volatile LAS unsigned* st) {
    XcdBarrier b; b.bar = bar; b.x = xb_xcc_id(); b.st = st;
    if (threadIdx.x == 0) (void)xb_add(&bar[XB_XCNT(b.x)], 1u);
    return b;
}
__device__ __forceinline__ void xcd_barrier_complete(unsigned* bar, unsigned x, unsigned& nloc, unsigned& nx) {
    const unsigned G = gridDim.x * gridDim.y * gridDim.z;
    unsigned sum, cnt, mine, sp = 0u;
    for (;;) {
        sum = 0u; cnt = 0u; mine = 0u;
#pragma unroll
        for (unsigned j = 0; j < 16; ++j) { const unsigned c = xb_ld(&bar[XB_XCNT(j)]); sum += c; cnt += (c > 0u) ? 1u : 0u; mine = (j == x) ? c : mine; }
        if (sum == G) break;
        __builtin_amdgcn_s_sleep(1);
        if ((++sp & 255u) == 0u) { if (xb_ld(&bar[XB_TMO])) break; if (sp > XB_SPIN_CAP) { atomicAdd(&bar[XB_TMO], 1u); break; } }
    }
    nloc = mine > 0u ? mine : 1u; nx = cnt > 0u ? cnt : 1u;
}

__device__ __forceinline__ void xcd_barrier(const XcdBarrier& b) {
    asm volatile("s_waitcnt vmcnt(0)" ::: "memory");
    __syncthreads();
    if (threadIdx.x == 0) {
        unsigned* bar = b.bar;
        __builtin_amdgcn_s_waitcnt(0);
        unsigned nloc = b.st[0], nx = b.st[1];
        if (nloc == 0u) { xcd_barrier_complete(bar, b.x, nloc, nx); b.st[0] = nloc; b.st[1] = nx; }
        const unsigned old = xb_add(&bar[XB_XSUB(b.x)], 1u);
        const unsigned gen = old / nloc;
        if (old + 1u == (gen + 1u) * nloc) {
            __builtin_amdgcn_fence(__ATOMIC_RELEASE, "agent");
            asm volatile("s_waitcnt vmcnt(0)" ::: "memory");
            const unsigned og = xb_add(&bar[XB_TOP], 1u);
            const unsigned tg = og / nx;
            if (og + 1u == (tg + 1u) * nx) xb_add(&bar[XB_TOPGEN], 1u);
            else XB_SPIN(xb_ld(&bar[XB_TOPGEN]) == tg, bar);
            __builtin_amdgcn_fence(__ATOMIC_ACQUIRE, "agent");
            xb_add(&bar[XB_XGEN(b.x)], 1u);
            asm volatile("s_waitcnt vmcnt(0)" ::: "memory");
        } else {
            XB_SPIN(xb_ld(&bar[XB_XGEN(b.x)]) == gen, bar);
            __builtin_amdgcn_fence(__ATOMIC_ACQUIRE, "agent");
            asm volatile("s_waitcnt vmcnt(0)" ::: "memory");
        }
    }
    __syncthreads();
}


constexpr int PH_PER_LAYER = 3;
constexpr int N_PHASES = 1 + 2 * PH_PER_LAYER;
constexpr int CW_BAR = 4096;
__global__ void __launch_bounds__(NTHREADS, 2) mk_fwd(Args a) {
    extern __shared__ __attribute__((aligned(16))) unsigned char lds_raw[];
    Ctx C; C.out = a.out; C.ws = a.ws; C.lds = (LAS unsigned char*)lds_raw;
    C.tid = threadIdx.x; C.lane = C.tid & 63; C.wave = __builtin_amdgcn_readfirstlane(C.tid >> 6); C.G = gridDim.x; C.bid = blockIdx.x;
    if (C.tid == 0) {
#pragma unroll
        for (int i = 0; i < 28; ++i) ((LAS cfp_t*)(C.lds + LDS_BYTES - 256))[i] = a.in[i];
        ((volatile LAS unsigned*)(C.lds + LDS_BYTES - 32))[0] = 0u; ((volatile LAS unsigned*)(C.lds + LDS_BYTES - 32))[1] = 0u;
        *(LAS unsigned long long*)(C.lds + LDS_BYTES - 16) = 0ull;
    }
    __syncthreads();
    const XcdBarrier bar = xcd_barrier_post((unsigned*)(a.ws + WS_CTL) + CW_BAR, (volatile LAS unsigned*)(C.lds + LDS_BYTES - 32));
    const Ctx C0 = C;
#define LAUNDER() const Ctx C = relaunder(C0)
#ifdef PROBE_PHASE
    unsigned long long pr_t0 = 0, pr_t1 = 0;
#endif
    for (int ph = a.ph_lo; ph < a.ph_hi; ++ph) {
#ifdef PROBE_PHASE
        if (ph == PROBE_PHASE) pr_t0 = __builtin_amdgcn_s_memrealtime();
#endif
        if (ph == 0) { LAUNDER(); phase_prologue(C); }
        else {
            const int l = (ph - 1) / PH_PER_LAYER, k = (ph - 1) % PH_PER_LAYER;
            if (k == 0) { LAUNDER(); phase_inproj_gemm(C, l); }
            else if (k == 1) { LAUNDER(); phase_mixers(C, l); }
            else { LAUNDER(); phase_outproj_gemm(C, l); }
        }
        if (ph + 1 < a.ph_hi) { if (ph == 0) cg::this_grid().sync(); else xcd_barrier(bar); }
#ifdef PROBE_PHASE
        if (ph == PROBE_PHASE) pr_t1 = __builtin_amdgcn_s_memrealtime();
#endif
    }
#ifdef PROBE_PHASE
#ifdef PROBE_SUB
    pr_t0 = 0; pr_t1 = *(LAS unsigned long long*)(C0.lds + LDS_BYTES - 16);
#endif
#ifndef PROBE_BLOCK
#define PROBE_BLOCK 0
#endif
    if (PROBE_BLOCK < 0 || (int)blockIdx.x == PROBE_BLOCK) { const unsigned long long te = __builtin_amdgcn_s_memrealtime(), span = 4ull * (pr_t1 - pr_t0); while (__builtin_amdgcn_s_memrealtime() - te < span) __builtin_amdgcn_s_sleep(8); }
#endif
}

extern "C" void kernel_launch(void* const* d_in, const int* in_sizes, int n_in, void* d_out, int out_size, void* d_ws, size_t ws_size, hipStream_t stream) {
    static int grid = 0;
    if (grid == 0) {
        if (n_in != 28 || (size_t)out_size != O_END || ws_size < WS_END) { fprintf(stderr, "kernel_launch: unexpected shapes n_in %d out %d ws %zu\n", n_in, out_size, ws_size); grid = -1; return; }
        int dev = 0, cus = 0, per_cu = 0;
        hipGetDevice(&dev); hipDeviceGetAttribute(&cus, hipDeviceAttributeMultiprocessorCount, dev);
        hipFuncSetAttribute((const void*)mk_fwd, hipFuncAttributeMaxDynamicSharedMemorySize, LDS_BYTES);
        hipOccupancyMaxActiveBlocksPerMultiprocessor(&per_cu, (const void*)mk_fwd, NTHREADS, LDS_BYTES);
        if (per_cu < 1) per_cu = 1;
        grid = cus * 1;
        (void)hipGetLastError();
    }
    if (grid < 0) return;
    hipMemsetAsync((char*)d_ws + WS_CTL, 0, CTL_BYTES, stream);
    Args a{};
    for (int i = 0; i < 28; ++i) a.in[i] = (const float*)d_in[i];
    a.out = (float*)d_out; a.ws = (unsigned char*)d_ws;
    a.ph_lo = 0; a.ph_hi = N_PHASES;
    void* args[] = {&a};
    hipError_t e = hipLaunchCooperativeKernel((const void*)mk_fwd, dim3(grid), dim3(NTHREADS), args, LDS_BYTES, stream);
    if (e != hipSuccess) fprintf(stderr, "cooperative launch failed: %s (grid %d)\n", hipGetErrorString(e), grid);
}
```

```cpp
#include <hip/hip_runtime.h>
#include <hip/hip_cooperative_groups.h>
#include <cstdio>
#include <cstdint>
namespace cg = cooperative_groups;

typedef unsigned short bf16_t;
typedef short bf16x8 __attribute__((ext_vector_type(8)));
typedef float f32x4 __attribute__((ext_vector_type(4)));
typedef float f32x16 __attribute__((ext_vector_type(16)));
typedef unsigned u32x4 __attribute__((ext_vector_type(4)));
typedef unsigned u32x2 __attribute__((ext_vector_type(2)));
#define LAS __attribute__((address_space(3)))
#define DI __device__ __forceinline__

constexpr int DM = 1024, NPB = 16, SEQ = 2048, NSB_S = 8, DSEQ = 64, PAST = 1024;
constexpr int ROWS_P = NPB * SEQ;
constexpr int ROWS = ROWS_P + NSB_S * DSEQ;
constexpr int NSB = NPB + NSB_S;
constexpr int DINP = 5204, NPAD = 5376;
constexpr int PJW = 4864;
constexpr int DMIX = 2048;
constexpr float EPS = 1e-6f;
constexpr int C_GL = 0, C_GA = 512, C_Z = 1024, C_XL = 2048, C_Q = 2560, C_QI = 3072, C_XBC = 3328, C_T19 = 4864, C_T20 = 5120;
constexpr int KVW = 320;
constexpr size_t KVB_LAYER = (size_t)NPB * SEQ * KVW + (size_t)NSB_S * (PAST + DSEQ) * KVW;

constexpr size_t O_YP = 0;
constexpr size_t O_YS = O_YP + (size_t)NPB * SEQ * DM;
constexpr size_t O_AKP = O_YS + (size_t)NSB_S * DSEQ * DM;
constexpr size_t O_AVP = O_AKP + (size_t)2 * NPB * SEQ * 128;
constexpr size_t O_IKP = O_AVP + (size_t)2 * NPB * SEQ * 128;
constexpr size_t O_LCP = O_IKP + (size_t)2 * NPB * SEQ * 64;
constexpr size_t O_LHP = O_LCP + (size_t)2 * NPB * 3 * 512;
constexpr size_t O_SCP = O_LHP + (size_t)2 * NPB * 512;
constexpr size_t O_SHP = O_SCP + (size_t)2 * NPB * 3 * 1536;
constexpr size_t O_AKS = O_SHP + (size_t)2 * NPB * 16 * 64 * 128;
constexpr size_t O_AVS = O_AKS + (size_t)2 * NSB_S * DSEQ * 128;
constexpr size_t O_IKS = O_AVS + (size_t)2 * NSB_S * DSEQ * 128;
constexpr size_t O_LCS = O_IKS + (size_t)2 * NSB_S * DSEQ * 64;
constexpr size_t O_LHS = O_LCS + (size_t)2 * NSB_S * 3 * 512;
constexpr size_t O_SCS = O_LHS + (size_t)2 * NSB_S * 512;
constexpr size_t O_SHS = O_SCS + (size_t)2 * NSB_S * 3 * 1536;
constexpr size_t O_END = O_SHS + (size_t)2 * NSB_S * 16 * 64 * 128;

constexpr size_t MiB = 1u << 20;
constexpr size_t WS_CTL = 0, CTL_BYTES = 1 * MiB;
constexpr size_t WS_WIN = 1 * MiB;
constexpr size_t WIN_LAYER = (size_t)NPAD * DM;
constexpr size_t WS_WOUT = 22 * MiB;
constexpr size_t WOUT_LAYER = (size_t)DM * DMIX;
constexpr size_t WS_HB = 30 * MiB;
constexpr size_t WS_RSS = 95 * MiB;
constexpr size_t WS_WI = 98 * MiB;
constexpr size_t WS_DTR = 99 * MiB;
constexpr size_t WS_SSQ = 102 * MiB;
constexpr size_t WS_KVB = 112 * MiB;
constexpr size_t WS_PROJ = 138 * MiB;
constexpr size_t WS_KEYS_B = 447 * MiB;
constexpr size_t KEYS_PER_WG = 512 * 1024;
constexpr size_t WS_END = WS_KEYS_B + 128 * KEYS_PER_WG;
static_assert(WS_KVB + KVB_LAYER * 2 <= WS_PROJ && WS_PROJ + (size_t)ROWS * PJW * 2 <= WS_KEYS_B && 128 * KEYS_PER_WG <= 65 * MiB, "ws map");
static_assert(WS_END <= 512 * MiB, "ws map");

constexpr int NTHREADS = 512, NWAVES = 8;
constexpr int LDS_BYTES = 163840;

DI float bf2f(bf16_t v) { return __uint_as_float(((unsigned)v) << 16); }
DI bf16_t f2bf(float f) { unsigned u = __float_as_uint(f); return (bf16_t)((u + 0x7fffu + ((u >> 16) & 1u)) >> 16); }
DI unsigned pk2(float lo, float hi) { return (unsigned)f2bf(lo) | ((unsigned)f2bf(hi) << 16); }
DI int crow(int reg, int h) { return (reg & 3) + 8 * (reg >> 2) + 4 * h; }
template <int O> DI float swz_xor(float v) { return __int_as_float(__builtin_amdgcn_ds_swizzle(__float_as_int(v), (O << 10) | 0x1f)); }
DI float xor32_sum(float v) { auto rr = __builtin_amdgcn_permlane32_swap(__float_as_uint(v), __float_as_uint(v), false, false); return __uint_as_float(rr[0]) + __uint_as_float(rr[1]); }
DI float xor32_max(float v) { auto rr = __builtin_amdgcn_permlane32_swap(__float_as_uint(v), __float_as_uint(v), false, false); return fmaxf(__uint_as_float(rr[0]), __uint_as_float(rr[1])); }
DI float half_sum32(float v) {
    v += swz_xor<1>(v); v += swz_xor<2>(v); v += swz_xor<4>(v); v += swz_xor<8>(v); v += swz_xor<16>(v); return v;
}
DI float wave_sum(float v) { return xor32_sum(half_sum32(v)); }
DI float wave_max(float v) {
    v = fmaxf(v, swz_xor<1>(v)); v = fmaxf(v, swz_xor<2>(v)); v = fmaxf(v, swz_xor<4>(v)); v = fmaxf(v, swz_xor<8>(v)); v = fmaxf(v, swz_xor<16>(v)); return xor32_max(v);
}
DI float sum_fq(float v) { return xor32_sum(v + swz_xor<16>(v)); }
DI float bperm(float v, int srclane) { return __int_as_float(__builtin_amdgcn_ds_bpermute(srclane << 2, __float_as_int(v))); }
DI float silu_f(float x) { return x / (1.f + expf(-x)); }
DI float sigmoid_f(float x) { return 1.f / (1.f + expf(-x)); }
DI float softplus_f(float x) { return x > 20.f ? x : log1pf(expf(x)); }
#define LDS_FENCE() asm volatile("s_waitcnt lgkmcnt(0)" ::: "memory")

__host__ __device__ inline int orig_col(int c) {
    if (c < 512) return 512 + c;
    if (c < 1024) return 1792 + (c - 512);
    if (c < 2048) return 2628 + (c - 1024);
    if (c < 2560) return c - 2048;
    if (c < 3072) return 1024 + (c - 2560);
    if (c < 3328) return 2304 + (c - 3072);
    if (c < 4864) return 3652 + (c - 3328);
    if (c < 5120) { const int cl = c - 4864, bj = cl >> 7, wc = (cl >> 5) & 3, j = cl & 31, d = 32 * bj + j; return (wc < 2 ? 1536 : 1664) + (wc & 1) * 64 + d; }
    const int cl = c - 5120;
    if (cl < 64) return 2560 + cl;
    if (cl < 68) return 2624 + (cl - 64);
    if (cl < 84) return 5188 + (cl - 68);
    return -1;
}
DI int sb_T(int sb) { return sb < NPB ? SEQ : DSEQ; }
DI int sb_P(int sb) { return sb < NPB ? 0 : PAST; }
DI int sb_row0(int sb) { return sb < NPB ? sb * SEQ : ROWS_P + (sb - NPB) * DSEQ; }
DI size_t kvb_off(int sb) { return sb < NPB ? (size_t)sb * SEQ * KVW : (size_t)NPB * SEQ * KVW + (size_t)(sb - NPB) * (PAST + DSEQ) * KVW; }
DI void row_sbt(int m, int& sb, int& t) { if (m < ROWS_P) { sb = m >> 11; t = m & 2047; } else { const int r = m - ROWS_P; sb = NPB + (r >> 6); t = r & 63; } }

typedef const float* cfp_t;
struct Args { const float* in[28]; float* out; unsigned char* ws; int ph_lo, ph_hi; };

struct Ctx {
    float* out; unsigned char* ws;
    LAS unsigned char* lds;
    DI const float* inp(int k) const { return (const float*)(const __attribute__((address_space(1))) float*)(((LAS unsigned long long*)(lds + LDS_BYTES - 256))[k]); }
    int tid, lane, wave, G, bid;
    DI bf16_t* win(int l) const { return (bf16_t*)(ws + WS_WIN) + (size_t)l * WIN_LAYER; }
    DI bf16_t* wout(int l) const { return (bf16_t*)(ws + WS_WOUT) + (size_t)l * WOUT_LAYER; }
    DI bf16_t* hb() const { return (bf16_t*)(ws + WS_HB); }
    DI float* rss() const { return (float*)(ws + WS_RSS); }
    DI float* wi() const { return (float*)(ws + WS_WI); }
    DI float* dtr() const { return (float*)(ws + WS_DTR); }
    DI float* ssq() const { return (float*)(ws + WS_SSQ); }
    DI bf16_t* kvb(int) const { return (bf16_t*)(ws + WS_KVB); }
    DI unsigned* keys() const { return (unsigned*)(bid < 128 ? ws + WS_HB + (size_t)bid * KEYS_PER_WG : ws + WS_KEYS_B + (size_t)(bid - 128) * KEYS_PER_WG); }
    DI bf16_t* proj() const { return (bf16_t*)(ws + WS_PROJ); }
};
DI float* out_ak(const Ctx& C, int l, int sb) { return sb < NPB ? C.out + O_AKP + ((size_t)(l * NPB + sb) * SEQ) * 128 : C.out + O_AKS + ((size_t)(l * NSB_S + sb - NPB) * DSEQ) * 128; }
DI float* out_av(const Ctx& C, int l, int sb) { return sb < NPB ? C.out + O_AVP + ((size_t)(l * NPB + sb) * SEQ) * 128 : C.out + O_AVS + ((size_t)(l * NSB_S + sb - NPB) * DSEQ) * 128; }
DI float* out_ik(const Ctx& C, int l, int sb) { return sb < NPB ? C.out + O_IKP + ((size_t)(l * NPB + sb) * SEQ) * 64 : C.out + O_IKS + ((size_t)(l * NSB_S + sb - NPB) * DSEQ) * 64; }
DI float* out_lc(const Ctx& C, int l, int sb) { return sb < NPB ? C.out + O_LCP + (size_t)(l * NPB + sb) * 3 * 512 : C.out + O_LCS + (size_t)(l * NSB_S + sb - NPB) * 3 * 512; }
DI float* out_lh(const Ctx& C, int l, int sb) { return sb < NPB ? C.out + O_LHP + (size_t)(l * NPB + sb) * 512 : C.out + O_LHS + (size_t)(l * NSB_S + sb - NPB) * 512; }
DI float* out_sc(const Ctx& C, int l, int sb) { return sb < NPB ? C.out + O_SCP + (size_t)(l * NPB + sb) * 3 * 1536 : C.out + O_SCS + (size_t)(l * NSB_S + sb - NPB) * 3 * 1536; }
DI float* out_sh(const Ctx& C, int l, int sb) { return sb < NPB ? C.out + O_SHP + (size_t)(l * NPB + sb) * 16 * 64 * 128 : C.out + O_SHS + (size_t)(l * NSB_S + sb - NPB) * 16 * 64 * 128; }

#ifdef PROBE_SUB
#define PROBE_BEGIN(id) unsigned long long pb_##id = __builtin_amdgcn_s_memrealtime()
#define PROBE_END(id, Cx) do { if ((id) == PROBE_SUB && (Cx).tid == 0) *(LAS unsigned long long*)((Cx).lds + LDS_BYTES - 16) += __builtin_amdgcn_s_memrealtime() - pb_##id; } while (0)
#else
#define PROBE_BEGIN(id) do {} while (0)
#define PROBE_END(id, Cx) do {} while (0)
#endif
namespace pg8 {
#define PG8_LAS __attribute__((address_space(3)))
constexpr int BM = 256, BK = 64, HALF = 128, HTB = HALF * BK * 2  , STAGE_BYTES = 8 * HTB, NXCD = 8, WGM = 8;

__host__ __device__ __forceinline__ int lds_byte(int r, int c) { const int st = (r >> 4) * 2 + (c >> 5), rr = r & 15, cc = c & 31, ob = rr * 64 + cc * 2; return st * 1024 + (ob ^ (((ob >> 9) & 1) << 5)); }
__host__ __device__ __forceinline__ void stage_rc(int b, int& R, int& C) { const int st = b / 1024, sb = b % 1024, swz = sb ^ (((sb >> 9) & 1) << 5); R = (st >> 1) * 16 + swz / 64; C = (st & 1) * 32 + (swz % 64) / 2; }
__host__ __device__ __forceinline__ int perm32(int rho) { const int n = rho >> 4, i = rho & 15; return 8 * (i >> 2) + 4 * n + (i & 3); }

struct Unit { int pm, pn; };
struct Gemm { const bf16_t* A; const bf16_t* Bt; int M, N, K, lda; };

struct StaticOrder {
    int nM, nN, nwg, G, c;
    __host__ __device__ void init(int M, int N, int G_, int c_) { nM = M / BM; nN = N / BM; nwg = nM * nN; G = G_; c = c_; }
    __host__ __device__ bool next(int i, Unit& u) const {
        const long L = (long)i * G + c; if (L >= nwg) return false;
        int wgid = (int)L; { const int q = nwg / NXCD, r = nwg % NXCD, xcd = wgid % NXCD, off = wgid / NXCD; wgid = (xcd < r ? xcd * (q + 1) : r * (q + 1) + (xcd - r) * q) + off; }
        const int nig = WGM * nN, gid = wgid / nig, fm = gid * WGM, gsz = (nM - fm) < WGM ? (nM - fm) : WGM;
        u.pm = fm + ((wgid % nig) % gsz); u.pn = (wgid % nig) / gsz; return true;
    }
    __device__ __forceinline__ void a_ready(const Unit&) const {}
    __device__ __forceinline__ void done(const Unit&) const {}
};

template <class Epi, class Sched, bool ALIGN_EPI = false, bool SP2 = false>
__device__ __forceinline__ void gemm_phase(PG8_LAS unsigned char* lds, const Gemm g, const Sched& S, const Epi& E, const int tid) {
    const int wid = __builtin_amdgcn_readfirstlane(tid >> 6), lane = tid & 63, wr = wid >> 2, wc = wid & 3, fr = lane & 15, fq = lane >> 4;
    const int K = g.K, nt = K / BK;
    unsigned voffA[2], voffB[2];
#pragma unroll
    for (int i = 0; i < 2; ++i) { int R, C; stage_rc(tid * 16 + i * 8192, R, C); const int Rb = Epi::PERM ? ((R & ~31) + perm32(R & 31)) : R;
        voffA[i] = (unsigned)(R * g.lda + C) * 2u; voffB[i] = (unsigned)(Rb * K + C) * 2u; }
    const size_t kstep = (size_t)(BK * 2);
    const size_t hstepA = (size_t)HALF * g.lda * 2, hstepB = (size_t)HALF * K * 2;
    const size_t tstepA = 2 * hstepA, tstepB = 2 * hstepB;
    const unsigned ldsw = (unsigned)wid * 1024u;
    const int aoff = lds_byte(wr * 64 + fr, fq * 8), boff = lds_byte(wc * 32 + fr, fq * 8);
#define PG8_SA(b, h) (((b) * 2 + (h)) * HTB)
#define PG8_SB(b, h) ((4 + (b) * 2 + (h)) * HTB)
#define PG8_STAGE(bufoff, gbase, voff) do { _Pragma("unroll") for (int _i = 0; _i < 2; ++_i) \
        __builtin_amdgcn_global_load_lds((const unsigned*)((const char*)(gbase) + (voff)[_i]), (PG8_LAS unsigned*)(lds + (bufoff) + ldsw + _i * 8192), 16, 0, 0); } while (0)
#define PG8_LDA(dst, b, h) do { _Pragma("unroll") for (int m = 0; m < 4; ++m) _Pragma("unroll") for (int k = 0; k < 2; ++k) dst[m][k] = *(const PG8_LAS bf16x8*)(lds + PG8_SA(b, h) + aoff + m * 2048 + k * 1024); } while (0)
#define PG8_LDB(dst, b, h) do { _Pragma("unroll") for (int n = 0; n < 2; ++n) _Pragma("unroll") for (int k = 0; k < 2; ++k) dst[n][k] = *(const PG8_LAS bf16x8*)(lds + PG8_SB(b, h) + boff + n * 2048 + k * 1024); } while (0)
#define PG8_MMA(ai, bj, At, Bt) do { __builtin_amdgcn_s_setprio(1); _Pragma("unroll") for (int m = 0; m < 4; ++m) _Pragma("unroll") for (int n = 0; n < 2; ++n) _Pragma("unroll") for (int k = 0; k < 2; ++k) \
        acc[ai][bj][m][n] = __builtin_amdgcn_mfma_f32_16x16x32_bf16(Bt[n][k], At[m][k], acc[ai][bj][m][n], 0, 0, 0); __builtin_amdgcn_s_setprio(0); } while (0)
#define PG8_WAIT_V(n) asm volatile("s_waitcnt vmcnt(" #n ")" ::: "memory")
#define PG8_WAIT_L(n) asm volatile("s_waitcnt lgkmcnt(" #n ")" ::: "memory")
#define PG8_BAR __builtin_amdgcn_s_barrier()
#define PG8_SCHED __builtin_amdgcn_sched_barrier(0)
    Unit cur, nxt; int ui = 0;
    if (!S.next(0, cur)) return;
    f32x4 acc[2][2][4][2];
#pragma unroll
    for (int a = 0; a < 2; ++a)
#pragma unroll
        for (int b = 0; b < 2; ++b)
#pragma unroll
            for (int m = 0; m < 4; ++m)
#pragma unroll
                for (int n = 0; n < 2; ++n) acc[a][b][m][n] = (f32x4){0.f, 0.f, 0.f, 0.f};
    bf16x8 At[4][2], B0[2][2], B1[2][2];
    const char* cA = (const char*)g.A + (size_t)cur.pm * tstepA; const char* cB = (const char*)g.Bt + (size_t)cur.pn * tstepB;
    S.a_ready(cur);
    if constexpr (SP2) {
        PG8_STAGE(PG8_SB(0, 0), cB, voffB); PG8_STAGE(PG8_SB(0, 1), cB + hstepB, voffB); PG8_STAGE(PG8_SA(0, 0), cA, voffA); PG8_STAGE(PG8_SA(0, 1), cA + hstepA, voffA);
        if (wr == 1) PG8_BAR;
        PG8_WAIT_V(2); PG8_BAR;
        PG8_STAGE(PG8_SB(1, 0), cB + kstep, voffB); PG8_STAGE(PG8_SA(1, 0), cA + kstep, voffA); PG8_STAGE(PG8_SB(1, 1), cB + hstepB + kstep, voffB);
        PG8_WAIT_V(6); PG8_BAR;
    } else {
        PG8_STAGE(PG8_SB(0, 0), cB, voffB); PG8_STAGE(PG8_SA(0, 0), cA, voffA); PG8_STAGE(PG8_SB(0, 1), cB + hstepB, voffB); PG8_STAGE(PG8_SA(0, 1), cA + hstepA, voffA);
        if (wr == 1) PG8_BAR;
        PG8_WAIT_V(4); PG8_BAR;
        PG8_STAGE(PG8_SB(1, 0), cB + kstep, voffB); PG8_STAGE(PG8_SA(1, 0), cA + kstep, voffA); PG8_STAGE(PG8_SB(1, 1), cB + hstepB + kstep, voffB);
        PG8_WAIT_V(6); PG8_BAR;
    }
    for (;;) {
        const bool has_next = S.next(ui + 1, nxt);
        const char* nA = has_next ? (const char*)g.A + (size_t)nxt.pm * tstepA : cA; const char* nB = has_next ? (const char*)g.Bt + (size_t)nxt.pn * tstepB : cB;
        for (int t = 0; t < nt; t += 2) {
            if constexpr (Epi::KSCALE) { if (t == Epi::KS_T0 || t == Epi::KS_T1) E.kscale(acc, ui, t, wr, fr); }
            const bool last = (t == nt - 2);
            const char* a1 = cA + (size_t)(t + 1) * kstep;
            const char* a2 = last ? nA : cA + (size_t)(t + 2) * kstep; const char* b2 = last ? nB : cB + (size_t)(t + 2) * kstep;
            const char* a3 = a2 + kstep; const char* b3 = b2 + kstep;
            if (last && has_next) S.a_ready(nxt);
            if constexpr (SP2) {
            PG8_LDB(B0, 0, 0); PG8_LDB(B1, 0, 1); PG8_SCHED; PG8_LDA(At, 0, 0); PG8_STAGE(PG8_SA(1, 1), a1 + hstepA, voffA);
            PG8_WAIT_V(8); PG8_WAIT_L(0); PG8_BAR; PG8_MMA(0, 0, At, B0); PG8_MMA(0, 1, At, B1); PG8_BAR; PG8_SCHED;
            PG8_LDA(At, 0, 1); PG8_STAGE(PG8_SB(0, 0), b2, voffB); PG8_STAGE(PG8_SB(0, 1), b2 + hstepB, voffB); PG8_STAGE(PG8_SA(0, 0), a2, voffA);
            PG8_WAIT_V(8); PG8_WAIT_L(0); PG8_BAR; PG8_MMA(1, 0, At, B0); PG8_MMA(1, 1, At, B1); PG8_BAR; PG8_SCHED;
            PG8_LDB(B0, 1, 0); PG8_LDB(B1, 1, 1); PG8_SCHED; PG8_LDA(At, 1, 0); PG8_STAGE(PG8_SA(0, 1), a2 + hstepA, voffA);
            PG8_WAIT_V(8); PG8_WAIT_L(0); PG8_BAR; PG8_MMA(0, 0, At, B0); PG8_MMA(0, 1, At, B1); PG8_BAR; PG8_SCHED;
            PG8_LDA(At, 1, 1); PG8_STAGE(PG8_SB(1, 0), b3, voffB); PG8_STAGE(PG8_SB(1, 1), b3 + hstepB, voffB); PG8_STAGE(PG8_SA(1, 0), a3, voffA);
            PG8_WAIT_V(8); PG8_WAIT_L(0); PG8_BAR; PG8_MMA(1, 0, At, B0); PG8_MMA(1, 1, At, B1); PG8_BAR; PG8_SCHED;
            } else {
            PG8_LDB(B0, 0, 0); PG8_SCHED; PG8_LDA(At, 0, 0); PG8_STAGE(PG8_SA(1, 1), a1 + hstepA, voffA);
            PG8_WAIT_L(8); PG8_BAR; PG8_WAIT_L(0); PG8_MMA(0, 0, At, B0); PG8_BAR; PG8_SCHED;
            PG8_LDB(B1, 0, 1); PG8_STAGE(PG8_SB(0, 0), b2, voffB);
            PG8_BAR; PG8_WAIT_L(0); PG8_MMA(0, 1, At, B1); PG8_BAR;
            PG8_LDA(At, 0, 1); PG8_STAGE(PG8_SA(0, 0), a2, voffA);
            PG8_BAR; PG8_WAIT_L(0); PG8_MMA(1, 0, At, B0); PG8_BAR; PG8_SCHED;
            PG8_STAGE(PG8_SB(0, 1), b2 + hstepB, voffB);
            PG8_WAIT_V(6); PG8_BAR; PG8_MMA(1, 1, At, B1); PG8_BAR;
            PG8_LDB(B0, 1, 0); PG8_SCHED; PG8_LDA(At, 1, 0); PG8_STAGE(PG8_SA(0, 1), a2 + hstepA, voffA);
            PG8_WAIT_L(8); PG8_BAR; PG8_WAIT_L(0); PG8_MMA(0, 0, At, B0); PG8_BAR; PG8_SCHED;
            PG8_LDB(B1, 1, 1); PG8_STAGE(PG8_SB(1, 0), b3, voffB);
            PG8_BAR; PG8_WAIT_L(0); PG8_MMA(0, 1, At, B1); PG8_BAR;
            PG8_LDA(At, 1, 1); PG8_STAGE(PG8_SA(1, 0), a3, voffA);
            PG8_BAR; PG8_WAIT_L(0); PG8_MMA(1, 0, At, B0); PG8_BAR; PG8_SCHED;
            PG8_STAGE(PG8_SB(1, 1), b3 + hstepB, voffB);
            PG8_WAIT_V(6); PG8_BAR; PG8_MMA(1, 1, At, B1); PG8_BAR;
            }
        }
        if constexpr (ALIGN_EPI) { if (wr == 0) PG8_BAR; }
        if constexpr (!Epi::AFTER_DRAIN) { E(acc, cur, wr, wc, fr, fq); S.done(cur); }
        if (!has_next) break;
#pragma unroll
        for (int a = 0; a < 2; ++a)
#pragma unroll
            for (int b = 0; b < 2; ++b)
#pragma unroll
                for (int m = 0; m < 4; ++m)
#pragma unroll
                    for (int n = 0; n < 2; ++n) acc[a][b][m][n] = (f32x4){0.f, 0.f, 0.f, 0.f};
        cur = nxt; cA = nA; cB = nB; ++ui;
        if constexpr (ALIGN_EPI) { if (wr == 1) PG8_BAR; }
    }
    PG8_WAIT_V(0);
    if constexpr (!ALIGN_EPI) { if (wr == 0) PG8_BAR; }
    PG8_BAR;
    if constexpr (Epi::AFTER_DRAIN) { E.fused(acc, cur, wr, wc, fr, fq, lds, wid, lane); S.done(cur); }
#undef PG8_SA
#undef PG8_SB
#undef PG8_STAGE
#undef PG8_LDA
#undef PG8_LDB
#undef PG8_MMA
#undef PG8_WAIT_V
#undef PG8_WAIT_L
#undef PG8_BAR
#undef PG8_SCHED
}
}

typedef float f32x2_t __attribute__((ext_vector_type(2))); typedef __bf16 bf16x2_t __attribute__((ext_vector_type(2)));
DI unsigned cvt_pk_bf16(float lo, float hi) { const f32x2_t v = {lo, hi}; const bf16x2_t b = __builtin_convertvector(v, bf16x2_t); return __builtin_bit_cast(unsigned, b); }
DI u32x4 pack8(const f32x4 a, const f32x4 b) { u32x4 w; w.x = cvt_pk_bf16(a[0], a[1]); w.y = cvt_pk_bf16(a[2], a[3]); w.z = cvt_pk_bf16(b[0], b[1]); w.w = cvt_pk_bf16(b[2], b[3]); return w; }
struct EpiIn {
    static constexpr bool PERM = true, AFTER_DRAIN = false, KSCALE = false; static constexpr int KS_T0 = -1, KS_T1 = -1;
    Ctx C; int l;
    DI void operator()(const f32x4 (&acc)[2][2][4][2], const pg8::Unit& u, int wr, int wc, int fr, int fq) const {
        const int row0 = u.pm * 256 + wr * 64 + fr;
        float rs[2][4];
#pragma unroll
        for (int ai = 0; ai < 2; ++ai)
#pragma unroll
            for (int m = 0; m < 4; ++m) {
                const f32x4 p = *(const f32x4*)(C.rss() + (size_t)(row0 + ai * 128 + m * 16) * 16 + 4 * fq);
                float s = sum_fq((p[0] + p[1]) + (p[2] + p[3]));
                rs[ai][m] = rsqrtf(s * (1.f / DM) + EPS);
            }
        if (u.pn < 19) {
            bf16_t* base = C.proj() + (size_t)row0 * PJW + u.pn * 256 + wc * 32 + 8 * fq;
#pragma unroll
            for (int ai = 0; ai < 2; ++ai)
#pragma unroll
                for (int m = 0; m < 4; ++m) {
                    bf16_t* rowp = base + (size_t)(ai * 128 + m * 16) * PJW; const float sc = rs[ai][m];
#pragma unroll
                    for (int bj = 0; bj < 2; ++bj) *(u32x4*)(rowp + bj * 128) = pack8(acc[ai][bj][m][0] * sc, acc[ai][bj][m][1] * sc);
                }
        } else if (u.pn == 19) {
            if (wc < 2) {
                const float* kw = C.inp(19) + l * 64 + 8 * fq;
                const f32x4 k00 = *(const f32x4*)(kw), k01 = *(const f32x4*)(kw + 4), k10 = *(const f32x4*)(kw + 32), k11 = *(const f32x4*)(kw + 36);
#pragma unroll
                for (int ai = 0; ai < 2; ++ai)
#pragma unroll
                    for (int m = 0; m < 4; ++m) {
                        const int row = row0 + ai * 128 + m * 16; int sb, t; row_sbt(row, sb, t);
                        const float sc = rs[ai][m];
                        f32x4 a0 = acc[ai][0][m][0] * sc, a1 = acc[ai][0][m][1] * sc, b0 = acc[ai][1][m][0] * sc, b1 = acc[ai][1][m][1] * sc;
                        float ss = 0.f;
#pragma unroll
                        for (int i = 0; i < 4; ++i) ss += (a0[i] * a0[i] + a1[i] * a1[i]) + (b0[i] * b0[i] + b1[i] * b1[i]);
                        ss = sum_fq(ss);
                        const float rn = rsqrtf(ss * (1.f / 64.f) + EPS);
                        a0 = a0 * rn * k00; a1 = a1 * rn * k01; b0 = b0 * rn * k10; b1 = b1 * rn * k11;
                        float* o = out_ak(C, l, sb) + (size_t)t * 128 + wc * 64 + 8 * fq;
                        *(f32x4*)(o) = a0; *(f32x4*)(o + 4) = a1; *(f32x4*)(o + 32) = b0; *(f32x4*)(o + 36) = b1;
                        bf16_t* kv = C.kvb(l) + kvb_off(sb) + (size_t)(sb_P(sb) + t) * KVW + wc * 64 + 8 * fq;
                        *(u32x4*)(kv) = pack8(a0, a1); *(u32x4*)(kv + 32) = pack8(b0, b1);
                    }
            } else {
                const int kvh = wc - 2;
#pragma unroll
                for (int ai = 0; ai < 2; ++ai)
#pragma unroll
                    for (int m = 0; m < 4; ++m) {
                        const int row = row0 + ai * 128 + m * 16; int sb, t; row_sbt(row, sb, t);
                        const float sc = rs[ai][m];
                        const f32x4 a0 = acc[ai][0][m][0] * sc, a1 = acc[ai][0][m][1] * sc, b0 = acc[ai][1][m][0] * sc, b1 = acc[ai][1][m][1] * sc;
                        float* o = out_av(C, l, sb) + (size_t)t * 128 + kvh * 64 + 8 * fq;
                        *(f32x4*)(o) = a0; *(f32x4*)(o + 4) = a1; *(f32x4*)(o + 32) = b0; *(f32x4*)(o + 36) = b1;
                        bf16_t* kv = C.kvb(l) + kvb_off(sb) + (size_t)(sb_P(sb) + t) * KVW + 128 + kvh * 64 + 8 * fq;
                        *(u32x4*)(kv) = pack8(a0, a1); *(u32x4*)(kv + 32) = pack8(b0, b1);
                    }
            }
        } else {
#pragma unroll
            for (int ai = 0; ai < 2; ++ai)
#pragma unroll
                for (int m = 0; m < 4; ++m) {
                    const int row = row0 + ai * 128 + m * 16; int sb, t; row_sbt(row, sb, t);
                    const float sc = rs[ai][m];
                    const f32x4 a0 = acc[ai][0][m][0] * sc, a1 = acc[ai][0][m][1] * sc;
                    if (wc < 2) {
                        const int d = 32 * wc + 8 * fq;
                        float* o = out_ik(C, l, sb) + (size_t)t * 64 + d;
                        *(f32x4*)(o) = a0; *(f32x4*)(o + 4) = a1;
                        *(u32x4*)(C.kvb(l) + kvb_off(sb) + (size_t)(sb_P(sb) + t) * KVW + 256 + d) = pack8(a0, a1);
                    } else if (wc == 2) {
                        if (fq == 0) { *(f32x4*)(C.wi() + (size_t)row * 4) = a0; *(f32x4*)(C.dtr() + (size_t)row * 16) = a1; }
                        else if (fq == 1) { *(f32x4*)(C.dtr() + (size_t)row * 16 + 4) = a0; *(f32x4*)(C.dtr() + (size_t)row * 16 + 8) = a1; }
                        else if (fq == 2) { *(f32x4*)(C.dtr() + (size_t)row * 16 + 12) = a0; }
                    }
                }
        }
    }
};
constexpr int LDS_GNT = 131072;
struct EpiOut {
    static constexpr bool PERM = false, AFTER_DRAIN = false, KSCALE = true; static constexpr int KS_T0 = 16, KS_T1 = 24;
    Ctx C; int l, pm0, pn0;
    DI void kscale(f32x4 (&acc)[2][2][4][2], int ui, int t, int wr, int fr) const {
        const LAS f32x4* tab = (const LAS f32x4*)(C.lds + LDS_GNT) + (ui & 1) * 256;
#pragma unroll
        for (int ai = 0; ai < 2; ++ai)
#pragma unroll
            for (int m = 0; m < 4; ++m) {
                const f32x4 f4 = tab[ai * 128 + wr * 64 + m * 16 + fr]; const float f = (t == KS_T0) ? f4[0] : f4[1];
#pragma unroll
                for (int bj = 0; bj < 2; ++bj)
#pragma unroll
                    for (int n = 0; n < 2; ++n) acc[ai][bj][m][n] = acc[ai][bj][m][n] * f;
            }
    }
    DI void operator()(const f32x4 (&acc)[2][2][4][2], const pg8::Unit& u, int wr, int wc, int fr, int fq) const {
        const int row0 = u.pm * 256 + wr * 64 + fr, col0 = u.pn * 256 + wc * 32 + 4 * fq;
        const LAS f32x4* tab = (const LAS f32x4*)(C.lds + LDS_GNT) + ((u.pm == pm0 && u.pn == pn0) ? 0 : 256);
#pragma unroll
        for (int ai = 0; ai < 2; ++ai)
#pragma unroll
            for (int m = 0; m < 4; ++m) {
                const int row = row0 + ai * 128 + m * 16;
                const float r1 = tab[ai * 128 + wr * 64 + m * 16 + fr][2];
                const float* xres = (l == 0) ? ((row < ROWS_P) ? C.inp(0) + (size_t)row * DM : C.inp(1) + (size_t)(row - ROWS_P) * DM) : C.out + (size_t)row * DM;
                float ss = 0.f;
#pragma unroll
                for (int bj = 0; bj < 2; ++bj)
#pragma unroll
                    for (int n = 0; n < 2; ++n) {
                        const int col = col0 + bj * 128 + n * 16;
                        const f32x4 v = *(const f32x4*)(xres + col) + acc[ai][bj][m][n] * r1;
                        *(f32x4*)(C.out + (size_t)row * DM + col) = v;
                        if (l == 0) {
                            u32x2 w; w.x = cvt_pk_bf16(v[0], v[1]); w.y = cvt_pk_bf16(v[2], v[3]);
                            *(u32x2*)(C.hb() + (size_t)row * DM + col) = w;
                            ss += (v[0] * v[0] + v[1] * v[1]) + (v[2] * v[2] + v[3] * v[3]);
                        }
                    }
                if (l == 0) {
                    ss = sum_fq(ss);
                    if (fq == 0) C.rss()[(size_t)row * 16 + u.pn * 4 + wc] = ss;
                }
            }
    }
};
DI void phase_inproj_gemm(const Ctx& C, int l) {
    pg8::Gemm g{C.hb(), C.win(l), ROWS, NPAD, DM, DM};
    pg8::StaticOrder S; S.init(ROWS, NPAD, C.G, C.bid);
    EpiIn E{C, l};
    pg8::gemm_phase<EpiIn, pg8::StaticOrder, true, true>(C.lds, g, S, E, C.tid);
}
DI void outproj_tail_item(const Ctx& C, int l, int rt, int g);
DI void prep_layer(const Ctx& C, int l, int part, int nparts);
DI void prep_cache(const Ctx& C, int l, int part, int nparts);
DI void phase_outproj_gemm(const Ctx& C, int l) {
    for (int i = C.bid * NTHREADS + C.tid; i < NSB * 3 * 1536; i += C.G * NTHREADS) {
        const int sb = i / (3 * 1536), j = (i / 1536) % 3, ch = i % 1536;
        out_sc(C, l, sb)[j * 1536 + ch] = bf2f(C.proj()[(size_t)(sb_row0(sb) + sb_T(sb) - 3 + j) * PJW + C_XBC + ch]);
    }
    for (int i = C.bid * NTHREADS + C.tid; i < NSB * 3 * 512; i += C.G * NTHREADS) {
        const int sb = i / (3 * 512), j = (i / 512) % 3, ch = i % 512;
        out_lc(C, l, sb)[j * 512 + ch] = bf2f(C.proj()[(size_t)(sb_row0(sb) + sb_T(sb) - 3 + j) * PJW + C_XL + ch]);
    }
    if (C.bid < 256) outproj_tail_item(C, l, ROWS_P / 32 + (C.bid >> 4), C.bid & 15);
    if (l == 0) prep_cache(C, 1, C.bid, C.G);
    __syncthreads();
    pg8::Gemm g{C.proj(), C.wout(l), ROWS_P, DM, DMIX, PJW};
    pg8::StaticOrder S; S.init(ROWS_P, DM, C.G, C.bid);
    pg8::Unit u0{0, 0}, uu;
    (void)S.next(0, u0);
    { const int ui = C.tid >> 8, row = C.tid & 255;
      if (S.next(ui, uu)) {
          const float* p = C.ssq() + (size_t)(uu.pm * 256 + row) * 64; float s0 = 0.f, s1 = 0.f;
#pragma unroll
          for (int j = 0; j < 8; ++j) { const f32x4 a = *(const f32x4*)(p + 4 * j), b = *(const f32x4*)(p + 32 + 4 * j); s0 += (a[0] + a[1]) + (a[2] + a[3]); s1 += (b[0] + b[1]) + (b[2] + b[3]); }
          const float q0 = s0 * (1.f / 512.f) + EPS, q1 = s1 * (1.f / 512.f) + EPS, r0 = rsqrtf(q0), r1 = rsqrtf(q1);
          f32x4 f; f[0] = sqrtf(q0); f[1] = r0 * sqrtf(q1); f[2] = r1; f[3] = 0.f;
          ((LAS f32x4*)(C.lds + LDS_GNT))[ui * 256 + row] = f;
      } }
    __syncthreads();
    EpiOut E{C, l, u0.pm, u0.pn};
    pg8::gemm_phase<EpiOut, pg8::StaticOrder, true, true>(C.lds, g, S, E, C.tid);
}
template <int MODE>
DI void p0_transpose_item(const Ctx& C, const float* W, const float* scale, int K, int Nsrc, int Ndst, bf16_t* WT, LAS float* scr, int item) {
    const int lane = C.lane, nblk = Ndst / 64, kb = item / nblk, nb = item % nblk, k0 = 64 * kb, n0 = 64 * nb;
    const int cgp = lane & 15, kq = lane >> 4;
    const int ncol = n0 + 4 * cgp;
    const int src = (MODE == 0) ? orig_col(ncol) : ncol;
#pragma unroll 8
    for (int i = 0; i < 16; ++i) {
        const int kk = 4 * i + kq, k = k0 + kk;
        f32x4 v = (f32x4){0.f, 0.f, 0.f, 0.f};
        if (src >= 0) {
            v = *(const f32x4*)(W + (size_t)k * Nsrc + src);
            const float sc = (MODE == 0) ? scale[k] : (k >= 1024 ? scale[k - 1024] : 1.f);
            v = v * sc;
        }
        scr[(4 * cgp + 0) * 65 + kk] = v[0]; scr[(4 * cgp + 1) * 65 + kk] = v[1]; scr[(4 * cgp + 2) * 65 + kk] = v[2]; scr[(4 * cgp + 3) * 65 + kk] = v[3];
    }
    LDS_FENCE();
    const LAS float* sr = scr + lane * 65;
    bf16_t* orow = WT + (size_t)(n0 + lane) * K + k0;
#pragma unroll
    for (int j = 0; j < 8; ++j) {
        u32x4 o; o.x = cvt_pk_bf16(sr[8 * j], sr[8 * j + 1]); o.y = cvt_pk_bf16(sr[8 * j + 2], sr[8 * j + 3]); o.z = cvt_pk_bf16(sr[8 * j + 4], sr[8 * j + 5]); o.w = cvt_pk_bf16(sr[8 * j + 6], sr[8 * j + 7]);
        *(u32x4*)(orow + 8 * j) = o;
    }
    LDS_FENCE();
}
DI void prep_layer(const Ctx& C, int l, int part, int nparts) {
    LAS float* scr = (LAS float*)(C.lds + C.wave * 16640);
    const int gw = part * NWAVES + C.wave, NGW = nparts * NWAVES;
    constexpr int I_IN = (DM / 64) * (NPAD / 64), I_OUT = (DMIX / 64) * (DM / 64);
    for (int it = gw; it < I_IN + I_OUT; it += NGW) {
        if (it < I_IN) p0_transpose_item<0>(C, C.inp(10) + (size_t)l * DM * DINP, C.inp(9) + l * DM, DM, DINP, NPAD, C.win(l), scr, it);
        else p0_transpose_item<1>(C, C.inp(27) + (size_t)l * DMIX * DM, C.inp(26) + l * 1024, DMIX, DM, DM, C.wout(l), scr, it - I_IN);
    }
}
DI void prep_cache(const Ctx& C, int l, int part, int nparts) {
    const int gw = part * NWAVES + C.wave, NGW = nparts * NWAVES;
    for (int it = gw; it < NSB_S * PAST / 4; it += NGW) {
        const int b = it / (PAST / 4), pos0 = 4 * (it % (PAST / 4));
#pragma unroll
        for (int j = 0; j < 5; ++j) {
            const int pc = C.lane + 64 * j, pp = pc / 80, q = pc % 80, pos = pos0 + pp;
            const size_t base = ((size_t)(l * NSB_S + b) * PAST + pos);
            const f32x4 v = (q < 32) ? *(const f32x4*)(C.inp(2) + base * 128 + 4 * q) : (q < 64 ? *(const f32x4*)(C.inp(3) + base * 128 + 4 * (q - 32)) : *(const f32x4*)(C.inp(4) + base * 64 + 4 * (q - 64)));
            u32x2 o; o.x = cvt_pk_bf16(v[0], v[1]); o.y = cvt_pk_bf16(v[2], v[3]);
            *(u32x2*)(C.kvb(l) + kvb_off(NPB + b) + (size_t)pos * KVW + 4 * q) = o;
        }
    }
}
DI void phase_prologue(const Ctx& C) {
    prep_layer(C, 0, C.bid, C.G); prep_cache(C, 0, C.bid, C.G);
    const int gw = C.bid * NWAVES + C.wave, NGW = C.G * NWAVES;
    for (int m0 = 4 * gw; m0 < ROWS; m0 += 4 * NGW) {
        f32x4 v[4][4];
#pragma unroll
        for (int rr = 0; rr < 4; ++rr) { const int m = m0 + rr; const float* xr = (m < ROWS_P) ? C.inp(0) + (size_t)m * DM : C.inp(1) + (size_t)(m - ROWS_P) * DM;
#pragma unroll
            for (int j = 0; j < 4; ++j) v[rr][j] = *(const f32x4*)(xr + 4 * C.lane + 256 * j); }
#pragma unroll
        for (int rr = 0; rr < 4; ++rr) { const int m = m0 + rr; float ss = 0.f;
#pragma unroll
            for (int j = 0; j < 4; ++j) { const f32x4 x = v[rr][j]; ss += (x[0] * x[0] + x[1] * x[1]) + (x[2] * x[2] + x[3] * x[3]);
                u32x2 o; o.x = cvt_pk_bf16(x[0], x[1]); o.y = cvt_pk_bf16(x[2], x[3]); *(u32x2*)(C.hb() + (size_t)m * DM + 4 * C.lane + 256 * j) = o; }
            ss = wave_sum(ss);
            if (C.lane < 16) C.rss()[(size_t)m * 16 + C.lane] = (C.lane == 0) ? ss : 0.f; }
    }
}

#define MFMA32(a, b, c) __builtin_amdgcn_mfma_f32_32x32x16_bf16((a), (b), (c), 0, 0, 0)
DI void outproj_tail_item(const Ctx& C, int l, int rt, int g) {
    const int lane = C.lane, wave = C.wave, r = lane & 31, h = lane >> 5;
    const bf16_t* WO = C.wout(l); const bf16_t* PJ = C.proj();
    const int m0 = rt * 32, c0 = 64 * g, c1 = c0 + 32, kbeg = 256 * wave;
    f32x16 a0, a1;
#pragma unroll
    for (int i = 0; i < 16; ++i) { a0[i] = 0.f; a1[i] = 0.f; }
    const bf16_t* Ap = PJ + (size_t)(m0 + r) * PJW + 8 * h + kbeg;
    const bf16_t* B0 = WO + (size_t)(c0 + r) * DMIX + 8 * h + kbeg;
    const bf16_t* B1 = WO + (size_t)(c1 + r) * DMIX + 8 * h + kbeg;
#pragma unroll 8
    for (int k0 = 0; k0 < 256; k0 += 16) { const bf16x8 a = *(const bf16x8*)(Ap + k0); a0 = MFMA32(a, *(const bf16x8*)(B0 + k0), a0); a1 = MFMA32(a, *(const bf16x8*)(B1 + k0), a1); }
    LAS float* part = (LAS float*)C.lds;
#pragma unroll
    for (int i = 0; i < 16; ++i) { part[((wave * 2 + 0) * 16 + i) * 64 + lane] = a0[i]; part[((wave * 2 + 1) * 16 + i) * 64 + lane] = a1[i]; }
    __syncthreads();
    if (wave == 0) {
        float r0, r1; { const float* p = C.ssq() + (size_t)(m0 + r) * 64; float s0 = 0.f, s1 = 0.f;
#pragma unroll
            for (int j = 0; j < 32; ++j) { s0 += p[j]; s1 += p[32 + j]; }
            r0 = rsqrtf(s0 * (1.f / 512.f) + EPS); r1 = rsqrtf(s1 * (1.f / 512.f) + EPS); }
#pragma unroll
        for (int reg = 0; reg < 16; ++reg) {
            const int rowl = crow(reg, h), m = m0 + rowl;
            const float g0 = bperm(r0, rowl), g1 = bperm(r1, rowl);
            float sab[2], sc0[2], sc1[2];
#pragma unroll
            for (int t = 0; t < 2; ++t) {
                sab[t] = (part[((0 * 2 + t) * 16 + reg) * 64 + lane] + part[((1 * 2 + t) * 16 + reg) * 64 + lane]) + (part[((2 * 2 + t) * 16 + reg) * 64 + lane] + part[((3 * 2 + t) * 16 + reg) * 64 + lane]);
                sc0[t] = part[((4 * 2 + t) * 16 + reg) * 64 + lane] + part[((5 * 2 + t) * 16 + reg) * 64 + lane];
                sc1[t] = part[((6 * 2 + t) * 16 + reg) * 64 + lane] + part[((7 * 2 + t) * 16 + reg) * 64 + lane];
            }
            const float* xres = (l == 0) ? ((m < ROWS_P) ? C.inp(0) + (size_t)m * DM : C.inp(1) + (size_t)(m - ROWS_P) * DM) : C.out + (size_t)m * DM;
            const float v0 = xres[c0 + r] + sab[0] + g0 * sc0[0] + g1 * sc1[0];
            const float v1 = xres[c1 + r] + sab[1] + g0 * sc0[1] + g1 * sc1[1];
            C.out[(size_t)m * DM + c0 + r] = v0; C.out[(size_t)m * DM + c1 + r] = v1;
            if (l == 0) {
                C.hb()[(size_t)m * DM + c0 + r] = f2bf(v0); C.hb()[(size_t)m * DM + c1 + r] = f2bf(v1);
                const float ss = half_sum32(v0 * v0 + v1 * v1);
                if (r == 0) C.rss()[(size_t)m * 16 + g] = ss;
            }
        }
    }
    __syncthreads();
}

constexpr int SS_XST = 0;
constexpr int SS_BM = SS_XST + 64 * 144;
constexpr int SS_CM = SS_BM + 64 * 272;
constexpr int SS_BWT = SS_CM + 64 * 272;
constexpr int SS_HA = SS_BWT + 128 * 144;
constexpr int SS_SCAL = SS_HA + 2 * 64 * 272;
constexpr int SS_CW = SS_SCAL + 2 * 1024;
constexpr int SS_RAW = SS_CW + 5 * 320 * 4;
constexpr int SS_Z = SS_RAW + 67 * 640;
constexpr int SS_WT = SS_Z + 8192;
constexpr int SS_END = SS_WT + 3 * 2048;
static_assert(SS_END <= LDS_BYTES - 256, "SSD LDS map");
typedef short s16x4 __attribute__((ext_vector_type(4)));
DI float fast_silu(float x) { return x * __builtin_amdgcn_rcpf(1.f + __builtin_amdgcn_exp2f(-1.4426950408889634f * x)); }
DI bf16x8 lds_frag(const LAS unsigned char* base, int row, int rowbytes, int col) { return *(const LAS bf16x8*)(base + row * rowbytes + col * 2); }

DI void ssd_item(const Ctx& C, int l, int sb, int hd) {
    const int tid = C.tid, lane = C.lane, wave = C.wave, r = lane & 31, h = lane >> 5;
    const int T = sb_T(sb), row0 = sb_row0(sb), g = hd >> 3, NC = T / 64;
    LAS unsigned char* L = C.lds;
    bf16_t* PJ = C.proj();
    const float aneg = -expf(C.inp(24)[l * 16 + hd]), dtb = C.inp(23)[l * 16 + hd], Dh = C.inp(25)[l * 16 + hd];
    const bool stager = tid < 320;
    const int gp = 32 * wave + (lane & 31), sth = lane >> 5;
    const int cg = 0, seg = 0; (void)cg; (void)seg;
    int colbase, cch;
    if (cg < 8) { cch = hd * 64 + 8 * cg; } else if (cg < 24) { cch = 1024 + g * 128 + 8 * (cg - 8); } else { cch = 1280 + g * 128 + 8 * (cg - 24); }
    colbase = C_XBC + cch;
    for (int i = tid; i < 5 * 320; i += NTHREADS) {
        const int j = i / 320, c = i % 320, cg2 = c >> 3, e = c & 7;
        const int ch = (cg2 < 8) ? hd * 64 + 8 * cg2 + e : (cg2 < 24 ? 1024 + g * 128 + 8 * (cg2 - 8) + e : 1280 + g * 128 + 8 * (cg2 - 24) + e);
        ((LAS float*)(L + SS_CW))[i] = (j < 4) ? C.inp(21)[((size_t)l * 4 + j) * 1536 + ch] : C.inp(22)[l * 1536 + ch];
    }
    const int sj = wave - 4, sph = sj & 1, nq0 = 2 * (sj >> 1);
    f32x16 hacc0, hacc1;
#pragma unroll
    for (int i = 0; i < 16; ++i) { hacc0[i] = 0.f; hacc1[i] = 0.f; }
    if (wave >= 4) {
        if (sb >= NPB) {
            const float* st = C.inp(8) + (((size_t)(l * NSB_S + sb - NPB) * 16 + hd) * 64 + 32 * sph + r) * 128;
#pragma unroll
            for (int gq = 0; gq < 4; ++gq) {
                const f32x4 v0 = *(const f32x4*)(st + 32 * nq0 + 8 * gq + 4 * h), v1 = *(const f32x4*)(st + 32 * (nq0 + 1) + 8 * gq + 4 * h);
#pragma unroll
                for (int e = 0; e < 4; ++e) { hacc0[4 * gq + e] = v0[e]; hacc1[4 * gq + e] = v1[e]; }
            }
        }
#pragma unroll
        for (int gq = 0; gq < 4; ++gq) {
            u32x2 w0, w1; w0.x = cvt_pk_bf16(hacc0[4 * gq], hacc0[4 * gq + 1]); w0.y = cvt_pk_bf16(hacc0[4 * gq + 2], hacc0[4 * gq + 3]);
            w1.x = cvt_pk_bf16(hacc1[4 * gq], hacc1[4 * gq + 1]); w1.y = cvt_pk_bf16(hacc1[4 * gq + 2], hacc1[4 * gq + 3]);
            *(LAS u32x2*)(L + SS_HA + (32 * sph + r) * 272 + (32 * nq0 + 8 * gq + 4 * h) * 2) = w0;
            *(LAS u32x2*)(L + SS_HA + (32 * sph + r) * 272 + (32 * (nq0 + 1) + 8 * gq + 4 * h) * 2) = w1;
        }
    }
    const int yph = wave & 1, ylh = (wave >> 1) & 1;
#define SSD_DMA_RAW(cc) do { const int t0_ = 64 * (cc); \
        for (int k_ = wave; k_ < 42; k_ += NWAVES) { \
            const int q_ = 64 * k_ + lane, rr_ = q_ / 40, pc_ = q_ - 40 * rr_, t_ = t0_ - 3 + rr_; \
            const int col_ = C_XBC + ((pc_ < 8) ? hd * 64 + 8 * pc_ : (pc_ < 24 ? 1024 + g * 128 + 8 * (pc_ - 8) : 1280 + g * 128 + 8 * (pc_ - 24))); \
            if (q_ < 2680 && t_ >= 0) __builtin_amdgcn_global_load_lds((const unsigned*)(PJ + (size_t)(row0 + t_) * PJW + col_), (LAS unsigned*)(L + SS_RAW + k_ * 1024), 16, 0, 0); } \
    } while (0)
#define SSD_DMA_Z(cc) do { const int t0_ = 64 * (cc); \
        if (wave < 4) { _Pragma("unroll") for (int k_ = 0; k_ < 2; ++k_) { const int rr_ = 16 * k_ + (lane >> 2), pc_ = lane & 3; \
            __builtin_amdgcn_global_load_lds((const unsigned*)(PJ + (size_t)(row0 + t0_ + 32 * ylh + rr_) * PJW + C_Z + hd * 64 + 32 * yph + 8 * pc_), \
                                             (LAS unsigned*)(L + SS_Z + (2 * yph + ylh) * 2048 + k_ * 1024), 16, 0, 0); } } \
    } while (0)
    if (tid < 120) {
        const int rr = tid / 40, pc = tid % 40;
        const int ch = (pc < 8) ? hd * 64 + 8 * pc : (pc < 24 ? 1024 + g * 128 + 8 * (pc - 8) : 1280 + g * 128 + 8 * (pc - 24));
        u32x4 v = (u32x4){0u, 0u, 0u, 0u};
        if (sb >= NPB) { const float* st = C.inp(7) + ((size_t)(l * NSB_S + sb - NPB) * 3 + rr) * 1536 + ch; v = pack8(*(const f32x4*)st, *(const f32x4*)(st + 4)); }
        *(LAS u32x4*)(L + SS_RAW + rr * 640 + pc * 16) = v;
    }
#define SSD_S0(cc) do { LAS float* SC_ = (LAS float*)(L + SS_SCAL + ((cc) & 1) * 1024); \
        const float dt_ = softplus_f(C.dtr()[(size_t)(row0 + 64 * (cc) + lane) * 16 + hd] + dtb); float x_ = dt_ * aneg; \
        _Pragma("unroll") for (int o_ = 1; o_ < 64; o_ <<= 1) { const float y_ = bperm(x_, lane - o_); if (lane >= o_) x_ += y_; } \
        const float c63_ = __int_as_float(__builtin_amdgcn_readlane(__float_as_int(x_), 63)); \
        SC_[lane] = x_; SC_[64 + lane] = dt_; SC_[128 + lane] = __builtin_amdgcn_exp2f(1.4426950408889634f * (c63_ - x_)) * dt_; SC_[192 + lane] = __builtin_amdgcn_exp2f(1.4426950408889634f * x_); } while (0)
    if (wave == 7) SSD_S0(0);
    SSD_DMA_RAW(0); SSD_DMA_Z(0);
    asm volatile("s_waitcnt vmcnt(0)" ::: "memory");
    __syncthreads();
    for (int c = 0; c < NC; ++c) {
        const int t0 = 64 * c, par = c & 1;
        LAS float* SC = (LAS float*)(L + SS_SCAL + par * 1024);
        PROBE_BEGIN(12);
        asm volatile("s_waitcnt vmcnt(0)" ::: "memory"); LDS_FENCE(); __syncthreads();
        if (l == 0) PROBE_END(12, C);
        PROBE_BEGIN(10);
        if (stager) {
            const LAS float* CW = (const LAS float*)(L + SS_CW) + 2 * gp;
            const float a0 = CW[0], a1 = CW[320], a2 = CW[640], a3 = CW[960], ab = CW[1280];
            const float b0 = CW[1], b1 = CW[321], b2 = CW[641], b3 = CW[961], bb = CW[1281];
            const bool isB = (gp >= 32 && gp < 96);
#pragma unroll
            for (int tb = 0; tb < 4; ++tb) {
                const int tk0 = 32 * sth + 8 * tb;
                float xa[11], xb[11];
#pragma unroll
                for (int i = 0; i < 11; ++i) { const unsigned w = *(const LAS unsigned*)(L + SS_RAW + (tk0 + i) * 640 + 4 * gp); xa[i] = __uint_as_float(w << 16); xb[i] = __uint_as_float(w & 0xffff0000u); }
                float ta[8], tc[8];
#pragma unroll
                for (int j = 0; j < 8; ++j) {
                    ta[j] = fast_silu(ab + a0 * xa[j] + a1 * xa[j + 1] + a2 * xa[j + 2] + a3 * xa[j + 3]);
                    tc[j] = fast_silu(bb + b0 * xb[j] + b1 * xb[j + 1] + b2 * xb[j + 2] + b3 * xb[j + 3]);
                }
                if (gp < 32) {
                    u32x4 wa, wb;
                    wa.x = cvt_pk_bf16(ta[0], ta[1]); wa.y = cvt_pk_bf16(ta[2], ta[3]); wa.z = cvt_pk_bf16(ta[4], ta[5]); wa.w = cvt_pk_bf16(ta[6], ta[7]);
                    wb.x = cvt_pk_bf16(tc[0], tc[1]); wb.y = cvt_pk_bf16(tc[2], tc[3]); wb.z = cvt_pk_bf16(tc[4], tc[5]); wb.w = cvt_pk_bf16(tc[6], tc[7]);
                    *(LAS u32x4*)(L + SS_XST + (2 * gp) * 144 + tk0 * 2) = wa; *(LAS u32x4*)(L + SS_XST + (2 * gp + 1) * 144 + tk0 * 2) = wb;
                } else {
                    const int n0 = isB ? 2 * (gp - 32) : 2 * (gp - 96);
                    LAS unsigned char* img = L + (isB ? SS_BM : SS_CM);
#pragma unroll
                    for (int j = 0; j < 8; ++j) *(LAS unsigned*)(img + (tk0 + j) * 272 + n0 * 2) = cvt_pk_bf16(ta[j], tc[j]);
                    if (isB) {
                        float te[8];
#pragma unroll
                        for (int j = 0; j < 8; ++j) te[j] = SC[128 + tk0 + j];
                        u32x4 wa, wb;
                        wa.x = cvt_pk_bf16(ta[0] * te[0], ta[1] * te[1]); wa.y = cvt_pk_bf16(ta[2] * te[2], ta[3] * te[3]); wa.z = cvt_pk_bf16(ta[4] * te[4], ta[5] * te[5]); wa.w = cvt_pk_bf16(ta[6] * te[6], ta[7] * te[7]);
                        wb.x = cvt_pk_bf16(tc[0] * te[0], tc[1] * te[1]); wb.y = cvt_pk_bf16(tc[2] * te[2], tc[3] * te[3]); wb.z = cvt_pk_bf16(tc[4] * te[4], tc[5] * te[5]); wb.w = cvt_pk_bf16(tc[6] * te[6], tc[7] * te[7]);
                        *(LAS u32x4*)(L + SS_BWT + n0 * 144 + tk0 * 2) = wa; *(LAS u32x4*)(L + SS_BWT + (n0 + 1) * 144 + tk0 * 2) = wb;
                    }
                }
            }
        }
        if (l == 0) PROBE_END(10, C);
        PROBE_BEGIN(13);
        LDS_FENCE(); __syncthreads();
        if (l == 0) PROBE_END(13, C);
        PROBE_BEGIN(11);
        if (c + 1 < NC) SSD_DMA_RAW(c + 1);
        if (wave < 4) {
            const LAS unsigned char* HAc = L + SS_HA + par * (64 * 272);
            const float ecl = SC[192 + 32 * ylh + r];
            f32x16 ya;
#pragma unroll
            for (int i = 0; i < 16; ++i) ya[i] = 0.f;
#pragma unroll
            for (int ks = 0; ks < 8; ++ks) ya = MFMA32(lds_frag(HAc, 32 * yph + r, 272, 16 * ks + 8 * h), lds_frag(L + SS_CM, 32 * ylh + r, 272, 16 * ks + 8 * h), ya);
#pragma unroll
            for (int i = 0; i < 16; ++i) ya[i] *= ecl;
            LDS_FENCE(); __syncthreads();
#pragma unroll
            for (int sh = 0; sh < 2; ++sh) {
                if (sh <= ylh) {
#pragma unroll
                    for (int s2 = 0; s2 < 2; ++s2) {
                        const LAS unsigned char* xp = L + SS_XST + (32 * yph + r) * 144 + (32 * sh + 16 * s2 + 4 * h) * 2;
                        const u32x2 lo = *(const LAS u32x2*)(xp), hi = *(const LAS u32x2*)(xp + 16);
                        u32x4 a; a.x = lo.x; a.y = lo.y; a.z = hi.x; a.w = hi.y;
                        const bf16x8 wf = *(const LAS bf16x8*)(L + SS_WT + (sh + ylh) * 2048 + s2 * 1024 + lane * 16);
                        ya = MFMA32(__builtin_bit_cast(bf16x8, a), wf, ya);
                    }
                }
            }
            float ss = 0.f;
            bf16_t* zp = PJ + (size_t)(row0 + t0 + 32 * ylh + r) * PJW + C_Z + hd * 64 + 32 * yph + 4 * h;
#pragma unroll
            for (int gq = 0; gq < 4; ++gq) {
                const u32x2 zz = *(const LAS u32x2*)(L + SS_Z + (2 * yph + ylh) * 2048 + r * 64 + (8 * gq + 4 * h) * 2);
                const float z0 = __uint_as_float(zz.x << 16), z1 = __uint_as_float(zz.x & 0xffff0000u), z2 = __uint_as_float(zz.y << 16), z3 = __uint_as_float(zz.y & 0xffff0000u);
                const float y0 = ya[4 * gq] * fast_silu(z0), y1 = ya[4 * gq + 1] * fast_silu(z1), y2 = ya[4 * gq + 2] * fast_silu(z2), y3 = ya[4 * gq + 3] * fast_silu(z3);
                ss += (y0 * y0 + y1 * y1) + (y2 * y2 + y3 * y3);
                u32x2 w; w.x = cvt_pk_bf16(y0, y1); w.y = cvt_pk_bf16(y2, y3);
                *(u32x2*)(zp + 8 * gq) = w;
            }
            ss = xor32_sum(ss);
            if (h == 0) { float* q = C.ssq() + (size_t)(row0 + t0 + 32 * ylh + r) * 64 + hd * 4 + yph; q[0] = ss; q[2] = 0.f; }
            LDS_FENCE();
            if (c + 1 < NC) SSD_DMA_Z(c + 1);
        } else {
            if (wave == 7) { if (c + 1 < NC) SSD_S0(c + 1); }
            else {
                const int gt = wave - 4, gsh = gt >> 1, glh = (gt + 1) >> 1;
                const float cuml = SC[32 * glh + r];
                f32x16 ga;
#pragma unroll
                for (int i = 0; i < 16; ++i) ga[i] = 0.f;
#pragma unroll
                for (int ks = 0; ks < 8; ++ks) ga = MFMA32(lds_frag(L + SS_BM, 32 * gsh + r, 272, 16 * ks + 8 * h), lds_frag(L + SS_CM, 32 * glh + r, 272, 16 * ks + 8 * h), ga);
                float wv[16];
#pragma unroll
                for (int reg = 0; reg < 16; ++reg) {
                    const int s_ = 32 * gsh + crow(reg, h), ll = 32 * glh + r;
                    const float cs = SC[s_], ds = SC[64 + s_];
                    float w = (s_ <= ll) ? ga[reg] * __builtin_amdgcn_exp2f(1.4426950408889634f * (cuml - cs)) * ds : 0.f;
                    if (s_ == ll) w += Dh;
                    wv[reg] = w;
                }
#pragma unroll
                for (int s2 = 0; s2 < 2; ++s2) {
                    u32x4 p; p.x = cvt_pk_bf16(wv[8 * s2], wv[8 * s2 + 1]); p.y = cvt_pk_bf16(wv[8 * s2 + 2], wv[8 * s2 + 3]); p.z = cvt_pk_bf16(wv[8 * s2 + 4], wv[8 * s2 + 5]); p.w = cvt_pk_bf16(wv[8 * s2 + 6], wv[8 * s2 + 7]);
                    *(LAS u32x4*)(L + SS_WT + gt * 2048 + s2 * 1024 + lane * 16) = p;
                }
            }
            LDS_FENCE(); __syncthreads();
            const float decay = SC[192 + 63];
#pragma unroll
            for (int i = 0; i < 16; ++i) { hacc0[i] *= decay; hacc1[i] *= decay; }
#pragma unroll
            for (int ks = 0; ks < 4; ++ks) {
                const bf16x8 xb = lds_frag(L + SS_XST, 32 * sph + r, 144, 16 * ks + 8 * h);
                hacc0 = MFMA32(lds_frag(L + SS_BWT, 32 * nq0 + r, 144, 16 * ks + 8 * h), xb, hacc0);
                hacc1 = MFMA32(lds_frag(L + SS_BWT, 32 * (nq0 + 1) + r, 144, 16 * ks + 8 * h), xb, hacc1);
            }
            LAS unsigned char* HAn = L + SS_HA + (par ^ 1) * (64 * 272);
#pragma unroll
            for (int gq = 0; gq < 4; ++gq) {
                u32x2 w0, w1; w0.x = cvt_pk_bf16(hacc0[4 * gq], hacc0[4 * gq + 1]); w0.y = cvt_pk_bf16(hacc0[4 * gq + 2], hacc0[4 * gq + 3]);
                w1.x = cvt_pk_bf16(hacc1[4 * gq], hacc1[4 * gq + 1]); w1.y = cvt_pk_bf16(hacc1[4 * gq + 2], hacc1[4 * gq + 3]);
                *(LAS u32x2*)(HAn + (32 * sph + r) * 272 + (32 * nq0 + 8 * gq + 4 * h) * 2) = w0;
                *(LAS u32x2*)(HAn + (32 * sph + r) * 272 + (32 * (nq0 + 1) + 8 * gq + 4 * h) * 2) = w1;
            }
        }
        if (l == 0) PROBE_END(11, C);
    }
    if (wave >= 4) {
        float* o = out_sh(C, l, sb) + ((size_t)hd * 64 + 32 * sph + r) * 128;
#pragma unroll
        for (int gq = 0; gq < 4; ++gq) {
            f32x4 v0, v1;
#pragma unroll
            for (int e = 0; e < 4; ++e) { v0[e] = hacc0[4 * gq + e]; v1[e] = hacc1[4 * gq + e]; }
            *(f32x4*)(o + 32 * nq0 + 8 * gq + 4 * h) = v0; *(f32x4*)(o + 32 * (nq0 + 1) + 8 * gq + 4 * h) = v1;
        }
    }
    __syncthreads();
#undef SSD_DMA_RAW
#undef SSD_DMA_Z
#undef SSD_S0
}

DI unsigned mono_key(float f) { const unsigned u = __float_as_uint(f); return (u & 0x80000000u) ? ~u : (u | 0x80000000u); }
DI int t5_bucket(int rel) {
    const int n = rel < 0 ? -rel : rel; int b;
    if (n < 8) b = n; else if (n < 12) b = 8; else if (n < 16) b = 9; else if (n < 23) b = 10; else if (n < 32) b = 11; else if (n < 46) b = 12; else if (n < 64) b = 13; else if (n < 91) b = 14; else b = 15;
    return b + (rel > 0 ? 16 : 0);
}
constexpr int AT_MASK = 0;
constexpr int AT_TMASK = AT_MASK + 64 * 65 * 4;
constexpr int AT_QST = AT_TMASK + 64 * 65 * 4;
constexpr int AT_MISC = AT_QST + 1024;
constexpr int AT_LUT = AT_MISC + 64;
constexpr int AT_HIST = AT_LUT + 8192;
constexpr int AT_RING = AT_HIST;
constexpr int AT_QI = AT_HIST + 65792;
constexpr int AT_END = AT_QI + 64 * 528;
static_assert(AT_END <= LDS_BYTES - 256 && AT_RING + 65536 <= AT_END, "attention LDS map");
typedef short v4i16_t __attribute__((ext_vector_type(4)));
DI float max3f(float a, float b, float c) { float r; asm("v_max3_f32 %0, %1, %2, %3" : "=v"(r) : "v"(a), "v"(b), "v"(c)); return r; }
#define AT_WAIT_V(n) asm volatile("s_waitcnt vmcnt(" #n ")" ::: "memory")
#define AT_BAR() do { asm volatile("s_waitcnt lgkmcnt(0)" ::: "memory"); __builtin_amdgcn_s_barrier(); asm volatile("" ::: "memory"); } while (0)

template <int MODE, bool FIRST>
DI void idx_pass(const Ctx& C, const bf16_t* KV, const float (&w4)[4], int ntiles, int tq4, int qh, int r, int h) {
    LAS unsigned char* L = C.lds;
    const int q = 32 * qh + r, lane = 32 * h + r;
    const LAS unsigned* QS = (const LAS unsigned*)(L + AT_QST) + 4 * q;
    const unsigned pfx = QS[0], info = QS[1];
    const int lvl = info & 15; const bool done = (info >> 4) & 1, tie = (info >> 5) & 1;
    const int sh = (MODE == 0) ? (lvl == 0 ? 23 : (lvl == 1 ? 14 : (lvl == 2 ? 5 : 0))) : (int)(info >> 8);
    const unsigned bmask = (lvl == 3) ? 31u : 511u;
    const int psh = (lvl == 1) ? 23 : (lvl == 2 ? 14 : 5);
    unsigned* KS = C.keys();
    bf16x8 an[2][4];
    if (FIRST && tq4 < ntiles) {
#pragma unroll
        for (int kh = 0; kh < 2; ++kh)
#pragma unroll
            for (int ks = 0; ks < 4; ++ks) an[kh][ks] = *(const bf16x8*)(KV + (size_t)(64 * tq4 + 32 * kh + r) * KVW + 256 + 8 * h + 16 * ks);
    }
    for (int t = tq4; t < ntiles; t += 4) {
        bf16x8 ac[2][4];
        if (FIRST) {
#pragma unroll
            for (int kh = 0; kh < 2; ++kh)
#pragma unroll
                for (int ks = 0; ks < 4; ++ks) ac[kh][ks] = an[kh][ks];
            if (t + 4 < ntiles) {
#pragma unroll
                for (int kh = 0; kh < 2; ++kh)
#pragma unroll
                    for (int ks = 0; ks < 4; ++ks) an[kh][ks] = *(const bf16x8*)(KV + (size_t)(64 * (t + 4) + 32 * kh + r) * KVW + 256 + 8 * h + 16 * ks);
            }
        }
#pragma unroll
        for (int kh = 0; kh < 2; ++kh) {
            unsigned* kslot = KS + (size_t)((t * 2 + kh) * 2 + qh) * 1024 + lane;
            unsigned key[16];
            if (FIRST) {
                float sc[16];
#pragma unroll
                for (int i = 0; i < 16; ++i) sc[i] = 0.f;
#pragma unroll
                for (int hh = 0; hh < 4; ++hh) {
                    f32x16 acc;
#pragma unroll
                    for (int i = 0; i < 16; ++i) acc[i] = 0.f;
#pragma unroll
                    for (int ks = 0; ks < 4; ++ks) acc = MFMA32(ac[kh][ks], *(const LAS bf16x8*)(L + AT_QI + q * 528 + (64 * hh + 16 * ks + 8 * h) * 2), acc);
#pragma unroll
                    for (int i = 0; i < 16; ++i) sc[i] += w4[hh] * fmaxf(acc[i], 0.f);
                }
#pragma unroll
                for (int i = 0; i < 16; ++i) { key[i] = mono_key(sc[i]); kslot[64 * i] = key[i]; }
            } else {
#pragma unroll
                for (int i = 0; i < 16; ++i) key[i] = __hip_atomic_load(kslot + 64 * i, __ATOMIC_RELAXED, __HIP_MEMORY_SCOPE_AGENT);
            }
            if (MODE == 0) {
                if (!done) {
                    LAS unsigned* HR = (LAS unsigned*)(L + AT_HIST) + 257 * q;
#pragma unroll
                    for (int i = 0; i < 16; ++i) {
                        const bool part = (lvl == 0) || ((key[i] >> psh) == pfx);
                        if (part) { const unsigned bin = (key[i] >> sh) & bmask; atomicAdd((unsigned*)(HR + (bin >> 1)), 1u << ((bin & 1u) << 4)); }
                    }
                }
            } else {
                unsigned mw = 0u, tw = 0u;
#pragma unroll
                for (int i = 15; i >= 0; --i) {
                    const bool sel = tie ? (key[i] > pfx) : ((key[i] >> sh) >= pfx);
                    const bool tb = tie && (key[i] == pfx);
                    mw = (mw << 1) | (sel ? 1u : 0u); tw = (tw << 1) | (tb ? 1u : 0u);
                    if ((i & 3) == 0 && i > 0) { mw <<= 4; tw <<= 4; }
                }
                mw <<= 4 * h; tw <<= 4 * h;
                if (mw) atomicOr((unsigned*)((LAS unsigned*)(L + AT_MASK) + 65 * q + 2 * t + kh), mw);
                if (tw) atomicOr((unsigned*)((LAS unsigned*)(L + AT_TMASK) + 65 * q + 2 * t + kh), tw);
            }
        }
    }
    if (FIRST) asm volatile("s_waitcnt vmcnt(0)" ::: "memory");
}

DI void attn_item(const Ctx& C, int l, int sb, int qb) {
    const int tid = C.tid, lane = C.lane, wave = C.wave, r = lane & 31, h = lane >> 5;
    LAS unsigned char* L = C.lds;
    const int P = sb_P(sb), row0 = sb_row0(sb), t0 = 64 * qb, pos0 = P + t0;
    const int ntiles = (pos0 >> 6) + 1, Ladm = 64 * ntiles;
    bf16_t* PJ = C.proj(); const bf16_t* KV = C.kvb(l) + kvb_off(sb);
    LAS unsigned* MASK = (LAS unsigned*)(L + AT_MASK); LAS unsigned* TMASK = (LAS unsigned*)(L + AT_TMASK);
    LAS unsigned* QST = (LAS unsigned*)(L + AT_QST); LAS unsigned* MISC = (LAS unsigned*)(L + AT_MISC);
#ifdef PROBE_QB
    const bool pcond = (l == 0 && sb == 0 && qb == PROBE_QB);
#else
    const bool pcond = false;
#endif
    PROBE_BEGIN(40); PROBE_BEGIN(41);
    for (int i = tid; i < 64 * 65; i += NTHREADS) { const int w = i % 65; MASK[i] = (Ladm <= 256 && w < 2 * ntiles) ? 0xffffffffu : 0u; TMASK[i] = 0u; }
    for (int i = tid; i < 64 * 257; i += NTHREADS) ((LAS unsigned*)(L + AT_HIST))[i] = 0u;
    if (tid < 64) { unsigned k256 = 256u; asm volatile("" : "+v"(k256)); QST[4 * tid] = 0u; QST[4 * tid + 1] = 0u; QST[4 * tid + 2] = k256; QST[4 * tid + 3] = 0u; }
    for (int i = tid; i < 8 * 256; i += NTHREADS) { const int hq = i >> 8, rel = (i & 255) - 191; ((LAS float*)(L + AT_LUT))[i] = 1.4426950408889634f * (C.inp(20)[t5_bucket(rel) * 8 + hq] - C.inp(20)[15 * 8 + hq]); }
    if (tid == 0) MISC[0] = 0u;
    __syncthreads();
    if (pcond) PROBE_END(41, C);
    PROBE_BEGIN(4); PROBE_BEGIN(42);
    if (Ladm > 256) {
        const int qh = wave & 1, tq4 = wave >> 1, q = 32 * qh + r;
        float w4[4];
        { const f32x4 wv = *(const f32x4*)(C.wi() + (size_t)(row0 + t0 + q) * 4); w4[0] = wv[0]; w4[1] = wv[1]; w4[2] = wv[2]; w4[3] = wv[3]; }
        for (int i = tid; i < 2048; i += NTHREADS) { const int qq = i >> 5, pc = i & 31;
            *(LAS u32x4*)(L + AT_QI + qq * 528 + pc * 16) = *(const u32x4*)(PJ + (size_t)(row0 + t0 + qq) * PJW + C_QI + 8 * pc); }
        __syncthreads();
        for (int lvl = 0; lvl < 4; ++lvl) {
            PROBE_BEGIN(20);
            if (lvl == 0) idx_pass<0, true>(C, KV, w4, ntiles, tq4, qh, r, h); else idx_pass<0, false>(C, KV, w4, ntiles, tq4, qh, r, h);
            if (tid == 0) MISC[0] = 0u;
            __syncthreads();
            if (l == 0) PROBE_END(20, C);
            PROBE_BEGIN(21);
            int ln = lane; asm volatile("" : "+v"(ln));
            for (int qq = 8 * wave; qq < 8 * wave + 8; ++qq) {
                const unsigned pfx = QST[4 * qq], info = QST[4 * qq + 1], need = QST[4 * qq + 2];
                if ((info >> 4) & 1) continue;
                LAS unsigned* HR = (LAS unsigned*)(L + AT_HIST) + 257 * qq + 4 * ln;
                unsigned c[8];
#pragma unroll
                for (int j = 0; j < 4; ++j) { const unsigned wv = HR[j]; c[2 * j] = wv & 0xffffu; c[2 * j + 1] = wv >> 16; HR[j] = 0u; }
                unsigned ct = 0u;
#pragma unroll
                for (int j = 0; j < 8; ++j) ct += c[j];
                unsigned S = ct;
#pragma unroll
                for (int o = 1; o < 64; o <<= 1) { const unsigned y = (unsigned)__builtin_amdgcn_ds_bpermute((ln + o) << 2, (int)S); if (ln + o < 64) S += y; }
                if (S >= need && (S - ct) < need) {
                    unsigned rem = need - (S - ct), cum = 0u; int b = 0; unsigned cb = 0u;
                    bool found = false;
#pragma unroll
                    for (int j = 7; j >= 0; --j) { if (!found) { if (cum + c[j] >= rem) { b = j; cb = c[j]; found = true; } else cum += c[j]; } }
                    const unsigned need2 = rem - cum, binidx = 8u * ln + (unsigned)b;
                    const int bits = (lvl == 3) ? 5 : 9, shc = (lvl == 0) ? 23 : (lvl == 1 ? 14 : (lvl == 2 ? 5 : 0));
                    const unsigned npfx = (lvl == 0) ? binidx : ((pfx << bits) | binidx);
                    unsigned ninfo, nneed = need2, opfx = npfx;
                    if (need2 == cb) ninfo = (unsigned)lvl | 16u | ((unsigned)shc << 8);
                    else if (lvl == 0 && (binidx == 256u || binidx == 255u)) { ninfo = 16u | 32u; opfx = (binidx == 256u) ? 0x80000000u : 0x7fffffffu; }
                    else if (lvl == 3) ninfo = 16u | 32u;
                    else { ninfo = (unsigned)(lvl + 1); atomicAdd((unsigned*)MISC, 1u); }
                    QST[4 * qq] = opfx; QST[4 * qq + 1] = ninfo; QST[4 * qq + 2] = nneed;
                }
            }
            __syncthreads();
            if (l == 0) PROBE_END(21, C);
            if (MISC[0] == 0u) break;
            __syncthreads();
        }
        PROBE_BEGIN(22);
        idx_pass<1, false>(C, KV, w4, ntiles, tq4, qh, r, h);
        __syncthreads();
        if (l == 0) PROBE_END(22, C);
        PROBE_BEGIN(23);
        int ln2 = lane; asm volatile("" : "+v"(ln2));
        for (int qq = 8 * wave; qq < 8 * wave + 8; ++qq) {
            if (!((QST[4 * qq + 1] >> 5) & 1)) continue;
            const unsigned mwd = (ln2 < 2 * ntiles) ? MASK[65 * qq + ln2] : 0u, twd = (ln2 < 2 * ntiles) ? TMASK[65 * qq + ln2] : 0u;
            int have = __popc(mwd);
#pragma unroll
            for (int o = 1; o < 64; o <<= 1) have += __builtin_amdgcn_ds_bpermute((ln2 ^ o) << 2, have);
            const int want = 256 - have, pc = __popc(twd);
            int incl = pc;
#pragma unroll
            for (int o = 1; o < 64; o <<= 1) { const int y = __builtin_amdgcn_ds_bpermute((ln2 - o) << 2, incl); if (ln2 >= o) incl += y; }
            int take = want - (incl - pc); take = take < 0 ? 0 : (take > pc ? pc : take);
            unsigned wrem = twd, add = 0u;
            for (int k = 0; k < take; ++k) { add |= wrem & (0u - wrem); wrem &= wrem - 1u; }
            if (add) MASK[65 * qq + ln2] = mwd | add;
        }
        __syncthreads();
        if (l == 0) PROBE_END(23, C);
    }
    if (l == 0) PROBE_END(4, C);
    if (pcond) PROBE_END(42, C);
    PROBE_BEGIN(43);
    PROBE_BEGIN(5);
    const int hq = wave, kvh = wave >> 2;
    const unsigned ring = (unsigned)(size_t)(L + AT_RING);
    const float* LUT = nullptr; (void)LUT;
    const LAS float* lut = (const LAS float*)(L + AT_LUT) + 256 * hq;
    const float cfar = 1.4426950408889634f * C.inp(20)[15 * 8 + hq];
#define AT_DMA(tt, slot) do { const bf16_t* src_ = KV + (size_t)(64 * (tt)) * KVW; \
        _Pragma("unroll") for (int i_ = 0; i_ < 2; ++i_) { const int k_ = wave * 2 + i_, row_ = 4 * k_ + (lane >> 4), pc_ = lane & 15; \
            __builtin_amdgcn_global_load_lds((const unsigned*)(src_ + (size_t)row_ * KVW + 8 * (pc_ ^ (row_ & 15))), (LAS unsigned*)(L + AT_RING + (slot) * 32768 + k_ * 1024), 16, 0, 0); \
            __builtin_amdgcn_global_load_lds((const unsigned*)(src_ + (size_t)row_ * KVW + 128 + 8 * pc_), (LAS unsigned*)(L + AT_RING + (slot) * 32768 + 16384 + k_ * 1024), 16, 0, 0); } \
    } while (0)
    bf16x8 qfA[4], qfB[4];
#pragma unroll
    for (int qh = 0; qh < 2; ++qh) {
        const bf16_t* qp = PJ + (size_t)(row0 + t0 + 32 * qh + r) * PJW + C_Q + hq * 64 + 8 * h; float qv[4][8]; float ss = 0.f;
#pragma unroll
        for (int ks = 0; ks < 4; ++ks) { const u32x4 v = *(const u32x4*)(qp + 16 * ks);
            qv[ks][0] = __uint_as_float(v.x << 16); qv[ks][1] = __uint_as_float(v.x & 0xffff0000u); qv[ks][2] = __uint_as_float(v.y << 16); qv[ks][3] = __uint_as_float(v.y & 0xffff0000u);
            qv[ks][4] = __uint_as_float(v.z << 16); qv[ks][5] = __uint_as_float(v.z & 0xffff0000u); qv[ks][6] = __uint_as_float(v.w << 16); qv[ks][7] = __uint_as_float(v.w & 0xffff0000u);
#pragma unroll
            for (int j = 0; j < 8; ++j) ss += qv[ks][j] * qv[ks][j]; }
        ss = xor32_sum(ss);
        const float sc = rsqrtf(ss * (1.f / 64.f) + EPS) * (0.125f * 1.4426950408889634f);
        const float* qn = C.inp(18) + l * 64 + 8 * h;
#pragma unroll
        for (int ks = 0; ks < 4; ++ks) { const f32x4 n0 = *(const f32x4*)(qn + 16 * ks), n1 = *(const f32x4*)(qn + 16 * ks + 4);
            u32x4 p; p.x = cvt_pk_bf16(qv[ks][0] * sc * n0[0], qv[ks][1] * sc * n0[1]); p.y = cvt_pk_bf16(qv[ks][2] * sc * n0[2], qv[ks][3] * sc * n0[3]);
            p.z = cvt_pk_bf16(qv[ks][4] * sc * n1[0], qv[ks][5] * sc * n1[1]); p.w = cvt_pk_bf16(qv[ks][6] * sc * n1[2], qv[ks][7] * sc * n1[3]);
            if (qh == 0) qfA[ks] = __builtin_bit_cast(bf16x8, p); else qfB[ks] = __builtin_bit_cast(bf16x8, p); }
    }
    f32x16 oA0, oA1, oB0, oB1;
#pragma unroll
    for (int i = 0; i < 16; ++i) { oA0[i] = 0.f; oA1[i] = 0.f; oB0[i] = 0.f; oB1[i] = 0.f; }
    float mrefA = 0.f, lrunA = 0.f, mrefB = 0.f, lrunB = 0.f;
#define AT_HALF(QF, QQ, MREF, LRUN, O0, O1, PW) do { \
        f32x16 s0, s1; { const float ini = cfar - MREF; _Pragma("unroll") for (int i = 0; i < 16; ++i) { s0[i] = ini; s1[i] = ini; } } \
        _Pragma("unroll") for (int ks = 0; ks < 4; ++ks) { s0 = MFMA32(kf0[ks], QF[ks], s0); s1 = MFMA32(kf1[ks], QF[ks], s1); } \
        const int nm0 = (int)(~(MASK[65 * (QQ) + 2 * t] >> (4 * h))), nm1 = (int)(~(MASK[65 * (QQ) + 2 * t + 1] >> (4 * h))); \
        if (nearb) { _Pragma("unroll") for (int i = 0; i < 16; ++i) { const int kl = (i & 3) + 8 * (i >> 2), rel = 64 * t + kl + 4 * h - (pos0 + (QQ)); s0[i] += lut[rel + 191]; s1[i] += lut[rel + 32 + 191]; } } \
        _Pragma("unroll") for (int i = 0; i < 16; ++i) { const int kl = (i & 3) + 8 * (i >> 2); \
            s0[i] += __int_as_float(__builtin_amdgcn_sbfe(nm0, kl, 1) & (int)0xff800000u); s1[i] += __int_as_float(__builtin_amdgcn_sbfe(nm1, kl, 1) & (int)0xff800000u); } \
        float tm; { float a = max3f(s0[0], s0[1], s1[0]), b = max3f(s0[2], s0[3], s1[1]); a = max3f(a, s1[2], s1[3]); \
            _Pragma("unroll") for (int i = 4; i < 16; i += 4) { a = max3f(a, s0[i], s0[i + 1]); b = max3f(b, s0[i + 2], s0[i + 3]); a = max3f(a, s1[i], s1[i + 1]); b = max3f(b, s1[i + 2], s1[i + 3]); } \
            tm = xor32_max(fmaxf(a, b)); } \
        if (__builtin_amdgcn_ballot_w64(tm > 0.f) != 0ull) { const float dl = fmaxf(tm, 0.f), al = __builtin_amdgcn_exp2f(-dl); MREF += dl; LRUN *= al; \
            _Pragma("unroll") for (int i = 0; i < 16; ++i) { s0[i] -= dl; s1[i] -= dl; O0[i] *= al; O1[i] *= al; } } \
        float psum = 0.f; \
        _Pragma("unroll") for (int i = 0; i < 16; ++i) { s0[i] = __builtin_amdgcn_exp2f(s0[i]); s1[i] = __builtin_amdgcn_exp2f(s1[i]); psum += s0[i] + s1[i]; } \
        LRUN += psum; \
        _Pragma("unroll") for (int kk = 0; kk < 2; ++kk) { u32x4 w0, w1; \
            w0.x = cvt_pk_bf16(s0[8 * kk], s0[8 * kk + 1]); w0.y = cvt_pk_bf16(s0[8 * kk + 2], s0[8 * kk + 3]); w0.z = cvt_pk_bf16(s0[8 * kk + 4], s0[8 * kk + 5]); w0.w = cvt_pk_bf16(s0[8 * kk + 6], s0[8 * kk + 7]); \
            w1.x = cvt_pk_bf16(s1[8 * kk], s1[8 * kk + 1]); w1.y = cvt_pk_bf16(s1[8 * kk + 2], s1[8 * kk + 3]); w1.z = cvt_pk_bf16(s1[8 * kk + 4], s1[8 * kk + 5]); w1.w = cvt_pk_bf16(s1[8 * kk + 6], s1[8 * kk + 7]); \
            PW[kk] = __builtin_bit_cast(bf16x8, w0); PW[2 + kk] = __builtin_bit_cast(bf16x8, w1); } \
    } while (0)
    AT_WAIT_V(0);
    AT_DMA(0, 0);
    if (ntiles > 1) AT_DMA(1, 1);
    int sl = 0, sl2 = 2;
    for (int t = 0; t < ntiles; ++t) {
        if (t + 1 < ntiles) { AT_WAIT_V(4); } else { AT_WAIT_V(0); }
        AT_BAR();
        if (t + 2 < ntiles) AT_DMA(t + 2, sl2);
        const LAS unsigned char* Kt = L + AT_RING + sl * 32768; const LAS unsigned char* Vt = Kt + 16384;
        bf16x8 kf0[4], kf1[4];
#pragma unroll
        for (int ks = 0; ks < 4; ++ks) { const int pc = kvh * 8 + 2 * ks + h;
            kf0[ks] = *(const LAS bf16x8*)(Kt + r * 256 + ((pc ^ (r & 15)) << 4)); kf1[ks] = *(const LAS bf16x8*)(Kt + (32 + r) * 256 + ((pc ^ (r & 15)) << 4)); }
        const bool nearb = (t + 3 > ntiles - 1);
        bf16x8 pA[4], pB[4];
        AT_HALF(qfA, r, mrefA, lrunA, oA0, oA1, pA);
        AT_HALF(qfB, 32 + r, mrefB, lrunB, oB0, oB1, pB);
#pragma unroll
        for (int kk = 0; kk < 4; ++kk) {
            const int i16 = lane & 15, key0 = 16 * kk + 4 * h + (i16 >> 2);
#pragma unroll
            for (int dh = 0; dh < 2; ++dh) {
                const int dcol = kvh * 64 + 32 * dh + 16 * ((lane >> 4) & 1) + 4 * (i16 & 3);
                const v4i16_t lo = __builtin_amdgcn_ds_read_tr16_b64_v4i16((LAS v4i16_t*)(Vt + key0 * 256 + dcol * 2));
                const v4i16_t hi = __builtin_amdgcn_ds_read_tr16_b64_v4i16((LAS v4i16_t*)(Vt + (key0 + 8) * 256 + dcol * 2));
                const bf16x8 va = (bf16x8){lo[0], lo[1], lo[2], lo[3], hi[0], hi[1], hi[2], hi[3]};
                if (dh == 0) { oA0 = MFMA32(va, pA[kk], oA0); oB0 = MFMA32(va, pB[kk], oB0); } else { oA1 = MFMA32(va, pA[kk], oA1); oB1 = MFMA32(va, pB[kk], oB1); }
            }
        }
        sl2 = sl; sl = (sl == 2) ? 0 : sl + 1; sl2 = (sl == 0) ? 2 : sl - 1;
    }
#undef AT_HALF
#pragma unroll
    for (int qh = 0; qh < 2; ++qh) {
        const float inv = 1.f / xor32_sum(qh == 0 ? lrunA : lrunB);
        bf16_t* gp = PJ + (size_t)(row0 + t0 + 32 * qh + r) * PJW + C_GA + hq * 64 + 4 * h;
#pragma unroll
        for (int dh = 0; dh < 2; ++dh)
#pragma unroll
            for (int gq = 0; gq < 4; ++gq) {
                const u32x2 gg = *(const u32x2*)(gp + 32 * dh + 8 * gq);
                const float g0 = __uint_as_float(gg.x << 16), g1 = __uint_as_float(gg.x & 0xffff0000u), g2 = __uint_as_float(gg.y << 16), g3 = __uint_as_float(gg.y & 0xffff0000u);
                const f32x16& oo = (qh == 0) ? (dh == 0 ? oA0 : oA1) : (dh == 0 ? oB0 : oB1);
                const float a0 = oo[4 * gq] * inv, a1 = oo[4 * gq + 1] * inv, a2 = oo[4 * gq + 2] * inv, a3 = oo[4 * gq + 3] * inv;
                u32x2 w; w.x = cvt_pk_bf16(a0 * fast_silu(g0), a1 * fast_silu(g1)); w.y = cvt_pk_bf16(a2 * fast_silu(g2), a3 * fast_silu(g3));
                *(u32x2*)(gp + 32 * dh + 8 * gq) = w;
            }
    }
#undef AT_DMA
    AT_WAIT_V(0);
    __syncthreads();
    if (l == 0) PROBE_END(5, C);
    if (pcond) { PROBE_END(43, C); PROBE_END(40, C); }
}

constexpr int LR_RAW = 0;
constexpr int LR_GL = LR_RAW + 67 * 128;
constexpr int LR_XC = LR_GL + 2 * 8192;
constexpr int LR_XCF = LR_XC + 64 * 144;
constexpr int LR_SEG = LR_XCF + 64 * 256;
constexpr int LR_YS = LR_SEG + 2048;
constexpr int LR_END = LR_YS + 8192;
static_assert(LR_END <= LDS_BYTES - 256, "LRU LDS map");
typedef float f32x4v __attribute__((ext_vector_type(4)));
#define MFMA16(a, b, c) __builtin_amdgcn_mfma_f32_16x16x32_bf16((a), (b), (c), 0, 0, 0)
DI float fast_sigmoid(float x) { return __builtin_amdgcn_rcpf(1.f + __builtin_amdgcn_exp2f(-1.4426950408889634f * x)); }

DI void lru_item(const Ctx& C, int l, int sb, int blk) {
    const int tid = C.tid, lane = C.lane, wave = C.wave, fr = lane & 15, fq = lane >> 4;
    const int T = sb_T(sb), row0 = sb_row0(sb), NC = T / 64;
    LAS unsigned char* L = C.lds;
    bf16_t* PJ = C.proj();
    const int ts = wave >> 1, dh = wave & 1;
    bf16x8 wf[2][2][2];
#pragma unroll
    for (int gt = 0; gt < 2; ++gt)
#pragma unroll
        for (int db = 0; db < 2; ++db)
#pragma unroll
            for (int kb = 0; kb < 2; ++kb) {
                const float* wp = (gt == 0 ? C.inp(13) : C.inp(15)) + ((size_t)(l * 8 + blk) * 64 + 32 * kb + 8 * fq) * 64 + 32 * dh + 16 * db + fr;
                u32x4 p; p.x = cvt_pk_bf16(wp[0], wp[64]); p.y = cvt_pk_bf16(wp[128], wp[192]); p.z = cvt_pk_bf16(wp[256], wp[320]); p.w = cvt_pk_bf16(wp[384], wp[448]);
                wf[gt][db][kb] = __builtin_bit_cast(bf16x8, p);
            }
    float ba[2], bx[2], spl[2], hc[2];
#pragma unroll
    for (int db = 0; db < 2; ++db) {
        const int ch = blk * 64 + 32 * dh + 16 * db + fr;
        ba[db] = C.inp(14)[l * 512 + ch]; bx[db] = C.inp(16)[l * 512 + ch]; spl[db] = 8.f * 1.4426950408889634f * softplus_f(-C.inp(17)[l * 512 + ch]);
        hc[db] = (sb >= NPB) ? C.inp(6)[(size_t)(l * NSB_S + sb - NPB) * 512 + ch] : 0.f;
    }
    const int cp = tid & 31, sg = tid >> 5;
    float cw[2][5];
#pragma unroll
    for (int e = 0; e < 2; ++e) { const int ch = blk * 64 + 2 * cp + e;
#pragma unroll
        for (int j = 0; j < 4; ++j) cw[e][j] = C.inp(11)[((size_t)l * 4 + j) * 512 + ch];
        cw[e][4] = C.inp(12)[l * 512 + ch]; }
#define LRU_DMA(cc) do { const int t0_ = 64 * (cc); \
        for (int k_ = wave; k_ < 9; k_ += NWAVES) { const int q_ = 64 * k_ + lane, rr_ = q_ >> 3, pc_ = q_ & 7, t_ = t0_ - 3 + rr_; \
            if (q_ < 536 && t_ >= 0) __builtin_amdgcn_global_load_lds((const unsigned*)(PJ + (size_t)(row0 + t_) * PJW + C_XL + blk * 64 + 8 * pc_), (LAS unsigned*)(L + LR_RAW + k_ * 1024), 16, 0, 0); } \
        { const int rr_ = 8 * wave + (lane >> 3), pc_ = lane & 7; \
          __builtin_amdgcn_global_load_lds((const unsigned*)(PJ + (size_t)(row0 + t0_ + rr_) * PJW + C_GL + blk * 64 + 8 * pc_), (LAS unsigned*)(L + LR_GL + ((cc) & 1) * 8192 + wave * 1024), 16, 0, 0); } \
    } while (0)
    if (tid < 24) {
        const int rr = tid >> 3, pc = tid & 7; u32x4 v = (u32x4){0u, 0u, 0u, 0u};
        if (sb >= NPB) { const float* st = C.inp(5) + ((size_t)(l * NSB_S + sb - NPB) * 3 + rr) * 512 + blk * 64 + 8 * pc; v = pack8(*(const f32x4*)st, *(const f32x4*)(st + 4)); }
        *(LAS u32x4*)(L + LR_RAW + rr * 128 + pc * 16) = v;
    }
    LRU_DMA(0);
    asm volatile("s_waitcnt vmcnt(0)" ::: "memory");
    __syncthreads();
    for (int c = 0; c < NC; ++c) {
        const int t0 = 64 * c;
        {
            float xa[7], xb[7];
#pragma unroll
            for (int i = 0; i < 7; ++i) { const unsigned w = *(const LAS unsigned*)(L + LR_RAW + (4 * sg + i) * 128 + 4 * cp); xa[i] = __uint_as_float(w << 16); xb[i] = __uint_as_float(w & 0xffff0000u); }
#pragma unroll
            for (int j = 0; j < 4; ++j) {
                const float ya = cw[0][4] + cw[0][0] * xa[j] + cw[0][1] * xa[j + 1] + cw[0][2] * xa[j + 2] + cw[0][3] * xa[j + 3];
                const float yb = cw[1][4] + cw[1][0] * xb[j] + cw[1][1] * xb[j + 1] + cw[1][2] * xb[j + 2] + cw[1][3] * xb[j + 3];
                *(LAS unsigned*)(L + LR_XC + (4 * sg + j) * 144 + 4 * cp) = cvt_pk_bf16(ya, yb);
                f32x2_t v2 = {ya, yb}; *(LAS f32x2_t*)(L + LR_XCF + (4 * sg + j) * 256 + 8 * cp) = v2;
            }
        }
        LDS_FENCE(); __syncthreads();
        if (c + 1 < NC) LRU_DMA(c + 1);
        f32x4v ga[2], gx[2];
#pragma unroll
        for (int db = 0; db < 2; ++db) { ga[db] = (f32x4v){0.f, 0.f, 0.f, 0.f}; gx[db] = (f32x4v){0.f, 0.f, 0.f, 0.f}; }
#pragma unroll
        for (int kb = 0; kb < 2; ++kb) {
            const bf16x8 af = *(const LAS bf16x8*)(L + LR_XC + (16 * ts + fr) * 144 + (32 * kb + 8 * fq) * 2);
#pragma unroll
            for (int db = 0; db < 2; ++db) { ga[db] = MFMA16(af, wf[0][db][kb], ga[db]); gx[db] = MFMA16(af, wf[1][db][kb], gx[db]); }
        }
        float Pk[2][4], Hk[2][4], Pq[2], Hq[2];
#pragma unroll
        for (int db = 0; db < 2; ++db) {
            float P = 1.f, H = 0.f;
#pragma unroll
            for (int reg = 0; reg < 4; ++reg) {
                const float xc = *(const LAS float*)(L + LR_XCF + (16 * ts + 4 * fq + reg) * 256 + (32 * dh + 16 * db + fr) * 4);
                const float rg = fast_sigmoid(ga[db][reg] + ba[db]), ig = fast_sigmoid(gx[db][reg] + bx[db]);
                const float a = __builtin_amdgcn_exp2f(-rg * spl[db]);
                const float b = sqrtf(fmaxf(1.f - a * a, 0.f)) * (ig * xc);
                H = a * H + b; P = a * P; Pk[db][reg] = P; Hk[db][reg] = H;
            }
            float Pi = P, Hi = H;
            { const float Pp = bperm(Pi, lane - 16), Hp = bperm(Hi, lane - 16); if (fq >= 1) { Hi = Pi * Hp + Hi; Pi = Pi * Pp; } }
            { const float Pp = bperm(Pi, lane - 32), Hp = bperm(Hi, lane - 32); if (fq >= 2) { Hi = Pi * Hp + Hi; Pi = Pi * Pp; } }
            if (fq == 3) { f32x2_t v2 = {Pi, Hi}; *(LAS f32x2_t*)(L + LR_SEG + (ts * 64 + 32 * dh + 16 * db + fr) * 8) = v2; }
            const float Pe = bperm(Pi, lane - 16), He = bperm(Hi, lane - 16);
            Pq[db] = (fq >= 1) ? Pe : 1.f; Hq[db] = (fq >= 1) ? He : 0.f;
        }
        LDS_FENCE(); __syncthreads();
#pragma unroll
        for (int db = 0; db < 2; ++db) {
            float s = hc[db], sin = hc[db];
#pragma unroll
            for (int k = 0; k < 4; ++k) { const f32x2_t m = *(const LAS f32x2_t*)(L + LR_SEG + (k * 64 + 32 * dh + 16 * db + fr) * 8); if (k == ts) sin = s; s = m[0] * s + m[1]; }
            hc[db] = s;
            const float hin = Pq[db] * sin + Hq[db];
            const bf16_t* glp = nullptr; (void)glp;
#pragma unroll
            for (int reg = 0; reg < 4; ++reg) {
                const float hval = Pk[db][reg] * hin + Hk[db][reg];
                const int t = 16 * ts + 4 * fq + reg, d = 32 * dh + 16 * db + fr;
                const float glv = bf2f(*(const LAS bf16_t*)(L + LR_GL + (c & 1) * 8192 + t * 128 + d * 2));
                *(LAS bf16_t*)(L + LR_YS + t * 128 + d * 2) = f2bf(hval * fast_silu(glv));
            }
        }
        asm volatile("s_waitcnt vmcnt(0)" ::: "memory");
        LDS_FENCE(); __syncthreads();
        { const int rr = tid >> 3, pc = tid & 7;
          *(u32x4*)(PJ + (size_t)(row0 + t0 + rr) * PJW + C_GL + blk * 64 + 8 * pc) = *(const LAS u32x4*)(L + LR_YS + rr * 128 + pc * 16); }
    }
    if (ts == 0 && fq == 0) {
#pragma unroll
        for (int db = 0; db < 2; ++db) out_lh(C, l, sb)[blk * 64 + 32 * dh + 16 * db + fr] = hc[db];
    }
#undef LRU_DMA
    asm volatile("s_waitcnt vmcnt(0)" ::: "memory");
    __syncthreads();
}

DI Ctx relaunder(const Ctx& C0) {
    Ctx C = C0; int ln; asm volatile("v_mbcnt_lo_u32_b32 %0, -1, 0\n\tv_mbcnt_hi_u32_b32 %0, -1, %0" : "=v"(ln)); C.lane = ln; C.tid = C.wave * 64 + ln;
    { unsigned long long w = (unsigned long long)C.ws, o = (unsigned long long)C.out; asm volatile("" : "+s"(w), "+s"(o));
      C.ws = (unsigned char*)(__attribute__((address_space(1))) unsigned char*)w; C.out = (float*)(__attribute__((address_space(1))) float*)o; }
    asm volatile("" : "+s"(C.G), "+s"(C.bid));
    return C;
}
constexpr int CW_QUEUE = 8192;
constexpr int MX_PREP = 64;
constexpr int MX_A = 144, MX_B = MX_A + 256, MX_C0 = MX_B + 8, MX_C = MX_C0 + 240, MX_D = MX_C + 128, MX_E = MX_D + 128, MX_F = MX_E + 128, MX_N = MX_F + 64;
DI void phase_mixers(const Ctx& Cin, int l) {
    unsigned* head = (unsigned*)(Cin.ws + WS_CTL) + CW_QUEUE + 64 * l;
    volatile LAS int* slot = (volatile LAS int*)(Cin.lds + LDS_BYTES - 24);
    for (;;) {
        __syncthreads();
        if (Cin.tid == 0) *slot = (int)__hip_atomic_fetch_add(head, 1u, __ATOMIC_RELAXED, __HIP_MEMORY_SCOPE_AGENT);
        __syncthreads();
        const int i = __builtin_amdgcn_readfirstlane(*slot);
        if (i >= MX_N + (l == 0 ? MX_PREP : 0)) break;
        const Ctx C = relaunder(Cin);
        if (i >= MX_N) { prep_layer(C, 1, i - MX_N, MX_PREP); continue; }
        int kind, sb, sub;
        if (i < MX_A) { kind = 0; sb = i & 15; sub = 31 - (i >> 4); }
        else if (i < MX_B) { const int j = i - MX_A; kind = 1; sb = j >> 4; sub = j & 15; }
        else if (i < MX_C0) { kind = 0; sb = NPB + (i - MX_B); sub = 0; }
        else if (i < MX_C) { const int j = i - MX_C0; kind = 0; sb = j & 15; sub = 22 - (j >> 4); }
        else if (i < MX_D) { const int j = i - MX_C; kind = 2; sb = j >> 3; sub = j & 7; }
        else if (i < MX_E) { const int j = i - MX_D; kind = 0; sb = j & 15; sub = 7 - (j >> 4); }
        else if (i < MX_F) { const int j = i - MX_E; kind = 1; sb = NPB + (j >> 4); sub = j & 15; }
        else { const int j = i - MX_F; kind = 2; sb = NPB + (j >> 3); sub = j & 7; }
        PROBE_BEGIN(50); PROBE_BEGIN(51); PROBE_BEGIN(52); PROBE_BEGIN(53);
        if (kind == 0) attn_item(C, l, sb, sub);
        else if (kind == 1) ssd_item(C, l, sb, sub);
        else lru_item(C, l, sb, sub);
        if (l == 0) { PROBE_END(50, C); if (kind == 0) PROBE_END(51, C); if (kind == 1) PROBE_END(52, C); if (kind == 2) PROBE_END(53, C); }
    }
}

#define XB_TMO      128
#define XB_XCNT(j)  (256  + 64 * (j))
#define XB_XSUB(j)  (1280 + 64 * (j))
#define XB_XGEN(j)  (2304 + 64 * (j))
#define XB_TOP      3328
#define XB_TOPGEN   3392
#define XCD_BAR_WORDS 3456
#define XB_SPIN_CAP (1u << 22)

__device__ __forceinline__ unsigned xb_ld(unsigned* p)              { return __hip_atomic_load(p, __ATOMIC_RELAXED, __HIP_MEMORY_SCOPE_AGENT); }
__device__ __forceinline__ unsigned xb_add(unsigned* p, unsigned v) { return __hip_atomic_fetch_add(p, v, __ATOMIC_RELAXED, __HIP_MEMORY_SCOPE_AGENT); }
__device__ __forceinline__ unsigned xb_xcc_id() { return (unsigned)__builtin_amdgcn_s_getreg((3 << 11) | 20) & 0xFu; }
#define XB_SPIN(cond, bar) do { unsigned _sp = 0; while (cond) { __builtin_amdgcn_s_sleep(1); \
    if ((++_sp & 255u) == 0u) { if (xb_ld(&(bar)[XB_TMO])) break; if (_sp > XB_SPIN_CAP) { atomicAdd(&(bar)[XB_TMO], 1u); break; } } } } while (0)

struct XcdBarrier {
    unsigned* bar; unsigned x;
    volatile LAS unsigned* st;
};

__device__ __forceinline__ XcdBarrier xcd_barrier_post(unsigned* bar, volatile LAS unsigned* st) {
    XcdBarrier b; b.bar = bar; b.x = xb_xcc_id(); b.st = st;
    if (threadIdx.x == 0) (void)xb_add(&bar[XB_XCNT(b.x)], 1u);
    return b;
}
__device__ __forceinline__ void xcd_barrier_complete(unsigned* bar, unsigned x, unsigned& nloc, unsigned& nx) {
    const unsigned G = gridDim.x * gridDim.y * gridDim.z;
    unsigned sum, cnt, mine, sp = 0u;
    for (;;) {
        sum = 0u; cnt = 0u; mine = 0u;
#pragma unroll
        for (unsigned j = 0; j < 16; ++j) { const unsigned c = xb_ld(&bar[XB_XCNT(j)]); sum += c; cnt += (c > 0u) ? 1u : 0u; mine = (j == x) ? c : mine; }
        if (sum == G) break;
        __builtin_amdgcn_s_sleep(1);
        if ((++sp & 255u) == 0u) { if (xb_ld(&bar[XB_TMO])) break; if (sp > XB_SPIN_CAP) { atomicAdd(&bar[XB_TMO], 1u); break; } }
    }
    nloc = mine > 0u ? mine : 1u; nx = cnt > 0u ? cnt : 1u;
}

__device__ __forceinline__ void xcd_barrier(const XcdBarrier& b) {
    asm volatile("s_waitcnt vmcnt(0)" ::: "memory");
    __syncthreads();
    if (threadIdx.x == 0) {
        unsigned* bar = b.bar;
        __builtin_amdgcn_s_waitcnt(0);
        unsigned nloc = b.st[0], nx = b.st[1];
        if (nloc == 0u) { xcd_barrier_complete(bar, b.x, nloc, nx); b.st[0] = nloc; b.st[1] = nx; }
        const unsigned old = xb_add(&bar[XB_XSUB(b.x)], 1u);
        const unsigned gen = old / nloc;
        if (old + 1u == (gen + 1u) * nloc) {
            __builtin_amdgcn_fence(__ATOMIC_RELEASE, "agent");
            asm volatile("s_waitcnt vmcnt(0)" ::: "memory");
            const unsigned og = xb_add(&bar[XB_TOP], 1u);
            const unsigned tg = og / nx;
            if (og + 1u == (tg + 1u) * nx) xb_add(&bar[XB_TOPGEN], 1u);
            else XB_SPIN(xb_ld(&bar[XB_TOPGEN]) == tg, bar);
            __builtin_amdgcn_fence(__ATOMIC_ACQUIRE, "agent");
            xb_add(&bar[XB_XGEN(b.x)], 1u);
            asm volatile("s_waitcnt vmcnt(0)" ::: "memory");
        } else {
            XB_SPIN(xb_ld(&bar[XB_XGEN(b.x)]) == gen, bar);
            __builtin_amdgcn_fence(__ATOMIC_ACQUIRE, "agent");
            asm volatile("s_waitcnt vmcnt(0)" ::: "memory");
        }
    }
    __syncthreads();
}


constexpr int PH_PER_LAYER = 3;
constexpr int N_PHASES = 1 + 2 * PH_PER_LAYER;
constexpr int CW_BAR = 4096;
__global__ void __launch_bounds__(NTHREADS, 2) mk_fwd(Args a) {
    extern __shared__ __attribute__((aligned(16))) unsigned char lds_raw[];
    Ctx C; C.out = a.out; C.ws = a.ws; C.lds = (LAS unsigned char*)lds_raw;
    C.tid = threadIdx.x; C.lane = C.tid & 63; C.wave = __builtin_amdgcn_readfirstlane(C.tid >> 6); C.G = gridDim.x; C.bid = blockIdx.x;
    if (C.tid == 0) {
#pragma unroll
        for (int i = 0; i < 28; ++i) ((LAS cfp_t*)(C.lds + LDS_BYTES - 256))[i] = a.in[i];
        ((volatile LAS unsigned*)(C.lds + LDS_BYTES - 32))[0] = 0u; ((volatile LAS unsigned*)(C.lds + LDS_BYTES - 32))[1] = 0u;
        *(LAS unsigned long long*)(C.lds + LDS_BYTES - 16) = 0ull;
    }
    __syncthreads();
    const XcdBarrier bar = xcd_barrier_post((unsigned*)(a.ws + WS_CTL) + CW_BAR, (volatile LAS unsigned*)(C.lds + LDS_BYTES - 32));
    const Ctx C0 = C;
#define LAUNDER() const Ctx C = relaunder(C0)
#ifdef PROBE_PHASE
    unsigned long long pr_t0 = 0, pr_t1 = 0;
#endif
    for (int ph = a.ph_lo; ph < a.ph_hi; ++ph) {
#ifdef PROBE_PHASE
        if (ph == PROBE_PHASE) pr_t0 = __builtin_amdgcn_s_memrealtime();
#endif
        if (ph == 0) { LAUNDER(); phase_prologue(C); }
        else {
            const int l = (ph - 1) / PH_PER_LAYER, k = (ph - 1) % PH_PER_LAYER;
            if (k == 0) { LAUNDER(); phase_inproj_gemm(C, l); }
            else if (k == 1) { LAUNDER(); phase_mixers(C, l); }
            else { LAUNDER(); phase_outproj_gemm(C, l); }
        }
        if (ph + 1 < a.ph_hi) { if (ph == 0) cg::this_grid().sync(); else xcd_barrier(bar); }
#ifdef PROBE_PHASE
        if (ph == PROBE_PHASE) pr_t1 = __builtin_amdgcn_s_memrealtime();
#endif
    }
#ifdef PROBE_PHASE
#ifdef PROBE_SUB
    pr_t0 = 0; pr_t1 = *(LAS unsigned long long*)(C0.lds + LDS_BYTES - 16);
#endif
#ifndef PROBE_BLOCK
#define PROBE_BLOCK 0
#endif
    if (PROBE_BLOCK < 0 || (int)blockIdx.x == PROBE_BLOCK) { const unsigned long long te = __builtin_amdgcn_s_memrealtime(), span = 4ull * (pr_t1 - pr_t0); while (__builtin_amdgcn_s_memrealtime() - te < span) __builtin_amdgcn_s_sleep(8); }
#endif
}

extern "C" void kernel_launch(void* const* d_in, const int* in_sizes, int n_in, void* d_out, int out_size, void* d_ws, size_t ws_size, hipStream_t stream) {
    static int grid = 0;
    if (grid == 0) {
        if (n_in != 28 || (size_t)out_size != O_END || ws_size < WS_END) { fprintf(stderr, "kernel_launch: unexpected shapes n_in %d out %d ws %zu\n", n_in, out_size, ws_size); grid = -1; return; }
        int dev = 0, cus = 0, per_cu = 0;
        hipGetDevice(&dev); hipDeviceGetAttribute(&cus, hipDeviceAttributeMultiprocessorCount, dev);
        hipFuncSetAttribute((const void*)mk_fwd, hipFuncAttributeMaxDynamicSharedMemorySize, LDS_BYTES);
        hipOccupancyMaxActiveBlocksPerMultiprocessor(&per_cu, (const void*)mk_fwd, NTHREADS, LDS_BYTES);
        if (per_cu < 1) per_cu = 1;
        grid = cus * 1;
        (void)hipGetLastError();
    }
    if (grid < 0) return;
    hipMemsetAsync((char*)d_ws + WS_CTL, 0, CTL_BYTES, stream);
    Args a{};
    for (int i = 0; i < 28; ++i) a.in[i] = (const float*)d_in[i];
    a.out = (float*)d_out; a.ws = (unsigned char*)d_ws;
    a.ph_lo = 0; a.ph_hi = N_PHASES;
    void* args[] = {&a};
    hipError_t e = hipLaunchCooperativeKernel((const void*)mk_fwd, dim3(grid), dim3(NTHREADS), args, LDS_BYTES, stream);
    if (e != hipSuccess) fprintf(stderr, "cooperative launch failed: %s (grid %d)\n", hipGetErrorString(e), grid);
}
```

```cpp
#include <hip/hip_runtime.h>
#include <hip/hip_cooperative_groups.h>
#include <cstdio>
#include <cstdint>
namespace cg = cooperative_groups;

typedef unsigned short bf16_t;
typedef short bf16x8 __attribute__((ext_vector_type(8)));
typedef float f32x4 __attribute__((ext_vector_type(4)));
typedef float f32x16 __attribute__((ext_vector_type(16)));
typedef unsigned u32x4 __attribute__((ext_vector_type(4)));
typedef unsigned u32x2 __attribute__((ext_vector_type(2)));
#define LAS __attribute__((address_space(3)))
#define DI __device__ __forceinline__

constexpr int DM = 1024, NPB = 16, SEQ = 2048, NSB_S = 8, DSEQ = 64, PAST = 1024;
constexpr int ROWS_P = NPB * SEQ;
constexpr int ROWS = ROWS_P + NSB_S * DSEQ;
constexpr int NSB = NPB + NSB_S;
constexpr int DINP = 5204, NPAD = 5376;
constexpr int PJW = 4864;
constexpr int DMIX = 2048;
constexpr float EPS = 1e-6f;
constexpr int C_GL = 0, C_GA = 512, C_Z = 1024, C_XL = 2048, C_Q = 2560, C_QI = 3072, C_XBC = 3328, C_T19 = 4864, C_T20 = 5120;
constexpr int KVW = 320;
constexpr size_t KVB_LAYER = (size_t)NPB * SEQ * KVW + (size_t)NSB_S * (PAST + DSEQ) * KVW;

constexpr size_t O_YP = 0;
constexpr size_t O_YS = O_YP + (size_t)NPB * SEQ * DM;
constexpr size_t O_AKP = O_YS + (size_t)NSB_S * DSEQ * DM;
constexpr size_t O_AVP = O_AKP + (size_t)2 * NPB * SEQ * 128;
constexpr size_t O_IKP = O_AVP + (size_t)2 * NPB * SEQ * 128;
constexpr size_t O_LCP = O_IKP + (size_t)2 * NPB * SEQ * 64;
constexpr size_t O_LHP = O_LCP + (size_t)2 * NPB * 3 * 512;
constexpr size_t O_SCP = O_LHP + (size_t)2 * NPB * 512;
constexpr size_t O_SHP = O_SCP + (size_t)2 * NPB * 3 * 1536;
constexpr size_t O_AKS = O_SHP + (size_t)2 * NPB * 16 * 64 * 128;
constexpr size_t O_AVS = O_AKS + (size_t)2 * NSB_S * DSEQ * 128;
constexpr size_t O_IKS = O_AVS + (size_t)2 * NSB_S * DSEQ * 128;
constexpr size_t O_LCS = O_IKS + (size_t)2 * NSB_S * DSEQ * 64;
constexpr size_t O_LHS = O_LCS + (size_t)2 * NSB_S * 3 * 512;
constexpr size_t O_SCS = O_LHS + (size_t)2 * NSB_S * 512;
constexpr size_t O_SHS = O_SCS + (size_t)2 * NSB_S * 3 * 1536;
constexpr size_t O_END = O_SHS + (size_t)2 * NSB_S * 16 * 64 * 128;

constexpr size_t MiB = 1u << 20;
constexpr size_t WS_CTL = 0, CTL_BYTES = 1 * MiB;
constexpr size_t WS_WIN = 1 * MiB;
constexpr size_t WIN_LAYER = (size_t)NPAD * DM;
constexpr size_t WS_WOUT = 22 * MiB;
constexpr size_t WOUT_LAYER = (size_t)DM * DMIX;
constexpr size_t WS_HB = 30 * MiB;
constexpr size_t WS_RSS = 95 * MiB;
constexpr size_t WS_WI = 98 * MiB;
constexpr size_t WS_DTR = 99 * MiB;
constexpr size_t WS_SSQ = 102 * MiB;
constexpr size_t WS_KVB = 112 * MiB;
constexpr size_t WS_PROJ = 138 * MiB;
constexpr size_t WS_KEYS_B = 447 * MiB;
constexpr size_t KEYS_PER_WG = 512 * 1024;
constexpr size_t WS_END = WS_KEYS_B + 128 * KEYS_PER_WG;
static_assert(WS_KVB + KVB_LAYER * 2 <= WS_PROJ && WS_PROJ + (size_t)ROWS * PJW * 2 <= WS_KEYS_B && 128 * KEYS_PER_WG <= 65 * MiB, "ws map");
static_assert(WS_END <= 512 * MiB, "ws map");

constexpr int NTHREADS = 512, NWAVES = 8;
constexpr int LDS_BYTES = 163840;

DI float bf2f(bf16_t v) { return __uint_as_float(((unsigned)v) << 16); }
DI bf16_t f2bf(float f) { unsigned u = __float_as_uint(f); return (bf16_t)((u + 0x7fffu + ((u >> 16) & 1u)) >> 16); }
DI unsigned pk2(float lo, float hi) { return (unsigned)f2bf(lo) | ((unsigned)f2bf(hi) << 16); }
DI int crow(int reg, int h) { return (reg & 3) + 8 * (reg >> 2) + 4 * h; }
template <int O> DI float swz_xor(float v) { return __int_as_float(__builtin_amdgcn_ds_swizzle(__float_as_int(v), (O << 10) | 0x1f)); }
DI float xor32_sum(float v) { auto rr = __builtin_amdgcn_permlane32_swap(__float_as_uint(v), __float_as_uint(v), false, false); return __uint_as_float(rr[0]) + __uint_as_float(rr[1]); }
DI float xor32_max(float v) { auto rr = __builtin_amdgcn_permlane32_swap(__float_as_uint(v), __float_as_uint(v), false, false); return fmaxf(__uint_as_float(rr[0]), __uint_as_float(rr[1])); }
DI float half_sum32(float v) {
    v += swz_xor<1>(v); v += swz_xor<2>(v); v += swz_xor<4>(v); v += swz_xor<8>(v); v += swz_xor<16>(v); return v;
}
DI float wave_sum(float v) { return xor32_sum(half_sum32(v)); }
DI float wave_max(float v) {
    v = fmaxf(v, swz_xor<1>(v)); v = fmaxf(v, swz_xor<2>(v)); v = fmaxf(v, swz_xor<4>(v)); v = fmaxf(v, swz_xor<8>(v)); v = fmaxf(v, swz_xor<16>(v)); return xor32_max(v);
}
DI float sum_fq(float v) { return xor32_sum(v + swz_xor<16>(v)); }
DI float bperm(float v, int srclane) { return __int_as_float(__builtin_amdgcn_ds_bpermute(srclane << 2, __float_as_int(v))); }
DI float silu_f(float x) { return x / (1.f + expf(-x)); }
DI float sigmoid_f(float x) { return 1.f / (1.f + expf(-x)); }
DI float softplus_f(float x) { return x > 20.f ? x : log1pf(expf(x)); }
#define LDS_FENCE() asm volatile("s_waitcnt lgkmcnt(0)" ::: "memory")

__host__ __device__ inline int orig_col(int c) {
    if (c < 512) return 512 + c;
    if (c < 1024) return 1792 + (c - 512);
    if (c < 2048) return 2628 + (c - 1024);
    if (c < 2560) return c - 2048;
    if (c < 3072) return 1024 + (c - 2560);
    if (c < 3328) return 2304 + (c - 3072);
    if (c < 4864) return 3652 + (c - 3328);
    if (c < 5120) { const int cl = c - 4864, bj = cl >> 7, wc = (cl >> 5) & 3, j = cl & 31, d = 32 * bj + j; return (wc < 2 ? 1536 : 1664) + (wc & 1) * 64 + d; }
    const int cl = c - 5120;
    if (cl < 64) return 2560 + cl;
    if (cl < 68) return 2624 + (cl - 64);
    if (cl < 84) return 5188 + (cl - 68);
    return -1;
}
DI int sb_T(int sb) { return sb < NPB ? SEQ : DSEQ; }
DI int sb_P(int sb) { return sb < NPB ? 0 : PAST; }
DI int sb_row0(int sb) { return sb < NPB ? sb * SEQ : ROWS_P + (sb - NPB) * DSEQ; }
DI size_t kvb_off(int sb) { return sb < NPB ? (size_t)sb * SEQ * KVW : (size_t)NPB * SEQ * KVW + (size_t)(sb - NPB) * (PAST + DSEQ) * KVW; }
DI void row_sbt(int m, int& sb, int& t) { if (m < ROWS_P) { sb = m >> 11; t = m & 2047; } else { const int r = m - ROWS_P; sb = NPB + (r >> 6); t = r & 63; } }

typedef const float* cfp_t;
struct Args { const float* in[28]; float* out; unsigned char* ws; int ph_lo, ph_hi; };

struct Ctx {
    float* out; unsigned char* ws;
    LAS unsigned char* lds;
    DI const float* inp(int k) const { return (const float*)(const __attribute__((address_space(1))) float*)(((LAS unsigned long long*)(lds + LDS_BYTES - 256))[k]); }
    int tid, lane, wave, G, bid;
    DI bf16_t* win(int l) const { return (bf16_t*)(ws + WS_WIN) + (size_t)l * WIN_LAYER; }
    DI bf16_t* wout(int l) const { return (bf16_t*)(ws + WS_WOUT) + (size_t)l * WOUT_LAYER; }
    DI bf16_t* hb() const { return (bf16_t*)(ws + WS_HB); }
    DI float* rss() const { return (float*)(ws + WS_RSS); }
    DI float* wi() const { return (float*)(ws + WS_WI); }
    DI float* dtr() const { return (float*)(ws + WS_DTR); }
    DI float* ssq() const { return (float*)(ws + WS_SSQ); }
    DI bf16_t* kvb(int) const { return (bf16_t*)(ws + WS_KVB); }
    DI unsigned* keys() const { return (unsigned*)(bid < 128 ? ws + WS_HB + (size_t)bid * KEYS_PER_WG : ws + WS_KEYS_B + (size_t)(bid - 128) * KEYS_PER_WG); }
    DI bf16_t* proj() const { return (bf16_t*)(ws + WS_PROJ); }
};
DI float* out_ak(const Ctx& C, int l, int sb) { return sb < NPB ? C.out + O_AKP + ((size_t)(l * NPB + sb) * SEQ) * 128 : C.out + O_AKS + ((size_t)(l * NSB_S + sb - NPB) * DSEQ) * 128; }
DI float* out_av(const Ctx& C, int l, int sb) { return sb < NPB ? C.out + O_AVP + ((size_t)(l * NPB + sb) * SEQ) * 128 : C.out + O_AVS + ((size_t)(l * NSB_S + sb - NPB) * DSEQ) * 128; }
DI float* out_ik(const Ctx& C, int l, int sb) { return sb < NPB ? C.out + O_IKP + ((size_t)(l * NPB + sb) * SEQ) * 64 : C.out + O_IKS + ((size_t)(l * NSB_S + sb - NPB) * DSEQ) * 64; }
DI float* out_lc(const Ctx& C, int l, int sb) { return sb < NPB ? C.out + O_LCP + (size_t)(l * NPB + sb) * 3 * 512 : C.out + O_LCS + (size_t)(l * NSB_S + sb - NPB) * 3 * 512; }
DI float* out_lh(const Ctx& C, int l, int sb) { return sb < NPB ? C.out + O_LHP + (size_t)(l * NPB + sb) * 512 : C.out + O_LHS + (size_t)(l * NSB_S + sb - NPB) * 512; }
DI float* out_sc(const Ctx& C, int l, int sb) { return sb < NPB ? C.out + O_SCP + (size_t)(l * NPB + sb) * 3 * 1536 : C.out + O_SCS + (size_t)(l * NSB_S + sb - NPB) * 3 * 1536; }
DI float* out_sh(const Ctx& C, int l, int sb) { return sb < NPB ? C.out + O_SHP + (size_t)(l * NPB + sb) * 16 * 64 * 128 : C.out + O_SHS + (size_t)(l * NSB_S + sb - NPB) * 16 * 64 * 128; }

#ifdef PROBE_SUB
#define PROBE_BEGIN(id) unsigned long long pb_##id = __builtin_amdgcn_s_memrealtime()
#define PROBE_END(id, Cx) do { if ((id) == PROBE_SUB && (Cx).tid == 0) *(LAS unsigned long long*)((Cx).lds + LDS_BYTES - 16) += __builtin_amdgcn_s_memrealtime() - pb_##id; } while (0)
#else
#define PROBE_BEGIN(id) do {} while (0)
#define PROBE_END(id, Cx) do {} while (0)
#endif
namespace pg8 {
#define PG8_LAS __attribute__((address_space(3)))
constexpr int BM = 256, BK = 64, HALF = 128, HTB = HALF * BK * 2  , STAGE_BYTES = 8 * HTB, NXCD = 8, WGM = 8;

__host__ __device__ __forceinline__ int lds_byte(int r, int c) { const int st = (r >> 4) * 2 + (c >> 5), rr = r & 15, cc = c & 31, ob = rr * 64 + cc * 2; return st * 1024 + (ob ^ (((ob >> 9) & 1) << 5)); }
__host__ __device__ __forceinline__ void stage_rc(int b, int& R, int& C) { const int st = b / 1024, sb = b % 1024, swz = sb ^ (((sb >> 9) & 1) << 5); R = (st >> 1) * 16 + swz / 64; C = (st & 1) * 32 + (swz % 64) / 2; }
__host__ __device__ __forceinline__ int perm32(int rho) { const int n = rho >> 4, i = rho & 15; return 8 * (i >> 2) + 4 * n + (i & 3); }

struct Unit { int pm, pn; };
struct Gemm { const bf16_t* A; const bf16_t* Bt; int M, N, K, lda; };

struct StaticOrder {
    int nM, nN, nwg, G, c;
    __host__ __device__ void init(int M, int N, int G_, int c_) { nM = M / BM; nN = N / BM; nwg = nM * nN; G = G_; c = c_; }
    __host__ __device__ bool next(int i, Unit& u) const {
        const long L = (long)i * G + c; if (L >= nwg) return false;
        int wgid = (int)L; { const int q = nwg / NXCD, r = nwg % NXCD, xcd = wgid % NXCD, off = wgid / NXCD; wgid = (xcd < r ? xcd * (q + 1) : r * (q + 1) + (xcd - r) * q) + off; }
        const int nig = WGM * nN, gid = wgid / nig, fm = gid * WGM, gsz = (nM - fm) < WGM ? (nM - fm) : WGM;
        u.pm = fm + ((wgid % nig) % gsz); u.pn = (wgid % nig) / gsz; return true;
    }
    __device__ __forceinline__ void a_ready(const Unit&) const {}
    __device__ __forceinline__ void done(const Unit&) const {}
};

template <class Epi, class Sched, bool ALIGN_EPI = false, bool SP2 = false>
__device__ __forceinline__ void gemm_phase(PG8_LAS unsigned char* lds, const Gemm g, const Sched& S, const Epi& E, const int tid) {
    const int wid = __builtin_amdgcn_readfirstlane(tid >> 6), lane = tid & 63, wr = wid >> 2, wc = wid & 3, fr = lane & 15, fq = lane >> 4;
    const int K = g.K, nt = K / BK;
    unsigned voffA[2], voffB[2];
#pragma unroll
    for (int i = 0; i < 2; ++i) { int R, C; stage_rc(tid * 16 + i * 8192, R, C); const int Rb = Epi::PERM ? ((R & ~31) + perm32(R & 31)) : R;
        voffA[i] = (unsigned)(R * g.lda + C) * 2u; voffB[i] = (unsigned)(Rb * K + C) * 2u; }
    const size_t kstep = (size_t)(BK * 2);
    const size_t hstepA = (size_t)HALF * g.lda * 2, hstepB = (size_t)HALF * K * 2;
    const size_t tstepA = 2 * hstepA, tstepB = 2 * hstepB;
    const unsigned ldsw = (unsigned)wid * 1024u;
    const int aoff = lds_byte(wr * 64 + fr, fq * 8), boff = lds_byte(wc * 32 + fr, fq * 8);
#define PG8_SA(b, h) (((b) * 2 + (h)) * HTB)
#define PG8_SB(b, h) ((4 + (b) * 2 + (h)) * HTB)
#define PG8_STAGE(bufoff, gbase, voff) do { _Pragma("unroll") for (int _i = 0; _i < 2; ++_i) \
        __builtin_amdgcn_global_load_lds((const unsigned*)((const char*)(gbase) + (voff)[_i]), (PG8_LAS unsigned*)(lds + (bufoff) + ldsw + _i * 8192), 16, 0, 0); } while (0)
#define PG8_LDA(dst, b, h) do { _Pragma("unroll") for (int m = 0; m < 4; ++m) _Pragma("unroll") for (int k = 0; k < 2; ++k) dst[m][k] = *(const PG8_LAS bf16x8*)(lds + PG8_SA(b, h) + aoff + m * 2048 + k * 1024); } while (0)
#define PG8_LDB(dst, b, h) do { _Pragma("unroll") for (int n = 0; n < 2; ++n) _Pragma("unroll") for (int k = 0; k < 2; ++k) dst[n][k] = *(const PG8_LAS bf16x8*)(lds + PG8_SB(b, h) + boff + n * 2048 + k * 1024); } while (0)
#define PG8_MMA(ai, bj, At, Bt) do { __builtin_amdgcn_s_setprio(1); _Pragma("unroll") for (int m = 0; m < 4; ++m) _Pragma("unroll") for (int n = 0; n < 2; ++n) _Pragma("unroll") for (int k = 0; k < 2; ++k) \
        acc[ai][bj][m][n] = __builtin_amdgcn_mfma_f32_16x16x32_bf16(Bt[n][k], At[m][k], acc[ai][bj][m][n], 0, 0, 0); __builtin_amdgcn_s_setprio(0); } while (0)
#define PG8_WAIT_V(n) asm volatile("s_waitcnt vmcnt(" #n ")" ::: "memory")
#define PG8_WAIT_L(n) asm volatile("s_waitcnt lgkmcnt(" #n ")" ::: "memory")
#define PG8_BAR __builtin_amdgcn_s_barrier()
#define PG8_SCHED __builtin_amdgcn_sched_barrier(0)
    Unit cur, nxt; int ui = 0;
    if (!S.next(0, cur)) return;
    f32x4 acc[2][2][4][2];
#pragma unroll
    for (int a = 0; a < 2; ++a)
#pragma unroll
        for (int b = 0; b < 2; ++b)
#pragma unroll
            for (int m = 0; m < 4; ++m)
#pragma unroll
                for (int n = 0; n < 2; ++n) acc[a][b][m][n] = (f32x4){0.f, 0.f, 0.f, 0.f};
    bf16x8 At[4][2], B0[2][2], B1[2][2];
    const char* cA = (const char*)g.A + (size_t)cur.pm * tstepA; const char* cB = (const char*)g.Bt + (size_t)cur.pn * tstepB;
    S.a_ready(cur);
    if constexpr (SP2) {
        PG8_STAGE(PG8_SB(0, 0), cB, voffB); PG8_STAGE(PG8_SB(0, 1), cB + hstepB, voffB); PG8_STAGE(PG8_SA(0, 0), cA, voffA); PG8_STAGE(PG8_SA(0, 1), cA + hstepA, voffA);
        if (wr == 1) PG8_BAR;
        PG8_WAIT_V(2); PG8_BAR;
        PG8_STAGE(PG8_SB(1, 0), cB + kstep, voffB); PG8_STAGE(PG8_SA(1, 0), cA + kstep, voffA); PG8_STAGE(PG8_SB(1, 1), cB + hstepB + kstep, voffB);
        PG8_WAIT_V(6); PG8_BAR;
    } else {
        PG8_STAGE(PG8_SB(0, 0), cB, voffB); PG8_STAGE(PG8_SA(0, 0), cA, voffA); PG8_STAGE(PG8_SB(0, 1), cB + hstepB, voffB); PG8_STAGE(PG8_SA(0, 1), cA + hstepA, voffA);
        if (wr == 1) PG8_BAR;
        PG8_WAIT_V(4); PG8_BAR;
        PG8_STAGE(PG8_SB(1, 0), cB + kstep, voffB); PG8_STAGE(PG8_SA(1, 0), cA + kstep, voffA); PG8_STAGE(PG8_SB(1, 1), cB + hstepB + kstep, voffB);
        PG8_WAIT_V(6); PG8_BAR;
    }
    for (;;) {
        const bool has_next = S.next(ui + 1, nxt);
        const char* nA = has_next ? (const char*)g.A + (size_t)nxt.pm * tstepA : cA; const char* nB = has_next ? (const char*)g.Bt + (size_t)nxt.pn * tstepB : cB;
        for (int t = 0; t < nt; t += 2) {
            if constexpr (Epi::KSCALE) { if (t == Epi::KS_T0 || t == Epi::KS_T1) E.kscale(acc, ui, t, wr, fr); }
            const bool last = (t == nt - 2);
            const char* a1 = cA + (size_t)(t + 1) * kstep;
            const char* a2 = last ? nA : cA + (size_t)(t + 2) * kstep; const char* b2 = last ? nB : cB + (size_t)(t + 2) * kstep;
            const char* a3 = a2 + kstep; const char* b3 = b2 + kstep;
            if (last && has_next) S.a_ready(nxt);
            if constexpr (SP2) {
            PG8_LDB(B0, 0, 0); PG8_LDB(B1, 0, 1); PG8_SCHED; PG8_LDA(At, 0, 0); PG8_STAGE(PG8_SA(1, 1), a1 + hstepA, voffA);
            PG8_WAIT_V(8); PG8_WAIT_L(0); PG8_BAR; PG8_MMA(0, 0, At, B0); PG8_MMA(0, 1, At, B1); PG8_BAR; PG8_SCHED;
            PG8_LDA(At, 0, 1); PG8_STAGE(PG8_SB(0, 0), b2, voffB); PG8_STAGE(PG8_SB(0, 1), b2 + hstepB, voffB); PG8_STAGE(PG8_SA(0, 0), a2, voffA);
            PG8_WAIT_V(8); PG8_WAIT_L(0); PG8_BAR; PG8_MMA(1, 0, At, B0); PG8_MMA(1, 1, At, B1); PG8_BAR; PG8_SCHED;
            PG8_LDB(B0, 1, 0); PG8_LDB(B1, 1, 1); PG8_SCHED; PG8_LDA(At, 1, 0); PG8_STAGE(PG8_SA(0, 1), a2 + hstepA, voffA);
            PG8_WAIT_V(8); PG8_WAIT_L(0); PG8_BAR; PG8_MMA(0, 0, At, B0); PG8_MMA(0, 1, At, B1); PG8_BAR; PG8_SCHED;
            PG8_LDA(At, 1, 1); PG8_STAGE(PG8_SB(1, 0), b3, voffB); PG8_STAGE(PG8_SB(1, 1), b3 + hstepB, voffB); PG8_STAGE(PG8_SA(1, 0), a3, voffA);
            PG8_WAIT_V(8); PG8_WAIT_L(0); PG8_BAR; PG8_MMA(1, 0, At, B0); PG8_MMA(1, 1, At, B1); PG8_BAR; PG8_SCHED;
            } else {
            PG8_LDB(B0, 0, 0); PG8_SCHED; PG8_LDA(At, 0, 0); PG8_STAGE(PG8_SA(1, 1), a1 + hstepA, voffA);
            PG8_WAIT_L(8); PG8_BAR; PG8_WAIT_L(0); PG8_MMA(0, 0, At, B0); PG8_BAR; PG8_SCHED;
            PG8_LDB(B1, 0, 1); PG8_STAGE(PG8_SB(0, 0), b2, voffB);
            PG8_BAR; PG8_WAIT_L(0); PG8_MMA(0, 1, At, B1); PG8_BAR;
            PG8_LDA(At, 0, 1); PG8_STAGE(PG8_SA(0, 0), a2, voffA);
            PG8_BAR; PG8_WAIT_L(0); PG8_MMA(1, 0, At, B0); PG8_BAR; PG8_SCHED;
            PG8_STAGE(PG8_SB(0, 1), b2 + hstepB, voffB);
            PG8_WAIT_V(6); PG8_BAR; PG8_MMA(1, 1, At, B1); PG8_BAR;
            PG8_LDB(B0, 1, 0); PG8_SCHED; PG8_LDA(At, 1, 0); PG8_STAGE(PG8_SA(0, 1), a2 + hstepA, voffA);
            PG8_WAIT_L(8); PG8_BAR; PG8_WAIT_L(0); PG8_MMA(0, 0, At, B0); PG8_BAR; PG8_SCHED;
            PG8_LDB(B1, 1, 1); PG8_STAGE(PG8_SB(1, 0), b3, voffB);
            PG8_BAR; PG8_WAIT_L(0); PG8_MMA(0, 1, At, B1); PG8_BAR;
            PG8_LDA(At, 1, 1); PG8_STAGE(PG8_SA(1, 0), a3, voffA);
            PG8_BAR; PG8_WAIT_L(0); PG8_MMA(1, 0, At, B0); PG8_BAR; PG8_SCHED;
            PG8_STAGE(PG8_SB(1, 1), b3 + hstepB, voffB);
            PG8_WAIT_V(6); PG8_BAR; PG8_MMA(1, 1, At, B1); PG8_BAR;
            }
        }
        if constexpr (ALIGN_EPI) { if (wr == 0) PG8_BAR; }
        if constexpr (!Epi::AFTER_DRAIN) { E(acc, cur, wr, wc, fr, fq); S.done(cur); }
        if (!has_next) break;
#pragma unroll
        for (int a = 0; a < 2; ++a)
#pragma unroll
            for (int b = 0; b < 2; ++b)
#pragma unroll
                for (int m = 0; m < 4; ++m)
#pragma unroll
                    for (int n = 0; n < 2; ++n) acc[a][b][m][n] = (f32x4){0.f, 0.f, 0.f, 0.f};
        cur = nxt; cA = nA; cB = nB; ++ui;
        if constexpr (ALIGN_EPI) { if (wr == 1) PG8_BAR; }
    }
    PG8_WAIT_V(0);
    if constexpr (!ALIGN_EPI) { if (wr == 0) PG8_BAR; }
    PG8_BAR;
    if constexpr (Epi::AFTER_DRAIN) { E.fused(acc, cur, wr, wc, fr, fq, lds, wid, lane); S.done(cur); }
#undef PG8_SA
#undef PG8_SB
#undef PG8_STAGE
#undef PG8_LDA
#undef PG8_LDB
#undef PG8_MMA
#undef PG8_WAIT_V
#undef PG8_WAIT_L
#undef PG8_BAR
#undef PG8_SCHED
}
}

typedef float f32x2_t __attribute__((ext_vector_type(2))); typedef __bf16 bf16x2_t __attribute__((ext_vector_type(2)));
DI unsigned cvt_pk_bf16(float lo, float hi) { const f32x2_t v = {lo, hi}; const bf16x2_t b = __builtin_convertvector(v, bf16x2_t); return __builtin_bit_cast(unsigned, b); }
DI u32x4 pack8(const f32x4 a, const f32x4 b) { u32x4 w; w.x = cvt_pk_bf16(a[0], a[1]); w.y = cvt_pk_bf16(a[2], a[3]); w.z = cvt_pk_bf16(b[0], b[1]); w.w = cvt_pk_bf16(b[2], b[3]); return w; }
struct EpiIn {
    static constexpr bool PERM = true, AFTER_DRAIN = false, KSCALE = false; static constexpr int KS_T0 = -1, KS_T1 = -1;
    Ctx C; int l;
    DI void operator()(const f32x4 (&acc)[2][2][4][2], const pg8::Unit& u, int wr, int wc, int fr, int fq) const {
        const int row0 = u.pm * 256 + wr * 64 + fr;
        float rs[2][4];
#pragma unroll
        for (int ai = 0; ai < 2; ++ai)
#pragma unroll
            for (int m = 0; m < 4; ++m) {
                const f32x4 p = *(const f32x4*)(C.rss() + (size_t)(row0 + ai * 128 + m * 16) * 16 + 4 * fq);
                float s = sum_fq((p[0] + p[1]) + (p[2] + p[3]));
                rs[ai][m] = rsqrtf(s * (1.f / DM) + EPS);
            }
        if (u.pn < 19) {
            bf16_t* base = C.proj() + (size_t)row0 * PJW + u.pn * 256 + wc * 32 + 8 * fq;
#pragma unroll
            for (int ai = 0; ai < 2; ++ai)
#pragma unroll
                for (int m = 0; m < 4; ++m) {
                    bf16_t* rowp = base + (size_t)(ai * 128 + m * 16) * PJW; const float sc = rs[ai][m];
#pragma unroll
                    for (int bj = 0; bj < 2; ++bj) *(u32x4*)(rowp + bj * 128) = pack8(acc[ai][bj][m][0] * sc, acc[ai][bj][m][1] * sc);
                }
        } else if (u.pn == 19) {
            if (wc < 2) {
                const float* kw = C.inp(19) + l * 64 + 8 * fq;
                const f32x4 k00 = *(const f32x4*)(kw), k01 = *(const f32x4*)(kw + 4), k10 = *(const f32x4*)(kw + 32), k11 = *(const f32x4*)(kw + 36);
#pragma unroll
                for (int ai = 0; ai < 2; ++ai)
#pragma unroll
                    for (int m = 0; m < 4; ++m) {
                        const int row = row0 + ai * 128 + m * 16; int sb, t; row_sbt(row, sb, t);
                        const float sc = rs[ai][m];
                        f32x4 a0 = acc[ai][0][m][0] * sc, a1 = acc[ai][0][m][1] * sc, b0 = acc[ai][1][m][0] * sc, b1 = acc[ai][1][m][1] * sc;
                        float ss = 0.f;
#pragma unroll
                        for (int i = 0; i < 4; ++i) ss += (a0[i] * a0[i] + a1[i] * a1[i]) + (b0[i] * b0[i] + b1[i] * b1[i]);
                        ss = sum_fq(ss);
                        const float rn = rsqrtf(ss * (1.f / 64.f) + EPS);
                        a0 = a0 * rn * k00; a1 = a1 * rn * k01; b0 = b0 * rn * k10; b1 = b1 * rn * k11;
                        float* o = out_ak(C, l, sb) + (size_t)t * 128 + wc * 64 + 8 * fq;
                        *(f32x4*)(o) = a0; *(f32x4*)(o + 4) = a1; *(f32x4*)(o + 32) = b0; *(f32x4*)(o + 36) = b1;
                        bf16_t* kv = C.kvb(l) + kvb_off(sb) + (size_t)(sb_P(sb) + t) * KVW + wc * 64 + 8 * fq;
                        *(u32x4*)(kv) = pack8(a0, a1); *(u32x4*)(kv + 32) = pack8(b0, b1);
                    }
            } else {
                const int kvh = wc - 2;
#pragma unroll
                for (int ai = 0; ai < 2; ++ai)
#pragma unroll
                    for (int m = 0; m < 4; ++m) {
                        const int row = row0 + ai * 128 + m * 16; int sb, t; row_sbt(row, sb, t);
                        const float sc = rs[ai][m];
                        const f32x4 a0 = acc[ai][0][m][0] * sc, a1 = acc[ai][0][m][1] * sc, b0 = acc[ai][1][m][0] * sc, b1 = acc[ai][1][m][1] * sc;
                        float* o = out_av(C, l, sb) + (size_t)t * 128 + kvh * 64 + 8 * fq;
                        *(f32x4*)(o) = a0; *(f32x4*)(o + 4) = a1; *(f32x4*)(o + 32) = b0; *(f32x4*)(o + 36) = b1;
                        bf16_t* kv = C.kvb(l) + kvb_off(sb) + (size_t)(sb_P(sb) + t) * KVW + 128 + kvh * 64 + 8 * fq;
                        *(u32x4*)(kv) = pack8(a0, a1); *(u32x4*)(kv + 32) = pack8(b0, b1);
                    }
            }
        } else {
#pragma unroll
            for (int ai = 0; ai < 2; ++ai)
#pragma unroll
                for (int m = 0; m < 4; ++m) {
                    const int row = row0 + ai * 128 + m * 16; int sb, t; row_sbt(row, sb, t);
                    const float sc = rs[ai][m];
                    const f32x4 a0 = acc[ai][0][m][0] * sc, a1 = acc[ai][0][m][1] * sc;
                    if (wc < 2) {
                        const int d = 32 * wc + 8 * fq;
                        float* o = out_ik(C, l, sb) + (size_t)t * 64 + d;
                        *(f32x4*)(o) = a0; *(f32x4*)(o + 4) = a1;
                        *(u32x4*)(C.kvb(l) + kvb_off(sb) + (size_t)(sb_P(sb) + t) * KVW + 256 + d) = pack8(a0, a1);
                    } else if (wc == 2) {
                        if (fq == 0) { *(f32x4*)(C.wi() + (size_t)row * 4) = a0; *(f32x4*)(C.dtr() + (size_t)row * 16) = a1; }
                        else if (fq == 1) { *(f32x4*)(C.dtr() + (size_t)row * 16 + 4) = a0; *(f32x4*)(C.dtr() + (size_t)row * 16 + 8) = a1; }
                        else if (fq == 2) { *(f32x4*)(C.dtr() + (size_t)row * 16 + 12) = a0; }
                    }
                }
        }
    }
};
constexpr int LDS_GNT = 131072;
struct EpiOut {
    static constexpr bool PERM = false, AFTER_DRAIN = false, KSCALE = true; static constexpr int KS_T0 = 16, KS_T1 = 24;
    Ctx C; int l, pm0, pn0;
    DI void kscale(f32x4 (&acc)[2][2][4][2], int ui, int t, int wr, int fr) const {
        const LAS f32x4* tab = (const LAS f32x4*)(C.lds + LDS_GNT) + (ui & 1) * 256;
#pragma unroll
        for (int ai = 0; ai < 2; ++ai)
#pragma unroll
            for (int m = 0; m < 4; ++m) {
                const f32x4 f4 = tab[ai * 128 + wr * 64 + m * 16 + fr]; const float f = (t == KS_T0) ? f4[0] : f4[1];
#pragma unroll
                for (int bj = 0; bj < 2; ++bj)
#pragma unroll
                    for (int n = 0; n < 2; ++n) acc[ai][bj][m][n] = acc[ai][bj][m][n] * f;
            }
    }
    DI void operator()(const f32x4 (&acc)[2][2][4][2], const pg8::Unit& u, int wr, int wc, int fr, int fq) const {
        const int row0 = u.pm * 256 + wr * 64 + fr, col0 = u.pn * 256 + wc * 32 + 4 * fq;
        const LAS f32x4* tab = (const LAS f32x4*)(C.lds + LDS_GNT) + ((u.pm == pm0 && u.pn == pn0) ? 0 : 256);
#pragma unroll
        for (int ai = 0; ai < 2; ++ai)
#pragma unroll
            for (int m = 0; m < 4; ++m) {
                const int row = row0 + ai * 128 + m * 16;
                const float r1 = tab[ai * 128 + wr * 64 + m * 16 + fr][2];
                const float* xres = (l == 0) ? ((row < ROWS_P) ? C.inp(0) + (size_t)row * DM : C.inp(1) + (size_t)(row - ROWS_P) * DM) : C.out + (size_t)row * DM;
                float ss = 0.f;
#pragma unroll
                for (int bj = 0; bj < 2; ++bj)
#pragma unroll
                    for (int n = 0; n < 2; ++n) {
                        const int col = col0 + bj * 128 + n * 16;
                        const f32x4 v = *(const f32x4*)(xres + col) + acc[ai][bj][m][n] * r1;
                        *(f32x4*)(C.out + (size_t)row * DM + col) = v;
                        if (l == 0) {
                            u32x2 w; w.x = cvt_pk_bf16(v[0], v[1]); w.y = cvt_pk_bf16(v[2], v[3]);
                            *(u32x2*)(C.hb() + (size_t)row * DM + col) = w;
                            ss += (v[0] * v[0] + v[1] * v[1]) + (v[2] * v[2] + v[3] * v[3]);
                        }
                    }
                if (l == 0) {
                    ss = sum_fq(ss);
                    if (fq == 0) C.rss()[(size_t)row * 16 + u.pn * 4 + wc] = ss;
                }
            }
    }
};
DI void phase_inproj_gemm(const Ctx& C, int l) {
    pg8::Gemm g{C.hb(), C.win(l), ROWS, NPAD, DM, DM};
    pg8::StaticOrder S; S.init(ROWS, NPAD, C.G, C.bid);
    EpiIn E{C, l};
    pg8::gemm_phase<EpiIn, pg8::StaticOrder, true, true>(C.lds, g, S, E, C.tid);
}
DI void outproj_tail_item(const Ctx& C, int l, int rt, int g);
DI void prep_layer(const Ctx& C, int l, int part, int nparts);
DI void prep_cache(const Ctx& C, int l, int part, int nparts);
DI void phase_outproj_gemm(const Ctx& C, int l) {
    for (int i = C.bid * NTHREADS + C.tid; i < NSB * 3 * 1536; i += C.G * NTHREADS) {
        const int sb = i / (3 * 1536), j = (i / 1536) % 3, ch = i % 1536;
        out_sc(C, l, sb)[j * 1536 + ch] = bf2f(C.proj()[(size_t)(sb_row0(sb) + sb_T(sb) - 3 + j) * PJW + C_XBC + ch]);
    }
    for (int i = C.bid * NTHREADS + C.tid; i < NSB * 3 * 512; i += C.G * NTHREADS) {
        const int sb = i / (3 * 512), j = (i / 512) % 3, ch = i % 512;
        out_lc(C, l, sb)[j * 512 + ch] = bf2f(C.proj()[(size_t)(sb_row0(sb) + sb_T(sb) - 3 + j) * PJW + C_XL + ch]);
    }
    if (C.bid < 256) outproj_tail_item(C, l, ROWS_P / 32 + (C.bid >> 4), C.bid & 15);
    if (l == 0) prep_cache(C, 1, C.bid, C.G);
    __syncthreads();
    pg8::Gemm g{C.proj(), C.wout(l), ROWS_P, DM, DMIX, PJW};
    pg8::StaticOrder S; S.init(ROWS_P, DM, C.G, C.bid);
    pg8::Unit u0{0, 0}, uu;
    (void)S.next(0, u0);
    { const int ui = C.tid >> 8, row = C.tid & 255;
      if (S.next(ui, uu)) {
          const float* p = C.ssq() + (size_t)(uu.pm * 256 + row) * 64; float s0 = 0.f, s1 = 0.f;
#pragma unroll
          for (int j = 0; j < 8; ++j) { const f32x4 a = *(const f32x4*)(p + 4 * j), b = *(const f32x4*)(p + 32 + 4 * j); s0 += (a[0] + a[1]) + (a[2] + a[3]); s1 += (b[0] + b[1]) + (b[2] + b[3]); }
          const float q0 = s0 * (1.f / 512.f) + EPS, q1 = s1 * (1.f / 512.f) + EPS, r0 = rsqrtf(q0), r1 = rsqrtf(q1);
          f32x4 f; f[0] = sqrtf(q0); f[1] = r0 * sqrtf(q1); f[2] = r1; f[3] = 0.f;
          ((LAS f32x4*)(C.lds + LDS_GNT))[ui * 256 + row] = f;
      } }
    __syncthreads();
    EpiOut E{C, l, u0.pm, u0.pn};
    pg8::gemm_phase<EpiOut, pg8::StaticOrder, true, true>(C.lds, g, S, E, C.tid);
}
template <int MODE>
DI void p0_transpose_item(const Ctx& C, const float* W, const float* scale, int K, int Nsrc, int Ndst, bf16_t* WT, LAS float* scr, int item) {
    const int lane = C.lane, nblk = Ndst / 64, kb = item / nblk, nb = item % nblk, k0 = 64 * kb, n0 = 64 * nb;
    const int cgp = lane & 15, kq = lane >> 4;
    const int ncol = n0 + 4 * cgp;
    const int src = (MODE == 0) ? orig_col(ncol) : ncol;
#pragma unroll 8
    for (int i = 0; i < 16; ++i) {
        const int kk = 4 * i + kq, k = k0 + kk;
        f32x4 v = (f32x4){0.f, 0.f, 0.f, 0.f};
        if (src >= 0) {
            v = *(const f32x4*)(W + (size_t)k * Nsrc + src);
            const float sc = (MODE == 0) ? scale[k] : (k >= 1024 ? scale[k - 1024] : 1.f);
            v = v * sc;
        }
        scr[(4 * cgp + 0) * 65 + kk] = v[0]; scr[(4 * cgp + 1) * 65 + kk] = v[1]; scr[(4 * cgp + 2) * 65 + kk] = v[2]; scr[(4 * cgp + 3) * 65 + kk] = v[3];
    }
    LDS_FENCE();
    const LAS float* sr = scr + lane * 65;
    bf16_t* orow = WT + (size_t)(n0 + lane) * K + k0;
#pragma unroll
    for (int j = 0; j < 8; ++j) {
        u32x4 o; o.x = cvt_pk_bf16(sr[8 * j], sr[8 * j + 1]); o.y = cvt_pk_bf16(sr[8 * j + 2], sr[8 * j + 3]); o.z = cvt_pk_bf16(sr[8 * j + 4], sr[8 * j + 5]); o.w = cvt_pk_bf16(sr[8 * j + 6], sr[8 * j + 7]);
        *(u32x4*)(orow + 8 * j) = o;
    }
    LDS_FENCE();
}
DI void prep_layer(const Ctx& C, int l, int part, int nparts) {
    LAS float* scr = (LAS float*)(C.lds + C.wave * 16640);
    const int gw = part * NWAVES + C.wave, NGW = nparts * NWAVES;
    constexpr int I_IN = (DM / 64) * (NPAD / 64), I_OUT = (DMIX / 64) * (DM / 64);
    for (int it = gw; it < I_IN + I_OUT; it += NGW) {
        if (it < I_IN) p0_transpose_item<0>(C, C.inp(10) + (size_t)l * DM * DINP, C.inp(9) + l * DM, DM, DINP, NPAD, C.win(l), scr, it);
        else p0_transpose_item<1>(C, C.inp(27) + (size_t)l * DMIX * DM, C.inp(26) + l * 1024, DMIX, DM, DM, C.wout(l), scr, it - I_IN);
    }
}
DI void prep_cache(const Ctx& C, int l, int part, int nparts) {
    const int gw = part * NWAVES + C.wave, NGW = nparts * NWAVES;
    for (int it = gw; it < NSB_S * PAST / 4; it += NGW) {
        const int b = it / (PAST / 4), pos0 = 4 * (it % (PAST / 4));
#pragma unroll
        for (int j = 0; j < 5; ++j) {
            const int pc = C.lane + 64 * j, pp = pc / 80, q = pc % 80, pos = pos0 + pp;
            const size_t base = ((size_t)(l * NSB_S + b) * PAST + pos);
            const f32x4 v = (q < 32) ? *(const f32x4*)(C.inp(2) + base * 128 + 4 * q) : (q < 64 ? *(const f32x4*)(C.inp(3) + base * 128 + 4 * (q - 32)) : *(const f32x4*)(C.inp(4) + base * 64 + 4 * (q - 64)));
            u32x2 o; o.x = cvt_pk_bf16(v[0], v[1]); o.y = cvt_pk_bf16(v[2], v[3]);
            *(u32x2*)(C.kvb(l) + kvb_off(NPB + b) + (size_t)pos * KVW + 4 * q) = o;
        }
    }
}
DI void phase_prologue(const Ctx& C) {
    prep_layer(C, 0, C.bid, C.G); prep_cache(C, 0, C.bid, C.G);
    const int gw = C.bid * NWAVES + C.wave, NGW = C.G * NWAVES;
    for (int m0 = 4 * gw; m0 < ROWS; m0 += 4 * NGW) {
        f32x4 v[4][4];
#pragma unroll
        for (int rr = 0; rr < 4; ++rr) { const int m = m0 + rr; const float* xr = (m < ROWS_P) ? C.inp(0) + (size_t)m * DM : C.inp(1) + (size_t)(m - ROWS_P) * DM;
#pragma unroll
            for (int j = 0; j < 4; ++j) v[rr][j] = *(const f32x4*)(xr + 4 * C.lane + 256 * j); }
#pragma unroll
        for (int rr = 0; rr < 4; ++rr) { const int m = m0 + rr; float ss = 0.f;
#pragma unroll
            for (int j = 0; j < 4; ++j) { const f32x4 x = v[rr][j]; ss += (x[0] * x[0] + x[1] * x[1]) + (x[2] * x[2] + x[3] * x[3]);
                u32x2 o; o.x = cvt_pk_bf16(x[0], x[1]); o.y = cvt_pk_bf16(x[2], x[3]); *(u32x2*)(C.hb() + (size_t)m * DM + 4 * C.lane + 256 * j) = o; }
            ss = wave_sum(ss);
            if (C.lane < 16) C.rss()[(size_t)m * 16 + C.lane] = (C.lane == 0) ? ss : 0.f; }
    }
}

#define MFMA32(a, b, c) __builtin_amdgcn_mfma_f32_32x32x16_bf16((a), (b), (c), 0, 0, 0)
DI void outproj_tail_item(const Ctx& C, int l, int rt, int g) {
    const int lane = C.lane, wave = C.wave, r = lane & 31, h = lane >> 5;
    const bf16_t* WO = C.wout(l); const bf16_t* PJ = C.proj();
    const int m0 = rt * 32, c0 = 64 * g, c1 = c0 + 32, kbeg = 256 * wave;
    f32x16 a0, a1;
#pragma unroll
    for (int i = 0; i < 16; ++i) { a0[i] = 0.f; a1[i] = 0.f; }
    const bf16_t* Ap = PJ + (size_t)(m0 + r) * PJW + 8 * h + kbeg;
    const bf16_t* B0 = WO + (size_t)(c0 + r) * DMIX + 8 * h + kbeg;
    const bf16_t* B1 = WO + (size_t)(c1 + r) * DMIX + 8 * h + kbeg;
#pragma unroll 8
    for (int k0 = 0; k0 < 256; k0 += 16) { const bf16x8 a = *(const bf16x8*)(Ap + k0); a0 = MFMA32(a, *(const bf16x8*)(B0 + k0), a0); a1 = MFMA32(a, *(const bf16x8*)(B1 + k0), a1); }
    LAS float* part = (LAS float*)C.lds;
#pragma unroll
    for (int i = 0; i < 16; ++i) { part[((wave * 2 + 0) * 16 + i) * 64 + lane] = a0[i]; part[((wave * 2 + 1) * 16 + i) * 64 + lane] = a1[i]; }
    __syncthreads();
    if (wave == 0) {
        float r0, r1; { const float* p = C.ssq() + (size_t)(m0 + r) * 64; float s0 = 0.f, s1 = 0.f;
#pragma unroll
            for (int j = 0; j < 32; ++j) { s0 += p[j]; s1 += p[32 + j]; }
            r0 = rsqrtf(s0 * (1.f / 512.f) + EPS); r1 = rsqrtf(s1 * (1.f / 512.f) + EPS); }
#pragma unroll
        for (int reg = 0; reg < 16; ++reg) {
            const int rowl = crow(reg, h), m = m0 + rowl;
            const float g0 = bperm(r0, rowl), g1 = bperm(r1, rowl);
            float sab[2], sc0[2], sc1[2];
#pragma unroll
            for (int t = 0; t < 2; ++t) {
                sab[t] = (part[((0 * 2 + t) * 16 + reg) * 64 + lane] + part[((1 * 2 + t) * 16 + reg) * 64 + lane]) + (part[((2 * 2 + t) * 16 + reg) * 64 + lane] + part[((3 * 2 + t) * 16 + reg) * 64 + lane]);
                sc0[t] = part[((4 * 2 + t) * 16 + reg) * 64 + lane] + part[((5 * 2 + t) * 16 + reg) * 64 + lane];
                sc1[t] = part[((6 * 2 + t) * 16 + reg) * 64 + lane] + part[((7 * 2 + t) * 16 + reg) * 64 + lane];
            }
            const float* xres = (l == 0) ? ((m < ROWS_P) ? C.inp(0) + (size_t)m * DM : C.inp(1) + (size_t)(m - ROWS_P) * DM) : C.out + (size_t)m * DM;
            const float v0 = xres[c0 + r] + sab[0] + g0 * sc0[0] + g1 * sc1[0];
            const float v1 = xres[c1 + r] + sab[1] + g0 * sc0[1] + g1 * sc1[1];
            C.out[(size_t)m * DM + c0 + r] = v0; C.out[(size_t)m * DM + c1 + r] = v1;
            if (l == 0) {
                C.hb()[(size_t)m * DM + c0 + r] = f2bf(v0); C.hb()[(size_t)m * DM + c1 + r] = f2bf(v1);
                const float ss = half_sum32(v0 * v0 + v1 * v1);
                if (r == 0) C.rss()[(size_t)m * 16 + g] = ss;
            }
        }
    }
    __syncthreads();
}

constexpr int SS_XST = 0;
constexpr int SS_BM = SS_XST + 64 * 144;
constexpr int SS_CM = SS_BM + 64 * 272;
constexpr int SS_BWT = SS_CM + 64 * 272;
constexpr int SS_HA = SS_BWT + 128 * 144;
constexpr int SS_SCAL = SS_HA + 2 * 64 * 272;
constexpr int SS_CW = SS_SCAL + 2 * 1024;
constexpr int SS_RAW = SS_CW + 5 * 320 * 4;
constexpr int SS_Z = SS_RAW + 67 * 640;
constexpr int SS_WT = SS_Z + 8192;
constexpr int SS_END = SS_WT + 3 * 2048;
static_assert(SS_END <= LDS_BYTES - 256, "SSD LDS map");
typedef short s16x4 __attribute__((ext_vector_type(4)));
DI float fast_silu(float x) { return x * __builtin_amdgcn_rcpf(1.f + __builtin_amdgcn_exp2f(-1.4426950408889634f * x)); }
DI bf16x8 lds_frag(const LAS unsigned char* base, int row, int rowbytes, int col) { return *(const LAS bf16x8*)(base + row * rowbytes + col * 2); }

DI void ssd_item(const Ctx& C, int l, int sb, int hd) {
    const int tid = C.tid, lane = C.lane, wave = C.wave, r = lane & 31, h = lane >> 5;
    const int T = sb_T(sb), row0 = sb_row0(sb), g = hd >> 3, NC = T / 64;
    LAS unsigned char* L = C.lds;
    bf16_t* PJ = C.proj();
    const float aneg = -expf(C.inp(24)[l * 16 + hd]), dtb = C.inp(23)[l * 16 + hd], Dh = C.inp(25)[l * 16 + hd];
    const int cg = 0, seg = 0; (void)cg; (void)seg;
    int colbase, cch;
    if (cg < 8) { cch = hd * 64 + 8 * cg; } else if (cg < 24) { cch = 1024 + g * 128 + 8 * (cg - 8); } else { cch = 1280 + g * 128 + 8 * (cg - 24); }
    colbase = C_XBC + cch;
    for (int i = tid; i < 5 * 320; i += NTHREADS) {
        const int j = i / 320, c = i % 320, cg2 = c >> 3, e = c & 7;
        const int ch = (cg2 < 8) ? hd * 64 + 8 * cg2 + e : (cg2 < 24 ? 1024 + g * 128 + 8 * (cg2 - 8) + e : 1280 + g * 128 + 8 * (cg2 - 24) + e);
        ((LAS float*)(L + SS_CW))[i] = (j < 4) ? C.inp(21)[((size_t)l * 4 + j) * 1536 + ch] : C.inp(22)[l * 1536 + ch];
    }
    const int sj = wave - 4, sph = sj & 1, nq0 = 2 * (sj >> 1);
    f32x16 hacc0, hacc1;
#pragma unroll
    for (int i = 0; i < 16; ++i) { hacc0[i] = 0.f; hacc1[i] = 0.f; }
    if (wave >= 4) {
        if (sb >= NPB) {
            const float* st = C.inp(8) + (((size_t)(l * NSB_S + sb - NPB) * 16 + hd) * 64 + 32 * sph + r) * 128;
#pragma unroll
            for (int gq = 0; gq < 4; ++gq) {
                const f32x4 v0 = *(const f32x4*)(st + 32 * nq0 + 8 * gq + 4 * h), v1 = *(const f32x4*)(st + 32 * (nq0 + 1) + 8 * gq + 4 * h);
#pragma unroll
                for (int e = 0; e < 4; ++e) { hacc0[4 * gq + e] = v0[e]; hacc1[4 * gq + e] = v1[e]; }
            }
        }
#pragma unroll
        for (int gq = 0; gq < 4; ++gq) {
            u32x2 w0, w1; w0.x = cvt_pk_bf16(hacc0[4 * gq], hacc0[4 * gq + 1]); w0.y = cvt_pk_bf16(hacc0[4 * gq + 2], hacc0[4 * gq + 3]);
            w1.x = cvt_pk_bf16(hacc1[4 * gq], hacc1[4 * gq + 1]); w1.y = cvt_pk_bf16(hacc1[4 * gq + 2], hacc1[4 * gq + 3]);
            *(LAS u32x2*)(L + SS_HA + (32 * sph + r) * 272 + (32 * nq0 + 8 * gq + 4 * h) * 2) = w0;
            *(LAS u32x2*)(L + SS_HA + (32 * sph + r) * 272 + (32 * (nq0 + 1) + 8 * gq + 4 * h) * 2) = w1;
        }
    }
    const int yph = wave & 1, ylh = (wave >> 1) & 1;
#define SSD_DMA_RAW(cc) do { const int t0_ = 64 * (cc); \
        for (int k_ = wave; k_ < 42; k_ += NWAVES) { \
            const int q_ = 64 * k_ + lane, rr_ = q_ / 40, pc_ = q_ - 40 * rr_, t_ = t0_ - 3 + rr_; \
            const int col_ = C_XBC + ((pc_ < 8) ? hd * 64 + 8 * pc_ : (pc_ < 24 ? 1024 + g * 128 + 8 * (pc_ - 8) : 1280 + g * 128 + 8 * (pc_ - 24))); \
            if (q_ < 2680 && t_ >= 0) __builtin_amdgcn_global_load_lds((const unsigned*)(PJ + (size_t)(row0 + t_) * PJW + col_), (LAS unsigned*)(L + SS_RAW + k_ * 1024), 16, 0, 0); } \
    } while (0)
#define SSD_DMA_Z(cc) do { const int t0_ = 64 * (cc); \
        if (wave < 4) { _Pragma("unroll") for (int k_ = 0; k_ < 2; ++k_) { const int rr_ = 16 * k_ + (lane >> 2), pc_ = lane & 3; \
            __builtin_amdgcn_global_load_lds((const unsigned*)(PJ + (size_t)(row0 + t0_ + 32 * ylh + rr_) * PJW + C_Z + hd * 64 + 32 * yph + 8 * pc_), \
                                             (LAS unsigned*)(L + SS_Z + (2 * yph + ylh) * 2048 + k_ * 1024), 16, 0, 0); } } \
    } while (0)
    if (tid < 120) {
        const int rr = tid / 40, pc = tid % 40;
        const int ch = (pc < 8) ? hd * 64 + 8 * pc : (pc < 24 ? 1024 + g * 128 + 8 * (pc - 8) : 1280 + g * 128 + 8 * (pc - 24));
        u32x4 v = (u32x4){0u, 0u, 0u, 0u};
        if (sb >= NPB) { const float* st = C.inp(7) + ((size_t)(l * NSB_S + sb - NPB) * 3 + rr) * 1536 + ch; v = pack8(*(const f32x4*)st, *(const f32x4*)(st + 4)); }
        *(LAS u32x4*)(L + SS_RAW + rr * 640 + pc * 16) = v;
    }
#define SSD_S0(cc) do { LAS float* SC_ = (LAS float*)(L + SS_SCAL + ((cc) & 1) * 1024); \
        const float dt_ = softplus_f(C.dtr()[(size_t)(row0 + 64 * (cc) + lane) * 16 + hd] + dtb); float x_ = dt_ * aneg; \
        _Pragma("unroll") for (int o_ = 1; o_ < 64; o_ <<= 1) { const float y_ = bperm(x_, lane - o_); if (lane >= o_) x_ += y_; } \
        const float c63_ = __int_as_float(__builtin_amdgcn_readlane(__float_as_int(x_), 63)); \
        SC_[lane] = x_; SC_[64 + lane] = dt_; SC_[128 + lane] = __builtin_amdgcn_exp2f(1.4426950408889634f * (c63_ - x_)) * dt_; SC_[192 + lane] = __builtin_amdgcn_exp2f(1.4426950408889634f * x_); } while (0)
    if (wave == 7) SSD_S0(0);
    SSD_DMA_RAW(0); SSD_DMA_Z(0);
    asm volatile("s_waitcnt vmcnt(0)" ::: "memory");
    __syncthreads();
    for (int c = 0; c < NC; ++c) {
        const int t0 = 64 * c, par = c & 1;
        LAS float* SC = (LAS float*)(L + SS_SCAL + par * 1024);
        PROBE_BEGIN(12);
        asm volatile("s_waitcnt vmcnt(0)" ::: "memory"); LDS_FENCE(); __syncthreads();
        if (l == 0) PROBE_END(12, C);
        PROBE_BEGIN(10);
        {
            const int njob = (wave < 4) ? 3 : 2;
#pragma unroll
            for (int jb = 0; jb < 3; ++jb) {
                if (jb < njob) {
                    const int pg = (wave < 4) ? (jb == 0 ? 0 : 2 + jb) : 1 + ((wave - 4) >> 1);
                    const int tb16 = (wave < 4) ? wave : 2 * ((wave - 4) & 1) + jb;
                    const int gp = 32 * pg + r, tk0 = 16 * tb16 + 8 * h;
                    const LAS float* CW = (const LAS float*)(L + SS_CW) + 2 * gp;
                    const float a0 = CW[0], a1 = CW[320], a2 = CW[640], a3 = CW[960], ab = CW[1280];
                    const float b0 = CW[1], b1 = CW[321], b2 = CW[641], b3 = CW[961], bb = CW[1281];
                    float xa[11], xb[11];
#pragma unroll
                    for (int i = 0; i < 11; ++i) { const unsigned w = *(const LAS unsigned*)(L + SS_RAW + (tk0 + i) * 640 + 4 * gp); xa[i] = __uint_as_float(w << 16); xb[i] = __uint_as_float(w & 0xffff0000u); }
                    float ta[8], tc[8];
#pragma unroll
                    for (int j = 0; j < 8; ++j) {
                        ta[j] = fast_silu(ab + a0 * xa[j] + a1 * xa[j + 1] + a2 * xa[j + 2] + a3 * xa[j + 3]);
                        tc[j] = fast_silu(bb + b0 * xb[j] + b1 * xb[j + 1] + b2 * xb[j + 2] + b3 * xb[j + 3]);
                    }
                    if (pg == 0) {
                        u32x4 wa, wb;
                        wa.x = cvt_pk_bf16(ta[0], ta[1]); wa.y = cvt_pk_bf16(ta[2], ta[3]); wa.z = cvt_pk_bf16(ta[4], ta[5]); wa.w = cvt_pk_bf16(ta[6], ta[7]);
                        wb.x = cvt_pk_bf16(tc[0], tc[1]); wb.y = cvt_pk_bf16(tc[2], tc[3]); wb.z = cvt_pk_bf16(tc[4], tc[5]); wb.w = cvt_pk_bf16(tc[6], tc[7]);
                        *(LAS u32x4*)(L + SS_XST + (2 * gp) * 144 + tk0 * 2) = wa; *(LAS u32x4*)(L + SS_XST + (2 * gp + 1) * 144 + tk0 * 2) = wb;
                    } else {
                        const bool isB = (pg < 3);
                        const int n0 = isB ? 2 * (gp - 32) : 2 * (gp - 96);
                        LAS unsigned char* img = L + (isB ? SS_BM : SS_CM);
#pragma unroll
                        for (int j = 0; j < 8; ++j) *(LAS unsigned*)(img + (tk0 + j) * 272 + n0 * 2) = cvt_pk_bf16(ta[j], tc[j]);
                        if (isB) {
                            float te[8];
#pragma unroll
                            for (int j = 0; j < 8; ++j) te[j] = SC[128 + tk0 + j];
                            u32x4 wa, wb;
                            wa.x = cvt_pk_bf16(ta[0] * te[0], ta[1] * te[1]); wa.y = cvt_pk_bf16(ta[2] * te[2], ta[3] * te[3]); wa.z = cvt_pk_bf16(ta[4] * te[4], ta[5] * te[5]); wa.w = cvt_pk_bf16(ta[6] * te[6], ta[7] * te[7]);
                            wb.x = cvt_pk_bf16(tc[0] * te[0], tc[1] * te[1]); wb.y = cvt_pk_bf16(tc[2] * te[2], tc[3] * te[3]); wb.z = cvt_pk_bf16(tc[4] * te[4], tc[5] * te[5]); wb.w = cvt_pk_bf16(tc[6] * te[6], tc[7] * te[7]);
                            *(LAS u32x4*)(L + SS_BWT + n0 * 144 + tk0 * 2) = wa; *(LAS u32x4*)(L + SS_BWT + (n0 + 1) * 144 + tk0 * 2) = wb;
                        }
                    }
                }
            }
        }
        if (l == 0) PROBE_END(10, C);
        PROBE_BEGIN(13);
        LDS_FENCE(); __syncthreads();
        if (l == 0) PROBE_END(13, C);
        PROBE_BEGIN(11);
        if (c + 1 < NC) SSD_DMA_RAW(c + 1);
        if (wave < 4) {
            const LAS unsigned char* HAc = L + SS_HA + par * (64 * 272);
            const float ecl = SC[192 + 32 * ylh + r];
            f32x16 ya;
#pragma unroll
            for (int i = 0; i < 16; ++i) ya[i] = 0.f;
#pragma unroll
            for (int ks = 0; ks < 8; ++ks) ya = MFMA32(lds_frag(HAc, 32 * yph + r, 272, 16 * ks + 8 * h), lds_frag(L + SS_CM, 32 * ylh + r, 272, 16 * ks + 8 * h), ya);
#pragma unroll
            for (int i = 0; i < 16; ++i) ya[i] *= ecl;
            LDS_FENCE(); __syncthreads();
#pragma unroll
            for (int sh = 0; sh < 2; ++sh) {
                if (sh <= ylh) {
#pragma unroll
                    for (int s2 = 0; s2 < 2; ++s2) {
                        const LAS unsigned char* xp = L + SS_XST + (32 * yph + r) * 144 + (32 * sh + 16 * s2 + 4 * h) * 2;
                        const u32x2 lo = *(const LAS u32x2*)(xp), hi = *(const LAS u32x2*)(xp + 16);
                        u32x4 a; a.x = lo.x; a.y = lo.y; a.z = hi.x; a.w = hi.y;
                        const bf16x8 wf = *(const LAS bf16x8*)(L + SS_WT + (sh + ylh) * 2048 + s2 * 1024 + lane * 16);
                        ya = MFMA32(__builtin_bit_cast(bf16x8, a), wf, ya);
                    }
                }
            }
            float ss = 0.f;
            bf16_t* zp = PJ + (size_t)(row0 + t0 + 32 * ylh + r) * PJW + C_Z + hd * 64 + 32 * yph + 4 * h;
#pragma unroll
            for (int gq = 0; gq < 4; ++gq) {
                const u32x2 zz = *(const LAS u32x2*)(L + SS_Z + (2 * yph + ylh) * 2048 + r * 64 + (8 * gq + 4 * h) * 2);
                const float z0 = __uint_as_float(zz.x << 16), z1 = __uint_as_float(zz.x & 0xffff0000u), z2 = __uint_as_float(zz.y << 16), z3 = __uint_as_float(zz.y & 0xffff0000u);
                const float y0 = ya[4 * gq] * fast_silu(z0), y1 = ya[4 * gq + 1] * fast_silu(z1), y2 = ya[4 * gq + 2] * fast_silu(z2), y3 = ya[4 * gq + 3] * fast_silu(z3);
                ss += (y0 * y0 + y1 * y1) + (y2 * y2 + y3 * y3);
                u32x2 w; w.x = cvt_pk_bf16(y0, y1); w.y = cvt_pk_bf16(y2, y3);
                *(u32x2*)(zp + 8 * gq) = w;
            }
            ss = xor32_sum(ss);
            if (h == 0) { float* q = C.ssq() + (size_t)(row0 + t0 + 32 * ylh + r) * 64 + hd * 4 + yph; q[0] = ss; q[2] = 0.f; }
            LDS_FENCE();
            if (c + 1 < NC) SSD_DMA_Z(c + 1);
        } else {
            if (wave == 7) { if (c + 1 < NC) SSD_S0(c + 1); }
            else {
                const int gt = wave - 4, gsh = gt >> 1, glh = (gt + 1) >> 1;
                const float cuml = SC[32 * glh + r];
                f32x16 ga;
#pragma unroll
                for (int i = 0; i < 16; ++i) ga[i] = 0.f;
#pragma unroll
                for (int ks = 0; ks < 8; ++ks) ga = MFMA32(lds_frag(L + SS_BM, 32 * gsh + r, 272, 16 * ks + 8 * h), lds_frag(L + SS_CM, 32 * glh + r, 272, 16 * ks + 8 * h), ga);
                float wv[16];
#pragma unroll
                for (int reg = 0; reg < 16; ++reg) {
                    const int s_ = 32 * gsh + crow(reg, h), ll = 32 * glh + r;
                    const float cs = SC[s_], ds = SC[64 + s_];
                    float w = (s_ <= ll) ? ga[reg] * __builtin_amdgcn_exp2f(1.4426950408889634f * (cuml - cs)) * ds : 0.f;
                    if (s_ == ll) w += Dh;
                    wv[reg] = w;
                }
#pragma unroll
                for (int s2 = 0; s2 < 2; ++s2) {
                    u32x4 p; p.x = cvt_pk_bf16(wv[8 * s2], wv[8 * s2 + 1]); p.y = cvt_pk_bf16(wv[8 * s2 + 2], wv[8 * s2 + 3]); p.z = cvt_pk_bf16(wv[8 * s2 + 4], wv[8 * s2 + 5]); p.w = cvt_pk_bf16(wv[8 * s2 + 6], wv[8 * s2 + 7]);
                    *(LAS u32x4*)(L + SS_WT + gt * 2048 + s2 * 1024 + lane * 16) = p;
                }
            }
            LDS_FENCE(); __syncthreads();
            const float decay = SC[192 + 63];
#pragma unroll
            for (int i = 0; i < 16; ++i) { hacc0[i] *= decay; hacc1[i] *= decay; }
#pragma unroll
            for (int ks = 0; ks < 4; ++ks) {
                const bf16x8 xb = lds_frag(L + SS_XST, 32 * sph + r, 144, 16 * ks + 8 * h);
                hacc0 = MFMA32(lds_frag(L + SS_BWT, 32 * nq0 + r, 144, 16 * ks + 8 * h), xb, hacc0);
                hacc1 = MFMA32(lds_frag(L + SS_BWT, 32 * (nq0 + 1) + r, 144, 16 * ks + 8 * h), xb, hacc1);
            }
            LAS unsigned char* HAn = L + SS_HA + (par ^ 1) * (64 * 272);
#pragma unroll
            for (int gq = 0; gq < 4; ++gq) {
                u32x2 w0, w1; w0.x = cvt_pk_bf16(hacc0[4 * gq], hacc0[4 * gq + 1]); w0.y = cvt_pk_bf16(hacc0[4 * gq + 2], hacc0[4 * gq + 3]);
                w1.x = cvt_pk_bf16(hacc1[4 * gq], hacc1[4 * gq + 1]); w1.y = cvt_pk_bf16(hacc1[4 * gq + 2], hacc1[4 * gq + 3]);
                *(LAS u32x2*)(HAn + (32 * sph + r) * 272 + (32 * nq0 + 8 * gq + 4 * h) * 2) = w0;
                *(LAS u32x2*)(HAn + (32 * sph + r) * 272 + (32 * (nq0 + 1) + 8 * gq + 4 * h) * 2) = w1;
            }
        }
        if (l == 0) PROBE_END(11, C);
    }
    if (wave >= 4) {
        float* o = out_sh(C, l, sb) + ((size_t)hd * 64 + 32 * sph + r) * 128;
#pragma unroll
        for (int gq = 0; gq < 4; ++gq) {
            f32x4 v0, v1;
#pragma unroll
            for (int e = 0; e < 4; ++e) { v0[e] = hacc0[4 * gq + e]; v1[e] = hacc1[4 * gq + e]; }
            *(f32x4*)(o + 32 * nq0 + 8 * gq + 4 * h) = v0; *(f32x4*)(o + 32 * (nq0 + 1) + 8 * gq + 4 * h) = v1;
        }
    }
    __syncthreads();
#undef SSD_DMA_RAW
#undef SSD_DMA_Z
#undef SSD_S0
}

DI unsigned mono_key(float f) { const unsigned u = __float_as_uint(f); return (u & 0x80000000u) ? ~u : (u | 0x80000000u); }
DI int t5_bucket(int rel) {
    const int n = rel < 0 ? -rel : rel; int b;
    if (n < 8) b = n; else if (n < 12) b = 8; else if (n < 16) b = 9; else if (n < 23) b = 10; else if (n < 32) b = 11; else if (n < 46) b = 12; else if (n < 64) b = 13; else if (n < 91) b = 14; else b = 15;
    return b + (rel > 0 ? 16 : 0);
}
constexpr int AT_MASK = 0;
constexpr int AT_TMASK = AT_MASK + 64 * 65 * 4;
constexpr int AT_QST = AT_TMASK + 64 * 65 * 4;
constexpr int AT_MISC = AT_QST + 1024;
constexpr int AT_LUT = AT_MISC + 64;
constexpr int AT_HIST = AT_LUT + 8192;
constexpr int AT_RING = AT_HIST;
constexpr int AT_QI = AT_HIST + 65792;
constexpr int AT_END = AT_QI + 64 * 528;
static_assert(AT_END <= LDS_BYTES - 256 && AT_RING + 65536 <= AT_END, "attention LDS map");
typedef short v4i16_t __attribute__((ext_vector_type(4)));
DI float max3f(float a, float b, float c) { float r; asm("v_max3_f32 %0, %1, %2, %3" : "=v"(r) : "v"(a), "v"(b), "v"(c)); return r; }
#define AT_WAIT_V(n) asm volatile("s_waitcnt vmcnt(" #n ")" ::: "memory")
#define AT_BAR() do { asm volatile("s_waitcnt lgkmcnt(0)" ::: "memory"); __builtin_amdgcn_s_barrier(); asm volatile("" ::: "memory"); } while (0)

template <int MODE, bool FIRST>
DI void idx_pass(const Ctx& C, const bf16_t* KV, const float (&w4)[4], int ntiles, int tq4, int qh, int r, int h) {
    LAS unsigned char* L = C.lds;
    const int q = 32 * qh + r, lane = 32 * h + r;
    const LAS unsigned* QS = (const LAS unsigned*)(L + AT_QST) + 4 * q;
    const unsigned pfx = QS[0], info = QS[1];
    const int lvl = info & 15; const bool done = (info >> 4) & 1, tie = (info >> 5) & 1;
    const int sh = (MODE == 0) ? (lvl == 0 ? 23 : (lvl == 1 ? 14 : (lvl == 2 ? 5 : 0))) : (int)(info >> 8);
    const unsigned bmask = (lvl == 3) ? 31u : 511u;
    const int psh = (lvl == 1) ? 23 : (lvl == 2 ? 14 : 5);
    unsigned* KS = C.keys();
    bf16x8 an[2][4];
    if (FIRST && tq4 < ntiles) {
#pragma unroll
        for (int kh = 0; kh < 2; ++kh)
#pragma unroll
            for (int ks = 0; ks < 4; ++ks) an[kh][ks] = *(const bf16x8*)(KV + (size_t)(64 * tq4 + 32 * kh + r) * KVW + 256 + 8 * h + 16 * ks);
    }
    for (int t = tq4; t < ntiles; t += 4) {
        bf16x8 ac[2][4];
        if (FIRST) {
#pragma unroll
            for (int kh = 0; kh < 2; ++kh)
#pragma unroll
                for (int ks = 0; ks < 4; ++ks) ac[kh][ks] = an[kh][ks];
            if (t + 4 < ntiles) {
#pragma unroll
                for (int kh = 0; kh < 2; ++kh)
#pragma unroll
                    for (int ks = 0; ks < 4; ++ks) an[kh][ks] = *(const bf16x8*)(KV + (size_t)(64 * (t + 4) + 32 * kh + r) * KVW + 256 + 8 * h + 16 * ks);
            }
        }
#pragma unroll
        for (int kh = 0; kh < 2; ++kh) {
            unsigned* kslot = KS + (size_t)((t * 2 + kh) * 2 + qh) * 1024 + lane;
            unsigned key[16];
            if (FIRST) {
                float sc[16];
#pragma unroll
                for (int i = 0; i < 16; ++i) sc[i] = 0.f;
#pragma unroll
                for (int hh = 0; hh < 4; ++hh) {
                    f32x16 acc;
#pragma unroll
                    for (int i = 0; i < 16; ++i) acc[i] = 0.f;
#pragma unroll
                    for (int ks = 0; ks < 4; ++ks) acc = MFMA32(ac[kh][ks], *(const LAS bf16x8*)(L + AT_QI + q * 528 + (64 * hh + 16 * ks + 8 * h) * 2), acc);
#pragma unroll
                    for (int i = 0; i < 16; ++i) sc[i] += w4[hh] * fmaxf(acc[i], 0.f);
                }
#pragma unroll
                for (int i = 0; i < 16; ++i) { key[i] = mono_key(sc[i]); kslot[64 * i] = key[i]; }
            } else {
#pragma unroll
                for (int i = 0; i < 16; ++i) key[i] = __hip_atomic_load(kslot + 64 * i, __ATOMIC_RELAXED, __HIP_MEMORY_SCOPE_AGENT);
            }
            if (MODE == 0) {
                if (!done) {
                    LAS unsigned* HR = (LAS unsigned*)(L + AT_HIST) + 257 * q;
#pragma unroll
                    for (int i = 0; i < 16; ++i) {
                        const bool part = (lvl == 0) || ((key[i] >> psh) == pfx);
                        if (part) { const unsigned bin = (key[i] >> sh) & bmask; atomicAdd((unsigned*)(HR + (bin >> 1)), 1u << ((bin & 1u) << 4)); }
                    }
                }
            } else {
                unsigned mw = 0u, tw = 0u;
#pragma unroll
                for (int i = 15; i >= 0; --i) {
                    const bool sel = tie ? (key[i] > pfx) : ((key[i] >> sh) >= pfx);
                    const bool tb = tie && (key[i] == pfx);
                    mw = (mw << 1) | (sel ? 1u : 0u); tw = (tw << 1) | (tb ? 1u : 0u);
                    if ((i & 3) == 0 && i > 0) { mw <<= 4; tw <<= 4; }
                }
                mw <<= 4 * h; tw <<= 4 * h;
                if (mw) atomicOr((unsigned*)((LAS unsigned*)(L + AT_MASK) + 65 * q + 2 * t + kh), mw);
                if (tw) atomicOr((unsigned*)((LAS unsigned*)(L + AT_TMASK) + 65 * q + 2 * t + kh), tw);
            }
        }
    }
    if (FIRST) asm volatile("s_waitcnt vmcnt(0)" ::: "memory");
}

DI void attn_item(const Ctx& C, int l, int sb, int qb) {
    const int tid = C.tid, lane = C.lane, wave = C.wave, r = lane & 31, h = lane >> 5;
    LAS unsigned char* L = C.lds;
    const int P = sb_P(sb), row0 = sb_row0(sb), t0 = 64 * qb, pos0 = P + t0;
    const int ntiles = (pos0 >> 6) + 1, Ladm = 64 * ntiles;
    bf16_t* PJ = C.proj(); const bf16_t* KV = C.kvb(l) + kvb_off(sb);
    LAS unsigned* MASK = (LAS unsigned*)(L + AT_MASK); LAS unsigned* TMASK = (LAS unsigned*)(L + AT_TMASK);
    LAS unsigned* QST = (LAS unsigned*)(L + AT_QST); LAS unsigned* MISC = (LAS unsigned*)(L + AT_MISC);
#ifdef PROBE_QB
    const bool pcond = (l == 0 && sb == 0 && qb == PROBE_QB);
#else
    const bool pcond = false;
#endif
    PROBE_BEGIN(40); PROBE_BEGIN(41);
    for (int i = tid; i < 64 * 65; i += NTHREADS) { const int w = i % 65; MASK[i] = (Ladm <= 256 && w < 2 * ntiles) ? 0xffffffffu : 0u; TMASK[i] = 0u; }
    for (int i = tid; i < 64 * 257; i += NTHREADS) ((LAS unsigned*)(L + AT_HIST))[i] = 0u;
    if (tid < 64) { unsigned k256 = 256u; asm volatile("" : "+v"(k256)); QST[4 * tid] = 0u; QST[4 * tid + 1] = 0u; QST[4 * tid + 2] = k256; QST[4 * tid + 3] = 0u; }
    for (int i = tid; i < 8 * 256; i += NTHREADS) { const int hq = i >> 8, rel = (i & 255) - 191; ((LAS float*)(L + AT_LUT))[i] = 1.4426950408889634f * (C.inp(20)[t5_bucket(rel) * 8 + hq] - C.inp(20)[15 * 8 + hq]); }
    if (tid == 0) MISC[0] = 0u;
    __syncthreads();
    if (pcond) PROBE_END(41, C);
    PROBE_BEGIN(4); PROBE_BEGIN(42);
    if (Ladm > 256) {
        const int qh = wave & 1, tq4 = wave >> 1, q = 32 * qh + r;
        float w4[4];
        { const f32x4 wv = *(const f32x4*)(C.wi() + (size_t)(row0 + t0 + q) * 4); w4[0] = wv[0]; w4[1] = wv[1]; w4[2] = wv[2]; w4[3] = wv[3]; }
        for (int i = tid; i < 2048; i += NTHREADS) { const int qq = i >> 5, pc = i & 31;
            *(LAS u32x4*)(L + AT_QI + qq * 528 + pc * 16) = *(const u32x4*)(PJ + (size_t)(row0 + t0 + qq) * PJW + C_QI + 8 * pc); }
        __syncthreads();
        for (int lvl = 0; lvl < 4; ++lvl) {
            PROBE_BEGIN(20);
            if (lvl == 0) idx_pass<0, true>(C, KV, w4, ntiles, tq4, qh, r, h); else idx_pass<0, false>(C, KV, w4, ntiles, tq4, qh, r, h);
            if (tid == 0) MISC[0] = 0u;
            __syncthreads();
            if (l == 0) PROBE_END(20, C);
            PROBE_BEGIN(21);
            int ln = lane; asm volatile("" : "+v"(ln));
            for (int qq = 8 * wave; qq < 8 * wave + 8; ++qq) {
                const unsigned pfx = QST[4 * qq], info = QST[4 * qq + 1], need = QST[4 * qq + 2];
                if ((info >> 4) & 1) continue;
                LAS unsigned* HR = (LAS unsigned*)(L + AT_HIST) + 257 * qq + 4 * ln;
                unsigned c[8];
#pragma unroll
                for (int j = 0; j < 4; ++j) { const unsigned wv = HR[j]; c[2 * j] = wv & 0xffffu; c[2 * j + 1] = wv >> 16; HR[j] = 0u; }
                unsigned ct = 0u;
#pragma unroll
                for (int j = 0; j < 8; ++j) ct += c[j];
                unsigned S = ct;
#pragma unroll
                for (int o = 1; o < 64; o <<= 1) { const unsigned y = (unsigned)__builtin_amdgcn_ds_bpermute((ln + o) << 2, (int)S); if (ln + o < 64) S += y; }
                if (S >= need && (S - ct) < need) {
                    unsigned rem = need - (S - ct), cum = 0u; int b = 0; unsigned cb = 0u;
                    bool found = false;
#pragma unroll
                    for (int j = 7; j >= 0; --j) { if (!found) { if (cum + c[j] >= rem) { b = j; cb = c[j]; found = true; } else cum += c[j]; } }
                    const unsigned need2 = rem - cum, binidx = 8u * ln + (unsigned)b;
                    const int bits = (lvl == 3) ? 5 : 9, shc = (lvl == 0) ? 23 : (lvl == 1 ? 14 : (lvl == 2 ? 5 : 0));
                    const unsigned npfx = (lvl == 0) ? binidx : ((pfx << bits) | binidx);
                    unsigned ninfo, nneed = need2, opfx = npfx;
                    if (need2 == cb) ninfo = (unsigned)lvl | 16u | ((unsigned)shc << 8);
                    else if (lvl == 0 && (binidx == 256u || binidx == 255u)) { ninfo = 16u | 32u; opfx = (binidx == 256u) ? 0x80000000u : 0x7fffffffu; }
                    else if (lvl == 3) ninfo = 16u | 32u;
                    else { ninfo = (unsigned)(lvl + 1); atomicAdd((unsigned*)MISC, 1u); }
                    QST[4 * qq] = opfx; QST[4 * qq + 1] = ninfo; QST[4 * qq + 2] = nneed;
                }
            }
            __syncthreads();
            if (l == 0) PROBE_END(21, C);
            if (MISC[0] == 0u) break;
            __syncthreads();
        }
        PROBE_BEGIN(22);
        idx_pass<1, false>(C, KV, w4, ntiles, tq4, qh, r, h);
        __syncthreads();
        if (l == 0) PROBE_END(22, C);
        PROBE_BEGIN(23);
        int ln2 = lane; asm volatile("" : "+v"(ln2));
        for (int qq = 8 * wave; qq < 8 * wave + 8; ++qq) {
            if (!((QST[4 * qq + 1] >> 5) & 1)) continue;
            const unsigned mwd = (ln2 < 2 * ntiles) ? MASK[65 * qq + ln2] : 0u, twd = (ln2 < 2 * ntiles) ? TMASK[65 * qq + ln2] : 0u;
            int have = __popc(mwd);
#pragma unroll
            for (int o = 1; o < 64; o <<= 1) have += __builtin_amdgcn_ds_bpermute((ln2 ^ o) << 2, have);
            const int want = 256 - have, pc = __popc(twd);
            int incl = pc;
#pragma unroll
            for (int o = 1; o < 64; o <<= 1) { const int y = __builtin_amdgcn_ds_bpermute((ln2 - o) << 2, incl); if (ln2 >= o) incl += y; }
            int take = want - (incl - pc); take = take < 0 ? 0 : (take > pc ? pc : take);
            unsigned wrem = twd, add = 0u;
            for (int k = 0; k < take; ++k) { add |= wrem & (0u - wrem); wrem &= wrem - 1u; }
            if (add) MASK[65 * qq + ln2] = mwd | add;
        }
        __syncthreads();
        if (l == 0) PROBE_END(23, C);
    }
    if (l == 0) PROBE_END(4, C);
    if (pcond) PROBE_END(42, C);
    PROBE_BEGIN(43);
    PROBE_BEGIN(5);
    const int hq = wave, kvh = wave >> 2;
    const unsigned ring = (unsigned)(size_t)(L + AT_RING);
    const float* LUT = nullptr; (void)LUT;
    const LAS float* lut = (const LAS float*)(L + AT_LUT) + 256 * hq;
    const float cfar = 1.4426950408889634f * C.inp(20)[15 * 8 + hq];
#define AT_DMA(tt, slot) do { const bf16_t* src_ = KV + (size_t)(64 * (tt)) * KVW; \
        _Pragma("unroll") for (int i_ = 0; i_ < 2; ++i_) { const int k_ = wave * 2 + i_, row_ = 4 * k_ + (lane >> 4), pc_ = lane & 15; \
            __builtin_amdgcn_global_load_lds((const unsigned*)(src_ + (size_t)row_ * KVW + 8 * (pc_ ^ (row_ & 15))), (LAS unsigned*)(L + AT_RING + (slot) * 32768 + k_ * 1024), 16, 0, 0); \
            __builtin_amdgcn_global_load_lds((const unsigned*)(src_ + (size_t)row_ * KVW + 128 + 8 * pc_), (LAS unsigned*)(L + AT_RING + (slot) * 32768 + 16384 + k_ * 1024), 16, 0, 0); } \
    } while (0)
    bf16x8 qfA[4], qfB[4];
#pragma unroll
    for (int qh = 0; qh < 2; ++qh) {
        const bf16_t* qp = PJ + (size_t)(row0 + t0 + 32 * qh + r) * PJW + C_Q + hq * 64 + 8 * h; float qv[4][8]; float ss = 0.f;
#pragma unroll
        for (int ks = 0; ks < 4; ++ks) { const u32x4 v = *(const u32x4*)(qp + 16 * ks);
            qv[ks][0] = __uint_as_float(v.x << 16); qv[ks][1] = __uint_as_float(v.x & 0xffff0000u); qv[ks][2] = __uint_as_float(v.y << 16); qv[ks][3] = __uint_as_float(v.y & 0xffff0000u);
            qv[ks][4] = __uint_as_float(v.z << 16); qv[ks][5] = __uint_as_float(v.z & 0xffff0000u); qv[ks][6] = __uint_as_float(v.w << 16); qv[ks][7] = __uint_as_float(v.w & 0xffff0000u);
#pragma unroll
            for (int j = 0; j < 8; ++j) ss += qv[ks][j] * qv[ks][j]; }
        ss = xor32_sum(ss);
        const float sc = rsqrtf(ss * (1.f / 64.f) + EPS) * (0.125f * 1.4426950408889634f);
        const float* qn = C.inp(18) + l * 64 + 8 * h;
#pragma unroll
        for (int ks = 0; ks < 4; ++ks) { const f32x4 n0 = *(const f32x4*)(qn + 16 * ks), n1 = *(const f32x4*)(qn + 16 * ks + 4);
            u32x4 p; p.x = cvt_pk_bf16(qv[ks][0] * sc * n0[0], qv[ks][1] * sc * n0[1]); p.y = cvt_pk_bf16(qv[ks][2] * sc * n0[2], qv[ks][3] * sc * n0[3]);
            p.z = cvt_pk_bf16(qv[ks][4] * sc * n1[0], qv[ks][5] * sc * n1[1]); p.w = cvt_pk_bf16(qv[ks][6] * sc * n1[2], qv[ks][7] * sc * n1[3]);
            if (qh == 0) qfA[ks] = __builtin_bit_cast(bf16x8, p); else qfB[ks] = __builtin_bit_cast(bf16x8, p); }
    }
    f32x16 oA0, oA1, oB0, oB1;
#pragma unroll
    for (int i = 0; i < 16; ++i) { oA0[i] = 0.f; oA1[i] = 0.f; oB0[i] = 0.f; oB1[i] = 0.f; }
    float mrefA = 0.f, lrunA = 0.f, mrefB = 0.f, lrunB = 0.f;
#define AT_HALF(QF, QQ, MREF, LRUN, O0, O1, PW) do { \
        f32x16 s0, s1; { const float ini = cfar - MREF; _Pragma("unroll") for (int i = 0; i < 16; ++i) { s0[i] = ini; s1[i] = ini; } } \
        _Pragma("unroll") for (int ks = 0; ks < 4; ++ks) { s0 = MFMA32(kf0[ks], QF[ks], s0); s1 = MFMA32(kf1[ks], QF[ks], s1); } \
        const int nm0 = (int)(~(MASK[65 * (QQ) + 2 * t] >> (4 * h))), nm1 = (int)(~(MASK[65 * (QQ) + 2 * t + 1] >> (4 * h))); \
        if (nearb) { _Pragma("unroll") for (int i = 0; i < 16; ++i) { const int kl = (i & 3) + 8 * (i >> 2), rel = 64 * t + kl + 4 * h - (pos0 + (QQ)); s0[i] += lut[rel + 191]; s1[i] += lut[rel + 32 + 191]; } } \
        _Pragma("unroll") for (int i = 0; i < 16; ++i) { const int kl = (i & 3) + 8 * (i >> 2); \
            s0[i] += __int_as_float(__builtin_amdgcn_sbfe(nm0, kl, 1) & (int)0xff800000u); s1[i] += __int_as_float(__builtin_amdgcn_sbfe(nm1, kl, 1) & (int)0xff800000u); } \
        float tm; { float a = max3f(s0[0], s0[1], s1[0]), b = max3f(s0[2], s0[3], s1[1]); a = max3f(a, s1[2], s1[3]); \
            _Pragma("unroll") for (int i = 4; i < 16; i += 4) { a = max3f(a, s0[i], s0[i + 1]); b = max3f(b, s0[i + 2], s0[i + 3]); a = max3f(a, s1[i], s1[i + 1]); b = max3f(b, s1[i + 2], s1[i + 3]); } \
            tm = xor32_max(fmaxf(a, b)); } \
        if (__builtin_amdgcn_ballot_w64(tm > 0.f) != 0ull) { const float dl = fmaxf(tm, 0.f), al = __builtin_amdgcn_exp2f(-dl); MREF += dl; LRUN *= al; \
            _Pragma("unroll") for (int i = 0; i < 16; ++i) { s0[i] -= dl; s1[i] -= dl; O0[i] *= al; O1[i] *= al; } } \
        float psum = 0.f; \
        _Pragma("unroll") for (int i = 0; i < 16; ++i) { s0[i] = __builtin_amdgcn_exp2f(s0[i]); s1[i] = __builtin_amdgcn_exp2f(s1[i]); psum += s0[i] + s1[i]; } \
        LRUN += psum; \
        _Pragma("unroll") for (int kk = 0; kk < 2; ++kk) { u32x4 w0, w1; \
            w0.x = cvt_pk_bf16(s0[8 * kk], s0[8 * kk + 1]); w0.y = cvt_pk_bf16(s0[8 * kk + 2], s0[8 * kk + 3]); w0.z = cvt_pk_bf16(s0[8 * kk + 4], s0[8 * kk + 5]); w0.w = cvt_pk_bf16(s0[8 * kk + 6], s0[8 * kk + 7]); \
            w1.x = cvt_pk_bf16(s1[8 * kk], s1[8 * kk + 1]); w1.y = cvt_pk_bf16(s1[8 * kk + 2], s1[8 * kk + 3]); w1.z = cvt_pk_bf16(s1[8 * kk + 4], s1[8 * kk + 5]); w1.w = cvt_pk_bf16(s1[8 * kk + 6], s1[8 * kk + 7]); \
            PW[kk] = __builtin_bit_cast(bf16x8, w0); PW[2 + kk] = __builtin_bit_cast(bf16x8, w1); } \
    } while (0)
    AT_WAIT_V(0);
    AT_DMA(0, 0);
    if (ntiles > 1) AT_DMA(1, 1);
    int sl = 0, sl2 = 2;
    for (int t = 0; t < ntiles; ++t) {
        if (t + 1 < ntiles) { AT_WAIT_V(4); } else { AT_WAIT_V(0); }
        AT_BAR();
        if (t + 2 < ntiles) AT_DMA(t + 2, sl2);
        const LAS unsigned char* Kt = L + AT_RING + sl * 32768; const LAS unsigned char* Vt = Kt + 16384;
        bf16x8 kf0[4], kf1[4];
#pragma unroll
        for (int ks = 0; ks < 4; ++ks) { const int pc = kvh * 8 + 2 * ks + h;
            kf0[ks] = *(const LAS bf16x8*)(Kt + r * 256 + ((pc ^ (r & 15)) << 4)); kf1[ks] = *(const LAS bf16x8*)(Kt + (32 + r) * 256 + ((pc ^ (r & 15)) << 4)); }
        const bool nearb = (t + 3 > ntiles - 1);
        bf16x8 pA[4], pB[4];
        AT_HALF(qfA, r, mrefA, lrunA, oA0, oA1, pA);
        AT_HALF(qfB, 32 + r, mrefB, lrunB, oB0, oB1, pB);
#pragma unroll
        for (int kk = 0; kk < 4; ++kk) {
            const int i16 = lane & 15, key0 = 16 * kk + 4 * h + (i16 >> 2);
#pragma unroll
            for (int dh = 0; dh < 2; ++dh) {
                const int dcol = kvh * 64 + 32 * dh + 16 * ((lane >> 4) & 1) + 4 * (i16 & 3);
                const v4i16_t lo = __builtin_amdgcn_ds_read_tr16_b64_v4i16((LAS v4i16_t*)(Vt + key0 * 256 + dcol * 2));
                const v4i16_t hi = __builtin_amdgcn_ds_read_tr16_b64_v4i16((LAS v4i16_t*)(Vt + (key0 + 8) * 256 + dcol * 2));
                const bf16x8 va = (bf16x8){lo[0], lo[1], lo[2], lo[3], hi[0], hi[1], hi[2], hi[3]};
                if (dh == 0) { oA0 = MFMA32(va, pA[kk], oA0); oB0 = MFMA32(va, pB[kk], oB0); } else { oA1 = MFMA32(va, pA[kk], oA1); oB1 = MFMA32(va, pB[kk], oB1); }
            }
        }
        sl2 = sl; sl = (sl == 2) ? 0 : sl + 1; sl2 = (sl == 0) ? 2 : sl - 1;
    }
#undef AT_HALF
#pragma unroll
    for (int qh = 0; qh < 2; ++qh) {
        const float inv = 1.f / xor32_sum(qh == 0 ? lrunA : lrunB);
        bf16_t* gp = PJ + (size_t)(row0 + t0 + 32 * qh + r) * PJW + C_GA + hq * 64 + 4 * h;
#pragma unroll
        for (int dh = 0; dh < 2; ++dh)
#pragma unroll
            for (int gq = 0; gq < 4; ++gq) {
                const u32x2 gg = *(const u32x2*)(gp + 32 * dh + 8 * gq);
                const float g0 = __uint_as_float(gg.x << 16), g1 = __uint_as_float(gg.x & 0xffff0000u), g2 = __uint_as_float(gg.y << 16), g3 = __uint_as_float(gg.y & 0xffff0000u);
                const f32x16& oo = (qh == 0) ? (dh == 0 ? oA0 : oA1) : (dh == 0 ? oB0 : oB1);
                const float a0 = oo[4 * gq] * inv, a1 = oo[4 * gq + 1] * inv, a2 = oo[4 * gq + 2] * inv, a3 = oo[4 * gq + 3] * inv;
                u32x2 w; w.x = cvt_pk_bf16(a0 * fast_silu(g0), a1 * fast_silu(g1)); w.y = cvt_pk_bf16(a2 * fast_silu(g2), a3 * fast_silu(g3));
                *(u32x2*)(gp + 32 * dh + 8 * gq) = w;
            }
    }
#undef AT_DMA
    AT_WAIT_V(0);
    __syncthreads();
    if (l == 0) PROBE_END(5, C);
    if (pcond) { PROBE_END(43, C); PROBE_END(40, C); }
}

constexpr int LR_RAW = 0;
constexpr int LR_GL = LR_RAW + 67 * 128;
constexpr int LR_XC = LR_GL + 2 * 8192;
constexpr int LR_XCF = LR_XC + 64 * 144;
constexpr int LR_SEG = LR_XCF + 64 * 256;
constexpr int LR_YS = LR_SEG + 2048;
constexpr int LR_END = LR_YS + 8192;
static_assert(LR_END <= LDS_BYTES - 256, "LRU LDS map");
typedef float f32x4v __attribute__((ext_vector_type(4)));
#define MFMA16(a, b, c) __builtin_amdgcn_mfma_f32_16x16x32_bf16((a), (b), (c), 0, 0, 0)
DI float fast_sigmoid(float x) { return __builtin_amdgcn_rcpf(1.f + __builtin_amdgcn_exp2f(-1.4426950408889634f * x)); }

DI void lru_item(const Ctx& C, int l, int sb, int blk) {
    const int tid = C.tid, lane = C.lane, wave = C.wave, fr = lane & 15, fq = lane >> 4;
    const int T = sb_T(sb), row0 = sb_row0(sb), NC = T / 64;
    LAS unsigned char* L = C.lds;
    bf16_t* PJ = C.proj();
    const int ts = wave >> 1, dh = wave & 1;
    bf16x8 wf[2][2][2];
#pragma unroll
    for (int gt = 0; gt < 2; ++gt)
#pragma unroll
        for (int db = 0; db < 2; ++db)
#pragma unroll
            for (int kb = 0; kb < 2; ++kb) {
                const float* wp = (gt == 0 ? C.inp(13) : C.inp(15)) + ((size_t)(l * 8 + blk) * 64 + 32 * kb + 8 * fq) * 64 + 32 * dh + 16 * db + fr;
                u32x4 p; p.x = cvt_pk_bf16(wp[0], wp[64]); p.y = cvt_pk_bf16(wp[128], wp[192]); p.z = cvt_pk_bf16(wp[256], wp[320]); p.w = cvt_pk_bf16(wp[384], wp[448]);
                wf[gt][db][kb] = __builtin_bit_cast(bf16x8, p);
            }
    float ba[2], bx[2], spl[2], hc[2];
#pragma unroll
    for (int db = 0; db < 2; ++db) {
        const int ch = blk * 64 + 32 * dh + 16 * db + fr;
        ba[db] = C.inp(14)[l * 512 + ch]; bx[db] = C.inp(16)[l * 512 + ch]; spl[db] = 8.f * 1.4426950408889634f * softplus_f(-C.inp(17)[l * 512 + ch]);
        hc[db] = (sb >= NPB) ? C.inp(6)[(size_t)(l * NSB_S + sb - NPB) * 512 + ch] : 0.f;
    }
    const int cp = tid & 31, sg = tid >> 5;
    float cw[2][5];
#pragma unroll
    for (int e = 0; e < 2; ++e) { const int ch = blk * 64 + 2 * cp + e;
#pragma unroll
        for (int j = 0; j < 4; ++j) cw[e][j] = C.inp(11)[((size_t)l * 4 + j) * 512 + ch];
        cw[e][4] = C.inp(12)[l * 512 + ch]; }
#define LRU_DMA(cc) do { const int t0_ = 64 * (cc); \
        for (int k_ = wave; k_ < 9; k_ += NWAVES) { const int q_ = 64 * k_ + lane, rr_ = q_ >> 3, pc_ = q_ & 7, t_ = t0_ - 3 + rr_; \
            if (q_ < 536 && t_ >= 0) __builtin_amdgcn_global_load_lds((const unsigned*)(PJ + (size_t)(row0 + t_) * PJW + C_XL + blk * 64 + 8 * pc_), (LAS unsigned*)(L + LR_RAW + k_ * 1024), 16, 0, 0); } \
        { const int rr_ = 8 * wave + (lane >> 3), pc_ = lane & 7; \
          __builtin_amdgcn_global_load_lds((const unsigned*)(PJ + (size_t)(row0 + t0_ + rr_) * PJW + C_GL + blk * 64 + 8 * pc_), (LAS unsigned*)(L + LR_GL + ((cc) & 1) * 8192 + wave * 1024), 16, 0, 0); } \
    } while (0)
    if (tid < 24) {
        const int rr = tid >> 3, pc = tid & 7; u32x4 v = (u32x4){0u, 0u, 0u, 0u};
        if (sb >= NPB) { const float* st = C.inp(5) + ((size_t)(l * NSB_S + sb - NPB) * 3 + rr) * 512 + blk * 64 + 8 * pc; v = pack8(*(const f32x4*)st, *(const f32x4*)(st + 4)); }
        *(LAS u32x4*)(L + LR_RAW + rr * 128 + pc * 16) = v;
    }
    LRU_DMA(0);
    asm volatile("s_waitcnt vmcnt(0)" ::: "memory");
    __syncthreads();
    for (int c = 0; c < NC; ++c) {
        const int t0 = 64 * c;
        {
            float xa[7], xb[7];
#pragma unroll
            for (int i = 0; i < 7; ++i) { const unsigned w = *(const LAS unsigned*)(L + LR_RAW + (4 * sg + i) * 128 + 4 * cp); xa[i] = __uint_as_float(w << 16); xb[i] = __uint_as_float(w & 0xffff0000u); }
#pragma unroll
            for (int j = 0; j < 4; ++j) {
                const float ya = cw[0][4] + cw[0][0] * xa[j] + cw[0][1] * xa[j + 1] + cw[0][2] * xa[j + 2] + cw[0][3] * xa[j + 3];
                const float yb = cw[1][4] + cw[1][0] * xb[j] + cw[1][1] * xb[j + 1] + cw[1][2] * xb[j + 2] + cw[1][3] * xb[j + 3];
                *(LAS unsigned*)(L + LR_XC + (4 * sg + j) * 144 + 4 * cp) = cvt_pk_bf16(ya, yb);
                f32x2_t v2 = {ya, yb}; *(LAS f32x2_t*)(L + LR_XCF + (4 * sg + j) * 256 + 8 * cp) = v2;
            }
        }
        LDS_FENCE(); __syncthreads();
        if (c + 1 < NC) LRU_DMA(c + 1);
        f32x4v ga[2], gx[2];
#pragma unroll
        for (int db = 0; db < 2; ++db) { ga[db] = (f32x4v){0.f, 0.f, 0.f, 0.f}; gx[db] = (f32x4v){0.f, 0.f, 0.f, 0.f}; }
#pragma unroll
        for (int kb = 0; kb < 2; ++kb) {
            const bf16x8 af = *(const LAS bf16x8*)(L + LR_XC + (16 * ts + fr) * 144 + (32 * kb + 8 * fq) * 2);
#pragma unroll
            for (int db = 0; db < 2; ++db) { ga[db] = MFMA16(af, wf[0][db][kb], ga[db]); gx[db] = MFMA16(af, wf[1][db][kb], gx[db]); }
        }
        float Pk[2][4], Hk[2][4], Pq[2], Hq[2];
#pragma unroll
        for (int db = 0; db < 2; ++db) {
            float P = 1.f, H = 0.f;
#pragma unroll
            for (int reg = 0; reg < 4; ++reg) {
                const float xc = *(const LAS float*)(L + LR_XCF + (16 * ts + 4 * fq + reg) * 256 + (32 * dh + 16 * db + fr) * 4);
                const float rg = fast_sigmoid(ga[db][reg] + ba[db]), ig = fast_sigmoid(gx[db][reg] + bx[db]);
                const float a = __builtin_amdgcn_exp2f(-rg * spl[db]);
                const float b = sqrtf(fmaxf(1.f - a * a, 0.f)) * (ig * xc);
                H = a * H + b; P = a * P; Pk[db][reg] = P; Hk[db][reg] = H;
            }
            float Pi = P, Hi = H;
            { const float Pp = bperm(Pi, lane - 16), Hp = bperm(Hi, lane - 16); if (fq >= 1) { Hi = Pi * Hp + Hi; Pi = Pi * Pp; } }
            { const float Pp = bperm(Pi, lane - 32), Hp = bperm(Hi, lane - 32); if (fq >= 2) { Hi = Pi * Hp + Hi; Pi = Pi * Pp; } }
            if (fq == 3) { f32x2_t v2 = {Pi, Hi}; *(LAS f32x2_t*)(L + LR_SEG + (ts * 64 + 32 * dh + 16 * db + fr) * 8) = v2; }
            const float Pe = bperm(Pi, lane - 16), He = bperm(Hi, lane - 16);
            Pq[db] = (fq >= 1) ? Pe : 1.f; Hq[db] = (fq >= 1) ? He : 0.f;
        }
        LDS_FENCE(); __syncthreads();
#pragma unroll
        for (int db = 0; db < 2; ++db) {
            float s = hc[db], sin = hc[db];
#pragma unroll
            for (int k = 0; k < 4; ++k) { const f32x2_t m = *(const LAS f32x2_t*)(L + LR_SEG + (k * 64 + 32 * dh + 16 * db + fr) * 8); if (k == ts) sin = s; s = m[0] * s + m[1]; }
            hc[db] = s;
            const float hin = Pq[db] * sin + Hq[db];
            const bf16_t* glp = nullptr; (void)glp;
#pragma unroll
            for (int reg = 0; reg < 4; ++reg) {
                const float hval = Pk[db][reg] * hin + Hk[db][reg];
                const int t = 16 * ts + 4 * fq + reg, d = 32 * dh + 16 * db + fr;
                const float glv = bf2f(*(const LAS bf16_t*)(L + LR_GL + (c & 1) * 8192 + t * 128 + d * 2));
                *(LAS bf16_t*)(L + LR_YS + t * 128 + d * 2) = f2bf(hval * fast_silu(glv));
            }
        }
        asm volatile("s_waitcnt vmcnt(0)" ::: "memory");
        LDS_FENCE(); __syncthreads();
        { const int rr = tid >> 3, pc = tid & 7;
          *(u32x4*)(PJ + (size_t)(row0 + t0 + rr) * PJW + C_GL + blk * 64 + 8 * pc) = *(const LAS u32x4*)(L + LR_YS + rr * 128 + pc * 16); }
    }
    if (ts == 0 && fq == 0) {
#pragma unroll
        for (int db = 0; db < 2; ++db) out_lh(C, l, sb)[blk * 64 + 32 * dh + 16 * db + fr] = hc[db];
    }
#undef LRU_DMA
    asm volatile("s_waitcnt vmcnt(0)" ::: "memory");
    __syncthreads();
}

DI Ctx relaunder(const Ctx& C0) {
    Ctx C = C0; int ln; asm volatile("v_mbcnt_lo_u32_b32 %0, -1, 0\n\tv_mbcnt_hi_u32_b32 %0, -1, %0" : "=v"(ln)); C.lane = ln; C.tid = C.wave * 64 + ln;
    { unsigned long long w = (unsigned long long)C.ws, o = (unsigned long long)C.out; asm volatile("" : "+s"(w), "+s"(o));
      C.ws = (unsigned char*)(__attribute__((address_space(1))) unsigned char*)w; C.out = (float*)(__attribute__((address_space(1))) float*)o; }
    asm volatile("" : "+s"(C.G), "+s"(C.bid));
    return C;
}
constexpr int CW_QUEUE = 8192;
constexpr int MX_PREP = 64;
constexpr int MX_A = 144, MX_B = MX_A + 256, MX_C0 = MX_B + 8, MX_C = MX_C0 + 240, MX_D = MX_C + 128, MX_E = MX_D + 128, MX_F = MX_E + 128, MX_N = MX_F + 64;
DI void phase_mixers(const Ctx& Cin, int l) {
    unsigned* head = (unsigned*)(Cin.ws + WS_CTL) + CW_QUEUE + 64 * l;
    volatile LAS int* slot = (volatile LAS int*)(Cin.lds + LDS_BYTES - 24);
    for (;;) {
        __syncthreads();
        if (Cin.tid == 0) *slot = (int)__hip_atomic_fetch_add(head, 1u, __ATOMIC_RELAXED, __HIP_MEMORY_SCOPE_AGENT);
        __syncthreads();
        const int i = __builtin_amdgcn_readfirstlane(*slot);
        if (i >= MX_N + (l == 0 ? MX_PREP : 0)) break;
        const Ctx C = relaunder(Cin);
        if (i >= MX_N) { prep_layer(C, 1, i - MX_N, MX_PREP); continue; }
        int kind, sb, sub;
        if (i < MX_A) { kind = 0; sb = i & 15; sub = 31 - (i >> 4); }
        else if (i < MX_B) { const int j = i - MX_A; kind = 1; sb = j >> 4; sub = j & 15; }
        else if (i < MX_C0) { kind = 0; sb = NPB + (i - MX_B); sub = 0; }
        else if (i < MX_C) { const int j = i - MX_C0; kind = 0; sb = j & 15; sub = 22 - (j >> 4); }
        else if (i < MX_D) { const int j = i - MX_C; kind = 2; sb = j >> 3; sub = j & 7; }
        else if (i < MX_E) { const int j = i - MX_D; kind = 0; sb = j & 15; sub = 7 - (j >> 4); }
        else if (i < MX_F) { const int j = i - MX_E; kind = 1; sb = NPB + (j >> 4); sub = j & 15; }
        else { const int j = i - MX_F; kind = 2; sb = NPB + (j >> 3); sub = j & 7; }
        PROBE_BEGIN(50); PROBE_BEGIN(51); PROBE_BEGIN(52); PROBE_BEGIN(53);
        if (kind == 0) attn_item(C, l, sb, sub);
        else if (kind == 1) ssd_item(C, l, sb, sub);
        else lru_item(C, l, sb, sub);
        if (l == 0) { PROBE_END(50, C); if (kind == 0) PROBE_END(51, C); if (kind == 1) PROBE_END(52, C); if (kind == 2) PROBE_END(53, C); }
    }
}

#define XB_TMO      128
#define XB_XCNT(j)  (256  + 64 * (j))
#define XB_XSUB(j)  (1280 + 64 * (j))
#define XB_XGEN(j)  (2304 + 64 * (j))
#define XB_TOP      3328
#define XB_TOPGEN   3392
#define XCD_BAR_WORDS 3456
#define XB_SPIN_CAP (1u << 22)

__device__ __forceinline__ unsigned xb_ld(unsigned* p)              { return __hip_atomic_load(p, __ATOMIC_RELAXED, __HIP_MEMORY_SCOPE_AGENT); }
__device__ __forceinline__ unsigned xb_add(unsigned* p, unsigned v) { return __hip_atomic_fetch_add(p, v, __ATOMIC_RELAXED, __HIP_MEMORY_SCOPE_AGENT); }
__device__ __forceinline__ unsigned xb_xcc_id() { return (unsigned)__builtin_amdgcn_s_getreg((3 << 11) | 20) & 0xFu; }
#define XB_SPIN(cond, bar) do { unsigned _sp = 0; while (cond) { __builtin_amdgcn_s_sleep(1); \
    if ((++_sp & 255u) == 0u) { if (xb_ld(&(bar)[XB_TMO])) break; if (_sp > XB_SPIN_CAP) { atomicAdd(&(bar)[XB_TMO], 1u); break; } } } } while (0)

struct XcdBarrier {
    unsigned* bar; unsigned x;
    volatile LAS unsigned* st;
};

__device__ __forceinline__ XcdBarrier xcd_barrier_post(unsigned* bar, volatile LAS unsigned* st) {
    XcdBarrier b; b.bar = bar; b.x = xb_xcc_id(); b.st = st;
    if (threadIdx.x == 0) (void)xb_add(&bar[XB_XCNT(b.x)], 1u);
    return b;
}
__device__ __forceinline__ void xcd_barrier_complete(unsigned* bar, unsigned x, unsigned& nloc, unsigned& nx) {
    const unsigned G = gridDim.x * gridDim.y * gridDim.z;
    unsigned sum, cnt, mine, sp = 0u;
    for (;;) {
        sum = 0u; cnt = 0u; mine = 0u;
#pragma unroll
        for (unsigned j = 0; j < 16; ++j) { const unsigned c = xb_ld(&bar[XB_XCNT(j)]); sum += c; cnt += (c > 0u) ? 1u : 0u; mine = (j == x) ? c : mine; }
        if (sum == G) break;
        __builtin_amdgcn_s_sleep(1);
        if ((++sp & 255u) == 0u) { if (xb_ld(&bar[XB_TMO])) break; if (sp > XB_SPIN_CAP) { atomicAdd(&bar[XB_TMO], 1u); break; } }
    }
    nloc = mine > 0u ? mine : 1u; nx = cnt > 0u ? cnt : 1u;
}

__device__ __forceinline__ void xcd_barrier(const XcdBarrier& b) {
    asm volatile("s_waitcnt vmcnt(0)" ::: "memory");
    __syncthreads();
    if (threadIdx.x == 0) {
        unsigned* bar = b.bar;
        __builtin_amdgcn_s_waitcnt(0);
        unsigned nloc = b.st[0], nx = b.st[1];
        if (nloc == 0u) { xcd_barrier_complete(bar, b.x, nloc, nx); b.st[0] = nloc; b.st[1] = nx; }
        const unsigned old = xb_add(&bar[XB_XSUB(b.x)], 1u);
        const unsigned gen = old / nloc;
        if (old + 1u == (gen + 1u) * nloc) {
            __builtin_amdgcn_fence(__ATOMIC_RELEASE, "agent");
            asm volatile("s_waitcnt vmcnt(0)" ::: "memory");
            const unsigned og = xb_add(&bar[XB_TOP], 1u);
            const unsigned tg = og / nx;
            if (og + 1u == (tg + 1u) * nx) xb_add(&bar[XB_TOPGEN], 1u);
            else XB_SPIN(xb_ld(&bar[XB_TOPGEN]) == tg, bar);
            __builtin_amdgcn_fence(__ATOMIC_ACQUIRE, "agent");
            xb_add(&bar[XB_XGEN(b.x)], 1u);
            asm volatile("s_waitcnt vmcnt(0)" ::: "memory");
        } else {
            XB_SPIN(xb_ld(&bar[XB_XGEN(b.x)]) == gen, bar);
            __builtin_amdgcn_fence(__ATOMIC_ACQUIRE, "agent");
            asm volatile("s_waitcnt vmcnt(0)" ::: "memory");
        }
    }
    __syncthreads();
}


constexpr int PH_PER_LAYER = 3;
constexpr int N_PHASES = 1 + 2 * PH_PER_LAYER;
constexpr int CW_BAR = 4096;
__global__ void __launch_bounds__(NTHREADS, 2) mk_fwd(Args a) {
    extern __shared__ __attribute__((aligned(16))) unsigned char lds_raw[];
    Ctx C; C.out = a.out; C.ws = a.ws; C.lds = (LAS unsigned char*)lds_raw;
    C.tid = threadIdx.x; C.lane = C.tid & 63; C.wave = __builtin_amdgcn_readfirstlane(C.tid >> 6); C.G = gridDim.x; C.bid = blockIdx.x;
    if (C.tid == 0) {
#pragma unroll
        for (int i = 0; i < 28; ++i) ((LAS cfp_t*)(C.lds + LDS_BYTES - 256))[i] = a.in[i];
        ((volatile LAS unsigned*)(C.lds + LDS_BYTES - 32))[0] = 0u; ((volatile LAS unsigned*)(C.lds + LDS_BYTES - 32))[1] = 0u;
        *(LAS unsigned long long*)(C.lds + LDS_BYTES - 16) = 0ull;
    }
    __syncthreads();
    const XcdBarrier bar = xcd_barrier_post((unsigned*)(a.ws + WS_CTL) + CW_BAR, (volatile LAS unsigned*)(C.lds + LDS_BYTES - 32));
    const Ctx C0 = C;
#define LAUNDER() const Ctx C = relaunder(C0)
#ifdef PROBE_PHASE
    unsigned long long pr_t0 = 0, pr_t1 = 0;
#endif
    for (int ph = a.ph_lo; ph < a.ph_hi; ++ph) {
#ifdef PROBE_PHASE
        if (ph == PROBE_PHASE) pr_t0 = __builtin_amdgcn_s_memrealtime();
#endif
        if (ph == 0) { LAUNDER(); phase_prologue(C); }
        else {
            const int l = (ph - 1) / PH_PER_LAYER, k = (ph - 1) % PH_PER_LAYER;
            if (k == 0) { LAUNDER(); phase_inproj_gemm(C, l); }
            else if (k == 1) { LAUNDER(); phase_mixers(C, l); }
            else { LAUNDER(); phase_outproj_gemm(C, l); }
        }
        if (ph + 1 < a.ph_hi) { if (ph == 0) cg::this_grid().sync(); else xcd_barrier(bar); }
#ifdef PROBE_PHASE
        if (ph == PROBE_PHASE) pr_t1 = __builtin_amdgcn_s_memrealtime();
#endif
    }
#ifdef PROBE_PHASE
#ifdef PROBE_SUB
    pr_t0 = 0; pr_t1 = *(LAS unsigned long long*)(C0.lds + LDS_BYTES - 16);
#endif
#ifndef PROBE_BLOCK
#define PROBE_BLOCK 0
#endif
    if (PROBE_BLOCK < 0 || (int)blockIdx.x == PROBE_BLOCK) { const unsigned long long te = __builtin_amdgcn_s_memrealtime(), span = 4ull * (pr_t1 - pr_t0); while (__builtin_amdgcn_s_memrealtime() - te < span) __builtin_amdgcn_s_sleep(8); }
#endif
}

extern "C" void kernel_launch(void* const* d_in, const int* in_sizes, int n_in, void* d_out, int out_size, void* d_ws, size_t ws_size, hipStream_t stream) {
    static int grid = 0;
    if (grid == 0) {
        if (n_in != 28 || (size_t)out_size != O_END || ws_size < WS_END) { fprintf(stderr, "kernel_launch: unexpected shapes n_in %d out %d ws %zu\n", n_in, out_size, ws_size); grid = -1; return; }
        int dev = 0, cus = 0, per_cu = 0;
        hipGetDevice(&dev); hipDeviceGetAttribute(&cus, hipDeviceAttributeMultiprocessorCount, dev);
        hipFuncSetAttribute((const void*)mk_fwd, hipFuncAttributeMaxDynamicSharedMemorySize, LDS_BYTES);
        hipOccupancyMaxActiveBlocksPerMultiprocessor(&per_cu, (const void*)mk_fwd, NTHREADS, LDS_BYTES);
        if (per_cu < 1) per_cu = 1;
        grid = cus * 1;
        (void)hipGetLastError();
    }
    if (grid < 0) return;
    hipMemsetAsync((char*)d_ws + WS_CTL, 0, CTL_BYTES, stream);
    Args a{};
    for (int i = 0; i < 28; ++i) a.in[i] = (const float*)d_in[i];
    a.out = (float*)d_out; a.ws = (unsigned char*)d_ws;
    a.ph_lo = 0; a.ph_hi = N_PHASES;
    void* args[] = {&a};
    hipError_t e = hipLaunchCooperativeKernel((const void*)mk_fwd, dim3(grid), dim3(NTHREADS), args, LDS_BYTES, stream);
    if (e != hipSuccess) fprintf(stderr, "cooperative launch failed: %s (grid %d)\n", hipGetErrorString(e), grid);
}
```

```cpp
#include <hip/hip_runtime.h>
#include <hip/hip_cooperative_groups.h>
#include <cstdio>
#include <cstdint>
namespace cg = cooperative_groups;

typedef unsigned short bf16_t;
typedef short bf16x8 __attribute__((ext_vector_type(8)));
typedef float f32x4 __attribute__((ext_vector_type(4)));
typedef float f32x16 __attribute__((ext_vector_type(16)));
typedef unsigned u32x4 __attribute__((ext_vector_type(4)));
typedef unsigned u32x2 __attribute__((ext_vector_type(2)));
#define LAS __attribute__((address_space(3)))
#define DI __device__ __forceinline__

constexpr int DM = 1024, NPB = 16, SEQ = 2048, NSB_S = 8, DSEQ = 64, PAST = 1024;
constexpr int ROWS_P = NPB * SEQ;
constexpr int ROWS = ROWS_P + NSB_S * DSEQ;
constexpr int NSB = NPB + NSB_S;
constexpr int DINP = 5204, NPAD = 5376;
constexpr int PJW = 4864;
constexpr int DMIX = 2048;
constexpr float EPS = 1e-6f;
constexpr int C_GL = 0, C_GA = 512, C_Z = 1024, C_XL = 2048, C_Q = 2560, C_QI = 3072, C_XBC = 3328, C_T19 = 4864, C_T20 = 5120;
constexpr int KVW = 320;
constexpr size_t KVB_LAYER = (size_t)NPB * SEQ * KVW + (size_t)NSB_S * (PAST + DSEQ) * KVW;

constexpr size_t O_YP = 0;
constexpr size_t O_YS = O_YP + (size_t)NPB * SEQ * DM;
constexpr size_t O_AKP = O_YS + (size_t)NSB_S * DSEQ * DM;
constexpr size_t O_AVP = O_AKP + (size_t)2 * NPB * SEQ * 128;
constexpr size_t O_IKP = O_AVP + (size_t)2 * NPB * SEQ * 128;
constexpr size_t O_LCP = O_IKP + (size_t)2 * NPB * SEQ * 64;
constexpr size_t O_LHP = O_LCP + (size_t)2 * NPB * 3 * 512;
constexpr size_t O_SCP = O_LHP + (size_t)2 * NPB * 512;
constexpr size_t O_SHP = O_SCP + (size_t)2 * NPB * 3 * 1536;
constexpr size_t O_AKS = O_SHP + (size_t)2 * NPB * 16 * 64 * 128;
constexpr size_t O_AVS = O_AKS + (size_t)2 * NSB_S * DSEQ * 128;
constexpr size_t O_IKS = O_AVS + (size_t)2 * NSB_S * DSEQ * 128;
constexpr size_t O_LCS = O_IKS + (size_t)2 * NSB_S * DSEQ * 64;
constexpr size_t O_LHS = O_LCS + (size_t)2 * NSB_S * 3 * 512;
constexpr size_t O_SCS = O_LHS + (size_t)2 * NSB_S * 512;
constexpr size_t O_SHS = O_SCS + (size_t)2 * NSB_S * 3 * 1536;
constexpr size_t O_END = O_SHS + (size_t)2 * NSB_S * 16 * 64 * 128;

constexpr size_t MiB = 1u << 20;
constexpr size_t WS_CTL = 0, CTL_BYTES = 1 * MiB;
constexpr size_t WS_WIN = 1 * MiB;
constexpr size_t WIN_LAYER = (size_t)NPAD * DM;
constexpr size_t WS_WOUT = 22 * MiB;
constexpr size_t WOUT_LAYER = (size_t)DM * DMIX;
constexpr size_t WS_HB = 30 * MiB;
constexpr size_t WS_RSS = 95 * MiB;
constexpr size_t WS_WI = 98 * MiB;
constexpr size_t WS_DTR = 99 * MiB;
constexpr size_t WS_SSQ = 102 * MiB;
constexpr size_t WS_KVB = 112 * MiB;
constexpr size_t WS_PROJ = 138 * MiB;
constexpr size_t WS_KEYS_B = 447 * MiB;
constexpr size_t KEYS_PER_WG = 512 * 1024;
constexpr size_t WS_END = WS_KEYS_B + 128 * KEYS_PER_WG;
static_assert(WS_KVB + KVB_LAYER * 2 <= WS_PROJ && WS_PROJ + (size_t)ROWS * PJW * 2 <= WS_KEYS_B && 128 * KEYS_PER_WG <= 65 * MiB, "ws map");
static_assert(WS_END <= 512 * MiB, "ws map");

constexpr int NTHREADS = 512, NWAVES = 8;
constexpr int LDS_BYTES = 163840;

DI float bf2f(bf16_t v) { return __uint_as_float(((unsigned)v) << 16); }
DI bf16_t f2bf(float f) { unsigned u = __float_as_uint(f); return (bf16_t)((u + 0x7fffu + ((u >> 16) & 1u)) >> 16); }
DI unsigned pk2(float lo, float hi) { return (unsigned)f2bf(lo) | ((unsigned)f2bf(hi) << 16); }
DI int crow(int reg, int h) { return (reg & 3) + 8 * (reg >> 2) + 4 * h; }
template <int O> DI float swz_xor(float v) { return __int_as_float(__builtin_amdgcn_ds_swizzle(__float_as_int(v), (O << 10) | 0x1f)); }
DI float xor32_sum(float v) { auto rr = __builtin_amdgcn_permlane32_swap(__float_as_uint(v), __float_as_uint(v), false, false); return __uint_as_float(rr[0]) + __uint_as_float(rr[1]); }
DI float xor32_max(float v) { auto rr = __builtin_amdgcn_permlane32_swap(__float_as_uint(v), __float_as_uint(v), false, false); return fmaxf(__uint_as_float(rr[0]), __uint_as_float(rr[1])); }
DI float half_sum32(float v) {
    v += swz_xor<1>(v); v += swz_xor<2>(v); v += swz_xor<4>(v); v += swz_xor<8>(v); v += swz_xor<16>(v); return v;
}
DI float wave_sum(float v) { return xor32_sum(half_sum32(v)); }
DI float wave_max(float v) {
    v = fmaxf(v, swz_xor<1>(v)); v = fmaxf(v, swz_xor<2>(v)); v = fmaxf(v, swz_xor<4>(v)); v = fmaxf(v, swz_xor<8>(v)); v = fmaxf(v, swz_xor<16>(v)); return xor32_max(v);
}
DI float sum_fq(float v) { return xor32_sum(v + swz_xor<16>(v)); }
DI float bperm(float v, int srclane) { return __int_as_float(__builtin_amdgcn_ds_bpermute(srclane << 2, __float_as_int(v))); }
DI float silu_f(float x) { return x / (1.f + expf(-x)); }
DI float sigmoid_f(float x) { return 1.f / (1.f + expf(-x)); }
DI float softplus_f(float x) { return x > 20.f ? x : log1pf(expf(x)); }
#define LDS_FENCE() asm volatile("s_waitcnt lgkmcnt(0)" ::: "memory")

__host__ __device__ inline int orig_col(int c) {
    if (c < 512) return 512 + c;
    if (c < 1024) return 1792 + (c - 512);
    if (c < 2048) return 2628 + (c - 1024);
    if (c < 2560) return c - 2048;
    if (c < 3072) return 1024 + (c - 2560);
    if (c < 3328) return 2304 + (c - 3072);
    if (c < 4864) return 3652 + (c - 3328);
    if (c < 5120) { const int cl = c - 4864, bj = cl >> 7, wc = (cl >> 5) & 3, j = cl & 31, d = 32 * bj + j; return (wc < 2 ? 1536 : 1664) + (wc & 1) * 64 + d; }
    const int cl = c - 5120;
    if (cl < 64) return 2560 + cl;
    if (cl < 68) return 2624 + (cl - 64);
    if (cl < 84) return 5188 + (cl - 68);
    return -1;
}
DI int sb_T(int sb) { return sb < NPB ? SEQ : DSEQ; }
DI int sb_P(int sb) { return sb < NPB ? 0 : PAST; }
DI int sb_row0(int sb) { return sb < NPB ? sb * SEQ : ROWS_P + (sb - NPB) * DSEQ; }
DI size_t kvb_off(int sb) { return sb < NPB ? (size_t)sb * SEQ * KVW : (size_t)NPB * SEQ * KVW + (size_t)(sb - NPB) * (PAST + DSEQ) * KVW; }
DI void row_sbt(int m, int& sb, int& t) { if (m < ROWS_P) { sb = m >> 11; t = m & 2047; } else { const int r = m - ROWS_P; sb = NPB + (r >> 6); t = r & 63; } }

typedef const float* cfp_t;
struct Args { const float* in[28]; float* out; unsigned char* ws; int ph_lo, ph_hi; };

struct Ctx {
    float* out; unsigned char* ws;
    LAS unsigned char* lds;
    DI const float* inp(int k) const { return (const float*)(const __attribute__((address_space(1))) float*)(((LAS unsigned long long*)(lds + LDS_BYTES - 256))[k]); }
    int tid, lane, wave, G, bid;
    DI bf16_t* win(int l) const { return (bf16_t*)(ws + WS_WIN) + (size_t)l * WIN_LAYER; }
    DI bf16_t* wout(int l) const { return (bf16_t*)(ws + WS_WOUT) + (size_t)l * WOUT_LAYER; }
    DI bf16_t* hb() const { return (bf16_t*)(ws + WS_HB); }
    DI float* rss() const { return (float*)(ws + WS_RSS); }
    DI float* wi() const { return (float*)(ws + WS_WI); }
    DI float* dtr() const { return (float*)(ws + WS_DTR); }
    DI float* ssq() const { return (float*)(ws + WS_SSQ); }
    DI bf16_t* kvb(int) const { return (bf16_t*)(ws + WS_KVB); }
    DI unsigned* keys() const { return (unsigned*)(bid < 128 ? ws + WS_HB + (size_t)bid * KEYS_PER_WG : ws + WS_KEYS_B + (size_t)(bid - 128) * KEYS_PER_WG); }
    DI bf16_t* proj() const { return (bf16_t*)(ws + WS_PROJ); }
};
DI float* out_ak(const Ctx& C, int l, int sb) { return sb < NPB ? C.out + O_AKP + ((size_t)(l * NPB + sb) * SEQ) * 128 : C.out + O_AKS + ((size_t)(l * NSB_S + sb - NPB) * DSEQ) * 128; }
DI float* out_av(const Ctx& C, int l, int sb) { return sb < NPB ? C.out + O_AVP + ((size_t)(l * NPB + sb) * SEQ) * 128 : C.out + O_AVS + ((size_t)(l * NSB_S + sb - NPB) * DSEQ) * 128; }
DI float* out_ik(const Ctx& C, int l, int sb) { return sb < NPB ? C.out + O_IKP + ((size_t)(l * NPB + sb) * SEQ) * 64 : C.out + O_IKS + ((size_t)(l * NSB_S + sb - NPB) * DSEQ) * 64; }
DI float* out_lc(const Ctx& C, int l, int sb) { return sb < NPB ? C.out + O_LCP + (size_t)(l * NPB + sb) * 3 * 512 : C.out + O_LCS + (size_t)(l * NSB_S + sb - NPB) * 3 * 512; }
DI float* out_lh(const Ctx& C, int l, int sb) { return sb < NPB ? C.out + O_LHP + (size_t)(l * NPB + sb) * 512 : C.out + O_LHS + (size_t)(l * NSB_S + sb - NPB) * 512; }
DI float* out_sc(const Ctx& C, int l, int sb) { return sb < NPB ? C.out + O_SCP + (size_t)(l * NPB + sb) * 3 * 1536 : C.out + O_SCS + (size_t)(l * NSB_S + sb - NPB) * 3 * 1536; }
DI float* out_sh(const Ctx& C, int l, int sb) { return sb < NPB ? C.out + O_SHP + (size_t)(l * NPB + sb) * 16 * 64 * 128 : C.out + O_SHS + (size_t)(l * NSB_S + sb - NPB) * 16 * 64 * 128; }

#ifdef PROBE_SUB
#define PROBE_BEGIN(id) unsigned long long pb_##id = __builtin_amdgcn_s_memrealtime()
#define PROBE_END(id, Cx) do { if ((id) == PROBE_SUB && (Cx).tid == 0) *(LAS unsigned long long*)((Cx).lds + LDS_BYTES - 16) += __builtin_amdgcn_s_memrealtime() - pb_##id; } while (0)
#else
#define PROBE_BEGIN(id) do {} while (0)
#define PROBE_END(id, Cx) do {} while (0)
#endif
namespace pg8 {
#define PG8_LAS __attribute__((address_space(3)))
constexpr int BM = 256, BK = 64, HALF = 128, HTB = HALF * BK * 2  , STAGE_BYTES = 8 * HTB, NXCD = 8, WGM = 8;

__host__ __device__ __forceinline__ int lds_byte(int r, int c) { const int st = (r >> 4) * 2 + (c >> 5), rr = r & 15, cc = c & 31, ob = rr * 64 + cc * 2; return st * 1024 + (ob ^ (((ob >> 9) & 1) << 5)); }
__host__ __device__ __forceinline__ void stage_rc(int b, int& R, int& C) { const int st = b / 1024, sb = b % 1024, swz = sb ^ (((sb >> 9) & 1) << 5); R = (st >> 1) * 16 + swz / 64; C = (st & 1) * 32 + (swz % 64) / 2; }
__host__ __device__ __forceinline__ int perm32(int rho) { const int n = rho >> 4, i = rho & 15; return 8 * (i >> 2) + 4 * n + (i & 3); }

struct Unit { int pm, pn; };
struct Gemm { const bf16_t* A; const bf16_t* Bt; int M, N, K, lda; };

struct StaticOrder {
    int nM, nN, nwg, G, c;
    __host__ __device__ void init(int M, int N, int G_, int c_) { nM = M / BM; nN = N / BM; nwg = nM * nN; G = G_; c = c_; }
    __host__ __device__ bool next(int i, Unit& u) const {
        const long L = (long)i * G + c; if (L >= nwg) return false;
        int wgid = (int)L; { const int q = nwg / NXCD, r = nwg % NXCD, xcd = wgid % NXCD, off = wgid / NXCD; wgid = (xcd < r ? xcd * (q + 1) : r * (q + 1) + (xcd - r) * q) + off; }
        const int nig = WGM * nN, gid = wgid / nig, fm = gid * WGM, gsz = (nM - fm) < WGM ? (nM - fm) : WGM;
        u.pm = fm + ((wgid % nig) % gsz); u.pn = (wgid % nig) / gsz; return true;
    }
    __device__ __forceinline__ void a_ready(const Unit&) const {}
    __device__ __forceinline__ void done(const Unit&) const {}
};

template <class Epi, class Sched, bool ALIGN_EPI = false, bool SP2 = false>
__device__ __forceinline__ void gemm_phase(PG8_LAS unsigned char* lds, const Gemm g, const Sched& S, const Epi& E, const int tid) {
    const int wid = __builtin_amdgcn_readfirstlane(tid >> 6), lane = tid & 63, wr = wid >> 2, wc = wid & 3, fr = lane & 15, fq = lane >> 4;
    const int K = g.K, nt = K / BK;
    unsigned voffA[2], voffB[2];
#pragma unroll
    for (int i = 0; i < 2; ++i) { int R, C; stage_rc(tid * 16 + i * 8192, R, C); const int Rb = Epi::PERM ? ((R & ~31) + perm32(R & 31)) : R;
        voffA[i] = (unsigned)(R * g.lda + C) * 2u; voffB[i] = (unsigned)(Rb * K + C) * 2u; }
    const size_t kstep = (size_t)(BK * 2);
    const size_t hstepA = (size_t)HALF * g.lda * 2, hstepB = (size_t)HALF * K * 2;
    const size_t tstepA = 2 * hstepA, tstepB = 2 * hstepB;
    const unsigned ldsw = (unsigned)wid * 1024u;
    const int aoff = lds_byte(wr * 64 + fr, fq * 8), boff = lds_byte(wc * 32 + fr, fq * 8);
#define PG8_SA(b, h) (((b) * 2 + (h)) * HTB)
#define PG8_SB(b, h) ((4 + (b) * 2 + (h)) * HTB)
#define PG8_STAGE(bufoff, gbase, voff) do { _Pragma("unroll") for (int _i = 0; _i < 2; ++_i) \
        __builtin_amdgcn_global_load_lds((const unsigned*)((const char*)(gbase) + (voff)[_i]), (PG8_LAS unsigned*)(lds + (bufoff) + ldsw + _i * 8192), 16, 0, 0); } while (0)
#define PG8_LDA(dst, b, h) do { _Pragma("unroll") for (int m = 0; m < 4; ++m) _Pragma("unroll") for (int k = 0; k < 2; ++k) dst[m][k] = *(const PG8_LAS bf16x8*)(lds + PG8_SA(b, h) + aoff + m * 2048 + k * 1024); } while (0)
#define PG8_LDB(dst, b, h) do { _Pragma("unroll") for (int n = 0; n < 2; ++n) _Pragma("unroll") for (int k = 0; k < 2; ++k) dst[n][k] = *(const PG8_LAS bf16x8*)(lds + PG8_SB(b, h) + boff + n * 2048 + k * 1024); } while (0)
#define PG8_MMA(ai, bj, At, Bt) do { __builtin_amdgcn_s_setprio(1); _Pragma("unroll") for (int m = 0; m < 4; ++m) _Pragma("unroll") for (int n = 0; n < 2; ++n) _Pragma("unroll") for (int k = 0; k < 2; ++k) \
        acc[ai][bj][m][n] = __builtin_amdgcn_mfma_f32_16x16x32_bf16(Bt[n][k], At[m][k], acc[ai][bj][m][n], 0, 0, 0); __builtin_amdgcn_s_setprio(0); } while (0)
#define PG8_WAIT_V(n) asm volatile("s_waitcnt vmcnt(" #n ")" ::: "memory")
#define PG8_WAIT_L(n) asm volatile("s_waitcnt lgkmcnt(" #n ")" ::: "memory")
#define PG8_BAR __builtin_amdgcn_s_barrier()
#define PG8_SCHED __builtin_amdgcn_sched_barrier(0)
    Unit cur, nxt; int ui = 0;
    if (!S.next(0, cur)) return;
    f32x4 acc[2][2][4][2];
#pragma unroll
    for (int a = 0; a < 2; ++a)
#pragma unroll
        for (int b = 0; b < 2; ++b)
#pragma unroll
            for (int m = 0; m < 4; ++m)
#pragma unroll
                for (int n = 0; n < 2; ++n) acc[a][b][m][n] = (f32x4){0.f, 0.f, 0.f, 0.f};
    bf16x8 At[4][2], B0[2][2], B1[2][2];
    const char* cA = (const char*)g.A + (size_t)cur.pm * tstepA; const char* cB = (const char*)g.Bt + (size_t)cur.pn * tstepB;
    S.a_ready(cur);
    if constexpr (SP2) {
        PG8_STAGE(PG8_SB(0, 0), cB, voffB); PG8_STAGE(PG8_SB(0, 1), cB + hstepB, voffB); PG8_STAGE(PG8_SA(0, 0), cA, voffA); PG8_STAGE(PG8_SA(0, 1), cA + hstepA, voffA);
        if (wr == 1) PG8_BAR;
        PG8_WAIT_V(2); PG8_BAR;
        PG8_STAGE(PG8_SB(1, 0), cB + kstep, voffB); PG8_STAGE(PG8_SA(1, 0), cA + kstep, voffA); PG8_STAGE(PG8_SB(1, 1), cB + hstepB + kstep, voffB);
        PG8_WAIT_V(6); PG8_BAR;
    } else {
        PG8_STAGE(PG8_SB(0, 0), cB, voffB); PG8_STAGE(PG8_SA(0, 0), cA, voffA); PG8_STAGE(PG8_SB(0, 1), cB + hstepB, voffB); PG8_STAGE(PG8_SA(0, 1), cA + hstepA, voffA);
        if (wr == 1) PG8_BAR;
        PG8_WAIT_V(4); PG8_BAR;
        PG8_STAGE(PG8_SB(1, 0), cB + kstep, voffB); PG8_STAGE(PG8_SA(1, 0), cA + kstep, voffA); PG8_STAGE(PG8_SB(1, 1), cB + hstepB + kstep, voffB);
        PG8_WAIT_V(6); PG8_BAR;
    }
    for (;;) {
        const bool has_next = S.next(ui + 1, nxt);
        const char* nA = has_next ? (const char*)g.A + (size_t)nxt.pm * tstepA : cA; const char* nB = has_next ? (const char*)g.Bt + (size_t)nxt.pn * tstepB : cB;
        for (int t = 0; t < nt; t += 2) {
            if constexpr (Epi::KSCALE) { if (t == Epi::KS_T0 || t == Epi::KS_T1) E.kscale(acc, ui, t, wr, fr); }
            const bool last = (t == nt - 2);
            const char* a1 = cA + (size_t)(t + 1) * kstep;
            const char* a2 = last ? nA : cA + (size_t)(t + 2) * kstep; const char* b2 = last ? nB : cB + (size_t)(t + 2) * kstep;
            const char* a3 = a2 + kstep; const char* b3 = b2 + kstep;
            if (last && has_next) S.a_ready(nxt);
            if constexpr (SP2) {
            PG8_LDB(B0, 0, 0); PG8_LDB(B1, 0, 1); PG8_SCHED; PG8_LDA(At, 0, 0); PG8_STAGE(PG8_SA(1, 1), a1 + hstepA, voffA);
            PG8_WAIT_V(8); PG8_WAIT_L(0); PG8_BAR; PG8_MMA(0, 0, At, B0); PG8_MMA(0, 1, At, B1); PG8_BAR; PG8_SCHED;
            PG8_LDA(At, 0, 1); PG8_STAGE(PG8_SB(0, 0), b2, voffB); PG8_STAGE(PG8_SB(0, 1), b2 + hstepB, voffB); PG8_STAGE(PG8_SA(0, 0), a2, voffA);
            PG8_WAIT_V(8); PG8_WAIT_L(0); PG8_BAR; PG8_MMA(1, 0, At, B0); PG8_MMA(1, 1, At, B1); PG8_BAR; PG8_SCHED;
            PG8_LDB(B0, 1, 0); PG8_LDB(B1, 1, 1); PG8_SCHED; PG8_LDA(At, 1, 0); PG8_STAGE(PG8_SA(0, 1), a2 + hstepA, voffA);
            PG8_WAIT_V(8); PG8_WAIT_L(0); PG8_BAR; PG8_MMA(0, 0, At, B0); PG8_MMA(0, 1, At, B1); PG8_BAR; PG8_SCHED;
            PG8_LDA(At, 1, 1); PG8_STAGE(PG8_SB(1, 0), b3, voffB); PG8_STAGE(PG8_SB(1, 1), b3 + hstepB, voffB); PG8_STAGE(PG8_SA(1, 0), a3, voffA);
            PG8_WAIT_V(8); PG8_WAIT_L(0); PG8_BAR; PG8_MMA(1, 0, At, B0); PG8_MMA(1, 1, At, B1); PG8_BAR; PG8_SCHED;
            } else {
            PG8_LDB(B0, 0, 0); PG8_SCHED; PG8_LDA(At, 0, 0); PG8_STAGE(PG8_SA(1, 1), a1 + hstepA, voffA);
            PG8_WAIT_L(8); PG8_BAR; PG8_WAIT_L(0); PG8_MMA(0, 0, At, B0); PG8_BAR; PG8_SCHED;
            PG8_LDB(B1, 0, 1); PG8_STAGE(PG8_SB(0, 0), b2, voffB);
            PG8_BAR; PG8_WAIT_L(0); PG8_MMA(0, 1, At, B1); PG8_BAR;
            PG8_LDA(At, 0, 1); PG8_STAGE(PG8_SA(0, 0), a2, voffA);
            PG8_BAR; PG8_WAIT_L(0); PG8_MMA(1, 0, At, B0); PG8_BAR; PG8_SCHED;
            PG8_STAGE(PG8_SB(0, 1), b2 + hstepB, voffB);
            PG8_WAIT_V(6); PG8_BAR; PG8_MMA(1, 1, At, B1); PG8_BAR;
            PG8_LDB(B0, 1, 0); PG8_SCHED; PG8_LDA(At, 1, 0); PG8_STAGE(PG8_SA(0, 1), a2 + hstepA, voffA);
            PG8_WAIT_L(8); PG8_BAR; PG8_WAIT_L(0); PG8_MMA(0, 0, At, B0); PG8_BAR; PG8_SCHED;
            PG8_LDB(B1, 1, 1); PG8_STAGE(PG8_SB(1, 0), b3, voffB);
            PG8_BAR; PG8_WAIT_L(0); PG8_MMA(0, 1, At, B1); PG8_BAR;
            PG8_LDA(At, 1, 1); PG8_STAGE(PG8_SA(1, 0), a3, voffA);
            PG8_BAR; PG8_WAIT_L(0); PG8_MMA(1, 0, At, B0); PG8_BAR; PG8_SCHED;
            PG8_STAGE(PG8_SB(1, 1), b3 + hstepB, voffB);
            PG8_WAIT_V(6); PG8_BAR; PG8_MMA(1, 1, At, B1); PG8_BAR;
            }
        }
        if constexpr (ALIGN_EPI) { if (wr == 0) PG8_BAR; }
        if constexpr (!Epi::AFTER_DRAIN) { E(acc, cur, wr, wc, fr, fq); S.done(cur); }
        if (!has_next) break;
#pragma unroll
        for (int a = 0; a < 2; ++a)
#pragma unroll
            for (int b = 0; b < 2; ++b)
#pragma unroll
                for (int m = 0; m < 4; ++m)
#pragma unroll
                    for (int n = 0; n < 2; ++n) acc[a][b][m][n] = (f32x4){0.f, 0.f, 0.f, 0.f};
        cur = nxt; cA = nA; cB = nB; ++ui;
        if constexpr (ALIGN_EPI) { if (wr == 1) PG8_BAR; }
    }
    PG8_WAIT_V(0);
    if constexpr (!ALIGN_EPI) { if (wr == 0) PG8_BAR; }
    PG8_BAR;
    if constexpr (Epi::AFTER_DRAIN) { E.fused(acc, cur, wr, wc, fr, fq, lds, wid, lane); S.done(cur); }
#undef PG8_SA
#undef PG8_SB
#undef PG8_STAGE
#undef PG8_LDA
#undef PG8_LDB
#undef PG8_MMA
#undef PG8_WAIT_V
#undef PG8_WAIT_L
#undef PG8_BAR
#undef PG8_SCHED
}
}

typedef float f32x2_t __attribute__((ext_vector_type(2))); typedef __bf16 bf16x2_t __attribute__((ext_vector_type(2)));
DI unsigned cvt_pk_bf16(float lo, float hi) { const f32x2_t v = {lo, hi}; const bf16x2_t b = __builtin_convertvector(v, bf16x2_t); return __builtin_bit_cast(unsigned, b); }
DI u32x4 pack8(const f32x4 a, const f32x4 b) { u32x4 w; w.x = cvt_pk_bf16(a[0], a[1]); w.y = cvt_pk_bf16(a[2], a[3]); w.z = cvt_pk_bf16(b[0], b[1]); w.w = cvt_pk_bf16(b[2], b[3]); return w; }
struct EpiIn {
    static constexpr bool PERM = true, AFTER_DRAIN = false, KSCALE = false; static constexpr int KS_T0 = -1, KS_T1 = -1;
    Ctx C; int l;
    DI void operator()(const f32x4 (&acc)[2][2][4][2], const pg8::Unit& u, int wr, int wc, int fr, int fq) const {
        const int row0 = u.pm * 256 + wr * 64 + fr;
        float rs[2][4];
#pragma unroll
        for (int ai = 0; ai < 2; ++ai)
#pragma unroll
            for (int m = 0; m < 4; ++m) {
                const f32x4 p = *(const f32x4*)(C.rss() + (size_t)(row0 + ai * 128 + m * 16) * 16 + 4 * fq);
                float s = sum_fq((p[0] + p[1]) + (p[2] + p[3]));
                rs[ai][m] = rsqrtf(s * (1.f / DM) + EPS);
            }
        if (u.pn < 19) {
            bf16_t* base = C.proj() + (size_t)row0 * PJW + u.pn * 256 + wc * 32 + 8 * fq;
#pragma unroll
            for (int ai = 0; ai < 2; ++ai)
#pragma unroll
                for (int m = 0; m < 4; ++m) {
                    bf16_t* rowp = base + (size_t)(ai * 128 + m * 16) * PJW; const float sc = rs[ai][m];
#pragma unroll
                    for (int bj = 0; bj < 2; ++bj) *(u32x4*)(rowp + bj * 128) = pack8(acc[ai][bj][m][0] * sc, acc[ai][bj][m][1] * sc);
                }
        } else if (u.pn == 19) {
            if (wc < 2) {
                const float* kw = C.inp(19) + l * 64 + 8 * fq;
                const f32x4 k00 = *(const f32x4*)(kw), k01 = *(const f32x4*)(kw + 4), k10 = *(const f32x4*)(kw + 32), k11 = *(const f32x4*)(kw + 36);
#pragma unroll
                for (int ai = 0; ai < 2; ++ai)
#pragma unroll
                    for (int m = 0; m < 4; ++m) {
                        const int row = row0 + ai * 128 + m * 16; int sb, t; row_sbt(row, sb, t);
                        const float sc = rs[ai][m];
                        f32x4 a0 = acc[ai][0][m][0] * sc, a1 = acc[ai][0][m][1] * sc, b0 = acc[ai][1][m][0] * sc, b1 = acc[ai][1][m][1] * sc;
                        float ss = 0.f;
#pragma unroll
                        for (int i = 0; i < 4; ++i) ss += (a0[i] * a0[i] + a1[i] * a1[i]) + (b0[i] * b0[i] + b1[i] * b1[i]);
                        ss = sum_fq(ss);
                        const float rn = rsqrtf(ss * (1.f / 64.f) + EPS);
                        a0 = a0 * rn * k00; a1 = a1 * rn * k01; b0 = b0 * rn * k10; b1 = b1 * rn * k11;
                        float* o = out_ak(C, l, sb) + (size_t)t * 128 + wc * 64 + 8 * fq;
                        *(f32x4*)(o) = a0; *(f32x4*)(o + 4) = a1; *(f32x4*)(o + 32) = b0; *(f32x4*)(o + 36) = b1;
                        bf16_t* kv = C.kvb(l) + kvb_off(sb) + (size_t)(sb_P(sb) + t) * KVW + wc * 64 + 8 * fq;
                        *(u32x4*)(kv) = pack8(a0, a1); *(u32x4*)(kv + 32) = pack8(b0, b1);
                    }
            } else {
                const int kvh = wc - 2;
#pragma unroll
                for (int ai = 0; ai < 2; ++ai)
#pragma unroll
                    for (int m = 0; m < 4; ++m) {
                        const int row = row0 + ai * 128 + m * 16; int sb, t; row_sbt(row, sb, t);
                        const float sc = rs[ai][m];
                        const f32x4 a0 = acc[ai][0][m][0] * sc, a1 = acc[ai][0][m][1] * sc, b0 = acc[ai][1][m][0] * sc, b1 = acc[ai][1][m][1] * sc;
                        float* o = out_av(C, l, sb) + (size_t)t * 128 + kvh * 64 + 8 * fq;
                        *(f32x4*)(o) = a0; *(f32x4*)(o + 4) = a1; *(f32x4*)(o + 32) = b0; *(f32x4*)(o + 36) = b1;
                        bf16_t* kv = C.kvb(l) + kvb_off(sb) + (size_t)(sb_P(sb) + t) * KVW + 128 + kvh * 64 + 8 * fq;
                        *(u32x4*)(kv) = pack8(a0, a1); *(u32x4*)(kv + 32) = pack8(b0, b1);
                    }
            }
        } else {
#pragma unroll
            for (int ai = 0; ai < 2; ++ai)
#pragma unroll
                for (int m = 0; m < 4; ++m) {
                    const int row = row0 + ai * 128 + m * 16; int sb, t; row_sbt(row, sb, t);
                    const float sc = rs[ai][m];
                    const f32x4 a0 = acc[ai][0][m][0] * sc, a1 = acc[ai][0][m][1] * sc;
                    if (wc < 2) {
                        const int d = 32 * wc + 8 * fq;
                        float* o = out_ik(C, l, sb) + (size_t)t * 64 + d;
                        *(f32x4*)(o) = a0; *(f32x4*)(o + 4) = a1;
                        *(u32x4*)(C.kvb(l) + kvb_off(sb) + (size_t)(sb_P(sb) + t) * KVW + 256 + d) = pack8(a0, a1);
                    } else if (wc == 2) {
                        if (fq == 0) { *(f32x4*)(C.wi() + (size_t)row * 4) = a0; *(f32x4*)(C.dtr() + (size_t)row * 16) = a1; }
                        else if (fq == 1) { *(f32x4*)(C.dtr() + (size_t)row * 16 + 4) = a0; *(f32x4*)(C.dtr() + (size_t)row * 16 + 8) = a1; }
                        else if (fq == 2) { *(f32x4*)(C.dtr() + (size_t)row * 16 + 12) = a0; }
                    }
                }
        }
    }
};
constexpr int LDS_GNT = 131072;
struct EpiOut {
    static constexpr bool PERM = false, AFTER_DRAIN = false, KSCALE = true; static constexpr int KS_T0 = 16, KS_T1 = 24;
    Ctx C; int l, pm0, pn0;
    DI void kscale(f32x4 (&acc)[2][2][4][2], int ui, int t, int wr, int fr) const {
        const LAS f32x4* tab = (const LAS f32x4*)(C.lds + LDS_GNT) + (ui & 1) * 256;
#pragma unroll
        for (int ai = 0; ai < 2; ++ai)
#pragma unroll
            for (int m = 0; m < 4; ++m) {
                const f32x4 f4 = tab[ai * 128 + wr * 64 + m * 16 + fr]; const float f = (t == KS_T0) ? f4[0] : f4[1];
#pragma unroll
                for (int bj = 0; bj < 2; ++bj)
#pragma unroll
                    for (int n = 0; n < 2; ++n) acc[ai][bj][m][n] = acc[ai][bj][m][n] * f;
            }
    }
    DI void operator()(const f32x4 (&acc)[2][2][4][2], const pg8::Unit& u, int wr, int wc, int fr, int fq) const {
        const int row0 = u.pm * 256 + wr * 64 + fr, col0 = u.pn * 256 + wc * 32 + 4 * fq;
        const LAS f32x4* tab = (const LAS f32x4*)(C.lds + LDS_GNT) + ((u.pm == pm0 && u.pn == pn0) ? 0 : 256);
#pragma unroll
        for (int ai = 0; ai < 2; ++ai)
#pragma unroll
            for (int m = 0; m < 4; ++m) {
                const int row = row0 + ai * 128 + m * 16;
                const float r1 = tab[ai * 128 + wr * 64 + m * 16 + fr][2];
                const float* xres = (l == 0) ? ((row < ROWS_P) ? C.inp(0) + (size_t)row * DM : C.inp(1) + (size_t)(row - ROWS_P) * DM) : C.out + (size_t)row * DM;
                float ss = 0.f;
#pragma unroll
                for (int bj = 0; bj < 2; ++bj)
#pragma unroll
                    for (int n = 0; n < 2; ++n) {
                        const int col = col0 + bj * 128 + n * 16;
                        const f32x4 v = *(const f32x4*)(xres + col) + acc[ai][bj][m][n] * r1;
                        *(f32x4*)(C.out + (size_t)row * DM + col) = v;
                        if (l == 0) {
                            u32x2 w; w.x = cvt_pk_bf16(v[0], v[1]); w.y = cvt_pk_bf16(v[2], v[3]);
                            *(u32x2*)(C.hb() + (size_t)row * DM + col) = w;
                            ss += (v[0] * v[0] + v[1] * v[1]) + (v[2] * v[2] + v[3] * v[3]);
                        }
                    }
                if (l == 0) {
                    ss = sum_fq(ss);
                    if (fq == 0) C.rss()[(size_t)row * 16 + u.pn * 4 + wc] = ss;
                }
            }
    }
};
DI void phase_inproj_gemm(const Ctx& C, int l) {
    pg8::Gemm g{C.hb(), C.win(l), ROWS, NPAD, DM, DM};
    pg8::StaticOrder S; S.init(ROWS, NPAD, C.G, C.bid);
    EpiIn E{C, l};
    pg8::gemm_phase<EpiIn, pg8::StaticOrder, true, true>(C.lds, g, S, E, C.tid);
}
DI void outproj_tail_item(const Ctx& C, int l, int rt, int g);
DI void prep_layer(const Ctx& C, int l, int part, int nparts);
DI void prep_cache(const Ctx& C, int l, int part, int nparts);
DI void phase_outproj_gemm(const Ctx& C, int l) {
    for (int i = C.bid * NTHREADS + C.tid; i < NSB * 3 * 1536; i += C.G * NTHREADS) {
        const int sb = i / (3 * 1536), j = (i / 1536) % 3, ch = i % 1536;
        out_sc(C, l, sb)[j * 1536 + ch] = bf2f(C.proj()[(size_t)(sb_row0(sb) + sb_T(sb) - 3 + j) * PJW + C_XBC + ch]);
    }
    for (int i = C.bid * NTHREADS + C.tid; i < NSB * 3 * 512; i += C.G * NTHREADS) {
        const int sb = i / (3 * 512), j = (i / 512) % 3, ch = i % 512;
        out_lc(C, l, sb)[j * 512 + ch] = bf2f(C.proj()[(size_t)(sb_row0(sb) + sb_T(sb) - 3 + j) * PJW + C_XL + ch]);
    }
    if (C.bid < 256) outproj_tail_item(C, l, ROWS_P / 32 + (C.bid >> 4), C.bid & 15);
    if (l == 0) prep_cache(C, 1, C.bid, C.G);
    __syncthreads();
    pg8::Gemm g{C.proj(), C.wout(l), ROWS_P, DM, DMIX, PJW};
    pg8::StaticOrder S; S.init(ROWS_P, DM, C.G, C.bid);
    pg8::Unit u0{0, 0}, uu;
    (void)S.next(0, u0);
    { const int ui = C.tid >> 8, row = C.tid & 255;
      if (S.next(ui, uu)) {
          const float* p = C.ssq() + (size_t)(uu.pm * 256 + row) * 64; float s0 = 0.f, s1 = 0.f;
#pragma unroll
          for (int j = 0; j < 8; ++j) { const f32x4 a = *(const f32x4*)(p + 4 * j), b = *(const f32x4*)(p + 32 + 4 * j); s0 += (a[0] + a[1]) + (a[2] + a[3]); s1 += (b[0] + b[1]) + (b[2] + b[3]); }
          const float q0 = s0 * (1.f / 512.f) + EPS, q1 = s1 * (1.f / 512.f) + EPS, r0 = rsqrtf(q0), r1 = rsqrtf(q1);
          f32x4 f; f[0] = sqrtf(q0); f[1] = r0 * sqrtf(q1); f[2] = r1; f[3] = 0.f;
          ((LAS f32x4*)(C.lds + LDS_GNT))[ui * 256 + row] = f;
      } }
    __syncthreads();
    EpiOut E{C, l, u0.pm, u0.pn};
    pg8::gemm_phase<EpiOut, pg8::StaticOrder, true, true>(C.lds, g, S, E, C.tid);
}
template <int MODE>
DI void p0_transpose_item(const Ctx& C, const float* W, const float* scale, int K, int Nsrc, int Ndst, bf16_t* WT, LAS float* scr, int item) {
    const int lane = C.lane, nblk = Ndst / 64, kb = item / nblk, nb = item % nblk, k0 = 64 * kb, n0 = 64 * nb;
    const int cgp = lane & 15, kq = lane >> 4;
    const int ncol = n0 + 4 * cgp;
    const int src = (MODE == 0) ? orig_col(ncol) : ncol;
#pragma unroll 8
    for (int i = 0; i < 16; ++i) {
        const int kk = 4 * i + kq, k = k0 + kk;
        f32x4 v = (f32x4){0.f, 0.f, 0.f, 0.f};
        if (src >= 0) {
            v = *(const f32x4*)(W + (size_t)k * Nsrc + src);
            const float sc = (MODE == 0) ? scale[k] : (k >= 1024 ? scale[k - 1024] : 1.f);
            v = v * sc;
        }
        scr[(4 * cgp + 0) * 65 + kk] = v[0]; scr[(4 * cgp + 1) * 65 + kk] = v[1]; scr[(4 * cgp + 2) * 65 + kk] = v[2]; scr[(4 * cgp + 3) * 65 + kk] = v[3];
    }
    LDS_FENCE();
    const LAS float* sr = scr + lane * 65;
    bf16_t* orow = WT + (size_t)(n0 + lane) * K + k0;
#pragma unroll
    for (int j = 0; j < 8; ++j) {
        u32x4 o; o.x = cvt_pk_bf16(sr[8 * j], sr[8 * j + 1]); o.y = cvt_pk_bf16(sr[8 * j + 2], sr[8 * j + 3]); o.z = cvt_pk_bf16(sr[8 * j + 4], sr[8 * j + 5]); o.w = cvt_pk_bf16(sr[8 * j + 6], sr[8 * j + 7]);
        *(u32x4*)(orow + 8 * j) = o;
    }
    LDS_FENCE();
}
DI void prep_layer(const Ctx& C, int l, int part, int nparts) {
    LAS float* scr = (LAS float*)(C.lds + C.wave * 16640);
    const int gw = part * NWAVES + C.wave, NGW = nparts * NWAVES;
    constexpr int I_IN = (DM / 64) * (NPAD / 64), I_OUT = (DMIX / 64) * (DM / 64);
    for (int it = gw; it < I_IN + I_OUT; it += NGW) {
        if (it < I_IN) p0_transpose_item<0>(C, C.inp(10) + (size_t)l * DM * DINP, C.inp(9) + l * DM, DM, DINP, NPAD, C.win(l), scr, it);
        else p0_transpose_item<1>(C, C.inp(27) + (size_t)l * DMIX * DM, C.inp(26) + l * 1024, DMIX, DM, DM, C.wout(l), scr, it - I_IN);
    }
}
DI void prep_cache(const Ctx& C, int l, int part, int nparts) {
    const int gw = part * NWAVES + C.wave, NGW = nparts * NWAVES;
    for (int it = gw; it < NSB_S * PAST / 4; it += NGW) {
        const int b = it / (PAST / 4), pos0 = 4 * (it % (PAST / 4));
#pragma unroll
        for (int j = 0; j < 5; ++j) {
            const int pc = C.lane + 64 * j, pp = pc / 80, q = pc % 80, pos = pos0 + pp;
            const size_t base = ((size_t)(l * NSB_S + b) * PAST + pos);
            const f32x4 v = (q < 32) ? *(const f32x4*)(C.inp(2) + base * 128 + 4 * q) : (q < 64 ? *(const f32x4*)(C.inp(3) + base * 128 + 4 * (q - 32)) : *(const f32x4*)(C.inp(4) + base * 64 + 4 * (q - 64)));
            u32x2 o; o.x = cvt_pk_bf16(v[0], v[1]); o.y = cvt_pk_bf16(v[2], v[3]);
            *(u32x2*)(C.kvb(l) + kvb_off(NPB + b) + (size_t)pos * KVW + 4 * q) = o;
        }
    }
}
DI void phase_prologue(const Ctx& C) {
    prep_layer(C, 0, C.bid, C.G); prep_cache(C, 0, C.bid, C.G);
    const int gw = C.bid * NWAVES + C.wave, NGW = C.G * NWAVES;
    for (int m0 = 4 * gw; m0 < ROWS; m0 += 4 * NGW) {
        f32x4 v[4][4];
#pragma unroll
        for (int rr = 0; rr < 4; ++rr) { const int m = m0 + rr; const float* xr = (m < ROWS_P) ? C.inp(0) + (size_t)m * DM : C.inp(1) + (size_t)(m - ROWS_P) * DM;
#pragma unroll
            for (int j = 0; j < 4; ++j) v[rr][j] = *(const f32x4*)(xr + 4 * C.lane + 256 * j); }
#pragma unroll
        for (int rr = 0; rr < 4; ++rr) { const int m = m0 + rr; float ss = 0.f;
#pragma unroll
            for (int j = 0; j < 4; ++j) { const f32x4 x = v[rr][j]; ss += (x[0] * x[0] + x[1] * x[1]) + (x[2] * x[2] + x[3] * x[3]);
                u32x2 o; o.x = cvt_pk_bf16(x[0], x[1]); o.y = cvt_pk_bf16(x[2], x[3]); *(u32x2*)(C.hb() + (size_t)m * DM + 4 * C.lane + 256 * j) = o; }
            ss = wave_sum(ss);
            if (C.lane < 16) C.rss()[(size_t)m * 16 + C.lane] = (C.lane == 0) ? ss : 0.f; }
    }
}

#define MFMA32(a, b, c) __builtin_amdgcn_mfma_f32_32x32x16_bf16((a), (b), (c), 0, 0, 0)
DI void outproj_tail_item(const Ctx& C, int l, int rt, int g) {
    const int lane = C.lane, wave = C.wave, r = lane & 31, h = lane >> 5;
    const bf16_t* WO = C.wout(l); const bf16_t* PJ = C.proj();
    const int m0 = rt * 32, c0 = 64 * g, c1 = c0 + 32, kbeg = 256 * wave;
    f32x16 a0, a1;
#pragma unroll
    for (int i = 0; i < 16; ++i) { a0[i] = 0.f; a1[i] = 0.f; }
    const bf16_t* Ap = PJ + (size_t)(m0 + r) * PJW + 8 * h + kbeg;
    const bf16_t* B0 = WO + (size_t)(c0 + r) * DMIX + 8 * h + kbeg;
    const bf16_t* B1 = WO + (size_t)(c1 + r) * DMIX + 8 * h + kbeg;
#pragma unroll 8
    for (int k0 = 0; k0 < 256; k0 += 16) { const bf16x8 a = *(const bf16x8*)(Ap + k0); a0 = MFMA32(a, *(const bf16x8*)(B0 + k0), a0); a1 = MFMA32(a, *(const bf16x8*)(B1 + k0), a1); }
    LAS float* part = (LAS float*)C.lds;
#pragma unroll
    for (int i = 0; i < 16; ++i) { part[((wave * 2 + 0) * 16 + i) * 64 + lane] = a0[i]; part[((wave * 2 + 1) * 16 + i) * 64 + lane] = a1[i]; }
    __syncthreads();
    if (wave == 0) {
        float r0, r1; { const float* p = C.ssq() + (size_t)(m0 + r) * 64; float s0 = 0.f, s1 = 0.f;
#pragma unroll
            for (int j = 0; j < 32; ++j) { s0 += p[j]; s1 += p[32 + j]; }
            r0 = rsqrtf(s0 * (1.f / 512.f) + EPS); r1 = rsqrtf(s1 * (1.f / 512.f) + EPS); }
#pragma unroll
        for (int reg = 0; reg < 16; ++reg) {
            const int rowl = crow(reg, h), m = m0 + rowl;
            const float g0 = bperm(r0, rowl), g1 = bperm(r1, rowl);
            float sab[2], sc0[2], sc1[2];
#pragma unroll
            for (int t = 0; t < 2; ++t) {
                sab[t] = (part[((0 * 2 + t) * 16 + reg) * 64 + lane] + part[((1 * 2 + t) * 16 + reg) * 64 + lane]) + (part[((2 * 2 + t) * 16 + reg) * 64 + lane] + part[((3 * 2 + t) * 16 + reg) * 64 + lane]);
                sc0[t] = part[((4 * 2 + t) * 16 + reg) * 64 + lane] + part[((5 * 2 + t) * 16 + reg) * 64 + lane];
                sc1[t] = part[((6 * 2 + t) * 16 + reg) * 64 + lane] + part[((7 * 2 + t) * 16 + reg) * 64 + lane];
            }
            const float* xres = (l == 0) ? ((m < ROWS_P) ? C.inp(0) + (size_t)m * DM : C.inp(1) + (size_t)(m - ROWS_P) * DM) : C.out + (size_t)m * DM;
            const float v0 = xres[c0 + r] + sab[0] + g0 * sc0[0] + g1 * sc1[0];
            const float v1 = xres[c1 + r] + sab[1] + g0 * sc0[1] + g1 * sc1[1];
            C.out[(size_t)m * DM + c0 + r] = v0; C.out[(size_t)m * DM + c1 + r] = v1;
            if (l == 0) {
                C.hb()[(size_t)m * DM + c0 + r] = f2bf(v0); C.hb()[(size_t)m * DM + c1 + r] = f2bf(v1);
                const float ss = half_sum32(v0 * v0 + v1 * v1);
                if (r == 0) C.rss()[(size_t)m * 16 + g] = ss;
            }
        }
    }
    __syncthreads();
}

constexpr int SS_XST = 0;
constexpr int SS_BM = SS_XST + 64 * 144;
constexpr int SS_CM = SS_BM + 64 * 272;
constexpr int SS_BWT = SS_CM + 64 * 272;
constexpr int SS_HA = SS_BWT + 128 * 144;
constexpr int SS_SCAL = SS_HA + 2 * 64 * 272;
constexpr int SS_CW = SS_SCAL + 2 * 1024;
constexpr int SS_RAW = SS_CW + 5 * 320 * 4;
constexpr int SS_Z = SS_RAW + 67 * 640;
constexpr int SS_WT = SS_Z + 8192;
constexpr int SS_END = SS_WT + 3 * 2048;
static_assert(SS_END <= LDS_BYTES - 256, "SSD LDS map");
typedef short s16x4 __attribute__((ext_vector_type(4)));
DI float fast_silu(float x) { return x * __builtin_amdgcn_rcpf(1.f + __builtin_amdgcn_exp2f(-1.4426950408889634f * x)); }
DI bf16x8 lds_frag(const LAS unsigned char* base, int row, int rowbytes, int col) { return *(const LAS bf16x8*)(base + row * rowbytes + col * 2); }

DI void ssd_item(const Ctx& C, int l, int sb, int hd) {
    const int tid = C.tid, lane = C.lane, wave = C.wave, r = lane & 31, h = lane >> 5;
    const int T = sb_T(sb), row0 = sb_row0(sb), g = hd >> 3, NC = T / 64;
    LAS unsigned char* L = C.lds;
    bf16_t* PJ = C.proj();
    const float aneg = -expf(C.inp(24)[l * 16 + hd]), dtb = C.inp(23)[l * 16 + hd], Dh = C.inp(25)[l * 16 + hd];
    const int cg = 0, seg = 0; (void)cg; (void)seg;
    int colbase, cch;
    if (cg < 8) { cch = hd * 64 + 8 * cg; } else if (cg < 24) { cch = 1024 + g * 128 + 8 * (cg - 8); } else { cch = 1280 + g * 128 + 8 * (cg - 24); }
    colbase = C_XBC + cch;
    for (int i = tid; i < 5 * 320; i += NTHREADS) {
        const int j = i / 320, c = i % 320, cg2 = c >> 3, e = c & 7;
        const int ch = (cg2 < 8) ? hd * 64 + 8 * cg2 + e : (cg2 < 24 ? 1024 + g * 128 + 8 * (cg2 - 8) + e : 1280 + g * 128 + 8 * (cg2 - 24) + e);
        ((LAS float*)(L + SS_CW))[i] = (j < 4) ? C.inp(21)[((size_t)l * 4 + j) * 1536 + ch] : C.inp(22)[l * 1536 + ch];
    }
    const int sj = wave - 4, sph = sj & 1, nq0 = 2 * (sj >> 1);
    f32x16 hacc0, hacc1;
#pragma unroll
    for (int i = 0; i < 16; ++i) { hacc0[i] = 0.f; hacc1[i] = 0.f; }
    if (wave >= 4) {
        if (sb >= NPB) {
            const float* st = C.inp(8) + (((size_t)(l * NSB_S + sb - NPB) * 16 + hd) * 64 + 32 * sph + r) * 128;
#pragma unroll
            for (int gq = 0; gq < 4; ++gq) {
                const f32x4 v0 = *(const f32x4*)(st + 32 * nq0 + 8 * gq + 4 * h), v1 = *(const f32x4*)(st + 32 * (nq0 + 1) + 8 * gq + 4 * h);
#pragma unroll
                for (int e = 0; e < 4; ++e) { hacc0[4 * gq + e] = v0[e]; hacc1[4 * gq + e] = v1[e]; }
            }
        }
#pragma unroll
        for (int gq = 0; gq < 4; ++gq) {
            u32x2 w0, w1; w0.x = cvt_pk_bf16(hacc0[4 * gq], hacc0[4 * gq + 1]); w0.y = cvt_pk_bf16(hacc0[4 * gq + 2], hacc0[4 * gq + 3]);
            w1.x = cvt_pk_bf16(hacc1[4 * gq], hacc1[4 * gq + 1]); w1.y = cvt_pk_bf16(hacc1[4 * gq + 2], hacc1[4 * gq + 3]);
            *(LAS u32x2*)(L + SS_HA + (32 * sph + r) * 272 + (32 * nq0 + 8 * gq + 4 * h) * 2) = w0;
            *(LAS u32x2*)(L + SS_HA + (32 * sph + r) * 272 + (32 * (nq0 + 1) + 8 * gq + 4 * h) * 2) = w1;
        }
    }
    const int yph = wave & 1, ylh = (wave >> 1) & 1;
#define SSD_DMA_RAW(cc) do { const int t0_ = 64 * (cc); \
        for (int k_ = wave; k_ < 42; k_ += NWAVES) { \
            const int q_ = 64 * k_ + lane, rr_ = q_ / 40, pc_ = q_ - 40 * rr_, t_ = t0_ - 3 + rr_; \
            const int col_ = C_XBC + ((pc_ < 8) ? hd * 64 + 8 * pc_ : (pc_ < 24 ? 1024 + g * 128 + 8 * (pc_ - 8) : 1280 + g * 128 + 8 * (pc_ - 24))); \
            if (q_ < 2680 && t_ >= 0) __builtin_amdgcn_global_load_lds((const unsigned*)(PJ + (size_t)(row0 + t_) * PJW + col_), (LAS unsigned*)(L + SS_RAW + k_ * 1024), 16, 0, 0); } \
    } while (0)
#define SSD_DMA_Z(cc) do { const int t0_ = 64 * (cc); \
        if (wave < 4) { _Pragma("unroll") for (int k_ = 0; k_ < 2; ++k_) { const int rr_ = 16 * k_ + (lane >> 2), pc_ = lane & 3; \
            __builtin_amdgcn_global_load_lds((const unsigned*)(PJ + (size_t)(row0 + t0_ + 32 * ylh + rr_) * PJW + C_Z + hd * 64 + 32 * yph + 8 * pc_), \
                                             (LAS unsigned*)(L + SS_Z + (2 * yph + ylh) * 2048 + k_ * 1024), 16, 0, 0); } } \
    } while (0)
    if (tid < 120) {
        const int rr = tid / 40, pc = tid % 40;
        const int ch = (pc < 8) ? hd * 64 + 8 * pc : (pc < 24 ? 1024 + g * 128 + 8 * (pc - 8) : 1280 + g * 128 + 8 * (pc - 24));
        u32x4 v = (u32x4){0u, 0u, 0u, 0u};
        if (sb >= NPB) { const float* st = C.inp(7) + ((size_t)(l * NSB_S + sb - NPB) * 3 + rr) * 1536 + ch; v = pack8(*(const f32x4*)st, *(const f32x4*)(st + 4)); }
        *(LAS u32x4*)(L + SS_RAW + rr * 640 + pc * 16) = v;
    }
#define SSD_S0V(cc, raw) do { LAS float* SC_ = (LAS float*)(L + SS_SCAL + ((cc) & 1) * 1024); \
        const float dt_ = softplus_f((raw) + dtb); float x_ = dt_ * aneg; \
        _Pragma("unroll") for (int o_ = 1; o_ < 64; o_ <<= 1) { const float y_ = bperm(x_, lane - o_); if (lane >= o_) x_ += y_; } \
        const float c63_ = __int_as_float(__builtin_amdgcn_readlane(__float_as_int(x_), 63)); \
        SC_[lane] = x_; SC_[64 + lane] = dt_; SC_[128 + lane] = __builtin_amdgcn_exp2f(1.4426950408889634f * (c63_ - x_)) * dt_; SC_[192 + lane] = __builtin_amdgcn_exp2f(1.4426950408889634f * x_); } while (0)
    float dtr_nx = 0.f;
    if (wave == 7) { SSD_S0V(0, C.dtr()[(size_t)(row0 + lane) * 16 + hd]); if (NC > 1) dtr_nx = C.dtr()[(size_t)(row0 + 64 + lane) * 16 + hd]; }
    SSD_DMA_RAW(0); SSD_DMA_Z(0);
    int roff[6];
#pragma unroll
    for (int i = 0; i < 6; ++i) {
        const int k_ = wave + 8 * i, q_ = 64 * k_ + lane, rr_ = q_ / 40, pc_ = q_ - 40 * rr_;
        const int col_ = C_XBC + ((pc_ < 8) ? hd * 64 + 8 * pc_ : (pc_ < 24 ? 1024 + g * 128 + 8 * (pc_ - 8) : 1280 + g * 128 + 8 * (pc_ - 24)));
        roff[i] = (k_ < 42 && q_ < 2680) ? (rr_ * PJW + col_) * 2 : -1;
    }
    const unsigned zoff = (unsigned)(((32 * ylh + (lane >> 2)) * PJW + C_Z + hd * 64 + 32 * yph + 8 * (lane & 3)) * 2);
    const unsigned yoff = (unsigned)(((32 * ylh + r) * PJW + C_Z + hd * 64 + 32 * yph + 4 * h) * 2);
#define SSD_DMA_RAW_N(cc) do { const char* cb_ = (const char*)PJ + (size_t)(row0 + 64 * (cc) - 3) * (PJW * 2); \
        _Pragma("unroll") for (int i_ = 0; i_ < 6; ++i_) if (roff[i_] >= 0) \
            __builtin_amdgcn_global_load_lds((const unsigned*)(cb_ + (unsigned)roff[i_]), (LAS unsigned*)(L + SS_RAW + (wave + 8 * i_) * 1024), 16, 0, 0); } while (0)
#define SSD_DMA_Z_N(cc) do { const char* cb_ = (const char*)PJ + (size_t)(row0 + 64 * (cc)) * (PJW * 2); \
        _Pragma("unroll") for (int k_ = 0; k_ < 2; ++k_) \
            __builtin_amdgcn_global_load_lds((const unsigned*)(cb_ + zoff + (unsigned)(k_ * 16 * PJW * 2)), (LAS unsigned*)(L + SS_Z + (2 * yph + ylh) * 2048 + k_ * 1024), 16, 0, 0); } while (0)
    asm volatile("s_waitcnt vmcnt(0)" ::: "memory");
    __syncthreads();
    for (int c = 0; c < NC; ++c) {
        const int t0 = 64 * c, par = c & 1;
        LAS float* SC = (LAS float*)(L + SS_SCAL + par * 1024);
        PROBE_BEGIN(12);
        asm volatile("s_waitcnt vmcnt(0)" ::: "memory"); LDS_FENCE(); __syncthreads();
        if (l == 0) PROBE_END(12, C);
        PROBE_BEGIN(10);
        {
            const int njob = (wave < 4) ? 3 : 2;
#pragma unroll
            for (int jb = 0; jb < 3; ++jb) {
                if (jb < njob) {
                    const int pg = (wave < 4) ? (jb == 0 ? 0 : 2 + jb) : 1 + ((wave - 4) >> 1);
                    const int tb16 = (wave < 4) ? wave : 2 * ((wave - 4) & 1) + jb;
                    const int gp = 32 * pg + r, tk0 = 16 * tb16 + 8 * h;
                    const LAS float* CW = (const LAS float*)(L + SS_CW) + 2 * gp;
                    const float a0 = CW[0], a1 = CW[320], a2 = CW[640], a3 = CW[960], ab = CW[1280];
                    const float b0 = CW[1], b1 = CW[321], b2 = CW[641], b3 = CW[961], bb = CW[1281];
                    float xa[11], xb[11];
#pragma unroll
                    for (int i = 0; i < 11; ++i) { const unsigned w = *(const LAS unsigned*)(L + SS_RAW + (tk0 + i) * 640 + 4 * gp); xa[i] = __uint_as_float(w << 16); xb[i] = __uint_as_float(w & 0xffff0000u); }
                    float ta[8], tc[8];
#pragma unroll
                    for (int j = 0; j < 8; ++j) {
                        ta[j] = fast_silu(ab + a0 * xa[j] + a1 * xa[j + 1] + a2 * xa[j + 2] + a3 * xa[j + 3]);
                        tc[j] = fast_silu(bb + b0 * xb[j] + b1 * xb[j + 1] + b2 * xb[j + 2] + b3 * xb[j + 3]);
                    }
                    if (pg == 0) {
                        u32x4 wa, wb;
                        wa.x = cvt_pk_bf16(ta[0], ta[1]); wa.y = cvt_pk_bf16(ta[2], ta[3]); wa.z = cvt_pk_bf16(ta[4], ta[5]); wa.w = cvt_pk_bf16(ta[6], ta[7]);
                        wb.x = cvt_pk_bf16(tc[0], tc[1]); wb.y = cvt_pk_bf16(tc[2], tc[3]); wb.z = cvt_pk_bf16(tc[4], tc[5]); wb.w = cvt_pk_bf16(tc[6], tc[7]);
                        *(LAS u32x4*)(L + SS_XST + (2 * gp) * 144 + tk0 * 2) = wa; *(LAS u32x4*)(L + SS_XST + (2 * gp + 1) * 144 + tk0 * 2) = wb;
                    } else {
                        const bool isB = (pg < 3);
                        const int n0 = isB ? 2 * (gp - 32) : 2 * (gp - 96);
                        LAS unsigned char* img = L + (isB ? SS_BM : SS_CM);
#pragma unroll
                        for (int j = 0; j < 8; ++j) *(LAS unsigned*)(img + (tk0 + j) * 272 + n0 * 2) = cvt_pk_bf16(ta[j], tc[j]);
                        if (isB) {
                            float te[8];
#pragma unroll
                            for (int j = 0; j < 8; ++j) te[j] = SC[128 + tk0 + j];
                            u32x4 wa, wb;
                            wa.x = cvt_pk_bf16(ta[0] * te[0], ta[1] * te[1]); wa.y = cvt_pk_bf16(ta[2] * te[2], ta[3] * te[3]); wa.z = cvt_pk_bf16(ta[4] * te[4], ta[5] * te[5]); wa.w = cvt_pk_bf16(ta[6] * te[6], ta[7] * te[7]);
                            wb.x = cvt_pk_bf16(tc[0] * te[0], tc[1] * te[1]); wb.y = cvt_pk_bf16(tc[2] * te[2], tc[3] * te[3]); wb.z = cvt_pk_bf16(tc[4] * te[4], tc[5] * te[5]); wb.w = cvt_pk_bf16(tc[6] * te[6], tc[7] * te[7]);
                            *(LAS u32x4*)(L + SS_BWT + n0 * 144 + tk0 * 2) = wa; *(LAS u32x4*)(L + SS_BWT + (n0 + 1) * 144 + tk0 * 2) = wb;
                        }
                    }
                }
            }
        }
        if (l == 0) PROBE_END(10, C);
        PROBE_BEGIN(13);
        LDS_FENCE(); __syncthreads();
        if (l == 0) PROBE_END(13, C);
        PROBE_BEGIN(11);
        if (c + 1 < NC) SSD_DMA_RAW_N(c + 1);
        if (wave < 4) {
            const LAS unsigned char* HAc = L + SS_HA + par * (64 * 272);
            const float ecl = SC[192 + 32 * ylh + r];
            f32x16 ya;
#pragma unroll
            for (int i = 0; i < 16; ++i) ya[i] = 0.f;
#pragma unroll
            for (int ks = 0; ks < 8; ++ks) ya = MFMA32(lds_frag(HAc, 32 * yph + r, 272, 16 * ks + 8 * h), lds_frag(L + SS_CM, 32 * ylh + r, 272, 16 * ks + 8 * h), ya);
#pragma unroll
            for (int i = 0; i < 16; ++i) ya[i] *= ecl;
            LDS_FENCE(); __syncthreads();
#pragma unroll
            for (int sh = 0; sh < 2; ++sh) {
                if (sh <= ylh) {
#pragma unroll
                    for (int s2 = 0; s2 < 2; ++s2) {
                        const LAS unsigned char* xp = L + SS_XST + (32 * yph + r) * 144 + (32 * sh + 16 * s2 + 4 * h) * 2;
                        const u32x2 lo = *(const LAS u32x2*)(xp), hi = *(const LAS u32x2*)(xp + 16);
                        u32x4 a; a.x = lo.x; a.y = lo.y; a.z = hi.x; a.w = hi.y;
                        const bf16x8 wf = *(const LAS bf16x8*)(L + SS_WT + (sh + ylh) * 2048 + s2 * 1024 + lane * 16);
                        ya = MFMA32(__builtin_bit_cast(bf16x8, a), wf, ya);
                    }
                }
            }
            float ss = 0.f;
            bf16_t* zp = (bf16_t*)((char*)PJ + (size_t)(row0 + t0) * (PJW * 2) + yoff);
#pragma unroll
            for (int gq = 0; gq < 4; ++gq) {
                const u32x2 zz = *(const LAS u32x2*)(L + SS_Z + (2 * yph + ylh) * 2048 + r * 64 + (8 * gq + 4 * h) * 2);
                const float z0 = __uint_as_float(zz.x << 16), z1 = __uint_as_float(zz.x & 0xffff0000u), z2 = __uint_as_float(zz.y << 16), z3 = __uint_as_float(zz.y & 0xffff0000u);
                const float y0 = ya[4 * gq] * fast_silu(z0), y1 = ya[4 * gq + 1] * fast_silu(z1), y2 = ya[4 * gq + 2] * fast_silu(z2), y3 = ya[4 * gq + 3] * fast_silu(z3);
                ss += (y0 * y0 + y1 * y1) + (y2 * y2 + y3 * y3);
                u32x2 w; w.x = cvt_pk_bf16(y0, y1); w.y = cvt_pk_bf16(y2, y3);
                *(u32x2*)(zp + 8 * gq) = w;
            }
            ss = xor32_sum(ss);
            if (h == 0) { float* q = C.ssq() + (size_t)(row0 + t0 + 32 * ylh + r) * 64 + hd * 4 + yph; q[0] = ss; q[2] = 0.f; }
            LDS_FENCE();
            if (c + 1 < NC) SSD_DMA_Z_N(c + 1);
        } else {
            if (wave == 7) { if (c + 1 < NC) { const float raw_ = dtr_nx; if (c + 2 < NC) dtr_nx = C.dtr()[(size_t)(row0 + 64 * (c + 2) + lane) * 16 + hd]; SSD_S0V(c + 1, raw_); } }
            else {
                const int gt = wave - 4, gsh = gt >> 1, glh = (gt + 1) >> 1;
                const float cuml = SC[32 * glh + r];
                f32x16 ga;
#pragma unroll
                for (int i = 0; i < 16; ++i) ga[i] = 0.f;
#pragma unroll
                for (int ks = 0; ks < 8; ++ks) ga = MFMA32(lds_frag(L + SS_BM, 32 * gsh + r, 272, 16 * ks + 8 * h), lds_frag(L + SS_CM, 32 * glh + r, 272, 16 * ks + 8 * h), ga);
                float wv[16];
#pragma unroll
                for (int reg = 0; reg < 16; ++reg) {
                    const int s_ = 32 * gsh + crow(reg, h), ll = 32 * glh + r;
                    const f32x4 cs4 = *(const LAS f32x4*)(SC + 32 * gsh + 8 * (reg >> 2) + 4 * h), ds4 = *(const LAS f32x4*)(SC + 64 + 32 * gsh + 8 * (reg >> 2) + 4 * h);
                    const float cs = cs4[reg & 3], ds = ds4[reg & 3];
                    float w = (s_ <= ll) ? ga[reg] * __builtin_amdgcn_exp2f(1.4426950408889634f * (cuml - cs)) * ds : 0.f;
                    if (s_ == ll) w += Dh;
                    wv[reg] = w;
                }
#pragma unroll
                for (int s2 = 0; s2 < 2; ++s2) {
                    u32x4 p; p.x = cvt_pk_bf16(wv[8 * s2], wv[8 * s2 + 1]); p.y = cvt_pk_bf16(wv[8 * s2 + 2], wv[8 * s2 + 3]); p.z = cvt_pk_bf16(wv[8 * s2 + 4], wv[8 * s2 + 5]); p.w = cvt_pk_bf16(wv[8 * s2 + 6], wv[8 * s2 + 7]);
                    *(LAS u32x4*)(L + SS_WT + gt * 2048 + s2 * 1024 + lane * 16) = p;
                }
            }
            LDS_FENCE(); __syncthreads();
            const float decay = SC[192 + 63];
#pragma unroll
            for (int i = 0; i < 16; ++i) { hacc0[i] *= decay; hacc1[i] *= decay; }
#pragma unroll
            for (int ks = 0; ks < 4; ++ks) {
                const bf16x8 xb = lds_frag(L + SS_XST, 32 * sph + r, 144, 16 * ks + 8 * h);
                hacc0 = MFMA32(lds_frag(L + SS_BWT, 32 * nq0 + r, 144, 16 * ks + 8 * h), xb, hacc0);
                hacc1 = MFMA32(lds_frag(L + SS_BWT, 32 * (nq0 + 1) + r, 144, 16 * ks + 8 * h), xb, hacc1);
            }
            LAS unsigned char* HAn = L + SS_HA + (par ^ 1) * (64 * 272);
#pragma unroll
            for (int gq = 0; gq < 4; ++gq) {
                u32x2 w0, w1; w0.x = cvt_pk_bf16(hacc0[4 * gq], hacc0[4 * gq + 1]); w0.y = cvt_pk_bf16(hacc0[4 * gq + 2], hacc0[4 * gq + 3]);
                w1.x = cvt_pk_bf16(hacc1[4 * gq], hacc1[4 * gq + 1]); w1.y = cvt_pk_bf16(hacc1[4 * gq + 2], hacc1[4 * gq + 3]);
                *(LAS u32x2*)(HAn + (32 * sph + r) * 272 + (32 * nq0 + 8 * gq + 4 * h) * 2) = w0;
                *(LAS u32x2*)(HAn + (32 * sph + r) * 272 + (32 * (nq0 + 1) + 8 * gq + 4 * h) * 2) = w1;
            }
        }
        if (l == 0) PROBE_END(11, C);
    }
    if (wave >= 4) {
        float* o = out_sh(C, l, sb) + ((size_t)hd * 64 + 32 * sph + r) * 128;
#pragma unroll
        for (int gq = 0; gq < 4; ++gq) {
            f32x4 v0, v1;
#pragma unroll
            for (int e = 0; e < 4; ++e) { v0[e] = hacc0[4 * gq + e]; v1[e] = hacc1[4 * gq + e]; }
            *(f32x4*)(o + 32 * nq0 + 8 * gq + 4 * h) = v0; *(f32x4*)(o + 32 * (nq0 + 1) + 8 * gq + 4 * h) = v1;
        }
    }
    __syncthreads();
#undef SSD_DMA_RAW
#undef SSD_DMA_Z
#undef SSD_S0V
#undef SSD_DMA_RAW_N
#undef SSD_DMA_Z_N
}

DI unsigned mono_key(float f) { const unsigned u = __float_as_uint(f); return (u & 0x80000000u) ? ~u : (u | 0x80000000u); }
DI int t5_bucket(int rel) {
    const int n = rel < 0 ? -rel : rel; int b;
    if (n < 8) b = n; else if (n < 12) b = 8; else if (n < 16) b = 9; else if (n < 23) b = 10; else if (n < 32) b = 11; else if (n < 46) b = 12; else if (n < 64) b = 13; else if (n < 91) b = 14; else b = 15;
    return b + (rel > 0 ? 16 : 0);
}
constexpr int AT_MASK = 0;
constexpr int AT_TMASK = AT_MASK + 64 * 65 * 4;
constexpr int AT_QST = AT_TMASK + 64 * 65 * 4;
constexpr int AT_MISC = AT_QST + 1024;
constexpr int AT_LUT = AT_MISC + 64;
constexpr int AT_HIST = AT_LUT + 8192;
constexpr int AT_RING = AT_HIST;
constexpr int AT_QI = AT_HIST + 65792;
constexpr int AT_END = AT_QI + 64 * 528;
static_assert(AT_END <= LDS_BYTES - 256 && AT_RING + 65536 <= AT_END, "attention LDS map");
typedef short v4i16_t __attribute__((ext_vector_type(4)));
DI float max3f(float a, float b, float c) { float r; asm("v_max3_f32 %0, %1, %2, %3" : "=v"(r) : "v"(a), "v"(b), "v"(c)); return r; }
#define AT_WAIT_V(n) asm volatile("s_waitcnt vmcnt(" #n ")" ::: "memory")
#define AT_BAR() do { asm volatile("s_waitcnt lgkmcnt(0)" ::: "memory"); __builtin_amdgcn_s_barrier(); asm volatile("" ::: "memory"); } while (0)

template <int MODE, bool FIRST>
DI void idx_pass(const Ctx& C, const bf16_t* KV, const float (&w4)[4], int ntiles, int tq4, int qh, int r, int h) {
    LAS unsigned char* L = C.lds;
    const int q = 32 * qh + r, lane = 32 * h + r;
    const LAS unsigned* QS = (const LAS unsigned*)(L + AT_QST) + 4 * q;
    const unsigned pfx = QS[0], info = QS[1];
    const int lvl = info & 15; const bool done = (info >> 4) & 1, tie = (info >> 5) & 1;
    const int sh = (MODE == 0) ? (lvl == 0 ? 23 : (lvl == 1 ? 14 : (lvl == 2 ? 5 : 0))) : (int)(info >> 8);
    const unsigned bmask = (lvl == 3) ? 31u : 511u;
    const int psh = (lvl == 1) ? 23 : (lvl == 2 ? 14 : 5);
    unsigned* KS = C.keys();
    bf16x8 an[2][4];
    if (FIRST && tq4 < ntiles) {
#pragma unroll
        for (int kh = 0; kh < 2; ++kh)
#pragma unroll
            for (int ks = 0; ks < 4; ++ks) an[kh][ks] = *(const bf16x8*)(KV + (size_t)(64 * tq4 + 32 * kh + r) * KVW + 256 + 8 * h + 16 * ks);
    }
    for (int t = tq4; t < ntiles; t += 4) {
        bf16x8 ac[2][4];
        if (FIRST) {
#pragma unroll
            for (int kh = 0; kh < 2; ++kh)
#pragma unroll
                for (int ks = 0; ks < 4; ++ks) ac[kh][ks] = an[kh][ks];
            if (t + 4 < ntiles) {
#pragma unroll
                for (int kh = 0; kh < 2; ++kh)
#pragma unroll
                    for (int ks = 0; ks < 4; ++ks) an[kh][ks] = *(const bf16x8*)(KV + (size_t)(64 * (t + 4) + 32 * kh + r) * KVW + 256 + 8 * h + 16 * ks);
            }
        }
#pragma unroll
        for (int kh = 0; kh < 2; ++kh) {
            unsigned* kslot = KS + (size_t)((t * 2 + kh) * 2 + qh) * 1024 + lane;
            unsigned key[16];
            if (FIRST) {
                float sc[16];
#pragma unroll
                for (int i = 0; i < 16; ++i) sc[i] = 0.f;
#pragma unroll
                for (int hh = 0; hh < 4; ++hh) {
                    f32x16 acc;
#pragma unroll
                    for (int i = 0; i < 16; ++i) acc[i] = 0.f;
#pragma unroll
                    for (int ks = 0; ks < 4; ++ks) acc = MFMA32(ac[kh][ks], *(const LAS bf16x8*)(L + AT_QI + q * 528 + (64 * hh + 16 * ks + 8 * h) * 2), acc);
#pragma unroll
                    for (int i = 0; i < 16; ++i) sc[i] += w4[hh] * fmaxf(acc[i], 0.f);
                }
#pragma unroll
                for (int i = 0; i < 16; ++i) { key[i] = mono_key(sc[i]); kslot[64 * i] = key[i]; }
            } else {
#pragma unroll
                for (int i = 0; i < 16; ++i) key[i] = __hip_atomic_load(kslot + 64 * i, __ATOMIC_RELAXED, __HIP_MEMORY_SCOPE_AGENT);
            }
            if (MODE == 0) {
                if (!done) {
                    LAS unsigned* HR = (LAS unsigned*)(L + AT_HIST) + 257 * q;
#pragma unroll
                    for (int i = 0; i < 16; ++i) {
                        const bool part = (lvl == 0) || ((key[i] >> psh) == pfx);
                        if (part) { const unsigned bin = (key[i] >> sh) & bmask; atomicAdd((unsigned*)(HR + (bin >> 1)), 1u << ((bin & 1u) << 4)); }
                    }
                }
            } else {
                unsigned mw = 0u, tw = 0u;
#pragma unroll
                for (int i = 15; i >= 0; --i) {
                    const bool sel = tie ? (key[i] > pfx) : ((key[i] >> sh) >= pfx);
                    const bool tb = tie && (key[i] == pfx);
                    mw = (mw << 1) | (sel ? 1u : 0u); tw = (tw << 1) | (tb ? 1u : 0u);
                    if ((i & 3) == 0 && i > 0) { mw <<= 4; tw <<= 4; }
                }
                mw <<= 4 * h; tw <<= 4 * h;
                if (mw) atomicOr((unsigned*)((LAS unsigned*)(L + AT_MASK) + 65 * q + 2 * t + kh), mw);
                if (tw) atomicOr((unsigned*)((LAS unsigned*)(L + AT_TMASK) + 65 * q + 2 * t + kh), tw);
            }
        }
    }
    if (FIRST) asm volatile("s_waitcnt vmcnt(0)" ::: "memory");
}

DI void attn_item(const Ctx& C, int l, int sb, int qb) {
    const int tid = C.tid, lane = C.lane, wave = C.wave, r = lane & 31, h = lane >> 5;
    LAS unsigned char* L = C.lds;
    const int P = sb_P(sb), row0 = sb_row0(sb), t0 = 64 * qb, pos0 = P + t0;
    const int ntiles = (pos0 >> 6) + 1, Ladm = 64 * ntiles;
    bf16_t* PJ = C.proj(); const bf16_t* KV = C.kvb(l) + kvb_off(sb);
    LAS unsigned* MASK = (LAS unsigned*)(L + AT_MASK); LAS unsigned* TMASK = (LAS unsigned*)(L + AT_TMASK);
    LAS unsigned* QST = (LAS unsigned*)(L + AT_QST); LAS unsigned* MISC = (LAS unsigned*)(L + AT_MISC);
#ifdef PROBE_QB
    const bool pcond = (l == 0 && sb == 0 && qb == PROBE_QB);
#else
    const bool pcond = false;
#endif
    PROBE_BEGIN(40); PROBE_BEGIN(41);
    for (int i = tid; i < 64 * 65; i += NTHREADS) { const int w = i % 65; MASK[i] = (Ladm <= 256 && w < 2 * ntiles) ? 0xffffffffu : 0u; TMASK[i] = 0u; }
    for (int i = tid; i < 64 * 257; i += NTHREADS) ((LAS unsigned*)(L + AT_HIST))[i] = 0u;
    if (tid < 64) { unsigned k256 = 256u; asm volatile("" : "+v"(k256)); QST[4 * tid] = 0u; QST[4 * tid + 1] = 0u; QST[4 * tid + 2] = k256; QST[4 * tid + 3] = 0u; }
    for (int i = tid; i < 8 * 256; i += NTHREADS) { const int hq = i >> 8, rel = (i & 255) - 191; ((LAS float*)(L + AT_LUT))[i] = 1.4426950408889634f * (C.inp(20)[t5_bucket(rel) * 8 + hq] - C.inp(20)[15 * 8 + hq]); }
    if (tid == 0) MISC[0] = 0u;
    __syncthreads();
    if (pcond) PROBE_END(41, C);
    PROBE_BEGIN(4); PROBE_BEGIN(42);
    if (Ladm > 256) {
        const int qh = wave & 1, tq4 = wave >> 1, q = 32 * qh + r;
        float w4[4];
        { const f32x4 wv = *(const f32x4*)(C.wi() + (size_t)(row0 + t0 + q) * 4); w4[0] = wv[0]; w4[1] = wv[1]; w4[2] = wv[2]; w4[3] = wv[3]; }
        for (int i = tid; i < 2048; i += NTHREADS) { const int qq = i >> 5, pc = i & 31;
            *(LAS u32x4*)(L + AT_QI + qq * 528 + pc * 16) = *(const u32x4*)(PJ + (size_t)(row0 + t0 + qq) * PJW + C_QI + 8 * pc); }
        __syncthreads();
        for (int lvl = 0; lvl < 4; ++lvl) {
            PROBE_BEGIN(20);
            if (lvl == 0) idx_pass<0, true>(C, KV, w4, ntiles, tq4, qh, r, h); else idx_pass<0, false>(C, KV, w4, ntiles, tq4, qh, r, h);
            if (tid == 0) MISC[0] = 0u;
            __syncthreads();
            if (l == 0) PROBE_END(20, C);
            PROBE_BEGIN(21);
            int ln = lane; asm volatile("" : "+v"(ln));
            for (int qq = 8 * wave; qq < 8 * wave + 8; ++qq) {
                const unsigned pfx = QST[4 * qq], info = QST[4 * qq + 1], need = QST[4 * qq + 2];
                if ((info >> 4) & 1) continue;
                LAS unsigned* HR = (LAS unsigned*)(L + AT_HIST) + 257 * qq + 4 * ln;
                unsigned c[8];
#pragma unroll
                for (int j = 0; j < 4; ++j) { const unsigned wv = HR[j]; c[2 * j] = wv & 0xffffu; c[2 * j + 1] = wv >> 16; HR[j] = 0u; }
                unsigned ct = 0u;
#pragma unroll
                for (int j = 0; j < 8; ++j) ct += c[j];
                unsigned S = ct;
#pragma unroll
                for (int o = 1; o < 64; o <<= 1) { const unsigned y = (unsigned)__builtin_amdgcn_ds_bpermute((ln + o) << 2, (int)S); if (ln + o < 64) S += y; }
                if (S >= need && (S - ct) < need) {
                    unsigned rem = need - (S - ct), cum = 0u; int b = 0; unsigned cb = 0u;
                    bool found = false;
#pragma unroll
                    for (int j = 7; j >= 0; --j) { if (!found) { if (cum + c[j] >= rem) { b = j; cb = c[j]; found = true; } else cum += c[j]; } }
                    const unsigned need2 = rem - cum, binidx = 8u * ln + (unsigned)b;
                    const int bits = (lvl == 3) ? 5 : 9, shc = (lvl == 0) ? 23 : (lvl == 1 ? 14 : (lvl == 2 ? 5 : 0));
                    const unsigned npfx = (lvl == 0) ? binidx : ((pfx << bits) | binidx);
                    unsigned ninfo, nneed = need2, opfx = npfx;
                    if (need2 == cb) ninfo = (unsigned)lvl | 16u | ((unsigned)shc << 8);
                    else if (lvl == 0 && (binidx == 256u || binidx == 255u)) { ninfo = 16u | 32u; opfx = (binidx == 256u) ? 0x80000000u : 0x7fffffffu; }
                    else if (lvl == 3) ninfo = 16u | 32u;
                    else { ninfo = (unsigned)(lvl + 1); atomicAdd((unsigned*)MISC, 1u); }
                    QST[4 * qq] = opfx; QST[4 * qq + 1] = ninfo; QST[4 * qq + 2] = nneed;
                }
            }
            __syncthreads();
            if (l == 0) PROBE_END(21, C);
            if (MISC[0] == 0u) break;
            __syncthreads();
        }
        PROBE_BEGIN(22);
        idx_pass<1, false>(C, KV, w4, ntiles, tq4, qh, r, h);
        __syncthreads();
        if (l == 0) PROBE_END(22, C);
        PROBE_BEGIN(23);
        int ln2 = lane; asm volatile("" : "+v"(ln2));
        for (int qq = 8 * wave; qq < 8 * wave + 8; ++qq) {
            if (!((QST[4 * qq + 1] >> 5) & 1)) continue;
            const unsigned mwd = (ln2 < 2 * ntiles) ? MASK[65 * qq + ln2] : 0u, twd = (ln2 < 2 * ntiles) ? TMASK[65 * qq + ln2] : 0u;
            int have = __popc(mwd);
#pragma unroll
            for (int o = 1; o < 64; o <<= 1) have += __builtin_amdgcn_ds_bpermute((ln2 ^ o) << 2, have);
            const int want = 256 - have, pc = __popc(twd);
            int incl = pc;
#pragma unroll
            for (int o = 1; o < 64; o <<= 1) { const int y = __builtin_amdgcn_ds_bpermute((ln2 - o) << 2, incl); if (ln2 >= o) incl += y; }
            int take = want - (incl - pc); take = take < 0 ? 0 : (take > pc ? pc : take);
            unsigned wrem = twd, add = 0u;
            for (int k = 0; k < take; ++k) { add |= wrem & (0u - wrem); wrem &= wrem - 1u; }
            if (add) MASK[65 * qq + ln2] = mwd | add;
        }
        __syncthreads();
        if (l == 0) PROBE_END(23, C);
    }
    if (l == 0) PROBE_END(4, C);
    if (pcond) PROBE_END(42, C);
    PROBE_BEGIN(43);
    PROBE_BEGIN(5);
    const int hq = wave, kvh = wave >> 2;
    const unsigned ring = (unsigned)(size_t)(L + AT_RING);
    const float* LUT = nullptr; (void)LUT;
    const LAS float* lut = (const LAS float*)(L + AT_LUT) + 256 * hq;
    const float cfar = 1.4426950408889634f * C.inp(20)[15 * 8 + hq];
#define AT_DMA(tt, slot) do { const bf16_t* src_ = KV + (size_t)(64 * (tt)) * KVW; \
        _Pragma("unroll") for (int i_ = 0; i_ < 2; ++i_) { const int k_ = wave * 2 + i_, row_ = 4 * k_ + (lane >> 4), pc_ = lane & 15; \
            __builtin_amdgcn_global_load_lds((const unsigned*)(src_ + (size_t)row_ * KVW + 8 * (pc_ ^ (row_ & 15))), (LAS unsigned*)(L + AT_RING + (slot) * 32768 + k_ * 1024), 16, 0, 0); \
            __builtin_amdgcn_global_load_lds((const unsigned*)(src_ + (size_t)row_ * KVW + 128 + 8 * pc_), (LAS unsigned*)(L + AT_RING + (slot) * 32768 + 16384 + k_ * 1024), 16, 0, 0); } \
    } while (0)
    bf16x8 qfA[4], qfB[4];
#pragma unroll
    for (int qh = 0; qh < 2; ++qh) {
        const bf16_t* qp = PJ + (size_t)(row0 + t0 + 32 * qh + r) * PJW + C_Q + hq * 64 + 8 * h; float qv[4][8]; float ss = 0.f;
#pragma unroll
        for (int ks = 0; ks < 4; ++ks) { const u32x4 v = *(const u32x4*)(qp + 16 * ks);
            qv[ks][0] = __uint_as_float(v.x << 16); qv[ks][1] = __uint_as_float(v.x & 0xffff0000u); qv[ks][2] = __uint_as_float(v.y << 16); qv[ks][3] = __uint_as_float(v.y & 0xffff0000u);
            qv[ks][4] = __uint_as_float(v.z << 16); qv[ks][5] = __uint_as_float(v.z & 0xffff0000u); qv[ks][6] = __uint_as_float(v.w << 16); qv[ks][7] = __uint_as_float(v.w & 0xffff0000u);
#pragma unroll
            for (int j = 0; j < 8; ++j) ss += qv[ks][j] * qv[ks][j]; }
        ss = xor32_sum(ss);
        const float sc = rsqrtf(ss * (1.f / 64.f) + EPS) * (0.125f * 1.4426950408889634f);
        const float* qn = C.inp(18) + l * 64 + 8 * h;
#pragma unroll
        for (int ks = 0; ks < 4; ++ks) { const f32x4 n0 = *(const f32x4*)(qn + 16 * ks), n1 = *(const f32x4*)(qn + 16 * ks + 4);
            u32x4 p; p.x = cvt_pk_bf16(qv[ks][0] * sc * n0[0], qv[ks][1] * sc * n0[1]); p.y = cvt_pk_bf16(qv[ks][2] * sc * n0[2], qv[ks][3] * sc * n0[3]);
            p.z = cvt_pk_bf16(qv[ks][4] * sc * n1[0], qv[ks][5] * sc * n1[1]); p.w = cvt_pk_bf16(qv[ks][6] * sc * n1[2], qv[ks][7] * sc * n1[3]);
            if (qh == 0) qfA[ks] = __builtin_bit_cast(bf16x8, p); else qfB[ks] = __builtin_bit_cast(bf16x8, p); }
    }
    f32x16 oA0, oA1, oB0, oB1;
#pragma unroll
    for (int i = 0; i < 16; ++i) { oA0[i] = 0.f; oA1[i] = 0.f; oB0[i] = 0.f; oB1[i] = 0.f; }
    float mrefA = 0.f, lrunA = 0.f, mrefB = 0.f, lrunB = 0.f;
#define AT_HALF(QF, QQ, MREF, LRUN, O0, O1, PW) do { \
        f32x16 s0, s1; { const float ini = cfar - MREF; _Pragma("unroll") for (int i = 0; i < 16; ++i) { s0[i] = ini; s1[i] = ini; } } \
        _Pragma("unroll") for (int ks = 0; ks < 4; ++ks) { s0 = MFMA32(kf0[ks], QF[ks], s0); s1 = MFMA32(kf1[ks], QF[ks], s1); } \
        const int nm0 = (int)(~(MASK[65 * (QQ) + 2 * t] >> (4 * h))), nm1 = (int)(~(MASK[65 * (QQ) + 2 * t + 1] >> (4 * h))); \
        if (nearb) { _Pragma("unroll") for (int i = 0; i < 16; ++i) { const int kl = (i & 3) + 8 * (i >> 2), rel = 64 * t + kl + 4 * h - (pos0 + (QQ)); s0[i] += lut[rel + 191]; s1[i] += lut[rel + 32 + 191]; } } \
        _Pragma("unroll") for (int i = 0; i < 16; ++i) { const int kl = (i & 3) + 8 * (i >> 2); \
            s0[i] += __int_as_float(__builtin_amdgcn_sbfe(nm0, kl, 1) & (int)0xff800000u); s1[i] += __int_as_float(__builtin_amdgcn_sbfe(nm1, kl, 1) & (int)0xff800000u); } \
        float tm; { float a = max3f(s0[0], s0[1], s1[0]), b = max3f(s0[2], s0[3], s1[1]); a = max3f(a, s1[2], s1[3]); \
            _Pragma("unroll") for (int i = 4; i < 16; i += 4) { a = max3f(a, s0[i], s0[i + 1]); b = max3f(b, s0[i + 2], s0[i + 3]); a = max3f(a, s1[i], s1[i + 1]); b = max3f(b, s1[i + 2], s1[i + 3]); } \
            tm = xor32_max(fmaxf(a, b)); } \
        if (__builtin_amdgcn_ballot_w64(tm > 0.f) != 0ull) { const float dl = fmaxf(tm, 0.f), al = __builtin_amdgcn_exp2f(-dl); MREF += dl; LRUN *= al; \
            _Pragma("unroll") for (int i = 0; i < 16; ++i) { s0[i] -= dl; s1[i] -= dl; O0[i] *= al; O1[i] *= al; } } \
        float psum = 0.f; \
        _Pragma("unroll") for (int i = 0; i < 16; ++i) { s0[i] = __builtin_amdgcn_exp2f(s0[i]); s1[i] = __builtin_amdgcn_exp2f(s1[i]); psum += s0[i] + s1[i]; } \
        LRUN += psum; \
        _Pragma("unroll") for (int kk = 0; kk < 2; ++kk) { u32x4 w0, w1; \
            w0.x = cvt_pk_bf16(s0[8 * kk], s0[8 * kk + 1]); w0.y = cvt_pk_bf16(s0[8 * kk + 2], s0[8 * kk + 3]); w0.z = cvt_pk_bf16(s0[8 * kk + 4], s0[8 * kk + 5]); w0.w = cvt_pk_bf16(s0[8 * kk + 6], s0[8 * kk + 7]); \
            w1.x = cvt_pk_bf16(s1[8 * kk], s1[8 * kk + 1]); w1.y = cvt_pk_bf16(s1[8 * kk + 2], s1[8 * kk + 3]); w1.z = cvt_pk_bf16(s1[8 * kk + 4], s1[8 * kk + 5]); w1.w = cvt_pk_bf16(s1[8 * kk + 6], s1[8 * kk + 7]); \
            PW[kk] = __builtin_bit_cast(bf16x8, w0); PW[2 + kk] = __builtin_bit_cast(bf16x8, w1); } \
    } while (0)
    AT_WAIT_V(0);
    AT_DMA(0, 0);
    if (ntiles > 1) AT_DMA(1, 1);
    int sl = 0, sl2 = 2;
    for (int t = 0; t < ntiles; ++t) {
        if (t + 1 < ntiles) { AT_WAIT_V(4); } else { AT_WAIT_V(0); }
        AT_BAR();
        if (t + 2 < ntiles) AT_DMA(t + 2, sl2);
        const LAS unsigned char* Kt = L + AT_RING + sl * 32768; const LAS unsigned char* Vt = Kt + 16384;
        bf16x8 kf0[4], kf1[4];
#pragma unroll
        for (int ks = 0; ks < 4; ++ks) { const int pc = kvh * 8 + 2 * ks + h;
            kf0[ks] = *(const LAS bf16x8*)(Kt + r * 256 + ((pc ^ (r & 15)) << 4)); kf1[ks] = *(const LAS bf16x8*)(Kt + (32 + r) * 256 + ((pc ^ (r & 15)) << 4)); }
        const bool nearb = (t + 3 > ntiles - 1);
        bf16x8 pA[4], pB[4];
        AT_HALF(qfA, r, mrefA, lrunA, oA0, oA1, pA);
        AT_HALF(qfB, 32 + r, mrefB, lrunB, oB0, oB1, pB);
#pragma unroll
        for (int kk = 0; kk < 4; ++kk) {
            const int i16 = lane & 15, key0 = 16 * kk + 4 * h + (i16 >> 2);
#pragma unroll
            for (int dh = 0; dh < 2; ++dh) {
                const int dcol = kvh * 64 + 32 * dh + 16 * ((lane >> 4) & 1) + 4 * (i16 & 3);
                const v4i16_t lo = __builtin_amdgcn_ds_read_tr16_b64_v4i16((LAS v4i16_t*)(Vt + key0 * 256 + dcol * 2));
                const v4i16_t hi = __builtin_amdgcn_ds_read_tr16_b64_v4i16((LAS v4i16_t*)(Vt + (key0 + 8) * 256 + dcol * 2));
                const bf16x8 va = (bf16x8){lo[0], lo[1], lo[2], lo[3], hi[0], hi[1], hi[2], hi[3]};
                if (dh == 0) { oA0 = MFMA32(va, pA[kk], oA0); oB0 = MFMA32(va, pB[kk], oB0); } else { oA1 = MFMA32(va, pA[kk], oA1); oB1 = MFMA32(va, pB[kk], oB1); }
            }
        }
        sl2 = sl; sl = (sl == 2) ? 0 : sl + 1; sl2 = (sl == 0) ? 2 : sl - 1;
    }
#undef AT_HALF
#pragma unroll
    for (int qh = 0; qh < 2; ++qh) {
        const float inv = 1.f / xor32_sum(qh == 0 ? lrunA : lrunB);
        bf16_t* gp = PJ + (size_t)(row0 + t0 + 32 * qh + r) * PJW + C_GA + hq * 64 + 4 * h;
#pragma unroll
        for (int dh = 0; dh < 2; ++dh)
#pragma unroll
            for (int gq = 0; gq < 4; ++gq) {
                const u32x2 gg = *(const u32x2*)(gp + 32 * dh + 8 * gq);
                const float g0 = __uint_as_float(gg.x << 16), g1 = __uint_as_float(gg.x & 0xffff0000u), g2 = __uint_as_float(gg.y << 16), g3 = __uint_as_float(gg.y & 0xffff0000u);
                const f32x16& oo = (qh == 0) ? (dh == 0 ? oA0 : oA1) : (dh == 0 ? oB0 : oB1);
                const float a0 = oo[4 * gq] * inv, a1 = oo[4 * gq + 1] * inv, a2 = oo[4 * gq + 2] * inv, a3 = oo[4 * gq + 3] * inv;
                u32x2 w; w.x = cvt_pk_bf16(a0 * fast_silu(g0), a1 * fast_silu(g1)); w.y = cvt_pk_bf16(a2 * fast_silu(g2), a3 * fast_silu(g3));
                *(u32x2*)(gp + 32 * dh + 8 * gq) = w;
            }
    }
#undef AT_DMA
    AT_WAIT_V(0);
    __syncthreads();
    if (l == 0) PROBE_END(5, C);
    if (pcond) { PROBE_END(43, C); PROBE_END(40, C); }
}

constexpr int LR_RAW = 0;
constexpr int LR_GL = LR_RAW + 67 * 128;
constexpr int LR_XC = LR_GL + 2 * 8192;
constexpr int LR_XCF = LR_XC + 64 * 144;
constexpr int LR_SEG = LR_XCF + 64 * 256;
constexpr int LR_YS = LR_SEG + 2048;
constexpr int LR_END = LR_YS + 8192;
static_assert(LR_END <= LDS_BYTES - 256, "LRU LDS map");
typedef float f32x4v __attribute__((ext_vector_type(4)));
#define MFMA16(a, b, c) __builtin_amdgcn_mfma_f32_16x16x32_bf16((a), (b), (c), 0, 0, 0)
DI float fast_sigmoid(float x) { return __builtin_amdgcn_rcpf(1.f + __builtin_amdgcn_exp2f(-1.4426950408889634f * x)); }

DI void lru_item(const Ctx& C, int l, int sb, int blk) {
    const int tid = C.tid, lane = C.lane, wave = C.wave, fr = lane & 15, fq = lane >> 4;
    const int T = sb_T(sb), row0 = sb_row0(sb), NC = T / 64;
    LAS unsigned char* L = C.lds;
    bf16_t* PJ = C.proj();
    const int ts = wave >> 1, dh = wave & 1;
    bf16x8 wf[2][2][2];
#pragma unroll
    for (int gt = 0; gt < 2; ++gt)
#pragma unroll
        for (int db = 0; db < 2; ++db)
#pragma unroll
            for (int kb = 0; kb < 2; ++kb) {
                const float* wp = (gt == 0 ? C.inp(13) : C.inp(15)) + ((size_t)(l * 8 + blk) * 64 + 32 * kb + 8 * fq) * 64 + 32 * dh + 16 * db + fr;
                u32x4 p; p.x = cvt_pk_bf16(wp[0], wp[64]); p.y = cvt_pk_bf16(wp[128], wp[192]); p.z = cvt_pk_bf16(wp[256], wp[320]); p.w = cvt_pk_bf16(wp[384], wp[448]);
                wf[gt][db][kb] = __builtin_bit_cast(bf16x8, p);
            }
    float ba[2], bx[2], spl[2], hc[2];
#pragma unroll
    for (int db = 0; db < 2; ++db) {
        const int ch = blk * 64 + 32 * dh + 16 * db + fr;
        ba[db] = C.inp(14)[l * 512 + ch]; bx[db] = C.inp(16)[l * 512 + ch]; spl[db] = 8.f * 1.4426950408889634f * softplus_f(-C.inp(17)[l * 512 + ch]);
        hc[db] = (sb >= NPB) ? C.inp(6)[(size_t)(l * NSB_S + sb - NPB) * 512 + ch] : 0.f;
    }
    const int cp = tid & 31, sg = tid >> 5;
    float cw[2][5];
#pragma unroll
    for (int e = 0; e < 2; ++e) { const int ch = blk * 64 + 2 * cp + e;
#pragma unroll
        for (int j = 0; j < 4; ++j) cw[e][j] = C.inp(11)[((size_t)l * 4 + j) * 512 + ch];
        cw[e][4] = C.inp(12)[l * 512 + ch]; }
#define LRU_DMA(cc) do { const int t0_ = 64 * (cc); \
        for (int k_ = wave; k_ < 9; k_ += NWAVES) { const int q_ = 64 * k_ + lane, rr_ = q_ >> 3, pc_ = q_ & 7, t_ = t0_ - 3 + rr_; \
            if (q_ < 536 && t_ >= 0) __builtin_amdgcn_global_load_lds((const unsigned*)(PJ + (size_t)(row0 + t_) * PJW + C_XL + blk * 64 + 8 * pc_), (LAS unsigned*)(L + LR_RAW + k_ * 1024), 16, 0, 0); } \
        { const int rr_ = 8 * wave + (lane >> 3), pc_ = lane & 7; \
          __builtin_amdgcn_global_load_lds((const unsigned*)(PJ + (size_t)(row0 + t0_ + rr_) * PJW + C_GL + blk * 64 + 8 * pc_), (LAS unsigned*)(L + LR_GL + ((cc) & 1) * 8192 + wave * 1024), 16, 0, 0); } \
    } while (0)
    if (tid < 24) {
        const int rr = tid >> 3, pc = tid & 7; u32x4 v = (u32x4){0u, 0u, 0u, 0u};
        if (sb >= NPB) { const float* st = C.inp(5) + ((size_t)(l * NSB_S + sb - NPB) * 3 + rr) * 512 + blk * 64 + 8 * pc; v = pack8(*(const f32x4*)st, *(const f32x4*)(st + 4)); }
        *(LAS u32x4*)(L + LR_RAW + rr * 128 + pc * 16) = v;
    }
    LRU_DMA(0);
    asm volatile("s_waitcnt vmcnt(0)" ::: "memory");
    __syncthreads();
    for (int c = 0; c < NC; ++c) {
        const int t0 = 64 * c;
        {
            float xa[7], xb[7];
#pragma unroll
            for (int i = 0; i < 7; ++i) { const unsigned w = *(const LAS unsigned*)(L + LR_RAW + (4 * sg + i) * 128 + 4 * cp); xa[i] = __uint_as_float(w << 16); xb[i] = __uint_as_float(w & 0xffff0000u); }
#pragma unroll
            for (int j = 0; j < 4; ++j) {
                const float ya = cw[0][4] + cw[0][0] * xa[j] + cw[0][1] * xa[j + 1] + cw[0][2] * xa[j + 2] + cw[0][3] * xa[j + 3];
                const float yb = cw[1][4] + cw[1][0] * xb[j] + cw[1][1] * xb[j + 1] + cw[1][2] * xb[j + 2] + cw[1][3] * xb[j + 3];
                *(LAS unsigned*)(L + LR_XC + (4 * sg + j) * 144 + 4 * cp) = cvt_pk_bf16(ya, yb);
                f32x2_t v2 = {ya, yb}; *(LAS f32x2_t*)(L + LR_XCF + (4 * sg + j) * 256 + 8 * cp) = v2;
            }
        }
        LDS_FENCE(); __syncthreads();
        if (c + 1 < NC) LRU_DMA(c + 1);
        f32x4v ga[2], gx[2];
#pragma unroll
        for (int db = 0; db < 2; ++db) { ga[db] = (f32x4v){0.f, 0.f, 0.f, 0.f}; gx[db] = (f32x4v){0.f, 0.f, 0.f, 0.f}; }
#pragma unroll
        for (int kb = 0; kb < 2; ++kb) {
            const bf16x8 af = *(const LAS bf16x8*)(L + LR_XC + (16 * ts + fr) * 144 + (32 * kb + 8 * fq) * 2);
#pragma unroll
            for (int db = 0; db < 2; ++db) { ga[db] = MFMA16(af, wf[0][db][kb], ga[db]); gx[db] = MFMA16(af, wf[1][db][kb], gx[db]); }
        }
        float Pk[2][4], Hk[2][4], Pq[2], Hq[2];
#pragma unroll
        for (int db = 0; db < 2; ++db) {
            float P = 1.f, H = 0.f;
#pragma unroll
            for (int reg = 0; reg < 4; ++reg) {
                const float xc = *(const LAS float*)(L + LR_XCF + (16 * ts + 4 * fq + reg) * 256 + (32 * dh + 16 * db + fr) * 4);
                const float rg = fast_sigmoid(ga[db][reg] + ba[db]), ig = fast_sigmoid(gx[db][reg] + bx[db]);
                const float a = __builtin_amdgcn_exp2f(-rg * spl[db]);
                const float b = sqrtf(fmaxf(1.f - a * a, 0.f)) * (ig * xc);
                H = a * H + b; P = a * P; Pk[db][reg] = P; Hk[db][reg] = H;
            }
            float Pi = P, Hi = H;
            { const float Pp = bperm(Pi, lane - 16), Hp = bperm(Hi, lane - 16); if (fq >= 1) { Hi = Pi * Hp + Hi; Pi = Pi * Pp; } }
            { const float Pp = bperm(Pi, lane - 32), Hp = bperm(Hi, lane - 32); if (fq >= 2) { Hi = Pi * Hp + Hi; Pi = Pi * Pp; } }
            if (fq == 3) { f32x2_t v2 = {Pi, Hi}; *(LAS f32x2_t*)(L + LR_SEG + (ts * 64 + 32 * dh + 16 * db + fr) * 8) = v2; }
            const float Pe = bperm(Pi, lane - 16), He = bperm(Hi, lane - 16);
            Pq[db] = (fq >= 1) ? Pe : 1.f; Hq[db] = (fq >= 1) ? He : 0.f;
        }
        LDS_FENCE(); __syncthreads();
#pragma unroll
        for (int db = 0; db < 2; ++db) {
            float s = hc[db], sin = hc[db];
#pragma unroll
            for (int k = 0; k < 4; ++k) { const f32x2_t m = *(const LAS f32x2_t*)(L + LR_SEG + (k * 64 + 32 * dh + 16 * db + fr) * 8); if (k == ts) sin = s; s = m[0] * s + m[1]; }
            hc[db] = s;
            const float hin = Pq[db] * sin + Hq[db];
            const bf16_t* glp = nullptr; (void)glp;
#pragma unroll
            for (int reg = 0; reg < 4; ++reg) {
                const float hval = Pk[db][reg] * hin + Hk[db][reg];
                const int t = 16 * ts + 4 * fq + reg, d = 32 * dh + 16 * db + fr;
                const float glv = bf2f(*(const LAS bf16_t*)(L + LR_GL + (c & 1) * 8192 + t * 128 + d * 2));
                *(LAS bf16_t*)(L + LR_YS + t * 128 + d * 2) = f2bf(hval * fast_silu(glv));
            }
        }
        asm volatile("s_waitcnt vmcnt(0)" ::: "memory");
        LDS_FENCE(); __syncthreads();
        { const int rr = tid >> 3, pc = tid & 7;
          *(u32x4*)(PJ + (size_t)(row0 + t0 + rr) * PJW + C_GL + blk * 64 + 8 * pc) = *(const LAS u32x4*)(L + LR_YS + rr * 128 + pc * 16); }
    }
    if (ts == 0 && fq == 0) {
#pragma unroll
        for (int db = 0; db < 2; ++db) out_lh(C, l, sb)[blk * 64 + 32 * dh + 16 * db + fr] = hc[db];
    }
#undef LRU_DMA
    asm volatile("s_waitcnt vmcnt(0)" ::: "memory");
    __syncthreads();
}

DI Ctx relaunder(const Ctx& C0) {
    Ctx C = C0; int ln; asm volatile("v_mbcnt_lo_u32_b32 %0, -1, 0\n\tv_mbcnt_hi_u32_b32 %0, -1, %0" : "=v"(ln)); C.lane = ln; C.tid = C.wave * 64 + ln;
    { unsigned long long w = (unsigned long long)C.ws, o = (unsigned long long)C.out; asm volatile("" : "+s"(w), "+s"(o));
      C.ws = (unsigned char*)(__attribute__((address_space(1))) unsigned char*)w; C.out = (float*)(__attribute__((address_space(1))) float*)o; }
    asm volatile("" : "+s"(C.G), "+s"(C.bid));
    return C;
}
constexpr int CW_QUEUE = 8192;
constexpr int MX_PREP = 64;
constexpr int MX_A = 144, MX_B = MX_A + 256, MX_C0 = MX_B + 8, MX_C = MX_C0 + 240, MX_D = MX_C + 128, MX_E = MX_D + 128, MX_F = MX_E + 128, MX_N = MX_F + 64;
DI void phase_mixers(const Ctx& Cin, int l) {
    unsigned* head = (unsigned*)(Cin.ws + WS_CTL) + CW_QUEUE + 64 * l;
    volatile LAS int* slot = (volatile LAS int*)(Cin.lds + LDS_BYTES - 24);
    for (;;) {
        __syncthreads();
        if (Cin.tid == 0) *slot = (int)__hip_atomic_fetch_add(head, 1u, __ATOMIC_RELAXED, __HIP_MEMORY_SCOPE_AGENT);
        __syncthreads();
        const int i = __builtin_amdgcn_readfirstlane(*slot);
        if (i >= MX_N + (l == 0 ? MX_PREP : 0)) break;
        const Ctx C = relaunder(Cin);
        if (i >= MX_N) { prep_layer(C, 1, i - MX_N, MX_PREP); continue; }
        int kind, sb, sub;
        if (i < MX_A) { kind = 0; sb = i & 15; sub = 31 - (i >> 4); }
        else if (i < MX_B) { const int j = i - MX_A; kind = 1; sb = j >> 4; sub = j & 15; }
        else if (i < MX_C0) { kind = 0; sb = NPB + (i - MX_B); sub = 0; }
        else if (i < MX_C) { const int j = i - MX_C0; kind = 0; sb = j & 15; sub = 22 - (j >> 4); }
        else if (i < MX_D) { const int j = i - MX_C; kind = 2; sb = j >> 3; sub = j & 7; }
        else if (i < MX_E) { const int j = i - MX_D; kind = 0; sb = j & 15; sub = 7 - (j >> 4); }
        else if (i < MX_F) { const int j = i - MX_E; kind = 1; sb = NPB + (j >> 4); sub = j & 15; }
        else { const int j = i - MX_F; kind = 2; sb = NPB + (j >> 3); sub = j & 7; }
        PROBE_BEGIN(50); PROBE_BEGIN(51); PROBE_BEGIN(52); PROBE_BEGIN(53);
        if (kind == 0) attn_item(C, l, sb, sub);
        else if (kind == 1) ssd_item(C, l, sb, sub);
        else lru_item(C, l, sb, sub);
        if (l == 0) { PROBE_END(50, C); if (kind == 0) PROBE_END(51, C); if (kind == 1) PROBE_END(52, C); if (kind == 2) PROBE_END(53, C); }
    }
}

#define XB_TMO      128
#define XB_XCNT(j)  (256  + 64 * (j))
#define XB_XSUB(j)  (1280 + 64 * (j))
#define XB_XGEN(j)  (2304 + 64 * (j))
#define XB_TOP      3328
#define XB_TOPGEN   3392
#define XCD_BAR_WORDS 3456
#define XB_SPIN_CAP (1u << 22)

__device__ __forceinline__ unsigned xb_ld(unsigned* p)              { return __hip_atomic_load(p, __ATOMIC_RELAXED, __HIP_MEMORY_SCOPE_AGENT); }
__device__ __forceinline__ unsigned xb_add(unsigned* p, unsigned v) { return __hip_atomic_fetch_add(p, v, __ATOMIC_RELAXED, __HIP_MEMORY_SCOPE_AGENT); }
__device__ __forceinline__ unsigned xb_xcc_id() { return (unsigned)__builtin_amdgcn_s_getreg((3 << 11) | 20) & 0xFu; }
#define XB_SPIN(cond, bar) do { unsigned _sp = 0; while (cond) { __builtin_amdgcn_s_sleep(1); \
    if ((++_sp & 255u) == 0u) { if (xb_ld(&(bar)[XB_TMO])) break; if (_sp > XB_SPIN_CAP) { atomicAdd(&(bar)[XB_TMO], 1u); break; } } } } while (0)

struct XcdBarrier {
    unsigned* bar; unsigned x;
    volatile LAS unsigned* st;
};

__device__ __forceinline__ XcdBarrier xcd_barrier_post(unsigned* bar, volatile LAS unsigned* st) {
    XcdBarrier b; b.bar = bar; b.x = xb_xcc_id(); b.st = st;
    if (threadIdx.x == 0) (void)xb_add(&bar[XB_XCNT(b.x)], 1u);
    return b;
}
__device__ __forceinline__ void xcd_barrier_complete(unsigned* bar, unsigned x, unsigned& nloc, unsigned& nx) {
    const unsigned G = gridDim.x * gridDim.y * gridDim.z;
    unsigned sum, cnt, mine, sp = 0u;
    for (;;) {
        sum = 0u; cnt = 0u; mine = 0u;
#pragma unroll
        for (unsigned j = 0; j < 16; ++j) { const unsigned c = xb_ld(&bar[XB_XCNT(j)]); sum += c; cnt += (c > 0u) ? 1u : 0u; mine = (j == x) ? c : mine; }
        if (sum == G) break;
        __builtin_amdgcn_s_sleep(1);
        if ((++sp & 255u) == 0u) { if (xb_ld(&bar[XB_TMO])) break; if (sp > XB_SPIN_CAP) { atomicAdd(&bar[XB_TMO], 1u); break; } }
    }
    nloc = mine > 0u ? mine : 1u; nx = cnt > 0u ? cnt : 1u;
}

__device__ __forceinline__ void xcd_barrier(const XcdBarrier& b) {
    asm volatile("s_waitcnt vmcnt(0)" ::: "memory");
    __syncthreads();
    if (threadIdx.x == 0) {
        unsigned* bar = b.bar;
        __builtin_amdgcn_s_waitcnt(0);
        unsigned nloc = b.st[0], nx = b.st[1];
        if (nloc == 0u) { xcd_barrier_complete(bar, b.x, nloc, nx); b.st[0] = nloc; b.st[1] = nx; }
        const unsigned old = xb_add(&bar[XB_XSUB(b.x)], 1u);
        const unsigned gen = old / nloc;
        if (old + 1u == (gen + 1u) * nloc) {
            __builtin_amdgcn_fence(__ATOMIC_RELEASE, "agent");
            asm volatile("s_waitcnt vmcnt(0)" ::: "memory");
            const unsigned og = xb_add(&bar[XB_TOP], 1u);
            const unsigned tg = og / nx;
            if (og + 1u == (tg + 1u) * nx) xb_add(&bar[XB_TOPGEN], 1u);
            else XB_SPIN(xb_ld(&bar[XB_TOPGEN]) == tg, bar);
            __builtin_amdgcn_fence(__ATOMIC_ACQUIRE, "agent");
            xb_add(&bar[XB_XGEN(b.x)], 1u);
            asm volatile("s_waitcnt vmcnt(0)" ::: "memory");
        } else {
            XB_SPIN(xb_ld(&bar[XB_XGEN(b.x)]) == gen, bar);
            __builtin_amdgcn_fence(__ATOMIC_ACQUIRE, "agent");
            asm volatile("s_waitcnt vmcnt(0)" ::: "memory");
        }
    }
    __syncthreads();
}


constexpr int PH_PER_LAYER = 3;
constexpr int N_PHASES = 1 + 2 * PH_PER_LAYER;
constexpr int CW_BAR = 4096;
__global__ void __launch_bounds__(NTHREADS, 2) mk_fwd(Args a) {
    extern __shared__ __attribute__((aligned(16))) unsigned char lds_raw[];
    Ctx C; C.out = a.out; C.ws = a.ws; C.lds = (LAS unsigned char*)lds_raw;
    C.tid = threadIdx.x; C.lane = C.tid & 63; C.wave = __builtin_amdgcn_readfirstlane(C.tid >> 6); C.G = gridDim.x; C.bid = blockIdx.x;
    if (C.tid == 0) {
#pragma unroll
        for (int i = 0; i < 28; ++i) ((LAS cfp_t*)(C.lds + LDS_BYTES - 256))[i] = a.in[i];
        ((volatile LAS unsigned*)(C.lds + LDS_BYTES - 32))[0] = 0u; ((volatile LAS unsigned*)(C.lds + LDS_BYTES - 32))[1] = 0u;
        *(LAS unsigned long long*)(C.lds + LDS_BYTES - 16) = 0ull;
    }
    __syncthreads();
    const XcdBarrier bar = xcd_barrier_post((unsigned*)(a.ws + WS_CTL) + CW_BAR, (volatile LAS unsigned*)(C.lds + LDS_BYTES - 32));
    const Ctx C0 = C;
#define LAUNDER() const Ctx C = relaunder(C0)
#ifdef PROBE_PHASE
    unsigned long long pr_t0 = 0, pr_t1 = 0;
#endif
    for (int ph = a.ph_lo; ph < a.ph_hi; ++ph) {
#ifdef PROBE_PHASE
        if (ph == PROBE_PHASE) pr_t0 = __builtin_amdgcn_s_memrealtime();
#endif
        if (ph == 0) { LAUNDER(); phase_prologue(C); }
        else {
            const int l = (ph - 1) / PH_PER_LAYER, k = (ph - 1) % PH_PER_LAYER;
            if (k == 0) { LAUNDER(); phase_inproj_gemm(C, l); }
            else if (k == 1) { LAUNDER(); phase_mixers(C, l); }
            else { LAUNDER(); phase_outproj_gemm(C, l); }
        }
        if (ph + 1 < a.ph_hi) { if (ph == 0) cg::this_grid().sync(); else xcd_barrier(bar); }
#ifdef PROBE_PHASE
        if (ph == PROBE_PHASE) pr_t1 = __builtin_amdgcn_s_memrealtime();
#endif
    }
#ifdef PROBE_PHASE
#ifdef PROBE_SUB
    pr_t0 = 0; pr_t1 = *(LAS unsigned long long*)(C0.lds + LDS_BYTES - 16);
#endif
#ifndef PROBE_BLOCK
#define PROBE_BLOCK 0
#endif
    if (PROBE_BLOCK < 0 || (int)blockIdx.x == PROBE_BLOCK) { const unsigned long long te = __builtin_amdgcn_s_memrealtime(), span = 4ull * (pr_t1 - pr_t0); while (__builtin_amdgcn_s_memrealtime() - te < span) __builtin_amdgcn_s_sleep(8); }
#endif
}

extern "C" void kernel_launch(void* const* d_in, const int* in_sizes, int n_in, void* d_out, int out_size, void* d_ws, size_t ws_size, hipStream_t stream) {
    static int grid = 0;
    if (grid == 0) {
        if (n_in != 28 || (size_t)out_size != O_END || ws_size < WS_END) { fprintf(stderr, "kernel_launch: unexpected shapes n_in %d out %d ws %zu\n", n_in, out_size, ws_size); grid = -1; return; }
        int dev = 0, cus = 0, per_cu = 0;
        hipGetDevice(&dev); hipDeviceGetAttribute(&cus, hipDeviceAttributeMultiprocessorCount, dev);
        hipFuncSetAttribute((const void*)mk_fwd, hipFuncAttributeMaxDynamicSharedMemorySize, LDS_BYTES);
        hipOccupancyMaxActiveBlocksPerMultiprocessor(&per_cu, (const void*)mk_fwd, NTHREADS, LDS_BYTES);
        if (per_cu < 1) per_cu = 1;
        grid = cus * 1;
        (void)hipGetLastError();
    }
    if (grid < 0) return;
    hipMemsetAsync((char*)d_ws + WS_CTL, 0, CTL_BYTES, stream);
    Args a{};
    for (int i = 0; i < 28; ++i) a.in[i] = (const float*)d_in[i];
    a.out = (float*)d_out; a.ws = (unsigned char*)d_ws;
    a.ph_lo = 0; a.ph_hi = N_PHASES;
    void* args[] = {&a};
    hipError_t e = hipLaunchCooperativeKernel((const void*)mk_fwd, dim3(grid), dim3(NTHREADS), args, LDS_BYTES, stream);
    if (e != hipSuccess) fprintf(stderr, "cooperative launch failed: %s (grid %d)\n", hipGetErrorString(e), grid);
}
```

```cpp
#include <hip/hip_runtime.h>
#include <hip/hip_cooperative_groups.h>
#include <cstdio>
#include <cstdint>
namespace cg = cooperative_groups;

typedef unsigned short bf16_t;
typedef short bf16x8 __attribute__((ext_vector_type(8)));
typedef float f32x4 __attribute__((ext_vector_type(4)));
typedef float f32x16 __attribute__((ext_vector_type(16)));
typedef unsigned u32x4 __attribute__((ext_vector_type(4)));
typedef unsigned u32x2 __attribute__((ext_vector_type(2)));
#define LAS __attribute__((address_space(3)))
#define DI __device__ __forceinline__

constexpr int DM = 1024, NPB = 16, SEQ = 2048, NSB_S = 8, DSEQ = 64, PAST = 1024;
constexpr int ROWS_P = NPB * SEQ;
constexpr int ROWS = ROWS_P + NSB_S * DSEQ;
constexpr int NSB = NPB + NSB_S;
constexpr int DINP = 5204, NPAD = 5376;
constexpr int PJW = 4864;
constexpr int DMIX = 2048;
constexpr float EPS = 1e-6f;
constexpr int C_GL = 0, C_GA = 512, C_Z = 1024, C_XL = 2048, C_Q = 2560, C_QI = 3072, C_XBC = 3328, C_T19 = 4864, C_T20 = 5120;
constexpr int KVW = 320;
constexpr size_t KVB_LAYER = (size_t)NPB * SEQ * KVW + (size_t)NSB_S * (PAST + DSEQ) * KVW;

constexpr size_t O_YP = 0;
constexpr size_t O_YS = O_YP + (size_t)NPB * SEQ * DM;
constexpr size_t O_AKP = O_YS + (size_t)NSB_S * DSEQ * DM;
constexpr size_t O_AVP = O_AKP + (size_t)2 * NPB * SEQ * 128;
constexpr size_t O_IKP = O_AVP + (size_t)2 * NPB * SEQ * 128;
constexpr size_t O_LCP = O_IKP + (size_t)2 * NPB * SEQ * 64;
constexpr size_t O_LHP = O_LCP + (size_t)2 * NPB * 3 * 512;
constexpr size_t O_SCP = O_LHP + (size_t)2 * NPB * 512;
constexpr size_t O_SHP = O_SCP + (size_t)2 * NPB * 3 * 1536;
constexpr size_t O_AKS = O_SHP + (size_t)2 * NPB * 16 * 64 * 128;
constexpr size_t O_AVS = O_AKS + (size_t)2 * NSB_S * DSEQ * 128;
constexpr size_t O_IKS = O_AVS + (size_t)2 * NSB_S * DSEQ * 128;
constexpr size_t O_LCS = O_IKS + (size_t)2 * NSB_S * DSEQ * 64;
constexpr size_t O_LHS = O_LCS + (size_t)2 * NSB_S * 3 * 512;
constexpr size_t O_SCS = O_LHS + (size_t)2 * NSB_S * 512;
constexpr size_t O_SHS = O_SCS + (size_t)2 * NSB_S * 3 * 1536;
constexpr size_t O_END = O_SHS + (size_t)2 * NSB_S * 16 * 64 * 128;

constexpr size_t MiB = 1u << 20;
constexpr size_t WS_CTL = 0, CTL_BYTES = 1 * MiB;
constexpr size_t WS_WIN = 1 * MiB;
constexpr size_t WIN_LAYER = (size_t)NPAD * DM;
constexpr size_t WS_WOUT = 22 * MiB;
constexpr size_t WOUT_LAYER = (size_t)DM * DMIX;
constexpr size_t WS_HB = 30 * MiB;
constexpr size_t WS_RSS = 95 * MiB;
constexpr size_t WS_WI = 98 * MiB;
constexpr size_t WS_DTR = 99 * MiB;
constexpr size_t WS_SSQ = 102 * MiB;
constexpr size_t WS_KVB = 112 * MiB;
constexpr size_t WS_PROJ = 138 * MiB;
constexpr size_t WS_KEYS_B = 447 * MiB;
constexpr size_t KEYS_PER_WG = 512 * 1024;
constexpr int CW_LUTG = 32768;
constexpr size_t WS_END = WS_KEYS_B + 128 * KEYS_PER_WG;
static_assert(WS_KVB + KVB_LAYER * 2 <= WS_PROJ && WS_PROJ + (size_t)ROWS * PJW * 2 <= WS_KEYS_B && 128 * KEYS_PER_WG <= 65 * MiB, "ws map");
static_assert(WS_END <= 512 * MiB, "ws map");

constexpr int NTHREADS = 512, NWAVES = 8;
constexpr int LDS_BYTES = 163840;

DI float bf2f(bf16_t v) { return __uint_as_float(((unsigned)v) << 16); }
DI bf16_t f2bf(float f) { unsigned u = __float_as_uint(f); return (bf16_t)((u + 0x7fffu + ((u >> 16) & 1u)) >> 16); }
DI unsigned pk2(float lo, float hi) { return (unsigned)f2bf(lo) | ((unsigned)f2bf(hi) << 16); }
DI int crow(int reg, int h) { return (reg & 3) + 8 * (reg >> 2) + 4 * h; }
template <int O> DI float swz_xor(float v) { return __int_as_float(__builtin_amdgcn_ds_swizzle(__float_as_int(v), (O << 10) | 0x1f)); }
DI unsigned dpp_scan_u32(unsigned x) {
    x += (unsigned)__builtin_amdgcn_update_dpp(0, (int)x, 0x111, 0xf, 0xf, true); x += (unsigned)__builtin_amdgcn_update_dpp(0, (int)x, 0x112, 0xf, 0xf, true);
    x += (unsigned)__builtin_amdgcn_update_dpp(0, (int)x, 0x114, 0xf, 0xf, true); x += (unsigned)__builtin_amdgcn_update_dpp(0, (int)x, 0x118, 0xf, 0xf, true);
    x += (unsigned)__builtin_amdgcn_update_dpp(0, (int)x, 0x142, 0xa, 0xf, false); x += (unsigned)__builtin_amdgcn_update_dpp(0, (int)x, 0x143, 0xc, 0xf, false);
    return x;
}
DI float dpp_scan_f32(float x) {
    x += __int_as_float(__builtin_amdgcn_update_dpp(0, __float_as_int(x), 0x111, 0xf, 0xf, true)); x += __int_as_float(__builtin_amdgcn_update_dpp(0, __float_as_int(x), 0x112, 0xf, 0xf, true));
    x += __int_as_float(__builtin_amdgcn_update_dpp(0, __float_as_int(x), 0x114, 0xf, 0xf, true)); x += __int_as_float(__builtin_amdgcn_update_dpp(0, __float_as_int(x), 0x118, 0xf, 0xf, true));
    x += __int_as_float(__builtin_amdgcn_update_dpp(0, __float_as_int(x), 0x142, 0xa, 0xf, false)); x += __int_as_float(__builtin_amdgcn_update_dpp(0, __float_as_int(x), 0x143, 0xc, 0xf, false));
    return x;
}
DI float xor32_sum(float v) { auto rr = __builtin_amdgcn_permlane32_swap(__float_as_uint(v), __float_as_uint(v), false, false); return __uint_as_float(rr[0]) + __uint_as_float(rr[1]); }
DI float xor32_max(float v) { auto rr = __builtin_amdgcn_permlane32_swap(__float_as_uint(v), __float_as_uint(v), false, false); return fmaxf(__uint_as_float(rr[0]), __uint_as_float(rr[1])); }
DI float half_sum32(float v) {
    v += swz_xor<1>(v); v += swz_xor<2>(v); v += swz_xor<4>(v); v += swz_xor<8>(v); v += swz_xor<16>(v); return v;
}
DI float wave_sum(float v) { return xor32_sum(half_sum32(v)); }
DI float wave_max(float v) {
    v = fmaxf(v, swz_xor<1>(v)); v = fmaxf(v, swz_xor<2>(v)); v = fmaxf(v, swz_xor<4>(v)); v = fmaxf(v, swz_xor<8>(v)); v = fmaxf(v, swz_xor<16>(v)); return xor32_max(v);
}
DI float sum_fq(float v) { return xor32_sum(v + swz_xor<16>(v)); }
DI float bperm(float v, int srclane) { return __int_as_float(__builtin_amdgcn_ds_bpermute(srclane << 2, __float_as_int(v))); }
DI float silu_f(float x) { return x / (1.f + expf(-x)); }
DI float sigmoid_f(float x) { return 1.f / (1.f + expf(-x)); }
DI float softplus_f(float x) { return x > 20.f ? x : 0.6931471805599453f * __builtin_amdgcn_logf(1.f + __builtin_amdgcn_exp2f(1.4426950408889634f * x)); }
#define LDS_FENCE() asm volatile("s_waitcnt lgkmcnt(0)" ::: "memory")

__host__ __device__ inline int orig_col(int c) {
    if (c < 512) return 512 + c;
    if (c < 1024) return 1792 + (c - 512);
    if (c < 2048) return 2628 + (c - 1024);
    if (c < 2560) return c - 2048;
    if (c < 3072) return 1024 + (c - 2560);
    if (c < 3328) return 2304 + (c - 3072);
    if (c < 4864) return 3652 + (c - 3328);
    if (c < 5120) { const int cl = c - 4864, bj = cl >> 7, wc = (cl >> 5) & 3, j = cl & 31, d = 32 * bj + j; return (wc < 2 ? 1536 : 1664) + (wc & 1) * 64 + d; }
    const int cl = c - 5120;
    if (cl < 64) return 2560 + cl;
    if (cl < 68) return 2624 + (cl - 64);
    if (cl < 84) return 5188 + (cl - 68);
    return -1;
}
DI int sb_T(int sb) { return sb < NPB ? SEQ : DSEQ; }
DI int sb_P(int sb) { return sb < NPB ? 0 : PAST; }
DI int sb_row0(int sb) { return sb < NPB ? sb * SEQ : ROWS_P + (sb - NPB) * DSEQ; }
DI size_t kvb_off(int sb) { return sb < NPB ? (size_t)sb * SEQ * KVW : (size_t)NPB * SEQ * KVW + (size_t)(sb - NPB) * (PAST + DSEQ) * KVW; }
DI void row_sbt(int m, int& sb, int& t) { if (m < ROWS_P) { sb = m >> 11; t = m & 2047; } else { const int r = m - ROWS_P; sb = NPB + (r >> 6); t = r & 63; } }

typedef const float* cfp_t;
struct Args { const float* in[28]; float* out; unsigned char* ws; int ph_lo, ph_hi; };

struct Ctx {
    float* out; unsigned char* ws;
    LAS unsigned char* lds;
    DI const float* inp(int k) const { return (const float*)(const __attribute__((address_space(1))) float*)(((LAS unsigned long long*)(lds + LDS_BYTES - 256))[k]); }
    int tid, lane, wave, G, bid;
    DI bf16_t* win(int l) const { return (bf16_t*)(ws + WS_WIN) + (size_t)l * WIN_LAYER; }
    DI bf16_t* wout(int l) const { return (bf16_t*)(ws + WS_WOUT) + (size_t)l * WOUT_LAYER; }
    DI bf16_t* hb() const { return (bf16_t*)(ws + WS_HB); }
    DI bf16_t* act() const { return (bf16_t*)((unsigned char*)(out + O_YP) + 128 * KEYS_PER_WG); }
    DI float* rss() const { return (float*)(ws + WS_RSS); }
    DI float* wi() const { return (float*)(ws + WS_WI); }
    DI float* dtr() const { return (float*)(ws + WS_DTR); }
    DI float* ssq() const { return (float*)(ws + WS_SSQ); }
    DI bf16_t* kvb(int) const { return (bf16_t*)(ws + WS_KVB); }
    DI unsigned* keys() const { return bid < 128 ? (unsigned*)((unsigned char*)(out + O_YP) + (size_t)bid * KEYS_PER_WG) : (unsigned*)(ws + WS_KEYS_B + (size_t)(bid - 128) * KEYS_PER_WG); }
    DI bf16_t* proj() const { return (bf16_t*)(ws + WS_PROJ); }
};
DI float* out_ak(const Ctx& C, int l, int sb) { return sb < NPB ? C.out + O_AKP + ((size_t)(l * NPB + sb) * SEQ) * 128 : C.out + O_AKS + ((size_t)(l * NSB_S + sb - NPB) * DSEQ) * 128; }
DI float* out_av(const Ctx& C, int l, int sb) { return sb < NPB ? C.out + O_AVP + ((size_t)(l * NPB + sb) * SEQ) * 128 : C.out + O_AVS + ((size_t)(l * NSB_S + sb - NPB) * DSEQ) * 128; }
DI float* out_ik(const Ctx& C, int l, int sb) { return sb < NPB ? C.out + O_IKP + ((size_t)(l * NPB + sb) * SEQ) * 64 : C.out + O_IKS + ((size_t)(l * NSB_S + sb - NPB) * DSEQ) * 64; }
DI float* out_lc(const Ctx& C, int l, int sb) { return sb < NPB ? C.out + O_LCP + (size_t)(l * NPB + sb) * 3 * 512 : C.out + O_LCS + (size_t)(l * NSB_S + sb - NPB) * 3 * 512; }
DI float* out_lh(const Ctx& C, int l, int sb) { return sb < NPB ? C.out + O_LHP + (size_t)(l * NPB + sb) * 512 : C.out + O_LHS + (size_t)(l * NSB_S + sb - NPB) * 512; }
DI float* out_sc(const Ctx& C, int l, int sb) { return sb < NPB ? C.out + O_SCP + (size_t)(l * NPB + sb) * 3 * 1536 : C.out + O_SCS + (size_t)(l * NSB_S + sb - NPB) * 3 * 1536; }
DI float* out_sh(const Ctx& C, int l, int sb) { return sb < NPB ? C.out + O_SHP + (size_t)(l * NPB + sb) * 16 * 64 * 128 : C.out + O_SHS + (size_t)(l * NSB_S + sb - NPB) * 16 * 64 * 128; }

#ifdef PROBE_SUB
#define PROBE_BEGIN(id) unsigned long long pb_##id = __builtin_amdgcn_s_memrealtime()
#define PROBE_END(id, Cx) do { if ((id) == PROBE_SUB && (Cx).tid == 0) *(LAS unsigned long long*)((Cx).lds + LDS_BYTES - 16) += __builtin_amdgcn_s_memrealtime() - pb_##id; } while (0)
#else
#define PROBE_BEGIN(id) do {} while (0)
#define PROBE_END(id, Cx) do {} while (0)
#endif
namespace pg8 {
#define PG8_LAS __attribute__((address_space(3)))
constexpr int BM = 256, BK = 64, HALF = 128, HTB = HALF * BK * 2  , STAGE_BYTES = 8 * HTB, NXCD = 8, WGM = 4;

__host__ __device__ __forceinline__ int lds_byte(int r, int c) { const int st = (r >> 4) * 2 + (c >> 5), rr = r & 15, cc = c & 31, ob = rr * 64 + cc * 2; return st * 1024 + (ob ^ (((ob >> 9) & 1) << 5)); }
__host__ __device__ __forceinline__ void stage_rc(int b, int& R, int& C) { const int st = b / 1024, sb = b % 1024, swz = sb ^ (((sb >> 9) & 1) << 5); R = (st >> 1) * 16 + swz / 64; C = (st & 1) * 32 + (swz % 64) / 2; }
__host__ __device__ __forceinline__ int perm32(int rho) { const int n = rho >> 4, i = rho & 15; return 8 * (i >> 2) + 4 * n + (i & 3); }

struct Unit { int pm, pn; };
struct Gemm { const bf16_t* A; const bf16_t* Bt; int M, N, K, lda; };

struct StaticOrder {
    int nM, nN, nwg, G, c;
    __host__ __device__ void init(int M, int N, int G_, int c_) { nM = M / BM; nN = N / BM; nwg = nM * nN; G = G_; c = c_; }
    __host__ __device__ bool next(int i, Unit& u) const {
        const long L = (long)i * G + c; if (L >= nwg) return false;
        int wgid = (int)L; { const int q = nwg / NXCD, r = nwg % NXCD, xcd = wgid % NXCD, off = wgid / NXCD; wgid = (xcd < r ? xcd * (q + 1) : r * (q + 1) + (xcd - r) * q) + off; }
        const int nig = WGM * nN, gid = wgid / nig, fm = gid * WGM, gsz = (nM - fm) < WGM ? (nM - fm) : WGM;
        u.pm = fm + ((wgid % nig) % gsz); u.pn = (wgid % nig) / gsz; return true;
    }
    __device__ __forceinline__ void a_ready(const Unit&) const {}
    __device__ __forceinline__ void done(const Unit&) const {}
};

template <class Epi, class Sched, bool ALIGN_EPI = false, bool SP2 = false>
__device__ __forceinline__ void gemm_phase(PG8_LAS unsigned char* lds, const Gemm g, const Sched& S, const Epi& E, const int tid) {
    const int wid = __builtin_amdgcn_readfirstlane(tid >> 6), lane = tid & 63, wr = wid >> 2, wc = wid & 3, fr = lane & 15, fq = lane >> 4;
    const int K = g.K, nt = K / BK;
    unsigned voffA[2], voffB[2];
#pragma unroll
    for (int i = 0; i < 2; ++i) { int R, C; stage_rc(tid * 16 + i * 8192, R, C); const int Rb = Epi::PERM ? ((R & ~31) + perm32(R & 31)) : R;
        voffA[i] = (unsigned)(R * g.lda + C) * 2u; voffB[i] = (unsigned)(Rb * K + C) * 2u; }
    const size_t kstep = (size_t)(BK * 2);
    const size_t hstepA = (size_t)HALF * g.lda * 2, hstepB = (size_t)HALF * K * 2;
    const size_t tstepA = 2 * hstepA, tstepB = 2 * hstepB;
    const unsigned ldsw = (unsigned)wid * 1024u;
    const int aoff = lds_byte(wr * 64 + fr, fq * 8), boff = lds_byte(wc * 32 + fr, fq * 8);
#define PG8_SA(b, h) (((b) * 2 + (h)) * HTB)
#define PG8_SB(b, h) ((4 + (b) * 2 + (h)) * HTB)
#define PG8_STAGE(bufoff, gbase, voff) do { _Pragma("unroll") for (int _i = 0; _i < 2; ++_i) \
        __builtin_amdgcn_global_load_lds((const unsigned*)((const char*)(gbase) + (voff)[_i]), (PG8_LAS unsigned*)(lds + (bufoff) + ldsw + _i * 8192), 16, 0, 0); } while (0)
#define PG8_LDA(dst, b, h) do { _Pragma("unroll") for (int m = 0; m < 4; ++m) _Pragma("unroll") for (int k = 0; k < 2; ++k) dst[m][k] = *(const PG8_LAS bf16x8*)(lds + PG8_SA(b, h) + aoff + m * 2048 + k * 1024); } while (0)
#define PG8_LDB(dst, b, h) do { _Pragma("unroll") for (int n = 0; n < 2; ++n) _Pragma("unroll") for (int k = 0; k < 2; ++k) dst[n][k] = *(const PG8_LAS bf16x8*)(lds + PG8_SB(b, h) + boff + n * 2048 + k * 1024); } while (0)
#define PG8_MMA(ai, bj, At, Bt) do { __builtin_amdgcn_s_setprio(1); _Pragma("unroll") for (int m = 0; m < 4; ++m) _Pragma("unroll") for (int n = 0; n < 2; ++n) _Pragma("unroll") for (int k = 0; k < 2; ++k) \
        acc[ai][bj][m][n] = __builtin_amdgcn_mfma_f32_16x16x32_bf16(Bt[n][k], At[m][k], acc[ai][bj][m][n], 0, 0, 0); __builtin_amdgcn_s_setprio(0); } while (0)
#define PG8_WAIT_V(n) asm volatile("s_waitcnt vmcnt(" #n ")" ::: "memory")
#define PG8_WAIT_L(n) asm volatile("s_waitcnt lgkmcnt(" #n ")" ::: "memory")
#define PG8_BAR __builtin_amdgcn_s_barrier()
#define PG8_SCHED __builtin_amdgcn_sched_barrier(0)
    Unit cur, nxt; int ui = 0;
    if (!S.next(0, cur)) return;
    f32x4 acc[2][2][4][2];
#pragma unroll
    for (int a = 0; a < 2; ++a)
#pragma unroll
        for (int b = 0; b < 2; ++b)
#pragma unroll
            for (int m = 0; m < 4; ++m)
#pragma unroll
                for (int n = 0; n < 2; ++n) acc[a][b][m][n] = (f32x4){0.f, 0.f, 0.f, 0.f};
    bf16x8 At[4][2], B0[2][2], B1[2][2];
    const char* cA = (const char*)g.A + (size_t)cur.pm * tstepA; const char* cB = (const char*)g.Bt + (size_t)cur.pn * tstepB;
    S.a_ready(cur);
    if constexpr (SP2) {
        PG8_STAGE(PG8_SB(0, 0), cB, voffB); PG8_STAGE(PG8_SB(0, 1), cB + hstepB, voffB); PG8_STAGE(PG8_SA(0, 0), cA, voffA); PG8_STAGE(PG8_SA(0, 1), cA + hstepA, voffA);
        if (wr == 1) PG8_BAR;
        PG8_WAIT_V(2); PG8_BAR;
        PG8_STAGE(PG8_SB(1, 0), cB + kstep, voffB); PG8_STAGE(PG8_SA(1, 0), cA + kstep, voffA); PG8_STAGE(PG8_SB(1, 1), cB + hstepB + kstep, voffB);
        PG8_WAIT_V(6); PG8_BAR;
    } else {
        PG8_STAGE(PG8_SB(0, 0), cB, voffB); PG8_STAGE(PG8_SA(0, 0), cA, voffA); PG8_STAGE(PG8_SB(0, 1), cB + hstepB, voffB); PG8_STAGE(PG8_SA(0, 1), cA + hstepA, voffA);
        if (wr == 1) PG8_BAR;
        PG8_WAIT_V(4); PG8_BAR;
        PG8_STAGE(PG8_SB(1, 0), cB + kstep, voffB); PG8_STAGE(PG8_SA(1, 0), cA + kstep, voffA); PG8_STAGE(PG8_SB(1, 1), cB + hstepB + kstep, voffB);
        PG8_WAIT_V(6); PG8_BAR;
    }
    for (;;) {
        const bool has_next = S.next(ui + 1, nxt);
        const char* nA = has_next ? (const char*)g.A + (size_t)nxt.pm * tstepA : cA; const char* nB = has_next ? (const char*)g.Bt + (size_t)nxt.pn * tstepB : cB;
        for (int t = 0; t < nt; t += 2) {
            if constexpr (Epi::KSCALE) { if (t == Epi::KS_T0 || t == Epi::KS_T1) E.kscale(acc, ui, t, wr, fr); }
            const bool last = (t == nt - 2);
            const char* a1 = cA + (size_t)(t + 1) * kstep;
            const char* a2 = last ? nA : cA + (size_t)(t + 2) * kstep; const char* b2 = last ? nB : cB + (size_t)(t + 2) * kstep;
            const char* a3 = a2 + kstep; const char* b3 = b2 + kstep;
            if (last && has_next) S.a_ready(nxt);
            if constexpr (SP2) {
            PG8_LDB(B0, 0, 0); PG8_LDB(B1, 0, 1); PG8_SCHED; PG8_LDA(At, 0, 0); PG8_STAGE(PG8_SA(1, 1), a1 + hstepA, voffA);
            PG8_WAIT_V(8); PG8_WAIT_L(0); PG8_BAR; PG8_MMA(0, 0, At, B0); PG8_MMA(0, 1, At, B1); PG8_BAR; PG8_SCHED;
            PG8_LDA(At, 0, 1); PG8_STAGE(PG8_SB(0, 0), b2, voffB); PG8_STAGE(PG8_SB(0, 1), b2 + hstepB, voffB); PG8_STAGE(PG8_SA(0, 0), a2, voffA);
            PG8_WAIT_V(8); PG8_WAIT_L(0); PG8_BAR; PG8_MMA(1, 0, At, B0); PG8_MMA(1, 1, At, B1); PG8_BAR; PG8_SCHED;
            PG8_LDB(B0, 1, 0); PG8_LDB(B1, 1, 1); PG8_SCHED; PG8_LDA(At, 1, 0); PG8_STAGE(PG8_SA(0, 1), a2 + hstepA, voffA);
            PG8_WAIT_V(8); PG8_WAIT_L(0); PG8_BAR; PG8_MMA(0, 0, At, B0); PG8_MMA(0, 1, At, B1); PG8_BAR; PG8_SCHED;
            PG8_LDA(At, 1, 1); PG8_STAGE(PG8_SB(1, 0), b3, voffB); PG8_STAGE(PG8_SB(1, 1), b3 + hstepB, voffB); PG8_STAGE(PG8_SA(1, 0), a3, voffA);
            PG8_WAIT_V(8); PG8_WAIT_L(0); PG8_BAR; PG8_MMA(1, 0, At, B0); PG8_MMA(1, 1, At, B1); PG8_BAR; PG8_SCHED;
            } else {
            PG8_LDB(B0, 0, 0); PG8_SCHED; PG8_LDA(At, 0, 0); PG8_STAGE(PG8_SA(1, 1), a1 + hstepA, voffA);
            PG8_WAIT_L(8); PG8_BAR; PG8_WAIT_L(0); PG8_MMA(0, 0, At, B0); PG8_BAR; PG8_SCHED;
            PG8_LDB(B1, 0, 1); PG8_STAGE(PG8_SB(0, 0), b2, voffB);
            PG8_BAR; PG8_WAIT_L(0); PG8_MMA(0, 1, At, B1); PG8_BAR;
            PG8_LDA(At, 0, 1); PG8_STAGE(PG8_SA(0, 0), a2, voffA);
            PG8_BAR; PG8_WAIT_L(0); PG8_MMA(1, 0, At, B0); PG8_BAR; PG8_SCHED;
            PG8_STAGE(PG8_SB(0, 1), b2 + hstepB, voffB);
            PG8_WAIT_V(6); PG8_BAR; PG8_MMA(1, 1, At, B1); PG8_BAR;
            PG8_LDB(B0, 1, 0); PG8_SCHED; PG8_LDA(At, 1, 0); PG8_STAGE(PG8_SA(0, 1), a2 + hstepA, voffA);
            PG8_WAIT_L(8); PG8_BAR; PG8_WAIT_L(0); PG8_MMA(0, 0, At, B0); PG8_BAR; PG8_SCHED;
            PG8_LDB(B1, 1, 1); PG8_STAGE(PG8_SB(1, 0), b3, voffB);
            PG8_BAR; PG8_WAIT_L(0); PG8_MMA(0, 1, At, B1); PG8_BAR;
            PG8_LDA(At, 1, 1); PG8_STAGE(PG8_SA(1, 0), a3, voffA);
            PG8_BAR; PG8_WAIT_L(0); PG8_MMA(1, 0, At, B0); PG8_BAR; PG8_SCHED;
            PG8_STAGE(PG8_SB(1, 1), b3 + hstepB, voffB);
            PG8_WAIT_V(6); PG8_BAR; PG8_MMA(1, 1, At, B1); PG8_BAR;
            }
        }
        if constexpr (ALIGN_EPI) { if (wr == 0) PG8_BAR; }
        if constexpr (!Epi::AFTER_DRAIN) { E(acc, cur, ui, wr, wc, fr, fq); S.done(cur); }
        if (!has_next) break;
#pragma unroll
        for (int a = 0; a < 2; ++a)
#pragma unroll
            for (int b = 0; b < 2; ++b)
#pragma unroll
                for (int m = 0; m < 4; ++m)
#pragma unroll
                    for (int n = 0; n < 2; ++n) acc[a][b][m][n] = (f32x4){0.f, 0.f, 0.f, 0.f};
        cur = nxt; cA = nA; cB = nB; ++ui;
        if constexpr (ALIGN_EPI) { if (wr == 1) PG8_BAR; }
    }
    PG8_WAIT_V(0);
    if constexpr (!ALIGN_EPI) { if (wr == 0) PG8_BAR; }
    PG8_BAR;
    if constexpr (Epi::AFTER_DRAIN) { E.fused(acc, cur, wr, wc, fr, fq, lds, wid, lane); S.done(cur); }
#undef PG8_SA
#undef PG8_SB
#undef PG8_STAGE
#undef PG8_LDA
#undef PG8_LDB
#undef PG8_MMA
#undef PG8_WAIT_V
#undef PG8_WAIT_L
#undef PG8_BAR
#undef PG8_SCHED
}
}

typedef float f32x2_t __attribute__((ext_vector_type(2))); typedef __bf16 bf16x2_t __attribute__((ext_vector_type(2)));
DI unsigned cvt_pk_bf16(float lo, float hi) { const f32x2_t v = {lo, hi}; const bf16x2_t b = __builtin_convertvector(v, bf16x2_t); return __builtin_bit_cast(unsigned, b); }
DI u32x4 pack8(const f32x4 a, const f32x4 b) { u32x4 w; w.x = cvt_pk_bf16(a[0], a[1]); w.y = cvt_pk_bf16(a[2], a[3]); w.z = cvt_pk_bf16(b[0], b[1]); w.w = cvt_pk_bf16(b[2], b[3]); return w; }
constexpr int LDS_RSL = 131072;
struct EpiIn {
    static constexpr bool PERM = true, AFTER_DRAIN = false, KSCALE = false; static constexpr int KS_T0 = -1, KS_T1 = -1;
    Ctx C; int l;
    DI void operator()(const f32x4 (&acc)[2][2][4][2], const pg8::Unit& u, int ui, int wr, int wc, int fr, int fq) const {
        const int row0 = u.pm * 256 + wr * 64 + fr;
        float rs[2][4];
#pragma unroll
        for (int ai = 0; ai < 2; ++ai)
#pragma unroll
            for (int m = 0; m < 4; ++m) rs[ai][m] = ((const LAS float*)(C.lds + LDS_RSL))[ui * 256 + wr * 64 + fr + ai * 128 + m * 16];
        if (u.pn < 19) {
            bf16_t* base = C.proj() + (size_t)row0 * PJW + u.pn * 256 + wc * 32 + 8 * fq;
#pragma unroll
            for (int ai = 0; ai < 2; ++ai)
#pragma unroll
                for (int m = 0; m < 4; ++m) {
                    bf16_t* rowp = base + (size_t)(ai * 128 + m * 16) * PJW; const float sc = rs[ai][m];
#pragma unroll
                    for (int bj = 0; bj < 2; ++bj) __builtin_nontemporal_store(pack8(acc[ai][bj][m][0] * sc, acc[ai][bj][m][1] * sc), (u32x4*)(rowp + bj * 128));
                }
        } else if (u.pn == 19) {
            if (wc < 2) {
                const float* kw = C.inp(19) + l * 64 + 8 * fq;
                const f32x4 k00 = *(const f32x4*)(kw), k01 = *(const f32x4*)(kw + 4), k10 = *(const f32x4*)(kw + 32), k11 = *(const f32x4*)(kw + 36);
#pragma unroll
                for (int ai = 0; ai < 2; ++ai)
#pragma unroll
                    for (int m = 0; m < 4; ++m) {
                        const int row = row0 + ai * 128 + m * 16; int sb, t; row_sbt(row, sb, t);
                        const float sc = rs[ai][m];
                        f32x4 a0 = acc[ai][0][m][0] * sc, a1 = acc[ai][0][m][1] * sc, b0 = acc[ai][1][m][0] * sc, b1 = acc[ai][1][m][1] * sc;
                        float ss = 0.f;
#pragma unroll
                        for (int i = 0; i < 4; ++i) ss += (a0[i] * a0[i] + a1[i] * a1[i]) + (b0[i] * b0[i] + b1[i] * b1[i]);
                        ss = sum_fq(ss);
                        const float rn = rsqrtf(ss * (1.f / 64.f) + EPS);
                        a0 = a0 * rn * k00; a1 = a1 * rn * k01; b0 = b0 * rn * k10; b1 = b1 * rn * k11;
                        float* o = out_ak(C, l, sb) + (size_t)t * 128 + wc * 64 + 8 * fq;
                        *(f32x4*)(o) = a0; *(f32x4*)(o + 4) = a1; *(f32x4*)(o + 32) = b0; *(f32x4*)(o + 36) = b1;
                        bf16_t* kv = C.kvb(l) + kvb_off(sb) + (size_t)(sb_P(sb) + t) * KVW + wc * 64 + 8 * fq;
                        *(u32x4*)(kv) = pack8(a0, a1); *(u32x4*)(kv + 32) = pack8(b0, b1);
                    }
            } else {
                const int kvh = wc - 2;
#pragma unroll
                for (int ai = 0; ai < 2; ++ai)
#pragma unroll
                    for (int m = 0; m < 4; ++m) {
                        const int row = row0 + ai * 128 + m * 16; int sb, t; row_sbt(row, sb, t);
                        const float sc = rs[ai][m];
                        const f32x4 a0 = acc[ai][0][m][0] * sc, a1 = acc[ai][0][m][1] * sc, b0 = acc[ai][1][m][0] * sc, b1 = acc[ai][1][m][1] * sc;
                        float* o = out_av(C, l, sb) + (size_t)t * 128 + kvh * 64 + 8 * fq;
                        *(f32x4*)(o) = a0; *(f32x4*)(o + 4) = a1; *(f32x4*)(o + 32) = b0; *(f32x4*)(o + 36) = b1;
                        bf16_t* kv = C.kvb(l) + kvb_off(sb) + (size_t)(sb_P(sb) + t) * KVW + 128 + kvh * 64 + 8 * fq;
                        *(u32x4*)(kv) = pack8(a0, a1); *(u32x4*)(kv + 32) = pack8(b0, b1);
                    }
            }
        } else {
#pragma unroll
            for (int ai = 0; ai < 2; ++ai)
#pragma unroll
                for (int m = 0; m < 4; ++m) {
                    const int row = row0 + ai * 128 + m * 16; int sb, t; row_sbt(row, sb, t);
                    const float sc = rs[ai][m];
                    const f32x4 a0 = acc[ai][0][m][0] * sc, a1 = acc[ai][0][m][1] * sc;
                    if (wc < 2) {
                        const int d = 32 * wc + 8 * fq;
                        float* o = out_ik(C, l, sb) + (size_t)t * 64 + d;
                        *(f32x4*)(o) = a0; *(f32x4*)(o + 4) = a1;
                        *(u32x4*)(C.kvb(l) + kvb_off(sb) + (size_t)(sb_P(sb) + t) * KVW + 256 + d) = pack8(a0, a1);
                    } else if (wc == 2) {
                        if (fq == 0) { *(f32x4*)(C.wi() + (size_t)row * 4) = a0; *(f32x4*)(C.dtr() + (size_t)row * 16) = a1; }
                        else if (fq == 1) { *(f32x4*)(C.dtr() + (size_t)row * 16 + 4) = a0; *(f32x4*)(C.dtr() + (size_t)row * 16 + 8) = a1; }
                        else if (fq == 2) { *(f32x4*)(C.dtr() + (size_t)row * 16 + 12) = a0; }
                    }
                }
        }
    }
};
constexpr int LDS_GNT = 131072;
struct EpiOut {
    static constexpr bool PERM = false, AFTER_DRAIN = false, KSCALE = true; static constexpr int KS_T0 = 16, KS_T1 = 24;
    Ctx C; int l, pm0, pn0;
    DI void kscale(f32x4 (&acc)[2][2][4][2], int ui, int t, int wr, int fr) const {
        const LAS f32x4* tab = (const LAS f32x4*)(C.lds + LDS_GNT) + (ui & 1) * 256;
#pragma unroll
        for (int ai = 0; ai < 2; ++ai)
#pragma unroll
            for (int m = 0; m < 4; ++m) {
                const f32x4 f4 = tab[ai * 128 + wr * 64 + m * 16 + fr]; const float f = (t == KS_T0) ? f4[0] : f4[1];
#pragma unroll
                for (int bj = 0; bj < 2; ++bj)
#pragma unroll
                    for (int n = 0; n < 2; ++n) acc[ai][bj][m][n] = acc[ai][bj][m][n] * f;
            }
    }
    DI void operator()(const f32x4 (&acc)[2][2][4][2], const pg8::Unit& u, int, int wr, int wc, int fr, int fq) const {
        const int row0 = u.pm * 256 + wr * 64 + fr, col0 = u.pn * 256 + wc * 32 + 4 * fq;
        const LAS f32x4* tab = (const LAS f32x4*)(C.lds + LDS_GNT) + ((u.pm == pm0 && u.pn == pn0) ? 0 : 256);
#pragma unroll
        for (int ai = 0; ai < 2; ++ai)
#pragma unroll
            for (int m = 0; m < 4; ++m) {
                const int row = row0 + ai * 128 + m * 16;
                const float r1 = tab[ai * 128 + wr * 64 + m * 16 + fr][2];
                const float* xres = (row < ROWS_P) ? C.inp(0) + (size_t)row * DM : C.inp(1) + (size_t)(row - ROWS_P) * DM;
                float ss = 0.f;
#pragma unroll
                for (int bj = 0; bj < 2; ++bj)
#pragma unroll
                    for (int n = 0; n < 2; ++n) {
                        const int col = col0 + bj * 128 + n * 16;
                        f32x4 xr;
                        if (l == 0) xr = *(const f32x4*)(xres + col);
                        else { const u32x2 w = *(const u32x2*)(C.hb() + (size_t)row * DM + col); xr[0] = __uint_as_float(w.x << 16); xr[1] = __uint_as_float(w.x & 0xffff0000u); xr[2] = __uint_as_float(w.y << 16); xr[3] = __uint_as_float(w.y & 0xffff0000u); }
                        const f32x4 v = xr + acc[ai][bj][m][n] * r1;
                        if (l == 1) *(f32x4*)(C.out + (size_t)row * DM + col) = v;
                        if (l == 0) {
                            u32x2 w; w.x = cvt_pk_bf16(v[0], v[1]); w.y = cvt_pk_bf16(v[2], v[3]);
                            *(u32x2*)(C.hb() + (size_t)row * DM + col) = w;
                            ss += (v[0] * v[0] + v[1] * v[1]) + (v[2] * v[2] + v[3] * v[3]);
                        }
                    }
                if (l == 0) {
                    ss = sum_fq(ss);
                    if (fq == 0) C.rss()[(size_t)row * 16 + u.pn * 4 + wc] = ss;
                }
            }
    }
};
DI void prep_cache(const Ctx& C, int l, int part, int nparts);
DI void phase_inproj_gemm(const Ctx& C, int l) {
    pg8::Gemm g{C.hb(), C.win(l), ROWS, NPAD, DM, DM};
    pg8::StaticOrder S; S.init(ROWS, NPAD, C.G, C.bid);
    { pg8::Unit uu; const int row = C.tid & 255;
      for (int ui = C.tid >> 8; S.next(ui, uu); ui += 2) {
          const float* p = C.rss() + (size_t)(uu.pm * 256 + row) * 16;
          const f32x4 a = *(const f32x4*)(p), b = *(const f32x4*)(p + 4), c4 = *(const f32x4*)(p + 8), d = *(const f32x4*)(p + 12);
          const float s = ((a[0] + a[1]) + (a[2] + a[3])) + ((b[0] + b[1]) + (b[2] + b[3])) + ((c4[0] + c4[1]) + (c4[2] + c4[3])) + ((d[0] + d[1]) + (d[2] + d[3]));
          ((LAS float*)(C.lds + LDS_RSL))[ui * 256 + row] = rsqrtf(s * (1.f / DM) + EPS);
      } }
    __syncthreads();
    EpiIn E{C, l};
    pg8::gemm_phase<EpiIn, pg8::StaticOrder, true, true>(C.lds, g, S, E, C.tid);
    if (l == 1) {
        const int nunits = (ROWS / 256) * (NPAD / 256), first_idle = nunits - (nunits / C.G) * C.G;
        if (C.bid >= first_idle) prep_cache(C, 1, C.bid - first_idle, C.G - first_idle);
    }
}
DI void outproj_tail_item(const Ctx& C, int l, int rt, int g);
DI void prep_layer(const Ctx& C, int l, int part, int nparts);
DI void prep_cache(const Ctx& C, int l, int part, int nparts);
DI void phase_outproj_gemm(const Ctx& C, int l) {
    for (int i = C.bid * NTHREADS + C.tid; i < NSB * 3 * 1536; i += C.G * NTHREADS) {
        const int sb = i / (3 * 1536), j = (i / 1536) % 3, ch = i % 1536;
        out_sc(C, l, sb)[j * 1536 + ch] = bf2f(C.proj()[(size_t)(sb_row0(sb) + sb_T(sb) - 3 + j) * PJW + C_XBC + ch]);
    }
    for (int i = C.bid * NTHREADS + C.tid; i < NSB * 3 * 512; i += C.G * NTHREADS) {
        const int sb = i / (3 * 512), j = (i / 512) % 3, ch = i % 512;
        out_lc(C, l, sb)[j * 512 + ch] = bf2f(C.proj()[(size_t)(sb_row0(sb) + sb_T(sb) - 3 + j) * PJW + C_XL + ch]);
    }
    if (C.bid < 256) outproj_tail_item(C, l, ROWS_P / 32 + (C.bid >> 4), C.bid & 15);
    __syncthreads();
    pg8::Gemm g{C.proj(), C.wout(l), ROWS_P, DM, DMIX, PJW};
    pg8::StaticOrder S; S.init(ROWS_P, DM, C.G, C.bid);
    pg8::Unit u0{0, 0}, uu;
    (void)S.next(0, u0);
    { const int ui = C.tid >> 8, row = C.tid & 255;
      if (S.next(ui, uu)) {
          const float* p = C.ssq() + (size_t)(uu.pm * 256 + row) * 64; float s0 = 0.f, s1 = 0.f;
#pragma unroll
          for (int j = 0; j < 8; ++j) { const f32x4 a = *(const f32x4*)(p + 4 * j), b = *(const f32x4*)(p + 32 + 4 * j); s0 += (a[0] + a[1]) + (a[2] + a[3]); s1 += (b[0] + b[1]) + (b[2] + b[3]); }
          const float q0 = s0 * (1.f / 512.f) + EPS, q1 = s1 * (1.f / 512.f) + EPS, r0 = rsqrtf(q0), r1 = rsqrtf(q1);
          f32x4 f; f[0] = sqrtf(q0); f[1] = r0 * sqrtf(q1); f[2] = r1; f[3] = 0.f;
          ((LAS f32x4*)(C.lds + LDS_GNT))[ui * 256 + row] = f;
      } }
    __syncthreads();
    EpiOut E{C, l, u0.pm, u0.pn};
    pg8::gemm_phase<EpiOut, pg8::StaticOrder, true, true>(C.lds, g, S, E, C.tid);
}
template <int MODE>
DI void p0_transpose_item(const Ctx& C, const float* W, const float* scale, int K, int Nsrc, int Ndst, bf16_t* WT, LAS float* scr, int item) {
    const int lane = C.lane, nblk = Ndst / 64, kb = item / nblk, nb = item % nblk, k0 = 64 * kb, n0 = 64 * nb;
    const int cgp = lane & 15, kq = lane >> 4;
    const int ncol = n0 + 4 * cgp;
    const int src = (MODE == 0) ? orig_col(ncol) : ncol;
#pragma unroll 8
    for (int i = 0; i < 16; ++i) {
        const int kk = 4 * i + kq, k = k0 + kk;
        f32x4 v = (f32x4){0.f, 0.f, 0.f, 0.f};
        if (src >= 0) {
            v = *(const f32x4*)(W + (size_t)k * Nsrc + src);
            const float sc = (MODE == 0) ? scale[k] : (k >= 1024 ? scale[k - 1024] : 1.f);
            v = v * sc;
        }
        scr[(4 * cgp + 0) * 65 + kk] = v[0]; scr[(4 * cgp + 1) * 65 + kk] = v[1]; scr[(4 * cgp + 2) * 65 + kk] = v[2]; scr[(4 * cgp + 3) * 65 + kk] = v[3];
    }
    LDS_FENCE();
    const LAS float* sr = scr + lane * 65;
    bf16_t* orow = WT + (size_t)(n0 + lane) * K + k0;
#pragma unroll
    for (int j = 0; j < 8; ++j) {
        u32x4 o; o.x = cvt_pk_bf16(sr[8 * j], sr[8 * j + 1]); o.y = cvt_pk_bf16(sr[8 * j + 2], sr[8 * j + 3]); o.z = cvt_pk_bf16(sr[8 * j + 4], sr[8 * j + 5]); o.w = cvt_pk_bf16(sr[8 * j + 6], sr[8 * j + 7]);
        *(u32x4*)(orow + 8 * j) = o;
    }
    LDS_FENCE();
}
template <int MODE>
DI void p0_tr_load(const Ctx& C, const float* W, int Nsrc, int Ndst, int item, f32x4 (&tv)[16]) {
    const int lane = C.lane, nblk = Ndst / 64, kb = item / nblk, nb = item % nblk, k0 = 64 * kb, n0 = 64 * nb;
    const int cgp = lane & 15, kq = lane >> 4;
    const int ncol = n0 + 4 * cgp;
    const int src = (MODE == 0) ? orig_col(ncol) : ncol;
#pragma unroll
    for (int i = 0; i < 16; ++i) {
        const int k = k0 + 4 * i + kq;
        tv[i] = (f32x4){0.f, 0.f, 0.f, 0.f};
        if (src >= 0) tv[i] = *(const f32x4*)(W + (size_t)k * Nsrc + src);
    }
}
template <int MODE>
DI void p0_tr_finish(const Ctx& C, const f32x4 (&tv)[16], const float* scale, int K, int Ndst, bf16_t* WT, LAS float* scr, int item) {
    const int lane = C.lane, nblk = Ndst / 64, kb = item / nblk, nb = item % nblk, k0 = 64 * kb, n0 = 64 * nb;
    const int cgp = lane & 15, kq = lane >> 4;
#pragma unroll
    for (int i = 0; i < 16; ++i) {
        const int kk = 4 * i + kq, k = k0 + kk; const f32x4 v = tv[i] * ((MODE == 0) ? scale[k] : (k >= 1024 ? scale[k - 1024] : 1.f));
        scr[(4 * cgp + 0) * 65 + kk] = v[0]; scr[(4 * cgp + 1) * 65 + kk] = v[1]; scr[(4 * cgp + 2) * 65 + kk] = v[2]; scr[(4 * cgp + 3) * 65 + kk] = v[3];
    }
    LDS_FENCE();
    const LAS float* sr = scr + lane * 65;
    bf16_t* orow = WT + (size_t)(n0 + lane) * K + k0;
#pragma unroll
    for (int j = 0; j < 8; ++j) {
        u32x4 o; o.x = cvt_pk_bf16(sr[8 * j], sr[8 * j + 1]); o.y = cvt_pk_bf16(sr[8 * j + 2], sr[8 * j + 3]); o.z = cvt_pk_bf16(sr[8 * j + 4], sr[8 * j + 5]); o.w = cvt_pk_bf16(sr[8 * j + 6], sr[8 * j + 7]);
        *(u32x4*)(orow + 8 * j) = o;
    }
    LDS_FENCE();
}
DI void prep_layer(const Ctx& C, int l, int part, int nparts) {
    LAS float* scr = (LAS float*)(C.lds + C.wave * 16640);
    const int gw = part * NWAVES + C.wave, NGW = nparts * NWAVES;
    constexpr int I_IN = (DM / 64) * (NPAD / 64), I_OUT = (DMIX / 64) * (DM / 64);
    for (int it = gw; it < I_IN + I_OUT; it += NGW) {
        if (it < I_IN) p0_transpose_item<0>(C, C.inp(10) + (size_t)l * DM * DINP, C.inp(9) + l * DM, DM, DINP, NPAD, C.win(l), scr, it);
        else p0_transpose_item<1>(C, C.inp(27) + (size_t)l * DMIX * DM, C.inp(26) + l * 1024, DMIX, DM, DM, C.wout(l), scr, it - I_IN);
    }
}
DI void prep_cache(const Ctx& C, int l, int part, int nparts) {
    const int gw = part * NWAVES + C.wave, NGW = nparts * NWAVES;
    for (int it = gw; it < NSB_S * PAST / 4; it += NGW) {
        const int b = it / (PAST / 4), pos0 = 4 * (it % (PAST / 4));
#pragma unroll
        for (int j = 0; j < 5; ++j) {
            const int pc = C.lane + 64 * j, pp = pc / 80, q = pc % 80, pos = pos0 + pp;
            const size_t base = ((size_t)(l * NSB_S + b) * PAST + pos);
            const f32x4 v = (q < 32) ? *(const f32x4*)(C.inp(2) + base * 128 + 4 * q) : (q < 64 ? *(const f32x4*)(C.inp(3) + base * 128 + 4 * (q - 32)) : *(const f32x4*)(C.inp(4) + base * 64 + 4 * (q - 64)));
            u32x2 o; o.x = cvt_pk_bf16(v[0], v[1]); o.y = cvt_pk_bf16(v[2], v[3]);
            *(u32x2*)(C.kvb(l) + kvb_off(NPB + b) + (size_t)pos * KVW + 4 * q) = o;
        }
    }
}
DI int t5_bucket(int rel);
DI void phase_prologue(const Ctx& C) {
    for (int i = C.bid * NTHREADS + C.tid; i < 8 * 256; i += C.G * NTHREADS) { const int hq = i >> 8, rel = (i & 255) - 191;
        ((float*)(C.ws + WS_CTL + CW_LUTG * 4))[i] = 1.4426950408889634f * (C.inp(20)[t5_bucket(rel) * 8 + hq] - C.inp(20)[15 * 8 + hq]); }
    const int gw = C.bid * NWAVES + C.wave, NGW = C.G * NWAVES;
#define P0_XITER(m0_) do { f32x4 v[4][4]; \
        _Pragma("unroll") for (int rr = 0; rr < 4; ++rr) { const int m = (m0_) + rr; const float* xr = (m < ROWS_P) ? C.inp(0) + (size_t)m * DM : C.inp(1) + (size_t)(m - ROWS_P) * DM; \
            _Pragma("unroll") for (int j = 0; j < 4; ++j) v[rr][j] = *(const f32x4*)(xr + 4 * C.lane + 256 * j); } \
        _Pragma("unroll") for (int rr = 0; rr < 4; ++rr) { const int m = (m0_) + rr; float ss = 0.f; \
            _Pragma("unroll") for (int j = 0; j < 4; ++j) { const f32x4 x = v[rr][j]; ss += (x[0] * x[0] + x[1] * x[1]) + (x[2] * x[2] + x[3] * x[3]); \
                u32x2 o; o.x = cvt_pk_bf16(x[0], x[1]); o.y = cvt_pk_bf16(x[2], x[3]); *(u32x2*)(C.hb() + (size_t)m * DM + 4 * C.lane + 256 * j) = o; } \
            ss = wave_sum(ss); \
            if (C.lane < 16) C.rss()[(size_t)m * 16 + C.lane] = (C.lane == 0) ? ss : 0.f; } } while (0)
    constexpr int I_IN = (DM / 64) * (NPAD / 64), I_OUT = (DMIX / 64) * (DM / 64);
    LAS float* scr = (LAS float*)(C.lds + C.wave * 16640);
    const bool has = gw < I_IN + I_OUT;
    f32x4 tv[16];
    if (has) { if (gw < I_IN) p0_tr_load<0>(C, C.inp(10), DINP, NPAD, gw, tv); else p0_tr_load<1>(C, C.inp(27), DM, DM, gw - I_IN, tv); }
    int m0 = 4 * gw;
    if (m0 < ROWS) { P0_XITER(m0); m0 += 4 * NGW; }
    if (has) { if (gw < I_IN) p0_tr_finish<0>(C, tv, C.inp(9), DM, NPAD, C.win(0), scr, gw); else p0_tr_finish<1>(C, tv, C.inp(26), DMIX, DM, C.wout(0), scr, gw - I_IN); }
    for (int it = gw + NGW; it < I_IN + I_OUT; it += NGW) {
        if (it < I_IN) p0_transpose_item<0>(C, C.inp(10), C.inp(9), DM, DINP, NPAD, C.win(0), scr, it);
        else p0_transpose_item<1>(C, C.inp(27), C.inp(26), DMIX, DM, DM, C.wout(0), scr, it - I_IN);
    }
    prep_cache(C, 0, C.bid, C.G);
    for (; m0 < ROWS; m0 += 4 * NGW) P0_XITER(m0);
#undef P0_XITER
}

#define MFMA32(a, b, c) __builtin_amdgcn_mfma_f32_32x32x16_bf16((a), (b), (c), 0, 0, 0)
DI void outproj_tail_item(const Ctx& C, int l, int rt, int g) {
    const int lane = C.lane, wave = C.wave, r = lane & 31, h = lane >> 5;
    const bf16_t* WO = C.wout(l); const bf16_t* PJ = C.proj();
    const int m0 = rt * 32, c0 = 64 * g, c1 = c0 + 32, kbeg = 256 * wave;
    f32x16 a0, a1;
#pragma unroll
    for (int i = 0; i < 16; ++i) { a0[i] = 0.f; a1[i] = 0.f; }
    const bf16_t* Ap = PJ + (size_t)(m0 + r) * PJW + 8 * h + kbeg;
    const bf16_t* B0 = WO + (size_t)(c0 + r) * DMIX + 8 * h + kbeg;
    const bf16_t* B1 = WO + (size_t)(c1 + r) * DMIX + 8 * h + kbeg;
    float gs0 = 0.f, gs1 = 0.f;
    { const float* p = C.ssq() + (size_t)(m0 + r) * 64;
#pragma unroll
      for (int j = 0; j < 8; ++j) { const f32x4 a = *(const f32x4*)(p + 4 * j), b = *(const f32x4*)(p + 32 + 4 * j); gs0 += (a[0] + a[1]) + (a[2] + a[3]); gs1 += (b[0] + b[1]) + (b[2] + b[3]); } }
    float xr[2][2];
#pragma unroll
    for (int rr = 0; rr < 2; ++rr) {
        const int m = m0 + crow(2 * wave + rr, h);
        const float* xres = (m < ROWS_P) ? C.inp(0) + (size_t)m * DM : C.inp(1) + (size_t)(m - ROWS_P) * DM;
        xr[rr][0] = (l == 0) ? xres[c0 + r] : bf2f(C.hb()[(size_t)m * DM + c0 + r]); xr[rr][1] = (l == 0) ? xres[c1 + r] : bf2f(C.hb()[(size_t)m * DM + c1 + r]);
    }
#pragma unroll 8
    for (int k0 = 0; k0 < 256; k0 += 16) { const bf16x8 a = *(const bf16x8*)(Ap + k0); a0 = MFMA32(a, *(const bf16x8*)(B0 + k0), a0); a1 = MFMA32(a, *(const bf16x8*)(B1 + k0), a1); }
    LAS float* part = (LAS float*)C.lds;
#pragma unroll
    for (int i = 0; i < 16; ++i) { part[((wave * 2 + 0) * 16 + i) * 64 + lane] = a0[i]; part[((wave * 2 + 1) * 16 + i) * 64 + lane] = a1[i]; }
    __syncthreads();
    const float r0 = rsqrtf(gs0 * (1.f / 512.f) + EPS), r1 = rsqrtf(gs1 * (1.f / 512.f) + EPS);
#pragma unroll
    for (int rr = 0; rr < 2; ++rr) {
        const int reg = 2 * wave + rr, rowl = crow(reg, h), m = m0 + rowl;
        const float g0 = bperm(r0, rowl), g1 = bperm(r1, rowl);
        float sab[2], sc0[2], sc1[2];
#pragma unroll
        for (int t = 0; t < 2; ++t) {
            sab[t] = (part[((0 * 2 + t) * 16 + reg) * 64 + lane] + part[((1 * 2 + t) * 16 + reg) * 64 + lane]) + (part[((2 * 2 + t) * 16 + reg) * 64 + lane] + part[((3 * 2 + t) * 16 + reg) * 64 + lane]);
            sc0[t] = part[((4 * 2 + t) * 16 + reg) * 64 + lane] + part[((5 * 2 + t) * 16 + reg) * 64 + lane];
            sc1[t] = part[((6 * 2 + t) * 16 + reg) * 64 + lane] + part[((7 * 2 + t) * 16 + reg) * 64 + lane];
        }
        const float v0 = xr[rr][0] + sab[0] + g0 * sc0[0] + g1 * sc1[0];
        const float v1 = xr[rr][1] + sab[1] + g0 * sc0[1] + g1 * sc1[1];
        if (l == 1) { C.out[(size_t)m * DM + c0 + r] = v0; C.out[(size_t)m * DM + c1 + r] = v1; }
        if (l == 0) {
            C.hb()[(size_t)m * DM + c0 + r] = f2bf(v0); C.hb()[(size_t)m * DM + c1 + r] = f2bf(v1);
            const float ss = half_sum32(v0 * v0 + v1 * v1);
            if (r == 0) C.rss()[(size_t)m * 16 + g] = ss;
        }
    }
    __syncthreads();
}

constexpr int SS_XST = 0;
constexpr int SS_BM = SS_XST + 64 * 144;
constexpr int SS_CM = SS_BM + 64 * 272;
constexpr int SS_BWT = SS_CM + 64 * 272;
constexpr int SS_HA = SS_BWT + 128 * 144;
constexpr int SS_SCAL = SS_HA + 2 * 64 * 272;
constexpr int SS_RAW = SS_SCAL + 2 * 1024;
constexpr int SS_IMGD = SS_RAW + 67 * 128 - SS_BM;
constexpr int SS_Z = SS_BM + SS_IMGD + 2 * 64 * 272;
constexpr int SS_WT = SS_Z + 8192;
constexpr int SS_END = SS_WT + 2 * 3 * 2048;
static_assert(SS_END <= LDS_BYTES - 256, "SSD LDS map");
typedef short s16x4 __attribute__((ext_vector_type(4)));
DI float fast_silu(float x) { return x * __builtin_amdgcn_rcpf(1.f + __builtin_amdgcn_exp2f(-1.4426950408889634f * x)); }
DI bf16x8 lds_frag(const LAS unsigned char* base, int row, int rowbytes, int col) { return *(const LAS bf16x8*)(base + row * rowbytes + col * 2); }

constexpr int CW_ACT = 16384;
DI void bcact_item(const Ctx& C, int l, int j) {
    const int tid = C.tid, lane = C.lane, wave = C.wave;
    LAS unsigned char* L = C.lds;
    const bf16_t* PJ = C.proj();
    int sb, t0; row_sbt(64 * j, sb, t0);
    const int row0 = sb_row0(sb);
    LAS float* CWA = (LAS float*)(L + 67 * 1024);
    for (int k = wave; k < 67; k += NWAVES) { const int t = t0 - 3 + k;
        if (t >= 0) __builtin_amdgcn_global_load_lds((const unsigned*)(PJ + (size_t)(row0 + t) * PJW + C_XBC + 1024 + 8 * lane), (LAS unsigned*)(L + k * 1024), 16, 0, 0); }
    for (int i = tid; i < 5 * 512; i += NTHREADS) { const int jj = i >> 9, c = i & 511; CWA[i] = (jj < 4) ? C.inp(21)[((size_t)l * 4 + jj) * 1536 + 1024 + c] : C.inp(22)[l * 1536 + 1024 + c]; }
    if (t0 == 0 && tid < 192) {
        const int rr = tid >> 6, pc = tid & 63; u32x4 v = (u32x4){0u, 0u, 0u, 0u};
        if (sb >= NPB) { const float* st = C.inp(7) + ((size_t)(l * NSB_S + sb - NPB) * 3 + rr) * 1536 + 1024 + 8 * pc; v = pack8(*(const f32x4*)st, *(const f32x4*)(st + 4)); }
        *(LAS u32x4*)(L + rr * 1024 + pc * 16) = v;
    }
    asm volatile("s_waitcnt vmcnt(0)" ::: "memory");
    __syncthreads();
    {
        const int p = tid & 255, th = tid >> 8;
        const float a0 = CWA[2 * p], a1 = CWA[512 + 2 * p], a2 = CWA[1024 + 2 * p], a3 = CWA[1536 + 2 * p], ab = CWA[2048 + 2 * p];
        const float b0 = CWA[2 * p + 1], b1 = CWA[512 + 2 * p + 1], b2 = CWA[1024 + 2 * p + 1], b3 = CWA[1536 + 2 * p + 1], bb = CWA[2048 + 2 * p + 1];
        unsigned* dst = (unsigned*)(C.act() + (size_t)(64 * j) * 512) + p;
#pragma unroll
        for (int tb = 0; tb < 4; ++tb) {
            const int tk0 = 32 * th + 8 * tb;
            float xa[11], xb[11];
#pragma unroll
            for (int i = 0; i < 11; ++i) { const unsigned w = *(const LAS unsigned*)(L + (tk0 + i) * 1024 + 4 * p); xa[i] = __uint_as_float(w << 16); xb[i] = __uint_as_float(w & 0xffff0000u); }
#pragma unroll
            for (int jx = 0; jx < 8; ++jx) {
                const float ta = fast_silu(ab + a0 * xa[jx] + a1 * xa[jx + 1] + a2 * xa[jx + 2] + a3 * xa[jx + 3]);
                const float tc = fast_silu(bb + b0 * xb[jx] + b1 * xb[jx + 1] + b2 * xb[jx + 2] + b3 * xb[jx + 3]);
                dst[(size_t)(tk0 + jx) * 256] = cvt_pk_bf16(ta, tc);
            }
        }
    }
    asm volatile("s_waitcnt vmcnt(0)" ::: "memory");
    __syncthreads();
    if (tid == 0) {
        __builtin_amdgcn_fence(__ATOMIC_RELEASE, "agent");
        asm volatile("s_waitcnt vmcnt(0)" ::: "memory");
        int ci = CW_ACT + 64 * (l * NSB + sb); asm volatile("" : "+s"(ci));
        __hip_atomic_fetch_add((unsigned*)(C.ws + WS_CTL) + ci, 1u, __ATOMIC_RELAXED, __HIP_MEMORY_SCOPE_AGENT);
    }
}

DI void ssd_item(const Ctx& C, int l, int sb, int hd) {
    const int tid = C.tid, lane = C.lane, wave = C.wave, r = lane & 31, h = lane >> 5;
    const int T = sb_T(sb), row0 = sb_row0(sb), g = hd >> 3, NC = T / 64;
    LAS unsigned char* L = C.lds;
    bf16_t* PJ = C.proj();
    const float aneg = -expf(C.inp(24)[l * 16 + hd]), dtb = C.inp(23)[l * 16 + hd], Dh = C.inp(25)[l * 16 + hd];
    if (tid == 0) {
        int ci = CW_ACT + 64 * (l * NSB + sb); asm volatile("" : "+s"(ci));
        const unsigned* cntp = (const unsigned*)(C.ws + WS_CTL) + ci; const unsigned need = (unsigned)NC; unsigned sp = 0u;
        while (__hip_atomic_load(cntp, __ATOMIC_RELAXED, __HIP_MEMORY_SCOPE_AGENT) < need) { __builtin_amdgcn_s_sleep(8); if (++sp > (1u << 24)) break; }
        __builtin_amdgcn_fence(__ATOMIC_ACQUIRE, "agent");
        asm volatile("s_waitcnt vmcnt(0)" ::: "memory");
    }
    float cwa[5], cwb[5];
#pragma unroll
    for (int j = 0; j < 5; ++j) { const float* wp = (j < 4) ? C.inp(21) + ((size_t)l * 4 + j) * 1536 + hd * 64 + 2 * r : C.inp(22) + l * 1536 + hd * 64 + 2 * r; cwa[j] = (wave < 4) ? wp[0] : 0.f; cwb[j] = (wave < 4) ? wp[1] : 0.f; }
    __syncthreads();
    const int sj = wave - 4, sph = sj & 1, nq0 = 2 * (sj >> 1);
    f32x16 hacc0, hacc1;
#pragma unroll
    for (int i = 0; i < 16; ++i) { hacc0[i] = 0.f; hacc1[i] = 0.f; }
    if (wave >= 4) {
        if (sb >= NPB) {
            const float* st = C.inp(8) + (((size_t)(l * NSB_S + sb - NPB) * 16 + hd) * 64 + 32 * sph + r) * 128;
#pragma unroll
            for (int gq = 0; gq < 4; ++gq) {
                const f32x4 v0 = *(const f32x4*)(st + 32 * nq0 + 8 * gq + 4 * h), v1 = *(const f32x4*)(st + 32 * (nq0 + 1) + 8 * gq + 4 * h);
#pragma unroll
                for (int e = 0; e < 4; ++e) { hacc0[4 * gq + e] = v0[e]; hacc1[4 * gq + e] = v1[e]; }
            }
        }
#pragma unroll
        for (int gq = 0; gq < 4; ++gq) {
            u32x2 w0, w1; w0.x = cvt_pk_bf16(hacc0[4 * gq], hacc0[4 * gq + 1]); w0.y = cvt_pk_bf16(hacc0[4 * gq + 2], hacc0[4 * gq + 3]);
            w1.x = cvt_pk_bf16(hacc1[4 * gq], hacc1[4 * gq + 1]); w1.y = cvt_pk_bf16(hacc1[4 * gq + 2], hacc1[4 * gq + 3]);
            *(LAS u32x2*)(L + SS_HA + (32 * sph + r) * 272 + (32 * nq0 + 8 * gq + 4 * h) * 2) = w0;
            *(LAS u32x2*)(L + SS_HA + (32 * sph + r) * 272 + (32 * (nq0 + 1) + 8 * gq + 4 * h) * 2) = w1;
        }
    }
    const int yph = wave & 1, ylh = (wave >> 1) & 1;
    const bf16_t* ACT = C.act();
    int roff[9];
#pragma unroll
    for (int i = 0; i < 9; ++i) {
        if (wave >= 4) { const int k_ = (wave - 4) + 4 * i, q_ = 64 * (k_ < 17 ? k_ : k_ - 17) + lane, rr_ = q_ / 17, c16_ = q_ - 17 * rr_;
            roff[i] = (k_ < 34 && c16_ < 16) ? (rr_ * 512 + (k_ < 17 ? 0 : 256) + g * 128 + 8 * c16_) * 2 : -1; }
        else { const int k_ = wave + 4 * i, q_ = 64 * k_ + lane; roff[i] = (i < 3 && k_ < 9 && q_ < 536) ? ((q_ >> 3) * PJW + C_XBC + hd * 64 + 8 * (q_ & 7)) * 2 : -1; }
    }
#define SSD_DMA_IMG(cc) do { if (wave >= 4) { const char* ab_ = (const char*)ACT + (size_t)(row0 + 64 * (cc)) * 1024; \
        _Pragma("unroll") for (int i_ = 0; i_ < 9; ++i_) { const int k_ = (wave - 4) + 4 * i_; \
            if (roff[i_] >= 0) __builtin_amdgcn_global_load_lds((const unsigned*)(ab_ + (unsigned)roff[i_]), \
                    (LAS unsigned*)(L + (k_ < 17 ? SS_BM + ((cc) & 1) * SS_IMGD + k_ * 1024 : SS_CM + ((cc) & 1) * SS_IMGD + (k_ - 17) * 1024)), 16, 0, 0); } } } while (0)
#define SSD_DMA_XS(cc, FIRST) do { if (wave < 4) { const char* pb_ = (const char*)PJ + ((size_t)(row0 + 64 * (cc)) - 3) * (PJW * 2); \
        _Pragma("unroll") for (int i_ = 0; i_ < 3; ++i_) { const int k_ = wave + 4 * i_; \
            if (roff[i_] >= 0 && !((FIRST) && k_ == 0 && lane < 24)) \
                __builtin_amdgcn_global_load_lds((const unsigned*)(pb_ + (unsigned)roff[i_]), (LAS unsigned*)(L + SS_RAW + k_ * 1024), 16, 0, 0); } } } while (0)
#define SSD_DMA_Z(cc) do { const int t0_ = 64 * (cc); \
        if (wave < 4) { _Pragma("unroll") for (int k_ = 0; k_ < 2; ++k_) { const int rr_ = 16 * k_ + (lane >> 2), pc_ = lane & 3; \
            __builtin_amdgcn_global_load_lds((const unsigned*)(PJ + (size_t)(row0 + t0_ + 32 * ylh + rr_) * PJW + C_Z + hd * 64 + 32 * yph + 8 * pc_), \
                                             (LAS unsigned*)(L + SS_Z + (2 * yph + ylh) * 2048 + k_ * 1024), 16, 0, 0); } } \
    } while (0)
    if (tid < 24) {
        const int rr = tid >> 3, pc = tid & 7;
        u32x4 v = (u32x4){0u, 0u, 0u, 0u};
        if (sb >= NPB) { const float* st = C.inp(7) + ((size_t)(l * NSB_S + sb - NPB) * 3 + rr) * 1536 + hd * 64 + 8 * pc; v = pack8(*(const f32x4*)st, *(const f32x4*)(st + 4)); }
        *(LAS u32x4*)(L + SS_RAW + rr * 128 + pc * 16) = v;
    }
#define SSD_S0V(cc, raw) do { LAS float* SC_ = (LAS float*)(L + SS_SCAL + ((cc) & 1) * 1024); \
        const float dt_ = softplus_f((raw) + dtb); float x_ = dt_ * aneg; \
        x_ = dpp_scan_f32(x_); \
        const float c63_ = __int_as_float(__builtin_amdgcn_readlane(__float_as_int(x_), 63)); \
        SC_[lane] = x_; SC_[64 + lane] = dt_; SC_[128 + lane] = __builtin_amdgcn_exp2f(1.4426950408889634f * (c63_ - x_)) * dt_; SC_[192 + lane] = __builtin_amdgcn_exp2f(1.4426950408889634f * x_); } while (0)
#define SSD_GTILE(cc) do { const int gt = wave - 4, gsh = gt >> 1, glh = (gt + 1) >> 1, pg_ = (cc) & 1; \
        const LAS float* SCg = (const LAS float*)(L + SS_SCAL + pg_ * 1024); \
        const float cuml = SCg[32 * glh + r]; \
        f32x16 ga; \
        _Pragma("unroll") for (int i = 0; i < 16; ++i) ga[i] = 0.f; \
        _Pragma("unroll") for (int ks = 0; ks < 8; ++ks) ga = MFMA32(lds_frag(L + SS_BM + pg_ * SS_IMGD, 32 * gsh + r, 272, 16 * ks + 8 * h), lds_frag(L + SS_CM + pg_ * SS_IMGD, 32 * glh + r, 272, 16 * ks + 8 * h), ga); \
        float wv[16]; \
        _Pragma("unroll") for (int reg = 0; reg < 16; ++reg) { \
            const int s_ = 32 * gsh + crow(reg, h), ll = 32 * glh + r; \
            const f32x4 cs4 = *(const LAS f32x4*)(SCg + 32 * gsh + 8 * (reg >> 2) + 4 * h), ds4 = *(const LAS f32x4*)(SCg + 64 + 32 * gsh + 8 * (reg >> 2) + 4 * h); \
            const float cs = cs4[reg & 3], ds = ds4[reg & 3]; \
            float w = (s_ <= ll) ? ga[reg] * __builtin_amdgcn_exp2f(1.4426950408889634f * (cuml - cs)) * ds : 0.f; \
            if (s_ == ll) w += Dh; \
            wv[reg] = w; } \
        _Pragma("unroll") for (int s2 = 0; s2 < 2; ++s2) { \
            u32x4 p; p.x = cvt_pk_bf16(wv[8 * s2], wv[8 * s2 + 1]); p.y = cvt_pk_bf16(wv[8 * s2 + 2], wv[8 * s2 + 3]); p.z = cvt_pk_bf16(wv[8 * s2 + 4], wv[8 * s2 + 5]); p.w = cvt_pk_bf16(wv[8 * s2 + 6], wv[8 * s2 + 7]); \
            *(LAS u32x4*)(L + SS_WT + pg_ * 6144 + gt * 2048 + s2 * 1024 + lane * 16) = p; } \
    } while (0)
#define SSD_STATE() do { const float decay = SC[192 + 63]; \
        _Pragma("unroll") for (int i = 0; i < 16; ++i) { hacc0[i] *= decay; hacc1[i] *= decay; } \
        _Pragma("unroll") for (int ks = 0; ks < 4; ++ks) { \
            const bf16x8 xb = lds_frag(L + SS_XST, 32 * sph + r, 144, 16 * ks + 8 * h); \
            hacc0 = MFMA32(lds_frag(L + SS_BWT, 32 * nq0 + r, 144, 16 * ks + 8 * h), xb, hacc0); \
            hacc1 = MFMA32(lds_frag(L + SS_BWT, 32 * (nq0 + 1) + r, 144, 16 * ks + 8 * h), xb, hacc1); } \
        LAS unsigned char* HAn = L + SS_HA + (par ^ 1) * (64 * 272); \
        _Pragma("unroll") for (int gq = 0; gq < 4; ++gq) { \
            u32x2 w0, w1; w0.x = cvt_pk_bf16(hacc0[4 * gq], hacc0[4 * gq + 1]); w0.y = cvt_pk_bf16(hacc0[4 * gq + 2], hacc0[4 * gq + 3]); \
            w1.x = cvt_pk_bf16(hacc1[4 * gq], hacc1[4 * gq + 1]); w1.y = cvt_pk_bf16(hacc1[4 * gq + 2], hacc1[4 * gq + 3]); \
            *(LAS u32x2*)(HAn + (32 * sph + r) * 272 + (32 * nq0 + 8 * gq + 4 * h) * 2) = w0; \
            *(LAS u32x2*)(HAn + (32 * sph + r) * 272 + (32 * (nq0 + 1) + 8 * gq + 4 * h) * 2) = w1; } \
    } while (0)
    float dtr_nx = 0.f;
    if (wave == 7) { SSD_S0V(0, C.dtr()[(size_t)(row0 + lane) * 16 + hd]); if (NC > 1) dtr_nx = C.dtr()[(size_t)(row0 + 64 + lane) * 16 + hd]; }
    SSD_DMA_IMG(0); if (NC > 1) SSD_DMA_IMG(1); SSD_DMA_XS(0, true); SSD_DMA_Z(0);
    const unsigned zoff = (unsigned)(((32 * ylh + (lane >> 2)) * PJW + C_Z + hd * 64 + 32 * yph + 8 * (lane & 3)) * 2);
    const unsigned yoff = (unsigned)(((32 * ylh + r) * PJW + C_Z + hd * 64 + 32 * yph + 4 * h) * 2);
#define SSD_DMA_Z_N(cc) do { const char* cb_ = (const char*)PJ + (size_t)(row0 + 64 * (cc)) * (PJW * 2); \
        _Pragma("unroll") for (int k_ = 0; k_ < 2; ++k_) \
            __builtin_amdgcn_global_load_lds((const unsigned*)(cb_ + zoff + (unsigned)(k_ * 16 * PJW * 2)), (LAS unsigned*)(L + SS_Z + (2 * yph + ylh) * 2048 + k_ * 1024), 16, 0, 0); } while (0)
    asm volatile("s_waitcnt vmcnt(0)" ::: "memory");
    LDS_FENCE(); __syncthreads();
    if (wave >= 4 && wave < 7) SSD_GTILE(0);
    for (int c = 0; c < NC; ++c) {
        const int t0 = 64 * c, par = c & 1;
        LAS float* SC = (LAS float*)(L + SS_SCAL + par * 1024);
        PROBE_BEGIN(12);
        if (wave < 4) asm volatile("s_waitcnt vmcnt(0)" ::: "memory");
        LDS_FENCE(); __syncthreads();
        if (l == 0 && sb == 3 && hd == 5) PROBE_END(12, C);
        PROBE_BEGIN(10);
        if (wave < 4) {
            const int tk0 = 16 * wave + 8 * h;
            float xa[11], xb[11];
#pragma unroll
            for (int i = 0; i < 11; ++i) { const unsigned w = *(const LAS unsigned*)(L + SS_RAW + (tk0 + i) * 128 + 4 * r); xa[i] = __uint_as_float(w << 16); xb[i] = __uint_as_float(w & 0xffff0000u); }
            float ta[8], tc[8];
#pragma unroll
            for (int j = 0; j < 8; ++j) {
                ta[j] = fast_silu(cwa[4] + cwa[0] * xa[j] + cwa[1] * xa[j + 1] + cwa[2] * xa[j + 2] + cwa[3] * xa[j + 3]);
                tc[j] = fast_silu(cwb[4] + cwb[0] * xb[j] + cwb[1] * xb[j + 1] + cwb[2] * xb[j + 2] + cwb[3] * xb[j + 3]);
            }
            u32x4 wa, wb;
            wa.x = cvt_pk_bf16(ta[0], ta[1]); wa.y = cvt_pk_bf16(ta[2], ta[3]); wa.z = cvt_pk_bf16(ta[4], ta[5]); wa.w = cvt_pk_bf16(ta[6], ta[7]);
            wb.x = cvt_pk_bf16(tc[0], tc[1]); wb.y = cvt_pk_bf16(tc[2], tc[3]); wb.z = cvt_pk_bf16(tc[4], tc[5]); wb.w = cvt_pk_bf16(tc[6], tc[7]);
            *(LAS u32x4*)(L + SS_XST + (2 * r) * 144 + tk0 * 2) = wa; *(LAS u32x4*)(L + SS_XST + (2 * r + 1) * 144 + tk0 * 2) = wb;
        }
        f32x16 ya;
#pragma unroll
        for (int i = 0; i < 16; ++i) ya[i] = 0.f;
        if (wave < 4) {
            const LAS unsigned char* HAc = L + SS_HA + par * (64 * 272);
#pragma unroll
            for (int ks = 0; ks < 8; ++ks) ya = MFMA32(lds_frag(HAc, 32 * yph + r, 272, 16 * ks + 8 * h), lds_frag(L + SS_CM + par * SS_IMGD, 32 * ylh + r, 272, 16 * ks + 8 * h), ya);
        }
        {
            const int np = lane, tk0 = 8 * wave;
            float ta[8], tc[8];
#pragma unroll
            for (int j = 0; j < 8; ++j) { const unsigned w = *(const LAS unsigned*)(L + SS_BM + par * SS_IMGD + (tk0 + j) * 272 + 4 * np); const float te = SC[128 + tk0 + j];
                ta[j] = __uint_as_float(w << 16) * te; tc[j] = __uint_as_float(w & 0xffff0000u) * te; }
            u32x4 wa, wb;
            wa.x = cvt_pk_bf16(ta[0], ta[1]); wa.y = cvt_pk_bf16(ta[2], ta[3]); wa.z = cvt_pk_bf16(ta[4], ta[5]); wa.w = cvt_pk_bf16(ta[6], ta[7]);
            wb.x = cvt_pk_bf16(tc[0], tc[1]); wb.y = cvt_pk_bf16(tc[2], tc[3]); wb.z = cvt_pk_bf16(tc[4], tc[5]); wb.w = cvt_pk_bf16(tc[6], tc[7]);
            *(LAS u32x4*)(L + SS_BWT + (2 * np) * 144 + tk0 * 2) = wa; *(LAS u32x4*)(L + SS_BWT + (2 * np + 1) * 144 + tk0 * 2) = wb;
        }
        if (wave == 7 && c + 1 < NC) SSD_S0V(c + 1, dtr_nx);
        if (l == 0 && sb == 3 && hd == 5) PROBE_END(10, C);
        PROBE_BEGIN(13);
        if (wave >= 4) asm volatile("s_waitcnt vmcnt(0)" ::: "memory");
        LDS_FENCE(); __syncthreads();
        if (c + 2 < NC) SSD_DMA_IMG(c + 2);
        if (l == 0 && sb == 3 && hd == 5) PROBE_END(13, C);
        PROBE_BEGIN(11);
        if (c + 1 < NC) SSD_DMA_XS(c + 1, false);
        if (wave < 4) {
            const float ecl = SC[192 + 32 * ylh + r];
#pragma unroll
            for (int i = 0; i < 16; ++i) ya[i] *= ecl;
#pragma unroll
            for (int sh = 0; sh < 2; ++sh) {
                if (sh <= ylh) {
#pragma unroll
                    for (int s2 = 0; s2 < 2; ++s2) {
                        const LAS unsigned char* xp = L + SS_XST + (32 * yph + r) * 144 + (32 * sh + 16 * s2 + 4 * h) * 2;
                        const u32x2 lo = *(const LAS u32x2*)(xp), hi = *(const LAS u32x2*)(xp + 16);
                        u32x4 a; a.x = lo.x; a.y = lo.y; a.z = hi.x; a.w = hi.y;
                        const bf16x8 wf = *(const LAS bf16x8*)(L + SS_WT + par * 6144 + (sh + ylh) * 2048 + s2 * 1024 + lane * 16);
                        ya = MFMA32(__builtin_bit_cast(bf16x8, a), wf, ya);
                    }
                }
            }
            float ss = 0.f;
            bf16_t* zp = (bf16_t*)((char*)PJ + (size_t)(row0 + t0) * (PJW * 2) + yoff);
#pragma unroll
            for (int gq = 0; gq < 4; ++gq) {
                const u32x2 zz = *(const LAS u32x2*)(L + SS_Z + (2 * yph + ylh) * 2048 + r * 64 + (8 * gq + 4 * h) * 2);
                const float z0 = __uint_as_float(zz.x << 16), z1 = __uint_as_float(zz.x & 0xffff0000u), z2 = __uint_as_float(zz.y << 16), z3 = __uint_as_float(zz.y & 0xffff0000u);
                const float y0 = ya[4 * gq] * fast_silu(z0), y1 = ya[4 * gq + 1] * fast_silu(z1), y2 = ya[4 * gq + 2] * fast_silu(z2), y3 = ya[4 * gq + 3] * fast_silu(z3);
                ss += (y0 * y0 + y1 * y1) + (y2 * y2 + y3 * y3);
                u32x2 w; w.x = cvt_pk_bf16(y0, y1); w.y = cvt_pk_bf16(y2, y3);
                *(u32x2*)(zp + 8 * gq) = w;
            }
            ss = xor32_sum(ss);
            if (h == 0) { float* q = C.ssq() + (size_t)(row0 + t0 + 32 * ylh + r) * 64 + hd * 4 + yph; q[0] = ss; q[2] = 0.f; }
            LDS_FENCE();
            if (c + 1 < NC) SSD_DMA_Z_N(c + 1);
        } else {
            if (wave < 7 && c + 1 < NC) SSD_GTILE(c + 1);
            if (wave == 7 && c + 2 < NC) dtr_nx = C.dtr()[(size_t)(row0 + 64 * (c + 2) + lane) * 16 + hd];
            SSD_STATE();
        }
        if (l == 0 && sb == 3 && hd == 5) PROBE_END(11, C);
    }
    if (wave >= 4) {
        float* o = out_sh(C, l, sb) + ((size_t)hd * 64 + 32 * sph + r) * 128;
#pragma unroll
        for (int gq = 0; gq < 4; ++gq) {
            f32x4 v0, v1;
#pragma unroll
            for (int e = 0; e < 4; ++e) { v0[e] = hacc0[4 * gq + e]; v1[e] = hacc1[4 * gq + e]; }
            *(f32x4*)(o + 32 * nq0 + 8 * gq + 4 * h) = v0; *(f32x4*)(o + 32 * (nq0 + 1) + 8 * gq + 4 * h) = v1;
        }
    }
    __syncthreads();
#undef SSD_DMA_IMG
#undef SSD_DMA_XS
#undef SSD_DMA_Z
#undef SSD_S0V
#undef SSD_GTILE
#undef SSD_STATE
#undef SSD_DMA_Z_N
}

DI unsigned mono_key(float f) { const unsigned u = __float_as_uint(f); return (u & 0x80000000u) ? ~u : (u | 0x80000000u); }
DI int t5_bucket(int rel) {
    const int n = rel < 0 ? -rel : rel; int b;
    if (n < 8) b = n; else if (n < 12) b = 8; else if (n < 16) b = 9; else if (n < 23) b = 10; else if (n < 32) b = 11; else if (n < 46) b = 12; else if (n < 64) b = 13; else if (n < 91) b = 14; else b = 15;
    return b + (rel > 0 ? 16 : 0);
}
constexpr int AT_MASK = 0;
constexpr int AT_TMASK = AT_MASK + 64 * 65 * 4;
constexpr int AT_QST = AT_TMASK + 64 * 65 * 4;
constexpr int AT_MISC = AT_QST + 1024;
constexpr int AT_LUT = AT_MISC + 64;
constexpr int AT_HIST = AT_LUT + 8192;
constexpr int AT_RING = AT_HIST;
constexpr int AT_QI = AT_HIST + 65792;
constexpr int AT_END = AT_QI + 64 * 528;
static_assert(AT_END <= LDS_BYTES - 256 && AT_RING + 65536 <= AT_END, "attention LDS map");
typedef short v4i16_t __attribute__((ext_vector_type(4)));
DI float max3f(float a, float b, float c) { float r; asm("v_max3_f32 %0, %1, %2, %3" : "=v"(r) : "v"(a), "v"(b), "v"(c)); return r; }
#define AT_WAIT_V(n) asm volatile("s_waitcnt vmcnt(" #n ")" ::: "memory")
#define AT_BAR() do { asm volatile("s_waitcnt lgkmcnt(0)" ::: "memory"); __builtin_amdgcn_s_barrier(); asm volatile("" ::: "memory"); } while (0)

template <int MODE, bool FIRST>
DI void idx_pass(const Ctx& C, const bf16_t* KV, const float (&w4)[4], int ntiles, int tq4, int qh, int r, int h) {
    LAS unsigned char* L = C.lds;
    const int q = 32 * qh + r, lane = 32 * h + r;
    const LAS unsigned* QS = (const LAS unsigned*)(L + AT_QST) + 4 * q;
    const unsigned pfx = QS[0], info = QS[1];
    const int lvl = info & 15; const bool done = (info >> 4) & 1, tie = (info >> 5) & 1;
    const int sh = (MODE == 0) ? (lvl == 0 ? 23 : (lvl == 1 ? 14 : (lvl == 2 ? 5 : 0))) : (int)(info >> 8);
    const unsigned bmask = (lvl == 3) ? 31u : 511u;
    const int psh = (lvl == 1) ? 23 : (lvl == 2 ? 14 : 5);
    unsigned* KS = C.keys();
    bf16x8 an[2][4];
    if (FIRST && tq4 < ntiles) {
#pragma unroll
        for (int kh = 0; kh < 2; ++kh)
#pragma unroll
            for (int ks = 0; ks < 4; ++ks) an[kh][ks] = *(const bf16x8*)(KV + (size_t)(64 * tq4 + 32 * kh + r) * KVW + 256 + 8 * h + 16 * ks);
    }
#define IDX_LDKEYS(dst, tt) do { _Pragma("unroll") for (int kh_ = 0; kh_ < 2; ++kh_) _Pragma("unroll") for (int i_ = 0; i_ < 16; ++i_) \
        dst[kh_][i_] = __hip_atomic_load(KS + (size_t)(((tt) * 2 + kh_) * 2 + qh) * 1024 + lane + 64 * i_, __ATOMIC_RELAXED, __HIP_MEMORY_SCOPE_AGENT); } while (0)
    unsigned kn[2][16];
    if (!FIRST && tq4 < ntiles) IDX_LDKEYS(kn, tq4);
    for (int t = tq4; t < ntiles; t += 4) {
        bf16x8 ac[2][4];
        unsigned kc[2][16];
        if (!FIRST) {
#pragma unroll
            for (int kh = 0; kh < 2; ++kh)
#pragma unroll
                for (int i = 0; i < 16; ++i) kc[kh][i] = kn[kh][i];
            if (t + 4 < ntiles) IDX_LDKEYS(kn, t + 4);
        }
        if (FIRST) {
#pragma unroll
            for (int kh = 0; kh < 2; ++kh)
#pragma unroll
                for (int ks = 0; ks < 4; ++ks) ac[kh][ks] = an[kh][ks];
            if (t + 4 < ntiles) {
#pragma unroll
                for (int kh = 0; kh < 2; ++kh)
#pragma unroll
                    for (int ks = 0; ks < 4; ++ks) an[kh][ks] = *(const bf16x8*)(KV + (size_t)(64 * (t + 4) + 32 * kh + r) * KVW + 256 + 8 * h + 16 * ks);
            }
        }
#pragma unroll
        for (int kh = 0; kh < 2; ++kh) {
            unsigned* kslot = KS + (size_t)((t * 2 + kh) * 2 + qh) * 1024 + lane;
            unsigned key[16];
            if (FIRST) {
                float sc[16];
#pragma unroll
                for (int i = 0; i < 16; ++i) sc[i] = 0.f;
#pragma unroll
                for (int hh = 0; hh < 4; ++hh) {
                    f32x16 acc;
#pragma unroll
                    for (int i = 0; i < 16; ++i) acc[i] = 0.f;
#pragma unroll
                    for (int ks = 0; ks < 4; ++ks) acc = MFMA32(ac[kh][ks], *(const LAS bf16x8*)(L + AT_QI + q * 528 + (64 * hh + 16 * ks + 8 * h) * 2), acc);
#pragma unroll
                    for (int i = 0; i < 16; ++i) sc[i] += w4[hh] * fmaxf(acc[i], 0.f);
                }
#pragma unroll
                for (int i = 0; i < 16; ++i) { key[i] = mono_key(sc[i]); kslot[64 * i] = key[i]; }
            } else {
#pragma unroll
                for (int i = 0; i < 16; ++i) key[i] = kc[kh][i];
            }
            if (MODE == 0) {
                if (!done) {
                    LAS unsigned* HR = (LAS unsigned*)(L + AT_HIST) + 257 * q;
#pragma unroll
                    for (int i = 0; i < 16; ++i) {
                        const bool part = (lvl == 0) || ((key[i] >> psh) == pfx);
                        if (part) { const unsigned bin = (key[i] >> sh) & bmask; atomicAdd((unsigned*)(HR + (bin >> 1)), 1u << ((bin & 1u) << 4)); }
                    }
                }
            } else {
                unsigned mw = 0u, tw = 0u;
#pragma unroll
                for (int i = 15; i >= 0; --i) {
                    const bool sel = tie ? (key[i] > pfx) : ((key[i] >> sh) >= pfx);
                    const bool tb = tie && (key[i] == pfx);
                    mw = (mw << 1) | (sel ? 1u : 0u); tw = (tw << 1) | (tb ? 1u : 0u);
                    if ((i & 3) == 0 && i > 0) { mw <<= 4; tw <<= 4; }
                }
                mw <<= 4 * h; tw <<= 4 * h;
                if (mw) atomicOr((unsigned*)((LAS unsigned*)(L + AT_MASK) + 65 * q + 2 * t + kh), mw);
                if (tw) atomicOr((unsigned*)((LAS unsigned*)(L + AT_TMASK) + 65 * q + 2 * t + kh), tw);
            }
        }
    }
    if (FIRST) asm volatile("s_waitcnt vmcnt(0)" ::: "memory");
}

DI void attn_item(const Ctx& C, int l, int sb, int qb) {
    const int tid = C.tid, lane = C.lane, wave = C.wave, r = lane & 31, h = lane >> 5;
    LAS unsigned char* L = C.lds;
    const int P = sb_P(sb), row0 = sb_row0(sb), t0 = 64 * qb, pos0 = P + t0;
    const int ntiles = (pos0 >> 6) + 1, Ladm = 64 * ntiles;
    bf16_t* PJ = C.proj(); const bf16_t* KV = C.kvb(l) + kvb_off(sb);
    LAS unsigned* MASK = (LAS unsigned*)(L + AT_MASK); LAS unsigned* TMASK = (LAS unsigned*)(L + AT_TMASK);
    LAS unsigned* QST = (LAS unsigned*)(L + AT_QST); LAS unsigned* MISC = (LAS unsigned*)(L + AT_MISC);
#ifdef PROBE_QB
    const bool pcond = (l == 0 && sb == 0 && qb == PROBE_QB);
#else
    const bool pcond = false;
#endif
    const bool pc2 = (l == 0 && sb == 3 && qb == 31); (void)pc2;
    PROBE_BEGIN(40); PROBE_BEGIN(41); PROBE_BEGIN(29);
    for (int i = tid; i < 64 * 65; i += NTHREADS) { const int w = i % 65; MASK[i] = (Ladm <= 256 && w < 2 * ntiles) ? 0xffffffffu : 0u; TMASK[i] = 0u; }
    for (int i = tid; i < 64 * 257; i += NTHREADS) ((LAS unsigned*)(L + AT_HIST))[i] = 0u;
    if (tid < 64) { unsigned k256 = 256u; asm volatile("" : "+v"(k256)); QST[4 * tid] = 0u; QST[4 * tid + 1] = 0u; QST[4 * tid + 2] = k256; QST[4 * tid + 3] = 0u; }
    *(LAS f32x4*)(L + AT_LUT + 16 * tid) = *(const f32x4*)((const float*)(C.ws + WS_CTL + CW_LUTG * 4) + 4 * tid);
    if (tid == 0) MISC[0] = 0u;
    __syncthreads();
    if (pcond) PROBE_END(41, C);
    PROBE_BEGIN(4); PROBE_BEGIN(42);
    if (Ladm > 256) {
        const int qh = wave & 1, tq4 = wave >> 1, q = 32 * qh + r;
        float w4[4];
        { const f32x4 wv = *(const f32x4*)(C.wi() + (size_t)(row0 + t0 + q) * 4); w4[0] = wv[0]; w4[1] = wv[1]; w4[2] = wv[2]; w4[3] = wv[3]; }
        for (int i = tid; i < 2048; i += NTHREADS) { const int qq = i >> 5, pc = i & 31;
            *(LAS u32x4*)(L + AT_QI + qq * 528 + pc * 16) = *(const u32x4*)(PJ + (size_t)(row0 + t0 + qq) * PJW + C_QI + 8 * pc); }
        __syncthreads();
        for (int lvl = 0; lvl < 4; ++lvl) {
            PROBE_BEGIN(20); PROBE_BEGIN(24); PROBE_BEGIN(25);
            if (lvl == 0) idx_pass<0, true>(C, KV, w4, ntiles, tq4, qh, r, h); else idx_pass<0, false>(C, KV, w4, ntiles, tq4, qh, r, h);
            if (pc2 && lvl == 0) PROBE_END(24, C);
            if (pc2 && lvl > 0) PROBE_END(25, C);
            if (tid == 0) MISC[0] = 0u;
            __syncthreads();
            if (l == 0) PROBE_END(20, C);
            PROBE_BEGIN(21); PROBE_BEGIN(26);
            int ln = lane; asm volatile("" : "+v"(ln));
            for (int qq = 8 * wave; qq < 8 * wave + 8; ++qq) {
                const unsigned pfx = QST[4 * qq], info = QST[4 * qq + 1], need = QST[4 * qq + 2];
                if ((info >> 4) & 1) continue;
                LAS unsigned* HR = (LAS unsigned*)(L + AT_HIST) + 257 * qq + 4 * ln;
                unsigned c[8];
#pragma unroll
                for (int j = 0; j < 4; ++j) { const unsigned wv = HR[j]; c[2 * j] = wv & 0xffffu; c[2 * j + 1] = wv >> 16; HR[j] = 0u; }
                unsigned ct = 0u;
#pragma unroll
                for (int j = 0; j < 8; ++j) ct += c[j];
                const unsigned P_ = dpp_scan_u32(ct);
                const unsigned S = (unsigned)__builtin_amdgcn_readlane((int)P_, 63) - P_ + ct;
                if (S >= need && (S - ct) < need) {
                    unsigned rem = need - (S - ct), cum = 0u; int b = 0; unsigned cb = 0u;
                    bool found = false;
#pragma unroll
                    for (int j = 7; j >= 0; --j) { if (!found) { if (cum + c[j] >= rem) { b = j; cb = c[j]; found = true; } else cum += c[j]; } }
                    const unsigned need2 = rem - cum, binidx = 8u * ln + (unsigned)b;
                    const int bits = (lvl == 3) ? 5 : 9, shc = (lvl == 0) ? 23 : (lvl == 1 ? 14 : (lvl == 2 ? 5 : 0));
                    const unsigned npfx = (lvl == 0) ? binidx : ((pfx << bits) | binidx);
                    unsigned ninfo, nneed = need2, opfx = npfx;
                    if (need2 == cb) ninfo = (unsigned)lvl | 16u | ((unsigned)shc << 8);
                    else if (lvl == 0 && (binidx == 256u || binidx == 255u)) { ninfo = 16u | 32u; opfx = (binidx == 256u) ? 0x80000000u : 0x7fffffffu; }
                    else if (lvl == 3) ninfo = 16u | 32u;
                    else { ninfo = (unsigned)(lvl + 1); atomicAdd((unsigned*)MISC, 1u); }
                    QST[4 * qq] = opfx; QST[4 * qq + 1] = ninfo; QST[4 * qq + 2] = nneed;
                }
            }
            if (pc2) PROBE_END(26, C);
            __syncthreads();
            if (l == 0) PROBE_END(21, C);
            if (MISC[0] == 0u) break;
            __syncthreads();
        }
        PROBE_BEGIN(22); PROBE_BEGIN(27);
        idx_pass<1, false>(C, KV, w4, ntiles, tq4, qh, r, h);
        if (pc2) PROBE_END(27, C);
        __syncthreads();
        if (l == 0) PROBE_END(22, C);
        PROBE_BEGIN(23);
        int ln2 = lane; asm volatile("" : "+v"(ln2));
        for (int qq = 8 * wave; qq < 8 * wave + 8; ++qq) {
            if (!((QST[4 * qq + 1] >> 5) & 1)) continue;
            const unsigned mwd = (ln2 < 2 * ntiles) ? MASK[65 * qq + ln2] : 0u, twd = (ln2 < 2 * ntiles) ? TMASK[65 * qq + ln2] : 0u;
            const int have = __builtin_amdgcn_readlane((int)dpp_scan_u32((unsigned)__popc(mwd)), 63);
            const int want = 256 - have, pc = __popc(twd);
            const int incl = (int)dpp_scan_u32((unsigned)pc);
            int take = want - (incl - pc); take = take < 0 ? 0 : (take > pc ? pc : take);
            unsigned wrem = twd, add = 0u;
            for (int k = 0; k < take; ++k) { add |= wrem & (0u - wrem); wrem &= wrem - 1u; }
            if (add) MASK[65 * qq + ln2] = mwd | add;
        }
        __syncthreads();
        if (l == 0) PROBE_END(23, C);
    }
    if (l == 0) PROBE_END(4, C);
    if (pcond) PROBE_END(42, C);
    PROBE_BEGIN(43);
    PROBE_BEGIN(5); PROBE_BEGIN(28);
    const int hq = wave, kvh = wave >> 2;
    const unsigned ring = (unsigned)(size_t)(L + AT_RING);
    const float* LUT = nullptr; (void)LUT;
    const LAS float* lut = (const LAS float*)(L + AT_LUT) + 256 * hq;
    const float cfar = 1.4426950408889634f * C.inp(20)[15 * 8 + hq];
#define AT_DMA(tt, slot) do { const bf16_t* src_ = KV + (size_t)(64 * (tt)) * KVW; \
        _Pragma("unroll") for (int i_ = 0; i_ < 2; ++i_) { const int k_ = wave * 2 + i_, row_ = 4 * k_ + (lane >> 4), pc_ = lane & 15; \
            __builtin_amdgcn_global_load_lds((const unsigned*)(src_ + (size_t)row_ * KVW + 8 * (pc_ ^ (row_ & 15))), (LAS unsigned*)(L + AT_RING + (slot) * 32768 + k_ * 1024), 16, 0, 0); \
            __builtin_amdgcn_global_load_lds((const unsigned*)(src_ + (size_t)row_ * KVW + 128 + 8 * (pc_ ^ (4 * (row_ & 3)))), (LAS unsigned*)(L + AT_RING + (slot) * 32768 + 16384 + k_ * 1024), 16, 0, 0); } \
    } while (0)
    bf16x8 qfA[4], qfB[4];
#pragma unroll
    for (int qh = 0; qh < 2; ++qh) {
        const bf16_t* qp = PJ + (size_t)(row0 + t0 + 32 * qh + r) * PJW + C_Q + hq * 64 + 8 * h; float qv[4][8]; float ss = 0.f;
#pragma unroll
        for (int ks = 0; ks < 4; ++ks) { const u32x4 v = *(const u32x4*)(qp + 16 * ks);
            qv[ks][0] = __uint_as_float(v.x << 16); qv[ks][1] = __uint_as_float(v.x & 0xffff0000u); qv[ks][2] = __uint_as_float(v.y << 16); qv[ks][3] = __uint_as_float(v.y & 0xffff0000u);
            qv[ks][4] = __uint_as_float(v.z << 16); qv[ks][5] = __uint_as_float(v.z & 0xffff0000u); qv[ks][6] = __uint_as_float(v.w << 16); qv[ks][7] = __uint_as_float(v.w & 0xffff0000u);
#pragma unroll
            for (int j = 0; j < 8; ++j) ss += qv[ks][j] * qv[ks][j]; }
        ss = xor32_sum(ss);
        const float sc = rsqrtf(ss * (1.f / 64.f) + EPS) * (0.125f * 1.4426950408889634f);
        const float* qn = C.inp(18) + l * 64 + 8 * h;
#pragma unroll
        for (int ks = 0; ks < 4; ++ks) { const f32x4 n0 = *(const f32x4*)(qn + 16 * ks), n1 = *(const f32x4*)(qn + 16 * ks + 4);
            u32x4 p; p.x = cvt_pk_bf16(qv[ks][0] * sc * n0[0], qv[ks][1] * sc * n0[1]); p.y = cvt_pk_bf16(qv[ks][2] * sc * n0[2], qv[ks][3] * sc * n0[3]);
            p.z = cvt_pk_bf16(qv[ks][4] * sc * n1[0], qv[ks][5] * sc * n1[1]); p.w = cvt_pk_bf16(qv[ks][6] * sc * n1[2], qv[ks][7] * sc * n1[3]);
            if (qh == 0) qfA[ks] = __builtin_bit_cast(bf16x8, p); else qfB[ks] = __builtin_bit_cast(bf16x8, p); }
    }
    f32x16 oA0, oA1, oB0, oB1;
#pragma unroll
    for (int i = 0; i < 16; ++i) { oA0[i] = 0.f; oA1[i] = 0.f; oB0[i] = 0.f; oB1[i] = 0.f; }
    float mrefA = 0.f, lrunA = 0.f, mrefB = 0.f, lrunB = 0.f;
#define AT_QK(QF, S0, S1, MREF) do { \
        { const float ini = cfar - MREF; _Pragma("unroll") for (int i = 0; i < 16; ++i) { S0[i] = ini; S1[i] = ini; } } \
        _Pragma("unroll") for (int ks = 0; ks < 4; ++ks) { S0 = MFMA32(kf0[ks], QF[ks], S0); S1 = MFMA32(kf1[ks], QF[ks], S1); } \
    } while (0)
#define AT_PRE(QQ, S0, S1, KM0, KM1, MREF, LRUN, O0, O1) do { \
        KM0 = (int)(MASK[65 * (QQ) + 2 * t] >> (4 * h)); KM1 = (int)(MASK[65 * (QQ) + 2 * t + 1] >> (4 * h)); \
        if (nearb) { _Pragma("unroll") for (int i = 0; i < 16; ++i) { const int kl = (i & 3) + 8 * (i >> 2), rel = 64 * t + kl + 4 * h - (pos0 + (QQ)); S0[i] += lut[rel + 191]; S1[i] += lut[rel + 32 + 191]; } } \
        float tm; { float a = max3f(S0[0], S0[1], S1[0]), b = max3f(S0[2], S0[3], S1[1]); a = max3f(a, S1[2], S1[3]); \
            _Pragma("unroll") for (int i = 4; i < 16; i += 4) { a = max3f(a, S0[i], S0[i + 1]); b = max3f(b, S0[i + 2], S0[i + 3]); a = max3f(a, S1[i], S1[i + 1]); b = max3f(b, S1[i + 2], S1[i + 3]); } \
            tm = xor32_max(fmaxf(a, b)); } \
        if (__builtin_amdgcn_ballot_w64(tm > 0.f) != 0ull) { const float dl = fmaxf(tm, 0.f), al = __builtin_amdgcn_exp2f(-dl); MREF += dl; LRUN *= al; \
            _Pragma("unroll") for (int i = 0; i < 16; ++i) { S0[i] -= dl; S1[i] -= dl; O0[i] *= al; O1[i] *= al; } } \
    } while (0)
#define AT_EXPCH(S0, S1, KM0, KM1, c8) do { _Pragma("unroll") for (int i = 2 * (c8); i < 2 * (c8) + 2; ++i) { const int kl = (i & 3) + 8 * (i >> 2); \
            S0[i] = __int_as_float(__float_as_int(__builtin_amdgcn_exp2f(S0[i])) & __builtin_amdgcn_sbfe(KM0, kl, 1)); S1[i] = __int_as_float(__float_as_int(__builtin_amdgcn_exp2f(S1[i])) & __builtin_amdgcn_sbfe(KM1, kl, 1)); \
            psum += S0[i] + S1[i]; } } while (0)
#define AT_PACK(S0, S1, LRUN, PW) do { LRUN += psum; \
        _Pragma("unroll") for (int kk = 0; kk < 2; ++kk) { u32x4 w0, w1; \
            w0.x = cvt_pk_bf16(S0[8 * kk], S0[8 * kk + 1]); w0.y = cvt_pk_bf16(S0[8 * kk + 2], S0[8 * kk + 3]); w0.z = cvt_pk_bf16(S0[8 * kk + 4], S0[8 * kk + 5]); w0.w = cvt_pk_bf16(S0[8 * kk + 6], S0[8 * kk + 7]); \
            w1.x = cvt_pk_bf16(S1[8 * kk], S1[8 * kk + 1]); w1.y = cvt_pk_bf16(S1[8 * kk + 2], S1[8 * kk + 3]); w1.z = cvt_pk_bf16(S1[8 * kk + 4], S1[8 * kk + 5]); w1.w = cvt_pk_bf16(S1[8 * kk + 6], S1[8 * kk + 7]); \
            PW[kk] = __builtin_bit_cast(bf16x8, w0); PW[2 + kk] = __builtin_bit_cast(bf16x8, w1); } \
        asm volatile("" : "+v"(PW[0]), "+v"(PW[1]), "+v"(PW[2]), "+v"(PW[3]), "+v"(LRUN));     \
    } while (0)
#define AT_PV(PW, O0, O1) do { \
        _Pragma("unroll") for (int kk = 0; kk < 4; ++kk) { const int i16 = lane & 15, key0 = 16 * kk + 4 * h + (i16 >> 2); \
            _Pragma("unroll") for (int dh = 0; dh < 2; ++dh) { \
                const int dcol = kvh * 64 + 32 * dh + 16 * ((lane >> 4) & 1) + 4 * (i16 & 3); \
                const v4i16_t lo = __builtin_amdgcn_ds_read_tr16_b64_v4i16((LAS v4i16_t*)(Vt + key0 * 256 + (dcol * 2 ^ ((key0 & 3) << 6)))); \
                const v4i16_t hi = __builtin_amdgcn_ds_read_tr16_b64_v4i16((LAS v4i16_t*)(Vt + (key0 + 8) * 256 + (dcol * 2 ^ ((key0 & 3) << 6)))); \
                const bf16x8 va = (bf16x8){lo[0], lo[1], lo[2], lo[3], hi[0], hi[1], hi[2], hi[3]}; \
                if (dh == 0) O0 = MFMA32(va, PW[kk], O0); else O1 = MFMA32(va, PW[kk], O1); } } \
    } while (0)
    AT_WAIT_V(0);
    AT_DMA(0, 0);
    if (ntiles > 1) AT_DMA(1, 1);
    int sl = 0, sl2 = 2;
    for (int t = 0; t < ntiles; ++t) {
        if (t + 1 < ntiles) { AT_WAIT_V(4); } else { AT_WAIT_V(0); }
        AT_BAR();
        if (t + 2 < ntiles) AT_DMA(t + 2, sl2);
        const LAS unsigned char* Kt = L + AT_RING + sl * 32768; const LAS unsigned char* Vt = Kt + 16384;
        bf16x8 kf0[4], kf1[4];
#pragma unroll
        for (int ks = 0; ks < 4; ++ks) { const int pc = kvh * 8 + 2 * ks + h;
            kf0[ks] = *(const LAS bf16x8*)(Kt + r * 256 + ((pc ^ (r & 15)) << 4)); kf1[ks] = *(const LAS bf16x8*)(Kt + (32 + r) * 256 + ((pc ^ (r & 15)) << 4)); }
        const bool nearb = (t + 3 > ntiles - 1);
        bf16x8 pA[4], pB[4];
        f32x16 sA0, sA1, sB0, sB1; int kmA0, kmA1, kmB0, kmB1;
        AT_QK(qfA, sA0, sA1, mrefA);
        AT_PRE(r, sA0, sA1, kmA0, kmA1, mrefA, lrunA, oA0, oA1);
        { const float ini = cfar - mrefB;
#pragma unroll
          for (int i = 0; i < 16; ++i) { sB0[i] = ini; sB1[i] = ini; } }
        { float psum = 0.f;
#pragma unroll
          for (int c8 = 0; c8 < 8; ++c8) {
              AT_EXPCH(sA0, sA1, kmA0, kmA1, c8);
              if (c8 & 1) sB1 = MFMA32(kf1[c8 >> 1], qfB[c8 >> 1], sB1); else sB0 = MFMA32(kf0[c8 >> 1], qfB[c8 >> 1], sB0);
              __builtin_amdgcn_sched_barrier(0);
          }
          AT_PACK(sA0, sA1, lrunA, pA); }
        AT_PRE(32 + r, sB0, sB1, kmB0, kmB1, mrefB, lrunB, oB0, oB1);
        { float psum = 0.f;
#pragma unroll
          for (int c8 = 0; c8 < 8; ++c8) {
              const int kk = c8 >> 1, dh = c8 & 1, i16 = lane & 15, key0 = 16 * kk + 4 * h + (i16 >> 2), dcol = kvh * 64 + 32 * dh + 16 * ((lane >> 4) & 1) + 4 * (i16 & 3);
              const v4i16_t lo = __builtin_amdgcn_ds_read_tr16_b64_v4i16((LAS v4i16_t*)(Vt + key0 * 256 + (dcol * 2 ^ ((key0 & 3) << 6))));
              const v4i16_t hi = __builtin_amdgcn_ds_read_tr16_b64_v4i16((LAS v4i16_t*)(Vt + (key0 + 8) * 256 + (dcol * 2 ^ ((key0 & 3) << 6))));
              AT_EXPCH(sB0, sB1, kmB0, kmB1, c8);
              const bf16x8 va = (bf16x8){lo[0], lo[1], lo[2], lo[3], hi[0], hi[1], hi[2], hi[3]};
              if (dh == 0) oA0 = MFMA32(va, pA[kk], oA0); else oA1 = MFMA32(va, pA[kk], oA1);
              __builtin_amdgcn_sched_barrier(0);
          }
          AT_PACK(sB0, sB1, lrunB, pB); }
        AT_PV(pB, oB0, oB1);
        sl2 = sl; sl = (sl == 2) ? 0 : sl + 1; sl2 = (sl == 0) ? 2 : sl - 1;
    }
#undef AT_QK
#undef AT_PRE
#undef AT_EXPCH
#undef AT_PACK
#undef AT_PV
#pragma unroll
    for (int qh = 0; qh < 2; ++qh) {
        const float inv = 1.f / xor32_sum(qh == 0 ? lrunA : lrunB);
        bf16_t* gp = PJ + (size_t)(row0 + t0 + 32 * qh + r) * PJW + C_GA + hq * 64 + 4 * h;
#pragma unroll
        for (int dh = 0; dh < 2; ++dh)
#pragma unroll
            for (int gq = 0; gq < 4; ++gq) {
                const u32x2 gg = *(const u32x2*)(gp + 32 * dh + 8 * gq);
                const float g0 = __uint_as_float(gg.x << 16), g1 = __uint_as_float(gg.x & 0xffff0000u), g2 = __uint_as_float(gg.y << 16), g3 = __uint_as_float(gg.y & 0xffff0000u);
                const f32x16& oo = (qh == 0) ? (dh == 0 ? oA0 : oA1) : (dh == 0 ? oB0 : oB1);
                const float a0 = oo[4 * gq] * inv, a1 = oo[4 * gq + 1] * inv, a2 = oo[4 * gq + 2] * inv, a3 = oo[4 * gq + 3] * inv;
                u32x2 w; w.x = cvt_pk_bf16(a0 * fast_silu(g0), a1 * fast_silu(g1)); w.y = cvt_pk_bf16(a2 * fast_silu(g2), a3 * fast_silu(g3));
                *(u32x2*)(gp + 32 * dh + 8 * gq) = w;
            }
    }
#undef AT_DMA
    AT_WAIT_V(0);
    __syncthreads();
    if (l == 0) PROBE_END(5, C);
    if (pc2) { PROBE_END(28, C); PROBE_END(29, C); }
    if (pcond) { PROBE_END(43, C); PROBE_END(40, C); }
}

constexpr int LR_RAW = 0;
constexpr int LR_GL = LR_RAW + 67 * 128;
constexpr int LR_XC = LR_GL + 2 * 8192;
constexpr int LR_XCF = LR_XC + 64 * 144;
constexpr int LR_SEG = LR_XCF + 64 * 256;
constexpr int LR_YS = LR_SEG + 2048;
constexpr int LR_END = LR_YS + 8192;
static_assert(LR_END <= LDS_BYTES - 256, "LRU LDS map");
typedef float f32x4v __attribute__((ext_vector_type(4)));
#define MFMA16(a, b, c) __builtin_amdgcn_mfma_f32_16x16x32_bf16((a), (b), (c), 0, 0, 0)
DI float fast_sigmoid(float x) { return __builtin_amdgcn_rcpf(1.f + __builtin_amdgcn_exp2f(-1.4426950408889634f * x)); }

DI void lru_item(const Ctx& C, int l, int sb, int blk) {
    const int tid = C.tid, lane = C.lane, wave = C.wave, fr = lane & 15, fq = lane >> 4;
    const int T = sb_T(sb), row0 = sb_row0(sb), NC = T / 64;
    LAS unsigned char* L = C.lds;
    bf16_t* PJ = C.proj();
    const int ts = wave >> 1, dh = wave & 1;
    bf16x8 wf[2][2][2];
#pragma unroll
    for (int gt = 0; gt < 2; ++gt)
#pragma unroll
        for (int db = 0; db < 2; ++db)
#pragma unroll
            for (int kb = 0; kb < 2; ++kb) {
                const float* wp = (gt == 0 ? C.inp(13) : C.inp(15)) + ((size_t)(l * 8 + blk) * 64 + 32 * kb + 8 * fq) * 64 + 32 * dh + 16 * db + fr;
                u32x4 p; p.x = cvt_pk_bf16(wp[0], wp[64]); p.y = cvt_pk_bf16(wp[128], wp[192]); p.z = cvt_pk_bf16(wp[256], wp[320]); p.w = cvt_pk_bf16(wp[384], wp[448]);
                wf[gt][db][kb] = __builtin_bit_cast(bf16x8, p);
            }
    float ba[2], bx[2], spl[2], hc[2];
#pragma unroll
    for (int db = 0; db < 2; ++db) {
        const int ch = blk * 64 + 32 * dh + 16 * db + fr;
        ba[db] = C.inp(14)[l * 512 + ch]; bx[db] = C.inp(16)[l * 512 + ch]; spl[db] = 8.f * 1.4426950408889634f * softplus_f(-C.inp(17)[l * 512 + ch]);
        hc[db] = (sb >= NPB) ? C.inp(6)[(size_t)(l * NSB_S + sb - NPB) * 512 + ch] : 0.f;
    }
    const int cp = tid & 31, sg = tid >> 5;
    float cw[2][5];
#pragma unroll
    for (int e = 0; e < 2; ++e) { const int ch = blk * 64 + 2 * cp + e;
#pragma unroll
        for (int j = 0; j < 4; ++j) cw[e][j] = C.inp(11)[((size_t)l * 4 + j) * 512 + ch];
        cw[e][4] = C.inp(12)[l * 512 + ch]; }
#define LRU_DMA(cc) do { const int t0_ = 64 * (cc); \
        for (int k_ = wave; k_ < 9; k_ += NWAVES) { const int q_ = 64 * k_ + lane, rr_ = q_ >> 3, pc_ = q_ & 7, t_ = t0_ - 3 + rr_; \
            if (q_ < 536 && t_ >= 0) __builtin_amdgcn_global_load_lds((const unsigned*)(PJ + (size_t)(row0 + t_) * PJW + C_XL + blk * 64 + 8 * pc_), (LAS unsigned*)(L + LR_RAW + k_ * 1024), 16, 0, 0); } \
        { const int rr_ = 8 * wave + (lane >> 3), pc_ = lane & 7; \
          __builtin_amdgcn_global_load_lds((const unsigned*)(PJ + (size_t)(row0 + t0_ + rr_) * PJW + C_GL + blk * 64 + 8 * pc_), (LAS unsigned*)(L + LR_GL + ((cc) & 1) * 8192 + wave * 1024), 16, 0, 0); } \
    } while (0)
    if (tid < 24) {
        const int rr = tid >> 3, pc = tid & 7; u32x4 v = (u32x4){0u, 0u, 0u, 0u};
        if (sb >= NPB) { const float* st = C.inp(5) + ((size_t)(l * NSB_S + sb - NPB) * 3 + rr) * 512 + blk * 64 + 8 * pc; v = pack8(*(const f32x4*)st, *(const f32x4*)(st + 4)); }
        *(LAS u32x4*)(L + LR_RAW + rr * 128 + pc * 16) = v;
    }
    LRU_DMA(0);
    asm volatile("s_waitcnt vmcnt(0)" ::: "memory");
    __syncthreads();
    for (int c = 0; c < NC; ++c) {
        const int t0 = 64 * c;
        {
            float xa[7], xb[7];
#pragma unroll
            for (int i = 0; i < 7; ++i) { const unsigned w = *(const LAS unsigned*)(L + LR_RAW + (4 * sg + i) * 128 + 4 * cp); xa[i] = __uint_as_float(w << 16); xb[i] = __uint_as_float(w & 0xffff0000u); }
#pragma unroll
            for (int j = 0; j < 4; ++j) {
                const float ya = cw[0][4] + cw[0][0] * xa[j] + cw[0][1] * xa[j + 1] + cw[0][2] * xa[j + 2] + cw[0][3] * xa[j + 3];
                const float yb = cw[1][4] + cw[1][0] * xb[j] + cw[1][1] * xb[j + 1] + cw[1][2] * xb[j + 2] + cw[1][3] * xb[j + 3];
                *(LAS unsigned*)(L + LR_XC + (4 * sg + j) * 144 + 4 * cp) = cvt_pk_bf16(ya, yb);
                f32x2_t v2 = {ya, yb}; *(LAS f32x2_t*)(L + LR_XCF + (4 * sg + j) * 256 + 8 * cp) = v2;
            }
        }
        LDS_FENCE(); __syncthreads();
        if (c + 1 < NC) LRU_DMA(c + 1);
        f32x4v ga[2], gx[2];
#pragma unroll
        for (int db = 0; db < 2; ++db) { ga[db] = (f32x4v){0.f, 0.f, 0.f, 0.f}; gx[db] = (f32x4v){0.f, 0.f, 0.f, 0.f}; }
#pragma unroll
        for (int kb = 0; kb < 2; ++kb) {
            const bf16x8 af = *(const LAS bf16x8*)(L + LR_XC + (16 * ts + fr) * 144 + (32 * kb + 8 * fq) * 2);
#pragma unroll
            for (int db = 0; db < 2; ++db) { ga[db] = MFMA16(af, wf[0][db][kb], ga[db]); gx[db] = MFMA16(af, wf[1][db][kb], gx[db]); }
        }
        float Pk[2][4], Hk[2][4], Pq[2], Hq[2];
#pragma unroll
        for (int db = 0; db < 2; ++db) {
            float P = 1.f, H = 0.f;
#pragma unroll
            for (int reg = 0; reg < 4; ++reg) {
                const float xc = *(const LAS float*)(L + LR_XCF + (16 * ts + 4 * fq + reg) * 256 + (32 * dh + 16 * db + fr) * 4);
                const float rg = fast_sigmoid(ga[db][reg] + ba[db]), ig = fast_sigmoid(gx[db][reg] + bx[db]);
                const float a = __builtin_amdgcn_exp2f(-rg * spl[db]);
                const float b = sqrtf(fmaxf(1.f - a * a, 0.f)) * (ig * xc);
                H = a * H + b; P = a * P; Pk[db][reg] = P; Hk[db][reg] = H;
            }
            float Pi = P, Hi = H;
            { const float Pp = bperm(Pi, lane - 16), Hp = bperm(Hi, lane - 16); if (fq >= 1) { Hi = Pi * Hp + Hi; Pi = Pi * Pp; } }
            { const float Pp = bperm(Pi, lane - 32), Hp = bperm(Hi, lane - 32); if (fq >= 2) { Hi = Pi * Hp + Hi; Pi = Pi * Pp; } }
            if (fq == 3) { f32x2_t v2 = {Pi, Hi}; *(LAS f32x2_t*)(L + LR_SEG + (ts * 64 + 32 * dh + 16 * db + fr) * 8) = v2; }
            const float Pe = bperm(Pi, lane - 16), He = bperm(Hi, lane - 16);
            Pq[db] = (fq >= 1) ? Pe : 1.f; Hq[db] = (fq >= 1) ? He : 0.f;
        }
        LDS_FENCE(); __syncthreads();
#pragma unroll
        for (int db = 0; db < 2; ++db) {
            float s = hc[db], sin = hc[db];
#pragma unroll
            for (int k = 0; k < 4; ++k) { const f32x2_t m = *(const LAS f32x2_t*)(L + LR_SEG + (k * 64 + 32 * dh + 16 * db + fr) * 8); if (k == ts) sin = s; s = m[0] * s + m[1]; }
            hc[db] = s;
            const float hin = Pq[db] * sin + Hq[db];
            const bf16_t* glp = nullptr; (void)glp;
#pragma unroll
            for (int reg = 0; reg < 4; ++reg) {
                const float hval = Pk[db][reg] * hin + Hk[db][reg];
                const int t = 16 * ts + 4 * fq + reg, d = 32 * dh + 16 * db + fr;
                const float glv = bf2f(*(const LAS bf16_t*)(L + LR_GL + (c & 1) * 8192 + t * 128 + d * 2));
                *(LAS bf16_t*)(L + LR_YS + t * 128 + d * 2) = f2bf(hval * fast_silu(glv));
            }
        }
        asm volatile("s_waitcnt vmcnt(0)" ::: "memory");
        LDS_FENCE(); __syncthreads();
        { const int rr = tid >> 3, pc = tid & 7;
          *(u32x4*)(PJ + (size_t)(row0 + t0 + rr) * PJW + C_GL + blk * 64 + 8 * pc) = *(const LAS u32x4*)(L + LR_YS + rr * 128 + pc * 16); }
    }
    if (ts == 0 && fq == 0) {
#pragma unroll
        for (int db = 0; db < 2; ++db) out_lh(C, l, sb)[blk * 64 + 32 * dh + 16 * db + fr] = hc[db];
    }
#undef LRU_DMA
    asm volatile("s_waitcnt vmcnt(0)" ::: "memory");
    __syncthreads();
}

DI Ctx relaunder(const Ctx& C0) {
    Ctx C = C0; int ln; asm volatile("v_mbcnt_lo_u32_b32 %0, -1, 0\n\tv_mbcnt_hi_u32_b32 %0, -1, %0" : "=v"(ln)); C.lane = ln; C.tid = C.wave * 64 + ln;
    { unsigned long long w = (unsigned long long)C.ws, o = (unsigned long long)C.out; asm volatile("" : "+s"(w), "+s"(o));
      C.ws = (unsigned char*)(__attribute__((address_space(1))) unsigned char*)w; C.out = (float*)(__attribute__((address_space(1))) float*)o; }
    asm volatile("" : "+s"(C.G), "+s"(C.bid));
    return C;
}
constexpr int CW_QUEUE = 8192;
constexpr int MX_PREP = 256;
constexpr int MX_ACT = ROWS / 64;
constexpr int MX_A = 144, MX_B = MX_A + 256, MX_C0 = MX_B + 8, MX_C = MX_C0 + 240, MX_D = MX_C + 128, MX_E = MX_D + 128, MX_F = MX_E + 128, MX_N = MX_F + 64;
DI void phase_mixers(const Ctx& Cin, int l) {
    unsigned* head = (unsigned*)(Cin.ws + WS_CTL) + CW_QUEUE + 64 * l;
    volatile LAS int* slot = (volatile LAS int*)(Cin.lds + LDS_BYTES - 24);
    for (;;) {
        __syncthreads();
        if (Cin.tid == 0) *slot = (int)__hip_atomic_fetch_add(head, 1u, __ATOMIC_RELAXED, __HIP_MEMORY_SCOPE_AGENT);
        __syncthreads();
        const int iq = __builtin_amdgcn_readfirstlane(*slot);
        if (iq >= MX_ACT + MX_N + (l == 0 ? MX_PREP : 0)) break;
        if (iq < MX_ACT) { const Ctx CA = relaunder(Cin); bcact_item(CA, l, iq); continue; }
        const Ctx C = relaunder(Cin);
        const int i = iq - MX_ACT;
        if (i >= MX_N) { prep_layer(C, 1, i - MX_N, MX_PREP); continue; }
        int kind, sb, sub;
        if (i < MX_A) { kind = 0; sb = i & 15; sub = 31 - (i >> 4); }
        else if (i < MX_B) { const int j = i - MX_A; kind = 1; sb = j >> 4; sub = j & 15; }
        else if (i < MX_C0) { kind = 0; sb = NPB + (i - MX_B); sub = 0; }
        else if (i < MX_C) { const int j = i - MX_C0; kind = 0; sb = j & 15; sub = 22 - (j >> 4); }
        else if (i < MX_D) { const int j = i - MX_C; kind = 2; sb = j >> 3; sub = j & 7; }
        else if (i < MX_E) { const int j = i - MX_D; kind = 0; sb = j & 15; sub = 7 - (j >> 4); }
        else if (i < MX_F) { const int j = i - MX_E; kind = 1; sb = NPB + (j >> 4); sub = j & 15; }
        else { const int j = i - MX_F; kind = 2; sb = NPB + (j >> 3); sub = j & 7; }
        PROBE_BEGIN(50); PROBE_BEGIN(51); PROBE_BEGIN(52); PROBE_BEGIN(53);
        if (kind == 0) attn_item(C, l, sb, sub);
        else if (kind == 1) ssd_item(C, l, sb, sub);
        else lru_item(C, l, sb, sub);
        if (l == 0) { PROBE_END(50, C); if (kind == 0) PROBE_END(51, C); if (kind == 1) PROBE_END(52, C); if (kind == 2) PROBE_END(53, C); }
    }
}

#define XB_TMO      128
#define XB_XCNT(j)  (256  + 64 * (j))
#define XB_XSUB(j)  (1280 + 64 * (j))
#define XB_XGEN(j)  (2304 + 64 * (j))
#define XB_TOP      3328
#define XB_TOPGEN   3392
#define XCD_BAR_WORDS 3456
#define XB_SPIN_CAP (1u << 22)

__device__ __forceinline__ unsigned xb_ld(unsigned* p)              { return __hip_atomic_load(p, __ATOMIC_RELAXED, __HIP_MEMORY_SCOPE_AGENT); }
__device__ __forceinline__ unsigned xb_add(unsigned* p, unsigned v) { return __hip_atomic_fetch_add(p, v, __ATOMIC_RELAXED, __HIP_MEMORY_SCOPE_AGENT); }
__device__ __forceinline__ unsigned xb_xcc_id() { return (unsigned)__builtin_amdgcn_s_getreg((3 << 11) | 20) & 0xFu; }
#define XB_SPIN(cond, bar) do { unsigned _sp = 0; while (cond) { __builtin_amdgcn_s_sleep(1); \
    if ((++_sp & 255u) == 0u) { if (xb_ld(&(bar)[XB_TMO])) break; if (_sp > XB_SPIN_CAP) { atomicAdd(&(bar)[XB_TMO], 1u); break; } } } } while (0)

struct XcdBarrier {
    unsigned* bar; unsigned x;
    volatile LAS unsigned* st;
};

__device__ __forceinline__ XcdBarrier xcd_barrier_post(unsigned* bar, volatile LAS unsigned* st) {
    XcdBarrier b; b.bar = bar; b.x = xb_xcc_id(); b.st = st;
    if (threadIdx.x == 0) (void)xb_add(&bar[XB_XCNT(b.x)], 1u);
    return b;
}
__device__ __forceinline__ void xcd_barrier_complete(unsigned* bar, unsigned x, unsigned& nloc, unsigned& nx) {
    const unsigned G = gridDim.x * gridDim.y * gridDim.z;
    unsigned sum, cnt, mine, sp = 0u;
    for (;;) {
        sum = 0u; cnt = 0u; mine = 0u;
#pragma unroll
        for (unsigned j = 0; j < 16; ++j) { const unsigned c = xb_ld(&bar[XB_XCNT(j)]); sum += c; cnt += (c > 0u) ? 1u : 0u; mine = (j == x) ? c : mine; }
        if (sum == G) break;
        __builtin_amdgcn_s_sleep(1);
        if ((++sp & 255u) == 0u) { if (xb_ld(&bar[XB_TMO])) break; if (sp > XB_SPIN_CAP) { atomicAdd(&bar[XB_TMO], 1u); break; } }
    }
    nloc = mine > 0u ? mine : 1u; nx = cnt > 0u ? cnt : 1u;
}

__device__ __forceinline__ void xcd_barrier(const XcdBarrier& b) {
    asm volatile("s_waitcnt vmcnt(0)" ::: "memory");
    __syncthreads();
    if (threadIdx.x == 0) {
        unsigned* bar = b.bar;
        __builtin_amdgcn_s_waitcnt(0);
        unsigned nloc = b.st[0], nx = b.st[1];
        if (nloc == 0u) { xcd_barrier_complete(bar, b.x, nloc, nx); b.st[0] = nloc; b.st[1] = nx; }
        const unsigned old = xb_add(&bar[XB_XSUB(b.x)], 1u);
        const unsigned gen = old / nloc;
        if (old + 1u == (gen + 1u) * nloc) {
            __builtin_amdgcn_fence(__ATOMIC_RELEASE, "agent");
            asm volatile("s_waitcnt vmcnt(0)" ::: "memory");
            const unsigned og = xb_add(&bar[XB_TOP], 1u);
            const unsigned tg = og / nx;
            if (og + 1u == (tg + 1u) * nx) xb_add(&bar[XB_TOPGEN], 1u);
            else XB_SPIN(xb_ld(&bar[XB_TOPGEN]) == tg, bar);
            __builtin_amdgcn_fence(__ATOMIC_ACQUIRE, "agent");
            xb_add(&bar[XB_XGEN(b.x)], 1u);
            asm volatile("s_waitcnt vmcnt(0)" ::: "memory");
        } else {
            XB_SPIN(xb_ld(&bar[XB_XGEN(b.x)]) == gen, bar);
            __builtin_amdgcn_fence(__ATOMIC_ACQUIRE, "agent");
            asm volatile("s_waitcnt vmcnt(0)" ::: "memory");
        }
    }
    __syncthreads();
}


constexpr int PH_PER_LAYER = 3;
constexpr int N_PHASES = 1 + 2 * PH_PER_LAYER;
constexpr int CW_BAR = 4096;
__global__ void __launch_bounds__(NTHREADS, 2) mk_fwd(Args a) {
    extern __shared__ __attribute__((aligned(16))) unsigned char lds_raw[];
    Ctx C; C.out = a.out; C.ws = a.ws; C.lds = (LAS unsigned char*)lds_raw;
    C.tid = threadIdx.x; C.lane = C.tid & 63; C.wave = __builtin_amdgcn_readfirstlane(C.tid >> 6); C.G = gridDim.x; C.bid = blockIdx.x;
    if (C.tid == 0) {
#pragma unroll
        for (int i = 0; i < 28; ++i) ((LAS cfp_t*)(C.lds + LDS_BYTES - 256))[i] = a.in[i];
        ((volatile LAS unsigned*)(C.lds + LDS_BYTES - 32))[0] = 0u; ((volatile LAS unsigned*)(C.lds + LDS_BYTES - 32))[1] = 0u;
        *(LAS unsigned long long*)(C.lds + LDS_BYTES - 16) = 0ull;
    }
    __syncthreads();
    const XcdBarrier bar = xcd_barrier_post((unsigned*)(a.ws + WS_CTL) + CW_BAR, (volatile LAS unsigned*)(C.lds + LDS_BYTES - 32));
    const Ctx C0 = C;
#define LAUNDER() const Ctx C = relaunder(C0)
#ifdef PROBE_PHASE
    unsigned long long pr_t0 = 0, pr_t1 = 0;
#endif
    for (int ph = a.ph_lo; ph < a.ph_hi; ++ph) {
#ifdef PROBE_PHASE
        if (ph == PROBE_PHASE) pr_t0 = __builtin_amdgcn_s_memrealtime();
#endif
        if (ph == 0) { LAUNDER(); phase_prologue(C); }
        else {
            const int l = (ph - 1) / PH_PER_LAYER, k = (ph - 1) % PH_PER_LAYER;
            if (k == 0) { LAUNDER(); phase_inproj_gemm(C, l); }
            else if (k == 1) { LAUNDER(); phase_mixers(C, l); }
            else { LAUNDER(); phase_outproj_gemm(C, l); }
        }
        if (ph + 1 < a.ph_hi) { if (a.ph_hi > N_PHASES) cg::this_grid().sync(); else xcd_barrier(bar); }
#ifdef PROBE_PHASE
        if (ph == PROBE_PHASE) pr_t1 = __builtin_amdgcn_s_memrealtime();
#endif
    }
#ifdef PROBE_PHASE
#ifdef PROBE_SUB
    pr_t0 = 0; pr_t1 = *(LAS unsigned long long*)(C0.lds + LDS_BYTES - 16);
#endif
#ifndef PROBE_BLOCK
#define PROBE_BLOCK 0
#endif
    if (PROBE_BLOCK < 0 || (int)blockIdx.x == PROBE_BLOCK) { const unsigned long long te = __builtin_amdgcn_s_memrealtime(), span = 4ull * (pr_t1 - pr_t0); while (__builtin_amdgcn_s_memrealtime() - te < span) __builtin_amdgcn_s_sleep(8); }
#endif
}

extern "C" void kernel_launch(void* const* d_in, const int* in_sizes, int n_in, void* d_out, int out_size, void* d_ws, size_t ws_size, hipStream_t stream) {
    static int grid = 0;
    if (grid == 0) {
        if (n_in != 28 || (size_t)out_size != O_END || ws_size < WS_END) { fprintf(stderr, "kernel_launch: unexpected shapes n_in %d out %d ws %zu\n", n_in, out_size, ws_size); grid = -1; return; }
        int dev = 0, cus = 0, per_cu = 0;
        hipGetDevice(&dev); hipDeviceGetAttribute(&cus, hipDeviceAttributeMultiprocessorCount, dev);
        hipFuncSetAttribute((const void*)mk_fwd, hipFuncAttributeMaxDynamicSharedMemorySize, LDS_BYTES);
        hipOccupancyMaxActiveBlocksPerMultiprocessor(&per_cu, (const void*)mk_fwd, NTHREADS, LDS_BYTES);
        if (per_cu < 1) per_cu = 1;
        grid = cus * 1;
        (void)hipGetLastError();
    }
    if (grid < 0) return;
    hipMemsetAsync((char*)d_ws + WS_CTL, 0, CTL_BYTES, stream);
    Args a{};
    for (int i = 0; i < 28; ++i) a.in[i] = (const float*)d_in[i];
    a.out = (float*)d_out; a.ws = (unsigned char*)d_ws;
    a.ph_lo = 0; a.ph_hi = N_PHASES;
    void* args[] = {&a};
    hipError_t e = hipLaunchCooperativeKernel((const void*)mk_fwd, dim3(grid), dim3(NTHREADS), args, LDS_BYTES, stream);
    if (e != hipSuccess) fprintf(stderr, "cooperative launch failed: %s (grid %d)\n", hipGetErrorString(e), grid);
}
```
